# Optimizing an MI355X kernel written in HIP

```python
import math
import jax, jax.numpy as jnp
from jax import lax
import numpy as np

D_MODEL = 1024
BATCH = 8
SEQ = 2048
DEPTH = 1
DEC_BATCH = 128
DEC_SEQ = 1
PAST_LEN = 16384
PAGE_SIZE = 128

HEAD_DIM = 64
N_Q_HEADS = D_MODEL // HEAD_DIM
N_KV_HEADS = 2
GROUP = N_Q_HEADS // N_KV_HEADS
ATTN_WIDTH = N_Q_HEADS * HEAD_DIM
KV_WIDTH = N_KV_HEADS * HEAD_DIM
WINDOW = 128
ATTN_BLOCK = WINDOW
N_BUCKETS = 32
MAX_DISTANCE = 128
POOL_WINDOWS = (2, 4, 8, 16)
N_POOL_GROUPS = len(POOL_WINDOWS)
POOL_WIDTH = D_MODEL // 2
POOL_GROUP = POOL_WIDTH // N_POOL_GROUPS
POOL_OUT_GROUP = D_MODEL // N_POOL_GROUPS
POOL_HIST = max(POOL_WINDOWS) - 1
IN_WIDTH = ATTN_WIDTH + 2 * KV_WIDTH + POOL_WIDTH + 2 * D_MODEL
PEER_HEADS = 8
PEER_N_KEYS = 128
PEER_N_EXPERTS = PEER_N_KEYS * PEER_N_KEYS
PEER_KEY_DIM = 256
PEER_HALF = PEER_KEY_DIM // 2
PEER_TOPK = 16
PEER_CHUNK = 256
EPS = 1e-6

kernel_name = "hybrid_swa_pool_peer_adaln_step"


def rms_norm(x, g):
    xf = x.astype(jnp.float32)
    y = xf * lax.rsqrt(jnp.mean(xf * xf, axis=-1, keepdims=True) + EPS)
    return (y * g.astype(jnp.float32)).astype(x.dtype)


def rel_bucket(dist):
    d = jnp.maximum(dist, 0)
    max_exact = N_BUCKETS // 2
    df = jnp.maximum(d, 1).astype(jnp.float32)
    large = max_exact + (jnp.log(df / max_exact) / math.log(MAX_DISTANCE / max_exact)
                         * (N_BUCKETS - max_exact)).astype(jnp.int32)
    large = jnp.minimum(large, N_BUCKETS - 1)
    return jnp.where(d < max_exact, d, large)


def rel_bias(dist, table):
    b = table[rel_bucket(dist)]
    b = jnp.transpose(b, (2, 0, 1)).astype(jnp.float32)
    return b.reshape(N_KV_HEADS, GROUP, dist.shape[0], dist.shape[1])


def sink_attention(q, k, v, bias, mask, sinks):
    s = jnp.einsum('...qhgd,...khd->...hgqk', q, k,
                   preferred_element_type=jnp.float32) * (HEAD_DIM ** -0.5) + bias
    s = jnp.where(mask, s, -jnp.inf)
    sink = sinks.astype(jnp.float32).reshape(N_KV_HEADS, GROUP, 1, 1)
    m = jnp.maximum(jnp.max(s, axis=-1, keepdims=True), sink)
    p = jnp.exp(s - m)
    denom = jnp.sum(p, axis=-1, keepdims=True) + jnp.exp(sink - m)
    w = (p / denom).astype(v.dtype)
    return jnp.einsum('...hgqk,...khd->...qhgd', w, v)


def prompt_attention(q, k, v, table, sinks):
    B, T = q.shape[:2]
    nb = T // ATTN_BLOCK
    qb = q.reshape(B, nb, ATTN_BLOCK, N_KV_HEADS, GROUP, HEAD_DIM)

    def band(t):
        cur = t.reshape(B, nb, ATTN_BLOCK, N_KV_HEADS, HEAD_DIM)
        prev = jnp.concatenate([jnp.zeros_like(cur[:, :1]), cur[:, :-1]], axis=1)
        return jnp.concatenate([prev, cur], axis=2)

    kb, vb = band(k), band(v)
    qi = jnp.arange(ATTN_BLOCK)[:, None]
    kj = jnp.arange(2 * ATTN_BLOCK)[None, :]
    dist = qi + ATTN_BLOCK - kj
    blk = jnp.arange(nb)[:, None, None]
    valid = (dist >= 0) & (dist < WINDOW) & (blk * ATTN_BLOCK - ATTN_BLOCK + kj >= 0)
    mask = valid[None, :, None, None]
    out = sink_attention(qb, kb, vb, rel_bias(dist, table), mask, sinks)
    return out.reshape(B, T, ATTN_WIDTH)


def sample_attention(q, k, v, cache_k, cache_v, table, sinks):
    B, T = q.shape[:2]
    k_all = jnp.concatenate([cache_k, k], axis=1)
    v_all = jnp.concatenate([cache_v, v], axis=1)
    dist = jnp.arange(T)[:, None] + WINDOW - jnp.arange(WINDOW + T)[None, :]
    valid = (dist >= 0) & (dist < WINDOW)
    qg = q.reshape(B, T, N_KV_HEADS, GROUP, HEAD_DIM)
    out = sink_attention(qg, k_all, v_all, rel_bias(dist, table), valid, sinks)
    return out.reshape(B, T, ATTN_WIDTH), k_all[:, -WINDOW:], v_all[:, -WINDOW:]


def pool_mix(p_ext, pos, w_pool, pool_scale):
    T = pos.shape[0]
    pf = p_ext.astype(jnp.float32)
    cs = jnp.concatenate([jnp.zeros_like(pf[:, :1]), jnp.cumsum(pf, axis=1)], axis=1)
    outs = []
    for g, w in enumerate(POOL_WINDOWS):
        sl = slice(g * POOL_GROUP, (g + 1) * POOL_GROUP)
        tot = cs[:, POOL_HIST + 1:, sl] - cs[:, POOL_HIST + 1 - w:POOL_HIST + 1 - w + T, sl]
        cnt = jnp.minimum(w, pos + 1).astype(jnp.float32)[None, :, None]
        r = (tot / cnt - pf[:, POOL_HIST:, sl]).astype(p_ext.dtype)
        outs.append(r @ w_pool[g])
    return jnp.concatenate(outs, axis=-1) * pool_scale


def peer_ffn(h, w_query, sub_keys, u, v):
    B, T, D = h.shape
    n = B * T
    xt = h.reshape(n, D)
    qry = (xt @ w_query).reshape(n, PEER_HEADS, 2, PEER_HALF)
    s = jnp.einsum('nhpd,hpkd->nhpk', qry, sub_keys, preferred_element_type=jnp.float32)
    top_s, top_i = lax.top_k(s, PEER_TOPK)
    cand_s = (top_s[:, :, 0, :, None] + top_s[:, :, 1, None, :]).reshape(n, PEER_HEADS, PEER_TOPK * PEER_TOPK)
    cand_i = (top_i[:, :, 0, :, None] * PEER_N_KEYS + top_i[:, :, 1, None, :]).reshape(n, PEER_HEADS, PEER_TOPK * PEER_TOPK)
    best_s, best_pos = lax.top_k(cand_s, PEER_TOPK)
    idx = jnp.take_along_axis(cand_i, best_pos, axis=-1).reshape(n, PEER_HEADS * PEER_TOPK)
    gates = jax.nn.softmax(best_s, axis=-1).reshape(n, PEER_HEADS * PEER_TOPK).astype(h.dtype)
    chunk = min(PEER_CHUNK, n)
    n_chunks = -(-n // chunk)
    pad = n_chunks * chunk - n
    xt_p = jnp.pad(xt, ((0, pad), (0, 0))).reshape(n_chunks, chunk, D)
    idx_p = jnp.pad(idx, ((0, pad), (0, 0))).reshape(n_chunks, chunk, PEER_HEADS * PEER_TOPK)
    g_p = jnp.pad(gates, ((0, pad), (0, 0))).reshape(n_chunks, chunk, PEER_HEADS * PEER_TOPK)

    def experts(args):
        xc, ic, gc = args
        act = jax.nn.gelu(jnp.einsum('cd,ced->ce', xc, u[ic]), approximate=False)
        return jnp.einsum('ce,ced->cd', gc * act, v[ic])

    out = lax.map(experts, (xt_p, idx_p, g_p)).reshape(n_chunks * chunk, D)[:n]
    return out.reshape(B, T, D)


def trunk_layer(x, c, pos, cache_k, cache_v, pool_hist, rel_table, ada_w, ada_b, norm1_g, w_in,
                q_norm_g, k_norm_g, sinks, pool_w, pool_scale, w_out, norm2_g,
                peer_w_query, peer_sub_keys, peer_u, peer_v):
    B, T = x.shape[:2]
    mod = (jax.nn.silu(c) @ ada_w + ada_b)[:, None, :]
    shift1, scale1, gate1, shift2, scale2, gate2 = jnp.split(mod, 6, axis=-1)
    h1 = rms_norm(x, norm1_g) * (1 + scale1) + shift1
    proj = h1 @ w_in
    cuts = [ATTN_WIDTH, ATTN_WIDTH + KV_WIDTH, ATTN_WIDTH + 2 * KV_WIDTH,
            ATTN_WIDTH + 2 * KV_WIDTH + POOL_WIDTH, ATTN_WIDTH + 2 * KV_WIDTH + POOL_WIDTH + D_MODEL]
    q, k, v, pin, gate_a, gate_b = jnp.split(proj, cuts, axis=-1)
    q = rms_norm(q.reshape(B, T, N_Q_HEADS, HEAD_DIM), q_norm_g)
    k = rms_norm(k.reshape(B, T, N_KV_HEADS, HEAD_DIM), k_norm_g)
    v = v.reshape(B, T, N_KV_HEADS, HEAD_DIM)
    if cache_k is None:
        attn = prompt_attention(q, k, v, rel_table, sinks)
        k_buf, v_buf = k[:, -WINDOW:], v[:, -WINDOW:]
        pool_hist = jnp.zeros((B, POOL_HIST, POOL_WIDTH), pin.dtype)
    else:
        attn, k_buf, v_buf = sample_attention(q, k, v, cache_k, cache_v, rel_table, sinks)
    p_ext = jnp.concatenate([pool_hist, pin], axis=1)
    pool = pool_mix(p_ext, pos, pool_w, pool_scale)
    mixed = jax.nn.sigmoid(gate_a) * attn + jax.nn.sigmoid(gate_b) * pool
    x = x + gate1 * (mixed @ w_out)
    h2 = rms_norm(x, norm2_g) * (1 + scale2) + shift2
    x = x + gate2 * peer_ffn(h2, peer_w_query, peer_sub_keys, peer_u, peer_v)
    return x, k_buf, v_buf, p_ext[:, -POOL_HIST:]


def setup_inputs(seed: int = 0) -> dict:
    key = jax.random.key(seed)
    ks = jax.random.split(key, 24)

    def nrm(k, shape, scale):
        return jax.random.normal(k, shape, jnp.float32) * scale

    D = D_MODEL
    return {
        "x_prompt": nrm(ks[0], (BATCH, SEQ, D), 1.0),
        "x_sample": nrm(ks[1], (DEC_BATCH, DEC_SEQ, D), 1.0),
        "cache_k_win": nrm(ks[2], (DEPTH, DEC_BATCH, WINDOW, N_KV_HEADS, HEAD_DIM), 1.0),
        "cache_v_win": nrm(ks[3], (DEPTH, DEC_BATCH, WINDOW, N_KV_HEADS, HEAD_DIM), 1.0),
        "state_pool": nrm(ks[4], (DEPTH, DEC_BATCH, POOL_HIST, POOL_WIDTH), 1.0),
        "c_prompt": nrm(ks[5], (BATCH, D), 1.0),
        "c_sample": nrm(ks[6], (DEC_BATCH, D), 1.0),
        "rel_bias_table": nrm(ks[7], (N_BUCKETS, N_Q_HEADS), 0.5),
        "ada_w": nrm(ks[8], (DEPTH, D, 6 * D), 0.3 * D ** -0.5),
        "ada_b": nrm(ks[9], (DEPTH, 6 * D), 0.02),
        "norm1_g": 1.0 + nrm(ks[10], (DEPTH, D), 0.1),
        "w_in": nrm(ks[11], (DEPTH, D, IN_WIDTH), D ** -0.5),
        "q_norm_g": 1.0 + nrm(ks[12], (DEPTH, HEAD_DIM), 0.1),
        "k_norm_g": 1.0 + nrm(ks[13], (DEPTH, HEAD_DIM), 0.1),
        "attn_sinks": nrm(ks[14], (DEPTH, N_Q_HEADS), 0.5),
        "pool_w": nrm(ks[15], (DEPTH, N_POOL_GROUPS, POOL_GROUP, POOL_OUT_GROUP), POOL_GROUP ** -0.5),
        "pool_scale": 1.0 + nrm(ks[16], (DEPTH, D), 0.1),
        "w_out": nrm(ks[17], (DEPTH, D, D), D ** -0.5),
        "norm2_g": 1.0 + nrm(ks[18], (DEPTH, D), 0.1),
        "peer_w_query": nrm(ks[19], (DEPTH, D, PEER_HEADS * PEER_KEY_DIM), D ** -0.5),
        "peer_sub_keys": nrm(ks[20], (DEPTH, PEER_HEADS, 2, PEER_N_KEYS, PEER_HALF), PEER_HALF ** -0.5),
        "peer_u": nrm(ks[21], (DEPTH, PEER_N_EXPERTS, D), D ** -0.5),
        "peer_v": nrm(ks[22], (DEPTH, PEER_N_EXPERTS, D), 0.5),
    }


def reference(x_prompt, x_sample, cache_k_win, cache_v_win, state_pool, c_prompt, c_sample,
              rel_bias_table, ada_w, ada_b, norm1_g, w_in, q_norm_g, k_norm_g, attn_sinks,
              pool_w, pool_scale, w_out, norm2_g, peer_w_query, peer_sub_keys, peer_u, peer_v):
    pos_p = jnp.arange(x_prompt.shape[1], dtype=jnp.int32)
    pos_s = PAST_LEN + jnp.arange(x_sample.shape[1], dtype=jnp.int32)
    xp, xs = x_prompt, x_sample
    kp, vp, pp, ks_, vs_, ps_ = [], [], [], [], [], []
    for l in range(DEPTH):
        xp, k_buf, v_buf, p_buf = trunk_layer(
            xp, c_prompt, pos_p, None, None, None, rel_bias_table, ada_w[l], ada_b[l], norm1_g[l],
            w_in[l], q_norm_g[l], k_norm_g[l], attn_sinks[l], pool_w[l], pool_scale[l], w_out[l],
            norm2_g[l], peer_w_query[l], peer_sub_keys[l], peer_u[l], peer_v[l])
        kp.append(k_buf); vp.append(v_buf); pp.append(p_buf)
        xs, k_buf, v_buf, p_buf = trunk_layer(
            xs, c_sample, pos_s, cache_k_win[l], cache_v_win[l], state_pool[l], rel_bias_table,
            ada_w[l], ada_b[l], norm1_g[l], w_in[l], q_norm_g[l], k_norm_g[l], attn_sinks[l],
            pool_w[l], pool_scale[l], w_out[l], norm2_g[l], peer_w_query[l], peer_sub_keys[l],
            peer_u[l], peer_v[l])
        ks_.append(k_buf); vs_.append(v_buf); ps_.append(p_buf)
    return (xp, xs, jnp.stack(kp), jnp.stack(vp), jnp.stack(pp), jnp.stack(ks_), jnp.stack(vs_), jnp.stack(ps_))
```

```cpp
#include <hip/hip_runtime.h>
#include <stdint.h>
#include <stdio.h>

#ifndef ONE_LAUNCH
#define ONE_LAUNCH 1
#endif

typedef __bf16 bf16;
typedef __bf16 bf16x2 __attribute__((ext_vector_type(2)));
typedef __bf16 bf16x4 __attribute__((ext_vector_type(4)));
typedef __bf16 bf16x8 __attribute__((ext_vector_type(8)));
typedef float f32x2 __attribute__((ext_vector_type(2)));
typedef float f32x4 __attribute__((ext_vector_type(4)));
typedef float f32x16 __attribute__((ext_vector_type(16)));
typedef unsigned u32x2 __attribute__((ext_vector_type(2)));
typedef unsigned u32x4 __attribute__((ext_vector_type(4)));

#define DI __device__ __forceinline__
#define MFMA(a, b, c) __builtin_amdgcn_mfma_f32_32x32x16_bf16((a), (b), (c), 0, 0, 0)

constexpr int DM = 1024, NB = 8, SEQ = 2048, NS = 128, NPR = NB * SEQ, NTOK = NPR + NS;
constexpr int INW = 3840, NMOD = NB + NS;
constexpr int C_K = 1024, C_V = 1152, C_PIN = 1280, C_GA = 1792, C_GB = 2816;
constexpr int NEXP = 16384;
constexpr float EPS = 1e-6f;
constexpr size_t O_YP = 0, O_KWP = 16908288, O_VWP = 17039360, O_PP = 17170432, O_KWS = 17231872, O_VWS = 19329024, O_PS = 21426176;

constexpr int SMEM_BYTES = 77824;
constexpr int NTHREADS = 256;

struct P {
  const float *x_prompt, *x_sample, *cache_k, *cache_v, *state_pool, *c_prompt, *c_sample, *rel_table, *ada_w, *ada_b, *norm1_g, *w_in,
      *q_norm_g, *k_norm_g, *sinks, *pool_w, *pool_scale, *w_out, *norm2_g, *w_query, *sub_keys, *peer_u, *peer_v;
  float* out;
  char* ws;
};
constexpr size_t al256(size_t x) { return (x + 255) & ~(size_t)255; }
constexpr size_t OFF_BAR = 0;
constexpr size_t OFF_WTIN = OFF_BAR + al256(4096 * 4);
constexpr size_t OFF_WTOUT = OFF_WTIN + al256((size_t)INW * 1024 * 2);
constexpr size_t OFF_WTQ = OFF_WTOUT + al256((size_t)1024 * 1024 * 2);
constexpr size_t OFF_SK = OFF_WTQ + al256((size_t)2048 * 1024 * 2);
constexpr size_t OFF_PWT = OFF_SK + al256((size_t)16 * 128 * 128 * 2);
constexpr size_t OFF_UB = OFF_PWT + al256((size_t)4 * 256 * 128 * 2);
constexpr size_t OFF_VB = OFF_UB + al256((size_t)NEXP * DM * 2);
constexpr size_t OFF_MOD = OFF_VB + al256((size_t)NEXP * DM * 2);
constexpr size_t OFF_BIAS = OFF_MOD + al256((size_t)NMOD * 6144 * 4);
constexpr size_t OFF_VT = OFF_BIAS + al256(16 * 128 * 4);
constexpr size_t OFF_H = OFF_VT + al256((size_t)NB * 128 * SEQ * 2);
constexpr size_t OFF_MIXED = OFF_H;
constexpr size_t OFF_PROJ = OFF_H + al256((size_t)NTOK * DM * 2);
constexpr size_t OFF_X1 = OFF_PROJ;
constexpr size_t OFF_IDX = OFF_X1 + (size_t)NTOK * DM * 4;
constexpr size_t OFF_GATE = OFF_IDX + (size_t)NTOK * 128 * 4;
constexpr size_t WS_NEED = OFF_PROJ + al256((size_t)NTOK * INW * 2);
static_assert(OFF_GATE + (size_t)NTOK * 128 * 4 <= WS_NEED, "overlay fits");
static_assert(WS_NEED <= (size_t)256 * 1024 * 1024, "workspace budget");
#define WS_PTR(T, name, OFF) __device__ __forceinline__ T* name(const P& p) { return (T*)(p.ws + (OFF)); }
WS_PTR(unsigned, w_bar, OFF_BAR) WS_PTR(bf16, w_Wt_in, OFF_WTIN) WS_PTR(bf16, w_Wt_out, OFF_WTOUT) WS_PTR(bf16, w_Wt_q, OFF_WTQ) WS_PTR(bf16, w_SK, OFF_SK)
WS_PTR(bf16, w_PWt, OFF_PWT) WS_PTR(bf16, w_Ub, OFF_UB) WS_PTR(bf16, w_Vb, OFF_VB) WS_PTR(float, w_MOD, OFF_MOD) WS_PTR(float, w_BIAS, OFF_BIAS)
WS_PTR(bf16, w_VT, OFF_VT) WS_PTR(bf16, w_H, OFF_H) WS_PTR(bf16, w_MIXED, OFF_MIXED) WS_PTR(bf16, w_PROJ, OFF_PROJ) WS_PTR(float, w_X1, OFF_X1)
WS_PTR(int, w_IDX, OFF_IDX) WS_PTR(float, w_GATE, OFF_GATE)

DI int cond_row(int token) { return token < NPR ? (token >> 11) : (NB + token - NPR); }
DI int crow(int reg, int h) { return (reg & 3) + 8 * (reg >> 2) + 4 * h; }
DI const float* xrow(const P& p, int token) { return token < NPR ? p.x_prompt + (size_t)token * DM : p.x_sample + (size_t)(token - NPR) * DM; }

DI int opaque0() { int z = 0; asm volatile("" : "+v"(z)); return z; }
DI float bf2f(bf16 v) { return (float)v; }
DI f32x16 zero16() { f32x16 z; for (int i = 0; i < 16; ++i) z[i] = 0.f; return z; }
DI bf16x8 pack_step(const f32x16& x, int s) { bf16x8 v; for (int j = 0; j < 8; ++j) v[j] = (bf16)x[8 * s + j]; return v; }
DI bf16x8 cat4(bf16x4 lo, bf16x4 hi) { return __builtin_shufflevector(lo, hi, 0, 1, 2, 3, 4, 5, 6, 7); }
DI float wave_sum(float v) { for (int o = 32; o >= 1; o >>= 1) v += __shfl_xor(v, o); return v; }

#define XB_TMO 128
#define XB_XCNT(j) (256 + 64 * (j))
#define XB_XSUB(j) (1280 + 64 * (j))
#define XB_XGEN(j) (2304 + 64 * (j))
#define XB_TOP 3328
#define XB_TOPGEN 3392
#define XCD_BAR_WORDS 3456
#define XB_SPIN_CAP (1u << 22)
DI unsigned xb_ld(unsigned* p) { return __hip_atomic_load(p, __ATOMIC_RELAXED, __HIP_MEMORY_SCOPE_AGENT); }
DI unsigned xb_add(unsigned* p, unsigned v) { return __hip_atomic_fetch_add(p, v, __ATOMIC_RELAXED, __HIP_MEMORY_SCOPE_AGENT); }
DI unsigned xb_xcc_id() { return (unsigned)__builtin_amdgcn_s_getreg((3 << 11) | 20) & 0xFu; }
#define XB_SPIN(cond, bar) do { unsigned _sp = 0; while (cond) { __builtin_amdgcn_s_sleep(1); \
    if ((++_sp & 255u) == 0u) { if (xb_ld(&(bar)[XB_TMO])) break; if (_sp > XB_SPIN_CAP) { atomicAdd(&(bar)[XB_TMO], 1u); break; } } } } while (0)

DI void xcd_barrier_complete(unsigned* bar, unsigned x, unsigned& nloc, unsigned& nx) {
  const unsigned G = gridDim.x;
  unsigned sum, cnt, mine, sp = 0u;
  for (;;) {
    sum = 0u; cnt = 0u; mine = 0u;
#pragma unroll
    for (unsigned j = 0; j < 16; ++j) { const unsigned c = xb_ld(&bar[XB_XCNT(j)]); sum += c; cnt += (c > 0u) ? 1u : 0u; mine = (j == x) ? c : mine; }
    if (sum == G) break;
    __builtin_amdgcn_s_sleep(1);
    if ((++sp & 255u) == 0u) { if (xb_ld(&bar[XB_TMO])) break; if (sp > XB_SPIN_CAP) { atomicAdd(&bar[XB_TMO], 1u); break; } }
  }
  nloc = mine > 0u ? mine : 1u; nx = cnt > 0u ? cnt : 1u;
}
DI void xcd_barrier(unsigned* bar, unsigned x, volatile unsigned* st) {
  asm volatile("s_waitcnt vmcnt(0)" ::: "memory");
  __syncthreads();
  if (threadIdx.x == 0) {
    __builtin_amdgcn_s_waitcnt(0);
    unsigned nloc = st[0], nx = st[1];
    if (nloc == 0u) { xcd_barrier_complete(bar, x, nloc, nx); st[0] = nloc; st[1] = nx; }
    const unsigned old = xb_add(&bar[XB_XSUB(x)], 1u);
    const unsigned gen = old / nloc;
    if (old + 1u == (gen + 1u) * nloc) {
      __builtin_amdgcn_fence(__ATOMIC_RELEASE, "agent");
      asm volatile("s_waitcnt vmcnt(0)" ::: "memory");
      const unsigned og = xb_add(&bar[XB_TOP], 1u);
      const unsigned tg = og / nx;
      if (og + 1u == (tg + 1u) * nx) xb_add(&bar[XB_TOPGEN], 1u);
      else XB_SPIN(xb_ld(&bar[XB_TOPGEN]) == tg, bar);
      __builtin_amdgcn_fence(__ATOMIC_ACQUIRE, "agent");
      xb_add(&bar[XB_XGEN(x)], 1u);
      asm volatile("s_waitcnt vmcnt(0)" ::: "memory");
    } else {
      XB_SPIN(xb_ld(&bar[XB_XGEN(x)]) == gen, bar);
      __builtin_amdgcn_fence(__ATOMIC_ACQUIRE, "agent");
      asm volatile("s_waitcnt vmcnt(0)" ::: "memory");
    }
  }
  __syncthreads();
}

constexpr int U0_MOD = 192;
constexpr int U0_TIN = (1024 / 64) * (INW / 64);
constexpr int U0_TOUT = 16 * 16;
constexpr int U0_TQ = 16 * 32;
constexpr int U0_TPW = 4 * 2 * 4;
constexpr int U0_CSK = 32;
constexpr int U0_CU = 2048, U0_CV = 2048;
constexpr int U0_KW = 128, U0_VW = 128, U0_PW = 128, U0_BIAS = 1;
constexpr int U0_E0 = U0_MOD, U0_E1 = U0_E0 + U0_TIN, U0_E2 = U0_E1 + U0_TOUT, U0_E3 = U0_E2 + U0_TQ, U0_E4 = U0_E3 + U0_TPW, U0_E5 = U0_E4 + U0_CSK,
              U0_E6 = U0_E5 + U0_CU, U0_E7 = U0_E6 + U0_CV, U0_E8 = U0_E7 + U0_KW, U0_E9 = U0_E8 + U0_VW, U0_E10 = U0_E9 + U0_PW, U0_TOTAL = U0_E10 + U0_BIAS;

DI float silu_f(float x) { return x / (1.f + __expf(-x)); }

DI void unit_mod(const P& p, int u, char* smem) {
  const int t = threadIdx.x + opaque0(), lane = t & 63, w = t >> 6, r = lane & 31, h = lane >> 5;
  const int f0 = u * 32;
  f32x16 acc[5];
#pragma unroll
  for (int i = 0; i < 5; ++i) acc[i] = zero16();
#pragma unroll 1
  for (int ks = 0; ks < 16; ++ks) {
    const int k0 = w * 256 + ks * 16 + 8 * h;
    bf16x8 bfr;
#pragma unroll
    for (int j = 0; j < 8; ++j) bfr[j] = (bf16)p.ada_w[(size_t)(k0 + j) * 6144 + f0 + r];
#pragma unroll
    for (int i = 0; i < 5; ++i) {
      const int m = 32 * i + r;
      bf16x8 afr;
      if (m < NMOD) {
        const float* c = (m < NB ? p.c_prompt + (size_t)m * DM : p.c_sample + (size_t)(m - NB) * DM) + k0;
        const f32x4 c0 = *(const f32x4*)c, c1 = *(const f32x4*)(c + 4);
        afr[0] = (bf16)silu_f(c0[0]); afr[1] = (bf16)silu_f(c0[1]); afr[2] = (bf16)silu_f(c0[2]); afr[3] = (bf16)silu_f(c0[3]);
        afr[4] = (bf16)silu_f(c1[0]); afr[5] = (bf16)silu_f(c1[1]); afr[6] = (bf16)silu_f(c1[2]); afr[7] = (bf16)silu_f(c1[3]);
      } else {
#pragma unroll
        for (int j = 0; j < 8; ++j) afr[j] = (bf16)0.f;
      }
      acc[i] = MFMA(afr, bfr, acc[i]);
    }
  }
  float* red = (float*)smem;
  __syncthreads();
  if (w > 0) {
#pragma unroll
    for (int i = 0; i < 5; ++i)
#pragma unroll
      for (int j = 0; j < 16; ++j) red[((w - 1) * 80 + i * 16 + j) * 64 + lane] = acc[i][j];
  }
  __syncthreads();
  if (w == 0) {
    const float bias = p.ada_b[f0 + r];
#pragma unroll
    for (int i = 0; i < 5; ++i)
#pragma unroll
      for (int j = 0; j < 16; ++j) {
        const int m = 32 * i + crow(j, h);
        const float v = acc[i][j] + red[(0 * 80 + i * 16 + j) * 64 + lane] + red[(1 * 80 + i * 16 + j) * 64 + lane] + red[(2 * 80 + i * 16 + j) * 64 + lane] + bias;
        if (m < NMOD) w_MOD(p)[(size_t)m * 6144 + f0 + r] = v;
      }
  }
}

DI void unit_transpose(const float* __restrict__ src, bf16* __restrict__ dst, int R, int C, int tr, int tc, char* smem) {
  float* tile = (float*)smem;
  const int t = threadIdx.x + opaque0();
  __syncthreads();
#pragma unroll
  for (int i = 0; i < 4; ++i) {
    const int rr = (t >> 4) + 16 * i, cc = (t & 15) * 4;
    const f32x4 v = *(const f32x4*)(src + (size_t)(tr * 64 + rr) * C + tc * 64 + cc);
    tile[rr * 65 + cc] = v[0]; tile[rr * 65 + cc + 1] = v[1]; tile[rr * 65 + cc + 2] = v[2]; tile[rr * 65 + cc + 3] = v[3];
  }
  __syncthreads();
#pragma unroll
  for (int i = 0; i < 2; ++i) {
    const int orow = (t >> 3) + 32 * i, seg = (t & 7) * 8;
    bf16x8 v;
#pragma unroll
    for (int j = 0; j < 8; ++j) v[j] = (bf16)tile[(seg + j) * 65 + orow];
    *(bf16x8*)(dst + (size_t)(tc * 64 + orow) * R + tr * 64 + seg) = v;
  }
}
DI void unit_convert(const float* __restrict__ src, bf16* __restrict__ dst, int u) {
  const size_t base = (size_t)u * 8192 + (threadIdx.x + opaque0()) * 8;
#pragma unroll
  for (int i = 0; i < 4; ++i) {
    const size_t o = base + (size_t)i * 2048;
    const f32x4 a = *(const f32x4*)(src + o), b = *(const f32x4*)(src + o + 4);
    bf16x8 v; v[0] = (bf16)a[0]; v[1] = (bf16)a[1]; v[2] = (bf16)a[2]; v[3] = (bf16)a[3]; v[4] = (bf16)b[0]; v[5] = (bf16)b[1]; v[6] = (bf16)b[2]; v[7] = (bf16)b[3];
    *(bf16x8*)(dst + o) = v;
  }
}
DI void unit_copy_f4(const float* __restrict__ src, float* __restrict__ dst, int n4) {
  for (int i = threadIdx.x + opaque0(); i < n4; i += NTHREADS) ((f32x4*)dst)[i] = ((const f32x4*)src)[i];
}

DI void phase0_unit(const P& p, int u, char* smem) {
  if (u < U0_E0) { unit_mod(p, u, smem); }
  else if (u < U0_E1) { const int v = u - U0_E0; unit_transpose(p.w_in, w_Wt_in(p), 1024, INW, v / 60, v % 60, smem); }
  else if (u < U0_E2) { const int v = u - U0_E1; unit_transpose(p.w_out, w_Wt_out(p), 1024, 1024, v / 16, v % 16, smem); }
  else if (u < U0_E3) { const int v = u - U0_E2; unit_transpose(p.w_query, w_Wt_q(p), 1024, 2048, v / 32, v % 32, smem); }
  else if (u < U0_E4) { const int v = u - U0_E3, g = v >> 3, tt = v & 7; unit_transpose(p.pool_w + (size_t)g * 128 * 256, w_PWt(p) + (size_t)g * 256 * 128, 128, 256, tt >> 2, tt & 3, smem); }
  else if (u < U0_E5) { unit_convert(p.sub_keys, w_SK(p), u - U0_E4); }
  else if (u < U0_E6) { unit_convert(p.peer_u, w_Ub(p), u - U0_E5); }
  else if (u < U0_E7) { unit_convert(p.peer_v, w_Vb(p), u - U0_E6); }
  else if (u < U0_E8) { const int b = u - U0_E7; unit_copy_f4(p.cache_k + ((size_t)b * 128 + 1) * 128, p.out + O_KWS + (size_t)b * 128 * 128, 127 * 128 / 4); }
  else if (u < U0_E9) { const int b = u - U0_E8; unit_copy_f4(p.cache_v + ((size_t)b * 128 + 1) * 128, p.out + O_VWS + (size_t)b * 128 * 128, 127 * 128 / 4); }
  else if (u < U0_E10) { const int b = u - U0_E9; unit_copy_f4(p.state_pool + ((size_t)b * 15 + 1) * 512, p.out + O_PS + (size_t)b * 15 * 512, 14 * 512 / 4); }
  else {
    for (int i = threadIdx.x + opaque0(); i < 16 * 128; i += NTHREADS) {
      const int head = i >> 7, d = i & 127;
      int bk = d;
      if (d >= 16) { bk = 16 + (int)(logf((float)d / 16.f) / logf(8.f) * 16.f); bk = bk > 31 ? 31 : bk; }
      w_BIAS(p)[i] = p.rel_table[bk * 16 + head];
    }
  }
}

DI void norm_row(const P& p, int token, int which) {
  const int lane = (threadIdx.x + opaque0()) & 63;
  const float* src = which == 0 ? xrow(p, token) : w_X1(p) + (size_t)token * DM;
  const float* g = which == 0 ? p.norm1_g : p.norm2_g;
  const float* mod = w_MOD(p) + (size_t)cond_row(token) * 6144 + (which == 0 ? 0 : 3072);
  f32x4 v[4];
  float ss = 0.f;
#pragma unroll
  for (int i = 0; i < 4; ++i) { v[i] = *(const f32x4*)(src + 4 * lane + 256 * i); ss += v[i][0] * v[i][0] + v[i][1] * v[i][1] + v[i][2] * v[i][2] + v[i][3] * v[i][3]; }
  ss = wave_sum(ss);
  const float rstd = rsqrtf(ss * (1.f / DM) + EPS);
#pragma unroll
  for (int i = 0; i < 4; ++i) {
    const int c = 4 * lane + 256 * i;
    const f32x4 gg = *(const f32x4*)(g + c), sh = *(const f32x4*)(mod + c), sc = *(const f32x4*)(mod + 1024 + c);
    bf16x4 o;
#pragma unroll
    for (int j = 0; j < 4; ++j) o[j] = (bf16)((v[i][j] * rstd * gg[j]) * (1.f + sc[j]) + sh[j]);
    *(bf16x4*)(w_H(p) + (size_t)token * DM + c) = o;
  }
}

constexpr int LDSK = 72;
DI void gemm_tile(const bf16* __restrict__ Wt, const bf16* __restrict__ X, int K, int n0, int m0, char* smem, f32x16 (&acc)[4]) {
  bf16* As = (bf16*)smem;
  bf16* Bs = As + 128 * LDSK;
  const int t = threadIdx.x + opaque0(), lane = t & 63, w = t >> 6, r = lane & 31, h = lane >> 5;
#pragma unroll
  for (int i = 0; i < 4; ++i) acc[i] = zero16();
  const int lrow = t >> 3, lc = (t & 7) * 8;
  const bf16* ga = Wt + (size_t)(n0 + lrow) * K + lc;
  const bf16* gb = X + (size_t)(m0 + lrow) * K + lc;
  u32x4 ra[4], rb[4];
#pragma unroll
  for (int i = 0; i < 4; ++i) { ra[i] = *(const u32x4*)(ga + (size_t)(32 * i) * K); rb[i] = *(const u32x4*)(gb + (size_t)(32 * i) * K); }
  const int KT = K >> 6;
  for (int kt = 0; kt < KT; ++kt) {
    __syncthreads();
#pragma unroll
    for (int i = 0; i < 4; ++i) { *(u32x4*)(As + (lrow + 32 * i) * LDSK + lc) = ra[i]; *(u32x4*)(Bs + (lrow + 32 * i) * LDSK + lc) = rb[i]; }
    __syncthreads();
    if (kt + 1 < KT) {
      const int k0 = (kt + 1) * 64;
#pragma unroll
      for (int i = 0; i < 4; ++i) { ra[i] = *(const u32x4*)(ga + (size_t)(32 * i) * K + k0); rb[i] = *(const u32x4*)(gb + (size_t)(32 * i) * K + k0); }
    }
#pragma unroll
    for (int s = 0; s < 4; ++s) {
      const bf16x8 bfr = *(const bf16x8*)(Bs + (32 * w + r) * LDSK + 16 * s + 8 * h);
#pragma unroll
      for (int i = 0; i < 4; ++i) {
        const bf16x8 afr = *(const bf16x8*)(As + (32 * i + r) * LDSK + 16 * s + 8 * h);
        acc[i] = MFMA(afr, bfr, acc[i]);
      }
    }
  }
}

DI float sigmoid_f(float x) { return 1.f / (1.f + __expf(-x)); }

DI void unit_gemm1(const P& p, int u, char* smem) {
  const int mt = u / 30, nt = u % 30;
  const int n0 = nt * 128, m0 = mt * 128;
  f32x16 acc[4];
  gemm_tile(w_Wt_in(p), w_H(p), 1024, n0, m0, smem, acc);
  const int tz = threadIdx.x + opaque0();
  const int lane = tz & 63, w = tz >> 6, r = lane & 31, h = lane >> 5;
  const int token = m0 + 32 * w + r;
  bf16* prow = w_PROJ(p) + (size_t)token * INW;
  const bool is_prompt = token < NPR;
  const int b = is_prompt ? (token >> 11) : (token - NPR), pos = token & (SEQ - 1);
  if (n0 < C_V) {
    const float* gn = n0 < C_K ? p.q_norm_g : p.k_norm_g;
    const float post = n0 < C_K ? 0.125f : 1.f;
#pragma unroll
    for (int hh = 0; hh < 2; ++hh) {
      float ss = 0.f;
#pragma unroll
      for (int i = 0; i < 2; ++i)
#pragma unroll
        for (int j = 0; j < 16; ++j) ss += acc[2 * hh + i][j] * acc[2 * hh + i][j];
      ss += __shfl_xor(ss, 32);
      const float rstd = rsqrtf(ss * (1.f / 64.f) + EPS);
#pragma unroll
      for (int i = 0; i < 2; ++i)
#pragma unroll
        for (int q4 = 0; q4 < 4; ++q4) {
          const int d = 32 * i + 8 * q4 + 4 * h;
          const f32x4 gg = *(const f32x4*)(gn + d);
          f32x4 v;
#pragma unroll
          for (int j = 0; j < 4; ++j) v[j] = acc[2 * hh + i][4 * q4 + j] * rstd * gg[j];
          bf16x4 o;
#pragma unroll
          for (int j = 0; j < 4; ++j) o[j] = (bf16)(v[j] * post);
          const int f = n0 + 64 * hh + d;
          *(bf16x4*)(prow + f) = o;
          if (n0 == C_K) {
            if (is_prompt) { if (pos >= SEQ - 128) *(f32x4*)(p.out + O_KWP + ((size_t)b * 128 + (pos - (SEQ - 128))) * 128 + 64 * hh + d) = v; }
            else *(f32x4*)(p.out + O_KWS + ((size_t)b * 128 + 127) * 128 + 64 * hh + d) = v;
          }
        }
    }
  } else if (n0 == C_V) {
#pragma unroll
    for (int i = 0; i < 4; ++i)
#pragma unroll
      for (int q4 = 0; q4 < 4; ++q4) {
        const int f = 32 * i + 8 * q4 + 4 * h;
        f32x4 v;
#pragma unroll
        for (int j = 0; j < 4; ++j) v[j] = acc[i][4 * q4 + j];
        if (is_prompt) {
#pragma unroll
          for (int j = 0; j < 4; ++j) w_VT(p)[((size_t)b * 128 + f + j) * SEQ + pos] = (bf16)v[j];
          if (pos >= SEQ - 128) *(f32x4*)(p.out + O_VWP + ((size_t)b * 128 + (pos - (SEQ - 128))) * 128 + f) = v;
        } else *(f32x4*)(p.out + O_VWS + ((size_t)b * 128 + 127) * 128 + f) = v;
      }
  } else if (n0 < C_GA) {
#pragma unroll
    for (int i = 0; i < 4; ++i)
#pragma unroll
      for (int q4 = 0; q4 < 4; ++q4) {
        const int f = n0 + 32 * i + 8 * q4 + 4 * h;
        f32x4 v; bf16x4 o;
#pragma unroll
        for (int j = 0; j < 4; ++j) { v[j] = acc[i][4 * q4 + j]; o[j] = (bf16)v[j]; }
        *(bf16x4*)(prow + f) = o;
        if (is_prompt) { if (pos >= SEQ - 15) *(f32x4*)(p.out + O_PP + ((size_t)b * 15 + (pos - (SEQ - 15))) * 512 + (f - C_PIN)) = v; }
        else *(f32x4*)(p.out + O_PS + ((size_t)b * 15 + 14) * 512 + (f - C_PIN)) = v;
      }
  } else {
#pragma unroll
    for (int i = 0; i < 4; ++i)
#pragma unroll
      for (int q4 = 0; q4 < 4; ++q4) {
        const int f = n0 + 32 * i + 8 * q4 + 4 * h;
        bf16x4 o;
#pragma unroll
        for (int j = 0; j < 4; ++j) o[j] = (bf16)sigmoid_f(acc[i][4 * q4 + j]);
        *(bf16x4*)(prow + f) = o;
      }
  }
}

constexpr int VTS = 260;
constexpr int RS = 136;
DI void unit_attn_prompt(const P& p, int u, char* smem) {
  const int b = u >> 8, blk = (u >> 4) & 15, head = u & 15, hk = head >> 3;
  const int qpos0 = blk * 128;
  const int t = threadIdx.x + opaque0(), lane = t & 63, w = t >> 6, r = lane & 31, h = lane >> 5;
  bf16* Ks = (bf16*)smem;
  bf16* VTs = Ks + 256 * LDSK;
  float* bs = (float*)(VTs + 64 * VTS);
  bf16* Rs = Ks;
  __syncthreads();
#pragma unroll
  for (int i = 0; i < 8; ++i) {
    const int c = t + 256 * i, row = c >> 3, c16 = c & 7, kp = qpos0 - 128 + row;
    u32x4 v = {0u, 0u, 0u, 0u};
    if (kp >= 0) v = *(const u32x4*)(w_PROJ(p) + ((size_t)b * SEQ + kp) * INW + C_K + hk * 64 + c16 * 8);
    *(u32x4*)(Ks + row * LDSK + c16 * 8) = v;
  }
#pragma unroll
  for (int i = 0; i < 8; ++i) {
    const int c = t + 256 * i, drow = c >> 5, c16 = c & 31, kp0 = qpos0 - 128 + c16 * 8;
    u32x4 v = {0u, 0u, 0u, 0u};
    if (kp0 >= 0) v = *(const u32x4*)(w_VT(p) + ((size_t)(b * 2 + hk) * 64 + drow) * SEQ + kp0);
    u32x2* d2 = (u32x2*)(VTs + drow * VTS + c16 * 8);
    d2[0] = (u32x2){v[0], v[1]}; d2[1] = (u32x2){v[2], v[3]};
  }
  if (t < 192) { const int dist = 159 - t; bs[t] = (dist >= 0 && dist < 128) ? w_BIAS(p)[head * 128 + dist] : 0.f; }
  const int qi = 32 * w + r;
  const size_t tokq = (size_t)b * SEQ + qpos0 + qi;
  bf16x8 qf[4];
#pragma unroll
  for (int s = 0; s < 4; ++s) qf[s] = *(const bf16x8*)(w_PROJ(p) + tokq * INW + head * 64 + 16 * s + 8 * h);
  __syncthreads();
  f32x16 st[5];
#pragma unroll
  for (int tt = 0; tt < 5; ++tt) {
    st[tt] = zero16();
#pragma unroll
    for (int s = 0; s < 4; ++s) {
      const bf16x8 a = *(const bf16x8*)(Ks + (32 * (w + tt) + r) * LDSK + 16 * s + 8 * h);
      st[tt] = MFMA(a, qf[s], st[tt]);
    }
  }
  const float sink = p.sinks[head];
  float m = -INFINITY;
  {
    const int x = 31 - r + 4 * h;
    const float* bl = bs + x;
    const int kbase = blk > 0 ? 1024 : 32 * w + 4 * h;
#pragma unroll
    for (int tt = 0; tt < 5; ++tt)
#pragma unroll
      for (int j = 0; j < 16; ++j) {
        const int c = 32 * tt + (j & 3) + 8 * (j >> 2);
        const bool valid = (x + c >= 32) && (x + c <= 159) && (kbase + c >= 128);
        const float bv = bl[c];
        const float s = valid ? st[tt][j] + bv : -INFINITY;
        st[tt][j] = s;
        m = fmaxf(m, s);
      }
  }
  m = fmaxf(m, __shfl_xor(m, 32));
  m = fmaxf(m, sink);
  float sum = 0.f;
#pragma unroll
  for (int tt = 0; tt < 5; ++tt)
#pragma unroll
    for (int j = 0; j < 16; ++j) { const float e = __expf(st[tt][j] - m); st[tt][j] = e; sum += e; }
  sum += __shfl_xor(sum, 32);
  const float inv = 1.f / (sum + __expf(sink - m));
  f32x16 o[2] = {zero16(), zero16()};
#pragma unroll
  for (int tt = 0; tt < 5; ++tt)
#pragma unroll
    for (int s = 0; s < 2; ++s) {
      const bf16x8 pb = pack_step(st[tt], s);
#pragma unroll
      for (int i = 0; i < 2; ++i) {
        const bf16* vp = VTs + (32 * i + r) * VTS + 32 * (w + tt) + 16 * s + 4 * h;
        const bf16x8 a = cat4(*(const bf16x4*)vp, *(const bf16x4*)(vp + 8));
        o[i] = MFMA(a, pb, o[i]);
      }
    }
  __syncthreads();
  const int g = head >> 2, win = 2 << g;
  {
    const int tk = t >> 4, cc = t & 15;
    const int p0 = qpos0 + tk * 8;
    const bf16* pin = w_PROJ(p) + (size_t)b * SEQ * INW + C_PIN + g * 128 + cc * 8;
    float S[8];
#pragma unroll
    for (int j = 0; j < 8; ++j) S[j] = 0.f;
    for (int i = 0; i < win; ++i) {
      const int pp = p0 - i;
      if (pp >= 0) { const bf16x8 v = *(const bf16x8*)(pin + (size_t)pp * INW);
#pragma unroll
        for (int j = 0; j < 8; ++j) S[j] += bf2f(v[j]); }
    }
    for (int i = 0; i < 8; ++i) {
      const int pos = p0 + i;
      const bf16x8 cur = *(const bf16x8*)(pin + (size_t)pos * INW);
      if (i > 0) {
#pragma unroll
        for (int j = 0; j < 8; ++j) S[j] += bf2f(cur[j]);
        if (pos - win >= 0) { const bf16x8 old = *(const bf16x8*)(pin + (size_t)(pos - win) * INW);
#pragma unroll
          for (int j = 0; j < 8; ++j) S[j] -= bf2f(old[j]); }
      }
      const float icnt = 1.f / (float)(win < pos + 1 ? win : pos + 1);
      bf16x8 rr;
#pragma unroll
      for (int j = 0; j < 8; ++j) rr[j] = (bf16)(S[j] * icnt - bf2f(cur[j]));
      *(bf16x8*)(Rs + (tk * 8 + i) * RS + cc * 8) = rr;
    }
  }
  __syncthreads();
  f32x16 pa[2] = {zero16(), zero16()};
#pragma unroll
  for (int s = 0; s < 8; ++s) {
    const bf16x8 bfr = *(const bf16x8*)(Rs + (32 * w + r) * RS + 16 * s + 8 * h);
#pragma unroll
    for (int i = 0; i < 2; ++i) {
      const bf16x8 a = *(const bf16x8*)(w_PWt(p) + ((size_t)g * 256 + (head & 3) * 64 + 32 * i + r) * 128 + 16 * s + 8 * h);
      pa[i] = MFMA(a, bfr, pa[i]);
    }
  }
  const bf16* prow = w_PROJ(p) + tokq * INW;
#pragma unroll
  for (int i = 0; i < 2; ++i)
#pragma unroll
    for (int q4 = 0; q4 < 4; ++q4) {
      const int f = head * 64 + 32 * i + 8 * q4 + 4 * h;
      const bf16x4 ga = *(const bf16x4*)(prow + C_GA + f), gb = *(const bf16x4*)(prow + C_GB + f);
      const f32x4 ps = *(const f32x4*)(p.pool_scale + f);
      bf16x4 ov;
#pragma unroll
      for (int j = 0; j < 4; ++j) ov[j] = (bf16)(bf2f(ga[j]) * (o[i][4 * q4 + j] * inv) + bf2f(gb[j]) * (pa[i][4 * q4 + j] * ps[j]));
      *(bf16x4*)(w_MIXED(p) + tokq * DM + f) = ov;
    }
}

DI void unit_attn_sample(const P& p, int u, char* smem) {
  const int b = u >> 1, hk = u & 1;
  const int t = threadIdx.x + opaque0(), g8 = t >> 5, l32 = t & 31;
  float* ks = (float*)smem;
  float* vs = ks + 128 * 65;
  float* qs = vs + 128 * 64;
  float* ps = qs + 512;
  float* os = ps + 1024;
  float* rs = os + 512;
  const size_t token = (size_t)NPR + b;
  __syncthreads();
  const float* kw = p.out + O_KWS + (size_t)b * 128 * 128 + hk * 64;
  const float* vw = p.out + O_VWS + (size_t)b * 128 * 128 + hk * 64;
#pragma unroll 4
  for (int i = t; i < 128 * 64; i += NTHREADS) { const int j = i >> 6, d = i & 63; ks[j * 65 + d] = kw[(size_t)j * 128 + d]; vs[j * 64 + d] = vw[(size_t)j * 128 + d]; }
#pragma unroll 1
  for (int i = t; i < 512; i += NTHREADS) qs[i] = bf2f(w_PROJ(p)[token * INW + hk * 512 + i]);
  {
    const int gi = t >> 7, ch = t & 127, g = 2 * hk + gi, win = 2 << g;
    const float cur = p.out[O_PS + ((size_t)b * 15 + 14) * 512 + g * 128 + ch];
    float tot = cur;
#pragma unroll 1
    for (int i = 1; i < win; ++i) tot += p.state_pool[((size_t)b * 15 + 15 - i) * 512 + g * 128 + ch];
    rs[gi * 128 + ch] = tot / (float)win - cur;
  }
  __syncthreads();
  const int head = hk * 8 + g8;
  float s[4];
  float m = p.sinks[head];
#pragma unroll
  for (int i = 0; i < 4; ++i) {
    const int j = l32 + 32 * i;
    float a = 0.f;
#pragma unroll 8
    for (int d = 0; d < 64; ++d) a += qs[g8 * 64 + d] * ks[j * 65 + d];
    s[i] = a + w_BIAS(p)[head * 128 + 127 - j];
    m = fmaxf(m, s[i]);
  }
  for (int o = 16; o >= 1; o >>= 1) m = fmaxf(m, __shfl_xor(m, o));
  float sum = 0.f;
#pragma unroll
  for (int i = 0; i < 4; ++i) { s[i] = __expf(s[i] - m); sum += s[i]; }
  for (int o = 16; o >= 1; o >>= 1) sum += __shfl_xor(sum, o);
  const float inv = 1.f / (sum + __expf(p.sinks[head] - m));
#pragma unroll
  for (int i = 0; i < 4; ++i) ps[g8 * 128 + l32 + 32 * i] = s[i] * inv;
  __syncthreads();
#pragma unroll
  for (int i = 0; i < 2; ++i) {
    const int d = l32 + 32 * i;
    float a = 0.f;
#pragma unroll 8
    for (int j = 0; j < 128; ++j) a += ps[g8 * 128 + j] * vs[j * 64 + d];
    os[g8 * 64 + d] = a;
  }
  __syncthreads();
#pragma unroll
  for (int i = 0; i < 2; ++i) {
    const int fl = t + 256 * i, f = hk * 512 + fl, g = f >> 8, gi = g - 2 * hk, oc = f & 255;
    float pl = 0.f;
    const float* pw = p.pool_w + (size_t)g * 128 * 256 + oc;
#pragma unroll 8
    for (int ch = 0; ch < 128; ++ch) pl += rs[gi * 128 + ch] * pw[(size_t)ch * 256];
    pl *= p.pool_scale[f];
    const float ga = bf2f(w_PROJ(p)[token * INW + C_GA + f]), gb = bf2f(w_PROJ(p)[token * INW + C_GB + f]);
    w_MIXED(p)[token * DM + f] = (bf16)(ga * os[fl] + gb * pl);
  }
}

DI void unit_gemm2(const P& p, int u, char* smem) {
  const int mt = u >> 3, nt = u & 7;
  const int n0 = nt * 128, m0 = mt * 128;
  f32x16 acc[4];
  gemm_tile(w_Wt_out(p), w_MIXED(p), 1024, n0, m0, smem, acc);
  const int tz = threadIdx.x + opaque0();
  const int lane = tz & 63, w = tz >> 6, r = lane & 31, h = lane >> 5;
  const int token = m0 + 32 * w + r;
  const float* xr = xrow(p, token);
  const float* g1 = w_MOD(p) + (size_t)cond_row(token) * 6144 + 2048;
#pragma unroll
  for (int i = 0; i < 4; ++i)
#pragma unroll
    for (int q4 = 0; q4 < 4; ++q4) {
      const int f = n0 + 32 * i + 8 * q4 + 4 * h;
      const f32x4 xv = *(const f32x4*)(xr + f), gv = *(const f32x4*)(g1 + f);
      f32x4 o;
#pragma unroll
      for (int j = 0; j < 4; ++j) o[j] = xv[j] + gv[j] * acc[i][4 * q4 + j];
      *(f32x4*)(w_X1(p) + (size_t)token * DM + f) = o;
    }
}

DI unsigned f2ord(float f) { const unsigned u = __float_as_uint(f); return (u & 0x80000000u) ? ~u : (u | 0x80000000u); }
DI float ord2f(unsigned u) { return __uint_as_float((u & 0x80000000u) ? (u & 0x7fffffffu) : ~u); }
DI unsigned umin_(unsigned a, unsigned b) { return a < b ? a : b; }
DI unsigned umax_(unsigned a, unsigned b) { return a > b ? a : b; }
template <int OFF> DI void sort16_desc(unsigned (&a)[64]) {
#pragma unroll
  for (int lk = 1; lk <= 4; ++lk)
#pragma unroll
    for (int lj = lk - 1; lj >= 0; --lj)
#pragma unroll
      for (int i = 0; i < 16; ++i) {
        const int k = 1 << lk, j = 1 << lj, l = i ^ j;
        if (l > i) {
          const unsigned lo = umin_(a[OFF + i], a[OFF + l]), hi = umax_(a[OFF + i], a[OFF + l]);
          const bool desc = (i & k) == 0;
          a[OFF + i] = desc ? hi : lo; a[OFF + l] = desc ? lo : hi;
        }
      }
}
DI void merge16_desc(unsigned (&a)[16]) {
#pragma unroll
  for (int lj = 3; lj >= 0; --lj)
#pragma unroll
    for (int i = 0; i < 16; ++i) {
      const int j = 1 << lj, l = i ^ j;
      if (l > i) { const unsigned lo = umin_(a[i], a[l]), hi = umax_(a[i], a[l]); a[i] = hi; a[l] = lo; }
    }
}
DI void top16_of_64(unsigned (&a)[64], unsigned (&out)[16]) {
  sort16_desc<0>(a); sort16_desc<16>(a); sort16_desc<32>(a); sort16_desc<48>(a);
  unsigned x[16], y[16];
#pragma unroll
  for (int i = 0; i < 16; ++i) { x[i] = umax_(a[i], a[31 - i]); y[i] = umax_(a[32 + i], a[63 - i]); }
  merge16_desc(x); merge16_desc(y);
#pragma unroll
  for (int i = 0; i < 16; ++i) out[i] = umax_(x[i], y[15 - i]);
  merge16_desc(out);
}
__device__ constexpr int COFF[16] = {0, 16, 24, 29, 33, 36, 38, 40, 42, 43, 44, 45, 46, 47, 48, 49};
DI unsigned umax3(unsigned a, unsigned b, unsigned c) { const unsigned m = a > b ? a : b; return m > c ? m : c; }

DI void unit_peer_route(const P& p, int u, char* smem) {
  const int mt = u >> 3, hd = u & 7;
  const int m0 = mt * 128;
  const int t = threadIdx.x + opaque0(), lane = t & 63, w = t >> 6, r = lane & 31, h = lane >> 5;
  unsigned char* myidx = (unsigned char*)smem + 2 * 128 * LDSK * 2 + t * 32;
  unsigned* mytop = (unsigned*)(smem + 2 * 128 * LDSK * 2 + NTHREADS * 32) + t * 16;
  unsigned top[2][16];
#pragma unroll
  for (int pp = 0; pp < 2; ++pp) {
    f32x16 acc[4];
    gemm_tile(w_Wt_q(p), w_H(p), 1024, hd * 256 + pp * 128, m0, smem, acc);
    f32x16 sc[4] = {zero16(), zero16(), zero16(), zero16()};
    const bf16* skb = w_SK(p) + (size_t)(hd * 2 + pp) * 128 * 128;
#pragma unroll
    for (int i = 0; i < 4; ++i)
#pragma unroll
      for (int s = 0; s < 2; ++s) {
        const bf16x8 bq = pack_step(acc[i], s);
#pragma unroll
        for (int kt = 0; kt < 4; ++kt) {
          const bf16* ap = skb + (size_t)(32 * kt + r) * 128 + 32 * i + 16 * s + 4 * h;
          const bf16x8 a = cat4(*(const bf16x4*)ap, *(const bf16x4*)(ap + 8));
          sc[kt] = MFMA(a, bq, sc[kt]);
        }
      }
    unsigned pk[64];
#pragma unroll
    for (int kt = 0; kt < 4; ++kt)
#pragma unroll
      for (int j = 0; j < 16; ++j) { const int key = 32 * kt + crow(j, h); pk[kt * 16 + j] = (f2ord(sc[kt][j]) & ~127u) | (unsigned)(127 - key); }
    unsigned mine[16];
    top16_of_64(pk, mine);
#pragma unroll
    for (int i = 0; i < 16; ++i) top[pp][i] = (unsigned)__shfl_xor((int)mine[15 - i], 32);
#pragma unroll
    for (int i = 0; i < 16; ++i) top[pp][i] = umax_(top[pp][i], mine[i]);
    merge16_desc(top[pp]);
    if (pp == 0) {
#pragma unroll
      for (int i = 0; i < 4; ++i) *(u32x4*)(mytop + 4 * i) = (u32x4){top[0][4 * i], top[0][4 * i + 1], top[0][4 * i + 2], top[0][4 * i + 3]};
    }
  }
#pragma unroll
  for (int i = 0; i < 4; ++i) { const u32x4 v = *(const u32x4*)(mytop + 4 * i); top[0][4 * i] = v[0]; top[0][4 * i + 1] = v[1]; top[0][4 * i + 2] = v[2]; top[0][4 * i + 3] = v[3]; }
  float v0[16], v1[16];
#pragma unroll
  for (int a = 0; a < 16; ++a) {
    v0[a] = ord2f(top[0][a] & ~127u); v1[a] = ord2f(top[1][a] & ~127u);
    myidx[a] = (unsigned char)(127u - (top[0][a] & 127u)); myidx[16 + a] = (unsigned char)(127u - (top[1][a] & 127u));
  }
  unsigned cand[64];
#pragma unroll
  for (int i = 50; i < 64; ++i) cand[i] = 0u;
#pragma unroll
  for (int a = 0; a < 16; ++a)
#pragma unroll
    for (int bb = 0; bb < 16 / (a + 1); ++bb)
      cand[COFF[a] + bb] = (f2ord(v0[a] + v1[bb]) & ~255u) | (unsigned)(255 - (a * 16 + bb));
  unsigned best[16];
  top16_of_64(cand, best);
  const float smax = ord2f(best[0] & ~255u);
  float e[16], esum = 0.f;
#pragma unroll
  for (int i = 0; i < 16; ++i) { e[i] = __expf(ord2f(best[i] & ~255u) - smax); esum += e[i]; }
  const float einv = 1.f / esum;
  const size_t token = (size_t)m0 + 32 * w + r;
  int* ip = w_IDX(p) + token * 128 + hd * 16 + 8 * h;
  float* gp = w_GATE(p) + token * 128 + hd * 16 + 8 * h;
  const unsigned hmask = 0u - (unsigned)h;
#pragma unroll
  for (int i = 0; i < 8; ++i) {
    const unsigned bsel = best[i] ^ ((best[i] ^ best[8 + i]) & hmask);
    const float esel = __uint_as_float(__float_as_uint(e[i]) ^ ((__float_as_uint(e[i]) ^ __float_as_uint(e[8 + i])) & hmask));
    const unsigned code = 255u - (bsel & 255u);
    const int a = code >> 4, bb = code & 15;
    ip[i] = (int)myidx[a] * 128 + (int)myidx[16 + bb];
    gp[i] = esel * einv;
  }
}

DI float gelu_exact(float a) { return 0.5f * a * (1.f + erff(a * 0.70710678118654752f)); }
DI float dot8(u32x4 a, u32x4 b, float acc) {
#pragma unroll
  for (int i = 0; i < 4; ++i) { const unsigned ai = a[i], bi = b[i];
    acc = __builtin_amdgcn_fdot2_f32_bf16(__builtin_bit_cast(bf16x2, ai), __builtin_bit_cast(bf16x2, bi), acc, false); }
  return acc;
}
DI void axpy8(float (&o)[8], u32x4 v, float c) {
#pragma unroll
  for (int i = 0; i < 4; ++i) { o[2 * i] += c * __uint_as_float(v[i] << 16); o[2 * i + 1] += c * __uint_as_float(v[i] & 0xffff0000u); }
}
DI void peer_token(const P& p, int token) {
  const int lane = (threadIdx.x + opaque0()) & 63;
  const bf16* hrow = w_H(p) + (size_t)token * DM;
  const u32x4 xa = *(const u32x4*)(hrow + 8 * lane), xb = *(const u32x4*)(hrow + 512 + 8 * lane);
  const int id0 = w_IDX(p)[(size_t)token * 128 + lane], id1 = w_IDX(p)[(size_t)token * 128 + 64 + lane];
  const float gt0 = w_GATE(p)[(size_t)token * 128 + lane], gt1 = w_GATE(p)[(size_t)token * 128 + 64 + lane];
  float oa[8], ob[8];
#pragma unroll
  for (int i = 0; i < 8; ++i) { oa[i] = 0.f; ob[i] = 0.f; }
  const int h = lane >> 5, b4 = (lane >> 4) & 1;
  for (int e0 = 0; e0 < 128; e0 += 4) {
    u32x4 ua[4], ub[4], va[4], vb[4];
    float gg[4];
#pragma unroll
    for (int q = 0; q < 4; ++q) {
      const int e = e0 + q;
      const int id = e < 64 ? __builtin_amdgcn_readlane(id0, e & 63) : __builtin_amdgcn_readlane(id1, e & 63);
      gg[q] = __int_as_float(e < 64 ? __builtin_amdgcn_readlane(__float_as_int(gt0), e & 63) : __builtin_amdgcn_readlane(__float_as_int(gt1), e & 63));
      const bf16* ur = w_Ub(p) + (size_t)id * DM;
      const bf16* vr = w_Vb(p) + (size_t)id * DM;
      ua[q] = *(const u32x4*)(ur + 8 * lane); ub[q] = *(const u32x4*)(ur + 512 + 8 * lane);
      va[q] = *(const u32x4*)(vr + 8 * lane); vb[q] = *(const u32x4*)(vr + 512 + 8 * lane);
    }
    float d[4];
#pragma unroll
    for (int q = 0; q < 4; ++q) d[q] = dot8(ub[q], xb, dot8(ua[q], xa, 0.f));
    float a0 = h ? d[2] : d[0], a1 = h ? d[3] : d[1], s0 = h ? d[0] : d[2], s1 = h ? d[1] : d[3];
    a0 += __shfl_xor(s0, 32); a1 += __shfl_xor(s1, 32);
    float k = b4 ? a1 : a0, s = b4 ? a0 : a1;
    k += __shfl_xor(s, 16);
    k += __shfl_xor(k, 8); k += __shfl_xor(k, 4); k += __shfl_xor(k, 2); k += __shfl_xor(k, 1);
#pragma unroll
    for (int q = 0; q < 4; ++q) {
      const float a = __int_as_float(__builtin_amdgcn_readlane(__float_as_int(k), 16 * q));
      const float c = gg[q] * gelu_exact(a);
      axpy8(oa, va[q], c); axpy8(ob, vb[q], c);
    }
  }
  const float* x1 = w_X1(p) + (size_t)token * DM;
  const float* g2 = w_MOD(p) + (size_t)cond_row(token) * 6144 + 5120;
  float* y = p.out + O_YP + (size_t)token * DM;
#pragma unroll
  for (int i = 0; i < 2; ++i) {
    const int c0 = 8 * lane + 4 * i, c1 = 512 + 8 * lane + 4 * i;
    const f32x4 xv0 = *(const f32x4*)(x1 + c0), gv0 = *(const f32x4*)(g2 + c0), xv1 = *(const f32x4*)(x1 + c1), gv1 = *(const f32x4*)(g2 + c1);
    f32x4 y0, y1;
#pragma unroll
    for (int j = 0; j < 4; ++j) { y0[j] = xv0[j] + gv0[j] * oa[4 * i + j]; y1[j] = xv1[j] + gv1[j] * ob[4 * i + j]; }
    *(f32x4*)(y + c0) = y0; *(f32x4*)(y + c1) = y1;
  }
}

constexpr int NPHASE = 8;
template <int PH> DI void run_phase(const P& p, char* smem) {
  const int G = gridDim.x, bid = blockIdx.x, w = __builtin_amdgcn_readfirstlane(threadIdx.x >> 6);
  if constexpr (PH == 0) { for (int u = bid; u < U0_TOTAL; u += G) phase0_unit(p, u, smem); }
  if constexpr (PH == 1) { for (int tk = bid * 4 + w; tk < NTOK; tk += G * 4) norm_row(p, tk, 0); }
  if constexpr (PH == 2) { for (int u = bid; u < 129 * 30; u += G) unit_gemm1(p, u, smem); }
  if constexpr (PH == 3) { for (int u = bid; u < 2048; u += G) unit_attn_prompt(p, u, smem);
                           for (int u = bid; u < 256; u += G) unit_attn_sample(p, u, smem); }
  if constexpr (PH == 4) { for (int u = bid; u < 129 * 8; u += G) unit_gemm2(p, u, smem); }
  if constexpr (PH == 5) { for (int tk = bid * 4 + w; tk < NTOK; tk += G * 4) norm_row(p, tk, 1); }
  if constexpr (PH == 6) { for (int u = bid; u < 129 * 8; u += G) unit_peer_route(p, u, smem); }
  if constexpr (PH == 7) { for (int tk = bid * 4 + w; tk < NTOK; tk += G * 4) peer_token(p, tk); }
}
#if ONE_LAUNCH
__global__ void __launch_bounds__(NTHREADS, 2) mega(P p) {
  __shared__ __attribute__((aligned(16))) char smem[SMEM_BYTES];
  __shared__ uint4 xbw;
  if (threadIdx.x == 0) xbw = make_uint4(0u, 0u, 0u, 0u);
  __syncthreads();
  const unsigned xcc = xb_xcc_id();
  if (threadIdx.x == 0) (void)xb_add(&w_bar(p)[XB_XCNT(xcc)], 1u);
  volatile unsigned* st = (volatile unsigned*)&xbw;
  run_phase<0>(p, smem); xcd_barrier(w_bar(p), xcc, st);
  run_phase<1>(p, smem); xcd_barrier(w_bar(p), xcc, st);
  run_phase<2>(p, smem); xcd_barrier(w_bar(p), xcc, st);
  run_phase<3>(p, smem); xcd_barrier(w_bar(p), xcc, st);
  run_phase<4>(p, smem); xcd_barrier(w_bar(p), xcc, st);
  run_phase<5>(p, smem); xcd_barrier(w_bar(p), xcc, st);
  run_phase<6>(p, smem); xcd_barrier(w_bar(p), xcc, st);
  run_phase<7>(p, smem);
}
#else
template <int PH> __global__ void __launch_bounds__(NTHREADS, 2) mega(P p) {
  __shared__ __attribute__((aligned(16))) char smem[SMEM_BYTES];
  run_phase<PH>(p, smem);
}
#endif


#ifdef PROBE
#ifndef PROBE_ALPHA
#define PROBE_ALPHA 1.0f
#endif
__device__ __forceinline__ int probe_token(int i) { return i < 120 ? i * 137 + 5 : NPR + (i - 120) * 16; }
__device__ float block_sum(float v, float* red) {
  __syncthreads();
  v = wave_sum(v);
  if ((threadIdx.x & 63) == 0) red[threadIdx.x >> 6] = v;
  __syncthreads();
  return red[0] + red[1] + red[2] + red[3];
}
__global__ void __launch_bounds__(256) probe_peer_gather(P p) {
  __shared__ float red[4];
  const int i = blockIdx.x, token = probe_token(i), t = threadIdx.x;
  const bf16* hrow = w_H(p) + (size_t)token * DM;
  float acc[4] = {0.f, 0.f, 0.f, 0.f};
  for (int e = 0; e < 128; ++e) {
    const int id = w_IDX(p)[(size_t)token * 128 + e];
    const float g = w_GATE(p)[(size_t)token * 128 + e];
    float part = 0.f;
    for (int d = t; d < DM; d += 256) part += (float)hrow[d] * (float)w_Ub(p)[(size_t)id * DM + d];
    const float a = block_sum(part, red);
    const float c = g * 0.5f * a * (1.f + erff(a * 0.70710678118654752f));
    for (int q = 0; q < 4; ++q) acc[q] += c * (float)w_Vb(p)[(size_t)id * DM + t + 256 * q];
  }
  const float* g2 = w_MOD(p) + (size_t)cond_row(token) * 6144 + 5120;
  for (int q = 0; q < 4; ++q) {
    const int ch = t + 256 * q;
    const float ynaive = w_X1(p)[(size_t)token * DM + ch] + g2[ch] * acc[q];
    const float yfast = p.out[O_YP + (size_t)token * DM + ch];
    p.out[O_KWP + (size_t)i * DM + ch] += PROBE_ALPHA * (yfast - ynaive);
  }
}
__global__ void __launch_bounds__(256) probe_peer_route(P p) {
  __shared__ float qry[2048];
  __shared__ float sc[16][128];
  __shared__ float tv[16][16];
  __shared__ int ti[16][16];
  __shared__ float bs[8][16];
  __shared__ int bi[8][16];
  __shared__ float css[8][256];
  const int i = blockIdx.x, token = probe_token(i), t = threadIdx.x;
  const bf16* hrow = w_H(p) + (size_t)token * DM;
  for (int f = t; f < 2048; f += 256) {
    float a = 0.f;
    for (int d = 0; d < DM; ++d) a += (float)hrow[d] * (float)w_Wt_q(p)[(size_t)f * DM + d];
    qry[f] = (float)(bf16)a;
  }
  __syncthreads();
  for (int o = t; o < 16 * 128; o += 256) {
    const int hp = o >> 7, k = o & 127;
    float a = 0.f;
    for (int d = 0; d < 128; ++d) a += qry[hp * 128 + d] * (float)w_SK(p)[((size_t)hp * 128 + k) * 128 + d];
    sc[hp][k] = a;
  }
  __syncthreads();
  if (t < 16) {
    for (int r = 0; r < 16; ++r) {
      int bk = 0; float bv = -INFINITY;
      for (int k = 0; k < 128; ++k) if (sc[t][k] > bv) { bv = sc[t][k]; bk = k; }
      tv[t][r] = bv; ti[t][r] = bk; sc[t][bk] = -INFINITY;
    }
  }
  __syncthreads();
  if (t < 8) {
    float* cs = css[t];
    for (int a = 0; a < 16; ++a) for (int b = 0; b < 16; ++b) cs[a * 16 + b] = tv[2 * t][a] + tv[2 * t + 1][b];
    float mx = -INFINITY;
    for (int r = 0; r < 16; ++r) {
      int bk = 0; float bv = -INFINITY;
      for (int k = 0; k < 256; ++k) if (cs[k] > bv) { bv = cs[k]; bk = k; }
      if (r == 0) mx = bv;
      bs[t][r] = bv; bi[t][r] = ti[2 * t][bk >> 4] * 128 + ti[2 * t + 1][bk & 15]; cs[bk] = -INFINITY;
    }
    float sum = 0.f;
    for (int r = 0; r < 16; ++r) { bs[t][r] = expf(bs[t][r] - mx); sum += bs[t][r]; }
    for (int r = 0; r < 16; ++r) bs[t][r] /= sum;
  }
  __syncthreads();
  if (t < 128) {
    const int hd = t >> 4, r = t & 15;
    float gf = 0.f;
    for (int e = 0; e < 16; ++e) if (w_IDX(p)[(size_t)token * 128 + hd * 16 + e] == bi[hd][r]) gf = w_GATE(p)[(size_t)token * 128 + hd * 16 + e];
    const float diff = bs[hd][r] - gf;
    for (int q = 0; q < 8; ++q) p.out[O_KWP + (size_t)i * DM + t * 8 + q] += PROBE_ALPHA * diff;
  }
}
#endif
extern "C" void kernel_launch(void* const* d_in, const int* in_sizes, int n_in, void* d_out, int out_size, void* d_ws, size_t ws_size, hipStream_t stream) {
  P p{};
  const float* const* in = (const float* const*)d_in;
  p.x_prompt = in[0]; p.x_sample = in[1]; p.cache_k = in[2]; p.cache_v = in[3]; p.state_pool = in[4]; p.c_prompt = in[5]; p.c_sample = in[6];
  p.rel_table = in[7]; p.ada_w = in[8]; p.ada_b = in[9]; p.norm1_g = in[10]; p.w_in = in[11]; p.q_norm_g = in[12]; p.k_norm_g = in[13]; p.sinks = in[14];
  p.pool_w = in[15]; p.pool_scale = in[16]; p.w_out = in[17]; p.norm2_g = in[18]; p.w_query = in[19]; p.sub_keys = in[20]; p.peer_u = in[21]; p.peer_v = in[22];
  p.out = (float*)d_out;
  p.ws = (char*)d_ws;
  if (WS_NEED > ws_size) { fprintf(stderr, "workspace too small: need %zu have %zu\n", (size_t)WS_NEED, ws_size); return; }

  static int grid_blocks = 0;
  if (!grid_blocks) {
    int dev = 0, cus = 0, per_cu = 0;
    (void)hipGetDevice(&dev);
    (void)hipDeviceGetAttribute(&cus, hipDeviceAttributeMultiprocessorCount, dev);
#if ONE_LAUNCH
    (void)hipOccupancyMaxActiveBlocksPerMultiprocessor(&per_cu, mega, NTHREADS, 0);
#else
    per_cu = 2;
#endif
    if (per_cu > 2) per_cu = 2;
    if (per_cu < 1) per_cu = 1;
    if (cus < 1) cus = 256;
    grid_blocks = cus * per_cu;
  }
#if ONE_LAUNCH
  (void)hipMemsetAsync(p.ws + OFF_BAR, 0, XCD_BAR_WORDS * 4, stream);
  hipLaunchKernelGGL(mega, dim3(grid_blocks), dim3(NTHREADS), 0, stream, p);
#else
  hipLaunchKernelGGL(mega<0>, dim3(grid_blocks), dim3(NTHREADS), 0, stream, p);
  hipLaunchKernelGGL(mega<1>, dim3(grid_blocks), dim3(NTHREADS), 0, stream, p);
  hipLaunchKernelGGL(mega<2>, dim3(grid_blocks), dim3(NTHREADS), 0, stream, p);
  hipLaunchKernelGGL(mega<3>, dim3(grid_blocks), dim3(NTHREADS), 0, stream, p);
  hipLaunchKernelGGL(mega<4>, dim3(grid_blocks), dim3(NTHREADS), 0, stream, p);
  hipLaunchKernelGGL(mega<5>, dim3(grid_blocks), dim3(NTHREADS), 0, stream, p);
  hipLaunchKernelGGL(mega<6>, dim3(grid_blocks), dim3(NTHREADS), 0, stream, p);
  hipLaunchKernelGGL(mega<7>, dim3(grid_blocks), dim3(NTHREADS), 0, stream, p);
#endif
#ifdef PROBE
#if PROBE == 1
  hipLaunchKernelGGL(probe_peer_gather, dim3(128), dim3(256), 0, stream, p);
#elif PROBE == 2
  hipLaunchKernelGGL(probe_peer_route, dim3(128), dim3(256), 0, stream, p);
#endif
#endif
}
```

```cpp
#include <hip/hip_runtime.h>
#include <stdint.h>
#include <stdio.h>

#ifndef ONE_LAUNCH
#define ONE_LAUNCH 1
#endif

typedef __bf16 bf16;
typedef __bf16 bf16x2 __attribute__((ext_vector_type(2)));
typedef __bf16 bf16x4 __attribute__((ext_vector_type(4)));
typedef __bf16 bf16x8 __attribute__((ext_vector_type(8)));
typedef float f32x2 __attribute__((ext_vector_type(2)));
typedef float f32x4 __attribute__((ext_vector_type(4)));
typedef float f32x16 __attribute__((ext_vector_type(16)));
typedef unsigned u32x2 __attribute__((ext_vector_type(2)));
typedef unsigned u32x4 __attribute__((ext_vector_type(4)));

#define DI __device__ __forceinline__
#define MFMA(a, b, c) __builtin_amdgcn_mfma_f32_32x32x16_bf16((a), (b), (c), 0, 0, 0)

constexpr int DM = 1024, NB = 8, SEQ = 2048, NS = 128, NPR = NB * SEQ, NTOK = NPR + NS;
constexpr int INW = 3840, NMOD = NB + NS;
constexpr int C_K = 1024, C_V = 1152, C_PIN = 1280, C_GA = 1792, C_GB = 2816;
constexpr int NEXP = 16384;
constexpr float EPS = 1e-6f;
constexpr size_t O_YP = 0, O_KWP = 16908288, O_VWP = 17039360, O_PP = 17170432, O_KWS = 17231872, O_VWS = 19329024, O_PS = 21426176;

constexpr int SMEM_BYTES = 77824;
constexpr int NTHREADS = 256;

struct P {
  const float *x_prompt, *x_sample, *cache_k, *cache_v, *state_pool, *c_prompt, *c_sample, *rel_table, *ada_w, *ada_b, *norm1_g, *w_in,
      *q_norm_g, *k_norm_g, *sinks, *pool_w, *pool_scale, *w_out, *norm2_g, *w_query, *sub_keys, *peer_u, *peer_v;
  float* out;
  char* ws;
};
constexpr size_t al256(size_t x) { return (x + 255) & ~(size_t)255; }
constexpr size_t OFF_BAR = 0;
constexpr size_t OFF_WTIN = OFF_BAR + al256(4096 * 4);
constexpr size_t OFF_WTOUT = OFF_WTIN + al256((size_t)INW * 1024 * 2);
constexpr size_t OFF_WTQ = OFF_WTOUT + al256((size_t)1024 * 1024 * 2);
constexpr size_t OFF_SK = OFF_WTQ + al256((size_t)2048 * 1024 * 2);
constexpr size_t OFF_PWT = OFF_SK + al256((size_t)16 * 128 * 128 * 2);
constexpr size_t OFF_UB = OFF_PWT + al256((size_t)4 * 256 * 128 * 2);
constexpr size_t OFF_VB = OFF_UB + al256((size_t)NEXP * DM);
constexpr size_t OFF_SU = OFF_VB + al256((size_t)NEXP * DM);
constexpr size_t OFF_SV = OFF_SU + al256((size_t)NEXP * 4);
constexpr size_t OFF_MOD = OFF_SV + al256((size_t)NEXP * 4);
constexpr size_t OFF_BIAS = OFF_MOD + al256((size_t)NMOD * 6144 * 4);
constexpr size_t OFF_VT = OFF_BIAS + al256(16 * 128 * 4);
constexpr size_t OFF_H = OFF_VT + al256((size_t)NB * 128 * SEQ * 2);
constexpr size_t OFF_MIXED = OFF_H;
constexpr size_t OFF_PROJ = OFF_H + al256((size_t)NTOK * DM * 2);
constexpr size_t OFF_X1 = OFF_PROJ;
constexpr size_t OFF_IDX = OFF_X1 + (size_t)NTOK * DM * 4;
constexpr size_t OFF_GATE = OFF_IDX + (size_t)NTOK * 128 * 4;
constexpr size_t WS_NEED = OFF_PROJ + al256((size_t)NTOK * INW * 2);
static_assert(OFF_GATE + (size_t)NTOK * 128 * 4 <= WS_NEED, "overlay fits");
static_assert(WS_NEED <= (size_t)256 * 1024 * 1024, "workspace budget");
#define WS_PTR(T, name, OFF) __device__ __forceinline__ T* name(const P& p) { return (T*)(p.ws + (OFF)); }
WS_PTR(unsigned, w_bar, OFF_BAR) WS_PTR(bf16, w_Wt_in, OFF_WTIN) WS_PTR(bf16, w_Wt_out, OFF_WTOUT) WS_PTR(bf16, w_Wt_q, OFF_WTQ) WS_PTR(bf16, w_SK, OFF_SK)
WS_PTR(bf16, w_PWt, OFF_PWT) WS_PTR(unsigned char, w_Ub, OFF_UB) WS_PTR(unsigned char, w_Vb, OFF_VB) WS_PTR(float, w_SU, OFF_SU) WS_PTR(float, w_SV, OFF_SV) WS_PTR(float, w_MOD, OFF_MOD) WS_PTR(float, w_BIAS, OFF_BIAS)
WS_PTR(bf16, w_VT, OFF_VT) WS_PTR(bf16, w_H, OFF_H) WS_PTR(bf16, w_MIXED, OFF_MIXED) WS_PTR(bf16, w_PROJ, OFF_PROJ) WS_PTR(float, w_X1, OFF_X1)
WS_PTR(int, w_IDX, OFF_IDX) WS_PTR(float, w_GATE, OFF_GATE)

DI int cond_row(int token) { return token < NPR ? (token >> 11) : (NB + token - NPR); }
DI int crow(int reg, int h) { return (reg & 3) + 8 * (reg >> 2) + 4 * h; }
DI const float* xrow(const P& p, int token) { return token < NPR ? p.x_prompt + (size_t)token * DM : p.x_sample + (size_t)(token - NPR) * DM; }

DI int opaque0() { int z = 0; asm volatile("" : "+v"(z)); return z; }
DI float bf2f(bf16 v) { return (float)v; }
DI f32x16 zero16() { f32x16 z; for (int i = 0; i < 16; ++i) z[i] = 0.f; return z; }
DI bf16x8 pack_step(const f32x16& x, int s) { bf16x8 v; for (int j = 0; j < 8; ++j) v[j] = (bf16)x[8 * s + j]; return v; }
DI bf16x8 cat4(bf16x4 lo, bf16x4 hi) { return __builtin_shufflevector(lo, hi, 0, 1, 2, 3, 4, 5, 6, 7); }
DI float wave_sum(float v) { for (int o = 32; o >= 1; o >>= 1) v += __shfl_xor(v, o); return v; }

#define XB_TMO 128
#define XB_XCNT(j) (256 + 64 * (j))
#define XB_XSUB(j) (1280 + 64 * (j))
#define XB_XGEN(j) (2304 + 64 * (j))
#define XB_TOP 3328
#define XB_TOPGEN 3392
#define XCD_BAR_WORDS 3456
#define XB_SPIN_CAP (1u << 22)
DI unsigned xb_ld(unsigned* p) { return __hip_atomic_load(p, __ATOMIC_RELAXED, __HIP_MEMORY_SCOPE_AGENT); }
DI unsigned xb_add(unsigned* p, unsigned v) { return __hip_atomic_fetch_add(p, v, __ATOMIC_RELAXED, __HIP_MEMORY_SCOPE_AGENT); }
DI unsigned xb_xcc_id() { return (unsigned)__builtin_amdgcn_s_getreg((3 << 11) | 20) & 0xFu; }
#define XB_SPIN(cond, bar) do { unsigned _sp = 0; while (cond) { __builtin_amdgcn_s_sleep(1); \
    if ((++_sp & 255u) == 0u) { if (xb_ld(&(bar)[XB_TMO])) break; if (_sp > XB_SPIN_CAP) { atomicAdd(&(bar)[XB_TMO], 1u); break; } } } } while (0)

DI void xcd_barrier_complete(unsigned* bar, unsigned x, unsigned& nloc, unsigned& nx) {
  const unsigned G = gridDim.x;
  unsigned sum, cnt, mine, sp = 0u;
  for (;;) {
    sum = 0u; cnt = 0u; mine = 0u;
#pragma unroll
    for (unsigned j = 0; j < 16; ++j) { const unsigned c = xb_ld(&bar[XB_XCNT(j)]); sum += c; cnt += (c > 0u) ? 1u : 0u; mine = (j == x) ? c : mine; }
    if (sum == G) break;
    __builtin_amdgcn_s_sleep(1);
    if ((++sp & 255u) == 0u) { if (xb_ld(&bar[XB_TMO])) break; if (sp > XB_SPIN_CAP) { atomicAdd(&bar[XB_TMO], 1u); break; } }
  }
  nloc = mine > 0u ? mine : 1u; nx = cnt > 0u ? cnt : 1u;
}
DI void xcd_barrier(unsigned* bar, unsigned x, volatile unsigned* st) {
  asm volatile("s_waitcnt vmcnt(0)" ::: "memory");
  __syncthreads();
  if (threadIdx.x == 0) {
    __builtin_amdgcn_s_waitcnt(0);
    unsigned nloc = st[0], nx = st[1];
    if (nloc == 0u) { xcd_barrier_complete(bar, x, nloc, nx); st[0] = nloc; st[1] = nx; }
    const unsigned old = xb_add(&bar[XB_XSUB(x)], 1u);
    const unsigned gen = old / nloc;
    if (old + 1u == (gen + 1u) * nloc) {
      __builtin_amdgcn_fence(__ATOMIC_RELEASE, "agent");
      asm volatile("s_waitcnt vmcnt(0)" ::: "memory");
      const unsigned og = xb_add(&bar[XB_TOP], 1u);
      const unsigned tg = og / nx;
      if (og + 1u == (tg + 1u) * nx) xb_add(&bar[XB_TOPGEN], 1u);
      else XB_SPIN(xb_ld(&bar[XB_TOPGEN]) == tg, bar);
      __builtin_amdgcn_fence(__ATOMIC_ACQUIRE, "agent");
      xb_add(&bar[XB_XGEN(x)], 1u);
      asm volatile("s_waitcnt vmcnt(0)" ::: "memory");
    } else {
      XB_SPIN(xb_ld(&bar[XB_XGEN(x)]) == gen, bar);
      __builtin_amdgcn_fence(__ATOMIC_ACQUIRE, "agent");
      asm volatile("s_waitcnt vmcnt(0)" ::: "memory");
    }
  }
  __syncthreads();
}

constexpr int U0_MOD = 192;
constexpr int U0_TIN = (1024 / 64) * (INW / 64);
constexpr int U0_TOUT = 16 * 16;
constexpr int U0_TQ = 16 * 32;
constexpr int U0_TPW = 4 * 2 * 4;
constexpr int U0_CSK = 32;
constexpr int U0_CU = 2048, U0_CV = 2048;
constexpr int U0_KW = 128, U0_VW = 128, U0_PW = 128, U0_BIAS = 1;
constexpr int U0_E0 = U0_MOD, U0_E1 = U0_E0 + U0_TIN, U0_E2 = U0_E1 + U0_TOUT, U0_E3 = U0_E2 + U0_TQ, U0_E4 = U0_E3 + U0_TPW, U0_E5 = U0_E4 + U0_CSK,
              U0_E6 = U0_E5 + U0_CU, U0_E7 = U0_E6 + U0_CV, U0_E8 = U0_E7 + U0_KW, U0_E9 = U0_E8 + U0_VW, U0_E10 = U0_E9 + U0_PW, U0_TOTAL = U0_E10 + U0_BIAS;

DI float silu_f(float x) { return x / (1.f + __expf(-x)); }

DI void unit_mod(const P& p, int u, char* smem) {
  const int t = threadIdx.x + opaque0(), lane = t & 63, w = t >> 6, r = lane & 31, h = lane >> 5;
  const int f0 = u * 32;
  f32x16 acc[5];
#pragma unroll
  for (int i = 0; i < 5; ++i) acc[i] = zero16();
#pragma unroll 1
  for (int ks = 0; ks < 16; ++ks) {
    const int k0 = w * 256 + ks * 16 + 8 * h;
    bf16x8 bfr;
#pragma unroll
    for (int j = 0; j < 8; ++j) bfr[j] = (bf16)p.ada_w[(size_t)(k0 + j) * 6144 + f0 + r];
#pragma unroll
    for (int i = 0; i < 5; ++i) {
      const int m = 32 * i + r;
      bf16x8 afr;
      if (m < NMOD) {
        const float* c = (m < NB ? p.c_prompt + (size_t)m * DM : p.c_sample + (size_t)(m - NB) * DM) + k0;
        const f32x4 c0 = *(const f32x4*)c, c1 = *(const f32x4*)(c + 4);
        afr[0] = (bf16)silu_f(c0[0]); afr[1] = (bf16)silu_f(c0[1]); afr[2] = (bf16)silu_f(c0[2]); afr[3] = (bf16)silu_f(c0[3]);
        afr[4] = (bf16)silu_f(c1[0]); afr[5] = (bf16)silu_f(c1[1]); afr[6] = (bf16)silu_f(c1[2]); afr[7] = (bf16)silu_f(c1[3]);
      } else {
#pragma unroll
        for (int j = 0; j < 8; ++j) afr[j] = (bf16)0.f;
      }
      acc[i] = MFMA(afr, bfr, acc[i]);
    }
  }
  float* red = (float*)smem;
  __syncthreads();
  if (w > 0) {
#pragma unroll
    for (int i = 0; i < 5; ++i)
#pragma unroll
      for (int j = 0; j < 16; ++j) red[((w - 1) * 80 + i * 16 + j) * 64 + lane] = acc[i][j];
  }
  __syncthreads();
  if (w == 0) {
    const float bias = p.ada_b[f0 + r];
#pragma unroll
    for (int i = 0; i < 5; ++i)
#pragma unroll
      for (int j = 0; j < 16; ++j) {
        const int m = 32 * i + crow(j, h);
        const float v = acc[i][j] + red[(0 * 80 + i * 16 + j) * 64 + lane] + red[(1 * 80 + i * 16 + j) * 64 + lane] + red[(2 * 80 + i * 16 + j) * 64 + lane] + bias;
        if (m < NMOD) w_MOD(p)[(size_t)m * 6144 + f0 + r] = v;
      }
  }
}

DI void unit_transpose(const float* __restrict__ src, bf16* __restrict__ dst, int R, int C, int tr, int tc, char* smem) {
  float* tile = (float*)smem;
  const int t = threadIdx.x + opaque0();
  __syncthreads();
#pragma unroll
  for (int i = 0; i < 4; ++i) {
    const int rr = (t >> 4) + 16 * i, cc = (t & 15) * 4;
    const f32x4 v = *(const f32x4*)(src + (size_t)(tr * 64 + rr) * C + tc * 64 + cc);
    tile[rr * 65 + cc] = v[0]; tile[rr * 65 + cc + 1] = v[1]; tile[rr * 65 + cc + 2] = v[2]; tile[rr * 65 + cc + 3] = v[3];
  }
  __syncthreads();
#pragma unroll
  for (int i = 0; i < 2; ++i) {
    const int orow = (t >> 3) + 32 * i, seg = (t & 7) * 8;
    bf16x8 v;
#pragma unroll
    for (int j = 0; j < 8; ++j) v[j] = (bf16)tile[(seg + j) * 65 + orow];
    *(bf16x8*)(dst + (size_t)(tc * 64 + orow) * R + tr * 64 + seg) = v;
  }
}
DI void unit_convert(const float* __restrict__ src, bf16* __restrict__ dst, int u) {
  const size_t base = (size_t)u * 8192 + (threadIdx.x + opaque0()) * 8;
#pragma unroll
  for (int i = 0; i < 4; ++i) {
    const size_t o = base + (size_t)i * 2048;
    const f32x4 a = *(const f32x4*)(src + o), b = *(const f32x4*)(src + o + 4);
    bf16x8 v; v[0] = (bf16)a[0]; v[1] = (bf16)a[1]; v[2] = (bf16)a[2]; v[3] = (bf16)a[3]; v[4] = (bf16)b[0]; v[5] = (bf16)b[1]; v[6] = (bf16)b[2]; v[7] = (bf16)b[3];
    *(bf16x8*)(dst + o) = v;
  }
}
DI void unit_quant_rows(const float* __restrict__ src, unsigned char* __restrict__ dst, float* __restrict__ scale, int u) {
  const int t = threadIdx.x + opaque0(), lane = t & 63, w = t >> 6;
#pragma unroll
  for (int rr = 0; rr < 2; ++rr) {
    const size_t row = (size_t)u * 8 + 2 * w + rr;
    const float* s = src + row * DM + 16 * lane;
    f32x4 v[4];
    float amax = 0.f;
#pragma unroll
    for (int i = 0; i < 4; ++i) { v[i] = *(const f32x4*)(s + 4 * i); amax = fmaxf(amax, fmaxf(fmaxf(fabsf(v[i][0]), fabsf(v[i][1])), fmaxf(fabsf(v[i][2]), fabsf(v[i][3])))); }
#pragma unroll
    for (int o = 32; o >= 1; o >>= 1) amax = fmaxf(amax, __shfl_xor(amax, o));
    const float sc = amax > 0.f ? amax * (1.f / 440.f) : 1.f, inv = 1.f / sc;
    u32x4 q;
#pragma unroll
    for (int i = 0; i < 4; ++i) {
      int wd = 0;
      wd = __builtin_amdgcn_cvt_pk_fp8_f32(v[i][0] * inv, v[i][1] * inv, wd, false);
      wd = __builtin_amdgcn_cvt_pk_fp8_f32(v[i][2] * inv, v[i][3] * inv, wd, true);
      q[i] = (unsigned)wd;
    }
    *(u32x4*)(dst + row * DM + 16 * lane) = q;
    if (lane == 0) scale[row] = sc;
  }
}
DI void unit_copy_f4(const float* __restrict__ src, float* __restrict__ dst, int n4) {
  for (int i = threadIdx.x + opaque0(); i < n4; i += NTHREADS) ((f32x4*)dst)[i] = ((const f32x4*)src)[i];
}

DI void phase0_unit(const P& p, int u, char* smem) {
  if (u < U0_E0) { unit_mod(p, u, smem); }
  else if (u < U0_E1) { const int v = u - U0_E0; unit_transpose(p.w_in, w_Wt_in(p), 1024, INW, v / 60, v % 60, smem); }
  else if (u < U0_E2) { const int v = u - U0_E1; unit_transpose(p.w_out, w_Wt_out(p), 1024, 1024, v / 16, v % 16, smem); }
  else if (u < U0_E3) { const int v = u - U0_E2; unit_transpose(p.w_query, w_Wt_q(p), 1024, 2048, v / 32, v % 32, smem); }
  else if (u < U0_E4) { const int v = u - U0_E3, g = v >> 3, tt = v & 7; unit_transpose(p.pool_w + (size_t)g * 128 * 256, w_PWt(p) + (size_t)g * 256 * 128, 128, 256, tt >> 2, tt & 3, smem); }
  else if (u < U0_E5) { unit_convert(p.sub_keys, w_SK(p), u - U0_E4); }
  else if (u < U0_E6) { unit_quant_rows(p.peer_u, w_Ub(p), w_SU(p), u - U0_E5); }
  else if (u < U0_E7) { unit_quant_rows(p.peer_v, w_Vb(p), w_SV(p), u - U0_E6); }
  else if (u < U0_E8) { const int b = u - U0_E7; unit_copy_f4(p.cache_k + ((size_t)b * 128 + 1) * 128, p.out + O_KWS + (size_t)b * 128 * 128, 127 * 128 / 4); }
  else if (u < U0_E9) { const int b = u - U0_E8; unit_copy_f4(p.cache_v + ((size_t)b * 128 + 1) * 128, p.out + O_VWS + (size_t)b * 128 * 128, 127 * 128 / 4); }
  else if (u < U0_E10) { const int b = u - U0_E9; unit_copy_f4(p.state_pool + ((size_t)b * 15 + 1) * 512, p.out + O_PS + (size_t)b * 15 * 512, 14 * 512 / 4); }
  else {
    for (int i = threadIdx.x + opaque0(); i < 16 * 128; i += NTHREADS) {
      const int head = i >> 7, d = i & 127;
      int bk = d;
      if (d >= 16) { bk = 16 + (int)(logf((float)d / 16.f) / logf(8.f) * 16.f); bk = bk > 31 ? 31 : bk; }
      w_BIAS(p)[i] = p.rel_table[bk * 16 + head];
    }
  }
}

DI void norm_row(const P& p, int token, int which) {
  const int lane = (threadIdx.x + opaque0()) & 63;
  const float* src = which == 0 ? xrow(p, token) : w_X1(p) + (size_t)token * DM;
  const float* g = which == 0 ? p.norm1_g : p.norm2_g;
  const float* mod = w_MOD(p) + (size_t)cond_row(token) * 6144 + (which == 0 ? 0 : 3072);
  f32x4 v[4];
  float ss = 0.f;
#pragma unroll
  for (int i = 0; i < 4; ++i) { v[i] = *(const f32x4*)(src + 4 * lane + 256 * i); ss += v[i][0] * v[i][0] + v[i][1] * v[i][1] + v[i][2] * v[i][2] + v[i][3] * v[i][3]; }
  ss = wave_sum(ss);
  const float rstd = rsqrtf(ss * (1.f / DM) + EPS);
#pragma unroll
  for (int i = 0; i < 4; ++i) {
    const int c = 4 * lane + 256 * i;
    const f32x4 gg = *(const f32x4*)(g + c), sh = *(const f32x4*)(mod + c), sc = *(const f32x4*)(mod + 1024 + c);
    bf16x4 o;
#pragma unroll
    for (int j = 0; j < 4; ++j) o[j] = (bf16)((v[i][j] * rstd * gg[j]) * (1.f + sc[j]) + sh[j]);
    *(bf16x4*)(w_H(p) + (size_t)token * DM + c) = o;
  }
}

constexpr int LDSK = 72;
DI void gemm_tile(const bf16* __restrict__ Wt, const bf16* __restrict__ X, int K, int n0, int m0, char* smem, f32x16 (&acc)[4]) {
  bf16* As = (bf16*)smem;
  bf16* Bs = As + 128 * LDSK;
  const int t = threadIdx.x + opaque0(), lane = t & 63, w = t >> 6, r = lane & 31, h = lane >> 5;
#pragma unroll
  for (int i = 0; i < 4; ++i) acc[i] = zero16();
  const int lrow = t >> 3, lc = (t & 7) * 8;
  const bf16* ga = Wt + (size_t)(n0 + lrow) * K + lc;
  const bf16* gb = X + (size_t)(m0 + lrow) * K + lc;
  u32x4 ra[4], rb[4];
#pragma unroll
  for (int i = 0; i < 4; ++i) { ra[i] = *(const u32x4*)(ga + (size_t)(32 * i) * K); rb[i] = *(const u32x4*)(gb + (size_t)(32 * i) * K); }
  const int KT = K >> 6;
  for (int kt = 0; kt < KT; ++kt) {
    __syncthreads();
#pragma unroll
    for (int i = 0; i < 4; ++i) { *(u32x4*)(As + (lrow + 32 * i) * LDSK + lc) = ra[i]; *(u32x4*)(Bs + (lrow + 32 * i) * LDSK + lc) = rb[i]; }
    __syncthreads();
    if (kt + 1 < KT) {
      const int k0 = (kt + 1) * 64;
#pragma unroll
      for (int i = 0; i < 4; ++i) { ra[i] = *(const u32x4*)(ga + (size_t)(32 * i) * K + k0); rb[i] = *(const u32x4*)(gb + (size_t)(32 * i) * K + k0); }
    }
#pragma unroll
    for (int s = 0; s < 4; ++s) {
      const bf16x8 bfr = *(const bf16x8*)(Bs + (32 * w + r) * LDSK + 16 * s + 8 * h);
#pragma unroll
      for (int i = 0; i < 4; ++i) {
        const bf16x8 afr = *(const bf16x8*)(As + (32 * i + r) * LDSK + 16 * s + 8 * h);
        acc[i] = MFMA(afr, bfr, acc[i]);
      }
    }
  }
}

DI float sigmoid_f(float x) { return 1.f / (1.f + __expf(-x)); }

DI void unit_gemm1(const P& p, int u, char* smem) {
  const int mt = u / 30, nt = u % 30;
  const int n0 = nt * 128, m0 = mt * 128;
  f32x16 acc[4];
  gemm_tile(w_Wt_in(p), w_H(p), 1024, n0, m0, smem, acc);
  const int tz = threadIdx.x + opaque0();
  const int lane = tz & 63, w = tz >> 6, r = lane & 31, h = lane >> 5;
  const int token = m0 + 32 * w + r;
  bf16* prow = w_PROJ(p) + (size_t)token * INW;
  const bool is_prompt = token < NPR;
  const int b = is_prompt ? (token >> 11) : (token - NPR), pos = token & (SEQ - 1);
  if (n0 < C_V) {
    const float* gn = n0 < C_K ? p.q_norm_g : p.k_norm_g;
    const float post = n0 < C_K ? 0.125f : 1.f;
#pragma unroll
    for (int hh = 0; hh < 2; ++hh) {
      float ss = 0.f;
#pragma unroll
      for (int i = 0; i < 2; ++i)
#pragma unroll
        for (int j = 0; j < 16; ++j) ss += acc[2 * hh + i][j] * acc[2 * hh + i][j];
      ss += __shfl_xor(ss, 32);
      const float rstd = rsqrtf(ss * (1.f / 64.f) + EPS);
#pragma unroll
      for (int i = 0; i < 2; ++i)
#pragma unroll
        for (int q4 = 0; q4 < 4; ++q4) {
          const int d = 32 * i + 8 * q4 + 4 * h;
          const f32x4 gg = *(const f32x4*)(gn + d);
          f32x4 v;
#pragma unroll
          for (int j = 0; j < 4; ++j) v[j] = acc[2 * hh + i][4 * q4 + j] * rstd * gg[j];
          bf16x4 o;
#pragma unroll
          for (int j = 0; j < 4; ++j) o[j] = (bf16)(v[j] * post);
          const int f = n0 + 64 * hh + d;
          *(bf16x4*)(prow + f) = o;
          if (n0 == C_K) {
            if (is_prompt) { if (pos >= SEQ - 128) *(f32x4*)(p.out + O_KWP + ((size_t)b * 128 + (pos - (SEQ - 128))) * 128 + 64 * hh + d) = v; }
            else *(f32x4*)(p.out + O_KWS + ((size_t)b * 128 + 127) * 128 + 64 * hh + d) = v;
          }
        }
    }
  } else if (n0 == C_V) {
#pragma unroll
    for (int i = 0; i < 4; ++i)
#pragma unroll
      for (int q4 = 0; q4 < 4; ++q4) {
        const int f = 32 * i + 8 * q4 + 4 * h;
        f32x4 v;
#pragma unroll
        for (int j = 0; j < 4; ++j) v[j] = acc[i][4 * q4 + j];
        if (is_prompt) {
#pragma unroll
          for (int j = 0; j < 4; ++j) w_VT(p)[((size_t)b * 128 + f + j) * SEQ + pos] = (bf16)v[j];
          if (pos >= SEQ - 128) *(f32x4*)(p.out + O_VWP + ((size_t)b * 128 + (pos - (SEQ - 128))) * 128 + f) = v;
        } else *(f32x4*)(p.out + O_VWS + ((size_t)b * 128 + 127) * 128 + f) = v;
      }
  } else if (n0 < C_GA) {
#pragma unroll
    for (int i = 0; i < 4; ++i)
#pragma unroll
      for (int q4 = 0; q4 < 4; ++q4) {
        const int f = n0 + 32 * i + 8 * q4 + 4 * h;
        f32x4 v; bf16x4 o;
#pragma unroll
        for (int j = 0; j < 4; ++j) { v[j] = acc[i][4 * q4 + j]; o[j] = (bf16)v[j]; }
        *(bf16x4*)(prow + f) = o;
        if (is_prompt) { if (pos >= SEQ - 15) *(f32x4*)(p.out + O_PP + ((size_t)b * 15 + (pos - (SEQ - 15))) * 512 + (f - C_PIN)) = v; }
        else *(f32x4*)(p.out + O_PS + ((size_t)b * 15 + 14) * 512 + (f - C_PIN)) = v;
      }
  } else {
#pragma unroll
    for (int i = 0; i < 4; ++i)
#pragma unroll
      for (int q4 = 0; q4 < 4; ++q4) {
        const int f = n0 + 32 * i + 8 * q4 + 4 * h;
        bf16x4 o;
#pragma unroll
        for (int j = 0; j < 4; ++j) o[j] = (bf16)sigmoid_f(acc[i][4 * q4 + j]);
        *(bf16x4*)(prow + f) = o;
      }
  }
}

constexpr int VTS = 260;
constexpr int RS = 136;
DI void unit_attn_prompt(const P& p, int u, char* smem) {
  const int b = u >> 8, blk = (u >> 4) & 15, head = u & 15, hk = head >> 3;
  const int qpos0 = blk * 128;
  const int t = threadIdx.x + opaque0(), lane = t & 63, w = t >> 6, r = lane & 31, h = lane >> 5;
  bf16* Ks = (bf16*)smem;
  bf16* VTs = Ks + 256 * LDSK;
  float* bs = (float*)(VTs + 64 * VTS);
  bf16* Rs = Ks;
  __syncthreads();
#pragma unroll
  for (int i = 0; i < 8; ++i) {
    const int c = t + 256 * i, row = c >> 3, c16 = c & 7, kp = qpos0 - 128 + row;
    u32x4 v = {0u, 0u, 0u, 0u};
    if (kp >= 0) v = *(const u32x4*)(w_PROJ(p) + ((size_t)b * SEQ + kp) * INW + C_K + hk * 64 + c16 * 8);
    *(u32x4*)(Ks + row * LDSK + c16 * 8) = v;
  }
#pragma unroll
  for (int i = 0; i < 8; ++i) {
    const int c = t + 256 * i, drow = c >> 5, c16 = c & 31, kp0 = qpos0 - 128 + c16 * 8;
    u32x4 v = {0u, 0u, 0u, 0u};
    if (kp0 >= 0) v = *(const u32x4*)(w_VT(p) + ((size_t)(b * 2 + hk) * 64 + drow) * SEQ + kp0);
    u32x2* d2 = (u32x2*)(VTs + drow * VTS + c16 * 8);
    d2[0] = (u32x2){v[0], v[1]}; d2[1] = (u32x2){v[2], v[3]};
  }
  if (t < 192) { const int dist = 159 - t; bs[t] = (dist >= 0 && dist < 128) ? w_BIAS(p)[head * 128 + dist] : 0.f; }
  const int qi = 32 * w + r;
  const size_t tokq = (size_t)b * SEQ + qpos0 + qi;
  bf16x8 qf[4];
#pragma unroll
  for (int s = 0; s < 4; ++s) qf[s] = *(const bf16x8*)(w_PROJ(p) + tokq * INW + head * 64 + 16 * s + 8 * h);
  __syncthreads();
  f32x16 st[5];
#pragma unroll
  for (int tt = 0; tt < 5; ++tt) {
    st[tt] = zero16();
#pragma unroll
    for (int s = 0; s < 4; ++s) {
      const bf16x8 a = *(const bf16x8*)(Ks + (32 * (w + tt) + r) * LDSK + 16 * s + 8 * h);
      st[tt] = MFMA(a, qf[s], st[tt]);
    }
  }
  const float sink = p.sinks[head];
  float m = -INFINITY;
  {
    const int x = 31 - r + 4 * h;
    const float* bl = bs + x;
    const int kbase = blk > 0 ? 1024 : 32 * w + 4 * h;
#pragma unroll
    for (int tt = 0; tt < 5; ++tt)
#pragma unroll
      for (int j = 0; j < 16; ++j) {
        const int c = 32 * tt + (j & 3) + 8 * (j >> 2);
        const bool valid = (x + c >= 32) && (x + c <= 159) && (kbase + c >= 128);
        const float bv = bl[c];
        const float s = valid ? st[tt][j] + bv : -INFINITY;
        st[tt][j] = s;
        m = fmaxf(m, s);
      }
  }
  m = fmaxf(m, __shfl_xor(m, 32));
  m = fmaxf(m, sink);
  float sum = 0.f;
#pragma unroll
  for (int tt = 0; tt < 5; ++tt)
#pragma unroll
    for (int j = 0; j < 16; ++j) { const float e = __expf(st[tt][j] - m); st[tt][j] = e; sum += e; }
  sum += __shfl_xor(sum, 32);
  const float inv = 1.f / (sum + __expf(sink - m));
  f32x16 o[2] = {zero16(), zero16()};
#pragma unroll
  for (int tt = 0; tt < 5; ++tt)
#pragma unroll
    for (int s = 0; s < 2; ++s) {
      const bf16x8 pb = pack_step(st[tt], s);
#pragma unroll
      for (int i = 0; i < 2; ++i) {
        const bf16* vp = VTs + (32 * i + r) * VTS + 32 * (w + tt) + 16 * s + 4 * h;
        const bf16x8 a = cat4(*(const bf16x4*)vp, *(const bf16x4*)(vp + 8));
        o[i] = MFMA(a, pb, o[i]);
      }
    }
  __syncthreads();
  const int g = head >> 2, win = 2 << g;
  {
    const int tk = t >> 4, cc = t & 15;
    const int p0 = qpos0 + tk * 8;
    const bf16* pin = w_PROJ(p) + (size_t)b * SEQ * INW + C_PIN + g * 128 + cc * 8;
    float S[8];
#pragma unroll
    for (int j = 0; j < 8; ++j) S[j] = 0.f;
    for (int i = 0; i < win; ++i) {
      const int pp = p0 - i;
      if (pp >= 0) { const bf16x8 v = *(const bf16x8*)(pin + (size_t)pp * INW);
#pragma unroll
        for (int j = 0; j < 8; ++j) S[j] += bf2f(v[j]); }
    }
    for (int i = 0; i < 8; ++i) {
      const int pos = p0 + i;
      const bf16x8 cur = *(const bf16x8*)(pin + (size_t)pos * INW);
      if (i > 0) {
#pragma unroll
        for (int j = 0; j < 8; ++j) S[j] += bf2f(cur[j]);
        if (pos - win >= 0) { const bf16x8 old = *(const bf16x8*)(pin + (size_t)(pos - win) * INW);
#pragma unroll
          for (int j = 0; j < 8; ++j) S[j] -= bf2f(old[j]); }
      }
      const float icnt = 1.f / (float)(win < pos + 1 ? win : pos + 1);
      bf16x8 rr;
#pragma unroll
      for (int j = 0; j < 8; ++j) rr[j] = (bf16)(S[j] * icnt - bf2f(cur[j]));
      *(bf16x8*)(Rs + (tk * 8 + i) * RS + cc * 8) = rr;
    }
  }
  __syncthreads();
  f32x16 pa[2] = {zero16(), zero16()};
#pragma unroll
  for (int s = 0; s < 8; ++s) {
    const bf16x8 bfr = *(const bf16x8*)(Rs + (32 * w + r) * RS + 16 * s + 8 * h);
#pragma unroll
    for (int i = 0; i < 2; ++i) {
      const bf16x8 a = *(const bf16x8*)(w_PWt(p) + ((size_t)g * 256 + (head & 3) * 64 + 32 * i + r) * 128 + 16 * s + 8 * h);
      pa[i] = MFMA(a, bfr, pa[i]);
    }
  }
  const bf16* prow = w_PROJ(p) + tokq * INW;
#pragma unroll
  for (int i = 0; i < 2; ++i)
#pragma unroll
    for (int q4 = 0; q4 < 4; ++q4) {
      const int f = head * 64 + 32 * i + 8 * q4 + 4 * h;
      const bf16x4 ga = *(const bf16x4*)(prow + C_GA + f), gb = *(const bf16x4*)(prow + C_GB + f);
      const f32x4 ps = *(const f32x4*)(p.pool_scale + f);
      bf16x4 ov;
#pragma unroll
      for (int j = 0; j < 4; ++j) ov[j] = (bf16)(bf2f(ga[j]) * (o[i][4 * q4 + j] * inv) + bf2f(gb[j]) * (pa[i][4 * q4 + j] * ps[j]));
      *(bf16x4*)(w_MIXED(p) + tokq * DM + f) = ov;
    }
}

DI void unit_attn_sample(const P& p, int u, char* smem) {
  const int b = u >> 1, hk = u & 1;
  const int t = threadIdx.x + opaque0(), g8 = t >> 5, l32 = t & 31;
  float* ks = (float*)smem;
  float* vs = ks + 128 * 65;
  float* qs = vs + 128 * 64;
  float* ps = qs + 512;
  float* os = ps + 1024;
  float* rs = os + 512;
  const size_t token = (size_t)NPR + b;
  __syncthreads();
  const float* kw = p.out + O_KWS + (size_t)b * 128 * 128 + hk * 64;
  const float* vw = p.out + O_VWS + (size_t)b * 128 * 128 + hk * 64;
#pragma unroll 4
  for (int i = t; i < 128 * 64; i += NTHREADS) { const int j = i >> 6, d = i & 63; ks[j * 65 + d] = kw[(size_t)j * 128 + d]; vs[j * 64 + d] = vw[(size_t)j * 128 + d]; }
#pragma unroll 1
  for (int i = t; i < 512; i += NTHREADS) qs[i] = bf2f(w_PROJ(p)[token * INW + hk * 512 + i]);
  {
    const int gi = t >> 7, ch = t & 127, g = 2 * hk + gi, win = 2 << g;
    const float cur = p.out[O_PS + ((size_t)b * 15 + 14) * 512 + g * 128 + ch];
    float tot = cur;
#pragma unroll 1
    for (int i = 1; i < win; ++i) tot += p.state_pool[((size_t)b * 15 + 15 - i) * 512 + g * 128 + ch];
    rs[gi * 128 + ch] = tot / (float)win - cur;
  }
  __syncthreads();
  const int head = hk * 8 + g8;
  float s[4];
  float m = p.sinks[head];
#pragma unroll
  for (int i = 0; i < 4; ++i) {
    const int j = l32 + 32 * i;
    float a = 0.f;
#pragma unroll 8
    for (int d = 0; d < 64; ++d) a += qs[g8 * 64 + d] * ks[j * 65 + d];
    s[i] = a + w_BIAS(p)[head * 128 + 127 - j];
    m = fmaxf(m, s[i]);
  }
  for (int o = 16; o >= 1; o >>= 1) m = fmaxf(m, __shfl_xor(m, o));
  float sum = 0.f;
#pragma unroll
  for (int i = 0; i < 4; ++i) { s[i] = __expf(s[i] - m); sum += s[i]; }
  for (int o = 16; o >= 1; o >>= 1) sum += __shfl_xor(sum, o);
  const float inv = 1.f / (sum + __expf(p.sinks[head] - m));
#pragma unroll
  for (int i = 0; i < 4; ++i) ps[g8 * 128 + l32 + 32 * i] = s[i] * inv;
  __syncthreads();
#pragma unroll
  for (int i = 0; i < 2; ++i) {
    const int d = l32 + 32 * i;
    float a = 0.f;
#pragma unroll 8
    for (int j = 0; j < 128; ++j) a += ps[g8 * 128 + j] * vs[j * 64 + d];
    os[g8 * 64 + d] = a;
  }
  __syncthreads();
#pragma unroll
  for (int i = 0; i < 2; ++i) {
    const int fl = t + 256 * i, f = hk * 512 + fl, g = f >> 8, gi = g - 2 * hk, oc = f & 255;
    float pl = 0.f;
    const float* pw = p.pool_w + (size_t)g * 128 * 256 + oc;
#pragma unroll 8
    for (int ch = 0; ch < 128; ++ch) pl += rs[gi * 128 + ch] * pw[(size_t)ch * 256];
    pl *= p.pool_scale[f];
    const float ga = bf2f(w_PROJ(p)[token * INW + C_GA + f]), gb = bf2f(w_PROJ(p)[token * INW + C_GB + f]);
    w_MIXED(p)[token * DM + f] = (bf16)(ga * os[fl] + gb * pl);
  }
}

DI void unit_gemm2(const P& p, int u, char* smem) {
  const int mt = u >> 3, nt = u & 7;
  const int n0 = nt * 128, m0 = mt * 128;
  f32x16 acc[4];
  gemm_tile(w_Wt_out(p), w_MIXED(p), 1024, n0, m0, smem, acc);
  const int tz = threadIdx.x + opaque0();
  const int lane = tz & 63, w = tz >> 6, r = lane & 31, h = lane >> 5;
  const int token = m0 + 32 * w + r;
  const float* xr = xrow(p, token);
  const float* g1 = w_MOD(p) + (size_t)cond_row(token) * 6144 + 2048;
#pragma unroll
  for (int i = 0; i < 4; ++i)
#pragma unroll
    for (int q4 = 0; q4 < 4; ++q4) {
      const int f = n0 + 32 * i + 8 * q4 + 4 * h;
      const f32x4 xv = *(const f32x4*)(xr + f), gv = *(const f32x4*)(g1 + f);
      f32x4 o;
#pragma unroll
      for (int j = 0; j < 4; ++j) o[j] = xv[j] + gv[j] * acc[i][4 * q4 + j];
      *(f32x4*)(w_X1(p) + (size_t)token * DM + f) = o;
    }
}

DI unsigned f2ord(float f) { const unsigned u = __float_as_uint(f); return (u & 0x80000000u) ? ~u : (u | 0x80000000u); }
DI float ord2f(unsigned u) { return __uint_as_float((u & 0x80000000u) ? (u & 0x7fffffffu) : ~u); }
DI unsigned umin_(unsigned a, unsigned b) { return a < b ? a : b; }
DI unsigned umax_(unsigned a, unsigned b) { return a > b ? a : b; }
template <int OFF> DI void sort16_desc(unsigned (&a)[64]) {
#pragma unroll
  for (int lk = 1; lk <= 4; ++lk)
#pragma unroll
    for (int lj = lk - 1; lj >= 0; --lj)
#pragma unroll
      for (int i = 0; i < 16; ++i) {
        const int k = 1 << lk, j = 1 << lj, l = i ^ j;
        if (l > i) {
          const unsigned lo = umin_(a[OFF + i], a[OFF + l]), hi = umax_(a[OFF + i], a[OFF + l]);
          const bool desc = (i & k) == 0;
          a[OFF + i] = desc ? hi : lo; a[OFF + l] = desc ? lo : hi;
        }
      }
}
DI void merge16_desc(unsigned (&a)[16]) {
#pragma unroll
  for (int lj = 3; lj >= 0; --lj)
#pragma unroll
    for (int i = 0; i < 16; ++i) {
      const int j = 1 << lj, l = i ^ j;
      if (l > i) { const unsigned lo = umin_(a[i], a[l]), hi = umax_(a[i], a[l]); a[i] = hi; a[l] = lo; }
    }
}
DI void top16_of_64(unsigned (&a)[64], unsigned (&out)[16]) {
  sort16_desc<0>(a); sort16_desc<16>(a); sort16_desc<32>(a); sort16_desc<48>(a);
  unsigned x[16], y[16];
#pragma unroll
  for (int i = 0; i < 16; ++i) { x[i] = umax_(a[i], a[31 - i]); y[i] = umax_(a[32 + i], a[63 - i]); }
  merge16_desc(x); merge16_desc(y);
#pragma unroll
  for (int i = 0; i < 16; ++i) out[i] = umax_(x[i], y[15 - i]);
  merge16_desc(out);
}
__device__ constexpr int COFF[16] = {0, 16, 24, 29, 33, 36, 38, 40, 42, 43, 44, 45, 46, 47, 48, 49};
DI unsigned umax3(unsigned a, unsigned b, unsigned c) { const unsigned m = a > b ? a : b; return m > c ? m : c; }

DI void unit_peer_route(const P& p, int u, char* smem) {
  const int mt = u >> 3, hd = u & 7;
  const int m0 = mt * 128;
  const int t = threadIdx.x + opaque0(), lane = t & 63, w = t >> 6, r = lane & 31, h = lane >> 5;
  unsigned char* myidx = (unsigned char*)smem + 2 * 128 * LDSK * 2 + t * 32;
  unsigned* mytop = (unsigned*)(smem + 2 * 128 * LDSK * 2 + NTHREADS * 32) + t * 16;
  unsigned top[2][16];
#pragma unroll
  for (int pp = 0; pp < 2; ++pp) {
    f32x16 acc[4];
    gemm_tile(w_Wt_q(p), w_H(p), 1024, hd * 256 + pp * 128, m0, smem, acc);
    f32x16 sc[4] = {zero16(), zero16(), zero16(), zero16()};
    const bf16* skb = w_SK(p) + (size_t)(hd * 2 + pp) * 128 * 128;
#pragma unroll
    for (int i = 0; i < 4; ++i)
#pragma unroll
      for (int s = 0; s < 2; ++s) {
        const bf16x8 bq = pack_step(acc[i], s);
#pragma unroll
        for (int kt = 0; kt < 4; ++kt) {
          const bf16* ap = skb + (size_t)(32 * kt + r) * 128 + 32 * i + 16 * s + 4 * h;
          const bf16x8 a = cat4(*(const bf16x4*)ap, *(const bf16x4*)(ap + 8));
          sc[kt] = MFMA(a, bq, sc[kt]);
        }
      }
    unsigned pk[64];
#pragma unroll
    for (int kt = 0; kt < 4; ++kt)
#pragma unroll
      for (int j = 0; j < 16; ++j) { const int key = 32 * kt + crow(j, h); pk[kt * 16 + j] = (f2ord(sc[kt][j]) & ~127u) | (unsigned)(127 - key); }
    unsigned mine[16];
    top16_of_64(pk, mine);
#pragma unroll
    for (int i = 0; i < 16; ++i) top[pp][i] = (unsigned)__shfl_xor((int)mine[15 - i], 32);
#pragma unroll
    for (int i = 0; i < 16; ++i) top[pp][i] = umax_(top[pp][i], mine[i]);
    merge16_desc(top[pp]);
    if (pp == 0) {
#pragma unroll
      for (int i = 0; i < 4; ++i) *(u32x4*)(mytop + 4 * i) = (u32x4){top[0][4 * i], top[0][4 * i + 1], top[0][4 * i + 2], top[0][4 * i + 3]};
    }
  }
#pragma unroll
  for (int i = 0; i < 4; ++i) { const u32x4 v = *(const u32x4*)(mytop + 4 * i); top[0][4 * i] = v[0]; top[0][4 * i + 1] = v[1]; top[0][4 * i + 2] = v[2]; top[0][4 * i + 3] = v[3]; }
  float v0[16], v1[16];
#pragma unroll
  for (int a = 0; a < 16; ++a) {
    v0[a] = ord2f(top[0][a] & ~127u); v1[a] = ord2f(top[1][a] & ~127u);
    myidx[a] = (unsigned char)(127u - (top[0][a] & 127u)); myidx[16 + a] = (unsigned char)(127u - (top[1][a] & 127u));
  }
  unsigned cand[64];
#pragma unroll
  for (int i = 50; i < 64; ++i) cand[i] = 0u;
#pragma unroll
  for (int a = 0; a < 16; ++a)
#pragma unroll
    for (int bb = 0; bb < 16 / (a + 1); ++bb)
      cand[COFF[a] + bb] = (f2ord(v0[a] + v1[bb]) & ~255u) | (unsigned)(255 - (a * 16 + bb));
  unsigned best[16];
  top16_of_64(cand, best);
  const float smax = ord2f(best[0] & ~255u);
  float e[16], esum = 0.f;
#pragma unroll
  for (int i = 0; i < 16; ++i) { e[i] = __expf(ord2f(best[i] & ~255u) - smax); esum += e[i]; }
  const float einv = 1.f / esum;
  const size_t token = (size_t)m0 + 32 * w + r;
  int* ip = w_IDX(p) + token * 128 + hd * 16 + 8 * h;
  float* gp = w_GATE(p) + token * 128 + hd * 16 + 8 * h;
  const unsigned hmask = 0u - (unsigned)h;
#pragma unroll
  for (int i = 0; i < 8; ++i) {
    const unsigned bsel = best[i] ^ ((best[i] ^ best[8 + i]) & hmask);
    const float esel = __uint_as_float(__float_as_uint(e[i]) ^ ((__float_as_uint(e[i]) ^ __float_as_uint(e[8 + i])) & hmask));
    const unsigned code = 255u - (bsel & 255u);
    const int a = code >> 4, bb = code & 15;
    ip[i] = (int)myidx[a] * 128 + (int)myidx[16 + bb];
    gp[i] = esel * einv;
  }
}

DI float gelu_fast(float v) {
  const float av = fabsf(v), tt = __builtin_amdgcn_rcpf(av * 0.2316418882f + 1.0f);
  float q = tt * 0.5307027145f - 0.7265760135f; q = q * tt + 0.7107068705f; q = q * tt - 0.142248368f; q = q * tt + 0.127414796f; q = q * tt;
  const float e = __builtin_amdgcn_exp2f(v * v * -0.72134752044f);
  const float m = v * (q * e);
  return v < 0.f ? m : v - m;
}
DI float dot2bf(unsigned a, unsigned b, float acc) { return __builtin_amdgcn_fdot2_f32_bf16(__builtin_bit_cast(bf16x2, a), __builtin_bit_cast(bf16x2, b), acc, false); }
DI unsigned pkbf(f32x2 v) { bf16x2 r; r[0] = (bf16)v[0]; r[1] = (bf16)v[1]; return __builtin_bit_cast(unsigned, r); }
DI float dot16(u32x4 u8, u32x4 xlo, u32x4 xhi, float d) {
#pragma unroll
  for (int m = 0; m < 4; ++m) {
    const int wd = (int)u8[m];
    const unsigned p01 = pkbf(__builtin_amdgcn_cvt_pk_f32_fp8(wd, false)), p23 = pkbf(__builtin_amdgcn_cvt_pk_f32_fp8(wd, true));
    const unsigned x01 = m < 2 ? xlo[2 * m] : xhi[2 * m - 4], x23 = m < 2 ? xlo[2 * m + 1] : xhi[2 * m - 3];
    d = dot2bf(p01, x01, d); d = dot2bf(p23, x23, d);
  }
  return d;
}
DI void axpy16(float* o, u32x4 v8, float c) {
#pragma unroll
  for (int m = 0; m < 4; ++m) {
    const int wd = (int)v8[m];
    const f32x2 a = __builtin_amdgcn_cvt_pk_f32_fp8(wd, false), b = __builtin_amdgcn_cvt_pk_f32_fp8(wd, true);
    o[4 * m] += c * a[0]; o[4 * m + 1] += c * a[1]; o[4 * m + 2] += c * b[0]; o[4 * m + 3] += c * b[1];
  }
}
DI float reduce4(const float (&d)[4], int lane) {
  const int h = lane >> 5, b4 = (lane >> 4) & 1;
  float a0 = h ? d[2] : d[0], a1 = h ? d[3] : d[1];
  const float s0 = h ? d[0] : d[2], s1 = h ? d[1] : d[3];
  a0 += __shfl_xor(s0, 32); a1 += __shfl_xor(s1, 32);
  float k = b4 ? a1 : a0;
  const float s = b4 ? a0 : a1;
  k += __shfl_xor(s, 16);
  k += __shfl_xor(k, 8); k += __shfl_xor(k, 4); k += __shfl_xor(k, 2); k += __shfl_xor(k, 1);
  return k;
}
#define LDS_WAIT() asm volatile("s_waitcnt lgkmcnt(0)" ::: "memory")
DI float dpp_add16(float v) {
  v += __int_as_float(__builtin_amdgcn_update_dpp(0, __float_as_int(v), 0x140, 0xf, 0xf, true));
  v += __int_as_float(__builtin_amdgcn_update_dpp(0, __float_as_int(v), 0x141, 0xf, 0xf, true));
  v += __int_as_float(__builtin_amdgcn_update_dpp(0, __float_as_int(v), 0x4e, 0xf, 0xf, true));
  v += __int_as_float(__builtin_amdgcn_update_dpp(0, __float_as_int(v), 0xb1, 0xf, 0xf, true));
  return v;
}
constexpr int PEER_GLDS = 512 + 128 * 16;
constexpr int PEER_WLDS = 4 * PEER_GLDS;
DI void peer_wave4(const P& p, int g, char* wl) {
  const int lane = (threadIdx.x + opaque0()) & 63, q = lane >> 4, j16 = lane & 15;
  unsigned* hist = (unsigned*)(wl + q * PEER_GLDS);
  u32x4* list = (u32x4*)(wl + q * PEER_GLDS + 512);
  const int token = 4 * g + q;
  u32x4 x[8];
  {
    const bf16* hrow = w_H(p) + (size_t)token * DM + 16 * j16;
#pragma unroll
    for (int i = 0; i < 4; ++i) { x[2 * i] = *(const u32x4*)(hrow + 256 * i); x[2 * i + 1] = *(const u32x4*)(hrow + 256 * i + 8); }
  }
  {
    int ids[8]; float gts[8], su[8];
#pragma unroll
    for (int i = 0; i < 8; ++i) { const size_t o = (size_t)token * 128 + j16 + 16 * i; ids[i] = w_IDX(p)[o]; gts[i] = w_GATE(p)[o]; }
#pragma unroll
    for (int i = 0; i < 8; ++i) { su[i] = w_SU(p)[ids[i]]; gts[i] *= w_SV(p)[ids[i]]; }
    LDS_WAIT();
    *(u32x4*)(hist + 8 * j16) = (u32x4){0u, 0u, 0u, 0u}; *(u32x4*)(hist + 8 * j16 + 4) = (u32x4){0u, 0u, 0u, 0u};
    LDS_WAIT();
#pragma unroll
    for (int i = 0; i < 8; ++i) (void)__hip_atomic_fetch_add(&hist[ids[i] >> 7], 1u, __ATOMIC_RELAXED, __HIP_MEMORY_SCOPE_WAVEFRONT);
    LDS_WAIT();
    const u32x4 ca = *(const u32x4*)(hist + 8 * j16), cb = *(const u32x4*)(hist + 8 * j16 + 4);
    const unsigned tot = ca[0] + ca[1] + ca[2] + ca[3] + cb[0] + cb[1] + cb[2] + cb[3];
    unsigned scan = tot;
#pragma unroll
    for (int o = 1; o < 16; o <<= 1) { const unsigned tv = (unsigned)__shfl_up((int)scan, o, 16); if (j16 >= o) scan += tv; }
    unsigned e0 = scan - tot;
    u32x4 pa, pb;
    pa[0] = e0; e0 += ca[0]; pa[1] = e0; e0 += ca[1]; pa[2] = e0; e0 += ca[2]; pa[3] = e0; e0 += ca[3];
    pb[0] = e0; e0 += cb[0]; pb[1] = e0; e0 += cb[1]; pb[2] = e0; e0 += cb[2]; pb[3] = e0;
    LDS_WAIT();
    *(u32x4*)(hist + 8 * j16) = pa; *(u32x4*)(hist + 8 * j16 + 4) = pb;
    LDS_WAIT();
#pragma unroll
    for (int i = 0; i < 8; ++i) {
      const unsigned pos = __hip_atomic_fetch_add(&hist[ids[i] >> 7], 1u, __ATOMIC_RELAXED, __HIP_MEMORY_SCOPE_WAVEFRONT);
      list[pos] = (u32x4){(unsigned)ids[i], __float_as_uint(su[i]), __float_as_uint(gts[i]), 0u};
    }
    LDS_WAIT();
  }
  float acc[64];
#pragma unroll
  for (int i = 0; i < 64; ++i) acc[i] = 0.f;
  const unsigned char* Ub = w_Ub(p) + 16 * j16;
  const unsigned char* Vb = w_Vb(p) + 16 * j16;
  u32x4 u[4], v[4];
  u32x4 en = list[0];
  {
    const size_t ro = (size_t)en[0] * DM;
#pragma unroll
    for (int i = 0; i < 4; ++i) u[i] = *(const u32x4*)(Ub + ro + 256 * i);
#pragma unroll
    for (int i = 0; i < 4; ++i) v[i] = *(const u32x4*)(Vb + ro + 256 * i);
  }
#pragma unroll 1
  for (int k = 0; k < 128; ++k) {
    const float su = __uint_as_float(en[1]), gsv = __uint_as_float(en[2]);
    en = list[k + 1 < 128 ? k + 1 : 127];
    const size_t ro = (size_t)en[0] * DM;
    float d0 = 0.f, d1 = 0.f;
    d0 = dot16(u[0], x[0], x[1], d0); d1 = dot16(u[1], x[2], x[3], d1); d0 = dot16(u[2], x[4], x[5], d0); d1 = dot16(u[3], x[6], x[7], d1);
#pragma unroll
    for (int i = 0; i < 4; ++i) u[i] = *(const u32x4*)(Ub + ro + 256 * i);
    const float c = gsv * gelu_fast(su * dpp_add16(d0 + d1));
#pragma unroll
    for (int i = 0; i < 4; ++i) axpy16(acc + 16 * i, v[i], c);
#pragma unroll
    for (int i = 0; i < 4; ++i) v[i] = *(const u32x4*)(Vb + ro + 256 * i);
  }
  const float* x1 = w_X1(p) + (size_t)token * DM + 16 * j16;
  const float* g2 = w_MOD(p) + (size_t)cond_row(token) * 6144 + 5120 + 16 * j16;
  float* y = p.out + O_YP + (size_t)token * DM + 16 * j16;
#pragma unroll
  for (int i = 0; i < 4; ++i)
#pragma unroll
    for (int mm = 0; mm < 4; ++mm) {
      const int c0 = 256 * i + 4 * mm;
      const f32x4 xv = *(const f32x4*)(x1 + c0), gv = *(const f32x4*)(g2 + c0);
      f32x4 yv;
#pragma unroll
      for (int j = 0; j < 4; ++j) yv[j] = xv[j] + gv[j] * acc[16 * i + 4 * mm + j];
      *(f32x4*)(y + c0) = yv;
    }
}
DI void peer_token_block(const P& p, int token, char* smem) {
  const int t = threadIdx.x + opaque0(), lane = t & 63, w = t >> 6;
  float* red = (float*)smem;
  const bf16* hrow = w_H(p) + (size_t)token * DM + 16 * lane;
  const u32x4 xlo = *(const u32x4*)hrow, xhi = *(const u32x4*)(hrow + 8);
  const int myid = w_IDX(p)[(size_t)token * 128 + 32 * w + (lane & 31)];
  const float mysu = w_SU(p)[myid];
  const float mygs = w_GATE(p)[(size_t)token * 128 + 32 * w + (lane & 31)] * w_SV(p)[myid];
  float o[16];
#pragma unroll
  for (int i = 0; i < 16; ++i) o[i] = 0.f;
#pragma unroll 1
  for (int e0 = 0; e0 < 32; e0 += 4) {
    u32x4 u8[4], v8[4];
#pragma unroll
    for (int qq = 0; qq < 4; ++qq) {
      const size_t ro = (size_t)__builtin_amdgcn_readlane(myid, e0 + qq) * DM + 16 * lane;
      u8[qq] = *(const u32x4*)(w_Ub(p) + ro); v8[qq] = *(const u32x4*)(w_Vb(p) + ro);
    }
    float d[4];
#pragma unroll
    for (int qq = 0; qq < 4; ++qq) d[qq] = dot16(u8[qq], xlo, xhi, 0.f);
    const float kv = reduce4(d, lane);
#pragma unroll
    for (int qq = 0; qq < 4; ++qq) {
      const float a = __int_as_float(__builtin_amdgcn_readlane(__float_as_int(kv), 16 * qq)) * __int_as_float(__builtin_amdgcn_readlane(__float_as_int(mysu), e0 + qq));
      const float c = __int_as_float(__builtin_amdgcn_readlane(__float_as_int(mygs), e0 + qq)) * gelu_fast(a);
      axpy16(o, v8[qq], c);
    }
  }
  __syncthreads();
#pragma unroll
  for (int i = 0; i < 16; ++i) red[w * 1024 + 16 * lane + i] = o[i];
  __syncthreads();
  if (w == 0) {
    const float* x1 = w_X1(p) + (size_t)token * DM + 16 * lane;
    const float* g2 = w_MOD(p) + (size_t)cond_row(token) * 6144 + 5120 + 16 * lane;
    float* y = p.out + O_YP + (size_t)token * DM + 16 * lane;
#pragma unroll
    for (int mm = 0; mm < 4; ++mm) {
      const f32x4 xv = *(const f32x4*)(x1 + 4 * mm), gv = *(const f32x4*)(g2 + 4 * mm);
      f32x4 yv;
#pragma unroll
      for (int j = 0; j < 4; ++j) { const int c = 16 * lane + 4 * mm + j; yv[j] = xv[j] + gv[j] * (red[c] + red[1024 + c] + red[2048 + c] + red[3072 + c]); }
      *(f32x4*)(y + 4 * mm) = yv;
    }
  }
}

constexpr int NPHASE = 8;
template <int PH> DI void run_phase(const P& p, char* smem) {
  const int G = gridDim.x, bid = blockIdx.x, w = __builtin_amdgcn_readfirstlane(threadIdx.x >> 6);
  if constexpr (PH == 0) { for (int u = bid; u < U0_TOTAL; u += G) phase0_unit(p, u, smem); }
  if constexpr (PH == 1) { for (int tk = bid * 4 + w; tk < NTOK; tk += G * 4) norm_row(p, tk, 0); }
  if constexpr (PH == 2) { for (int u = bid; u < 129 * 30; u += G) unit_gemm1(p, u, smem); }
  if constexpr (PH == 3) { for (int u = bid; u < 2048; u += G) unit_attn_prompt(p, u, smem);
                           for (int u = bid; u < 256; u += G) unit_attn_sample(p, u, smem); }
  if constexpr (PH == 4) { for (int u = bid; u < 129 * 8; u += G) unit_gemm2(p, u, smem); }
  if constexpr (PH == 5) { for (int tk = bid * 4 + w; tk < NTOK; tk += G * 4) norm_row(p, tk, 1); }
  if constexpr (PH == 6) { for (int u = bid; u < 129 * 8; u += G) unit_peer_route(p, u, smem); }
  if constexpr (PH == 7) {
    for (int g = bid * 4 + w; g < NPR / 4; g += G * 4) peer_wave4(p, g, smem + w * PEER_WLDS);
    for (int s = bid; s < NS; s += G) peer_token_block(p, NPR + s, smem + 4 * PEER_WLDS);
  }
}
#if ONE_LAUNCH
__global__ void __launch_bounds__(NTHREADS, 2) mega(P p) {
  __shared__ __attribute__((aligned(16))) char smem[SMEM_BYTES];
  __shared__ uint4 xbw;
  if (threadIdx.x == 0) xbw = make_uint4(0u, 0u, 0u, 0u);
  __syncthreads();
  const unsigned xcc = xb_xcc_id();
  if (threadIdx.x == 0) (void)xb_add(&w_bar(p)[XB_XCNT(xcc)], 1u);
  volatile unsigned* st = (volatile unsigned*)&xbw;
#ifndef REPEAT_MASK
#define REPEAT_MASK 0
#endif
#define RUN_PH(k) do { run_phase<k>(p, smem); if ((REPEAT_MASK >> k) & 1) { xcd_barrier(w_bar(p), xcc, st); run_phase<k>(p, smem); } } while (0)
  RUN_PH(0); xcd_barrier(w_bar(p), xcc, st);
  RUN_PH(1); xcd_barrier(w_bar(p), xcc, st);
  RUN_PH(2); xcd_barrier(w_bar(p), xcc, st);
  RUN_PH(3); xcd_barrier(w_bar(p), xcc, st);
  RUN_PH(4); xcd_barrier(w_bar(p), xcc, st);
  RUN_PH(5); xcd_barrier(w_bar(p), xcc, st);
  RUN_PH(6); xcd_barrier(w_bar(p), xcc, st);
  RUN_PH(7);
}
#else
template <int PH> __global__ void __launch_bounds__(NTHREADS, 2) mega(P p) {
  __shared__ __attribute__((aligned(16))) char smem[SMEM_BYTES];
  run_phase<PH>(p, smem);
}
#endif


extern "C" void kernel_launch(void* const* d_in, const int* in_sizes, int n_in, void* d_out, int out_size, void* d_ws, size_t ws_size, hipStream_t stream) {
  P p{};
  const float* const* in = (const float* const*)d_in;
  p.x_prompt = in[0]; p.x_sample = in[1]; p.cache_k = in[2]; p.cache_v = in[3]; p.state_pool = in[4]; p.c_prompt = in[5]; p.c_sample = in[6];
  p.rel_table = in[7]; p.ada_w = in[8]; p.ada_b = in[9]; p.norm1_g = in[10]; p.w_in = in[11]; p.q_norm_g = in[12]; p.k_norm_g = in[13]; p.sinks = in[14];
  p.pool_w = in[15]; p.pool_scale = in[16]; p.w_out = in[17]; p.norm2_g = in[18]; p.w_query = in[19]; p.sub_keys = in[20]; p.peer_u = in[21]; p.peer_v = in[22];
  p.out = (float*)d_out;
  p.ws = (char*)d_ws;
  if (WS_NEED > ws_size) { fprintf(stderr, "workspace too small: need %zu have %zu\n", (size_t)WS_NEED, ws_size); return; }

  static int grid_blocks = 0;
  if (!grid_blocks) {
    int dev = 0, cus = 0, per_cu = 0;
    (void)hipGetDevice(&dev);
    (void)hipDeviceGetAttribute(&cus, hipDeviceAttributeMultiprocessorCount, dev);
#if ONE_LAUNCH
    (void)hipOccupancyMaxActiveBlocksPerMultiprocessor(&per_cu, mega, NTHREADS, 0);
#else
    per_cu = 2;
#endif
    if (per_cu > 2) per_cu = 2;
    if (per_cu < 1) per_cu = 1;
    if (cus < 1) cus = 256;
    grid_blocks = cus * per_cu;
  }
#if ONE_LAUNCH
  (void)hipMemsetAsync(p.ws + OFF_BAR, 0, XCD_BAR_WORDS * 4, stream);
  hipLaunchKernelGGL(mega, dim3(grid_blocks), dim3(NTHREADS), 0, stream, p);
#else
  hipLaunchKernelGGL(mega<0>, dim3(grid_blocks), dim3(NTHREADS), 0, stream, p);
  hipLaunchKernelGGL(mega<1>, dim3(grid_blocks), dim3(NTHREADS), 0, stream, p);
  hipLaunchKernelGGL(mega<2>, dim3(grid_blocks), dim3(NTHREADS), 0, stream, p);
  hipLaunchKernelGGL(mega<3>, dim3(grid_blocks), dim3(NTHREADS), 0, stream, p);
  hipLaunchKernelGGL(mega<4>, dim3(grid_blocks), dim3(NTHREADS), 0, stream, p);
  hipLaunchKernelGGL(mega<5>, dim3(grid_blocks), dim3(NTHREADS), 0, stream, p);
  hipLaunchKernelGGL(mega<6>, dim3(grid_blocks), dim3(NTHREADS), 0, stream, p);
  hipLaunchKernelGGL(mega<7>, dim3(grid_blocks), dim3(NTHREADS), 0, stream, p);
#endif

}
```

```cpp
#include <hip/hip_runtime.h>
#include <stdint.h>
#include <stdio.h>

#ifndef ONE_LAUNCH
#define ONE_LAUNCH 1
#endif

typedef __bf16 bf16;
typedef __bf16 bf16x2 __attribute__((ext_vector_type(2)));
typedef __bf16 bf16x4 __attribute__((ext_vector_type(4)));
typedef __bf16 bf16x8 __attribute__((ext_vector_type(8)));
typedef float f32x2 __attribute__((ext_vector_type(2)));
typedef float f32x4 __attribute__((ext_vector_type(4)));
typedef float f32x16 __attribute__((ext_vector_type(16)));
typedef unsigned u32x2 __attribute__((ext_vector_type(2)));
typedef unsigned u32x4 __attribute__((ext_vector_type(4)));

#define DI __device__ __forceinline__
#define MFMA(a, b, c) __builtin_amdgcn_mfma_f32_32x32x16_bf16((a), (b), (c), 0, 0, 0)

constexpr int DM = 1024, NB = 8, SEQ = 2048, NS = 128, NPR = NB * SEQ, NTOK = NPR + NS;
constexpr int INW = 3840, NMOD = NB + NS;
constexpr int C_K = 1024, C_V = 1152, C_PIN = 1280, C_GA = 1792, C_GB = 2816;
constexpr int NEXP = 16384;
constexpr float EPS = 1e-6f;
constexpr size_t O_YP = 0, O_KWP = 16908288, O_VWP = 17039360, O_PP = 17170432, O_KWS = 17231872, O_VWS = 19329024, O_PS = 21426176;

constexpr int SMEM_BYTES = 77824;
constexpr int NTHREADS = 256;

struct P {
  const float *x_prompt, *x_sample, *cache_k, *cache_v, *state_pool, *c_prompt, *c_sample, *rel_table, *ada_w, *ada_b, *norm1_g, *w_in,
      *q_norm_g, *k_norm_g, *sinks, *pool_w, *pool_scale, *w_out, *norm2_g, *w_query, *sub_keys, *peer_u, *peer_v;
  float* out;
  char* ws;
};
constexpr size_t al256(size_t x) { return (x + 255) & ~(size_t)255; }
constexpr size_t OFF_BAR = 0;
constexpr size_t OFF_WTIN = OFF_BAR + al256(4096 * 4);
constexpr size_t OFF_WTOUT = OFF_WTIN + al256((size_t)INW * 1024 * 2);
constexpr size_t OFF_WTQ = OFF_WTOUT + al256((size_t)1024 * 1024 * 2);
constexpr size_t OFF_SK = OFF_WTQ + al256((size_t)2048 * 1024 * 2);
constexpr size_t OFF_PWT = OFF_SK + al256((size_t)16 * 128 * 128 * 2);
constexpr size_t OFF_UB = OFF_PWT + al256((size_t)4 * 256 * 128 * 2);
constexpr size_t OFF_VB = OFF_UB + al256((size_t)NEXP * DM);
constexpr size_t OFF_SU = OFF_VB + al256((size_t)NEXP * DM);
constexpr size_t OFF_SV = OFF_SU + al256((size_t)NEXP * 4);
constexpr size_t OFF_H8 = OFF_SV + al256((size_t)NEXP * 4);
constexpr size_t OFF_HS = OFF_H8 + al256((size_t)NTOK * DM);
constexpr size_t OFF_MOD = OFF_HS + al256((size_t)NTOK * 4);
constexpr size_t OFF_BIAS = OFF_MOD + al256((size_t)NMOD * 6144 * 4);
constexpr size_t OFF_VT = OFF_BIAS + al256(16 * 128 * 4);
constexpr size_t OFF_H = OFF_VT + al256((size_t)NB * 128 * SEQ * 2);
constexpr size_t OFF_MIXED = OFF_H;
constexpr size_t OFF_PROJ = OFF_H + al256((size_t)NTOK * DM * 2);
constexpr size_t OFF_X1 = OFF_PROJ;
constexpr size_t OFF_IDX = OFF_X1 + (size_t)NTOK * DM * 4;
constexpr size_t OFF_GATE = OFF_IDX + (size_t)NTOK * 128 * 4;
constexpr size_t WS_NEED = OFF_PROJ + al256((size_t)NTOK * INW * 2);
static_assert(OFF_GATE + (size_t)NTOK * 128 * 4 <= WS_NEED, "overlay fits");
static_assert(WS_NEED <= (size_t)256 * 1024 * 1024, "workspace budget");
#define WS_PTR(T, name, OFF) __device__ __forceinline__ T* name(const P& p) { return (T*)(p.ws + (OFF)); }
WS_PTR(unsigned, w_bar, OFF_BAR) WS_PTR(bf16, w_Wt_in, OFF_WTIN) WS_PTR(bf16, w_Wt_out, OFF_WTOUT) WS_PTR(bf16, w_Wt_q, OFF_WTQ) WS_PTR(bf16, w_SK, OFF_SK)
WS_PTR(bf16, w_PWt, OFF_PWT) WS_PTR(unsigned char, w_Ub, OFF_UB) WS_PTR(unsigned char, w_Vb, OFF_VB) WS_PTR(float, w_SU, OFF_SU) WS_PTR(float, w_SV, OFF_SV) WS_PTR(unsigned char, w_H8, OFF_H8) WS_PTR(float, w_HS, OFF_HS) WS_PTR(float, w_MOD, OFF_MOD) WS_PTR(float, w_BIAS, OFF_BIAS)
WS_PTR(bf16, w_VT, OFF_VT) WS_PTR(bf16, w_H, OFF_H) WS_PTR(bf16, w_MIXED, OFF_MIXED) WS_PTR(bf16, w_PROJ, OFF_PROJ) WS_PTR(float, w_X1, OFF_X1)
WS_PTR(int, w_IDX, OFF_IDX) WS_PTR(float, w_GATE, OFF_GATE)

DI int cond_row(int token) { return token < NPR ? (token >> 11) : (NB + token - NPR); }
DI int crow(int reg, int h) { return (reg & 3) + 8 * (reg >> 2) + 4 * h; }
DI const float* xrow(const P& p, int token) { return token < NPR ? p.x_prompt + (size_t)token * DM : p.x_sample + (size_t)(token - NPR) * DM; }

#define LDS_WAIT() asm volatile("s_waitcnt lgkmcnt(0)" ::: "memory")
DI int opaque0() { int z = 0; asm volatile("" : "+v"(z)); return z; }
DI float bf2f(bf16 v) { return (float)v; }
DI f32x16 zero16() { f32x16 z; for (int i = 0; i < 16; ++i) z[i] = 0.f; return z; }
DI bf16x8 pack_step(const f32x16& x, int s) { bf16x8 v; for (int j = 0; j < 8; ++j) v[j] = (bf16)x[8 * s + j]; return v; }
DI bf16x8 cat4(bf16x4 lo, bf16x4 hi) { return __builtin_shufflevector(lo, hi, 0, 1, 2, 3, 4, 5, 6, 7); }
DI float wave_sum(float v) { for (int o = 32; o >= 1; o >>= 1) v += __shfl_xor(v, o); return v; }

#define XB_TMO 128
#define XB_XCNT(j) (256 + 64 * (j))
#define XB_XSUB(j) (1280 + 64 * (j))
#define XB_XGEN(j) (2304 + 64 * (j))
#define XB_TOP 3328
#define XB_TOPGEN 3392
#define XCD_BAR_WORDS 3456
#define XB_SPIN_CAP (1u << 22)
DI unsigned xb_ld(unsigned* p) { return __hip_atomic_load(p, __ATOMIC_RELAXED, __HIP_MEMORY_SCOPE_AGENT); }
DI unsigned xb_add(unsigned* p, unsigned v) { return __hip_atomic_fetch_add(p, v, __ATOMIC_RELAXED, __HIP_MEMORY_SCOPE_AGENT); }
DI unsigned xb_xcc_id() { return (unsigned)__builtin_amdgcn_s_getreg((3 << 11) | 20) & 0xFu; }
#define XB_SPIN(cond, bar) do { unsigned _sp = 0; while (cond) { __builtin_amdgcn_s_sleep(1); \
    if ((++_sp & 255u) == 0u) { if (xb_ld(&(bar)[XB_TMO])) break; if (_sp > XB_SPIN_CAP) { atomicAdd(&(bar)[XB_TMO], 1u); break; } } } } while (0)

DI void xcd_barrier_complete(unsigned* bar, unsigned x, unsigned& nloc, unsigned& nx) {
  const unsigned G = gridDim.x;
  unsigned sum, cnt, mine, sp = 0u;
  for (;;) {
    sum = 0u; cnt = 0u; mine = 0u;
#pragma unroll
    for (unsigned j = 0; j < 16; ++j) { const unsigned c = xb_ld(&bar[XB_XCNT(j)]); sum += c; cnt += (c > 0u) ? 1u : 0u; mine = (j == x) ? c : mine; }
    if (sum == G) break;
    __builtin_amdgcn_s_sleep(1);
    if ((++sp & 255u) == 0u) { if (xb_ld(&bar[XB_TMO])) break; if (sp > XB_SPIN_CAP) { atomicAdd(&bar[XB_TMO], 1u); break; } }
  }
  nloc = mine > 0u ? mine : 1u; nx = cnt > 0u ? cnt : 1u;
}
DI void xcd_barrier(unsigned* bar, unsigned x, volatile unsigned* st) {
  asm volatile("s_waitcnt vmcnt(0)" ::: "memory");
  __syncthreads();
  if (threadIdx.x == 0) {
    __builtin_amdgcn_s_waitcnt(0);
    unsigned nloc = st[0], nx = st[1];
    if (nloc == 0u) { xcd_barrier_complete(bar, x, nloc, nx); st[0] = nloc; st[1] = nx; }
    const unsigned old = xb_add(&bar[XB_XSUB(x)], 1u);
    const unsigned gen = old / nloc;
    if (old + 1u == (gen + 1u) * nloc) {
      __builtin_amdgcn_fence(__ATOMIC_RELEASE, "agent");
      asm volatile("s_waitcnt vmcnt(0)" ::: "memory");
      const unsigned og = xb_add(&bar[XB_TOP], 1u);
      const unsigned tg = og / nx;
      if (og + 1u == (tg + 1u) * nx) xb_add(&bar[XB_TOPGEN], 1u);
      else XB_SPIN(xb_ld(&bar[XB_TOPGEN]) == tg, bar);
      __builtin_amdgcn_fence(__ATOMIC_ACQUIRE, "agent");
      xb_add(&bar[XB_XGEN(x)], 1u);
      asm volatile("s_waitcnt vmcnt(0)" ::: "memory");
    } else {
      XB_SPIN(xb_ld(&bar[XB_XGEN(x)]) == gen, bar);
      __builtin_amdgcn_fence(__ATOMIC_ACQUIRE, "agent");
      asm volatile("s_waitcnt vmcnt(0)" ::: "memory");
    }
  }
  __syncthreads();
}

constexpr int U0_MOD = 192;
constexpr int U0_TIN = (1024 / 64) * (INW / 64);
constexpr int U0_TOUT = 16 * 16;
constexpr int U0_TQ = 16 * 32;
constexpr int U0_TPW = 4 * 2 * 4;
constexpr int U0_CSK = 32;
constexpr int U0_CU = 2048, U0_CV = 2048;
constexpr int U0_KW = 128, U0_VW = 128, U0_PW = 128, U0_BIAS = 1;
constexpr int U0_E0 = U0_MOD, U0_E1 = U0_E0 + U0_TIN, U0_E2 = U0_E1 + U0_TOUT, U0_E3 = U0_E2 + U0_TQ, U0_E4 = U0_E3 + U0_TPW, U0_E5 = U0_E4 + U0_CSK,
              U0_E6 = U0_E5 + U0_CU, U0_E7 = U0_E6 + U0_CV, U0_E8 = U0_E7 + U0_KW, U0_E9 = U0_E8 + U0_VW, U0_E10 = U0_E9 + U0_PW, U0_TOTAL = U0_E10 + U0_BIAS;

DI float silu_f(float x) { return x / (1.f + __expf(-x)); }

DI void unit_mod(const P& p, int u, char* smem) {
  const int t = threadIdx.x + opaque0(), lane = t & 63, w = t >> 6, r = lane & 31, h = lane >> 5;
  const int f0 = u * 32;
  f32x16 acc[5];
#pragma unroll
  for (int i = 0; i < 5; ++i) acc[i] = zero16();
#pragma unroll 1
  for (int ks = 0; ks < 16; ++ks) {
    const int k0 = w * 256 + ks * 16 + 8 * h;
    bf16x8 bfr;
#pragma unroll
    for (int j = 0; j < 8; ++j) bfr[j] = (bf16)p.ada_w[(size_t)(k0 + j) * 6144 + f0 + r];
#pragma unroll
    for (int i = 0; i < 5; ++i) {
      const int m = 32 * i + r;
      bf16x8 afr;
      if (m < NMOD) {
        const float* c = (m < NB ? p.c_prompt + (size_t)m * DM : p.c_sample + (size_t)(m - NB) * DM) + k0;
        const f32x4 c0 = *(const f32x4*)c, c1 = *(const f32x4*)(c + 4);
        afr[0] = (bf16)silu_f(c0[0]); afr[1] = (bf16)silu_f(c0[1]); afr[2] = (bf16)silu_f(c0[2]); afr[3] = (bf16)silu_f(c0[3]);
        afr[4] = (bf16)silu_f(c1[0]); afr[5] = (bf16)silu_f(c1[1]); afr[6] = (bf16)silu_f(c1[2]); afr[7] = (bf16)silu_f(c1[3]);
      } else {
#pragma unroll
        for (int j = 0; j < 8; ++j) afr[j] = (bf16)0.f;
      }
      acc[i] = MFMA(afr, bfr, acc[i]);
    }
  }
  float* red = (float*)smem;
  __syncthreads();
  if (w > 0) {
#pragma unroll
    for (int i = 0; i < 5; ++i)
#pragma unroll
      for (int j = 0; j < 16; ++j) red[((w - 1) * 80 + i * 16 + j) * 64 + lane] = acc[i][j];
  }
  __syncthreads();
  if (w == 0) {
    const float bias = p.ada_b[f0 + r];
#pragma unroll
    for (int i = 0; i < 5; ++i)
#pragma unroll
      for (int j = 0; j < 16; ++j) {
        const int m = 32 * i + crow(j, h);
        const float v = acc[i][j] + red[(0 * 80 + i * 16 + j) * 64 + lane] + red[(1 * 80 + i * 16 + j) * 64 + lane] + red[(2 * 80 + i * 16 + j) * 64 + lane] + bias;
        if (m < NMOD) w_MOD(p)[(size_t)m * 6144 + f0 + r] = v;
      }
  }
}

DI void unit_transpose(const float* __restrict__ src, bf16* __restrict__ dst, int R, int C, int tr, int tc, char* smem) {
  float* tile = (float*)smem;
  const int t = threadIdx.x + opaque0();
  __syncthreads();
#pragma unroll
  for (int i = 0; i < 4; ++i) {
    const int rr = (t >> 4) + 16 * i, cc = (t & 15) * 4;
    const f32x4 v = *(const f32x4*)(src + (size_t)(tr * 64 + rr) * C + tc * 64 + cc);
    tile[rr * 65 + cc] = v[0]; tile[rr * 65 + cc + 1] = v[1]; tile[rr * 65 + cc + 2] = v[2]; tile[rr * 65 + cc + 3] = v[3];
  }
  __syncthreads();
#pragma unroll
  for (int i = 0; i < 2; ++i) {
    const int orow = (t >> 3) + 32 * i, seg = (t & 7) * 8;
    bf16x8 v;
#pragma unroll
    for (int j = 0; j < 8; ++j) v[j] = (bf16)tile[(seg + j) * 65 + orow];
    *(bf16x8*)(dst + (size_t)(tc * 64 + orow) * R + tr * 64 + seg) = v;
  }
}
DI void unit_convert(const float* __restrict__ src, bf16* __restrict__ dst, int u) {
  const size_t base = (size_t)u * 8192 + (threadIdx.x + opaque0()) * 8;
#pragma unroll
  for (int i = 0; i < 4; ++i) {
    const size_t o = base + (size_t)i * 2048;
    const f32x4 a = *(const f32x4*)(src + o), b = *(const f32x4*)(src + o + 4);
    bf16x8 v; v[0] = (bf16)a[0]; v[1] = (bf16)a[1]; v[2] = (bf16)a[2]; v[3] = (bf16)a[3]; v[4] = (bf16)b[0]; v[5] = (bf16)b[1]; v[6] = (bf16)b[2]; v[7] = (bf16)b[3];
    *(bf16x8*)(dst + o) = v;
  }
}
DI unsigned pack_i8(float a, float b, float c, float d) {
  const int ia = max(-127, min(127, __float2int_rn(a))), ib = max(-127, min(127, __float2int_rn(b))), ic = max(-127, min(127, __float2int_rn(c))), id = max(-127, min(127, __float2int_rn(d)));
  return (unsigned)(ia & 255) | ((unsigned)(ib & 255) << 8) | ((unsigned)(ic & 255) << 16) | ((unsigned)(id & 255) << 24);
}
template <bool I8>
DI void unit_quant_rows(const float* __restrict__ src, unsigned char* __restrict__ dst, float* __restrict__ scale, int u) {
  const int t = threadIdx.x + opaque0(), lane = t & 63, w = t >> 6;
#pragma unroll
  for (int rr = 0; rr < 2; ++rr) {
    const size_t row = (size_t)u * 8 + 2 * w + rr;
    const float* s = src + row * DM + 16 * lane;
    f32x4 v[4];
    float amax = 0.f;
#pragma unroll
    for (int i = 0; i < 4; ++i) { v[i] = *(const f32x4*)(s + 4 * i); amax = fmaxf(amax, fmaxf(fmaxf(fabsf(v[i][0]), fabsf(v[i][1])), fmaxf(fabsf(v[i][2]), fabsf(v[i][3])))); }
#pragma unroll
    for (int o = 32; o >= 1; o >>= 1) amax = fmaxf(amax, __shfl_xor(amax, o));
    const float sc = amax > 0.f ? amax * (I8 ? 1.f / 127.f : 1.f / 440.f) : 1.f, inv = 1.f / sc;
    u32x4 q;
#pragma unroll
    for (int i = 0; i < 4; ++i) {
      if (I8) {
        q[i] = pack_i8(v[i][0] * inv, v[i][1] * inv, v[i][2] * inv, v[i][3] * inv);
      } else {
        int wd = 0;
        wd = __builtin_amdgcn_cvt_pk_fp8_f32(v[i][0] * inv, v[i][1] * inv, wd, false);
        wd = __builtin_amdgcn_cvt_pk_fp8_f32(v[i][2] * inv, v[i][3] * inv, wd, true);
        q[i] = (unsigned)wd;
      }
    }
    *(u32x4*)(dst + row * DM + 16 * lane) = q;
    if (lane == 0) scale[row] = sc;
  }
}
DI void unit_copy_f4(const float* __restrict__ src, float* __restrict__ dst, int n4) {
  for (int i = threadIdx.x + opaque0(); i < n4; i += NTHREADS) ((f32x4*)dst)[i] = ((const f32x4*)src)[i];
}

DI void phase0_unit(const P& p, int u, char* smem) {
  if (u < U0_E0) { unit_mod(p, u, smem); }
  else if (u < U0_E1) { const int v = u - U0_E0; unit_transpose(p.w_in, w_Wt_in(p), 1024, INW, v / 60, v % 60, smem); }
  else if (u < U0_E2) { const int v = u - U0_E1; unit_transpose(p.w_out, w_Wt_out(p), 1024, 1024, v / 16, v % 16, smem); }
  else if (u < U0_E3) { const int v = u - U0_E2; unit_transpose(p.w_query, w_Wt_q(p), 1024, 2048, v / 32, v % 32, smem); }
  else if (u < U0_E4) { const int v = u - U0_E3, g = v >> 3, tt = v & 7; unit_transpose(p.pool_w + (size_t)g * 128 * 256, w_PWt(p) + (size_t)g * 256 * 128, 128, 256, tt >> 2, tt & 3, smem); }
  else if (u < U0_E5) { unit_convert(p.sub_keys, w_SK(p), u - U0_E4); }
  else if (u < U0_E6) { unit_quant_rows<true>(p.peer_u, w_Ub(p), w_SU(p), u - U0_E5); }
  else if (u < U0_E7) { unit_quant_rows<false>(p.peer_v, w_Vb(p), w_SV(p), u - U0_E6); }
  else if (u < U0_E8) { const int b = u - U0_E7; unit_copy_f4(p.cache_k + ((size_t)b * 128 + 1) * 128, p.out + O_KWS + (size_t)b * 128 * 128, 127 * 128 / 4); }
  else if (u < U0_E9) { const int b = u - U0_E8; unit_copy_f4(p.cache_v + ((size_t)b * 128 + 1) * 128, p.out + O_VWS + (size_t)b * 128 * 128, 127 * 128 / 4); }
  else if (u < U0_E10) { const int b = u - U0_E9; unit_copy_f4(p.state_pool + ((size_t)b * 15 + 1) * 512, p.out + O_PS + (size_t)b * 15 * 512, 14 * 512 / 4); }
  else {
    for (int i = threadIdx.x + opaque0(); i < 16 * 128; i += NTHREADS) {
      const int head = i >> 7, d = i & 127;
      int bk = d;
      if (d >= 16) { bk = 16 + (int)(logf((float)d / 16.f) / logf(8.f) * 16.f); bk = bk > 31 ? 31 : bk; }
      w_BIAS(p)[i] = p.rel_table[bk * 16 + head];
    }
  }
}

DI void norm_row(const P& p, int token, int which) {
  const int lane = (threadIdx.x + opaque0()) & 63;
  const float* src = which == 0 ? xrow(p, token) : w_X1(p) + (size_t)token * DM;
  const float* g = which == 0 ? p.norm1_g : p.norm2_g;
  const float* mod = w_MOD(p) + (size_t)cond_row(token) * 6144 + (which == 0 ? 0 : 3072);
  f32x4 v[4];
  float ss = 0.f;
#pragma unroll
  for (int i = 0; i < 4; ++i) { v[i] = *(const f32x4*)(src + 4 * lane + 256 * i); ss += v[i][0] * v[i][0] + v[i][1] * v[i][1] + v[i][2] * v[i][2] + v[i][3] * v[i][3]; }
  ss = wave_sum(ss);
  const float rstd = rsqrtf(ss * (1.f / DM) + EPS);
#pragma unroll
  for (int i = 0; i < 4; ++i) {
    const int c = 4 * lane + 256 * i;
    const f32x4 gg = *(const f32x4*)(g + c), sh = *(const f32x4*)(mod + c), sc = *(const f32x4*)(mod + 1024 + c);
    bf16x4 o;
#pragma unroll
    for (int j = 0; j < 4; ++j) { v[i][j] = (v[i][j] * rstd * gg[j]) * (1.f + sc[j]) + sh[j]; o[j] = (bf16)v[i][j]; }
    *(bf16x4*)(w_H(p) + (size_t)token * DM + c) = o;
  }
  if (which == 1) {
    float amax = 0.f;
#pragma unroll
    for (int i = 0; i < 4; ++i) amax = fmaxf(amax, fmaxf(fmaxf(fabsf(v[i][0]), fabsf(v[i][1])), fmaxf(fabsf(v[i][2]), fabsf(v[i][3]))));
#pragma unroll
    for (int o = 32; o >= 1; o >>= 1) amax = fmaxf(amax, __shfl_xor(amax, o));
    const float qs = amax > 0.f ? amax * (1.f / 127.f) : 1.f, inv = 1.f / qs;
#pragma unroll
    for (int i = 0; i < 4; ++i) *(unsigned*)(w_H8(p) + (size_t)token * DM + 4 * lane + 256 * i) = pack_i8(v[i][0] * inv, v[i][1] * inv, v[i][2] * inv, v[i][3] * inv);
    if (lane == 0) w_HS(p)[token] = qs;
  }
}

constexpr int LDSK = 72;
constexpr int GT = 128 * 64 * 2;
constexpr int GBUF = 2 * GT;
typedef __attribute__((address_space(3))) unsigned lds_u32;
typedef const __attribute__((address_space(1))) unsigned glb_u32;
DI void glds16(const void* g, char* l) { __builtin_amdgcn_global_load_lds((glb_u32*)g, (lds_u32*)l, 16, 0, 0); }
DI void gemm_tile(const bf16* __restrict__ Wt, const bf16* __restrict__ X, int K, int n0, int m0, char* smem, f32x16 (&acc)[4]) {
  const int t = threadIdx.x + opaque0(), lane = t & 63, r = lane & 31, h = lane >> 5;
  const int w = __builtin_amdgcn_readfirstlane(t >> 6);
#pragma unroll
  for (int i = 0; i < 4; ++i) acc[i] = zero16();
  const int swz = (lane & 7) ^ ((4 * w + (lane >> 4)) & 7);
  const bf16* ga = Wt + (size_t)(n0 + 8 * w + (lane >> 3)) * K + swz * 8;
  const bf16* gb = X + (size_t)(m0 + 8 * w + (lane >> 3)) * K + swz * 8;
  const int sw = (r >> 1) & 7;
  const int KT = K >> 6;
  __syncthreads();
#pragma unroll
  for (int q = 0; q < 4; ++q) { glds16(ga + (size_t)(32 * q) * K, smem + 1024 * (w + 4 * q)); glds16(gb + (size_t)(32 * q) * K, smem + GT + 1024 * (w + 4 * q)); }
  asm volatile("s_waitcnt vmcnt(0)" ::: "memory");
  __syncthreads();
  for (int kt = 0; kt < KT; ++kt) {
    const char* As = smem + (kt & 1) * GBUF;
    const char* Bs = As + GT;
    if (kt + 1 < KT) {
      char* An = smem + ((kt + 1) & 1) * GBUF;
      const int k0 = (kt + 1) * 64;
#pragma unroll
      for (int q = 0; q < 4; ++q) { glds16(ga + (size_t)(32 * q) * K + k0, An + 1024 * (w + 4 * q)); glds16(gb + (size_t)(32 * q) * K + k0, An + GT + 1024 * (w + 4 * q)); }
    }
#pragma unroll
    for (int s = 0; s < 4; ++s) {
      const int co = ((2 * s + h) ^ sw) * 16;
      const bf16x8 bfr = *(const bf16x8*)(Bs + (32 * w + r) * 128 + co);
#pragma unroll
      for (int i = 0; i < 4; ++i) {
        const bf16x8 afr = *(const bf16x8*)(As + (32 * i + r) * 128 + co);
        acc[i] = MFMA(afr, bfr, acc[i]);
      }
    }
    asm volatile("s_waitcnt vmcnt(0)" ::: "memory");
    __syncthreads();
  }
}

DI float sigmoid_f(float x) { return 1.f / (1.f + __expf(-x)); }

DI void unit_gemm1(const P& p, int u, char* smem) {
  const int mt = u / 30, nt = u % 30;
  const int n0 = nt * 128, m0 = mt * 128;
  f32x16 acc[4];
  gemm_tile(w_Wt_in(p), w_H(p), 1024, n0, m0, smem, acc);
  const int tz = threadIdx.x + opaque0();
  const int lane = tz & 63, w = tz >> 6, r = lane & 31, h = lane >> 5;
  const int token = m0 + 32 * w + r;
  bf16* tw = (bf16*)(smem + (tz >> 6) * 16384) + r * 136;
  const bool is_prompt = token < NPR;
  const int b = is_prompt ? (token >> 11) : (token - NPR), pos = token & (SEQ - 1);
  if (n0 < C_V) {
    const float* gn = n0 < C_K ? p.q_norm_g : p.k_norm_g;
    const float post = n0 < C_K ? 0.125f : 1.f;
#pragma unroll
    for (int hh = 0; hh < 2; ++hh) {
      float ss = 0.f;
#pragma unroll
      for (int i = 0; i < 2; ++i)
#pragma unroll
        for (int j = 0; j < 16; ++j) ss += acc[2 * hh + i][j] * acc[2 * hh + i][j];
      ss += __shfl_xor(ss, 32);
      const float rstd = rsqrtf(ss * (1.f / 64.f) + EPS);
#pragma unroll
      for (int i = 0; i < 2; ++i)
#pragma unroll
        for (int q4 = 0; q4 < 4; ++q4) {
          const int d = 32 * i + 8 * q4 + 4 * h;
          const f32x4 gg = *(const f32x4*)(gn + d);
          f32x4 v;
#pragma unroll
          for (int j = 0; j < 4; ++j) v[j] = acc[2 * hh + i][4 * q4 + j] * rstd * gg[j];
          bf16x4 o;
#pragma unroll
          for (int j = 0; j < 4; ++j) o[j] = (bf16)(v[j] * post);
          *(bf16x4*)(tw + 64 * hh + d) = o;
          if (n0 == C_K) {
            if (is_prompt) { if (pos >= SEQ - 128) *(f32x4*)(p.out + O_KWP + ((size_t)b * 128 + (pos - (SEQ - 128))) * 128 + 64 * hh + d) = v; }
            else *(f32x4*)(p.out + O_KWS + ((size_t)b * 128 + 127) * 128 + 64 * hh + d) = v;
          }
        }
    }
  } else if (n0 == C_V) {
#pragma unroll
    for (int i = 0; i < 4; ++i)
#pragma unroll
      for (int q4 = 0; q4 < 4; ++q4) {
        const int f = 32 * i + 8 * q4 + 4 * h;
        f32x4 v;
#pragma unroll
        for (int j = 0; j < 4; ++j) v[j] = acc[i][4 * q4 + j];
        if (is_prompt) {
#pragma unroll
          for (int j = 0; j < 4; ++j) w_VT(p)[((size_t)b * 128 + f + j) * SEQ + pos] = (bf16)v[j];
          if (pos >= SEQ - 128) *(f32x4*)(p.out + O_VWP + ((size_t)b * 128 + (pos - (SEQ - 128))) * 128 + f) = v;
        } else *(f32x4*)(p.out + O_VWS + ((size_t)b * 128 + 127) * 128 + f) = v;
      }
  } else if (n0 < C_GA) {
#pragma unroll
    for (int i = 0; i < 4; ++i)
#pragma unroll
      for (int q4 = 0; q4 < 4; ++q4) {
        const int f = n0 + 32 * i + 8 * q4 + 4 * h;
        f32x4 v; bf16x4 o;
#pragma unroll
        for (int j = 0; j < 4; ++j) { v[j] = acc[i][4 * q4 + j]; o[j] = (bf16)v[j]; }
        *(bf16x4*)(tw + (f - n0)) = o;
        if (is_prompt) { if (pos >= SEQ - 15) *(f32x4*)(p.out + O_PP + ((size_t)b * 15 + (pos - (SEQ - 15))) * 512 + (f - C_PIN)) = v; }
        else *(f32x4*)(p.out + O_PS + ((size_t)b * 15 + 14) * 512 + (f - C_PIN)) = v;
      }
  } else {
#pragma unroll
    for (int i = 0; i < 4; ++i)
#pragma unroll
      for (int q4 = 0; q4 < 4; ++q4) {
        const int f = n0 + 32 * i + 8 * q4 + 4 * h;
        bf16x4 o;
#pragma unroll
        for (int j = 0; j < 4; ++j) o[j] = (bf16)sigmoid_f(acc[i][4 * q4 + j]);
        *(bf16x4*)(tw + (f - n0)) = o;
      }
  }
  if (n0 != C_V) {
    LDS_WAIT();
    const bf16* tr = (const bf16*)(smem + (tz >> 6) * 16384);
    bf16* pg = w_PROJ(p) + (size_t)(m0 + 32 * w + (lane >> 4)) * INW + n0 + (lane & 15) * 8;
#pragma unroll
    for (int it = 0; it < 8; ++it) *(u32x4*)(pg + (size_t)(4 * it) * INW) = *(const u32x4*)(tr + ((lane >> 4) + 4 * it) * 136 + (lane & 15) * 8);
  }
}

constexpr int VTS = 260;
constexpr int RS = 136;
DI void unit_attn_prompt(const P& p, int u, char* smem) {
  const int b = u >> 8, blk = (u >> 4) & 15, head = u & 15, hk = head >> 3;
  const int qpos0 = blk * 128;
  const int t = threadIdx.x + opaque0(), lane = t & 63, w = t >> 6, r = lane & 31, h = lane >> 5;
  bf16* Ks = (bf16*)smem;
  bf16* VTs = Ks + 256 * LDSK;
  float* bs = (float*)(VTs + 64 * VTS);
  bf16* Rs = Ks;
  __syncthreads();
#pragma unroll
  for (int i = 0; i < 8; ++i) {
    const int c = t + 256 * i, row = c >> 3, c16 = c & 7, kp = qpos0 - 128 + row;
    u32x4 v = {0u, 0u, 0u, 0u};
    if (kp >= 0) v = *(const u32x4*)(w_PROJ(p) + ((size_t)b * SEQ + kp) * INW + C_K + hk * 64 + c16 * 8);
    *(u32x4*)(Ks + row * LDSK + c16 * 8) = v;
  }
#pragma unroll
  for (int i = 0; i < 8; ++i) {
    const int c = t + 256 * i, drow = c >> 5, c16 = c & 31, kp0 = qpos0 - 128 + c16 * 8;
    u32x4 v = {0u, 0u, 0u, 0u};
    if (kp0 >= 0) v = *(const u32x4*)(w_VT(p) + ((size_t)(b * 2 + hk) * 64 + drow) * SEQ + kp0);
    u32x2* d2 = (u32x2*)(VTs + drow * VTS + c16 * 8);
    d2[0] = (u32x2){v[0], v[1]}; d2[1] = (u32x2){v[2], v[3]};
  }
  if (t < 192) { const int dist = 159 - t; bs[t] = (dist >= 0 && dist < 128) ? w_BIAS(p)[head * 128 + dist] : 0.f; }
  const int qi = 32 * w + r;
  const size_t tokq = (size_t)b * SEQ + qpos0 + qi;
  bf16x8 qf[4];
#pragma unroll
  for (int s = 0; s < 4; ++s) qf[s] = *(const bf16x8*)(w_PROJ(p) + tokq * INW + head * 64 + 16 * s + 8 * h);
  __syncthreads();
  f32x16 st[5];
#pragma unroll
  for (int tt = 0; tt < 5; ++tt) {
    st[tt] = zero16();
#pragma unroll
    for (int s = 0; s < 4; ++s) {
      const bf16x8 a = *(const bf16x8*)(Ks + (32 * (w + tt) + r) * LDSK + 16 * s + 8 * h);
      st[tt] = MFMA(a, qf[s], st[tt]);
    }
  }
  const float sink = p.sinks[head];
  float m = -INFINITY;
  {
    const int x = 31 - r + 4 * h;
    const float* bl = bs + x;
    const int kbase = blk > 0 ? 1024 : 32 * w + 4 * h;
#pragma unroll
    for (int tt = 0; tt < 5; ++tt)
#pragma unroll
      for (int j = 0; j < 16; ++j) {
        const int c = 32 * tt + (j & 3) + 8 * (j >> 2);
        const bool valid = (x + c >= 32) && (x + c <= 159) && (kbase + c >= 128);
        const float bv = bl[c];
        const float s = valid ? st[tt][j] + bv : -INFINITY;
        st[tt][j] = s;
        m = fmaxf(m, s);
      }
  }
  m = fmaxf(m, __shfl_xor(m, 32));
  m = fmaxf(m, sink);
  float sum = 0.f;
#pragma unroll
  for (int tt = 0; tt < 5; ++tt)
#pragma unroll
    for (int j = 0; j < 16; ++j) { const float e = __expf(st[tt][j] - m); st[tt][j] = e; sum += e; }
  sum += __shfl_xor(sum, 32);
  const float inv = 1.f / (sum + __expf(sink - m));
  f32x16 o[2] = {zero16(), zero16()};
#pragma unroll
  for (int tt = 0; tt < 5; ++tt)
#pragma unroll
    for (int s = 0; s < 2; ++s) {
      const bf16x8 pb = pack_step(st[tt], s);
#pragma unroll
      for (int i = 0; i < 2; ++i) {
        const bf16* vp = VTs + (32 * i + r) * VTS + 32 * (w + tt) + 16 * s + 4 * h;
        const bf16x8 a = cat4(*(const bf16x4*)vp, *(const bf16x4*)(vp + 8));
        o[i] = MFMA(a, pb, o[i]);
      }
    }
  __syncthreads();
  const int g = head >> 2, win = 2 << g;
  {
    const int tk = t >> 4, cc = t & 15;
    const int p0 = qpos0 + tk * 8;
    const bf16* pin = w_PROJ(p) + (size_t)b * SEQ * INW + C_PIN + g * 128 + cc * 8;
    float S[8];
#pragma unroll
    for (int j = 0; j < 8; ++j) S[j] = 0.f;
    for (int i = 0; i < win; ++i) {
      const int pp = p0 - i;
      if (pp >= 0) { const bf16x8 v = *(const bf16x8*)(pin + (size_t)pp * INW);
#pragma unroll
        for (int j = 0; j < 8; ++j) S[j] += bf2f(v[j]); }
    }
    for (int i = 0; i < 8; ++i) {
      const int pos = p0 + i;
      const bf16x8 cur = *(const bf16x8*)(pin + (size_t)pos * INW);
      if (i > 0) {
#pragma unroll
        for (int j = 0; j < 8; ++j) S[j] += bf2f(cur[j]);
        if (pos - win >= 0) { const bf16x8 old = *(const bf16x8*)(pin + (size_t)(pos - win) * INW);
#pragma unroll
          for (int j = 0; j < 8; ++j) S[j] -= bf2f(old[j]); }
      }
      const float icnt = 1.f / (float)(win < pos + 1 ? win : pos + 1);
      bf16x8 rr;
#pragma unroll
      for (int j = 0; j < 8; ++j) rr[j] = (bf16)(S[j] * icnt - bf2f(cur[j]));
      *(bf16x8*)(Rs + (tk * 8 + i) * RS + cc * 8) = rr;
    }
  }
  __syncthreads();
  f32x16 pa[2] = {zero16(), zero16()};
#pragma unroll
  for (int s = 0; s < 8; ++s) {
    const bf16x8 bfr = *(const bf16x8*)(Rs + (32 * w + r) * RS + 16 * s + 8 * h);
#pragma unroll
    for (int i = 0; i < 2; ++i) {
      const bf16x8 a = *(const bf16x8*)(w_PWt(p) + ((size_t)g * 256 + (head & 3) * 64 + 32 * i + r) * 128 + 16 * s + 8 * h);
      pa[i] = MFMA(a, bfr, pa[i]);
    }
  }
  const bf16* prow = w_PROJ(p) + tokq * INW;
#pragma unroll
  for (int i = 0; i < 2; ++i)
#pragma unroll
    for (int q4 = 0; q4 < 4; ++q4) {
      const int f = head * 64 + 32 * i + 8 * q4 + 4 * h;
      const bf16x4 ga = *(const bf16x4*)(prow + C_GA + f), gb = *(const bf16x4*)(prow + C_GB + f);
      const f32x4 ps = *(const f32x4*)(p.pool_scale + f);
      bf16x4 ov;
#pragma unroll
      for (int j = 0; j < 4; ++j) ov[j] = (bf16)(bf2f(ga[j]) * (o[i][4 * q4 + j] * inv) + bf2f(gb[j]) * (pa[i][4 * q4 + j] * ps[j]));
      *(bf16x4*)(w_MIXED(p) + tokq * DM + f) = ov;
    }
}

DI void unit_attn_sample(const P& p, int u, char* smem) {
  const int b = u >> 1, hk = u & 1;
  const int t = threadIdx.x + opaque0(), g8 = t >> 5, l32 = t & 31;
  float* ks = (float*)smem;
  float* vs = ks + 128 * 65;
  float* qs = vs + 128 * 64;
  float* ps = qs + 512;
  float* os = ps + 1024;
  float* rs = os + 512;
  const size_t token = (size_t)NPR + b;
  __syncthreads();
  const float* kw = p.out + O_KWS + (size_t)b * 128 * 128 + hk * 64;
  const float* vw = p.out + O_VWS + (size_t)b * 128 * 128 + hk * 64;
#pragma unroll 4
  for (int i = t; i < 128 * 64; i += NTHREADS) { const int j = i >> 6, d = i & 63; ks[j * 65 + d] = kw[(size_t)j * 128 + d]; vs[j * 64 + d] = vw[(size_t)j * 128 + d]; }
#pragma unroll 1
  for (int i = t; i < 512; i += NTHREADS) qs[i] = bf2f(w_PROJ(p)[token * INW + hk * 512 + i]);
  {
    const int gi = t >> 7, ch = t & 127, g = 2 * hk + gi, win = 2 << g;
    const float cur = p.out[O_PS + ((size_t)b * 15 + 14) * 512 + g * 128 + ch];
    float tot = cur;
#pragma unroll 1
    for (int i = 1; i < win; ++i) tot += p.state_pool[((size_t)b * 15 + 15 - i) * 512 + g * 128 + ch];
    rs[gi * 128 + ch] = tot / (float)win - cur;
  }
  __syncthreads();
  const int head = hk * 8 + g8;
  float s[4];
  float m = p.sinks[head];
#pragma unroll
  for (int i = 0; i < 4; ++i) {
    const int j = l32 + 32 * i;
    float a = 0.f;
#pragma unroll 8
    for (int d = 0; d < 64; ++d) a += qs[g8 * 64 + d] * ks[j * 65 + d];
    s[i] = a + w_BIAS(p)[head * 128 + 127 - j];
    m = fmaxf(m, s[i]);
  }
  for (int o = 16; o >= 1; o >>= 1) m = fmaxf(m, __shfl_xor(m, o));
  float sum = 0.f;
#pragma unroll
  for (int i = 0; i < 4; ++i) { s[i] = __expf(s[i] - m); sum += s[i]; }
  for (int o = 16; o >= 1; o >>= 1) sum += __shfl_xor(sum, o);
  const float inv = 1.f / (sum + __expf(p.sinks[head] - m));
#pragma unroll
  for (int i = 0; i < 4; ++i) ps[g8 * 128 + l32 + 32 * i] = s[i] * inv;
  __syncthreads();
#pragma unroll
  for (int i = 0; i < 2; ++i) {
    const int d = l32 + 32 * i;
    float a = 0.f;
#pragma unroll 8
    for (int j = 0; j < 128; ++j) a += ps[g8 * 128 + j] * vs[j * 64 + d];
    os[g8 * 64 + d] = a;
  }
  __syncthreads();
#pragma unroll
  for (int i = 0; i < 2; ++i) {
    const int fl = t + 256 * i, f = hk * 512 + fl, g = f >> 8, gi = g - 2 * hk, oc = f & 255;
    float pl = 0.f;
    const float* pw = p.pool_w + (size_t)g * 128 * 256 + oc;
#pragma unroll 8
    for (int ch = 0; ch < 128; ++ch) pl += rs[gi * 128 + ch] * pw[(size_t)ch * 256];
    pl *= p.pool_scale[f];
    const float ga = bf2f(w_PROJ(p)[token * INW + C_GA + f]), gb = bf2f(w_PROJ(p)[token * INW + C_GB + f]);
    w_MIXED(p)[token * DM + f] = (bf16)(ga * os[fl] + gb * pl);
  }
}

DI void unit_gemm2(const P& p, int u, char* smem) {
  const int mt = u >> 3, nt = u & 7;
  const int n0 = nt * 128, m0 = mt * 128;
  f32x16 acc[4];
  gemm_tile(w_Wt_out(p), w_MIXED(p), 1024, n0, m0, smem, acc);
  const int tz = threadIdx.x + opaque0();
  const int lane = tz & 63, w = tz >> 6, r = lane & 31, h = lane >> 5;
  const int token = m0 + 32 * w + r;
  const float* xr = xrow(p, token);
  const float* g1 = w_MOD(p) + (size_t)cond_row(token) * 6144 + 2048;
#pragma unroll
  for (int i = 0; i < 4; ++i)
#pragma unroll
    for (int q4 = 0; q4 < 4; ++q4) {
      const int f = n0 + 32 * i + 8 * q4 + 4 * h;
      const f32x4 xv = *(const f32x4*)(xr + f), gv = *(const f32x4*)(g1 + f);
      f32x4 o;
#pragma unroll
      for (int j = 0; j < 4; ++j) o[j] = xv[j] + gv[j] * acc[i][4 * q4 + j];
      *(f32x4*)(w_X1(p) + (size_t)token * DM + f) = o;
    }
}

DI unsigned f2ord(float f) { const unsigned u = __float_as_uint(f); return (u & 0x80000000u) ? ~u : (u | 0x80000000u); }
DI float ord2f(unsigned u) { return __uint_as_float((u & 0x80000000u) ? (u & 0x7fffffffu) : ~u); }
DI unsigned umin_(unsigned a, unsigned b) { return a < b ? a : b; }
DI unsigned umax_(unsigned a, unsigned b) { return a > b ? a : b; }
template <int OFF> DI void sort16_desc(unsigned (&a)[64]) {
#pragma unroll
  for (int lk = 1; lk <= 4; ++lk)
#pragma unroll
    for (int lj = lk - 1; lj >= 0; --lj)
#pragma unroll
      for (int i = 0; i < 16; ++i) {
        const int k = 1 << lk, j = 1 << lj, l = i ^ j;
        if (l > i) {
          const unsigned lo = umin_(a[OFF + i], a[OFF + l]), hi = umax_(a[OFF + i], a[OFF + l]);
          const bool desc = (i & k) == 0;
          a[OFF + i] = desc ? hi : lo; a[OFF + l] = desc ? lo : hi;
        }
      }
}
DI void merge16_desc(unsigned (&a)[16]) {
#pragma unroll
  for (int lj = 3; lj >= 0; --lj)
#pragma unroll
    for (int i = 0; i < 16; ++i) {
      const int j = 1 << lj, l = i ^ j;
      if (l > i) { const unsigned lo = umin_(a[i], a[l]), hi = umax_(a[i], a[l]); a[i] = hi; a[l] = lo; }
    }
}
DI void top16_of_64(unsigned (&a)[64], unsigned (&out)[16]) {
  sort16_desc<0>(a); sort16_desc<16>(a); sort16_desc<32>(a); sort16_desc<48>(a);
  unsigned x[16], y[16];
#pragma unroll
  for (int i = 0; i < 16; ++i) { x[i] = umax_(a[i], a[31 - i]); y[i] = umax_(a[32 + i], a[63 - i]); }
  merge16_desc(x); merge16_desc(y);
#pragma unroll
  for (int i = 0; i < 16; ++i) out[i] = umax_(x[i], y[15 - i]);
  merge16_desc(out);
}
__device__ constexpr int COFF[16] = {0, 16, 24, 29, 33, 36, 38, 40, 42, 43, 44, 45, 46, 47, 48, 49};
DI unsigned umax3(unsigned a, unsigned b, unsigned c) { const unsigned m = a > b ? a : b; return m > c ? m : c; }

DI void unit_peer_route(const P& p, int u, char* smem) {
  const int mt = u >> 3, hd = u & 7;
  const int m0 = mt * 128;
  const int t = threadIdx.x + opaque0(), lane = t & 63, w = t >> 6, r = lane & 31, h = lane >> 5;
  unsigned char* myidx = (unsigned char*)smem + 2 * GBUF + t * 32;
  unsigned top[2][16];
#pragma unroll
  for (int pp = 0; pp < 2; ++pp) {
    f32x16 acc[4];
    gemm_tile(w_Wt_q(p), w_H(p), 1024, hd * 256 + pp * 128, m0, smem, acc);
    f32x16 sc[4] = {zero16(), zero16(), zero16(), zero16()};
    const bf16* skb = w_SK(p) + (size_t)(hd * 2 + pp) * 128 * 128;
#pragma unroll
    for (int i = 0; i < 4; ++i)
#pragma unroll
      for (int s = 0; s < 2; ++s) {
        const bf16x8 bq = pack_step(acc[i], s);
#pragma unroll
        for (int kt = 0; kt < 4; ++kt) {
          const bf16* ap = skb + (size_t)(32 * kt + r) * 128 + 32 * i + 16 * s + 4 * h;
          const bf16x8 a = cat4(*(const bf16x4*)ap, *(const bf16x4*)(ap + 8));
          sc[kt] = MFMA(a, bq, sc[kt]);
        }
      }
    unsigned pk[64];
#pragma unroll
    for (int kt = 0; kt < 4; ++kt)
#pragma unroll
      for (int j = 0; j < 16; ++j) { const int key = 32 * kt + crow(j, h); pk[kt * 16 + j] = (f2ord(sc[kt][j]) & ~127u) | (unsigned)(127 - key); }
    unsigned mine[16];
    top16_of_64(pk, mine);
#pragma unroll
    for (int i = 0; i < 16; ++i) top[pp][i] = (unsigned)__shfl_xor((int)mine[15 - i], 32);
#pragma unroll
    for (int i = 0; i < 16; ++i) top[pp][i] = umax_(top[pp][i], mine[i]);
    merge16_desc(top[pp]);
  }
  float v0[16], v1[16];
#pragma unroll
  for (int a = 0; a < 16; ++a) {
    v0[a] = ord2f(top[0][a] & ~127u); v1[a] = ord2f(top[1][a] & ~127u);
    myidx[a] = (unsigned char)(127u - (top[0][a] & 127u)); myidx[16 + a] = (unsigned char)(127u - (top[1][a] & 127u));
  }
  unsigned cand[64];
#pragma unroll
  for (int i = 50; i < 64; ++i) cand[i] = 0u;
#pragma unroll
  for (int a = 0; a < 16; ++a)
#pragma unroll
    for (int bb = 0; bb < 16 / (a + 1); ++bb)
      cand[COFF[a] + bb] = (f2ord(v0[a] + v1[bb]) & ~255u) | (unsigned)(255 - (a * 16 + bb));
  unsigned best[16];
  top16_of_64(cand, best);
  const float smax = ord2f(best[0] & ~255u);
  float e[16], esum = 0.f;
#pragma unroll
  for (int i = 0; i < 16; ++i) { e[i] = __expf(ord2f(best[i] & ~255u) - smax); esum += e[i]; }
  const float einv = 1.f / esum;
  const size_t token = (size_t)m0 + 32 * w + r;
  int* ip = w_IDX(p) + token * 128 + hd * 16 + 8 * h;
  float* gp = w_GATE(p) + token * 128 + hd * 16 + 8 * h;
  const unsigned hmask = 0u - (unsigned)h;
#pragma unroll
  for (int i = 0; i < 8; ++i) {
    const unsigned bsel = best[i] ^ ((best[i] ^ best[8 + i]) & hmask);
    const float esel = __uint_as_float(__float_as_uint(e[i]) ^ ((__float_as_uint(e[i]) ^ __float_as_uint(e[8 + i])) & hmask));
    const unsigned code = 255u - (bsel & 255u);
    const int a = code >> 4, bb = code & 15;
    ip[i] = (int)myidx[a] * 128 + (int)myidx[16 + bb];
    gp[i] = esel * einv;
  }
}

DI float gelu_fast(float v) {
  const float av = fabsf(v), tt = __builtin_amdgcn_rcpf(av * 0.2316418882f + 1.0f);
  float q = tt * 0.5307027145f - 0.7265760135f; q = q * tt + 0.7107068705f; q = q * tt - 0.142248368f; q = q * tt + 0.127414796f; q = q * tt;
  const float e = __builtin_amdgcn_exp2f(v * v * -0.72134752044f);
  const float m = v * (q * e);
  return v < 0.f ? m : v - m;
}
DI float dot2bf(unsigned a, unsigned b, float acc) { return __builtin_amdgcn_fdot2_f32_bf16(__builtin_bit_cast(bf16x2, a), __builtin_bit_cast(bf16x2, b), acc, false); }
DI unsigned pkbf(f32x2 v) { bf16x2 r; r[0] = (bf16)v[0]; r[1] = (bf16)v[1]; return __builtin_bit_cast(unsigned, r); }
DI int dot16i(u32x4 u8, u32x4 x8, int d) {
#pragma unroll
  for (int m = 0; m < 4; ++m) d = __builtin_amdgcn_sdot4((int)u8[m], (int)x8[m], d, false);
  return d;
}
DI void axpy16p(f32x2* o, u32x4 v8, f32x2 c2) {
#pragma unroll
  for (int m = 0; m < 4; ++m) {
    const int wd = (int)v8[m];
    o[2 * m] = __builtin_elementwise_fma(c2, __builtin_amdgcn_cvt_pk_f32_fp8(wd, false), o[2 * m]);
    o[2 * m + 1] = __builtin_elementwise_fma(c2, __builtin_amdgcn_cvt_pk_f32_fp8(wd, true), o[2 * m + 1]);
  }
}
DI int dpp_add16i(int v) {
  v += __builtin_amdgcn_update_dpp(0, v, 0x140, 0xf, 0xf, true);
  v += __builtin_amdgcn_update_dpp(0, v, 0x141, 0xf, 0xf, true);
  v += __builtin_amdgcn_update_dpp(0, v, 0x4e, 0xf, 0xf, true);
  v += __builtin_amdgcn_update_dpp(0, v, 0xb1, 0xf, 0xf, true);
  return v;
}
DI float dot16(u32x4 u8, u32x4 xlo, u32x4 xhi, float d) {
#pragma unroll
  for (int m = 0; m < 4; ++m) {
    const int wd = (int)u8[m];
    const unsigned p01 = pkbf(__builtin_amdgcn_cvt_pk_f32_fp8(wd, false)), p23 = pkbf(__builtin_amdgcn_cvt_pk_f32_fp8(wd, true));
    const unsigned x01 = m < 2 ? xlo[2 * m] : xhi[2 * m - 4], x23 = m < 2 ? xlo[2 * m + 1] : xhi[2 * m - 3];
    d = dot2bf(p01, x01, d); d = dot2bf(p23, x23, d);
  }
  return d;
}
DI void axpy16(float* o, u32x4 v8, float c) {
#pragma unroll
  for (int m = 0; m < 4; ++m) {
    const int wd = (int)v8[m];
    const f32x2 a = __builtin_amdgcn_cvt_pk_f32_fp8(wd, false), b = __builtin_amdgcn_cvt_pk_f32_fp8(wd, true);
    o[4 * m] += c * a[0]; o[4 * m + 1] += c * a[1]; o[4 * m + 2] += c * b[0]; o[4 * m + 3] += c * b[1];
  }
}
DI float reduce4(const float (&d)[4], int lane) {
  const int h = lane >> 5, b4 = (lane >> 4) & 1;
  float a0 = h ? d[2] : d[0], a1 = h ? d[3] : d[1];
  const float s0 = h ? d[0] : d[2], s1 = h ? d[1] : d[3];
  a0 += __shfl_xor(s0, 32); a1 += __shfl_xor(s1, 32);
  float k = b4 ? a1 : a0;
  const float s = b4 ? a0 : a1;
  k += __shfl_xor(s, 16);
  k += __shfl_xor(k, 8); k += __shfl_xor(k, 4); k += __shfl_xor(k, 2); k += __shfl_xor(k, 1);
  return k;
}
DI float dpp_add16(float v) {
  v += __int_as_float(__builtin_amdgcn_update_dpp(0, __float_as_int(v), 0x140, 0xf, 0xf, true));
  v += __int_as_float(__builtin_amdgcn_update_dpp(0, __float_as_int(v), 0x141, 0xf, 0xf, true));
  v += __int_as_float(__builtin_amdgcn_update_dpp(0, __float_as_int(v), 0x4e, 0xf, 0xf, true));
  v += __int_as_float(__builtin_amdgcn_update_dpp(0, __float_as_int(v), 0xb1, 0xf, 0xf, true));
  return v;
}
constexpr int PEER_GLDS = 512 + 128 * 16;
constexpr int PEER_WLDS = 4 * PEER_GLDS;
DI void peer_wave4(const P& p, int g, char* wl) {
  const int lane = (threadIdx.x + opaque0()) & 63, q = lane >> 4, j16 = lane & 15;
  unsigned* hist = (unsigned*)(wl + q * PEER_GLDS);
  u32x4* list = (u32x4*)(wl + q * PEER_GLDS + 512);
  const int token = 4 * g + q;
  u32x4 x[4];
  {
    const unsigned char* hrow = w_H8(p) + (size_t)token * DM + 16 * j16;
#pragma unroll
    for (int i = 0; i < 4; ++i) x[i] = *(const u32x4*)(hrow + 256 * i);
  }
  const float xs = w_HS(p)[token];
  {
    int ids[8]; float gts[8], su[8];
#pragma unroll
    for (int i = 0; i < 8; ++i) { const size_t o = (size_t)token * 128 + j16 + 16 * i; ids[i] = w_IDX(p)[o]; gts[i] = w_GATE(p)[o]; }
#pragma unroll
    for (int i = 0; i < 8; ++i) { su[i] = w_SU(p)[ids[i]] * xs; gts[i] *= w_SV(p)[ids[i]]; }
    LDS_WAIT();
    *(u32x4*)(hist + 8 * j16) = (u32x4){0u, 0u, 0u, 0u}; *(u32x4*)(hist + 8 * j16 + 4) = (u32x4){0u, 0u, 0u, 0u};
    LDS_WAIT();
#pragma unroll
    for (int i = 0; i < 8; ++i) (void)__hip_atomic_fetch_add(&hist[ids[i] >> 7], 1u, __ATOMIC_RELAXED, __HIP_MEMORY_SCOPE_WAVEFRONT);
    LDS_WAIT();
    const u32x4 ca = *(const u32x4*)(hist + 8 * j16), cb = *(const u32x4*)(hist + 8 * j16 + 4);
    const unsigned tot = ca[0] + ca[1] + ca[2] + ca[3] + cb[0] + cb[1] + cb[2] + cb[3];
    unsigned scan = tot;
#pragma unroll
    for (int o = 1; o < 16; o <<= 1) { const unsigned tv = (unsigned)__shfl_up((int)scan, o, 16); if (j16 >= o) scan += tv; }
    unsigned e0 = scan - tot;
    u32x4 pa, pb;
    pa[0] = e0; e0 += ca[0]; pa[1] = e0; e0 += ca[1]; pa[2] = e0; e0 += ca[2]; pa[3] = e0; e0 += ca[3];
    pb[0] = e0; e0 += cb[0]; pb[1] = e0; e0 += cb[1]; pb[2] = e0; e0 += cb[2]; pb[3] = e0;
    LDS_WAIT();
    *(u32x4*)(hist + 8 * j16) = pa; *(u32x4*)(hist + 8 * j16 + 4) = pb;
    LDS_WAIT();
#pragma unroll
    for (int i = 0; i < 8; ++i) {
      const unsigned pos = __hip_atomic_fetch_add(&hist[ids[i] >> 7], 1u, __ATOMIC_RELAXED, __HIP_MEMORY_SCOPE_WAVEFRONT);
      list[pos] = (u32x4){(unsigned)ids[i], __float_as_uint(su[i]), __float_as_uint(gts[i]), 0u};
    }
    LDS_WAIT();
  }
  f32x2 acc[32];
#pragma unroll
  for (int i = 0; i < 32; ++i) acc[i] = (f32x2){0.f, 0.f};
  const unsigned char* Ub = w_Ub(p) + 16 * j16;
  const unsigned char* Vb = w_Vb(p) + 16 * j16;
  u32x4 u[4], v[4];
  u32x4 en = list[0];
  {
    const size_t ro = (size_t)en[0] * DM;
#pragma unroll
    for (int i = 0; i < 4; ++i) u[i] = *(const u32x4*)(Ub + ro + 256 * i);
#pragma unroll
    for (int i = 0; i < 4; ++i) v[i] = *(const u32x4*)(Vb + ro + 256 * i);
  }
#pragma unroll 1
  for (int k = 0; k < 128; ++k) {
    const float su = __uint_as_float(en[1]), gsv = __uint_as_float(en[2]);
    en = list[k + 1 < 128 ? k + 1 : 127];
    const size_t ro = (size_t)en[0] * DM;
    int d0 = 0, d1 = 0;
    d0 = dot16i(u[0], x[0], d0); d1 = dot16i(u[1], x[1], d1); d0 = dot16i(u[2], x[2], d0); d1 = dot16i(u[3], x[3], d1);
#pragma unroll
    for (int i = 0; i < 4; ++i) u[i] = *(const u32x4*)(Ub + ro + 256 * i);
    const float c = gsv * gelu_fast(su * (float)dpp_add16i(d0 + d1));
    const f32x2 c2 = {c, c};
#pragma unroll
    for (int i = 0; i < 4; ++i) axpy16p(acc + 8 * i, v[i], c2);
#pragma unroll
    for (int i = 0; i < 4; ++i) v[i] = *(const u32x4*)(Vb + ro + 256 * i);
  }
  const float* x1 = w_X1(p) + (size_t)token * DM + 16 * j16;
  const float* g2 = w_MOD(p) + (size_t)cond_row(token) * 6144 + 5120 + 16 * j16;
  float* y = p.out + O_YP + (size_t)token * DM + 16 * j16;
#pragma unroll
  for (int i = 0; i < 4; ++i)
#pragma unroll
    for (int mm = 0; mm < 4; ++mm) {
      const int c0 = 256 * i + 4 * mm;
      const f32x4 xv = *(const f32x4*)(x1 + c0), gv = *(const f32x4*)(g2 + c0);
      f32x4 yv;
#pragma unroll
      for (int j = 0; j < 4; ++j) yv[j] = xv[j] + gv[j] * acc[8 * i + 2 * mm + (j >> 1)][j & 1];
      *(f32x4*)(y + c0) = yv;
    }
}
DI void peer_token_block(const P& p, int token, char* smem) {
  const int t = threadIdx.x + opaque0(), lane = t & 63, w = t >> 6;
  float* red = (float*)smem;
  const u32x4 x8 = *(const u32x4*)(w_H8(p) + (size_t)token * DM + 16 * lane);
  const int myid = w_IDX(p)[(size_t)token * 128 + 32 * w + (lane & 31)];
  const float mysu = w_SU(p)[myid] * w_HS(p)[token];
  const float mygs = w_GATE(p)[(size_t)token * 128 + 32 * w + (lane & 31)] * w_SV(p)[myid];
  float o[16];
#pragma unroll
  for (int i = 0; i < 16; ++i) o[i] = 0.f;
#pragma unroll 1
  for (int e0 = 0; e0 < 32; e0 += 4) {
    u32x4 u8[4], v8[4];
#pragma unroll
    for (int qq = 0; qq < 4; ++qq) {
      const size_t ro = (size_t)__builtin_amdgcn_readlane(myid, e0 + qq) * DM + 16 * lane;
      u8[qq] = *(const u32x4*)(w_Ub(p) + ro); v8[qq] = *(const u32x4*)(w_Vb(p) + ro);
    }
    float d[4];
#pragma unroll
    for (int qq = 0; qq < 4; ++qq) d[qq] = (float)dot16i(u8[qq], x8, 0);
    const float kv = reduce4(d, lane);
#pragma unroll
    for (int qq = 0; qq < 4; ++qq) {
      const float a = __int_as_float(__builtin_amdgcn_readlane(__float_as_int(kv), 16 * qq)) * __int_as_float(__builtin_amdgcn_readlane(__float_as_int(mysu), e0 + qq));
      const float c = __int_as_float(__builtin_amdgcn_readlane(__float_as_int(mygs), e0 + qq)) * gelu_fast(a);
      axpy16(o, v8[qq], c);
    }
  }
  __syncthreads();
#pragma unroll
  for (int i = 0; i < 16; ++i) red[w * 1024 + 16 * lane + i] = o[i];
  __syncthreads();
  if (w == 0) {
    const float* x1 = w_X1(p) + (size_t)token * DM + 16 * lane;
    const float* g2 = w_MOD(p) + (size_t)cond_row(token) * 6144 + 5120 + 16 * lane;
    float* y = p.out + O_YP + (size_t)token * DM + 16 * lane;
#pragma unroll
    for (int mm = 0; mm < 4; ++mm) {
      const f32x4 xv = *(const f32x4*)(x1 + 4 * mm), gv = *(const f32x4*)(g2 + 4 * mm);
      f32x4 yv;
#pragma unroll
      for (int j = 0; j < 4; ++j) { const int c = 16 * lane + 4 * mm + j; yv[j] = xv[j] + gv[j] * (red[c] + red[1024 + c] + red[2048 + c] + red[3072 + c]); }
      *(f32x4*)(y + 4 * mm) = yv;
    }
  }
}

constexpr int NPHASE = 8;
template <int PH> DI void run_phase(const P& p, char* smem) {
  const int G = gridDim.x, bid = blockIdx.x, w = __builtin_amdgcn_readfirstlane(threadIdx.x >> 6);
  if constexpr (PH == 0) { for (int u = bid; u < U0_TOTAL; u += G) phase0_unit(p, u, smem); }
  if constexpr (PH == 1) { for (int tk = bid * 4 + w; tk < NTOK; tk += G * 4) norm_row(p, tk, 0); }
  if constexpr (PH == 2) { for (int u = bid; u < 129 * 30; u += G) unit_gemm1(p, u, smem); }
  if constexpr (PH == 3) { for (int u = bid; u < 2048; u += G) unit_attn_prompt(p, u, smem);
                           for (int u = bid; u < 256; u += G) unit_attn_sample(p, u, smem); }
  if constexpr (PH == 4) { for (int u = bid; u < 129 * 8; u += G) unit_gemm2(p, u, smem); }
  if constexpr (PH == 5) { for (int tk = bid * 4 + w; tk < NTOK; tk += G * 4) norm_row(p, tk, 1); }
  if constexpr (PH == 6) { for (int u = bid; u < 129 * 8; u += G) unit_peer_route(p, u, smem); }
  if constexpr (PH == 7) {
    for (int g = bid * 4 + w; g < NPR / 4; g += G * 4) peer_wave4(p, g, smem + w * PEER_WLDS);
    for (int s = bid; s < NS; s += G) peer_token_block(p, NPR + s, smem + 4 * PEER_WLDS);
  }
}
#if ONE_LAUNCH
__global__ void __launch_bounds__(NTHREADS, 2) mega(P p) {
  __shared__ __attribute__((aligned(16))) char smem[SMEM_BYTES + 16];
  volatile unsigned* st = (volatile unsigned*)(smem + SMEM_BYTES);
  if (threadIdx.x == 0) { st[0] = 0u; st[1] = 0u; }
  __syncthreads();
  const unsigned xcc = xb_xcc_id();
  if (threadIdx.x == 0) (void)xb_add(&w_bar(p)[XB_XCNT(xcc)], 1u);
#ifndef REPEAT_MASK
#define REPEAT_MASK 0
#endif
#define RUN_PH(k) do { run_phase<k>(p, smem); if ((REPEAT_MASK >> k) & 1) { xcd_barrier(w_bar(p), xcc, st); run_phase<k>(p, smem); } } while (0)
  RUN_PH(0); xcd_barrier(w_bar(p), xcc, st);
  RUN_PH(1); xcd_barrier(w_bar(p), xcc, st);
  RUN_PH(2); xcd_barrier(w_bar(p), xcc, st);
  RUN_PH(3); xcd_barrier(w_bar(p), xcc, st);
  RUN_PH(4); xcd_barrier(w_bar(p), xcc, st);
  RUN_PH(5); xcd_barrier(w_bar(p), xcc, st);
  RUN_PH(6); xcd_barrier(w_bar(p), xcc, st);
  RUN_PH(7);
}
#else
template <int PH> __global__ void __launch_bounds__(NTHREADS, 2) mega(P p) {
  __shared__ __attribute__((aligned(16))) char smem[SMEM_BYTES];
  run_phase<PH>(p, smem);
}
#endif


extern "C" void kernel_launch(void* const* d_in, const int* in_sizes, int n_in, void* d_out, int out_size, void* d_ws, size_t ws_size, hipStream_t stream) {
  P p{};
  const float* const* in = (const float* const*)d_in;
  p.x_prompt = in[0]; p.x_sample = in[1]; p.cache_k = in[2]; p.cache_v = in[3]; p.state_pool = in[4]; p.c_prompt = in[5]; p.c_sample = in[6];
  p.rel_table = in[7]; p.ada_w = in[8]; p.ada_b = in[9]; p.norm1_g = in[10]; p.w_in = in[11]; p.q_norm_g = in[12]; p.k_norm_g = in[13]; p.sinks = in[14];
  p.pool_w = in[15]; p.pool_scale = in[16]; p.w_out = in[17]; p.norm2_g = in[18]; p.w_query = in[19]; p.sub_keys = in[20]; p.peer_u = in[21]; p.peer_v = in[22];
  p.out = (float*)d_out;
  p.ws = (char*)d_ws;
  if (WS_NEED > ws_size) { fprintf(stderr, "workspace too small: need %zu have %zu\n", (size_t)WS_NEED, ws_size); return; }

  static int grid_blocks = 0;
  if (!grid_blocks) {
    int dev = 0, cus = 0, per_cu = 0;
    (void)hipGetDevice(&dev);
    (void)hipDeviceGetAttribute(&cus, hipDeviceAttributeMultiprocessorCount, dev);
#if ONE_LAUNCH
    (void)hipOccupancyMaxActiveBlocksPerMultiprocessor(&per_cu, mega, NTHREADS, 0);
#else
    per_cu = 2;
#endif
    if (per_cu > 2) per_cu = 2;
    if (per_cu < 1) per_cu = 1;
    if (cus < 1) cus = 256;
    grid_blocks = cus * per_cu;
  }
#if ONE_LAUNCH
  (void)hipMemsetAsync(p.ws + OFF_BAR, 0, XCD_BAR_WORDS * 4, stream);
  hipLaunchKernelGGL(mega, dim3(grid_blocks), dim3(NTHREADS), 0, stream, p);
#else
  hipLaunchKernelGGL(mega<0>, dim3(grid_blocks), dim3(NTHREADS), 0, stream, p);
  hipLaunchKernelGGL(mega<1>, dim3(grid_blocks), dim3(NTHREADS), 0, stream, p);
  hipLaunchKernelGGL(mega<2>, dim3(grid_blocks), dim3(NTHREADS), 0, stream, p);
  hipLaunchKernelGGL(mega<3>, dim3(grid_blocks), dim3(NTHREADS), 0, stream, p);
  hipLaunchKernelGGL(mega<4>, dim3(grid_blocks), dim3(NTHREADS), 0, stream, p);
  hipLaunchKernelGGL(mega<5>, dim3(grid_blocks), dim3(NTHREADS), 0, stream, p);
  hipLaunchKernelGGL(mega<6>, dim3(grid_blocks), dim3(NTHREADS), 0, stream, p);
  hipLaunchKernelGGL(mega<7>, dim3(grid_blocks), dim3(NTHREADS), 0, stream, p);
#endif

}
```

```cpp
#include <hip/hip_runtime.h>
#include <stdint.h>
#include <stdio.h>

#ifndef ONE_LAUNCH
#define ONE_LAUNCH 1
#endif

typedef __bf16 bf16;
typedef __bf16 bf16x2 __attribute__((ext_vector_type(2)));
typedef __bf16 bf16x4 __attribute__((ext_vector_type(4)));
typedef __bf16 bf16x8 __attribute__((ext_vector_type(8)));
typedef float f32x2 __attribute__((ext_vector_type(2)));
typedef float f32x4 __attribute__((ext_vector_type(4)));
typedef float f32x16 __attribute__((ext_vector_type(16)));
typedef unsigned u32x2 __attribute__((ext_vector_type(2)));
typedef unsigned u32x4 __attribute__((ext_vector_type(4)));

#define DI __device__ __forceinline__
#define MFMA(a, b, c) __builtin_amdgcn_mfma_f32_32x32x16_bf16((a), (b), (c), 0, 0, 0)

constexpr int DM = 1024, NB = 8, SEQ = 2048, NS = 128, NPR = NB * SEQ, NTOK = NPR + NS;
constexpr int INW = 3840, NMOD = NB + NS;
constexpr int C_K = 1024, C_V = 1152, C_PIN = 1280, C_GA = 1792, C_GB = 2816;
constexpr int NEXP = 16384;
constexpr float EPS = 1e-6f;
constexpr size_t O_YP = 0, O_KWP = 16908288, O_VWP = 17039360, O_PP = 17170432, O_KWS = 17231872, O_VWS = 19329024, O_PS = 21426176;

constexpr int SMEM_BYTES = 77824;
constexpr int NTHREADS = 256;

struct P {
  const float *x_prompt, *x_sample, *cache_k, *cache_v, *state_pool, *c_prompt, *c_sample, *rel_table, *ada_w, *ada_b, *norm1_g, *w_in,
      *q_norm_g, *k_norm_g, *sinks, *pool_w, *pool_scale, *w_out, *norm2_g, *w_query, *sub_keys, *peer_u, *peer_v;
  float* out;
  char* ws;
};
constexpr size_t al256(size_t x) { return (x + 255) & ~(size_t)255; }
constexpr size_t OFF_BAR = 0;
constexpr size_t OFF_WTIN = OFF_BAR + al256(4096 * 4);
constexpr size_t OFF_WTOUT = OFF_WTIN + al256((size_t)INW * 1024 * 2);
constexpr size_t OFF_WTQ = OFF_WTOUT + al256((size_t)1024 * 1024 * 2);
constexpr size_t OFF_SK = OFF_WTQ + al256((size_t)2048 * 1024 * 2);
constexpr size_t OFF_PWT = OFF_SK + al256((size_t)16 * 128 * 128 * 2);
constexpr size_t OFF_UB = OFF_PWT + al256((size_t)4 * 256 * 128 * 2);
constexpr size_t OFF_VB = OFF_UB + al256((size_t)NEXP * DM);
constexpr size_t OFF_SU = OFF_VB + al256((size_t)NEXP * DM);
constexpr size_t OFF_SV = OFF_SU + al256((size_t)NEXP * 4);
constexpr size_t OFF_H8 = OFF_SV + al256((size_t)NEXP * 4);
constexpr size_t OFF_HS = OFF_H8 + al256((size_t)NTOK * DM);
constexpr size_t OFF_MOD = OFF_HS + al256((size_t)NTOK * 4);
constexpr size_t OFF_BIAS = OFF_MOD + al256((size_t)NMOD * 6144 * 4);
constexpr size_t OFF_VT = OFF_BIAS + al256(16 * 128 * 4);
constexpr size_t OFF_H = OFF_VT + al256((size_t)NB * 128 * SEQ * 2);
constexpr size_t OFF_MIXED = OFF_H;
constexpr size_t OFF_PROJ = OFF_H + al256((size_t)NTOK * DM * 2);
constexpr size_t OFF_X1 = OFF_PROJ;
constexpr size_t OFF_IDX = OFF_X1 + (size_t)NTOK * DM * 4;
constexpr size_t OFF_GATE = OFF_IDX + (size_t)NTOK * 128 * 4;
constexpr size_t WS_NEED = OFF_PROJ + al256((size_t)NTOK * INW * 2);
static_assert(OFF_GATE + (size_t)NTOK * 128 * 4 <= WS_NEED, "overlay fits");
static_assert(WS_NEED <= (size_t)256 * 1024 * 1024, "workspace budget");
#define WS_PTR(T, name, OFF) __device__ __forceinline__ T* name(const P& p) { return (T*)(p.ws + (OFF)); }
WS_PTR(unsigned, w_bar, OFF_BAR) WS_PTR(bf16, w_Wt_in, OFF_WTIN) WS_PTR(bf16, w_Wt_out, OFF_WTOUT) WS_PTR(bf16, w_Wt_q, OFF_WTQ) WS_PTR(bf16, w_SK, OFF_SK)
WS_PTR(bf16, w_PWt, OFF_PWT) WS_PTR(unsigned char, w_Ub, OFF_UB) WS_PTR(unsigned char, w_Vb, OFF_VB) WS_PTR(float, w_SU, OFF_SU) WS_PTR(float, w_SV, OFF_SV) WS_PTR(unsigned char, w_H8, OFF_H8) WS_PTR(float, w_HS, OFF_HS) WS_PTR(float, w_MOD, OFF_MOD) WS_PTR(float, w_BIAS, OFF_BIAS)
WS_PTR(bf16, w_VT, OFF_VT) WS_PTR(bf16, w_H, OFF_H) WS_PTR(bf16, w_MIXED, OFF_MIXED) WS_PTR(bf16, w_PROJ, OFF_PROJ) WS_PTR(float, w_X1, OFF_X1)
WS_PTR(int, w_IDX, OFF_IDX) WS_PTR(float, w_GATE, OFF_GATE)

DI int cond_row(int token) { return token < NPR ? (token >> 11) : (NB + token - NPR); }
DI int crow(int reg, int h) { return (reg & 3) + 8 * (reg >> 2) + 4 * h; }
DI const float* xrow(const P& p, int token) { return token < NPR ? p.x_prompt + (size_t)token * DM : p.x_sample + (size_t)(token - NPR) * DM; }

#define LDS_WAIT() asm volatile("s_waitcnt lgkmcnt(0)" ::: "memory")
DI int opaque0() { int z = 0; asm volatile("" : "+v"(z)); return z; }
DI float bf2f(bf16 v) { return (float)v; }
DI f32x16 zero16() { f32x16 z; for (int i = 0; i < 16; ++i) z[i] = 0.f; return z; }
DI bf16x8 pack_step(const f32x16& x, int s) { bf16x8 v; for (int j = 0; j < 8; ++j) v[j] = (bf16)x[8 * s + j]; return v; }
DI bf16x8 cat4(bf16x4 lo, bf16x4 hi) { return __builtin_shufflevector(lo, hi, 0, 1, 2, 3, 4, 5, 6, 7); }
DI float wave_sum(float v) { for (int o = 32; o >= 1; o >>= 1) v += __shfl_xor(v, o); return v; }

#define XB_TMO 128
#define XB_XCNT(j) (256 + 64 * (j))
#define XB_XSUB(j) (1280 + 64 * (j))
#define XB_XGEN(j) (2304 + 64 * (j))
#define XB_TOP 3328
#define XB_TOPGEN 3392
#define XCD_BAR_WORDS 3456
#define XB_SPIN_CAP (1u << 22)
DI unsigned xb_ld(unsigned* p) { return __hip_atomic_load(p, __ATOMIC_RELAXED, __HIP_MEMORY_SCOPE_AGENT); }
DI unsigned xb_add(unsigned* p, unsigned v) { return __hip_atomic_fetch_add(p, v, __ATOMIC_RELAXED, __HIP_MEMORY_SCOPE_AGENT); }
DI unsigned xb_xcc_id() { return (unsigned)__builtin_amdgcn_s_getreg((3 << 11) | 20) & 0xFu; }
#define XB_SPIN(cond, bar) do { unsigned _sp = 0; while (cond) { __builtin_amdgcn_s_sleep(1); \
    if ((++_sp & 255u) == 0u) { if (xb_ld(&(bar)[XB_TMO])) break; if (_sp > XB_SPIN_CAP) { atomicAdd(&(bar)[XB_TMO], 1u); break; } } } } while (0)

DI void xcd_barrier_complete(unsigned* bar, unsigned x, unsigned& nloc, unsigned& nx) {
  const unsigned G = gridDim.x;
  unsigned sum, cnt, mine, sp = 0u;
  for (;;) {
    sum = 0u; cnt = 0u; mine = 0u;
#pragma unroll
    for (unsigned j = 0; j < 16; ++j) { const unsigned c = xb_ld(&bar[XB_XCNT(j)]); sum += c; cnt += (c > 0u) ? 1u : 0u; mine = (j == x) ? c : mine; }
    if (sum == G) break;
    __builtin_amdgcn_s_sleep(1);
    if ((++sp & 255u) == 0u) { if (xb_ld(&bar[XB_TMO])) break; if (sp > XB_SPIN_CAP) { atomicAdd(&bar[XB_TMO], 1u); break; } }
  }
  nloc = mine > 0u ? mine : 1u; nx = cnt > 0u ? cnt : 1u;
}
DI void xcd_barrier(unsigned* bar, unsigned x, volatile unsigned* st) {
  asm volatile("s_waitcnt vmcnt(0)" ::: "memory");
  __syncthreads();
  if (threadIdx.x == 0) {
    __builtin_amdgcn_s_waitcnt(0);
    unsigned nloc = st[0], nx = st[1];
    if (nloc == 0u) { xcd_barrier_complete(bar, x, nloc, nx); st[0] = nloc; st[1] = nx; }
    const unsigned old = xb_add(&bar[XB_XSUB(x)], 1u);
    const unsigned gen = old / nloc;
    if (old + 1u == (gen + 1u) * nloc) {
      __builtin_amdgcn_fence(__ATOMIC_RELEASE, "agent");
      asm volatile("s_waitcnt vmcnt(0)" ::: "memory");
      const unsigned og = xb_add(&bar[XB_TOP], 1u);
      const unsigned tg = og / nx;
      if (og + 1u == (tg + 1u) * nx) xb_add(&bar[XB_TOPGEN], 1u);
      else XB_SPIN(xb_ld(&bar[XB_TOPGEN]) == tg, bar);
      __builtin_amdgcn_fence(__ATOMIC_ACQUIRE, "agent");
      xb_add(&bar[XB_XGEN(x)], 1u);
      asm volatile("s_waitcnt vmcnt(0)" ::: "memory");
    } else {
      XB_SPIN(xb_ld(&bar[XB_XGEN(x)]) == gen, bar);
      __builtin_amdgcn_fence(__ATOMIC_ACQUIRE, "agent");
      asm volatile("s_waitcnt vmcnt(0)" ::: "memory");
    }
  }
  __syncthreads();
}

constexpr int U0_MOD = 192;
constexpr int U0_TIN = (1024 / 64) * (INW / 64);
constexpr int U0_TOUT = 16 * 16;
constexpr int U0_TQ = 16 * 32;
constexpr int U0_TPW = 4 * 2 * 4;
constexpr int U0_CSK = 32;
constexpr int U0_CU = 2048, U0_CV = 2048;
constexpr int U0_KW = 128, U0_VW = 128, U0_PW = 128, U0_BIAS = 1;
constexpr int U0_E0 = U0_MOD, U0_E1 = U0_E0 + U0_TIN, U0_E2 = U0_E1 + U0_TOUT, U0_E3 = U0_E2 + U0_TQ, U0_E4 = U0_E3 + U0_TPW, U0_E5 = U0_E4 + U0_CSK,
              U0_E6 = U0_E5 + U0_CU, U0_E7 = U0_E6 + U0_CV, U0_E8 = U0_E7 + U0_KW, U0_E9 = U0_E8 + U0_VW, U0_E10 = U0_E9 + U0_PW, U0_TOTAL = U0_E10 + U0_BIAS;

DI float silu_f(float x) { return x / (1.f + __expf(-x)); }

DI void unit_mod(const P& p, int u, char* smem) {
  const int t = threadIdx.x + opaque0(), lane = t & 63, w = t >> 6, r = lane & 31, h = lane >> 5;
  const int f0 = u * 32;
  f32x16 acc[5];
#pragma unroll
  for (int i = 0; i < 5; ++i) acc[i] = zero16();
#pragma unroll 1
  for (int ks = 0; ks < 16; ++ks) {
    const int k0 = w * 256 + ks * 16 + 8 * h;
    bf16x8 bfr;
#pragma unroll
    for (int j = 0; j < 8; ++j) bfr[j] = (bf16)p.ada_w[(size_t)(k0 + j) * 6144 + f0 + r];
#pragma unroll
    for (int i = 0; i < 5; ++i) {
      const int m = 32 * i + r;
      bf16x8 afr;
      if (m < NMOD) {
        const float* c = (m < NB ? p.c_prompt + (size_t)m * DM : p.c_sample + (size_t)(m - NB) * DM) + k0;
        const f32x4 c0 = *(const f32x4*)c, c1 = *(const f32x4*)(c + 4);
        afr[0] = (bf16)silu_f(c0[0]); afr[1] = (bf16)silu_f(c0[1]); afr[2] = (bf16)silu_f(c0[2]); afr[3] = (bf16)silu_f(c0[3]);
        afr[4] = (bf16)silu_f(c1[0]); afr[5] = (bf16)silu_f(c1[1]); afr[6] = (bf16)silu_f(c1[2]); afr[7] = (bf16)silu_f(c1[3]);
      } else {
#pragma unroll
        for (int j = 0; j < 8; ++j) afr[j] = (bf16)0.f;
      }
      acc[i] = MFMA(afr, bfr, acc[i]);
    }
  }
  float* red = (float*)smem;
  __syncthreads();
  if (w > 0) {
#pragma unroll
    for (int i = 0; i < 5; ++i)
#pragma unroll
      for (int j = 0; j < 16; ++j) red[((w - 1) * 80 + i * 16 + j) * 64 + lane] = acc[i][j];
  }
  __syncthreads();
  if (w == 0) {
    const float bias = p.ada_b[f0 + r];
#pragma unroll
    for (int i = 0; i < 5; ++i)
#pragma unroll
      for (int j = 0; j < 16; ++j) {
        const int m = 32 * i + crow(j, h);
        const float v = acc[i][j] + red[(0 * 80 + i * 16 + j) * 64 + lane] + red[(1 * 80 + i * 16 + j) * 64 + lane] + red[(2 * 80 + i * 16 + j) * 64 + lane] + bias;
        if (m < NMOD) w_MOD(p)[(size_t)m * 6144 + f0 + r] = v;
      }
  }
}

DI void unit_transpose(const float* __restrict__ src, bf16* __restrict__ dst, int R, int C, int tr, int tc, char* smem) {
  float* tile = (float*)smem;
  const int t = threadIdx.x + opaque0();
  __syncthreads();
#pragma unroll
  for (int i = 0; i < 4; ++i) {
    const int rr = (t >> 4) + 16 * i, cc = (t & 15) * 4;
    const f32x4 v = *(const f32x4*)(src + (size_t)(tr * 64 + rr) * C + tc * 64 + cc);
    tile[rr * 65 + cc] = v[0]; tile[rr * 65 + cc + 1] = v[1]; tile[rr * 65 + cc + 2] = v[2]; tile[rr * 65 + cc + 3] = v[3];
  }
  __syncthreads();
#pragma unroll
  for (int i = 0; i < 2; ++i) {
    const int orow = (t >> 3) + 32 * i, seg = (t & 7) * 8;
    bf16x8 v;
#pragma unroll
    for (int j = 0; j < 8; ++j) v[j] = (bf16)tile[(seg + j) * 65 + orow];
    *(bf16x8*)(dst + (size_t)(tc * 64 + orow) * R + tr * 64 + seg) = v;
  }
}
DI void unit_convert(const float* __restrict__ src, bf16* __restrict__ dst, int u) {
  const size_t base = (size_t)u * 8192 + (threadIdx.x + opaque0()) * 8;
#pragma unroll
  for (int i = 0; i < 4; ++i) {
    const size_t o = base + (size_t)i * 2048;
    const f32x4 a = *(const f32x4*)(src + o), b = *(const f32x4*)(src + o + 4);
    bf16x8 v; v[0] = (bf16)a[0]; v[1] = (bf16)a[1]; v[2] = (bf16)a[2]; v[3] = (bf16)a[3]; v[4] = (bf16)b[0]; v[5] = (bf16)b[1]; v[6] = (bf16)b[2]; v[7] = (bf16)b[3];
    *(bf16x8*)(dst + o) = v;
  }
}
DI unsigned pack_i8(float a, float b, float c, float d) {
  const int ia = max(-127, min(127, __float2int_rn(a))), ib = max(-127, min(127, __float2int_rn(b))), ic = max(-127, min(127, __float2int_rn(c))), id = max(-127, min(127, __float2int_rn(d)));
  return (unsigned)(ia & 255) | ((unsigned)(ib & 255) << 8) | ((unsigned)(ic & 255) << 16) | ((unsigned)(id & 255) << 24);
}
template <bool I8>
DI void unit_quant_rows(const float* __restrict__ src, unsigned char* __restrict__ dst, float* __restrict__ scale, int u) {
  const int t = threadIdx.x + opaque0(), lane = t & 63, w = t >> 6;
#pragma unroll
  for (int rr = 0; rr < 2; ++rr) {
    const size_t row = (size_t)u * 8 + 2 * w + rr;
    const float* s = src + row * DM + 16 * lane;
    f32x4 v[4];
    float amax = 0.f;
#pragma unroll
    for (int i = 0; i < 4; ++i) { v[i] = *(const f32x4*)(s + 4 * i); amax = fmaxf(amax, fmaxf(fmaxf(fabsf(v[i][0]), fabsf(v[i][1])), fmaxf(fabsf(v[i][2]), fabsf(v[i][3])))); }
#pragma unroll
    for (int o = 32; o >= 1; o >>= 1) amax = fmaxf(amax, __shfl_xor(amax, o));
    const float sc = amax > 0.f ? amax * (I8 ? 1.f / 127.f : 1.f / 440.f) : 1.f, inv = 1.f / sc;
    u32x4 q;
#pragma unroll
    for (int i = 0; i < 4; ++i) {
      if (I8) {
        q[i] = pack_i8(v[i][0] * inv, v[i][1] * inv, v[i][2] * inv, v[i][3] * inv);
      } else {
        int wd = 0;
        wd = __builtin_amdgcn_cvt_pk_fp8_f32(v[i][0] * inv, v[i][1] * inv, wd, false);
        wd = __builtin_amdgcn_cvt_pk_fp8_f32(v[i][2] * inv, v[i][3] * inv, wd, true);
        q[i] = (unsigned)wd;
      }
    }
    *(u32x4*)(dst + row * DM + 16 * lane) = q;
    if (lane == 0) scale[row] = sc;
  }
}
DI void unit_copy_f4(const float* __restrict__ src, float* __restrict__ dst, int n4) {
  for (int i = threadIdx.x + opaque0(); i < n4; i += NTHREADS) ((f32x4*)dst)[i] = ((const f32x4*)src)[i];
}

DI void phase0_unit(const P& p, int u, char* smem) {
  if (u < U0_E0) { unit_mod(p, u, smem); }
  else if (u < U0_E1) { const int v = u - U0_E0; unit_transpose(p.w_in, w_Wt_in(p), 1024, INW, v / 60, v % 60, smem); }
  else if (u < U0_E2) { const int v = u - U0_E1; unit_transpose(p.w_out, w_Wt_out(p), 1024, 1024, v / 16, v % 16, smem); }
  else if (u < U0_E3) { const int v = u - U0_E2; unit_transpose(p.w_query, w_Wt_q(p), 1024, 2048, v / 32, v % 32, smem); }
  else if (u < U0_E4) { const int v = u - U0_E3, g = v >> 3, tt = v & 7; unit_transpose(p.pool_w + (size_t)g * 128 * 256, w_PWt(p) + (size_t)g * 256 * 128, 128, 256, tt >> 2, tt & 3, smem); }
  else if (u < U0_E5) { unit_convert(p.sub_keys, w_SK(p), u - U0_E4); }
  else if (u < U0_E6) { unit_quant_rows<true>(p.peer_u, w_Ub(p), w_SU(p), u - U0_E5); }
  else if (u < U0_E7) { unit_quant_rows<false>(p.peer_v, w_Vb(p), w_SV(p), u - U0_E6); }
  else if (u < U0_E8) { const int b = u - U0_E7; unit_copy_f4(p.cache_k + ((size_t)b * 128 + 1) * 128, p.out + O_KWS + (size_t)b * 128 * 128, 127 * 128 / 4); }
  else if (u < U0_E9) { const int b = u - U0_E8; unit_copy_f4(p.cache_v + ((size_t)b * 128 + 1) * 128, p.out + O_VWS + (size_t)b * 128 * 128, 127 * 128 / 4); }
  else if (u < U0_E10) { const int b = u - U0_E9; unit_copy_f4(p.state_pool + ((size_t)b * 15 + 1) * 512, p.out + O_PS + (size_t)b * 15 * 512, 14 * 512 / 4); }
  else {
    for (int i = threadIdx.x + opaque0(); i < 16 * 128; i += NTHREADS) {
      const int head = i >> 7, d = i & 127;
      int bk = d;
      if (d >= 16) { bk = 16 + (int)(logf((float)d / 16.f) / logf(8.f) * 16.f); bk = bk > 31 ? 31 : bk; }
      w_BIAS(p)[i] = p.rel_table[bk * 16 + head];
    }
  }
}

DI void norm_row(const P& p, int token, int which) {
  const int lane = (threadIdx.x + opaque0()) & 63;
  const float* src = which == 0 ? xrow(p, token) : w_X1(p) + (size_t)token * DM;
  const float* g = which == 0 ? p.norm1_g : p.norm2_g;
  const float* mod = w_MOD(p) + (size_t)cond_row(token) * 6144 + (which == 0 ? 0 : 3072);
  f32x4 v[4];
  float ss = 0.f;
#pragma unroll
  for (int i = 0; i < 4; ++i) { v[i] = *(const f32x4*)(src + 4 * lane + 256 * i); ss += v[i][0] * v[i][0] + v[i][1] * v[i][1] + v[i][2] * v[i][2] + v[i][3] * v[i][3]; }
  ss = wave_sum(ss);
  const float rstd = rsqrtf(ss * (1.f / DM) + EPS);
#pragma unroll
  for (int i = 0; i < 4; ++i) {
    const int c = 4 * lane + 256 * i;
    const f32x4 gg = *(const f32x4*)(g + c), sh = *(const f32x4*)(mod + c), sc = *(const f32x4*)(mod + 1024 + c);
    bf16x4 o;
#pragma unroll
    for (int j = 0; j < 4; ++j) { v[i][j] = (v[i][j] * rstd * gg[j]) * (1.f + sc[j]) + sh[j]; o[j] = (bf16)v[i][j]; }
    *(bf16x4*)(w_H(p) + (size_t)token * DM + c) = o;
  }
  if (which == 1) {
    float amax = 0.f;
#pragma unroll
    for (int i = 0; i < 4; ++i) amax = fmaxf(amax, fmaxf(fmaxf(fabsf(v[i][0]), fabsf(v[i][1])), fmaxf(fabsf(v[i][2]), fabsf(v[i][3]))));
#pragma unroll
    for (int o = 32; o >= 1; o >>= 1) amax = fmaxf(amax, __shfl_xor(amax, o));
    const float qs = amax > 0.f ? amax * (1.f / 127.f) : 1.f, inv = 1.f / qs;
#pragma unroll
    for (int i = 0; i < 4; ++i) *(unsigned*)(w_H8(p) + (size_t)token * DM + 4 * lane + 256 * i) = pack_i8(v[i][0] * inv, v[i][1] * inv, v[i][2] * inv, v[i][3] * inv);
    if (lane == 0) w_HS(p)[token] = qs;
  }
}

constexpr int LDSK = 72;
constexpr int GT = 128 * 64 * 2;
constexpr int GBUF = 2 * GT;
typedef __attribute__((address_space(3))) unsigned lds_u32;
typedef const __attribute__((address_space(1))) unsigned glb_u32;
DI void glds16(const void* g, char* l) { __builtin_amdgcn_global_load_lds((glb_u32*)g, (lds_u32*)l, 16, 0, 0); }
DI void gemm_tile(const bf16* __restrict__ Wt, const bf16* __restrict__ X, int K, int n0, int m0, char* smem, f32x16 (&acc)[4]) {
  const int t = threadIdx.x + opaque0(), lane = t & 63, r = lane & 31, h = lane >> 5;
  const int w = __builtin_amdgcn_readfirstlane(t >> 6);
#pragma unroll
  for (int i = 0; i < 4; ++i) acc[i] = zero16();
  const int swz = (lane & 7) ^ ((4 * w + (lane >> 4)) & 7);
  const bf16* ga = Wt + (size_t)(n0 + 8 * w + (lane >> 3)) * K + swz * 8;
  const bf16* gb = X + (size_t)(m0 + 8 * w + (lane >> 3)) * K + swz * 8;
  const int sw = (r >> 1) & 7;
  const int KT = K >> 6;
  __syncthreads();
#pragma unroll
  for (int q = 0; q < 4; ++q) { glds16(ga + (size_t)(32 * q) * K, smem + 1024 * (w + 4 * q)); glds16(gb + (size_t)(32 * q) * K, smem + GT + 1024 * (w + 4 * q)); }
  asm volatile("s_waitcnt vmcnt(0)" ::: "memory");
  __syncthreads();
  for (int kt = 0; kt < KT; ++kt) {
    const char* As = smem + (kt & 1) * GBUF;
    const char* Bs = As + GT;
    if (kt + 1 < KT) {
      char* An = smem + ((kt + 1) & 1) * GBUF;
      const int k0 = (kt + 1) * 64;
#pragma unroll
      for (int q = 0; q < 4; ++q) { glds16(ga + (size_t)(32 * q) * K + k0, An + 1024 * (w + 4 * q)); glds16(gb + (size_t)(32 * q) * K + k0, An + GT + 1024 * (w + 4 * q)); }
    }
#pragma unroll
    for (int s = 0; s < 4; ++s) {
      const int co = ((2 * s + h) ^ sw) * 16;
      const bf16x8 bfr = *(const bf16x8*)(Bs + (32 * w + r) * 128 + co);
#pragma unroll
      for (int i = 0; i < 4; ++i) {
        const bf16x8 afr = *(const bf16x8*)(As + (32 * i + r) * 128 + co);
        acc[i] = MFMA(afr, bfr, acc[i]);
      }
    }
    asm volatile("s_waitcnt vmcnt(0)" ::: "memory");
    __syncthreads();
  }
}

DI float sigmoid_f(float x) { return 1.f / (1.f + __expf(-x)); }

DI void unit_gemm1(const P& p, int u, char* smem) {
  const int mt = u / 30, nt = u % 30;
  const int n0 = nt * 128, m0 = mt * 128;
  f32x16 acc[4];
  gemm_tile(w_Wt_in(p), w_H(p), 1024, n0, m0, smem, acc);
  const int tz = threadIdx.x + opaque0();
  const int lane = tz & 63, w = tz >> 6, r = lane & 31, h = lane >> 5;
  const int token = m0 + 32 * w + r;
  bf16* tw = (bf16*)(smem + (tz >> 6) * 16384) + r * 136;
  const bool is_prompt = token < NPR;
  const int b = is_prompt ? (token >> 11) : (token - NPR), pos = token & (SEQ - 1);
  if (n0 < C_V) {
    const float* gn = n0 < C_K ? p.q_norm_g : p.k_norm_g;
    const float post = n0 < C_K ? 0.125f : 1.f;
#pragma unroll
    for (int hh = 0; hh < 2; ++hh) {
      float ss = 0.f;
#pragma unroll
      for (int i = 0; i < 2; ++i)
#pragma unroll
        for (int j = 0; j < 16; ++j) ss += acc[2 * hh + i][j] * acc[2 * hh + i][j];
      ss += __shfl_xor(ss, 32);
      const float rstd = rsqrtf(ss * (1.f / 64.f) + EPS);
#pragma unroll
      for (int i = 0; i < 2; ++i)
#pragma unroll
        for (int q4 = 0; q4 < 4; ++q4) {
          const int d = 32 * i + 8 * q4 + 4 * h;
          const f32x4 gg = *(const f32x4*)(gn + d);
          f32x4 v;
#pragma unroll
          for (int j = 0; j < 4; ++j) v[j] = acc[2 * hh + i][4 * q4 + j] * rstd * gg[j];
          bf16x4 o;
#pragma unroll
          for (int j = 0; j < 4; ++j) o[j] = (bf16)(v[j] * post);
          *(bf16x4*)(tw + 64 * hh + d) = o;
          if (n0 == C_K) {
            if (is_prompt) { if (pos >= SEQ - 128) *(f32x4*)(p.out + O_KWP + ((size_t)b * 128 + (pos - (SEQ - 128))) * 128 + 64 * hh + d) = v; }
            else *(f32x4*)(p.out + O_KWS + ((size_t)b * 128 + 127) * 128 + 64 * hh + d) = v;
          }
        }
    }
  } else if (n0 == C_V) {
#pragma unroll
    for (int i = 0; i < 4; ++i)
#pragma unroll
      for (int q4 = 0; q4 < 4; ++q4) {
        const int f = 32 * i + 8 * q4 + 4 * h;
        f32x4 v;
#pragma unroll
        for (int j = 0; j < 4; ++j) v[j] = acc[i][4 * q4 + j];
        if (is_prompt) {
#pragma unroll
          for (int j = 0; j < 4; ++j) w_VT(p)[((size_t)b * 128 + f + j) * SEQ + pos] = (bf16)v[j];
          if (pos >= SEQ - 128) *(f32x4*)(p.out + O_VWP + ((size_t)b * 128 + (pos - (SEQ - 128))) * 128 + f) = v;
        } else *(f32x4*)(p.out + O_VWS + ((size_t)b * 128 + 127) * 128 + f) = v;
      }
  } else if (n0 < C_GA) {
#pragma unroll
    for (int i = 0; i < 4; ++i)
#pragma unroll
      for (int q4 = 0; q4 < 4; ++q4) {
        const int f = n0 + 32 * i + 8 * q4 + 4 * h;
        f32x4 v; bf16x4 o;
#pragma unroll
        for (int j = 0; j < 4; ++j) { v[j] = acc[i][4 * q4 + j]; o[j] = (bf16)v[j]; }
        *(bf16x4*)(tw + (f - n0)) = o;
        if (is_prompt) { if (pos >= SEQ - 15) *(f32x4*)(p.out + O_PP + ((size_t)b * 15 + (pos - (SEQ - 15))) * 512 + (f - C_PIN)) = v; }
        else *(f32x4*)(p.out + O_PS + ((size_t)b * 15 + 14) * 512 + (f - C_PIN)) = v;
      }
  } else {
#pragma unroll
    for (int i = 0; i < 4; ++i)
#pragma unroll
      for (int q4 = 0; q4 < 4; ++q4) {
        const int f = n0 + 32 * i + 8 * q4 + 4 * h;
        bf16x4 o;
#pragma unroll
        for (int j = 0; j < 4; ++j) o[j] = (bf16)sigmoid_f(acc[i][4 * q4 + j]);
        *(bf16x4*)(tw + (f - n0)) = o;
      }
  }
  if (n0 != C_V) {
    LDS_WAIT();
    const bf16* tr = (const bf16*)(smem + (tz >> 6) * 16384);
    bf16* pg = w_PROJ(p) + (size_t)(m0 + 32 * w + (lane >> 4)) * INW + n0 + (lane & 15) * 8;
#pragma unroll
    for (int it = 0; it < 8; ++it) *(u32x4*)(pg + (size_t)(4 * it) * INW) = *(const u32x4*)(tr + ((lane >> 4) + 4 * it) * 136 + (lane & 15) * 8);
  }
}

constexpr int VTS = 260;
constexpr int RS = 136;
DI void unit_attn_prompt(const P& p, int u, char* smem) {
  const int b = u >> 8, blk = (u >> 4) & 15, head = u & 15, hk = head >> 3;
  const int qpos0 = blk * 128;
  const int t = threadIdx.x + opaque0(), lane = t & 63, w = t >> 6, r = lane & 31, h = lane >> 5;
  bf16* Ks = (bf16*)smem;
  bf16* VTs = Ks + 256 * LDSK;
  float* bs = (float*)(VTs + 64 * VTS);
  bf16* Rs = Ks;
  __syncthreads();
#pragma unroll
  for (int i = 0; i < 8; ++i) {
    const int c = t + 256 * i, row = c >> 3, c16 = c & 7, kp = qpos0 - 128 + row;
    u32x4 v = {0u, 0u, 0u, 0u};
    if (kp >= 0) v = *(const u32x4*)(w_PROJ(p) + ((size_t)b * SEQ + kp) * INW + C_K + hk * 64 + c16 * 8);
    *(u32x4*)(Ks + row * LDSK + c16 * 8) = v;
  }
#pragma unroll
  for (int i = 0; i < 8; ++i) {
    const int c = t + 256 * i, drow = c >> 5, c16 = c & 31, kp0 = qpos0 - 128 + c16 * 8;
    u32x4 v = {0u, 0u, 0u, 0u};
    if (kp0 >= 0) v = *(const u32x4*)(w_VT(p) + ((size_t)(b * 2 + hk) * 64 + drow) * SEQ + kp0);
    u32x2* d2 = (u32x2*)(VTs + drow * VTS + c16 * 8);
    d2[0] = (u32x2){v[0], v[1]}; d2[1] = (u32x2){v[2], v[3]};
  }
  if (t < 192) { const int dist = 159 - t; bs[t] = (dist >= 0 && dist < 128) ? w_BIAS(p)[head * 128 + dist] : 0.f; }
  const int qi = 32 * w + r;
  const size_t tokq = (size_t)b * SEQ + qpos0 + qi;
  bf16x8 qf[4];
#pragma unroll
  for (int s = 0; s < 4; ++s) qf[s] = *(const bf16x8*)(w_PROJ(p) + tokq * INW + head * 64 + 16 * s + 8 * h);
  __syncthreads();
  f32x16 st[5];
#pragma unroll
  for (int tt = 0; tt < 5; ++tt) {
    st[tt] = zero16();
#pragma unroll
    for (int s = 0; s < 4; ++s) {
      const bf16x8 a = *(const bf16x8*)(Ks + (32 * (w + tt) + r) * LDSK + 16 * s + 8 * h);
      st[tt] = MFMA(a, qf[s], st[tt]);
    }
  }
  const float sink = p.sinks[head];
  float m = -INFINITY;
  {
    const int x = 31 - r + 4 * h;
    const float* bl = bs + x;
    const int kbase = blk > 0 ? 1024 : 32 * w + 4 * h;
#pragma unroll
    for (int tt = 0; tt < 5; ++tt)
#pragma unroll
      for (int j = 0; j < 16; ++j) {
        const int c = 32 * tt + (j & 3) + 8 * (j >> 2);
        const bool valid = (x + c >= 32) && (x + c <= 159) && (kbase + c >= 128);
        const float bv = bl[c];
        const float s = valid ? st[tt][j] + bv : -INFINITY;
        st[tt][j] = s;
        m = fmaxf(m, s);
      }
  }
  m = fmaxf(m, __shfl_xor(m, 32));
  m = fmaxf(m, sink);
  float sum = 0.f;
#pragma unroll
  for (int tt = 0; tt < 5; ++tt)
#pragma unroll
    for (int j = 0; j < 16; ++j) { const float e = __expf(st[tt][j] - m); st[tt][j] = e; sum += e; }
  sum += __shfl_xor(sum, 32);
  const float inv = 1.f / (sum + __expf(sink - m));
  f32x16 o[2] = {zero16(), zero16()};
#pragma unroll
  for (int tt = 0; tt < 5; ++tt)
#pragma unroll
    for (int s = 0; s < 2; ++s) {
      const bf16x8 pb = pack_step(st[tt], s);
#pragma unroll
      for (int i = 0; i < 2; ++i) {
        const bf16* vp = VTs + (32 * i + r) * VTS + 32 * (w + tt) + 16 * s + 4 * h;
        const bf16x8 a = cat4(*(const bf16x4*)vp, *(const bf16x4*)(vp + 8));
        o[i] = MFMA(a, pb, o[i]);
      }
    }
  __syncthreads();
  const int g = head >> 2, win = 2 << g;
  {
    const int tk = t >> 4, cc = t & 15;
    const int p0 = qpos0 + tk * 8;
    const bf16* pin = w_PROJ(p) + (size_t)b * SEQ * INW + C_PIN + g * 128 + cc * 8;
    float S[8];
#pragma unroll
    for (int j = 0; j < 8; ++j) S[j] = 0.f;
    for (int i = 0; i < win; ++i) {
      const int pp = p0 - i;
      if (pp >= 0) { const bf16x8 v = *(const bf16x8*)(pin + (size_t)pp * INW);
#pragma unroll
        for (int j = 0; j < 8; ++j) S[j] += bf2f(v[j]); }
    }
    for (int i = 0; i < 8; ++i) {
      const int pos = p0 + i;
      const bf16x8 cur = *(const bf16x8*)(pin + (size_t)pos * INW);
      if (i > 0) {
#pragma unroll
        for (int j = 0; j < 8; ++j) S[j] += bf2f(cur[j]);
        if (pos - win >= 0) { const bf16x8 old = *(const bf16x8*)(pin + (size_t)(pos - win) * INW);
#pragma unroll
          for (int j = 0; j < 8; ++j) S[j] -= bf2f(old[j]); }
      }
      const float icnt = 1.f / (float)(win < pos + 1 ? win : pos + 1);
      bf16x8 rr;
#pragma unroll
      for (int j = 0; j < 8; ++j) rr[j] = (bf16)(S[j] * icnt - bf2f(cur[j]));
      *(bf16x8*)(Rs + (tk * 8 + i) * RS + cc * 8) = rr;
    }
  }
  __syncthreads();
  f32x16 pa[2] = {zero16(), zero16()};
#pragma unroll
  for (int s = 0; s < 8; ++s) {
    const bf16x8 bfr = *(const bf16x8*)(Rs + (32 * w + r) * RS + 16 * s + 8 * h);
#pragma unroll
    for (int i = 0; i < 2; ++i) {
      const bf16x8 a = *(const bf16x8*)(w_PWt(p) + ((size_t)g * 256 + (head & 3) * 64 + 32 * i + r) * 128 + 16 * s + 8 * h);
      pa[i] = MFMA(a, bfr, pa[i]);
    }
  }
  const bf16* prow = w_PROJ(p) + tokq * INW;
#pragma unroll
  for (int i = 0; i < 2; ++i)
#pragma unroll
    for (int q4 = 0; q4 < 4; ++q4) {
      const int f = head * 64 + 32 * i + 8 * q4 + 4 * h;
      const bf16x4 ga = *(const bf16x4*)(prow + C_GA + f), gb = *(const bf16x4*)(prow + C_GB + f);
      const f32x4 ps = *(const f32x4*)(p.pool_scale + f);
      bf16x4 ov;
#pragma unroll
      for (int j = 0; j < 4; ++j) ov[j] = (bf16)(bf2f(ga[j]) * (o[i][4 * q4 + j] * inv) + bf2f(gb[j]) * (pa[i][4 * q4 + j] * ps[j]));
      *(bf16x4*)(w_MIXED(p) + tokq * DM + f) = ov;
    }
}

DI void unit_attn_sample(const P& p, int u, char* smem) {
  const int b = u >> 1, hk = u & 1;
  const int t = threadIdx.x + opaque0(), g8 = t >> 5, l32 = t & 31;
  float* ks = (float*)smem;
  float* vs = ks + 128 * 65;
  float* qs = vs + 128 * 64;
  float* ps = qs + 512;
  float* os = ps + 1024;
  float* rs = os + 512;
  const size_t token = (size_t)NPR + b;
  __syncthreads();
  const float* kw = p.out + O_KWS + (size_t)b * 128 * 128 + hk * 64;
  const float* vw = p.out + O_VWS + (size_t)b * 128 * 128 + hk * 64;
#pragma unroll 4
  for (int i = t; i < 128 * 64; i += NTHREADS) { const int j = i >> 6, d = i & 63; ks[j * 65 + d] = kw[(size_t)j * 128 + d]; vs[j * 64 + d] = vw[(size_t)j * 128 + d]; }
#pragma unroll 1
  for (int i = t; i < 512; i += NTHREADS) qs[i] = bf2f(w_PROJ(p)[token * INW + hk * 512 + i]);
  {
    const int gi = t >> 7, ch = t & 127, g = 2 * hk + gi, win = 2 << g;
    const float cur = p.out[O_PS + ((size_t)b * 15 + 14) * 512 + g * 128 + ch];
    float tot = cur;
#pragma unroll 1
    for (int i = 1; i < win; ++i) tot += p.state_pool[((size_t)b * 15 + 15 - i) * 512 + g * 128 + ch];
    rs[gi * 128 + ch] = tot / (float)win - cur;
  }
  __syncthreads();
  const int head = hk * 8 + g8;
  float s[4];
  float m = p.sinks[head];
#pragma unroll
  for (int i = 0; i < 4; ++i) {
    const int j = l32 + 32 * i;
    float a = 0.f;
#pragma unroll 8
    for (int d = 0; d < 64; ++d) a += qs[g8 * 64 + d] * ks[j * 65 + d];
    s[i] = a + w_BIAS(p)[head * 128 + 127 - j];
    m = fmaxf(m, s[i]);
  }
  for (int o = 16; o >= 1; o >>= 1) m = fmaxf(m, __shfl_xor(m, o));
  float sum = 0.f;
#pragma unroll
  for (int i = 0; i < 4; ++i) { s[i] = __expf(s[i] - m); sum += s[i]; }
  for (int o = 16; o >= 1; o >>= 1) sum += __shfl_xor(sum, o);
  const float inv = 1.f / (sum + __expf(p.sinks[head] - m));
#pragma unroll
  for (int i = 0; i < 4; ++i) ps[g8 * 128 + l32 + 32 * i] = s[i] * inv;
  __syncthreads();
#pragma unroll
  for (int i = 0; i < 2; ++i) {
    const int d = l32 + 32 * i;
    float a = 0.f;
#pragma unroll 8
    for (int j = 0; j < 128; ++j) a += ps[g8 * 128 + j] * vs[j * 64 + d];
    os[g8 * 64 + d] = a;
  }
  __syncthreads();
#pragma unroll
  for (int i = 0; i < 2; ++i) {
    const int fl = t + 256 * i, f = hk * 512 + fl, g = f >> 8, gi = g - 2 * hk, oc = f & 255;
    float pl = 0.f;
    const float* pw = p.pool_w + (size_t)g * 128 * 256 + oc;
#pragma unroll 8
    for (int ch = 0; ch < 128; ++ch) pl += rs[gi * 128 + ch] * pw[(size_t)ch * 256];
    pl *= p.pool_scale[f];
    const float ga = bf2f(w_PROJ(p)[token * INW + C_GA + f]), gb = bf2f(w_PROJ(p)[token * INW + C_GB + f]);
    w_MIXED(p)[token * DM + f] = (bf16)(ga * os[fl] + gb * pl);
  }
}

DI void unit_gemm2(const P& p, int u, char* smem) {
  const int mt = u >> 3, nt = u & 7;
  const int n0 = nt * 128, m0 = mt * 128;
  f32x16 acc[4];
  gemm_tile(w_Wt_out(p), w_MIXED(p), 1024, n0, m0, smem, acc);
  const int tz = threadIdx.x + opaque0();
  const int lane = tz & 63, w = tz >> 6, r = lane & 31, h = lane >> 5;
  const int token = m0 + 32 * w + r;
  const float* xr = xrow(p, token);
  const float* g1 = w_MOD(p) + (size_t)cond_row(token) * 6144 + 2048;
#pragma unroll
  for (int i = 0; i < 4; ++i)
#pragma unroll
    for (int q4 = 0; q4 < 4; ++q4) {
      const int f = n0 + 32 * i + 8 * q4 + 4 * h;
      const f32x4 xv = *(const f32x4*)(xr + f), gv = *(const f32x4*)(g1 + f);
      f32x4 o;
#pragma unroll
      for (int j = 0; j < 4; ++j) o[j] = xv[j] + gv[j] * acc[i][4 * q4 + j];
      *(f32x4*)(w_X1(p) + (size_t)token * DM + f) = o;
    }
}

DI unsigned f2ord(float f) { const unsigned u = __float_as_uint(f); return (u & 0x80000000u) ? ~u : (u | 0x80000000u); }
DI float ord2f(unsigned u) { return __uint_as_float((u & 0x80000000u) ? (u & 0x7fffffffu) : ~u); }
DI unsigned umin_(unsigned a, unsigned b) { return a < b ? a : b; }
DI unsigned umax_(unsigned a, unsigned b) { return a > b ? a : b; }
template <int OFF> DI void sort16_desc(unsigned (&a)[64]) {
#pragma unroll
  for (int lk = 1; lk <= 4; ++lk)
#pragma unroll
    for (int lj = lk - 1; lj >= 0; --lj)
#pragma unroll
      for (int i = 0; i < 16; ++i) {
        const int k = 1 << lk, j = 1 << lj, l = i ^ j;
        if (l > i) {
          const unsigned lo = umin_(a[OFF + i], a[OFF + l]), hi = umax_(a[OFF + i], a[OFF + l]);
          const bool desc = (i & k) == 0;
          a[OFF + i] = desc ? hi : lo; a[OFF + l] = desc ? lo : hi;
        }
      }
}
DI void merge16_desc(unsigned (&a)[16]) {
#pragma unroll
  for (int lj = 3; lj >= 0; --lj)
#pragma unroll
    for (int i = 0; i < 16; ++i) {
      const int j = 1 << lj, l = i ^ j;
      if (l > i) { const unsigned lo = umin_(a[i], a[l]), hi = umax_(a[i], a[l]); a[i] = hi; a[l] = lo; }
    }
}
DI void top16_of_64(unsigned (&a)[64], unsigned (&out)[16]) {
  sort16_desc<0>(a); sort16_desc<16>(a); sort16_desc<32>(a); sort16_desc<48>(a);
  unsigned x[16], y[16];
#pragma unroll
  for (int i = 0; i < 16; ++i) { x[i] = umax_(a[i], a[31 - i]); y[i] = umax_(a[32 + i], a[63 - i]); }
  merge16_desc(x); merge16_desc(y);
#pragma unroll
  for (int i = 0; i < 16; ++i) out[i] = umax_(x[i], y[15 - i]);
  merge16_desc(out);
}
__device__ constexpr int COFF[16] = {0, 16, 24, 29, 33, 36, 38, 40, 42, 43, 44, 45, 46, 47, 48, 49};
DI unsigned umax3(unsigned a, unsigned b, unsigned c) { const unsigned m = a > b ? a : b; return m > c ? m : c; }

DI void unit_peer_route(const P& p, int u, char* smem) {
  const int mt = u >> 3, hd = u & 7;
  const int m0 = mt * 128;
  const int t = threadIdx.x + opaque0(), lane = t & 63, w = t >> 6, r = lane & 31, h = lane >> 5;
  unsigned char* myidx = (unsigned char*)smem + 2 * GBUF + t * 32;
  unsigned top[2][16];
#pragma unroll
  for (int pp = 0; pp < 2; ++pp) {
    f32x16 acc[4];
    gemm_tile(w_Wt_q(p), w_H(p), 1024, hd * 256 + pp * 128, m0, smem, acc);
    f32x16 sc[4] = {zero16(), zero16(), zero16(), zero16()};
    {
      const bf16* skb = w_SK(p) + (size_t)(hd * 2 + pp) * 128 * 128;
      const int wu = __builtin_amdgcn_readfirstlane(w);
#pragma unroll
      for (int q = 0; q < 8; ++q) {
        const int j = wu + 4 * q, row = 4 * j + (lane >> 4);
        glds16(skb + (size_t)row * 128 + (((lane & 15) ^ (row & 15)) * 8), smem + 1024 * j);
      }
      asm volatile("s_waitcnt vmcnt(0)" ::: "memory");
      __syncthreads();
    }
    bf16x8 bqs[8];
#pragma unroll
    for (int i = 0; i < 4; ++i)
#pragma unroll
      for (int s = 0; s < 2; ++s) bqs[2 * i + s] = pack_step(acc[i], s);
#pragma unroll
    for (int i = 0; i < 4; ++i)
#pragma unroll
      for (int s = 0; s < 2; ++s) {
        const bf16x8 bq = bqs[2 * i + s];
#pragma unroll
        for (int kt = 0; kt < 4; ++kt) {
          const int row = 32 * kt + r, cc = 4 * i + 2 * s;
          const char* rp = smem + row * 256 + 8 * h;
          const bf16x8 a = cat4(*(const bf16x4*)(rp + ((cc ^ (row & 15)) * 16)), *(const bf16x4*)(rp + (((cc + 1) ^ (row & 15)) * 16)));
          sc[kt] = MFMA(a, bq, sc[kt]);
        }
      }
    unsigned pk[64];
#pragma unroll
    for (int kt = 0; kt < 4; ++kt)
#pragma unroll
      for (int j = 0; j < 16; ++j) { const int key = 32 * kt + crow(j, h); pk[kt * 16 + j] = (f2ord(sc[kt][j]) & ~127u) | (unsigned)(127 - key); }
    unsigned mine[16];
    top16_of_64(pk, mine);
#pragma unroll
    for (int i = 0; i < 16; ++i) top[pp][i] = (unsigned)__shfl_xor((int)mine[15 - i], 32);
#pragma unroll
    for (int i = 0; i < 16; ++i) top[pp][i] = umax_(top[pp][i], mine[i]);
    merge16_desc(top[pp]);
  }
  float v0[16], v1[16];
#pragma unroll
  for (int a = 0; a < 16; ++a) {
    v0[a] = ord2f(top[0][a] & ~127u); v1[a] = ord2f(top[1][a] & ~127u);
    myidx[a] = (unsigned char)(127u - (top[0][a] & 127u)); myidx[16 + a] = (unsigned char)(127u - (top[1][a] & 127u));
  }
  unsigned cand[64];
#pragma unroll
  for (int i = 50; i < 64; ++i) cand[i] = 0u;
#pragma unroll
  for (int a = 0; a < 16; ++a)
#pragma unroll
    for (int bb = 0; bb < 16 / (a + 1); ++bb)
      cand[COFF[a] + bb] = (f2ord(v0[a] + v1[bb]) & ~255u) | (unsigned)(255 - (a * 16 + bb));
  unsigned best[16];
  top16_of_64(cand, best);
  const float smax = ord2f(best[0] & ~255u);
  float e[16], esum = 0.f;
#pragma unroll
  for (int i = 0; i < 16; ++i) { e[i] = __expf(ord2f(best[i] & ~255u) - smax); esum += e[i]; }
  const float einv = 1.f / esum;
  const size_t token = (size_t)m0 + 32 * w + r;
  int* ip = w_IDX(p) + token * 128 + hd * 16 + 8 * h;
  float* gp = w_GATE(p) + token * 128 + hd * 16 + 8 * h;
  const unsigned hmask = 0u - (unsigned)h;
#pragma unroll
  for (int i = 0; i < 8; ++i) {
    const unsigned bsel = best[i] ^ ((best[i] ^ best[8 + i]) & hmask);
    const float esel = __uint_as_float(__float_as_uint(e[i]) ^ ((__float_as_uint(e[i]) ^ __float_as_uint(e[8 + i])) & hmask));
    const unsigned code = 255u - (bsel & 255u);
    const int a = code >> 4, bb = code & 15;
    ip[i] = (int)myidx[a] * 128 + (int)myidx[16 + bb];
    gp[i] = esel * einv;
  }
}

DI float gelu_fast(float v) {
  const float av = fabsf(v), tt = __builtin_amdgcn_rcpf(av * 0.2316418882f + 1.0f);
  float q = tt * 0.5307027145f - 0.7265760135f; q = q * tt + 0.7107068705f; q = q * tt - 0.142248368f; q = q * tt + 0.127414796f; q = q * tt;
  const float e = __builtin_amdgcn_exp2f(v * v * -0.72134752044f);
  const float m = v * (q * e);
  return v < 0.f ? m : v - m;
}
DI float dot2bf(unsigned a, unsigned b, float acc) { return __builtin_amdgcn_fdot2_f32_bf16(__builtin_bit_cast(bf16x2, a), __builtin_bit_cast(bf16x2, b), acc, false); }
DI unsigned pkbf(f32x2 v) { bf16x2 r; r[0] = (bf16)v[0]; r[1] = (bf16)v[1]; return __builtin_bit_cast(unsigned, r); }
DI int dot16i(u32x4 u8, u32x4 x8, int d) {
#pragma unroll
  for (int m = 0; m < 4; ++m) d = __builtin_amdgcn_sdot4((int)u8[m], (int)x8[m], d, false);
  return d;
}
DI void axpy16p(f32x2* o, u32x4 v8, f32x2 c2) {
#pragma unroll
  for (int m = 0; m < 4; ++m) {
    const int wd = (int)v8[m];
    o[2 * m] = __builtin_elementwise_fma(c2, __builtin_amdgcn_cvt_pk_f32_fp8(wd, false), o[2 * m]);
    o[2 * m + 1] = __builtin_elementwise_fma(c2, __builtin_amdgcn_cvt_pk_f32_fp8(wd, true), o[2 * m + 1]);
  }
}
DI int dpp_add16i(int v) {
  v += __builtin_amdgcn_update_dpp(0, v, 0x140, 0xf, 0xf, true);
  v += __builtin_amdgcn_update_dpp(0, v, 0x141, 0xf, 0xf, true);
  v += __builtin_amdgcn_update_dpp(0, v, 0x4e, 0xf, 0xf, true);
  v += __builtin_amdgcn_update_dpp(0, v, 0xb1, 0xf, 0xf, true);
  return v;
}
DI float dot16(u32x4 u8, u32x4 xlo, u32x4 xhi, float d) {
#pragma unroll
  for (int m = 0; m < 4; ++m) {
    const int wd = (int)u8[m];
    const unsigned p01 = pkbf(__builtin_amdgcn_cvt_pk_f32_fp8(wd, false)), p23 = pkbf(__builtin_amdgcn_cvt_pk_f32_fp8(wd, true));
    const unsigned x01 = m < 2 ? xlo[2 * m] : xhi[2 * m - 4], x23 = m < 2 ? xlo[2 * m + 1] : xhi[2 * m - 3];
    d = dot2bf(p01, x01, d); d = dot2bf(p23, x23, d);
  }
  return d;
}
DI void axpy16(float* o, u32x4 v8, float c) {
#pragma unroll
  for (int m = 0; m < 4; ++m) {
    const int wd = (int)v8[m];
    const f32x2 a = __builtin_amdgcn_cvt_pk_f32_fp8(wd, false), b = __builtin_amdgcn_cvt_pk_f32_fp8(wd, true);
    o[4 * m] += c * a[0]; o[4 * m + 1] += c * a[1]; o[4 * m + 2] += c * b[0]; o[4 * m + 3] += c * b[1];
  }
}
DI float reduce4(const float (&d)[4], int lane) {
  const int h = lane >> 5, b4 = (lane >> 4) & 1;
  float a0 = h ? d[2] : d[0], a1 = h ? d[3] : d[1];
  const float s0 = h ? d[0] : d[2], s1 = h ? d[1] : d[3];
  a0 += __shfl_xor(s0, 32); a1 += __shfl_xor(s1, 32);
  float k = b4 ? a1 : a0;
  const float s = b4 ? a0 : a1;
  k += __shfl_xor(s, 16);
  k += __shfl_xor(k, 8); k += __shfl_xor(k, 4); k += __shfl_xor(k, 2); k += __shfl_xor(k, 1);
  return k;
}
DI float dpp_add16(float v) {
  v += __int_as_float(__builtin_amdgcn_update_dpp(0, __float_as_int(v), 0x140, 0xf, 0xf, true));
  v += __int_as_float(__builtin_amdgcn_update_dpp(0, __float_as_int(v), 0x141, 0xf, 0xf, true));
  v += __int_as_float(__builtin_amdgcn_update_dpp(0, __float_as_int(v), 0x4e, 0xf, 0xf, true));
  v += __int_as_float(__builtin_amdgcn_update_dpp(0, __float_as_int(v), 0xb1, 0xf, 0xf, true));
  return v;
}
constexpr int PEER_GLDS = 512 + 128 * 16;
constexpr int PEER_WLDS = 4 * PEER_GLDS;
DI void peer_wave4(const P& p, int g, char* wl) {
  const int lane = (threadIdx.x + opaque0()) & 63, q = lane >> 4, j16 = lane & 15;
  unsigned* hist = (unsigned*)(wl + q * PEER_GLDS);
  u32x4* list = (u32x4*)(wl + q * PEER_GLDS + 512);
  const int token = 4 * g + q;
  u32x4 x[4];
  {
    const unsigned char* hrow = w_H8(p) + (size_t)token * DM + 16 * j16;
#pragma unroll
    for (int i = 0; i < 4; ++i) x[i] = *(const u32x4*)(hrow + 256 * i);
  }
  const float xs = w_HS(p)[token];
  {
    int ids[8]; float gts[8], su[8];
#pragma unroll
    for (int i = 0; i < 8; ++i) { const size_t o = (size_t)token * 128 + j16 + 16 * i; ids[i] = w_IDX(p)[o]; gts[i] = w_GATE(p)[o]; }
#pragma unroll
    for (int i = 0; i < 8; ++i) { su[i] = w_SU(p)[ids[i]] * xs; gts[i] *= w_SV(p)[ids[i]]; }
    LDS_WAIT();
    *(u32x4*)(hist + 8 * j16) = (u32x4){0u, 0u, 0u, 0u}; *(u32x4*)(hist + 8 * j16 + 4) = (u32x4){0u, 0u, 0u, 0u};
    LDS_WAIT();
#pragma unroll
    for (int i = 0; i < 8; ++i) (void)__hip_atomic_fetch_add(&hist[ids[i] >> 7], 1u, __ATOMIC_RELAXED, __HIP_MEMORY_SCOPE_WAVEFRONT);
    LDS_WAIT();
    const u32x4 ca = *(const u32x4*)(hist + 8 * j16), cb = *(const u32x4*)(hist + 8 * j16 + 4);
    const unsigned tot = ca[0] + ca[1] + ca[2] + ca[3] + cb[0] + cb[1] + cb[2] + cb[3];
    unsigned scan = tot;
#pragma unroll
    for (int o = 1; o < 16; o <<= 1) { const unsigned tv = (unsigned)__shfl_up((int)scan, o, 16); if (j16 >= o) scan += tv; }
    unsigned e0 = scan - tot;
    u32x4 pa, pb;
    pa[0] = e0; e0 += ca[0]; pa[1] = e0; e0 += ca[1]; pa[2] = e0; e0 += ca[2]; pa[3] = e0; e0 += ca[3];
    pb[0] = e0; e0 += cb[0]; pb[1] = e0; e0 += cb[1]; pb[2] = e0; e0 += cb[2]; pb[3] = e0;
    LDS_WAIT();
    *(u32x4*)(hist + 8 * j16) = pa; *(u32x4*)(hist + 8 * j16 + 4) = pb;
    LDS_WAIT();
#pragma unroll
    for (int i = 0; i < 8; ++i) {
      const unsigned pos = __hip_atomic_fetch_add(&hist[ids[i] >> 7], 1u, __ATOMIC_RELAXED, __HIP_MEMORY_SCOPE_WAVEFRONT);
      list[pos] = (u32x4){(unsigned)ids[i], __float_as_uint(su[i]), __float_as_uint(gts[i]), 0u};
    }
    LDS_WAIT();
  }
  const unsigned char* Ub = w_Ub(p) + 16 * j16;
  const unsigned char* Vb = w_Vb(p) + 16 * j16;
  {
    u32x4 uA[4], uB[4];
    u32x4 eA = list[0], eB = list[1];
#pragma unroll
    for (int i = 0; i < 4; ++i) uA[i] = *(const u32x4*)(Ub + (size_t)eA[0] * DM + 256 * i);
#pragma unroll
    for (int i = 0; i < 4; ++i) uB[i] = *(const u32x4*)(Ub + (size_t)eB[0] * DM + 256 * i);
#define PEER_USTEP(U, E, K)                                                                                            \
    {                                                                                                                  \
      const float su = __uint_as_float(E[1]), gsv = __uint_as_float(E[2]);                                             \
      int d0 = 0, d1 = 0;                                                                                              \
      d0 = dot16i(U[0], x[0], d0); d1 = dot16i(U[1], x[1], d1); d0 = dot16i(U[2], x[2], d0); d1 = dot16i(U[3], x[3], d1); \
      E = list[(K) + 2 < 128 ? (K) + 2 : 127];                       \
      _Pragma("unroll") for (int i = 0; i < 4; ++i) U[i] = *(const u32x4*)(Ub + (size_t)E[0] * DM + 256 * i);          \
      const float c = gsv * gelu_fast(su * (float)dpp_add16i(d0 + d1));                                                \
      if (j16 == 0) ((float*)&list[K])[3] = c;                                                                          \
    }
#pragma unroll 1
    for (int k = 0; k < 128; k += 2) {
      PEER_USTEP(uA, eA, k)
      PEER_USTEP(uB, eB, k + 1)
    }
  }
  LDS_WAIT();
  f32x2 acc[32];
#pragma unroll
  for (int i = 0; i < 32; ++i) acc[i] = (f32x2){0.f, 0.f};
  {
    u32x4 vA[4], vB[4];
    u32x4 eA = list[0], eB = list[1];
#pragma unroll
    for (int i = 0; i < 4; ++i) vA[i] = *(const u32x4*)(Vb + (size_t)eA[0] * DM + 256 * i);
#pragma unroll
    for (int i = 0; i < 4; ++i) vB[i] = *(const u32x4*)(Vb + (size_t)eB[0] * DM + 256 * i);
#define PEER_VSTEP(V, E, K)                                                                                            \
    {                                                                                                                  \
      const float c = __uint_as_float(E[3]);                                                                           \
      const f32x2 c2 = {c, c};                                                                                         \
      _Pragma("unroll") for (int i = 0; i < 4; ++i) axpy16p(acc + 8 * i, V[i], c2);                                    \
      E = list[(K) + 2 < 128 ? (K) + 2 : 127];                                                                         \
      _Pragma("unroll") for (int i = 0; i < 4; ++i) V[i] = *(const u32x4*)(Vb + (size_t)E[0] * DM + 256 * i);          \
    }
#pragma unroll 1
    for (int k = 0; k < 128; k += 2) {
      PEER_VSTEP(vA, eA, k)
      PEER_VSTEP(vB, eB, k + 1)
    }
  }
  const float* x1 = w_X1(p) + (size_t)token * DM + 16 * j16;
  const float* g2 = w_MOD(p) + (size_t)cond_row(token) * 6144 + 5120 + 16 * j16;
  float* y = p.out + O_YP + (size_t)token * DM + 16 * j16;
#pragma unroll
  for (int i = 0; i < 4; ++i)
#pragma unroll
    for (int mm = 0; mm < 4; ++mm) {
      const int c0 = 256 * i + 4 * mm;
      const f32x4 xv = *(const f32x4*)(x1 + c0), gv = *(const f32x4*)(g2 + c0);
      f32x4 yv;
#pragma unroll
      for (int j = 0; j < 4; ++j) yv[j] = xv[j] + gv[j] * acc[8 * i + 2 * mm + (j >> 1)][j & 1];
      *(f32x4*)(y + c0) = yv;
    }
}
DI void peer_token_block(const P& p, int token, char* smem) {
  const int t = threadIdx.x + opaque0(), lane = t & 63, w = t >> 6;
  float* red = (float*)smem;
  const u32x4 x8 = *(const u32x4*)(w_H8(p) + (size_t)token * DM + 16 * lane);
  const int myid = w_IDX(p)[(size_t)token * 128 + 32 * w + (lane & 31)];
  const float mysu = w_SU(p)[myid] * w_HS(p)[token];
  const float mygs = w_GATE(p)[(size_t)token * 128 + 32 * w + (lane & 31)] * w_SV(p)[myid];
  float o[16];
#pragma unroll
  for (int i = 0; i < 16; ++i) o[i] = 0.f;
#pragma unroll 1
  for (int e0 = 0; e0 < 32; e0 += 4) {
    u32x4 u8[4], v8[4];
#pragma unroll
    for (int qq = 0; qq < 4; ++qq) {
      const size_t ro = (size_t)__builtin_amdgcn_readlane(myid, e0 + qq) * DM + 16 * lane;
      u8[qq] = *(const u32x4*)(w_Ub(p) + ro); v8[qq] = *(const u32x4*)(w_Vb(p) + ro);
    }
    float d[4];
#pragma unroll
    for (int qq = 0; qq < 4; ++qq) d[qq] = (float)dot16i(u8[qq], x8, 0);
    const float kv = reduce4(d, lane);
#pragma unroll
    for (int qq = 0; qq < 4; ++qq) {
      const float a = __int_as_float(__builtin_amdgcn_readlane(__float_as_int(kv), 16 * qq)) * __int_as_float(__builtin_amdgcn_readlane(__float_as_int(mysu), e0 + qq));
      const float c = __int_as_float(__builtin_amdgcn_readlane(__float_as_int(mygs), e0 + qq)) * gelu_fast(a);
      axpy16(o, v8[qq], c);
    }
  }
  __syncthreads();
#pragma unroll
  for (int i = 0; i < 16; ++i) red[w * 1024 + 16 * lane + i] = o[i];
  __syncthreads();
  if (w == 0) {
    const float* x1 = w_X1(p) + (size_t)token * DM + 16 * lane;
    const float* g2 = w_MOD(p) + (size_t)cond_row(token) * 6144 + 5120 + 16 * lane;
    float* y = p.out + O_YP + (size_t)token * DM + 16 * lane;
#pragma unroll
    for (int mm = 0; mm < 4; ++mm) {
      const f32x4 xv = *(const f32x4*)(x1 + 4 * mm), gv = *(const f32x4*)(g2 + 4 * mm);
      f32x4 yv;
#pragma unroll
      for (int j = 0; j < 4; ++j) { const int c = 16 * lane + 4 * mm + j; yv[j] = xv[j] + gv[j] * (red[c] + red[1024 + c] + red[2048 + c] + red[3072 + c]); }
      *(f32x4*)(y + 4 * mm) = yv;
    }
  }
}

constexpr int NPHASE = 8;
template <int PH> DI void run_phase(const P& p, char* smem) {
  const int G = gridDim.x, bid = blockIdx.x, w = __builtin_amdgcn_readfirstlane(threadIdx.x >> 6);
  if constexpr (PH == 0) { for (int u = bid; u < U0_TOTAL; u += G) phase0_unit(p, u, smem); }
  if constexpr (PH == 1) { for (int tk = bid * 4 + w; tk < NTOK; tk += G * 4) norm_row(p, tk, 0); }
  if constexpr (PH == 2) { for (int u = bid; u < 129 * 30; u += G) unit_gemm1(p, u, smem); }
  if constexpr (PH == 3) { for (int u = bid; u < 2048; u += G) unit_attn_prompt(p, u, smem);
                           for (int u = bid; u < 256; u += G) unit_attn_sample(p, u, smem); }
  if constexpr (PH == 4) { for (int u = bid; u < 129 * 8; u += G) unit_gemm2(p, u, smem); }
  if constexpr (PH == 5) { for (int tk = bid * 4 + w; tk < NTOK; tk += G * 4) norm_row(p, tk, 1); }
  if constexpr (PH == 6) { for (int u = bid; u < 129 * 8; u += G) unit_peer_route(p, u, smem); }
  if constexpr (PH == 7) {
    for (int g = bid * 4 + w; g < NPR / 4; g += G * 4) peer_wave4(p, g, smem + w * PEER_WLDS);
    for (int s = bid; s < NS; s += G) peer_token_block(p, NPR + s, smem + 4 * PEER_WLDS);
  }
}
#if ONE_LAUNCH
__global__ void __launch_bounds__(NTHREADS, 2) mega(P p) {
  __shared__ __attribute__((aligned(16))) char smem[SMEM_BYTES + 16];
  volatile unsigned* st = (volatile unsigned*)(smem + SMEM_BYTES);
  if (threadIdx.x == 0) { st[0] = 0u; st[1] = 0u; }
  __syncthreads();
  const unsigned xcc = xb_xcc_id();
  if (threadIdx.x == 0) (void)xb_add(&w_bar(p)[XB_XCNT(xcc)], 1u);
#ifndef REPEAT_MASK
#define REPEAT_MASK 0
#endif
#define RUN_PH(k) do { run_phase<k>(p, smem); if ((REPEAT_MASK >> k) & 1) { xcd_barrier(w_bar(p), xcc, st); run_phase<k>(p, smem); } } while (0)
  RUN_PH(0); xcd_barrier(w_bar(p), xcc, st);
  RUN_PH(1); xcd_barrier(w_bar(p), xcc, st);
  RUN_PH(2); xcd_barrier(w_bar(p), xcc, st);
  RUN_PH(3); xcd_barrier(w_bar(p), xcc, st);
  RUN_PH(4); xcd_barrier(w_bar(p), xcc, st);
  RUN_PH(5); xcd_barrier(w_bar(p), xcc, st);
  RUN_PH(6); xcd_barrier(w_bar(p), xcc, st);
  RUN_PH(7);
}
#else
template <int PH> __global__ void __launch_bounds__(NTHREADS, 2) mega(P p) {
  __shared__ __attribute__((aligned(16))) char smem[SMEM_BYTES];
  run_phase<PH>(p, smem);
}
#endif


extern "C" void kernel_launch(void* const* d_in, const int* in_sizes, int n_in, void* d_out, int out_size, void* d_ws, size_t ws_size, hipStream_t stream) {
  P p{};
  const float* const* in = (const float* const*)d_in;
  p.x_prompt = in[0]; p.x_sample = in[1]; p.cache_k = in[2]; p.cache_v = in[3]; p.state_pool = in[4]; p.c_prompt = in[5]; p.c_sample = in[6];
  p.rel_table = in[7]; p.ada_w = in[8]; p.ada_b = in[9]; p.norm1_g = in[10]; p.w_in = in[11]; p.q_norm_g = in[12]; p.k_norm_g = in[13]; p.sinks = in[14];
  p.pool_w = in[15]; p.pool_scale = in[16]; p.w_out = in[17]; p.norm2_g = in[18]; p.w_query = in[19]; p.sub_keys = in[20]; p.peer_u = in[21]; p.peer_v = in[22];
  p.out = (float*)d_out;
  p.ws = (char*)d_ws;
  if (WS_NEED > ws_size) { fprintf(stderr, "workspace too small: need %zu have %zu\n", (size_t)WS_NEED, ws_size); return; }

  static int grid_blocks = 0;
  if (!grid_blocks) {
    int dev = 0, cus = 0, per_cu = 0;
    (void)hipGetDevice(&dev);
    (void)hipDeviceGetAttribute(&cus, hipDeviceAttributeMultiprocessorCount, dev);
#if ONE_LAUNCH
    (void)hipOccupancyMaxActiveBlocksPerMultiprocessor(&per_cu, mega, NTHREADS, 0);
#else
    per_cu = 2;
#endif
    if (per_cu > 2) per_cu = 2;
    if (per_cu < 1) per_cu = 1;
    if (cus < 1) cus = 256;
    grid_blocks = cus * per_cu;
  }
#if ONE_LAUNCH
  (void)hipMemsetAsync(p.ws + OFF_BAR, 0, XCD_BAR_WORDS * 4, stream);
  hipLaunchKernelGGL(mega, dim3(grid_blocks), dim3(NTHREADS), 0, stream, p);
#else
  hipLaunchKernelGGL(mega<0>, dim3(grid_blocks), dim3(NTHREADS), 0, stream, p);
  hipLaunchKernelGGL(mega<1>, dim3(grid_blocks), dim3(NTHREADS), 0, stream, p);
  hipLaunchKernelGGL(mega<2>, dim3(grid_blocks), dim3(NTHREADS), 0, stream, p);
  hipLaunchKernelGGL(mega<3>, dim3(grid_blocks), dim3(NTHREADS), 0, stream, p);
  hipLaunchKernelGGL(mega<4>, dim3(grid_blocks), dim3(NTHREADS), 0, stream, p);
  hipLaunchKernelGGL(mega<5>, dim3(grid_blocks), dim3(NTHREADS), 0, stream, p);
  hipLaunchKernelGGL(mega<6>, dim3(grid_blocks), dim3(NTHREADS), 0, stream, p);
  hipLaunchKernelGGL(mega<7>, dim3(grid_blocks), dim3(NTHREADS), 0, stream, p);
#endif

}
```

```cpp
#include <hip/hip_runtime.h>
#include <stdint.h>
#include <stdio.h>

#ifndef ONE_LAUNCH
#define ONE_LAUNCH 1
#endif

typedef __bf16 bf16;
typedef __bf16 bf16x2 __attribute__((ext_vector_type(2)));
typedef __bf16 bf16x4 __attribute__((ext_vector_type(4)));
typedef __bf16 bf16x8 __attribute__((ext_vector_type(8)));
typedef float f32x2 __attribute__((ext_vector_type(2)));
typedef float f32x4 __attribute__((ext_vector_type(4)));
typedef float f32x16 __attribute__((ext_vector_type(16)));
typedef unsigned u32x2 __attribute__((ext_vector_type(2)));
typedef unsigned u32x4 __attribute__((ext_vector_type(4)));

#define DI __device__ __forceinline__
#define MFMA(a, b, c) __builtin_amdgcn_mfma_f32_32x32x16_bf16((a), (b), (c), 0, 0, 0)

constexpr int DM = 1024, NB = 8, SEQ = 2048, NS = 128, NPR = NB * SEQ, NTOK = NPR + NS;
constexpr int INW = 3840, NMOD = NB + NS;
constexpr int C_K = 1024, C_V = 1152, C_PIN = 1280, C_GA = 1792, C_GB = 2816;
constexpr int NEXP = 16384;
constexpr float EPS = 1e-6f;
constexpr size_t O_YP = 0, O_KWP = 16908288, O_VWP = 17039360, O_PP = 17170432, O_KWS = 17231872, O_VWS = 19329024, O_PS = 21426176;

constexpr int SMEM_BYTES = 77824;
constexpr int NTHREADS = 256;

struct P {
  const float *x_prompt, *x_sample, *cache_k, *cache_v, *state_pool, *c_prompt, *c_sample, *rel_table, *ada_w, *ada_b, *norm1_g, *w_in,
      *q_norm_g, *k_norm_g, *sinks, *pool_w, *pool_scale, *w_out, *norm2_g, *w_query, *sub_keys, *peer_u, *peer_v;
  float* out;
  char* ws;
};
constexpr size_t al256(size_t x) { return (x + 255) & ~(size_t)255; }
constexpr size_t OFF_BAR = 0;
constexpr size_t OFF_WTIN = OFF_BAR + al256(4096 * 4);
constexpr size_t OFF_WTOUT = OFF_WTIN + al256((size_t)INW * 1024 * 2);
constexpr size_t OFF_WTQ = OFF_WTOUT + al256((size_t)1024 * 1024 * 2);
constexpr size_t OFF_SK = OFF_WTQ + al256((size_t)2048 * 1024 * 2);
constexpr size_t OFF_PWT = OFF_SK + al256((size_t)16 * 128 * 128 * 2);
constexpr size_t OFF_UB = OFF_PWT + al256((size_t)4 * 256 * 128 * 2);
constexpr size_t OFF_VB = OFF_UB + al256((size_t)NEXP * DM);
constexpr size_t OFF_SU = OFF_VB + al256((size_t)NEXP * DM);
constexpr size_t OFF_SV = OFF_SU + al256((size_t)NEXP * 4);
constexpr size_t OFF_H8 = OFF_SV + al256((size_t)NEXP * 4);
constexpr size_t OFF_HS = OFF_H8 + al256((size_t)NTOK * DM);
constexpr size_t OFF_MOD = OFF_HS + al256((size_t)NTOK * 4);
constexpr size_t OFF_BIAS = OFF_MOD + al256((size_t)NMOD * 6144 * 4);
constexpr size_t OFF_VT = OFF_BIAS + al256(16 * 128 * 4);
constexpr size_t OFF_H = OFF_VT + al256((size_t)NB * 128 * SEQ * 2);
constexpr size_t OFF_MIXED = OFF_H;
constexpr size_t OFF_PROJ = OFF_H + al256((size_t)NTOK * DM * 2);
constexpr size_t OFF_X1 = OFF_PROJ;
constexpr size_t OFF_IDX = OFF_X1 + (size_t)NTOK * DM * 4;
constexpr size_t OFF_GATE = OFF_IDX + (size_t)NTOK * 128 * 4;
constexpr size_t WS_NEED = OFF_PROJ + al256((size_t)NTOK * INW * 2);
static_assert(OFF_GATE + (size_t)NTOK * 128 * 4 <= WS_NEED, "overlay fits");
static_assert(WS_NEED <= (size_t)256 * 1024 * 1024, "workspace budget");
#define WS_PTR(T, name, OFF) __device__ __forceinline__ T* name(const P& p) { return (T*)(p.ws + (OFF)); }
WS_PTR(unsigned, w_bar, OFF_BAR) WS_PTR(bf16, w_Wt_in, OFF_WTIN) WS_PTR(bf16, w_Wt_out, OFF_WTOUT) WS_PTR(bf16, w_Wt_q, OFF_WTQ) WS_PTR(bf16, w_SK, OFF_SK)
WS_PTR(bf16, w_PWt, OFF_PWT) WS_PTR(unsigned char, w_Ub, OFF_UB) WS_PTR(unsigned char, w_Vb, OFF_VB) WS_PTR(float, w_SU, OFF_SU) WS_PTR(float, w_SV, OFF_SV) WS_PTR(unsigned char, w_H8, OFF_H8) WS_PTR(float, w_HS, OFF_HS) WS_PTR(float, w_MOD, OFF_MOD) WS_PTR(float, w_BIAS, OFF_BIAS)
WS_PTR(bf16, w_VT, OFF_VT) WS_PTR(bf16, w_H, OFF_H) WS_PTR(bf16, w_MIXED, OFF_MIXED) WS_PTR(bf16, w_PROJ, OFF_PROJ) WS_PTR(float, w_X1, OFF_X1)
WS_PTR(int, w_IDX, OFF_IDX) WS_PTR(float, w_GATE, OFF_GATE)

DI int cond_row(int token) { return token < NPR ? (token >> 11) : (NB + token - NPR); }
DI int crow(int reg, int h) { return (reg & 3) + 8 * (reg >> 2) + 4 * h; }
DI const float* xrow(const P& p, int token) { return token < NPR ? p.x_prompt + (size_t)token * DM : p.x_sample + (size_t)(token - NPR) * DM; }

#define LDS_WAIT() asm volatile("s_waitcnt lgkmcnt(0)" ::: "memory")
DI int opaque0() { int z = 0; asm volatile("" : "+v"(z)); return z; }
DI float bf2f(bf16 v) { return (float)v; }
DI f32x16 zero16() { f32x16 z; for (int i = 0; i < 16; ++i) z[i] = 0.f; return z; }
DI bf16x8 pack_step(const f32x16& x, int s) { bf16x8 v; for (int j = 0; j < 8; ++j) v[j] = (bf16)x[8 * s + j]; return v; }
DI bf16x8 cat4(bf16x4 lo, bf16x4 hi) { return __builtin_shufflevector(lo, hi, 0, 1, 2, 3, 4, 5, 6, 7); }
DI float wave_sum(float v) { for (int o = 32; o >= 1; o >>= 1) v += __shfl_xor(v, o); return v; }

#define XB_TMO 128
#define XB_XCNT(j) (256 + 64 * (j))
#define XB_XSUB(j) (1280 + 64 * (j))
#define XB_XGEN(j) (2304 + 64 * (j))
#define XB_TOP 3328
#define XB_TOPGEN 3392
#define XCD_BAR_WORDS 3456
#define XB_SPIN_CAP (1u << 22)
DI unsigned xb_ld(unsigned* p) { return __hip_atomic_load(p, __ATOMIC_RELAXED, __HIP_MEMORY_SCOPE_AGENT); }
DI unsigned xb_add(unsigned* p, unsigned v) { return __hip_atomic_fetch_add(p, v, __ATOMIC_RELAXED, __HIP_MEMORY_SCOPE_AGENT); }
DI unsigned xb_xcc_id() { return (unsigned)__builtin_amdgcn_s_getreg((3 << 11) | 20) & 0xFu; }
#define XB_SPIN(cond, bar) do { unsigned _sp = 0; while (cond) { __builtin_amdgcn_s_sleep(1); \
    if ((++_sp & 255u) == 0u) { if (xb_ld(&(bar)[XB_TMO])) break; if (_sp > XB_SPIN_CAP) { atomicAdd(&(bar)[XB_TMO], 1u); break; } } } } while (0)

DI void xcd_barrier_complete(unsigned* bar, unsigned x, unsigned& nloc, unsigned& nx) {
  const unsigned G = gridDim.x;
  unsigned sum, cnt, mine, sp = 0u;
  for (;;) {
    sum = 0u; cnt = 0u; mine = 0u;
#pragma unroll
    for (unsigned j = 0; j < 16; ++j) { const unsigned c = xb_ld(&bar[XB_XCNT(j)]); sum += c; cnt += (c > 0u) ? 1u : 0u; mine = (j == x) ? c : mine; }
    if (sum == G) break;
    __builtin_amdgcn_s_sleep(1);
    if ((++sp & 255u) == 0u) { if (xb_ld(&bar[XB_TMO])) break; if (sp > XB_SPIN_CAP) { atomicAdd(&bar[XB_TMO], 1u); break; } }
  }
  nloc = mine > 0u ? mine : 1u; nx = cnt > 0u ? cnt : 1u;
}
DI void xcd_barrier(unsigned* bar, unsigned x, volatile unsigned* st) {
  asm volatile("s_waitcnt vmcnt(0)" ::: "memory");
  __syncthreads();
  if (threadIdx.x == 0) {
    __builtin_amdgcn_s_waitcnt(0);
    unsigned nloc = st[0], nx = st[1];
    if (nloc == 0u) { xcd_barrier_complete(bar, x, nloc, nx); st[0] = nloc; st[1] = nx; }
    const unsigned old = xb_add(&bar[XB_XSUB(x)], 1u);
    const unsigned gen = old / nloc;
    if (old + 1u == (gen + 1u) * nloc) {
      __builtin_amdgcn_fence(__ATOMIC_RELEASE, "agent");
      asm volatile("s_waitcnt vmcnt(0)" ::: "memory");
      const unsigned og = xb_add(&bar[XB_TOP], 1u);
      const unsigned tg = og / nx;
      if (og + 1u == (tg + 1u) * nx) xb_add(&bar[XB_TOPGEN], 1u);
      else XB_SPIN(xb_ld(&bar[XB_TOPGEN]) == tg, bar);
      __builtin_amdgcn_fence(__ATOMIC_ACQUIRE, "agent");
      xb_add(&bar[XB_XGEN(x)], 1u);
      asm volatile("s_waitcnt vmcnt(0)" ::: "memory");
    } else {
      XB_SPIN(xb_ld(&bar[XB_XGEN(x)]) == gen, bar);
      __builtin_amdgcn_fence(__ATOMIC_ACQUIRE, "agent");
      asm volatile("s_waitcnt vmcnt(0)" ::: "memory");
    }
  }
  __syncthreads();
}

constexpr int U0_MOD = 192;
constexpr int U0_TIN = (1024 / 64) * (INW / 64);
constexpr int F0_TOTAL = U0_TIN + 1;
constexpr int U0_TPW = 4 * 2 * 4;
constexpr int U0_CSK = 32;
constexpr int U0_KW = 128, U0_VW = 128, U0_PW = 128;
constexpr int F2_TOUT = 16 * 16, F2_TQ = 16 * 32, F2_E1 = F2_TOUT + F2_TQ, F2_E2 = F2_E1 + U0_TPW, F2_E3 = F2_E2 + U0_KW, F2_E4 = F2_E3 + U0_VW,
              F2_TOTAL = F2_E4 + U0_PW;
constexpr int F4_QU = 2048, F4_TOTAL = F4_QU + U0_CSK;
constexpr int F6_QV = 2048;

DI float silu_f(float x) { return x / (1.f + __expf(-x)); }

DI void unit_mod(const P& p, int u, char* smem) {
  const int t = threadIdx.x + opaque0(), lane = t & 63, w = t >> 6, r = lane & 31, h = lane >> 5;
  const int f0 = u * 32;
  f32x16 acc[5];
#pragma unroll
  for (int i = 0; i < 5; ++i) acc[i] = zero16();
  const float* wp = p.ada_w + (size_t)(w * 256 + 8 * h) * 6144 + f0 + r;
  const float* cp[5];
#pragma unroll
  for (int i = 0; i < 5; ++i) { const int m = 32 * i + r, mm = m < NMOD ? m : 0; cp[i] = (mm < NB ? p.c_prompt + (size_t)mm * DM : p.c_sample + (size_t)(mm - NB) * DM) + w * 256 + 8 * h; }
  float wv[8]; f32x4 cv[5][2];
#pragma unroll
  for (int j = 0; j < 8; ++j) wv[j] = wp[(size_t)j * 6144];
#pragma unroll
  for (int i = 0; i < 5; ++i) { cv[i][0] = *(const f32x4*)cp[i]; cv[i][1] = *(const f32x4*)(cp[i] + 4); }
#pragma unroll 1
  for (int ks = 0; ks < 16; ++ks) {
    bf16x8 bfr, afr[5];
#pragma unroll
    for (int j = 0; j < 8; ++j) bfr[j] = (bf16)wv[j];
#pragma unroll
    for (int i = 0; i < 5; ++i) {
      const bool ok = 32 * i + r < NMOD;
#pragma unroll
      for (int j = 0; j < 8; ++j) afr[i][j] = (bf16)(ok ? silu_f(cv[i][j >> 2][j & 3]) : 0.f);
    }
    const int kn = ks + 1 < 16 ? ks + 1 : 15;
#pragma unroll
    for (int j = 0; j < 8; ++j) wv[j] = wp[(size_t)(kn * 16 + j) * 6144];
#pragma unroll
    for (int i = 0; i < 5; ++i) { cv[i][0] = *(const f32x4*)(cp[i] + kn * 16); cv[i][1] = *(const f32x4*)(cp[i] + kn * 16 + 4); }
#pragma unroll
    for (int i = 0; i < 5; ++i) acc[i] = MFMA(afr[i], bfr, acc[i]);
  }
  float* red = (float*)smem;
  __syncthreads();
  if (w > 0) {
#pragma unroll
    for (int i = 0; i < 5; ++i)
#pragma unroll
      for (int j = 0; j < 16; ++j) red[((w - 1) * 80 + i * 16 + j) * 64 + lane] = acc[i][j];
  }
  __syncthreads();
  if (w == 0) {
    const float bias = p.ada_b[f0 + r];
#pragma unroll
    for (int i = 0; i < 5; ++i)
#pragma unroll
      for (int j = 0; j < 16; ++j) {
        const int m = 32 * i + crow(j, h);
        const float v = acc[i][j] + red[(0 * 80 + i * 16 + j) * 64 + lane] + red[(1 * 80 + i * 16 + j) * 64 + lane] + red[(2 * 80 + i * 16 + j) * 64 + lane] + bias;
        if (m < NMOD) w_MOD(p)[(size_t)m * 6144 + f0 + r] = v;
      }
  }
}

DI void unit_transpose(const float* __restrict__ src, bf16* __restrict__ dst, int R, int C, int tr, int tc, char* smem) {
  float* tile = (float*)smem;
  const int t = threadIdx.x + opaque0();
  __syncthreads();
#pragma unroll
  for (int i = 0; i < 4; ++i) {
    const int rr = (t >> 4) + 16 * i, cc = (t & 15) * 4;
    const f32x4 v = *(const f32x4*)(src + (size_t)(tr * 64 + rr) * C + tc * 64 + cc);
    tile[rr * 65 + cc] = v[0]; tile[rr * 65 + cc + 1] = v[1]; tile[rr * 65 + cc + 2] = v[2]; tile[rr * 65 + cc + 3] = v[3];
  }
  __syncthreads();
#pragma unroll
  for (int i = 0; i < 2; ++i) {
    const int orow = (t >> 3) + 32 * i, seg = (t & 7) * 8;
    bf16x8 v;
#pragma unroll
    for (int j = 0; j < 8; ++j) v[j] = (bf16)tile[(seg + j) * 65 + orow];
    *(bf16x8*)(dst + (size_t)(tc * 64 + orow) * R + tr * 64 + seg) = v;
  }
}
DI void unit_convert(const float* __restrict__ src, bf16* __restrict__ dst, int u) {
  const size_t base = (size_t)u * 8192 + (threadIdx.x + opaque0()) * 8;
#pragma unroll
  for (int i = 0; i < 4; ++i) {
    const size_t o = base + (size_t)i * 2048;
    const f32x4 a = *(const f32x4*)(src + o), b = *(const f32x4*)(src + o + 4);
    bf16x8 v; v[0] = (bf16)a[0]; v[1] = (bf16)a[1]; v[2] = (bf16)a[2]; v[3] = (bf16)a[3]; v[4] = (bf16)b[0]; v[5] = (bf16)b[1]; v[6] = (bf16)b[2]; v[7] = (bf16)b[3];
    *(bf16x8*)(dst + o) = v;
  }
}
DI unsigned pack_i8(float a, float b, float c, float d) {
  const int ia = max(-127, min(127, __float2int_rn(a))), ib = max(-127, min(127, __float2int_rn(b))), ic = max(-127, min(127, __float2int_rn(c))), id = max(-127, min(127, __float2int_rn(d)));
  return (unsigned)(ia & 255) | ((unsigned)(ib & 255) << 8) | ((unsigned)(ic & 255) << 16) | ((unsigned)(id & 255) << 24);
}
template <bool I8>
DI void unit_quant_rows(const float* __restrict__ src, unsigned char* __restrict__ dst, float* __restrict__ scale, int u) {
  const int t = threadIdx.x + opaque0(), lane = t & 63, w = t >> 6;
#pragma unroll
  for (int rr = 0; rr < 2; ++rr) {
    const size_t row = (size_t)u * 8 + 2 * w + rr;
    const float* s = src + row * DM + 16 * lane;
    f32x4 v[4];
    float amax = 0.f;
#pragma unroll
    for (int i = 0; i < 4; ++i) { v[i] = *(const f32x4*)(s + 4 * i); amax = fmaxf(amax, fmaxf(fmaxf(fabsf(v[i][0]), fabsf(v[i][1])), fmaxf(fabsf(v[i][2]), fabsf(v[i][3])))); }
#pragma unroll
    for (int o = 32; o >= 1; o >>= 1) amax = fmaxf(amax, __shfl_xor(amax, o));
    const float sc = amax > 0.f ? amax * (I8 ? 1.f / 127.f : 1.f / 440.f) : 1.f, inv = 1.f / sc;
    u32x4 q;
#pragma unroll
    for (int i = 0; i < 4; ++i) {
      if (I8) {
        q[i] = pack_i8(v[i][0] * inv, v[i][1] * inv, v[i][2] * inv, v[i][3] * inv);
      } else {
        int wd = 0;
        wd = __builtin_amdgcn_cvt_pk_fp8_f32(v[i][0] * inv, v[i][1] * inv, wd, false);
        wd = __builtin_amdgcn_cvt_pk_fp8_f32(v[i][2] * inv, v[i][3] * inv, wd, true);
        q[i] = (unsigned)wd;
      }
    }
    *(u32x4*)(dst + row * DM + 16 * lane) = q;
    if (lane == 0) scale[row] = sc;
  }
}
DI void unit_copy_f4(const float* __restrict__ src, float* __restrict__ dst, int n4) {
  for (int i = threadIdx.x + opaque0(); i < n4; i += NTHREADS) ((f32x4*)dst)[i] = ((const f32x4*)src)[i];
}

DI void phase0_filler(const P& p, int f, char* smem) {
  if (f < U0_TIN) { unit_transpose(p.w_in, w_Wt_in(p), 1024, INW, f / 60, f % 60, smem); }
  else {
    for (int i = threadIdx.x + opaque0(); i < 16 * 128; i += NTHREADS) {
      const int head = i >> 7, d = i & 127;
      int bk = d;
      if (d >= 16) { bk = 16 + (int)(logf((float)d / 16.f) / logf(8.f) * 16.f); bk = bk > 31 ? 31 : bk; }
      w_BIAS(p)[i] = p.rel_table[bk * 16 + head];
    }
  }
}
DI void phase2_filler(const P& p, int f, char* smem) {
  if (f < F2_TOUT) unit_transpose(p.w_out, w_Wt_out(p), 1024, 1024, f / 16, f % 16, smem);
  else if (f < F2_E1) { const int v = f - F2_TOUT; unit_transpose(p.w_query, w_Wt_q(p), 1024, 2048, v / 32, v % 32, smem); }
  else if (f < F2_E2) { const int v = f - F2_E1, g = v >> 3, tt = v & 7; unit_transpose(p.pool_w + (size_t)g * 128 * 256, w_PWt(p) + (size_t)g * 256 * 128, 128, 256, tt >> 2, tt & 3, smem); }
  else if (f < F2_E3) { const int b = f - F2_E2; unit_copy_f4(p.cache_k + ((size_t)b * 128 + 1) * 128, p.out + O_KWS + (size_t)b * 128 * 128, 127 * 128 / 4); }
  else if (f < F2_E4) { const int b = f - F2_E3; unit_copy_f4(p.cache_v + ((size_t)b * 128 + 1) * 128, p.out + O_VWS + (size_t)b * 128 * 128, 127 * 128 / 4); }
  else { const int b = f - F2_E4; unit_copy_f4(p.state_pool + ((size_t)b * 15 + 1) * 512, p.out + O_PS + (size_t)b * 15 * 512, 14 * 512 / 4); }
}

DI void norm_row(const P& p, int token, int which) {
  const int lane = (threadIdx.x + opaque0()) & 63;
  const float* src = which == 0 ? xrow(p, token) : w_X1(p) + (size_t)token * DM;
  const float* g = which == 0 ? p.norm1_g : p.norm2_g;
  const float* mod = w_MOD(p) + (size_t)cond_row(token) * 6144 + (which == 0 ? 0 : 3072);
  f32x4 v[4];
  float ss = 0.f;
#pragma unroll
  for (int i = 0; i < 4; ++i) { v[i] = *(const f32x4*)(src + 4 * lane + 256 * i); ss += v[i][0] * v[i][0] + v[i][1] * v[i][1] + v[i][2] * v[i][2] + v[i][3] * v[i][3]; }
  ss = wave_sum(ss);
  const float rstd = rsqrtf(ss * (1.f / DM) + EPS);
#pragma unroll
  for (int i = 0; i < 4; ++i) {
    const int c = 4 * lane + 256 * i;
    const f32x4 gg = *(const f32x4*)(g + c), sh = *(const f32x4*)(mod + c), sc = *(const f32x4*)(mod + 1024 + c);
    bf16x4 o;
#pragma unroll
    for (int j = 0; j < 4; ++j) { v[i][j] = (v[i][j] * rstd * gg[j]) * (1.f + sc[j]) + sh[j]; o[j] = (bf16)v[i][j]; }
    *(bf16x4*)(w_H(p) + (size_t)token * DM + c) = o;
  }
  if (which == 1) {
    float amax = 0.f;
#pragma unroll
    for (int i = 0; i < 4; ++i) amax = fmaxf(amax, fmaxf(fmaxf(fabsf(v[i][0]), fabsf(v[i][1])), fmaxf(fabsf(v[i][2]), fabsf(v[i][3]))));
#pragma unroll
    for (int o = 32; o >= 1; o >>= 1) amax = fmaxf(amax, __shfl_xor(amax, o));
    const float qs = amax > 0.f ? amax * (1.f / 127.f) : 1.f, inv = 1.f / qs;
#pragma unroll
    for (int i = 0; i < 4; ++i) *(unsigned*)(w_H8(p) + (size_t)token * DM + 4 * lane + 256 * i) = pack_i8(v[i][0] * inv, v[i][1] * inv, v[i][2] * inv, v[i][3] * inv);
    if (lane == 0) w_HS(p)[token] = qs;
  }
}

constexpr int LDSK = 72;
constexpr int GT = 128 * 64 * 2;
constexpr int GBUF = 2 * GT;
typedef __attribute__((address_space(3))) unsigned lds_u32;
typedef const __attribute__((address_space(1))) unsigned glb_u32;
DI void glds16(const void* g, char* l) { __builtin_amdgcn_global_load_lds((glb_u32*)g, (lds_u32*)l, 16, 0, 0); }
DI void gemm_tile(const bf16* __restrict__ Wt, const bf16* __restrict__ X, int K, int n0, int m0, char* smem, f32x16 (&acc)[4]) {
  const int t = threadIdx.x + opaque0(), lane = t & 63, r = lane & 31, h = lane >> 5;
  const int w = __builtin_amdgcn_readfirstlane(t >> 6);
#pragma unroll
  for (int i = 0; i < 4; ++i) acc[i] = zero16();
  const int swz = (lane & 7) ^ ((4 * w + (lane >> 4)) & 7);
  const bf16* ga = Wt + (size_t)(n0 + 8 * w + (lane >> 3)) * K + swz * 8;
  const bf16* gb = X + (size_t)(m0 + 8 * w + (lane >> 3)) * K + swz * 8;
  const int sw = (r >> 1) & 7;
  const int KT = K >> 6;
  __syncthreads();
#pragma unroll
  for (int q = 0; q < 4; ++q) { glds16(ga + (size_t)(32 * q) * K, smem + 1024 * (w + 4 * q)); glds16(gb + (size_t)(32 * q) * K, smem + GT + 1024 * (w + 4 * q)); }
  asm volatile("s_waitcnt vmcnt(0)" ::: "memory");
  __syncthreads();
  for (int kt = 0; kt < KT; ++kt) {
    const char* As = smem + (kt & 1) * GBUF;
    const char* Bs = As + GT;
    if (kt + 1 < KT) {
      char* An = smem + ((kt + 1) & 1) * GBUF;
      const int k0 = (kt + 1) * 64;
#pragma unroll
      for (int q = 0; q < 4; ++q) { glds16(ga + (size_t)(32 * q) * K + k0, An + 1024 * (w + 4 * q)); glds16(gb + (size_t)(32 * q) * K + k0, An + GT + 1024 * (w + 4 * q)); }
    }
#pragma unroll
    for (int s = 0; s < 4; ++s) {
      const int co = ((2 * s + h) ^ sw) * 16;
      const bf16x8 bfr = *(const bf16x8*)(Bs + (32 * w + r) * 128 + co);
#pragma unroll
      for (int i = 0; i < 4; ++i) {
        const bf16x8 afr = *(const bf16x8*)(As + (32 * i + r) * 128 + co);
        acc[i] = MFMA(afr, bfr, acc[i]);
      }
    }
    asm volatile("s_waitcnt vmcnt(0)" ::: "memory");
    __syncthreads();
  }
}

DI float sigmoid_f(float x) { return 1.f / (1.f + __expf(-x)); }

DI void unit_gemm1(const P& p, int u, char* smem) {
  const int mt = u / 30, nt = u % 30;
  const int n0 = nt * 128, m0 = mt * 128;
  f32x16 acc[4];
  gemm_tile(w_Wt_in(p), w_H(p), 1024, n0, m0, smem, acc);
  const int tz = threadIdx.x + opaque0();
  const int lane = tz & 63, w = tz >> 6, r = lane & 31, h = lane >> 5;
  const int token = m0 + 32 * w + r;
  bf16* tw = (bf16*)(smem + (tz >> 6) * 16384) + r * 136;
  const bool is_prompt = token < NPR;
  const int b = is_prompt ? (token >> 11) : (token - NPR), pos = token & (SEQ - 1);
  if (n0 < C_V) {
    const float* gn = n0 < C_K ? p.q_norm_g : p.k_norm_g;
    const float post = n0 < C_K ? 0.125f : 1.f;
#pragma unroll
    for (int hh = 0; hh < 2; ++hh) {
      float ss = 0.f;
#pragma unroll
      for (int i = 0; i < 2; ++i)
#pragma unroll
        for (int j = 0; j < 16; ++j) ss += acc[2 * hh + i][j] * acc[2 * hh + i][j];
      ss += __shfl_xor(ss, 32);
      const float rstd = rsqrtf(ss * (1.f / 64.f) + EPS);
#pragma unroll
      for (int i = 0; i < 2; ++i)
#pragma unroll
        for (int q4 = 0; q4 < 4; ++q4) {
          const int d = 32 * i + 8 * q4 + 4 * h;
          const f32x4 gg = *(const f32x4*)(gn + d);
          f32x4 v;
#pragma unroll
          for (int j = 0; j < 4; ++j) v[j] = acc[2 * hh + i][4 * q4 + j] * rstd * gg[j];
          bf16x4 o;
#pragma unroll
          for (int j = 0; j < 4; ++j) o[j] = (bf16)(v[j] * post);
          *(bf16x4*)(tw + 64 * hh + d) = o;
          if (n0 == C_K) {
            if (is_prompt) { if (pos >= SEQ - 128) *(f32x4*)(p.out + O_KWP + ((size_t)b * 128 + (pos - (SEQ - 128))) * 128 + 64 * hh + d) = v; }
            else *(f32x4*)(p.out + O_KWS + ((size_t)b * 128 + 127) * 128 + 64 * hh + d) = v;
          }
        }
    }
  } else if (n0 == C_V) {
#pragma unroll
    for (int i = 0; i < 4; ++i)
#pragma unroll
      for (int q4 = 0; q4 < 4; ++q4) {
        const int f = 32 * i + 8 * q4 + 4 * h;
        f32x4 v;
#pragma unroll
        for (int j = 0; j < 4; ++j) v[j] = acc[i][4 * q4 + j];
        if (is_prompt) {
#pragma unroll
          for (int j = 0; j < 4; ++j) w_VT(p)[((size_t)b * 128 + f + j) * SEQ + pos] = (bf16)v[j];
          if (pos >= SEQ - 128) *(f32x4*)(p.out + O_VWP + ((size_t)b * 128 + (pos - (SEQ - 128))) * 128 + f) = v;
        } else *(f32x4*)(p.out + O_VWS + ((size_t)b * 128 + 127) * 128 + f) = v;
      }
  } else if (n0 < C_GA) {
#pragma unroll
    for (int i = 0; i < 4; ++i)
#pragma unroll
      for (int q4 = 0; q4 < 4; ++q4) {
        const int f = n0 + 32 * i + 8 * q4 + 4 * h;
        f32x4 v; bf16x4 o;
#pragma unroll
        for (int j = 0; j < 4; ++j) { v[j] = acc[i][4 * q4 + j]; o[j] = (bf16)v[j]; }
        *(bf16x4*)(tw + (f - n0)) = o;
        if (is_prompt) { if (pos >= SEQ - 15) *(f32x4*)(p.out + O_PP + ((size_t)b * 15 + (pos - (SEQ - 15))) * 512 + (f - C_PIN)) = v; }
        else *(f32x4*)(p.out + O_PS + ((size_t)b * 15 + 14) * 512 + (f - C_PIN)) = v;
      }
  } else {
#pragma unroll
    for (int i = 0; i < 4; ++i)
#pragma unroll
      for (int q4 = 0; q4 < 4; ++q4) {
        const int f = n0 + 32 * i + 8 * q4 + 4 * h;
        bf16x4 o;
#pragma unroll
        for (int j = 0; j < 4; ++j) o[j] = (bf16)sigmoid_f(acc[i][4 * q4 + j]);
        *(bf16x4*)(tw + (f - n0)) = o;
      }
  }
  if (n0 != C_V) {
    LDS_WAIT();
    const bf16* tr = (const bf16*)(smem + (tz >> 6) * 16384);
    bf16* pg = w_PROJ(p) + (size_t)(m0 + 32 * w + (lane >> 4)) * INW + n0 + (lane & 15) * 8;
#pragma unroll
    for (int it = 0; it < 8; ++it) *(u32x4*)(pg + (size_t)(4 * it) * INW) = *(const u32x4*)(tr + ((lane >> 4) + 4 * it) * 136 + (lane & 15) * 8);
  }
}

constexpr int VTS = 260;
constexpr int RS = 136;
DI void unit_attn_prompt(const P& p, int u, char* smem) {
  const int b = u >> 8, blk = (u >> 4) & 15, head = u & 15, hk = head >> 3;
  const int qpos0 = blk * 128;
  const int t = threadIdx.x + opaque0(), lane = t & 63, w = t >> 6, r = lane & 31, h = lane >> 5;
  bf16* Ks = (bf16*)smem;
  bf16* VTs = Ks + 256 * LDSK;
  float* bs = (float*)(VTs + 64 * VTS);
  bf16* Rs = Ks;
  __syncthreads();
#pragma unroll
  for (int i = 0; i < 8; ++i) {
    const int c = t + 256 * i, row = c >> 3, c16 = c & 7, kp = qpos0 - 128 + row;
    u32x4 v = {0u, 0u, 0u, 0u};
    if (kp >= 0) v = *(const u32x4*)(w_PROJ(p) + ((size_t)b * SEQ + kp) * INW + C_K + hk * 64 + c16 * 8);
    *(u32x4*)(Ks + row * LDSK + c16 * 8) = v;
  }
#pragma unroll
  for (int i = 0; i < 8; ++i) {
    const int c = t + 256 * i, drow = c >> 5, c16 = c & 31, kp0 = qpos0 - 128 + c16 * 8;
    u32x4 v = {0u, 0u, 0u, 0u};
    if (kp0 >= 0) v = *(const u32x4*)(w_VT(p) + ((size_t)(b * 2 + hk) * 64 + drow) * SEQ + kp0);
    u32x2* d2 = (u32x2*)(VTs + drow * VTS + c16 * 8);
    d2[0] = (u32x2){v[0], v[1]}; d2[1] = (u32x2){v[2], v[3]};
  }
  if (t < 192) { const int dist = 159 - t; bs[t] = (dist >= 0 && dist < 128) ? w_BIAS(p)[head * 128 + dist] : 0.f; }
  const int qi = 32 * w + r;
  const size_t tokq = (size_t)b * SEQ + qpos0 + qi;
  bf16x8 qf[4];
#pragma unroll
  for (int s = 0; s < 4; ++s) qf[s] = *(const bf16x8*)(w_PROJ(p) + tokq * INW + head * 64 + 16 * s + 8 * h);
  __syncthreads();
  f32x16 st[5];
#pragma unroll
  for (int tt = 0; tt < 5; ++tt) {
    st[tt] = zero16();
#pragma unroll
    for (int s = 0; s < 4; ++s) {
      const bf16x8 a = *(const bf16x8*)(Ks + (32 * (w + tt) + r) * LDSK + 16 * s + 8 * h);
      st[tt] = MFMA(a, qf[s], st[tt]);
    }
  }
  const float sink = p.sinks[head];
  float m = -INFINITY;
  {
    const int x = 31 - r + 4 * h;
    const float* bl = bs + x;
    const int kbase = blk > 0 ? 1024 : 32 * w + 4 * h;
#pragma unroll
    for (int tt = 0; tt < 5; ++tt)
#pragma unroll
      for (int j = 0; j < 16; ++j) {
        const int c = 32 * tt + (j & 3) + 8 * (j >> 2);
        const bool valid = (x + c >= 32) && (x + c <= 159) && (kbase + c >= 128);
        const float bv = bl[c];
        const float s = valid ? st[tt][j] + bv : -INFINITY;
        st[tt][j] = s;
        m = fmaxf(m, s);
      }
  }
  m = fmaxf(m, __shfl_xor(m, 32));
  m = fmaxf(m, sink);
  float sum = 0.f;
#pragma unroll
  for (int tt = 0; tt < 5; ++tt)
#pragma unroll
    for (int j = 0; j < 16; ++j) { const float e = __expf(st[tt][j] - m); st[tt][j] = e; sum += e; }
  sum += __shfl_xor(sum, 32);
  const float inv = 1.f / (sum + __expf(sink - m));
  f32x16 o[2] = {zero16(), zero16()};
#pragma unroll
  for (int tt = 0; tt < 5; ++tt)
#pragma unroll
    for (int s = 0; s < 2; ++s) {
      const bf16x8 pb = pack_step(st[tt], s);
#pragma unroll
      for (int i = 0; i < 2; ++i) {
        const bf16* vp = VTs + (32 * i + r) * VTS + 32 * (w + tt) + 16 * s + 4 * h;
        const bf16x8 a = cat4(*(const bf16x4*)vp, *(const bf16x4*)(vp + 8));
        o[i] = MFMA(a, pb, o[i]);
      }
    }
  __syncthreads();
  const int g = head >> 2, win = 2 << g;
  {
    const int tk = t >> 4, cc = t & 15;
    const int p0 = qpos0 + tk * 8;
    const bf16* pin = w_PROJ(p) + (size_t)b * SEQ * INW + C_PIN + g * 128 + cc * 8;
    float S[8];
#pragma unroll
    for (int j = 0; j < 8; ++j) S[j] = 0.f;
    for (int i = 0; i < win; ++i) {
      const int pp = p0 - i;
      if (pp >= 0) { const bf16x8 v = *(const bf16x8*)(pin + (size_t)pp * INW);
#pragma unroll
        for (int j = 0; j < 8; ++j) S[j] += bf2f(v[j]); }
    }
    for (int i = 0; i < 8; ++i) {
      const int pos = p0 + i;
      const bf16x8 cur = *(const bf16x8*)(pin + (size_t)pos * INW);
      if (i > 0) {
#pragma unroll
        for (int j = 0; j < 8; ++j) S[j] += bf2f(cur[j]);
        if (pos - win >= 0) { const bf16x8 old = *(const bf16x8*)(pin + (size_t)(pos - win) * INW);
#pragma unroll
          for (int j = 0; j < 8; ++j) S[j] -= bf2f(old[j]); }
      }
      const float icnt = 1.f / (float)(win < pos + 1 ? win : pos + 1);
      bf16x8 rr;
#pragma unroll
      for (int j = 0; j < 8; ++j) rr[j] = (bf16)(S[j] * icnt - bf2f(cur[j]));
      *(bf16x8*)(Rs + (tk * 8 + i) * RS + cc * 8) = rr;
    }
  }
  __syncthreads();
  f32x16 pa[2] = {zero16(), zero16()};
#pragma unroll
  for (int s = 0; s < 8; ++s) {
    const bf16x8 bfr = *(const bf16x8*)(Rs + (32 * w + r) * RS + 16 * s + 8 * h);
#pragma unroll
    for (int i = 0; i < 2; ++i) {
      const bf16x8 a = *(const bf16x8*)(w_PWt(p) + ((size_t)g * 256 + (head & 3) * 64 + 32 * i + r) * 128 + 16 * s + 8 * h);
      pa[i] = MFMA(a, bfr, pa[i]);
    }
  }
  const bf16* prow = w_PROJ(p) + tokq * INW;
#pragma unroll
  for (int i = 0; i < 2; ++i)
#pragma unroll
    for (int q4 = 0; q4 < 4; ++q4) {
      const int f = head * 64 + 32 * i + 8 * q4 + 4 * h;
      const bf16x4 ga = *(const bf16x4*)(prow + C_GA + f), gb = *(const bf16x4*)(prow + C_GB + f);
      const f32x4 ps = *(const f32x4*)(p.pool_scale + f);
      bf16x4 ov;
#pragma unroll
      for (int j = 0; j < 4; ++j) ov[j] = (bf16)(bf2f(ga[j]) * (o[i][4 * q4 + j] * inv) + bf2f(gb[j]) * (pa[i][4 * q4 + j] * ps[j]));
      *(bf16x4*)(w_MIXED(p) + tokq * DM + f) = ov;
    }
}

DI void unit_attn_sample(const P& p, int u, char* smem) {
  const int b = u >> 1, hk = u & 1;
  const int t = threadIdx.x + opaque0(), g8 = t >> 5, l32 = t & 31;
  float* ks = (float*)smem;
  float* vs = ks + 128 * 65;
  float* qs = vs + 128 * 64;
  float* ps = qs + 512;
  float* os = ps + 1024;
  float* rs = os + 512;
  const size_t token = (size_t)NPR + b;
  __syncthreads();
  const float* kw = p.out + O_KWS + (size_t)b * 128 * 128 + hk * 64;
  const float* vw = p.out + O_VWS + (size_t)b * 128 * 128 + hk * 64;
#pragma unroll 4
  for (int i = t; i < 128 * 64; i += NTHREADS) { const int j = i >> 6, d = i & 63; ks[j * 65 + d] = kw[(size_t)j * 128 + d]; vs[j * 64 + d] = vw[(size_t)j * 128 + d]; }
#pragma unroll 1
  for (int i = t; i < 512; i += NTHREADS) qs[i] = bf2f(w_PROJ(p)[token * INW + hk * 512 + i]);
  {
    const int gi = t >> 7, ch = t & 127, g = 2 * hk + gi, win = 2 << g;
    const float cur = p.out[O_PS + ((size_t)b * 15 + 14) * 512 + g * 128 + ch];
    float tot = cur;
#pragma unroll 1
    for (int i = 1; i < win; ++i) tot += p.state_pool[((size_t)b * 15 + 15 - i) * 512 + g * 128 + ch];
    rs[gi * 128 + ch] = tot / (float)win - cur;
  }
  __syncthreads();
  const int head = hk * 8 + g8;
  float s[4];
  float m = p.sinks[head];
#pragma unroll
  for (int i = 0; i < 4; ++i) {
    const int j = l32 + 32 * i;
    float a = 0.f;
#pragma unroll 8
    for (int d = 0; d < 64; ++d) a += qs[g8 * 64 + d] * ks[j * 65 + d];
    s[i] = a + w_BIAS(p)[head * 128 + 127 - j];
    m = fmaxf(m, s[i]);
  }
  for (int o = 16; o >= 1; o >>= 1) m = fmaxf(m, __shfl_xor(m, o));
  float sum = 0.f;
#pragma unroll
  for (int i = 0; i < 4; ++i) { s[i] = __expf(s[i] - m); sum += s[i]; }
  for (int o = 16; o >= 1; o >>= 1) sum += __shfl_xor(sum, o);
  const float inv = 1.f / (sum + __expf(p.sinks[head] - m));
#pragma unroll
  for (int i = 0; i < 4; ++i) ps[g8 * 128 + l32 + 32 * i] = s[i] * inv;
  __syncthreads();
#pragma unroll
  for (int i = 0; i < 2; ++i) {
    const int d = l32 + 32 * i;
    float a = 0.f;
#pragma unroll 8
    for (int j = 0; j < 128; ++j) a += ps[g8 * 128 + j] * vs[j * 64 + d];
    os[g8 * 64 + d] = a;
  }
  __syncthreads();
#pragma unroll
  for (int i = 0; i < 2; ++i) {
    const int fl = t + 256 * i, f = hk * 512 + fl, g = f >> 8, gi = g - 2 * hk, oc = f & 255;
    float pl = 0.f;
    const float* pw = p.pool_w + (size_t)g * 128 * 256 + oc;
#pragma unroll 8
    for (int ch = 0; ch < 128; ++ch) pl += rs[gi * 128 + ch] * pw[(size_t)ch * 256];
    pl *= p.pool_scale[f];
    const float ga = bf2f(w_PROJ(p)[token * INW + C_GA + f]), gb = bf2f(w_PROJ(p)[token * INW + C_GB + f]);
    w_MIXED(p)[token * DM + f] = (bf16)(ga * os[fl] + gb * pl);
  }
}

DI void unit_gemm2(const P& p, int u, char* smem) {
  const int mt = u >> 3, nt = u & 7;
  const int n0 = nt * 128, m0 = mt * 128;
  f32x16 acc[4];
  gemm_tile(w_Wt_out(p), w_MIXED(p), 1024, n0, m0, smem, acc);
  const int tz = threadIdx.x + opaque0();
  const int lane = tz & 63, w = tz >> 6, r = lane & 31, h = lane >> 5;
  const int token = m0 + 32 * w + r;
  const float* xr = xrow(p, token);
  const float* g1 = w_MOD(p) + (size_t)cond_row(token) * 6144 + 2048;
#pragma unroll
  for (int i = 0; i < 4; ++i)
#pragma unroll
    for (int q4 = 0; q4 < 4; ++q4) {
      const int f = n0 + 32 * i + 8 * q4 + 4 * h;
      const f32x4 xv = *(const f32x4*)(xr + f), gv = *(const f32x4*)(g1 + f);
      f32x4 o;
#pragma unroll
      for (int j = 0; j < 4; ++j) o[j] = xv[j] + gv[j] * acc[i][4 * q4 + j];
      *(f32x4*)(w_X1(p) + (size_t)token * DM + f) = o;
    }
}

DI unsigned f2ord(float f) { const unsigned u = __float_as_uint(f); return (u & 0x80000000u) ? ~u : (u | 0x80000000u); }
DI float ord2f(unsigned u) { return __uint_as_float((u & 0x80000000u) ? (u & 0x7fffffffu) : ~u); }
DI unsigned umin_(unsigned a, unsigned b) { return a < b ? a : b; }
DI unsigned umax_(unsigned a, unsigned b) { return a > b ? a : b; }
template <int OFF> DI void sort16_desc(unsigned (&a)[64]) {
#pragma unroll
  for (int lk = 1; lk <= 4; ++lk)
#pragma unroll
    for (int lj = lk - 1; lj >= 0; --lj)
#pragma unroll
      for (int i = 0; i < 16; ++i) {
        const int k = 1 << lk, j = 1 << lj, l = i ^ j;
        if (l > i) {
          const unsigned lo = umin_(a[OFF + i], a[OFF + l]), hi = umax_(a[OFF + i], a[OFF + l]);
          const bool desc = (i & k) == 0;
          a[OFF + i] = desc ? hi : lo; a[OFF + l] = desc ? lo : hi;
        }
      }
}
DI void merge16_desc(unsigned (&a)[16]) {
#pragma unroll
  for (int lj = 3; lj >= 0; --lj)
#pragma unroll
    for (int i = 0; i < 16; ++i) {
      const int j = 1 << lj, l = i ^ j;
      if (l > i) { const unsigned lo = umin_(a[i], a[l]), hi = umax_(a[i], a[l]); a[i] = hi; a[l] = lo; }
    }
}
DI void top16_of_64(unsigned (&a)[64], unsigned (&out)[16]) {
  sort16_desc<0>(a); sort16_desc<16>(a); sort16_desc<32>(a); sort16_desc<48>(a);
  unsigned x[16], y[16];
#pragma unroll
  for (int i = 0; i < 16; ++i) { x[i] = umax_(a[i], a[31 - i]); y[i] = umax_(a[32 + i], a[63 - i]); }
  merge16_desc(x); merge16_desc(y);
#pragma unroll
  for (int i = 0; i < 16; ++i) out[i] = umax_(x[i], y[15 - i]);
  merge16_desc(out);
}
__device__ constexpr int COFF[16] = {0, 16, 24, 29, 33, 36, 38, 40, 42, 43, 44, 45, 46, 47, 48, 49};
DI unsigned umax3(unsigned a, unsigned b, unsigned c) { const unsigned m = a > b ? a : b; return m > c ? m : c; }

DI void unit_peer_route(const P& p, int u, char* smem) {
  const int mt = u >> 3, hd = u & 7;
  const int m0 = mt * 128;
  const int t = threadIdx.x + opaque0(), lane = t & 63, w = t >> 6, r = lane & 31, h = lane >> 5;
  unsigned char* myidx = (unsigned char*)smem + 2 * GBUF + t * 32;
  unsigned top[2][16];
#pragma unroll
  for (int pp = 0; pp < 2; ++pp) {
    f32x16 acc[4];
    gemm_tile(w_Wt_q(p), w_H(p), 1024, hd * 256 + pp * 128, m0, smem, acc);
    f32x16 sc[4] = {zero16(), zero16(), zero16(), zero16()};
    {
      const bf16* skb = w_SK(p) + (size_t)(hd * 2 + pp) * 128 * 128;
      const int wu = __builtin_amdgcn_readfirstlane(w);
#pragma unroll
      for (int q = 0; q < 8; ++q) {
        const int j = wu + 4 * q, row = 4 * j + (lane >> 4);
        glds16(skb + (size_t)row * 128 + (((lane & 15) ^ (row & 15)) * 8), smem + 1024 * j);
      }
      asm volatile("s_waitcnt vmcnt(0)" ::: "memory");
      __syncthreads();
    }
    bf16x8 bqs[8];
#pragma unroll
    for (int i = 0; i < 4; ++i)
#pragma unroll
      for (int s = 0; s < 2; ++s) bqs[2 * i + s] = pack_step(acc[i], s);
#pragma unroll
    for (int i = 0; i < 4; ++i)
#pragma unroll
      for (int s = 0; s < 2; ++s) {
        const bf16x8 bq = bqs[2 * i + s];
#pragma unroll
        for (int kt = 0; kt < 4; ++kt) {
          const int row = 32 * kt + r, cc = 4 * i + 2 * s;
          const char* rp = smem + row * 256 + 8 * h;
          const bf16x8 a = cat4(*(const bf16x4*)(rp + ((cc ^ (row & 15)) * 16)), *(const bf16x4*)(rp + (((cc + 1) ^ (row & 15)) * 16)));
          sc[kt] = MFMA(a, bq, sc[kt]);
        }
      }
    unsigned pk[64];
#pragma unroll
    for (int kt = 0; kt < 4; ++kt)
#pragma unroll
      for (int j = 0; j < 16; ++j) { const int key = 32 * kt + crow(j, h); pk[kt * 16 + j] = (f2ord(sc[kt][j]) & ~127u) | (unsigned)(127 - key); }
    unsigned mine[16];
    top16_of_64(pk, mine);
#pragma unroll
    for (int i = 0; i < 16; ++i) top[pp][i] = (unsigned)__shfl_xor((int)mine[15 - i], 32);
#pragma unroll
    for (int i = 0; i < 16; ++i) top[pp][i] = umax_(top[pp][i], mine[i]);
    merge16_desc(top[pp]);
  }
  float v0[16], v1[16];
#pragma unroll
  for (int a = 0; a < 16; ++a) {
    v0[a] = ord2f(top[0][a] & ~127u); v1[a] = ord2f(top[1][a] & ~127u);
    myidx[a] = (unsigned char)(127u - (top[0][a] & 127u)); myidx[16 + a] = (unsigned char)(127u - (top[1][a] & 127u));
  }
  unsigned cand[64];
#pragma unroll
  for (int i = 50; i < 64; ++i) cand[i] = 0u;
#pragma unroll
  for (int a = 0; a < 16; ++a)
#pragma unroll
    for (int bb = 0; bb < 16 / (a + 1); ++bb)
      cand[COFF[a] + bb] = (f2ord(v0[a] + v1[bb]) & ~255u) | (unsigned)(255 - (a * 16 + bb));
  unsigned best[16];
  top16_of_64(cand, best);
  const float smax = ord2f(best[0] & ~255u);
  float e[16], esum = 0.f;
#pragma unroll
  for (int i = 0; i < 16; ++i) { e[i] = __expf(ord2f(best[i] & ~255u) - smax); esum += e[i]; }
  const float einv = 1.f / esum;
  const size_t token = (size_t)m0 + 32 * w + r;
  int* ip = w_IDX(p) + token * 128 + hd * 16 + 8 * h;
  float* gp = w_GATE(p) + token * 128 + hd * 16 + 8 * h;
  const unsigned hmask = 0u - (unsigned)h;
#pragma unroll
  for (int i = 0; i < 8; ++i) {
    const unsigned bsel = best[i] ^ ((best[i] ^ best[8 + i]) & hmask);
    const float esel = __uint_as_float(__float_as_uint(e[i]) ^ ((__float_as_uint(e[i]) ^ __float_as_uint(e[8 + i])) & hmask));
    const unsigned code = 255u - (bsel & 255u);
    const int a = code >> 4, bb = code & 15;
    ip[i] = (int)myidx[a] * 128 + (int)myidx[16 + bb];
    gp[i] = esel * einv;
  }
}

DI float gelu_fast(float v) {
  const float av = fabsf(v), tt = __builtin_amdgcn_rcpf(av * 0.2316418882f + 1.0f);
  float q = tt * 0.5307027145f - 0.7265760135f; q = q * tt + 0.7107068705f; q = q * tt - 0.142248368f; q = q * tt + 0.127414796f; q = q * tt;
  const float e = __builtin_amdgcn_exp2f(v * v * -0.72134752044f);
  const float m = v * (q * e);
  return v < 0.f ? m : v - m;
}
DI float dot2bf(unsigned a, unsigned b, float acc) { return __builtin_amdgcn_fdot2_f32_bf16(__builtin_bit_cast(bf16x2, a), __builtin_bit_cast(bf16x2, b), acc, false); }
DI unsigned pkbf(f32x2 v) { bf16x2 r; r[0] = (bf16)v[0]; r[1] = (bf16)v[1]; return __builtin_bit_cast(unsigned, r); }
DI int dot16i(u32x4 u8, u32x4 x8, int d) {
#pragma unroll
  for (int m = 0; m < 4; ++m) d = __builtin_amdgcn_sdot4((int)u8[m], (int)x8[m], d, false);
  return d;
}
DI void axpy16p(f32x2* o, u32x4 v8, f32x2 c2) {
#pragma unroll
  for (int m = 0; m < 4; ++m) {
    const int wd = (int)v8[m];
    o[2 * m] = __builtin_elementwise_fma(c2, __builtin_amdgcn_cvt_pk_f32_fp8(wd, false), o[2 * m]);
    o[2 * m + 1] = __builtin_elementwise_fma(c2, __builtin_amdgcn_cvt_pk_f32_fp8(wd, true), o[2 * m + 1]);
  }
}
DI int dpp_add16i(int v) {
  v += __builtin_amdgcn_update_dpp(0, v, 0x140, 0xf, 0xf, true);
  v += __builtin_amdgcn_update_dpp(0, v, 0x141, 0xf, 0xf, true);
  v += __builtin_amdgcn_update_dpp(0, v, 0x4e, 0xf, 0xf, true);
  v += __builtin_amdgcn_update_dpp(0, v, 0xb1, 0xf, 0xf, true);
  return v;
}
DI float dot16(u32x4 u8, u32x4 xlo, u32x4 xhi, float d) {
#pragma unroll
  for (int m = 0; m < 4; ++m) {
    const int wd = (int)u8[m];
    const unsigned p01 = pkbf(__builtin_amdgcn_cvt_pk_f32_fp8(wd, false)), p23 = pkbf(__builtin_amdgcn_cvt_pk_f32_fp8(wd, true));
    const unsigned x01 = m < 2 ? xlo[2 * m] : xhi[2 * m - 4], x23 = m < 2 ? xlo[2 * m + 1] : xhi[2 * m - 3];
    d = dot2bf(p01, x01, d); d = dot2bf(p23, x23, d);
  }
  return d;
}
DI void axpy16(float* o, u32x4 v8, float c) {
#pragma unroll
  for (int m = 0; m < 4; ++m) {
    const int wd = (int)v8[m];
    const f32x2 a = __builtin_amdgcn_cvt_pk_f32_fp8(wd, false), b = __builtin_amdgcn_cvt_pk_f32_fp8(wd, true);
    o[4 * m] += c * a[0]; o[4 * m + 1] += c * a[1]; o[4 * m + 2] += c * b[0]; o[4 * m + 3] += c * b[1];
  }
}
DI float reduce4(const float (&d)[4], int lane) {
  const int h = lane >> 5, b4 = (lane >> 4) & 1;
  float a0 = h ? d[2] : d[0], a1 = h ? d[3] : d[1];
  const float s0 = h ? d[0] : d[2], s1 = h ? d[1] : d[3];
  a0 += __shfl_xor(s0, 32); a1 += __shfl_xor(s1, 32);
  float k = b4 ? a1 : a0;
  const float s = b4 ? a0 : a1;
  k += __shfl_xor(s, 16);
  k += __shfl_xor(k, 8); k += __shfl_xor(k, 4); k += __shfl_xor(k, 2); k += __shfl_xor(k, 1);
  return k;
}
DI float dpp_add16(float v) {
  v += __int_as_float(__builtin_amdgcn_update_dpp(0, __float_as_int(v), 0x140, 0xf, 0xf, true));
  v += __int_as_float(__builtin_amdgcn_update_dpp(0, __float_as_int(v), 0x141, 0xf, 0xf, true));
  v += __int_as_float(__builtin_amdgcn_update_dpp(0, __float_as_int(v), 0x4e, 0xf, 0xf, true));
  v += __int_as_float(__builtin_amdgcn_update_dpp(0, __float_as_int(v), 0xb1, 0xf, 0xf, true));
  return v;
}
constexpr int PEER_GLDS = 512 + 128 * 16;
constexpr int PEER_WLDS = 4 * PEER_GLDS;
DI void peer_wave4(const P& p, int g, char* wl) {
  const int lane = (threadIdx.x + opaque0()) & 63, q = lane >> 4, j16 = lane & 15;
  unsigned* hist = (unsigned*)(wl + q * PEER_GLDS);
  u32x4* list = (u32x4*)(wl + q * PEER_GLDS + 512);
  const int token = 4 * g + q;
  u32x4 x[4];
  {
    const unsigned char* hrow = w_H8(p) + (size_t)token * DM + 16 * j16;
#pragma unroll
    for (int i = 0; i < 4; ++i) x[i] = *(const u32x4*)(hrow + 256 * i);
  }
  const float xs = w_HS(p)[token];
  {
    int ids[8]; float gts[8], su[8];
#pragma unroll
    for (int i = 0; i < 8; ++i) { const size_t o = (size_t)token * 128 + j16 + 16 * i; ids[i] = w_IDX(p)[o]; gts[i] = w_GATE(p)[o]; }
#pragma unroll
    for (int i = 0; i < 8; ++i) { su[i] = w_SU(p)[ids[i]] * xs; gts[i] *= w_SV(p)[ids[i]]; }
    LDS_WAIT();
    *(u32x4*)(hist + 8 * j16) = (u32x4){0u, 0u, 0u, 0u}; *(u32x4*)(hist + 8 * j16 + 4) = (u32x4){0u, 0u, 0u, 0u};
    LDS_WAIT();
#pragma unroll
    for (int i = 0; i < 8; ++i) (void)__hip_atomic_fetch_add(&hist[ids[i] >> 7], 1u, __ATOMIC_RELAXED, __HIP_MEMORY_SCOPE_WAVEFRONT);
    LDS_WAIT();
    const u32x4 ca = *(const u32x4*)(hist + 8 * j16), cb = *(const u32x4*)(hist + 8 * j16 + 4);
    const unsigned tot = ca[0] + ca[1] + ca[2] + ca[3] + cb[0] + cb[1] + cb[2] + cb[3];
    unsigned scan = tot;
#pragma unroll
    for (int o = 1; o < 16; o <<= 1) { const unsigned tv = (unsigned)__shfl_up((int)scan, o, 16); if (j16 >= o) scan += tv; }
    unsigned e0 = scan - tot;
    u32x4 pa, pb;
    pa[0] = e0; e0 += ca[0]; pa[1] = e0; e0 += ca[1]; pa[2] = e0; e0 += ca[2]; pa[3] = e0; e0 += ca[3];
    pb[0] = e0; e0 += cb[0]; pb[1] = e0; e0 += cb[1]; pb[2] = e0; e0 += cb[2]; pb[3] = e0;
    LDS_WAIT();
    *(u32x4*)(hist + 8 * j16) = pa; *(u32x4*)(hist + 8 * j16 + 4) = pb;
    LDS_WAIT();
#pragma unroll
    for (int i = 0; i < 8; ++i) {
      const unsigned pos = __hip_atomic_fetch_add(&hist[ids[i] >> 7], 1u, __ATOMIC_RELAXED, __HIP_MEMORY_SCOPE_WAVEFRONT);
      list[pos] = (u32x4){(unsigned)ids[i], __float_as_uint(su[i]), __float_as_uint(gts[i]), 0u};
    }
    LDS_WAIT();
  }
  const unsigned char* Ub = w_Ub(p) + 16 * j16;
  const unsigned char* Vb = w_Vb(p) + 16 * j16;
  {
    u32x4 uA[4], uB[4];
    u32x4 eA = list[0], eB = list[1];
#pragma unroll
    for (int i = 0; i < 4; ++i) uA[i] = *(const u32x4*)(Ub + (size_t)eA[0] * DM + 256 * i);
#pragma unroll
    for (int i = 0; i < 4; ++i) uB[i] = *(const u32x4*)(Ub + (size_t)eB[0] * DM + 256 * i);
#define PEER_USTEP(U, E, K)                                                                                            \
    {                                                                                                                  \
      const float su = __uint_as_float(E[1]), gsv = __uint_as_float(E[2]);                                             \
      int d0 = 0, d1 = 0;                                                                                              \
      d0 = dot16i(U[0], x[0], d0); d1 = dot16i(U[1], x[1], d1); d0 = dot16i(U[2], x[2], d0); d1 = dot16i(U[3], x[3], d1); \
      E = list[(K) + 2 < 128 ? (K) + 2 : 127];                       \
      _Pragma("unroll") for (int i = 0; i < 4; ++i) U[i] = *(const u32x4*)(Ub + (size_t)E[0] * DM + 256 * i);          \
      const float c = gsv * gelu_fast(su * (float)dpp_add16i(d0 + d1));                                                \
      if (j16 == 0) ((float*)&list[K])[3] = c;                                                                          \
    }
#pragma unroll 1
    for (int k = 0; k < 128; k += 2) {
      PEER_USTEP(uA, eA, k)
      PEER_USTEP(uB, eB, k + 1)
    }
  }
  LDS_WAIT();
  f32x2 acc[32];
#pragma unroll
  for (int i = 0; i < 32; ++i) acc[i] = (f32x2){0.f, 0.f};
  {
    u32x4 vA[4], vB[4];
    u32x4 eA = list[0], eB = list[1];
#pragma unroll
    for (int i = 0; i < 4; ++i) vA[i] = *(const u32x4*)(Vb + (size_t)eA[0] * DM + 256 * i);
#pragma unroll
    for (int i = 0; i < 4; ++i) vB[i] = *(const u32x4*)(Vb + (size_t)eB[0] * DM + 256 * i);
#define PEER_VSTEP(V, E, K)                                                                                            \
    {                                                                                                                  \
      const float c = __uint_as_float(E[3]);                                                                           \
      const f32x2 c2 = {c, c};                                                                                         \
      _Pragma("unroll") for (int i = 0; i < 4; ++i) axpy16p(acc + 8 * i, V[i], c2);                                    \
      E = list[(K) + 2 < 128 ? (K) + 2 : 127];                                                                         \
      _Pragma("unroll") for (int i = 0; i < 4; ++i) V[i] = *(const u32x4*)(Vb + (size_t)E[0] * DM + 256 * i);          \
    }
#pragma unroll 1
    for (int k = 0; k < 128; k += 2) {
      PEER_VSTEP(vA, eA, k)
      PEER_VSTEP(vB, eB, k + 1)
    }
  }
  const float* x1 = w_X1(p) + (size_t)token * DM + 16 * j16;
  const float* g2 = w_MOD(p) + (size_t)cond_row(token) * 6144 + 5120 + 16 * j16;
  float* y = p.out + O_YP + (size_t)token * DM + 16 * j16;
#pragma unroll
  for (int i = 0; i < 4; ++i)
#pragma unroll
    for (int mm = 0; mm < 4; ++mm) {
      const int c0 = 256 * i + 4 * mm;
      const f32x4 xv = *(const f32x4*)(x1 + c0), gv = *(const f32x4*)(g2 + c0);
      f32x4 yv;
#pragma unroll
      for (int j = 0; j < 4; ++j) yv[j] = xv[j] + gv[j] * acc[8 * i + 2 * mm + (j >> 1)][j & 1];
      *(f32x4*)(y + c0) = yv;
    }
}
DI void peer_token_block(const P& p, int token, char* smem) {
  const int t = threadIdx.x + opaque0(), lane = t & 63, w = t >> 6;
  float* red = (float*)smem;
  const u32x4 x8 = *(const u32x4*)(w_H8(p) + (size_t)token * DM + 16 * lane);
  const int myid = w_IDX(p)[(size_t)token * 128 + 32 * w + (lane & 31)];
  const float mysu = w_SU(p)[myid] * w_HS(p)[token];
  const float mygs = w_GATE(p)[(size_t)token * 128 + 32 * w + (lane & 31)] * w_SV(p)[myid];
  float o[16];
#pragma unroll
  for (int i = 0; i < 16; ++i) o[i] = 0.f;
#pragma unroll 1
  for (int e0 = 0; e0 < 32; e0 += 4) {
    u32x4 u8[4], v8[4];
#pragma unroll
    for (int qq = 0; qq < 4; ++qq) {
      const size_t ro = (size_t)__builtin_amdgcn_readlane(myid, e0 + qq) * DM + 16 * lane;
      u8[qq] = *(const u32x4*)(w_Ub(p) + ro); v8[qq] = *(const u32x4*)(w_Vb(p) + ro);
    }
    float d[4];
#pragma unroll
    for (int qq = 0; qq < 4; ++qq) d[qq] = (float)dot16i(u8[qq], x8, 0);
    const float kv = reduce4(d, lane);
#pragma unroll
    for (int qq = 0; qq < 4; ++qq) {
      const float a = __int_as_float(__builtin_amdgcn_readlane(__float_as_int(kv), 16 * qq)) * __int_as_float(__builtin_amdgcn_readlane(__float_as_int(mysu), e0 + qq));
      const float c = __int_as_float(__builtin_amdgcn_readlane(__float_as_int(mygs), e0 + qq)) * gelu_fast(a);
      axpy16(o, v8[qq], c);
    }
  }
  __syncthreads();
#pragma unroll
  for (int i = 0; i < 16; ++i) red[w * 1024 + 16 * lane + i] = o[i];
  __syncthreads();
  if (w == 0) {
    const float* x1 = w_X1(p) + (size_t)token * DM + 16 * lane;
    const float* g2 = w_MOD(p) + (size_t)cond_row(token) * 6144 + 5120 + 16 * lane;
    float* y = p.out + O_YP + (size_t)token * DM + 16 * lane;
#pragma unroll
    for (int mm = 0; mm < 4; ++mm) {
      const f32x4 xv = *(const f32x4*)(x1 + 4 * mm), gv = *(const f32x4*)(g2 + 4 * mm);
      f32x4 yv;
#pragma unroll
      for (int j = 0; j < 4; ++j) { const int c = 16 * lane + 4 * mm + j; yv[j] = xv[j] + gv[j] * (red[c] + red[1024 + c] + red[2048 + c] + red[3072 + c]); }
      *(f32x4*)(y + 4 * mm) = yv;
    }
  }
}

constexpr int NPHASE = 8;
template <class Main, class Fill> DI void run_with_filler(int G, int bid, int nmain, int nfill, Main mainf, Fill fillf) {
  for (int u = bid; u < nmain; u += G) mainf(u);
  const int rem = nmain % G;
  if (rem == 0) { for (int f = bid; f < nfill; f += G) fillf(f); }
  else if (bid >= rem) { for (int f = bid - rem; f < nfill; f += G - rem) fillf(f); }
}
template <int PH> DI void run_phase(const P& p, char* smem) {
  const int G = gridDim.x, bid = blockIdx.x, w = __builtin_amdgcn_readfirstlane(threadIdx.x >> 6);
  if constexpr (PH == 0) { run_with_filler(G, bid, U0_MOD, F0_TOTAL, [&](int u) { unit_mod(p, u, smem); }, [&](int f) { phase0_filler(p, f, smem); }); }
  if constexpr (PH == 1) { for (int tk = bid * 4 + w; tk < NTOK; tk += G * 4) norm_row(p, tk, 0); }
  if constexpr (PH == 2) {
    run_with_filler(G, bid, 129 * 30, F2_TOTAL, [&](int u) { unit_gemm1(p, u, smem); }, [&](int f) { phase2_filler(p, f, smem); });
  }
  if constexpr (PH == 3) { for (int u = bid; u < 2048; u += G) unit_attn_prompt(p, u, smem);
                           for (int u = bid; u < 256; u += G) unit_attn_sample(p, u, smem); }
  if constexpr (PH == 4) {
    run_with_filler(G, bid, 129 * 8, F4_TOTAL, [&](int u) { unit_gemm2(p, u, smem); }, [&](int f) { if (f < F4_QU) unit_quant_rows<true>(p.peer_u, w_Ub(p), w_SU(p), f); else unit_convert(p.sub_keys, w_SK(p), f - F4_QU); });
  }
  if constexpr (PH == 5) { for (int tk = bid * 4 + w; tk < NTOK; tk += G * 4) norm_row(p, tk, 1); }
  if constexpr (PH == 6) {
    run_with_filler(G, bid, 129 * 8, F6_QV, [&](int u) { unit_peer_route(p, u, smem); }, [&](int f) { unit_quant_rows<false>(p.peer_v, w_Vb(p), w_SV(p), f); });
  }
  if constexpr (PH == 7) {
    for (int g = bid * 4 + w; g < NPR / 4; g += G * 4) peer_wave4(p, g, smem + w * PEER_WLDS);
    for (int s = bid; s < NS; s += G) peer_token_block(p, NPR + s, smem + 4 * PEER_WLDS);
  }
}
#if ONE_LAUNCH
__global__ void __launch_bounds__(NTHREADS, 2) mega(P p) {
  __shared__ __attribute__((aligned(16))) char smem[SMEM_BYTES + 16];
  volatile unsigned* st = (volatile unsigned*)(smem + SMEM_BYTES);
  if (threadIdx.x == 0) { st[0] = 0u; st[1] = 0u; }
  __syncthreads();
  const unsigned xcc = xb_xcc_id();
  if (threadIdx.x == 0) (void)xb_add(&w_bar(p)[XB_XCNT(xcc)], 1u);
#ifndef REPEAT_MASK
#define REPEAT_MASK 0
#endif
#define RUN_PH(k) do { run_phase<k>(p, smem); if ((REPEAT_MASK >> k) & 1) { xcd_barrier(w_bar(p), xcc, st); run_phase<k>(p, smem); } } while (0)
  RUN_PH(0); xcd_barrier(w_bar(p), xcc, st);
  RUN_PH(1); xcd_barrier(w_bar(p), xcc, st);
  RUN_PH(2); xcd_barrier(w_bar(p), xcc, st);
  RUN_PH(3); xcd_barrier(w_bar(p), xcc, st);
  RUN_PH(4); xcd_barrier(w_bar(p), xcc, st);
  RUN_PH(5); xcd_barrier(w_bar(p), xcc, st);
  RUN_PH(6); xcd_barrier(w_bar(p), xcc, st);
  RUN_PH(7);
}
#else
template <int PH> __global__ void __launch_bounds__(NTHREADS, 2) mega(P p) {
  __shared__ __attribute__((aligned(16))) char smem[SMEM_BYTES];
  run_phase<PH>(p, smem);
}
#endif


extern "C" void kernel_launch(void* const* d_in, const int* in_sizes, int n_in, void* d_out, int out_size, void* d_ws, size_t ws_size, hipStream_t stream) {
  P p{};
  const float* const* in = (const float* const*)d_in;
  p.x_prompt = in[0]; p.x_sample = in[1]; p.cache_k = in[2]; p.cache_v = in[3]; p.state_pool = in[4]; p.c_prompt = in[5]; p.c_sample = in[6];
  p.rel_table = in[7]; p.ada_w = in[8]; p.ada_b = in[9]; p.norm1_g = in[10]; p.w_in = in[11]; p.q_norm_g = in[12]; p.k_norm_g = in[13]; p.sinks = in[14];
  p.pool_w = in[15]; p.pool_scale = in[16]; p.w_out = in[17]; p.norm2_g = in[18]; p.w_query = in[19]; p.sub_keys = in[20]; p.peer_u = in[21]; p.peer_v = in[22];
  p.out = (float*)d_out;
  p.ws = (char*)d_ws;
  if (WS_NEED > ws_size) { fprintf(stderr, "workspace too small: need %zu have %zu\n", (size_t)WS_NEED, ws_size); return; }

  static int grid_blocks = 0;
  if (!grid_blocks) {
    int dev = 0, cus = 0, per_cu = 0;
    (void)hipGetDevice(&dev);
    (void)hipDeviceGetAttribute(&cus, hipDeviceAttributeMultiprocessorCount, dev);
#if ONE_LAUNCH
    (void)hipOccupancyMaxActiveBlocksPerMultiprocessor(&per_cu, mega, NTHREADS, 0);
#else
    per_cu = 2;
#endif
    if (per_cu > 2) per_cu = 2;
    if (per_cu < 1) per_cu = 1;
    if (cus < 1) cus = 256;
    grid_blocks = cus * per_cu;
  }
#if ONE_LAUNCH
  (void)hipMemsetAsync(p.ws + OFF_BAR, 0, XCD_BAR_WORDS * 4, stream);
  hipLaunchKernelGGL(mega, dim3(grid_blocks), dim3(NTHREADS), 0, stream, p);
#else
  hipLaunchKernelGGL(mega<0>, dim3(grid_blocks), dim3(NTHREADS), 0, stream, p);
  hipLaunchKernelGGL(mega<1>, dim3(grid_blocks), dim3(NTHREADS), 0, stream, p);
  hipLaunchKernelGGL(mega<2>, dim3(grid_blocks), dim3(NTHREADS), 0, stream, p);
  hipLaunchKernelGGL(mega<3>, dim3(grid_blocks), dim3(NTHREADS), 0, stream, p);
  hipLaunchKernelGGL(mega<4>, dim3(grid_blocks), dim3(NTHREADS), 0, stream, p);
  hipLaunchKernelGGL(mega<5>, dim3(grid_blocks), dim3(NTHREADS), 0, stream, p);
  hipLaunchKernelGGL(mega<6>, dim3(grid_blocks), dim3(NTHREADS), 0, stream, p);
  hipLaunchKernelGGL(mega<7>, dim3(grid_blocks), dim3(NTHREADS), 0, stream, p);
#endif

}
```

```cpp
#include <hip/hip_runtime.h>
#include <stdint.h>
#include <stdio.h>

#ifndef ONE_LAUNCH
#define ONE_LAUNCH 1
#endif

typedef __bf16 bf16;
typedef __bf16 bf16x2 __attribute__((ext_vector_type(2)));
typedef __bf16 bf16x4 __attribute__((ext_vector_type(4)));
typedef __bf16 bf16x8 __attribute__((ext_vector_type(8)));
typedef float f32x2 __attribute__((ext_vector_type(2)));
typedef float f32x4 __attribute__((ext_vector_type(4)));
typedef float f32x16 __attribute__((ext_vector_type(16)));
typedef unsigned u32x2 __attribute__((ext_vector_type(2)));
typedef unsigned u32x4 __attribute__((ext_vector_type(4)));

#define DI __device__ __forceinline__
#define MFMA(a, b, c) __builtin_amdgcn_mfma_f32_32x32x16_bf16((a), (b), (c), 0, 0, 0)

constexpr int DM = 1024, NB = 8, SEQ = 2048, NS = 128, NPR = NB * SEQ, NTOK = NPR + NS;
constexpr int INW = 3840, NMOD = NB + NS;
constexpr int C_K = 1024, C_V = 1152, C_PIN = 1280, C_GA = 1792, C_GB = 2816;
constexpr int NEXP = 16384;
constexpr float EPS = 1e-6f;
constexpr size_t O_YP = 0, O_KWP = 16908288, O_VWP = 17039360, O_PP = 17170432, O_KWS = 17231872, O_VWS = 19329024, O_PS = 21426176;

constexpr int SMEM_BYTES = 77824;
constexpr int NTHREADS = 256;

struct P {
  const float *x_prompt, *x_sample, *cache_k, *cache_v, *state_pool, *c_prompt, *c_sample, *rel_table, *ada_w, *ada_b, *norm1_g, *w_in,
      *q_norm_g, *k_norm_g, *sinks, *pool_w, *pool_scale, *w_out, *norm2_g, *w_query, *sub_keys, *peer_u, *peer_v;
  float* out;
  char* ws;
};
constexpr size_t al256(size_t x) { return (x + 255) & ~(size_t)255; }
constexpr size_t OFF_BAR = 0;
constexpr size_t OFF_WTIN = OFF_BAR + al256(4096 * 4);
constexpr size_t OFF_WTOUT = OFF_WTIN + al256((size_t)INW * 1024 * 2);
constexpr size_t OFF_WTQ = OFF_WTOUT + al256((size_t)1024 * 1024 * 2);
constexpr size_t OFF_SK = OFF_WTQ + al256((size_t)2048 * 1024 * 2);
constexpr size_t OFF_PWT = OFF_SK + al256((size_t)16 * 128 * 128 * 2);
constexpr size_t OFF_UB = OFF_PWT + al256((size_t)4 * 256 * 128 * 2);
constexpr size_t OFF_VB = OFF_UB + al256((size_t)NEXP * DM);
constexpr size_t OFF_SU = OFF_VB + al256((size_t)NEXP * DM);
constexpr size_t OFF_SV = OFF_SU + al256((size_t)NEXP * 4);
constexpr size_t OFF_H8 = OFF_SV + al256((size_t)NEXP * 4);
constexpr size_t OFF_HS = OFF_H8 + al256((size_t)NTOK * DM);
constexpr size_t OFF_MOD = OFF_HS + al256((size_t)NTOK * 4);
constexpr size_t OFF_BIAS = OFF_MOD + al256((size_t)NMOD * 6144 * 4);
constexpr size_t OFF_VT = OFF_BIAS + al256(16 * 128 * 4);
constexpr size_t OFF_H = OFF_VT + al256((size_t)NB * 128 * SEQ * 2);
constexpr size_t OFF_MIXED = OFF_H;
constexpr size_t OFF_PROJ = OFF_H + al256((size_t)NTOK * DM * 2);
constexpr size_t OFF_X1 = OFF_PROJ;
constexpr size_t OFF_IDX = OFF_X1 + (size_t)NTOK * DM * 4;
constexpr size_t OFF_GATE = OFF_IDX + (size_t)NTOK * 128 * 4;
constexpr size_t WS_NEED = OFF_PROJ + al256((size_t)NTOK * INW * 2);
static_assert(OFF_GATE + (size_t)NTOK * 128 * 4 <= WS_NEED, "overlay fits");
static_assert(WS_NEED <= (size_t)256 * 1024 * 1024, "workspace budget");
#define WS_PTR(T, name, OFF) __device__ __forceinline__ T* name(const P& p) { return (T*)(p.ws + (OFF)); }
WS_PTR(unsigned, w_bar, OFF_BAR) WS_PTR(bf16, w_Wt_in, OFF_WTIN) WS_PTR(bf16, w_Wt_out, OFF_WTOUT) WS_PTR(bf16, w_Wt_q, OFF_WTQ) WS_PTR(bf16, w_SK, OFF_SK)
WS_PTR(bf16, w_PWt, OFF_PWT) WS_PTR(unsigned char, w_Ub, OFF_UB) WS_PTR(unsigned char, w_Vb, OFF_VB) WS_PTR(float, w_SU, OFF_SU) WS_PTR(float, w_SV, OFF_SV) WS_PTR(unsigned char, w_H8, OFF_H8) WS_PTR(float, w_HS, OFF_HS) WS_PTR(float, w_MOD, OFF_MOD) WS_PTR(float, w_BIAS, OFF_BIAS)
WS_PTR(bf16, w_VT, OFF_VT) WS_PTR(bf16, w_H, OFF_H) WS_PTR(bf16, w_MIXED, OFF_MIXED) WS_PTR(bf16, w_PROJ, OFF_PROJ) WS_PTR(float, w_X1, OFF_X1)
WS_PTR(int, w_IDX, OFF_IDX) WS_PTR(float, w_GATE, OFF_GATE)

DI int cond_row(int token) { return token < NPR ? (token >> 11) : (NB + token - NPR); }
DI int crow(int reg, int h) { return (reg & 3) + 8 * (reg >> 2) + 4 * h; }
DI const float* xrow(const P& p, int token) { return token < NPR ? p.x_prompt + (size_t)token * DM : p.x_sample + (size_t)(token - NPR) * DM; }

#define LDS_WAIT() asm volatile("s_waitcnt lgkmcnt(0)" ::: "memory")
DI int opaque0() { int z = 0; asm volatile("" : "+v"(z)); return z; }
DI float bf2f(bf16 v) { return (float)v; }
DI f32x16 zero16() { f32x16 z; for (int i = 0; i < 16; ++i) z[i] = 0.f; return z; }
DI bf16x8 pack_step(const f32x16& x, int s) { bf16x8 v; for (int j = 0; j < 8; ++j) v[j] = (bf16)x[8 * s + j]; return v; }
DI bf16x8 cat4(bf16x4 lo, bf16x4 hi) { return __builtin_shufflevector(lo, hi, 0, 1, 2, 3, 4, 5, 6, 7); }
DI float wave_sum(float v) { for (int o = 32; o >= 1; o >>= 1) v += __shfl_xor(v, o); return v; }

#define XB_TMO 128
#define XB_XCNT(j) (256 + 64 * (j))
#define XB_XSUB(j) (1280 + 64 * (j))
#define XB_XGEN(j) (2304 + 64 * (j))
#define XB_TOP 3328
#define XB_TOPGEN 3392
#define XCD_BAR_WORDS 3456
#define XB_SPIN_CAP (1u << 22)
DI unsigned xb_ld(unsigned* p) { return __hip_atomic_load(p, __ATOMIC_RELAXED, __HIP_MEMORY_SCOPE_AGENT); }
DI unsigned xb_add(unsigned* p, unsigned v) { return __hip_atomic_fetch_add(p, v, __ATOMIC_RELAXED, __HIP_MEMORY_SCOPE_AGENT); }
DI unsigned xb_xcc_id() { return (unsigned)__builtin_amdgcn_s_getreg((3 << 11) | 20) & 0xFu; }
#define XB_SPIN(cond, bar) do { unsigned _sp = 0; while (cond) { __builtin_amdgcn_s_sleep(1); \
    if ((++_sp & 255u) == 0u) { if (xb_ld(&(bar)[XB_TMO])) break; if (_sp > XB_SPIN_CAP) { atomicAdd(&(bar)[XB_TMO], 1u); break; } } } } while (0)

DI void xcd_barrier_complete(unsigned* bar, unsigned x, unsigned& nloc, unsigned& nx) {
  const unsigned G = gridDim.x;
  unsigned sum, cnt, mine, sp = 0u;
  for (;;) {
    sum = 0u; cnt = 0u; mine = 0u;
#pragma unroll
    for (unsigned j = 0; j < 16; ++j) { const unsigned c = xb_ld(&bar[XB_XCNT(j)]); sum += c; cnt += (c > 0u) ? 1u : 0u; mine = (j == x) ? c : mine; }
    if (sum == G) break;
    __builtin_amdgcn_s_sleep(1);
    if ((++sp & 255u) == 0u) { if (xb_ld(&bar[XB_TMO])) break; if (sp > XB_SPIN_CAP) { atomicAdd(&bar[XB_TMO], 1u); break; } }
  }
  nloc = mine > 0u ? mine : 1u; nx = cnt > 0u ? cnt : 1u;
}
DI void xcd_barrier(unsigned* bar, unsigned x, volatile unsigned* st) {
  asm volatile("s_waitcnt vmcnt(0)" ::: "memory");
  __syncthreads();
  if (threadIdx.x == 0) {
    __builtin_amdgcn_s_waitcnt(0);
    unsigned nloc = st[0], nx = st[1];
    if (nloc == 0u) { xcd_barrier_complete(bar, x, nloc, nx); st[0] = nloc; st[1] = nx; }
    const unsigned old = xb_add(&bar[XB_XSUB(x)], 1u);
    const unsigned gen = old / nloc;
    if (old + 1u == (gen + 1u) * nloc) {
      __builtin_amdgcn_fence(__ATOMIC_RELEASE, "agent");
      asm volatile("s_waitcnt vmcnt(0)" ::: "memory");
      const unsigned og = xb_add(&bar[XB_TOP], 1u);
      const unsigned tg = og / nx;
      if (og + 1u == (tg + 1u) * nx) xb_add(&bar[XB_TOPGEN], 1u);
      else XB_SPIN(xb_ld(&bar[XB_TOPGEN]) == tg, bar);
      xb_add(&bar[XB_XGEN(x)], 1u);
      __builtin_amdgcn_fence(__ATOMIC_ACQUIRE, "agent");
      asm volatile("s_waitcnt vmcnt(0)" ::: "memory");
    } else {
      XB_SPIN(xb_ld(&bar[XB_XGEN(x)]) == gen, bar);
      __builtin_amdgcn_fence(__ATOMIC_ACQUIRE, "agent");
      asm volatile("s_waitcnt vmcnt(0)" ::: "memory");
    }
  }
  __syncthreads();
}

constexpr int U0_MOD = 192;
constexpr int U0_TIN = (1024 / 64) * (INW / 64);
constexpr int F0_TOTAL = U0_TIN + 1;
constexpr int U0_TPW = 4 * 2 * 4;
constexpr int U0_CSK = 32;
constexpr int U0_KW = 128, U0_VW = 128, U0_PW = 128;
constexpr int F2_TOUT = 16 * 16, F2_TQ = 16 * 32, F2_E1 = F2_TOUT + F2_TQ, F2_E2 = F2_E1 + U0_TPW, F2_E3 = F2_E2 + U0_KW, F2_E4 = F2_E3 + U0_VW,
              F2_TOTAL = F2_E4 + U0_PW;
constexpr int F4_QU = 2048, F4_TOTAL = F4_QU + U0_CSK;
constexpr int F6_QV = 2048;

DI float silu_f(float x) { return x / (1.f + __expf(-x)); }

DI void unit_mod(const P& p, int u, char* smem) {
  const int t = threadIdx.x + opaque0(), lane = t & 63, w = t >> 6, r = lane & 31, h = lane >> 5;
  const int f0 = u * 32;
  f32x16 acc[5];
#pragma unroll
  for (int i = 0; i < 5; ++i) acc[i] = zero16();
  const float* wp = p.ada_w + (size_t)(w * 256 + 8 * h) * 6144 + f0 + r;
  const float* cp[5];
#pragma unroll
  for (int i = 0; i < 5; ++i) { const int m = 32 * i + r, mm = m < NMOD ? m : 0; cp[i] = (mm < NB ? p.c_prompt + (size_t)mm * DM : p.c_sample + (size_t)(mm - NB) * DM) + w * 256 + 8 * h; }
  float wv[8]; f32x4 cv[5][2];
#pragma unroll
  for (int j = 0; j < 8; ++j) wv[j] = wp[(size_t)j * 6144];
#pragma unroll
  for (int i = 0; i < 5; ++i) { cv[i][0] = *(const f32x4*)cp[i]; cv[i][1] = *(const f32x4*)(cp[i] + 4); }
#pragma unroll 1
  for (int ks = 0; ks < 16; ++ks) {
    bf16x8 bfr, afr[5];
#pragma unroll
    for (int j = 0; j < 8; ++j) bfr[j] = (bf16)wv[j];
#pragma unroll
    for (int i = 0; i < 5; ++i) {
      const bool ok = 32 * i + r < NMOD;
#pragma unroll
      for (int j = 0; j < 8; ++j) afr[i][j] = (bf16)(ok ? silu_f(cv[i][j >> 2][j & 3]) : 0.f);
    }
    const int kn = ks + 1 < 16 ? ks + 1 : 15;
#pragma unroll
    for (int j = 0; j < 8; ++j) wv[j] = wp[(size_t)(kn * 16 + j) * 6144];
#pragma unroll
    for (int i = 0; i < 5; ++i) { cv[i][0] = *(const f32x4*)(cp[i] + kn * 16); cv[i][1] = *(const f32x4*)(cp[i] + kn * 16 + 4); }
#pragma unroll
    for (int i = 0; i < 5; ++i) acc[i] = MFMA(afr[i], bfr, acc[i]);
  }
  float* red = (float*)smem;
  __syncthreads();
  if (w > 0) {
#pragma unroll
    for (int i = 0; i < 5; ++i)
#pragma unroll
      for (int j = 0; j < 16; ++j) red[((w - 1) * 80 + i * 16 + j) * 64 + lane] = acc[i][j];
  }
  __syncthreads();
  if (w == 0) {
    const float bias = p.ada_b[f0 + r];
#pragma unroll
    for (int i = 0; i < 5; ++i)
#pragma unroll
      for (int j = 0; j < 16; ++j) {
        const int m = 32 * i + crow(j, h);
        const float v = acc[i][j] + red[(0 * 80 + i * 16 + j) * 64 + lane] + red[(1 * 80 + i * 16 + j) * 64 + lane] + red[(2 * 80 + i * 16 + j) * 64 + lane] + bias;
        if (m < NMOD) w_MOD(p)[(size_t)m * 6144 + f0 + r] = v;
      }
  }
}

DI void unit_transpose(const float* __restrict__ src, bf16* __restrict__ dst, int R, int C, int tr, int tc, char* smem) {
  float* tile = (float*)smem;
  const int t = threadIdx.x + opaque0();
  __syncthreads();
#pragma unroll
  for (int i = 0; i < 4; ++i) {
    const int rr = (t >> 4) + 16 * i, cc = (t & 15) * 4;
    const f32x4 v = *(const f32x4*)(src + (size_t)(tr * 64 + rr) * C + tc * 64 + cc);
    tile[rr * 65 + cc] = v[0]; tile[rr * 65 + cc + 1] = v[1]; tile[rr * 65 + cc + 2] = v[2]; tile[rr * 65 + cc + 3] = v[3];
  }
  __syncthreads();
#pragma unroll
  for (int i = 0; i < 2; ++i) {
    const int orow = (t >> 3) + 32 * i, seg = (t & 7) * 8;
    bf16x8 v;
#pragma unroll
    for (int j = 0; j < 8; ++j) v[j] = (bf16)tile[(seg + j) * 65 + orow];
    *(bf16x8*)(dst + (size_t)(tc * 64 + orow) * R + tr * 64 + seg) = v;
  }
}
DI void unit_convert(const float* __restrict__ src, bf16* __restrict__ dst, int u) {
  const size_t base = (size_t)u * 8192 + (threadIdx.x + opaque0()) * 8;
#pragma unroll
  for (int i = 0; i < 4; ++i) {
    const size_t o = base + (size_t)i * 2048;
    const f32x4 a = *(const f32x4*)(src + o), b = *(const f32x4*)(src + o + 4);
    bf16x8 v; v[0] = (bf16)a[0]; v[1] = (bf16)a[1]; v[2] = (bf16)a[2]; v[3] = (bf16)a[3]; v[4] = (bf16)b[0]; v[5] = (bf16)b[1]; v[6] = (bf16)b[2]; v[7] = (bf16)b[3];
    *(bf16x8*)(dst + o) = v;
  }
}
DI unsigned pack_i8(float a, float b, float c, float d) {
  const int ia = max(-127, min(127, __float2int_rn(a))), ib = max(-127, min(127, __float2int_rn(b))), ic = max(-127, min(127, __float2int_rn(c))), id = max(-127, min(127, __float2int_rn(d)));
  return (unsigned)(ia & 255) | ((unsigned)(ib & 255) << 8) | ((unsigned)(ic & 255) << 16) | ((unsigned)(id & 255) << 24);
}
template <bool I8>
DI void unit_quant_rows(const float* __restrict__ src, unsigned char* __restrict__ dst, float* __restrict__ scale, int u) {
  const int t = threadIdx.x + opaque0(), lane = t & 63, w = t >> 6;
#pragma unroll
  for (int rr = 0; rr < 2; ++rr) {
    const size_t row = (size_t)u * 8 + 2 * w + rr;
    const float* s = src + row * DM + 16 * lane;
    f32x4 v[4];
    float amax = 0.f;
#pragma unroll
    for (int i = 0; i < 4; ++i) { v[i] = *(const f32x4*)(s + 4 * i); amax = fmaxf(amax, fmaxf(fmaxf(fabsf(v[i][0]), fabsf(v[i][1])), fmaxf(fabsf(v[i][2]), fabsf(v[i][3])))); }
#pragma unroll
    for (int o = 32; o >= 1; o >>= 1) amax = fmaxf(amax, __shfl_xor(amax, o));
    const float sc = amax > 0.f ? amax * (I8 ? 1.f / 127.f : 1.f / 440.f) : 1.f, inv = 1.f / sc;
    u32x4 q;
#pragma unroll
    for (int i = 0; i < 4; ++i) {
      if (I8) {
        q[i] = pack_i8(v[i][0] * inv, v[i][1] * inv, v[i][2] * inv, v[i][3] * inv);
      } else {
        int wd = 0;
        wd = __builtin_amdgcn_cvt_pk_fp8_f32(v[i][0] * inv, v[i][1] * inv, wd, false);
        wd = __builtin_amdgcn_cvt_pk_fp8_f32(v[i][2] * inv, v[i][3] * inv, wd, true);
        q[i] = (unsigned)wd;
      }
    }
    *(u32x4*)(dst + row * DM + 16 * lane) = q;
    if (lane == 0) scale[row] = sc;
  }
}
DI void unit_copy_f4(const float* __restrict__ src, float* __restrict__ dst, int n4) {
  for (int i = threadIdx.x + opaque0(); i < n4; i += NTHREADS) ((f32x4*)dst)[i] = ((const f32x4*)src)[i];
}

DI void phase0_filler(const P& p, int f, char* smem) {
  if (f < U0_TIN) { unit_transpose(p.w_in, w_Wt_in(p), 1024, INW, f / 60, f % 60, smem); }
  else {
    for (int i = threadIdx.x + opaque0(); i < 16 * 128; i += NTHREADS) {
      const int head = i >> 7, d = i & 127;
      int bk = d;
      if (d >= 16) { bk = 16 + (int)(logf((float)d / 16.f) / logf(8.f) * 16.f); bk = bk > 31 ? 31 : bk; }
      w_BIAS(p)[i] = p.rel_table[bk * 16 + head];
    }
  }
}
DI void phase2_filler(const P& p, int f, char* smem) {
  if (f < F2_TOUT) unit_transpose(p.w_out, w_Wt_out(p), 1024, 1024, f / 16, f % 16, smem);
  else if (f < F2_E1) { const int v = f - F2_TOUT; unit_transpose(p.w_query, w_Wt_q(p), 1024, 2048, v / 32, v % 32, smem); }
  else if (f < F2_E2) { const int v = f - F2_E1, g = v >> 3, tt = v & 7; unit_transpose(p.pool_w + (size_t)g * 128 * 256, w_PWt(p) + (size_t)g * 256 * 128, 128, 256, tt >> 2, tt & 3, smem); }
  else if (f < F2_E3) { const int b = f - F2_E2; unit_copy_f4(p.cache_k + ((size_t)b * 128 + 1) * 128, p.out + O_KWS + (size_t)b * 128 * 128, 127 * 128 / 4); }
  else if (f < F2_E4) { const int b = f - F2_E3; unit_copy_f4(p.cache_v + ((size_t)b * 128 + 1) * 128, p.out + O_VWS + (size_t)b * 128 * 128, 127 * 128 / 4); }
  else { const int b = f - F2_E4; unit_copy_f4(p.state_pool + ((size_t)b * 15 + 1) * 512, p.out + O_PS + (size_t)b * 15 * 512, 14 * 512 / 4); }
}

DI void norm_row(const P& p, int token, int which) {
  const int lane = (threadIdx.x + opaque0()) & 63;
  const float* src = which == 0 ? xrow(p, token) : w_X1(p) + (size_t)token * DM;
  const float* g = which == 0 ? p.norm1_g : p.norm2_g;
  const float* mod = w_MOD(p) + (size_t)cond_row(token) * 6144 + (which == 0 ? 0 : 3072);
  f32x4 v[4];
  float ss = 0.f;
#pragma unroll
  for (int i = 0; i < 4; ++i) { v[i] = *(const f32x4*)(src + 4 * lane + 256 * i); ss += v[i][0] * v[i][0] + v[i][1] * v[i][1] + v[i][2] * v[i][2] + v[i][3] * v[i][3]; }
  ss = wave_sum(ss);
  const float rstd = rsqrtf(ss * (1.f / DM) + EPS);
#pragma unroll
  for (int i = 0; i < 4; ++i) {
    const int c = 4 * lane + 256 * i;
    const f32x4 gg = *(const f32x4*)(g + c), sh = *(const f32x4*)(mod + c), sc = *(const f32x4*)(mod + 1024 + c);
    bf16x4 o;
#pragma unroll
    for (int j = 0; j < 4; ++j) { v[i][j] = (v[i][j] * rstd * gg[j]) * (1.f + sc[j]) + sh[j]; o[j] = (bf16)v[i][j]; }
    *(bf16x4*)(w_H(p) + (size_t)token * DM + c) = o;
  }
  if (which == 1) {
    float amax = 0.f;
#pragma unroll
    for (int i = 0; i < 4; ++i) amax = fmaxf(amax, fmaxf(fmaxf(fabsf(v[i][0]), fabsf(v[i][1])), fmaxf(fabsf(v[i][2]), fabsf(v[i][3]))));
#pragma unroll
    for (int o = 32; o >= 1; o >>= 1) amax = fmaxf(amax, __shfl_xor(amax, o));
    const float qs = amax > 0.f ? amax * (1.f / 127.f) : 1.f, inv = 1.f / qs;
#pragma unroll
    for (int i = 0; i < 4; ++i) *(unsigned*)(w_H8(p) + (size_t)token * DM + 4 * lane + 256 * i) = pack_i8(v[i][0] * inv, v[i][1] * inv, v[i][2] * inv, v[i][3] * inv);
    if (lane == 0) w_HS(p)[token] = qs;
  }
}

constexpr int LDSK = 72;
constexpr int GT = 128 * 64 * 2;
constexpr int GBUF = 2 * GT;
typedef __attribute__((address_space(3))) unsigned lds_u32;
typedef const __attribute__((address_space(1))) unsigned glb_u32;
DI void glds16(const void* g, char* l) { __builtin_amdgcn_global_load_lds((glb_u32*)g, (lds_u32*)l, 16, 0, 0); }
DI void gemm_tile(const bf16* __restrict__ Wt, const bf16* __restrict__ X, int K, int n0, int m0, char* smem, f32x16 (&acc)[4]) {
  const int t = threadIdx.x + opaque0(), lane = t & 63, r = lane & 31, h = lane >> 5;
  const int w = __builtin_amdgcn_readfirstlane(t >> 6);
#pragma unroll
  for (int i = 0; i < 4; ++i) acc[i] = zero16();
  const int swz = (lane & 7) ^ ((4 * w + (lane >> 4)) & 7);
  const bf16* ga = Wt + (size_t)(n0 + 8 * w + (lane >> 3)) * K + swz * 8;
  const bf16* gb = X + (size_t)(m0 + 8 * w + (lane >> 3)) * K + swz * 8;
  const int sw = (r >> 1) & 7;
  const int KT = K >> 6;
  __syncthreads();
#pragma unroll
  for (int q = 0; q < 4; ++q) { glds16(ga + (size_t)(32 * q) * K, smem + 1024 * (w + 4 * q)); glds16(gb + (size_t)(32 * q) * K, smem + GT + 1024 * (w + 4 * q)); }
  asm volatile("s_waitcnt vmcnt(0)" ::: "memory");
  __syncthreads();
  for (int kt = 0; kt < KT; ++kt) {
    const char* As = smem + (kt & 1) * GBUF;
    const char* Bs = As + GT;
    if (kt + 1 < KT) {
      char* An = smem + ((kt + 1) & 1) * GBUF;
      const int k0 = (kt + 1) * 64;
#pragma unroll
      for (int q = 0; q < 4; ++q) { glds16(ga + (size_t)(32 * q) * K + k0, An + 1024 * (w + 4 * q)); glds16(gb + (size_t)(32 * q) * K + k0, An + GT + 1024 * (w + 4 * q)); }
    }
#pragma unroll
    for (int s = 0; s < 4; ++s) {
      const int co = ((2 * s + h) ^ sw) * 16;
      const bf16x8 bfr = *(const bf16x8*)(Bs + (32 * w + r) * 128 + co);
#pragma unroll
      for (int i = 0; i < 4; ++i) {
        const bf16x8 afr = *(const bf16x8*)(As + (32 * i + r) * 128 + co);
        acc[i] = MFMA(afr, bfr, acc[i]);
      }
    }
    asm volatile("s_waitcnt vmcnt(0)" ::: "memory");
    __syncthreads();
  }
}

DI float sigmoid_f(float x) { return 1.f / (1.f + __expf(-x)); }

DI void unit_gemm1(const P& p, int u, char* smem) {
  const int mt = u / 30, nt = u % 30;
  const int n0 = nt * 128, m0 = mt * 128;
  f32x16 acc[4];
  gemm_tile(w_Wt_in(p), w_H(p), 1024, n0, m0, smem, acc);
  const int tz = threadIdx.x + opaque0();
  const int lane = tz & 63, w = tz >> 6, r = lane & 31, h = lane >> 5;
  const int token = m0 + 32 * w + r;
  bf16* tw = (bf16*)(smem + (tz >> 6) * 16384) + r * 136;
  const bool is_prompt = token < NPR;
  const int b = is_prompt ? (token >> 11) : (token - NPR), pos = token & (SEQ - 1);
  if (n0 < C_V) {
    const float* gn = n0 < C_K ? p.q_norm_g : p.k_norm_g;
    const float post = n0 < C_K ? 0.125f : 1.f;
#pragma unroll
    for (int hh = 0; hh < 2; ++hh) {
      float ss = 0.f;
#pragma unroll
      for (int i = 0; i < 2; ++i)
#pragma unroll
        for (int j = 0; j < 16; ++j) ss += acc[2 * hh + i][j] * acc[2 * hh + i][j];
      ss += __shfl_xor(ss, 32);
      const float rstd = rsqrtf(ss * (1.f / 64.f) + EPS);
#pragma unroll
      for (int i = 0; i < 2; ++i)
#pragma unroll
        for (int q4 = 0; q4 < 4; ++q4) {
          const int d = 32 * i + 8 * q4 + 4 * h;
          const f32x4 gg = *(const f32x4*)(gn + d);
          f32x4 v;
#pragma unroll
          for (int j = 0; j < 4; ++j) v[j] = acc[2 * hh + i][4 * q4 + j] * rstd * gg[j];
          bf16x4 o;
#pragma unroll
          for (int j = 0; j < 4; ++j) o[j] = (bf16)(v[j] * post);
          *(bf16x4*)(tw + 64 * hh + d) = o;
          if (n0 == C_K) {
            if (is_prompt) { if (pos >= SEQ - 128) *(f32x4*)(p.out + O_KWP + ((size_t)b * 128 + (pos - (SEQ - 128))) * 128 + 64 * hh + d) = v; }
            else *(f32x4*)(p.out + O_KWS + ((size_t)b * 128 + 127) * 128 + 64 * hh + d) = v;
          }
        }
    }
  } else if (n0 == C_V) {
#pragma unroll
    for (int i = 0; i < 4; ++i)
#pragma unroll
      for (int q4 = 0; q4 < 4; ++q4) {
        const int f = 32 * i + 8 * q4 + 4 * h;
        f32x4 v;
#pragma unroll
        for (int j = 0; j < 4; ++j) v[j] = acc[i][4 * q4 + j];
        if (is_prompt) {
#pragma unroll
          for (int j = 0; j < 4; ++j) w_VT(p)[((size_t)b * 128 + f + j) * SEQ + pos] = (bf16)v[j];
          if (pos >= SEQ - 128) *(f32x4*)(p.out + O_VWP + ((size_t)b * 128 + (pos - (SEQ - 128))) * 128 + f) = v;
        } else *(f32x4*)(p.out + O_VWS + ((size_t)b * 128 + 127) * 128 + f) = v;
      }
  } else if (n0 < C_GA) {
#pragma unroll
    for (int i = 0; i < 4; ++i)
#pragma unroll
      for (int q4 = 0; q4 < 4; ++q4) {
        const int f = n0 + 32 * i + 8 * q4 + 4 * h;
        f32x4 v; bf16x4 o;
#pragma unroll
        for (int j = 0; j < 4; ++j) { v[j] = acc[i][4 * q4 + j]; o[j] = (bf16)v[j]; }
        *(bf16x4*)(tw + (f - n0)) = o;
        if (is_prompt) { if (pos >= SEQ - 15) *(f32x4*)(p.out + O_PP + ((size_t)b * 15 + (pos - (SEQ - 15))) * 512 + (f - C_PIN)) = v; }
        else *(f32x4*)(p.out + O_PS + ((size_t)b * 15 + 14) * 512 + (f - C_PIN)) = v;
      }
  } else {
#pragma unroll
    for (int i = 0; i < 4; ++i)
#pragma unroll
      for (int q4 = 0; q4 < 4; ++q4) {
        const int f = n0 + 32 * i + 8 * q4 + 4 * h;
        bf16x4 o;
#pragma unroll
        for (int j = 0; j < 4; ++j) o[j] = (bf16)sigmoid_f(acc[i][4 * q4 + j]);
        *(bf16x4*)(tw + (f - n0)) = o;
      }
  }
  if (n0 != C_V) {
    LDS_WAIT();
    const bf16* tr = (const bf16*)(smem + (tz >> 6) * 16384);
    bf16* pg = w_PROJ(p) + (size_t)(m0 + 32 * w + (lane >> 4)) * INW + n0 + (lane & 15) * 8;
#pragma unroll
    for (int it = 0; it < 8; ++it) *(u32x4*)(pg + (size_t)(4 * it) * INW) = *(const u32x4*)(tr + ((lane >> 4) + 4 * it) * 136 + (lane & 15) * 8);
  }
}

constexpr int VTS = 260;
constexpr int RS = 136;
DI void unit_attn_prompt(const P& p, int u, char* smem) {
  const int b = u >> 8, blk = (u >> 4) & 15, head = u & 15, hk = head >> 3;
  const int qpos0 = blk * 128;
  const int t = threadIdx.x + opaque0(), lane = t & 63, w = t >> 6, r = lane & 31, h = lane >> 5;
  bf16* Ks = (bf16*)smem;
  bf16* VTs = Ks + 256 * LDSK;
  float* bs = (float*)(VTs + 64 * VTS);
  bf16* Rs = Ks;
  __syncthreads();
#pragma unroll
  for (int i = 0; i < 8; ++i) {
    const int c = t + 256 * i, row = c >> 3, c16 = c & 7, kp = qpos0 - 128 + row;
    u32x4 v = {0u, 0u, 0u, 0u};
    if (kp >= 0) v = *(const u32x4*)(w_PROJ(p) + ((size_t)b * SEQ + kp) * INW + C_K + hk * 64 + c16 * 8);
    *(u32x4*)(Ks + row * LDSK + c16 * 8) = v;
  }
#pragma unroll
  for (int i = 0; i < 8; ++i) {
    const int c = t + 256 * i, drow = c >> 5, c16 = c & 31, kp0 = qpos0 - 128 + c16 * 8;
    u32x4 v = {0u, 0u, 0u, 0u};
    if (kp0 >= 0) v = *(const u32x4*)(w_VT(p) + ((size_t)(b * 2 + hk) * 64 + drow) * SEQ + kp0);
    u32x2* d2 = (u32x2*)(VTs + drow * VTS + c16 * 8);
    d2[0] = (u32x2){v[0], v[1]}; d2[1] = (u32x2){v[2], v[3]};
  }
  if (t < 192) { const int dist = 159 - t; bs[t] = (dist >= 0 && dist < 128) ? w_BIAS(p)[head * 128 + dist] : 0.f; }
  const int qi = 32 * w + r;
  const size_t tokq = (size_t)b * SEQ + qpos0 + qi;
  bf16x8 qf[4];
#pragma unroll
  for (int s = 0; s < 4; ++s) qf[s] = *(const bf16x8*)(w_PROJ(p) + tokq * INW + head * 64 + 16 * s + 8 * h);
  __syncthreads();
  f32x16 st[5];
#pragma unroll
  for (int tt = 0; tt < 5; ++tt) {
    st[tt] = zero16();
#pragma unroll
    for (int s = 0; s < 4; ++s) {
      const bf16x8 a = *(const bf16x8*)(Ks + (32 * (w + tt) + r) * LDSK + 16 * s + 8 * h);
      st[tt] = MFMA(a, qf[s], st[tt]);
    }
  }
  const float sink = p.sinks[head];
  float m = -INFINITY;
  {
    const int x = 31 - r + 4 * h;
    const float* bl = bs + x;
    const int kbase = blk > 0 ? 1024 : 32 * w + 4 * h;
#pragma unroll
    for (int tt = 0; tt < 5; ++tt)
#pragma unroll
      for (int j = 0; j < 16; ++j) {
        const int c = 32 * tt + (j & 3) + 8 * (j >> 2);
        const bool valid = (x + c >= 32) & (x + c <= 159) & (kbase + c >= 128);
        float bv = bl[c];
        asm volatile("" : "+v"(bv));
        const float s = valid ? st[tt][j] + bv : -INFINITY;
        st[tt][j] = s;
        m = fmaxf(m, s);
      }
  }
  m = fmaxf(m, __shfl_xor(m, 32));
  m = fmaxf(m, sink);
  float sum = 0.f;
#pragma unroll
  for (int tt = 0; tt < 5; ++tt)
#pragma unroll
    for (int j = 0; j < 16; ++j) { const float e = __expf(st[tt][j] - m); st[tt][j] = e; sum += e; }
  sum += __shfl_xor(sum, 32);
  const float inv = 1.f / (sum + __expf(sink - m));
  f32x16 o[2] = {zero16(), zero16()};
#pragma unroll
  for (int tt = 0; tt < 5; ++tt)
#pragma unroll
    for (int s = 0; s < 2; ++s) {
      const bf16x8 pb = pack_step(st[tt], s);
#pragma unroll
      for (int i = 0; i < 2; ++i) {
        const bf16* vp = VTs + (32 * i + r) * VTS + 32 * (w + tt) + 16 * s + 4 * h;
        const bf16x8 a = cat4(*(const bf16x4*)vp, *(const bf16x4*)(vp + 8));
        o[i] = MFMA(a, pb, o[i]);
      }
    }
  __syncthreads();
  const int g = head >> 2, win = 2 << g;
  {
    const int tk = t >> 4, cc = t & 15;
    const int p0 = qpos0 + tk * 8;
    const bf16* pin = w_PROJ(p) + (size_t)b * SEQ * INW + C_PIN + g * 128 + cc * 8;
    float S[8];
#pragma unroll
    for (int j = 0; j < 8; ++j) S[j] = 0.f;
    for (int i = 0; i < win; ++i) {
      const int pp = p0 - i;
      if (pp >= 0) { const bf16x8 v = *(const bf16x8*)(pin + (size_t)pp * INW);
#pragma unroll
        for (int j = 0; j < 8; ++j) S[j] += bf2f(v[j]); }
    }
    for (int i = 0; i < 8; ++i) {
      const int pos = p0 + i;
      const bf16x8 cur = *(const bf16x8*)(pin + (size_t)pos * INW);
      if (i > 0) {
#pragma unroll
        for (int j = 0; j < 8; ++j) S[j] += bf2f(cur[j]);
        if (pos - win >= 0) { const bf16x8 old = *(const bf16x8*)(pin + (size_t)(pos - win) * INW);
#pragma unroll
          for (int j = 0; j < 8; ++j) S[j] -= bf2f(old[j]); }
      }
      const float icnt = 1.f / (float)(win < pos + 1 ? win : pos + 1);
      bf16x8 rr;
#pragma unroll
      for (int j = 0; j < 8; ++j) rr[j] = (bf16)(S[j] * icnt - bf2f(cur[j]));
      *(bf16x8*)(Rs + (tk * 8 + i) * RS + cc * 8) = rr;
    }
  }
  __syncthreads();
  f32x16 pa[2] = {zero16(), zero16()};
#pragma unroll
  for (int s = 0; s < 8; ++s) {
    const bf16x8 bfr = *(const bf16x8*)(Rs + (32 * w + r) * RS + 16 * s + 8 * h);
#pragma unroll
    for (int i = 0; i < 2; ++i) {
      const bf16x8 a = *(const bf16x8*)(w_PWt(p) + ((size_t)g * 256 + (head & 3) * 64 + 32 * i + r) * 128 + 16 * s + 8 * h);
      pa[i] = MFMA(a, bfr, pa[i]);
    }
  }
  const bf16* prow = w_PROJ(p) + tokq * INW;
#pragma unroll
  for (int i = 0; i < 2; ++i)
#pragma unroll
    for (int q4 = 0; q4 < 4; ++q4) {
      const int f = head * 64 + 32 * i + 8 * q4 + 4 * h;
      const bf16x4 ga = *(const bf16x4*)(prow + C_GA + f), gb = *(const bf16x4*)(prow + C_GB + f);
      const f32x4 ps = *(const f32x4*)(p.pool_scale + f);
      bf16x4 ov;
#pragma unroll
      for (int j = 0; j < 4; ++j) ov[j] = (bf16)(bf2f(ga[j]) * (o[i][4 * q4 + j] * inv) + bf2f(gb[j]) * (pa[i][4 * q4 + j] * ps[j]));
      *(bf16x4*)(w_MIXED(p) + tokq * DM + f) = ov;
    }
}

DI void unit_attn_sample(const P& p, int u, char* smem) {
  const int b = u >> 1, hk = u & 1;
  const int t = threadIdx.x + opaque0(), g8 = t >> 5, l32 = t & 31;
  float* ks = (float*)smem;
  float* vs = ks + 128 * 65;
  float* qs = vs + 128 * 64;
  float* ps = qs + 512;
  float* os = ps + 1024;
  float* rs = os + 512;
  const size_t token = (size_t)NPR + b;
  __syncthreads();
  const float* kw = p.out + O_KWS + (size_t)b * 128 * 128 + hk * 64;
  const float* vw = p.out + O_VWS + (size_t)b * 128 * 128 + hk * 64;
#pragma unroll 4
  for (int i = t; i < 128 * 64; i += NTHREADS) { const int j = i >> 6, d = i & 63; ks[j * 65 + d] = kw[(size_t)j * 128 + d]; vs[j * 64 + d] = vw[(size_t)j * 128 + d]; }
#pragma unroll 1
  for (int i = t; i < 512; i += NTHREADS) qs[i] = bf2f(w_PROJ(p)[token * INW + hk * 512 + i]);
  {
    const int gi = t >> 7, ch = t & 127, g = 2 * hk + gi, win = 2 << g;
    const float cur = p.out[O_PS + ((size_t)b * 15 + 14) * 512 + g * 128 + ch];
    float tot = cur;
#pragma unroll 1
    for (int i = 1; i < win; ++i) tot += p.state_pool[((size_t)b * 15 + 15 - i) * 512 + g * 128 + ch];
    rs[gi * 128 + ch] = tot / (float)win - cur;
  }
  __syncthreads();
  const int head = hk * 8 + g8;
  float s[4];
  float m = p.sinks[head];
#pragma unroll
  for (int i = 0; i < 4; ++i) {
    const int j = l32 + 32 * i;
    float a = 0.f;
#pragma unroll 8
    for (int d = 0; d < 64; ++d) a += qs[g8 * 64 + d] * ks[j * 65 + d];
    s[i] = a + w_BIAS(p)[head * 128 + 127 - j];
    m = fmaxf(m, s[i]);
  }
  for (int o = 16; o >= 1; o >>= 1) m = fmaxf(m, __shfl_xor(m, o));
  float sum = 0.f;
#pragma unroll
  for (int i = 0; i < 4; ++i) { s[i] = __expf(s[i] - m); sum += s[i]; }
  for (int o = 16; o >= 1; o >>= 1) sum += __shfl_xor(sum, o);
  const float inv = 1.f / (sum + __expf(p.sinks[head] - m));
#pragma unroll
  for (int i = 0; i < 4; ++i) ps[g8 * 128 + l32 + 32 * i] = s[i] * inv;
  __syncthreads();
#pragma unroll
  for (int i = 0; i < 2; ++i) {
    const int d = l32 + 32 * i;
    float a = 0.f;
#pragma unroll 8
    for (int j = 0; j < 128; ++j) a += ps[g8 * 128 + j] * vs[j * 64 + d];
    os[g8 * 64 + d] = a;
  }
  __syncthreads();
#pragma unroll
  for (int i = 0; i < 2; ++i) {
    const int fl = t + 256 * i, f = hk * 512 + fl, g = f >> 8, gi = g - 2 * hk, oc = f & 255;
    float pl = 0.f;
    const float* pw = p.pool_w + (size_t)g * 128 * 256 + oc;
#pragma unroll 8
    for (int ch = 0; ch < 128; ++ch) pl += rs[gi * 128 + ch] * pw[(size_t)ch * 256];
    pl *= p.pool_scale[f];
    const float ga = bf2f(w_PROJ(p)[token * INW + C_GA + f]), gb = bf2f(w_PROJ(p)[token * INW + C_GB + f]);
    w_MIXED(p)[token * DM + f] = (bf16)(ga * os[fl] + gb * pl);
  }
}

DI void unit_gemm2(const P& p, int u, char* smem) {
  const int mt = u >> 3, nt = u & 7;
  const int n0 = nt * 128, m0 = mt * 128;
  f32x16 acc[4];
  gemm_tile(w_Wt_out(p), w_MIXED(p), 1024, n0, m0, smem, acc);
  const int tz = threadIdx.x + opaque0();
  const int lane = tz & 63, w = tz >> 6, r = lane & 31, h = lane >> 5;
  float* tw = (float*)(smem + w * 16896) + r * 132;
#pragma unroll
  for (int i = 0; i < 4; ++i)
#pragma unroll
    for (int q4 = 0; q4 < 4; ++q4) {
      f32x4 v;
#pragma unroll
      for (int j = 0; j < 4; ++j) v[j] = acc[i][4 * q4 + j];
      *(f32x4*)(tw + 32 * i + 8 * q4 + 4 * h) = v;
    }
  LDS_WAIT();
  const float* tr = (const float*)(smem + w * 16896);
  const int fc = (lane & 31) * 4, tsub = lane >> 5;
#pragma unroll
  for (int it = 0; it < 16; ++it) {
    const int tl = 2 * it + tsub, token = m0 + 32 * w + tl;
    const f32x4 a = *(const f32x4*)(tr + tl * 132 + fc);
    const f32x4 xv = *(const f32x4*)(xrow(p, token) + n0 + fc), gv = *(const f32x4*)(w_MOD(p) + (size_t)cond_row(token) * 6144 + 2048 + n0 + fc);
    f32x4 o;
#pragma unroll
    for (int j = 0; j < 4; ++j) o[j] = xv[j] + gv[j] * a[j];
    *(f32x4*)(w_X1(p) + (size_t)token * DM + n0 + fc) = o;
  }
}

DI unsigned f2ord(float f) { const unsigned u = __float_as_uint(f); return (u & 0x80000000u) ? ~u : (u | 0x80000000u); }
DI float ord2f(unsigned u) { return __uint_as_float((u & 0x80000000u) ? (u & 0x7fffffffu) : ~u); }
DI unsigned umin_(unsigned a, unsigned b) { return a < b ? a : b; }
DI unsigned umax_(unsigned a, unsigned b) { return a > b ? a : b; }
template <int OFF> DI void sort16_desc(unsigned (&a)[64]) {
#pragma unroll
  for (int lk = 1; lk <= 4; ++lk)
#pragma unroll
    for (int lj = lk - 1; lj >= 0; --lj)
#pragma unroll
      for (int i = 0; i < 16; ++i) {
        const int k = 1 << lk, j = 1 << lj, l = i ^ j;
        if (l > i) {
          const unsigned lo = umin_(a[OFF + i], a[OFF + l]), hi = umax_(a[OFF + i], a[OFF + l]);
          const bool desc = (i & k) == 0;
          a[OFF + i] = desc ? hi : lo; a[OFF + l] = desc ? lo : hi;
        }
      }
}
DI void merge16_desc(unsigned (&a)[16]) {
#pragma unroll
  for (int lj = 3; lj >= 0; --lj)
#pragma unroll
    for (int i = 0; i < 16; ++i) {
      const int j = 1 << lj, l = i ^ j;
      if (l > i) { const unsigned lo = umin_(a[i], a[l]), hi = umax_(a[i], a[l]); a[i] = hi; a[l] = lo; }
    }
}
DI void top16_of_64(unsigned (&a)[64], unsigned (&out)[16]) {
  sort16_desc<0>(a); sort16_desc<16>(a); sort16_desc<32>(a); sort16_desc<48>(a);
  unsigned x[16], y[16];
#pragma unroll
  for (int i = 0; i < 16; ++i) { x[i] = umax_(a[i], a[31 - i]); y[i] = umax_(a[32 + i], a[63 - i]); }
  merge16_desc(x); merge16_desc(y);
#pragma unroll
  for (int i = 0; i < 16; ++i) out[i] = umax_(x[i], y[15 - i]);
  merge16_desc(out);
}
__device__ constexpr int COFF[16] = {0, 16, 24, 29, 33, 36, 38, 40, 42, 43, 44, 45, 46, 47, 48, 49};
DI unsigned umax3(unsigned a, unsigned b, unsigned c) { const unsigned m = a > b ? a : b; return m > c ? m : c; }

DI void unit_peer_route(const P& p, int u, char* smem) {
  const int mt = u >> 3, hd = u & 7;
  const int m0 = mt * 128;
  const int t = threadIdx.x + opaque0(), lane = t & 63, w = t >> 6, r = lane & 31, h = lane >> 5;
  unsigned char* myidx = (unsigned char*)smem + 2 * GBUF + t * 32;
  unsigned top[2][16];
#pragma unroll
  for (int pp = 0; pp < 2; ++pp) {
    f32x16 acc[4];
    gemm_tile(w_Wt_q(p), w_H(p), 1024, hd * 256 + pp * 128, m0, smem, acc);
    f32x16 sc[4] = {zero16(), zero16(), zero16(), zero16()};
    {
      const bf16* skb = w_SK(p) + (size_t)(hd * 2 + pp) * 128 * 128;
      const int wu = __builtin_amdgcn_readfirstlane(w);
#pragma unroll
      for (int q = 0; q < 8; ++q) {
        const int j = wu + 4 * q, row = 4 * j + (lane >> 4);
        glds16(skb + (size_t)row * 128 + (((lane & 15) ^ (row & 15)) * 8), smem + 1024 * j);
      }
      asm volatile("s_waitcnt vmcnt(0)" ::: "memory");
      __syncthreads();
    }
    bf16x8 bqs[8];
#pragma unroll
    for (int i = 0; i < 4; ++i)
#pragma unroll
      for (int s = 0; s < 2; ++s) bqs[2 * i + s] = pack_step(acc[i], s);
#pragma unroll
    for (int i = 0; i < 4; ++i)
#pragma unroll
      for (int s = 0; s < 2; ++s) {
        const bf16x8 bq = bqs[2 * i + s];
#pragma unroll
        for (int kt = 0; kt < 4; ++kt) {
          const int row = 32 * kt + r, cc = 4 * i + 2 * s;
          const char* rp = smem + row * 256 + 8 * h;
          const bf16x8 a = cat4(*(const bf16x4*)(rp + ((cc ^ (row & 15)) * 16)), *(const bf16x4*)(rp + (((cc + 1) ^ (row & 15)) * 16)));
          sc[kt] = MFMA(a, bq, sc[kt]);
        }
      }
    unsigned pk[64];
#pragma unroll
    for (int kt = 0; kt < 4; ++kt)
#pragma unroll
      for (int j = 0; j < 16; ++j) { const int key = 32 * kt + crow(j, h); pk[kt * 16 + j] = (f2ord(sc[kt][j]) & ~127u) | (unsigned)(127 - key); }
    unsigned mine[16];
    top16_of_64(pk, mine);
#pragma unroll
    for (int i = 0; i < 16; ++i) top[pp][i] = (unsigned)__shfl_xor((int)mine[15 - i], 32);
#pragma unroll
    for (int i = 0; i < 16; ++i) top[pp][i] = umax_(top[pp][i], mine[i]);
    merge16_desc(top[pp]);
  }
  float v0[16], v1[16];
#pragma unroll
  for (int a = 0; a < 16; ++a) {
    v0[a] = ord2f(top[0][a] & ~127u); v1[a] = ord2f(top[1][a] & ~127u);
    myidx[a] = (unsigned char)(127u - (top[0][a] & 127u)); myidx[16 + a] = (unsigned char)(127u - (top[1][a] & 127u));
  }
  unsigned cand[64];
#pragma unroll
  for (int i = 50; i < 64; ++i) cand[i] = 0u;
#pragma unroll
  for (int a = 0; a < 16; ++a)
#pragma unroll
    for (int bb = 0; bb < 16 / (a + 1); ++bb)
      cand[COFF[a] + bb] = (f2ord(v0[a] + v1[bb]) & ~255u) | (unsigned)(255 - (a * 16 + bb));
  unsigned best[16];
  top16_of_64(cand, best);
  const float smax = ord2f(best[0] & ~255u);
  float e[16], esum = 0.f;
#pragma unroll
  for (int i = 0; i < 16; ++i) { e[i] = __expf(ord2f(best[i] & ~255u) - smax); esum += e[i]; }
  const float einv = 1.f / esum;
  const size_t token = (size_t)m0 + 32 * w + r;
  int* ip = w_IDX(p) + token * 128 + hd * 16 + 8 * h;
  float* gp = w_GATE(p) + token * 128 + hd * 16 + 8 * h;
  const unsigned hmask = 0u - (unsigned)h;
#pragma unroll
  for (int i = 0; i < 8; ++i) {
    const unsigned bsel = best[i] ^ ((best[i] ^ best[8 + i]) & hmask);
    const float esel = __uint_as_float(__float_as_uint(e[i]) ^ ((__float_as_uint(e[i]) ^ __float_as_uint(e[8 + i])) & hmask));
    const unsigned code = 255u - (bsel & 255u);
    const int a = code >> 4, bb = code & 15;
    ip[i] = (int)myidx[a] * 128 + (int)myidx[16 + bb];
    gp[i] = esel * einv;
  }
}

DI float gelu_fast(float v) {
  const float av = fabsf(v), tt = __builtin_amdgcn_rcpf(av * 0.2316418882f + 1.0f);
  float q = tt * 0.5307027145f - 0.7265760135f; q = q * tt + 0.7107068705f; q = q * tt - 0.142248368f; q = q * tt + 0.127414796f; q = q * tt;
  const float e = __builtin_amdgcn_exp2f(v * v * -0.72134752044f);
  const float m = v * (q * e);
  return v < 0.f ? m : v - m;
}
DI float dot2bf(unsigned a, unsigned b, float acc) { return __builtin_amdgcn_fdot2_f32_bf16(__builtin_bit_cast(bf16x2, a), __builtin_bit_cast(bf16x2, b), acc, false); }
DI unsigned pkbf(f32x2 v) { bf16x2 r; r[0] = (bf16)v[0]; r[1] = (bf16)v[1]; return __builtin_bit_cast(unsigned, r); }
DI int dot16i(u32x4 u8, u32x4 x8, int d) {
#pragma unroll
  for (int m = 0; m < 4; ++m) d = __builtin_amdgcn_sdot4((int)u8[m], (int)x8[m], d, false);
  return d;
}
DI void axpy16p(f32x2* o, u32x4 v8, f32x2 c2) {
#pragma unroll
  for (int m = 0; m < 4; ++m) {
    const int wd = (int)v8[m];
    o[2 * m] = __builtin_elementwise_fma(c2, __builtin_amdgcn_cvt_pk_f32_fp8(wd, false), o[2 * m]);
    o[2 * m + 1] = __builtin_elementwise_fma(c2, __builtin_amdgcn_cvt_pk_f32_fp8(wd, true), o[2 * m + 1]);
  }
}
DI int dpp_add16i(int v) {
  v += __builtin_amdgcn_update_dpp(0, v, 0x140, 0xf, 0xf, true);
  v += __builtin_amdgcn_update_dpp(0, v, 0x141, 0xf, 0xf, true);
  v += __builtin_amdgcn_update_dpp(0, v, 0x4e, 0xf, 0xf, true);
  v += __builtin_amdgcn_update_dpp(0, v, 0xb1, 0xf, 0xf, true);
  return v;
}
DI float dot16(u32x4 u8, u32x4 xlo, u32x4 xhi, float d) {
#pragma unroll
  for (int m = 0; m < 4; ++m) {
    const int wd = (int)u8[m];
    const unsigned p01 = pkbf(__builtin_amdgcn_cvt_pk_f32_fp8(wd, false)), p23 = pkbf(__builtin_amdgcn_cvt_pk_f32_fp8(wd, true));
    const unsigned x01 = m < 2 ? xlo[2 * m] : xhi[2 * m - 4], x23 = m < 2 ? xlo[2 * m + 1] : xhi[2 * m - 3];
    d = dot2bf(p01, x01, d); d = dot2bf(p23, x23, d);
  }
  return d;
}
DI void axpy16(float* o, u32x4 v8, float c) {
#pragma unroll
  for (int m = 0; m < 4; ++m) {
    const int wd = (int)v8[m];
    const f32x2 a = __builtin_amdgcn_cvt_pk_f32_fp8(wd, false), b = __builtin_amdgcn_cvt_pk_f32_fp8(wd, true);
    o[4 * m] += c * a[0]; o[4 * m + 1] += c * a[1]; o[4 * m + 2] += c * b[0]; o[4 * m + 3] += c * b[1];
  }
}
DI float reduce4(const float (&d)[4], int lane) {
  const int h = lane >> 5, b4 = (lane >> 4) & 1;
  float a0 = h ? d[2] : d[0], a1 = h ? d[3] : d[1];
  const float s0 = h ? d[0] : d[2], s1 = h ? d[1] : d[3];
  a0 += __shfl_xor(s0, 32); a1 += __shfl_xor(s1, 32);
  float k = b4 ? a1 : a0;
  const float s = b4 ? a0 : a1;
  k += __shfl_xor(s, 16);
  k += __shfl_xor(k, 8); k += __shfl_xor(k, 4); k += __shfl_xor(k, 2); k += __shfl_xor(k, 1);
  return k;
}
DI float dpp_add16(float v) {
  v += __int_as_float(__builtin_amdgcn_update_dpp(0, __float_as_int(v), 0x140, 0xf, 0xf, true));
  v += __int_as_float(__builtin_amdgcn_update_dpp(0, __float_as_int(v), 0x141, 0xf, 0xf, true));
  v += __int_as_float(__builtin_amdgcn_update_dpp(0, __float_as_int(v), 0x4e, 0xf, 0xf, true));
  v += __int_as_float(__builtin_amdgcn_update_dpp(0, __float_as_int(v), 0xb1, 0xf, 0xf, true));
  return v;
}
constexpr int PEER_GLDS = 512 + 128 * 16;
constexpr int PEER_WLDS = 4 * PEER_GLDS;
DI void peer_wave4(const P& p, int g, char* wl) {
  const int lane = (threadIdx.x + opaque0()) & 63, q = lane >> 4, j16 = lane & 15;
  unsigned* hist = (unsigned*)(wl + q * PEER_GLDS);
  u32x4* list = (u32x4*)(wl + q * PEER_GLDS + 512);
  const int token = 4 * g + q;
  u32x4 x[4];
  {
    const unsigned char* hrow = w_H8(p) + (size_t)token * DM + 16 * j16;
#pragma unroll
    for (int i = 0; i < 4; ++i) x[i] = *(const u32x4*)(hrow + 256 * i);
  }
  const float xs = w_HS(p)[token];
  {
    int ids[8]; float gts[8], su[8];
#pragma unroll
    for (int i = 0; i < 8; ++i) { const size_t o = (size_t)token * 128 + j16 + 16 * i; ids[i] = w_IDX(p)[o]; gts[i] = w_GATE(p)[o]; }
#pragma unroll
    for (int i = 0; i < 8; ++i) { su[i] = w_SU(p)[ids[i]] * xs; gts[i] *= w_SV(p)[ids[i]]; }
    LDS_WAIT();
    *(u32x4*)(hist + 8 * j16) = (u32x4){0u, 0u, 0u, 0u}; *(u32x4*)(hist + 8 * j16 + 4) = (u32x4){0u, 0u, 0u, 0u};
    LDS_WAIT();
#pragma unroll
    for (int i = 0; i < 8; ++i) (void)__hip_atomic_fetch_add(&hist[ids[i] >> 7], 1u, __ATOMIC_RELAXED, __HIP_MEMORY_SCOPE_WAVEFRONT);
    LDS_WAIT();
    const u32x4 ca = *(const u32x4*)(hist + 8 * j16), cb = *(const u32x4*)(hist + 8 * j16 + 4);
    const unsigned tot = ca[0] + ca[1] + ca[2] + ca[3] + cb[0] + cb[1] + cb[2] + cb[3];
    unsigned scan = tot;
#pragma unroll
    for (int o = 1; o < 16; o <<= 1) { const unsigned tv = (unsigned)__shfl_up((int)scan, o, 16); if (j16 >= o) scan += tv; }
    unsigned e0 = scan - tot;
    u32x4 pa, pb;
    pa[0] = e0; e0 += ca[0]; pa[1] = e0; e0 += ca[1]; pa[2] = e0; e0 += ca[2]; pa[3] = e0; e0 += ca[3];
    pb[0] = e0; e0 += cb[0]; pb[1] = e0; e0 += cb[1]; pb[2] = e0; e0 += cb[2]; pb[3] = e0;
    LDS_WAIT();
    *(u32x4*)(hist + 8 * j16) = pa; *(u32x4*)(hist + 8 * j16 + 4) = pb;
    LDS_WAIT();
#pragma unroll
    for (int i = 0; i < 8; ++i) {
      const unsigned pos = __hip_atomic_fetch_add(&hist[ids[i] >> 7], 1u, __ATOMIC_RELAXED, __HIP_MEMORY_SCOPE_WAVEFRONT);
      list[pos] = (u32x4){(unsigned)ids[i], __float_as_uint(su[i]), __float_as_uint(gts[i]), 0u};
    }
    LDS_WAIT();
  }
  const unsigned char* Ub = w_Ub(p) + 16 * j16;
  const unsigned char* Vb = w_Vb(p) + 16 * j16;
  {
    u32x4 uA[4], uB[4];
    u32x4 eA = list[0], eB = list[1];
#pragma unroll
    for (int i = 0; i < 4; ++i) uA[i] = *(const u32x4*)(Ub + (size_t)eA[0] * DM + 256 * i);
#pragma unroll
    for (int i = 0; i < 4; ++i) uB[i] = *(const u32x4*)(Ub + (size_t)eB[0] * DM + 256 * i);
#define PEER_USTEP(U, E, K)                                                                                            \
    {                                                                                                                  \
      const float su = __uint_as_float(E[1]), gsv = __uint_as_float(E[2]);                                             \
      int d0 = 0, d1 = 0;                                                                                              \
      d0 = dot16i(U[0], x[0], d0); d1 = dot16i(U[1], x[1], d1); d0 = dot16i(U[2], x[2], d0); d1 = dot16i(U[3], x[3], d1); \
      E = list[(K) + 2 < 128 ? (K) + 2 : 127];                       \
      _Pragma("unroll") for (int i = 0; i < 4; ++i) U[i] = *(const u32x4*)(Ub + (size_t)E[0] * DM + 256 * i);          \
      const float c = gsv * gelu_fast(su * (float)dpp_add16i(d0 + d1));                                                \
      if (j16 == 0) ((float*)&list[K])[3] = c;                                                                          \
    }
#pragma unroll 1
    for (int k = 0; k < 128; k += 2) {
      PEER_USTEP(uA, eA, k)
      PEER_USTEP(uB, eB, k + 1)
    }
  }
  LDS_WAIT();
  f32x2 acc[32];
#pragma unroll
  for (int i = 0; i < 32; ++i) acc[i] = (f32x2){0.f, 0.f};
  {
    u32x4 vA[4], vB[4];
    u32x4 eA = list[0], eB = list[1];
#pragma unroll
    for (int i = 0; i < 4; ++i) vA[i] = *(const u32x4*)(Vb + (size_t)eA[0] * DM + 256 * i);
#pragma unroll
    for (int i = 0; i < 4; ++i) vB[i] = *(const u32x4*)(Vb + (size_t)eB[0] * DM + 256 * i);
#define PEER_VSTEP(V, E, K)                                                                                            \
    {                                                                                                                  \
      const float c = __uint_as_float(E[3]);                                                                           \
      const f32x2 c2 = {c, c};                                                                                         \
      _Pragma("unroll") for (int i = 0; i < 4; ++i) axpy16p(acc + 8 * i, V[i], c2);                                    \
      E = list[(K) + 2 < 128 ? (K) + 2 : 127];                                                                         \
      _Pragma("unroll") for (int i = 0; i < 4; ++i) V[i] = *(const u32x4*)(Vb + (size_t)E[0] * DM + 256 * i);          \
    }
#pragma unroll 1
    for (int k = 0; k < 128; k += 2) {
      PEER_VSTEP(vA, eA, k)
      PEER_VSTEP(vB, eB, k + 1)
    }
  }
  const float* x1 = w_X1(p) + (size_t)token * DM + 16 * j16;
  const float* g2 = w_MOD(p) + (size_t)cond_row(token) * 6144 + 5120 + 16 * j16;
  float* y = p.out + O_YP + (size_t)token * DM + 16 * j16;
#pragma unroll
  for (int i = 0; i < 4; ++i)
#pragma unroll
    for (int mm = 0; mm < 4; ++mm) {
      const int c0 = 256 * i + 4 * mm;
      const f32x4 xv = *(const f32x4*)(x1 + c0), gv = *(const f32x4*)(g2 + c0);
      f32x4 yv;
#pragma unroll
      for (int j = 0; j < 4; ++j) yv[j] = xv[j] + gv[j] * acc[8 * i + 2 * mm + (j >> 1)][j & 1];
      *(f32x4*)(y + c0) = yv;
    }
}
DI void peer_token_block(const P& p, int token, char* smem) {
  const int t = threadIdx.x + opaque0(), lane = t & 63, w = t >> 6;
  float* red = (float*)smem;
  const u32x4 x8 = *(const u32x4*)(w_H8(p) + (size_t)token * DM + 16 * lane);
  const int myid = w_IDX(p)[(size_t)token * 128 + 32 * w + (lane & 31)];
  const float mysu = w_SU(p)[myid] * w_HS(p)[token];
  const float mygs = w_GATE(p)[(size_t)token * 128 + 32 * w + (lane & 31)] * w_SV(p)[myid];
  float o[16];
#pragma unroll
  for (int i = 0; i < 16; ++i) o[i] = 0.f;
#pragma unroll 1
  for (int e0 = 0; e0 < 32; e0 += 4) {
    u32x4 u8[4], v8[4];
#pragma unroll
    for (int qq = 0; qq < 4; ++qq) {
      const size_t ro = (size_t)__builtin_amdgcn_readlane(myid, e0 + qq) * DM + 16 * lane;
      u8[qq] = *(const u32x4*)(w_Ub(p) + ro); v8[qq] = *(const u32x4*)(w_Vb(p) + ro);
    }
    float d[4];
#pragma unroll
    for (int qq = 0; qq < 4; ++qq) d[qq] = (float)dot16i(u8[qq], x8, 0);
    const float kv = reduce4(d, lane);
#pragma unroll
    for (int qq = 0; qq < 4; ++qq) {
      const float a = __int_as_float(__builtin_amdgcn_readlane(__float_as_int(kv), 16 * qq)) * __int_as_float(__builtin_amdgcn_readlane(__float_as_int(mysu), e0 + qq));
      const float c = __int_as_float(__builtin_amdgcn_readlane(__float_as_int(mygs), e0 + qq)) * gelu_fast(a);
      axpy16(o, v8[qq], c);
    }
  }
  __syncthreads();
#pragma unroll
  for (int i = 0; i < 16; ++i) red[w * 1024 + 16 * lane + i] = o[i];
  __syncthreads();
  if (w == 0) {
    const float* x1 = w_X1(p) + (size_t)token * DM + 16 * lane;
    const float* g2 = w_MOD(p) + (size_t)cond_row(token) * 6144 + 5120 + 16 * lane;
    float* y = p.out + O_YP + (size_t)token * DM + 16 * lane;
#pragma unroll
    for (int mm = 0; mm < 4; ++mm) {
      const f32x4 xv = *(const f32x4*)(x1 + 4 * mm), gv = *(const f32x4*)(g2 + 4 * mm);
      f32x4 yv;
#pragma unroll
      for (int j = 0; j < 4; ++j) { const int c = 16 * lane + 4 * mm + j; yv[j] = xv[j] + gv[j] * (red[c] + red[1024 + c] + red[2048 + c] + red[3072 + c]); }
      *(f32x4*)(y + 4 * mm) = yv;
    }
  }
}

constexpr int NPHASE = 8;
template <class Main, class Fill> DI void run_with_filler(int G, int bid, int nmain, int nfill, Main mainf, Fill fillf) {
  for (int u = bid; u < nmain; u += G) mainf(u);
  const int rem = nmain % G;
  if (rem == 0) { for (int f = bid; f < nfill; f += G) fillf(f); }
  else if (bid >= rem) { for (int f = bid - rem; f < nfill; f += G - rem) fillf(f); }
}
template <int PH> DI void run_phase(const P& p, char* smem) {
  const int G = gridDim.x, bid = blockIdx.x, w = __builtin_amdgcn_readfirstlane(threadIdx.x >> 6);
  if constexpr (PH == 0) { run_with_filler(G, bid, U0_MOD, F0_TOTAL, [&](int u) { unit_mod(p, u, smem); }, [&](int f) { phase0_filler(p, f, smem); }); }
  if constexpr (PH == 1) { for (int tk = bid * 4 + w; tk < NTOK; tk += G * 4) norm_row(p, tk, 0); }
  if constexpr (PH == 2) {
    run_with_filler(G, bid, 129 * 30, F2_TOTAL, [&](int u) { unit_gemm1(p, u, smem); }, [&](int f) { phase2_filler(p, f, smem); });
  }
  if constexpr (PH == 3) { for (int u = bid; u < 2048; u += G) unit_attn_prompt(p, u, smem);
                           for (int u = bid; u < 256; u += G) unit_attn_sample(p, u, smem); }
  if constexpr (PH == 4) {
    run_with_filler(G, bid, 129 * 8, F4_TOTAL, [&](int u) { unit_gemm2(p, u, smem); }, [&](int f) { if (f < F4_QU) unit_quant_rows<true>(p.peer_u, w_Ub(p), w_SU(p), f); else unit_convert(p.sub_keys, w_SK(p), f - F4_QU); });
  }
  if constexpr (PH == 5) { for (int tk = bid * 4 + w; tk < NTOK; tk += G * 4) norm_row(p, tk, 1); }
  if constexpr (PH == 6) {
    run_with_filler(G, bid, 129 * 8, F6_QV, [&](int u) { unit_peer_route(p, u, smem); }, [&](int f) { unit_quant_rows<false>(p.peer_v, w_Vb(p), w_SV(p), f); });
  }
  if constexpr (PH == 7) {
    for (int g = bid * 4 + w; g < NPR / 4; g += G * 4) peer_wave4(p, g, smem + w * PEER_WLDS);
    for (int s = bid; s < NS; s += G) peer_token_block(p, NPR + s, smem + 4 * PEER_WLDS);
  }
}
#if ONE_LAUNCH
__global__ void __launch_bounds__(NTHREADS, 2) mega(P p) {
  __shared__ __attribute__((aligned(16))) char smem[SMEM_BYTES + 16];
  volatile unsigned* st = (volatile unsigned*)(smem + SMEM_BYTES);
  if (threadIdx.x == 0) { st[0] = 0u; st[1] = 0u; }
  __syncthreads();
  const unsigned xcc = xb_xcc_id();
  if (threadIdx.x == 0) (void)xb_add(&w_bar(p)[XB_XCNT(xcc)], 1u);
#ifndef REPEAT_MASK
#define REPEAT_MASK 0
#endif
#define RUN_PH(k) do { run_phase<k>(p, smem); if ((REPEAT_MASK >> k) & 1) { xcd_barrier(w_bar(p), xcc, st); run_phase<k>(p, smem); } } while (0)
  RUN_PH(0); xcd_barrier(w_bar(p), xcc, st);
  RUN_PH(1); xcd_barrier(w_bar(p), xcc, st);
  RUN_PH(2); xcd_barrier(w_bar(p), xcc, st);
  RUN_PH(3); xcd_barrier(w_bar(p), xcc, st);
  RUN_PH(4); xcd_barrier(w_bar(p), xcc, st);
  RUN_PH(5); xcd_barrier(w_bar(p), xcc, st);
  RUN_PH(6); xcd_barrier(w_bar(p), xcc, st);
  RUN_PH(7);
}
#else
template <int PH> __global__ void __launch_bounds__(NTHREADS, 2) mega(P p) {
  __shared__ __attribute__((aligned(16))) char smem[SMEM_BYTES];
  run_phase<PH>(p, smem);
}
#endif


extern "C" void kernel_launch(void* const* d_in, const int* in_sizes, int n_in, void* d_out, int out_size, void* d_ws, size_t ws_size, hipStream_t stream) {
  P p{};
  const float* const* in = (const float* const*)d_in;
  p.x_prompt = in[0]; p.x_sample = in[1]; p.cache_k = in[2]; p.cache_v = in[3]; p.state_pool = in[4]; p.c_prompt = in[5]; p.c_sample = in[6];
  p.rel_table = in[7]; p.ada_w = in[8]; p.ada_b = in[9]; p.norm1_g = in[10]; p.w_in = in[11]; p.q_norm_g = in[12]; p.k_norm_g = in[13]; p.sinks = in[14];
  p.pool_w = in[15]; p.pool_scale = in[16]; p.w_out = in[17]; p.norm2_g = in[18]; p.w_query = in[19]; p.sub_keys = in[20]; p.peer_u = in[21]; p.peer_v = in[22];
  p.out = (float*)d_out;
  p.ws = (char*)d_ws;
  if (WS_NEED > ws_size) { fprintf(stderr, "workspace too small: need %zu have %zu\n", (size_t)WS_NEED, ws_size); return; }

  static int grid_blocks = 0;
  if (!grid_blocks) {
    int dev = 0, cus = 0, per_cu = 0;
    (void)hipGetDevice(&dev);
    (void)hipDeviceGetAttribute(&cus, hipDeviceAttributeMultiprocessorCount, dev);
#if ONE_LAUNCH
    (void)hipOccupancyMaxActiveBlocksPerMultiprocessor(&per_cu, mega, NTHREADS, 0);
#else
    per_cu = 2;
#endif
    if (per_cu > 2) per_cu = 2;
    if (per_cu < 1) per_cu = 1;
    if (cus < 1) cus = 256;
    grid_blocks = cus * per_cu;
  }
#if ONE_LAUNCH
  (void)hipMemsetAsync(p.ws + OFF_BAR, 0, XCD_BAR_WORDS * 4, stream);
  hipLaunchKernelGGL(mega, dim3(grid_blocks), dim3(NTHREADS), 0, stream, p);
#else
  hipLaunchKernelGGL(mega<0>, dim3(grid_blocks), dim3(NTHREADS), 0, stream, p);
  hipLaunchKernelGGL(mega<1>, dim3(grid_blocks), dim3(NTHREADS), 0, stream, p);
  hipLaunchKernelGGL(mega<2>, dim3(grid_blocks), dim3(NTHREADS), 0, stream, p);
  hipLaunchKernelGGL(mega<3>, dim3(grid_blocks), dim3(NTHREADS), 0, stream, p);
  hipLaunchKernelGGL(mega<4>, dim3(grid_blocks), dim3(NTHREADS), 0, stream, p);
  hipLaunchKernelGGL(mega<5>, dim3(grid_blocks), dim3(NTHREADS), 0, stream, p);
  hipLaunchKernelGGL(mega<6>, dim3(grid_blocks), dim3(NTHREADS), 0, stream, p);
  hipLaunchKernelGGL(mega<7>, dim3(grid_blocks), dim3(NTHREADS), 0, stream, p);
#endif

}
```

```cpp
#include <hip/hip_runtime.h>
#include <stdint.h>
#include <stdio.h>

#ifndef ONE_LAUNCH
#define ONE_LAUNCH 1
#endif

typedef __bf16 bf16;
typedef __bf16 bf16x2 __attribute__((ext_vector_type(2)));
typedef __bf16 bf16x4 __attribute__((ext_vector_type(4)));
typedef __bf16 bf16x8 __attribute__((ext_vector_type(8)));
typedef float f32x2 __attribute__((ext_vector_type(2)));
typedef float f32x4 __attribute__((ext_vector_type(4)));
typedef float f32x16 __attribute__((ext_vector_type(16)));
typedef unsigned u32x2 __attribute__((ext_vector_type(2)));
typedef unsigned u32x4 __attribute__((ext_vector_type(4)));

#define DI __device__ __forceinline__
#define MFMA(a, b, c) __builtin_amdgcn_mfma_f32_32x32x16_bf16((a), (b), (c), 0, 0, 0)

constexpr int DM = 1024, NB = 8, SEQ = 2048, NS = 128, NPR = NB * SEQ, NTOK = NPR + NS;
constexpr int INW = 3840, NMOD = NB + NS;
constexpr int C_K = 1024, C_V = 1152, C_PIN = 1280, C_GA = 1792, C_GB = 2816;
constexpr int NEXP = 16384;
constexpr float EPS = 1e-6f;
constexpr size_t O_YP = 0, O_KWP = 16908288, O_VWP = 17039360, O_PP = 17170432, O_KWS = 17231872, O_VWS = 19329024, O_PS = 21426176;

constexpr int SMEM_BYTES = 77824;
constexpr int NTHREADS = 256;

struct P {
  const float *x_prompt, *x_sample, *cache_k, *cache_v, *state_pool, *c_prompt, *c_sample, *rel_table, *ada_w, *ada_b, *norm1_g, *w_in,
      *q_norm_g, *k_norm_g, *sinks, *pool_w, *pool_scale, *w_out, *norm2_g, *w_query, *sub_keys, *peer_u, *peer_v;
  float* out;
  char* ws;
};
constexpr size_t al256(size_t x) { return (x + 255) & ~(size_t)255; }
constexpr size_t OFF_BAR = 0;
constexpr size_t OFF_WTIN = OFF_BAR + al256(4096 * 4);
constexpr size_t OFF_WTOUT = OFF_WTIN + al256((size_t)INW * 1024 * 2);
constexpr size_t OFF_WTQ = OFF_WTOUT + al256((size_t)1024 * 1024 * 2);
constexpr size_t OFF_SK = OFF_WTQ + al256((size_t)2048 * 1024 * 2);
constexpr size_t OFF_PWT = OFF_SK + al256((size_t)16 * 128 * 128 * 2);
constexpr size_t OFF_UB = OFF_PWT + al256((size_t)4 * 256 * 128 * 2);
constexpr size_t OFF_VB = OFF_UB + al256((size_t)NEXP * DM);
constexpr size_t OFF_SU = OFF_VB + al256((size_t)NEXP * DM);
constexpr size_t OFF_SV = OFF_SU + al256((size_t)NEXP * 4);
constexpr size_t OFF_H8 = OFF_SV + al256((size_t)NEXP * 4);
constexpr size_t OFF_HS = OFF_H8 + al256((size_t)NTOK * DM);
constexpr size_t OFF_MOD = OFF_HS + al256((size_t)NTOK * 4);
constexpr size_t OFF_BIAS = OFF_MOD + al256((size_t)NMOD * 6144 * 4);
constexpr size_t OFF_VT = OFF_BIAS + al256(16 * 128 * 4);
constexpr size_t OFF_H = OFF_VT + al256((size_t)NB * 128 * SEQ * 2);
constexpr size_t OFF_MIXED = OFF_H;
constexpr size_t OFF_PROJ = OFF_H + al256((size_t)NTOK * DM * 2);
constexpr size_t OFF_X1 = OFF_PROJ;
constexpr size_t OFF_IDX = OFF_X1 + (size_t)NTOK * DM * 4;
constexpr size_t OFF_GATE = OFF_IDX + (size_t)NTOK * 128 * 4;
constexpr size_t WS_NEED = OFF_PROJ + al256((size_t)NTOK * INW * 2);
static_assert(OFF_GATE + (size_t)NTOK * 128 * 4 <= WS_NEED, "overlay fits");
static_assert(WS_NEED <= (size_t)256 * 1024 * 1024, "workspace budget");
#define WS_PTR(T, name, OFF) __device__ __forceinline__ T* name(const P& p) { return (T*)(p.ws + (OFF)); }
WS_PTR(unsigned, w_bar, OFF_BAR) WS_PTR(bf16, w_Wt_in, OFF_WTIN) WS_PTR(bf16, w_Wt_out, OFF_WTOUT) WS_PTR(bf16, w_Wt_q, OFF_WTQ) WS_PTR(bf16, w_SK, OFF_SK)
WS_PTR(bf16, w_PWt, OFF_PWT) WS_PTR(unsigned char, w_Ub, OFF_UB) WS_PTR(unsigned char, w_Vb, OFF_VB) WS_PTR(float, w_SU, OFF_SU) WS_PTR(float, w_SV, OFF_SV) WS_PTR(unsigned char, w_H8, OFF_H8) WS_PTR(float, w_HS, OFF_HS) WS_PTR(float, w_MOD, OFF_MOD) WS_PTR(float, w_BIAS, OFF_BIAS)
WS_PTR(bf16, w_VT, OFF_VT) WS_PTR(bf16, w_H, OFF_H) WS_PTR(bf16, w_MIXED, OFF_MIXED) WS_PTR(bf16, w_PROJ, OFF_PROJ) WS_PTR(float, w_X1, OFF_X1)
WS_PTR(int, w_IDX, OFF_IDX) WS_PTR(float, w_GATE, OFF_GATE)

DI int cond_row(int token) { return token < NPR ? (token >> 11) : (NB + token - NPR); }
DI int crow(int reg, int h) { return (reg & 3) + 8 * (reg >> 2) + 4 * h; }
DI const float* xrow(const P& p, int token) { return token < NPR ? p.x_prompt + (size_t)token * DM : p.x_sample + (size_t)(token - NPR) * DM; }

#define LDS_WAIT() asm volatile("s_waitcnt lgkmcnt(0)" ::: "memory")
DI int opaque0() { int z = 0; asm volatile("" : "+v"(z)); return z; }
DI float bf2f(bf16 v) { return (float)v; }
DI f32x16 zero16() { f32x16 z; for (int i = 0; i < 16; ++i) z[i] = 0.f; return z; }
DI bf16x8 pack_step(const f32x16& x, int s) { bf16x8 v; for (int j = 0; j < 8; ++j) v[j] = (bf16)x[8 * s + j]; return v; }
DI bf16x8 cat4(bf16x4 lo, bf16x4 hi) { return __builtin_shufflevector(lo, hi, 0, 1, 2, 3, 4, 5, 6, 7); }
DI float wave_sum(float v) { for (int o = 32; o >= 1; o >>= 1) v += __shfl_xor(v, o); return v; }

#define XB_TMO 128
#define XB_XCNT(j) (256 + 64 * (j))
#define XB_XSUB(j) (1280 + 64 * (j))
#define XB_XGEN(j) (2304 + 64 * (j))
#define XB_TOP 3328
#define XB_TOPGEN 3392
#define XCD_BAR_WORDS 3456
#define XB_SPIN_CAP (1u << 22)
DI unsigned xb_ld(unsigned* p) { return __hip_atomic_load(p, __ATOMIC_RELAXED, __HIP_MEMORY_SCOPE_AGENT); }
DI unsigned xb_add(unsigned* p, unsigned v) { return __hip_atomic_fetch_add(p, v, __ATOMIC_RELAXED, __HIP_MEMORY_SCOPE_AGENT); }
DI unsigned xb_xcc_id() { return (unsigned)__builtin_amdgcn_s_getreg((3 << 11) | 20) & 0xFu; }
#define XB_SPIN(cond, bar) do { unsigned _sp = 0; while (cond) { __builtin_amdgcn_s_sleep(1); \
    if ((++_sp & 255u) == 0u) { if (xb_ld(&(bar)[XB_TMO])) break; if (_sp > XB_SPIN_CAP) { atomicAdd(&(bar)[XB_TMO], 1u); break; } } } } while (0)

DI void xcd_barrier_complete(unsigned* bar, unsigned x, unsigned& nloc, unsigned& nx) {
  const unsigned G = gridDim.x;
  unsigned sum, cnt, mine, sp = 0u;
  for (;;) {
    sum = 0u; cnt = 0u; mine = 0u;
#pragma unroll
    for (unsigned j = 0; j < 16; ++j) { const unsigned c = xb_ld(&bar[XB_XCNT(j)]); sum += c; cnt += (c > 0u) ? 1u : 0u; mine = (j == x) ? c : mine; }
    if (sum == G) break;
    __builtin_amdgcn_s_sleep(1);
    if ((++sp & 255u) == 0u) { if (xb_ld(&bar[XB_TMO])) break; if (sp > XB_SPIN_CAP) { atomicAdd(&bar[XB_TMO], 1u); break; } }
  }
  nloc = mine > 0u ? mine : 1u; nx = cnt > 0u ? cnt : 1u;
}
DI void xcd_barrier(unsigned* bar, unsigned x, volatile unsigned* st) {
  asm volatile("s_waitcnt vmcnt(0)" ::: "memory");
  __syncthreads();
  if (threadIdx.x == 0) {
    __builtin_amdgcn_s_waitcnt(0);
    unsigned nloc = st[0], nx = st[1];
    if (nloc == 0u) { xcd_barrier_complete(bar, x, nloc, nx); st[0] = nloc; st[1] = nx; }
    const unsigned old = xb_add(&bar[XB_XSUB(x)], 1u);
    const unsigned gen = old / nloc;
    if (old + 1u == (gen + 1u) * nloc) {
      __builtin_amdgcn_fence(__ATOMIC_RELEASE, "agent");
      asm volatile("s_waitcnt vmcnt(0)" ::: "memory");
      const unsigned og = xb_add(&bar[XB_TOP], 1u);
      const unsigned tg = og / nx;
      if (og + 1u == (tg + 1u) * nx) xb_add(&bar[XB_TOPGEN], 1u);
      else XB_SPIN(xb_ld(&bar[XB_TOPGEN]) == tg, bar);
      xb_add(&bar[XB_XGEN(x)], 1u);
      __builtin_amdgcn_fence(__ATOMIC_ACQUIRE, "agent");
      asm volatile("s_waitcnt vmcnt(0)" ::: "memory");
    } else {
      XB_SPIN(xb_ld(&bar[XB_XGEN(x)]) == gen, bar);
      __builtin_amdgcn_fence(__ATOMIC_ACQUIRE, "agent");
      asm volatile("s_waitcnt vmcnt(0)" ::: "memory");
    }
  }
  __syncthreads();
}

constexpr int U0_MOD = 192;
constexpr int U0_TIN = (1024 / 64) * (INW / 64);
constexpr int F0_TOTAL = U0_TIN + 1;
constexpr int U0_TPW = 4 * 2 * 4;
constexpr int U0_CSK = 32;
constexpr int U0_KW = 128, U0_VW = 128, U0_PW = 128;
constexpr int F2_TOUT = 16 * 16, F2_TQ = 16 * 32, F2_E1 = F2_TOUT + F2_TQ, F2_E2 = F2_E1 + U0_TPW, F2_E3 = F2_E2 + U0_KW, F2_E4 = F2_E3 + U0_VW,
              F2_TOTAL = F2_E4 + U0_PW;
constexpr int F4_QU = 2048, F4_TOTAL = F4_QU + U0_CSK;
constexpr int F6_QV = 2048;

DI float silu_f(float x) { return x * __builtin_amdgcn_rcpf(1.f + __expf(-x)); }

DI void unit_mod(const P& p, int u, char* smem) {
  const int t = threadIdx.x + opaque0(), lane = t & 63, w = t >> 6, r = lane & 31, h = lane >> 5;
  const int f0 = u * 32;
  f32x16 acc[5];
#pragma unroll
  for (int i = 0; i < 5; ++i) acc[i] = zero16();
  const float* wp = p.ada_w + (size_t)(w * 256 + 8 * h) * 6144 + f0 + r;
  const float* cp[5];
#pragma unroll
  for (int i = 0; i < 5; ++i) { const int m = 32 * i + r, mm = m < NMOD ? m : 0; cp[i] = (mm < NB ? p.c_prompt + (size_t)mm * DM : p.c_sample + (size_t)(mm - NB) * DM) + w * 256 + 8 * h; }
  float wv[8]; f32x4 cv[5][2];
#pragma unroll
  for (int j = 0; j < 8; ++j) wv[j] = wp[(size_t)j * 6144];
#pragma unroll
  for (int i = 0; i < 5; ++i) { cv[i][0] = *(const f32x4*)cp[i]; cv[i][1] = *(const f32x4*)(cp[i] + 4); }
#pragma unroll 1
  for (int ks = 0; ks < 16; ++ks) {
    bf16x8 bfr, afr[5];
#pragma unroll
    for (int j = 0; j < 8; ++j) bfr[j] = (bf16)wv[j];
#pragma unroll
    for (int i = 0; i < 5; ++i) {
      const bool ok = 32 * i + r < NMOD;
#pragma unroll
      for (int j = 0; j < 8; ++j) afr[i][j] = (bf16)(ok ? silu_f(cv[i][j >> 2][j & 3]) : 0.f);
    }
    const int kn = ks + 1 < 16 ? ks + 1 : 15;
#pragma unroll
    for (int j = 0; j < 8; ++j) wv[j] = wp[(size_t)(kn * 16 + j) * 6144];
#pragma unroll
    for (int i = 0; i < 5; ++i) { cv[i][0] = *(const f32x4*)(cp[i] + kn * 16); cv[i][1] = *(const f32x4*)(cp[i] + kn * 16 + 4); }
#pragma unroll
    for (int i = 0; i < 5; ++i) acc[i] = MFMA(afr[i], bfr, acc[i]);
  }
  float* red = (float*)smem;
  __syncthreads();
  if (w > 0) {
#pragma unroll
    for (int i = 0; i < 5; ++i)
#pragma unroll
      for (int j = 0; j < 16; ++j) red[((w - 1) * 80 + i * 16 + j) * 64 + lane] = acc[i][j];
  }
  __syncthreads();
  if (w == 0) {
    const float bias = p.ada_b[f0 + r];
#pragma unroll
    for (int i = 0; i < 5; ++i)
#pragma unroll
      for (int j = 0; j < 16; ++j) {
        const int m = 32 * i + crow(j, h);
        const float v = acc[i][j] + red[(0 * 80 + i * 16 + j) * 64 + lane] + red[(1 * 80 + i * 16 + j) * 64 + lane] + red[(2 * 80 + i * 16 + j) * 64 + lane] + bias;
        if (m < NMOD) w_MOD(p)[(size_t)m * 6144 + f0 + r] = v;
      }
  }
}

DI void unit_transpose(const float* __restrict__ src, bf16* __restrict__ dst, int R, int C, int tr, int tc, char* smem) {
  float* tile = (float*)smem;
  const int t = threadIdx.x + opaque0();
  __syncthreads();
#pragma unroll
  for (int i = 0; i < 4; ++i) {
    const int rr = (t >> 4) + 16 * i, cc = (t & 15) * 4;
    const f32x4 v = *(const f32x4*)(src + (size_t)(tr * 64 + rr) * C + tc * 64 + cc);
    tile[rr * 65 + cc] = v[0]; tile[rr * 65 + cc + 1] = v[1]; tile[rr * 65 + cc + 2] = v[2]; tile[rr * 65 + cc + 3] = v[3];
  }
  __syncthreads();
#pragma unroll
  for (int i = 0; i < 2; ++i) {
    const int orow = (t >> 3) + 32 * i, seg = (t & 7) * 8;
    bf16x8 v;
#pragma unroll
    for (int j = 0; j < 8; ++j) v[j] = (bf16)tile[(seg + j) * 65 + orow];
    *(bf16x8*)(dst + (size_t)(tc * 64 + orow) * R + tr * 64 + seg) = v;
  }
}
DI void unit_convert(const float* __restrict__ src, bf16* __restrict__ dst, int u) {
  const size_t base = (size_t)u * 8192 + (threadIdx.x + opaque0()) * 8;
#pragma unroll
  for (int i = 0; i < 4; ++i) {
    const size_t o = base + (size_t)i * 2048;
    const f32x4 a = *(const f32x4*)(src + o), b = *(const f32x4*)(src + o + 4);
    bf16x8 v; v[0] = (bf16)a[0]; v[1] = (bf16)a[1]; v[2] = (bf16)a[2]; v[3] = (bf16)a[3]; v[4] = (bf16)b[0]; v[5] = (bf16)b[1]; v[6] = (bf16)b[2]; v[7] = (bf16)b[3];
    *(bf16x8*)(dst + o) = v;
  }
}
DI unsigned pack_i8(float a, float b, float c, float d) {
  const int ia = max(-127, min(127, __float2int_rn(a))), ib = max(-127, min(127, __float2int_rn(b))), ic = max(-127, min(127, __float2int_rn(c))), id = max(-127, min(127, __float2int_rn(d)));
  return (unsigned)(ia & 255) | ((unsigned)(ib & 255) << 8) | ((unsigned)(ic & 255) << 16) | ((unsigned)(id & 255) << 24);
}
template <bool I8>
DI void unit_quant_rows(const float* __restrict__ src, unsigned char* __restrict__ dst, float* __restrict__ scale, int u) {
  const int t = threadIdx.x + opaque0(), lane = t & 63, w = t >> 6;
#pragma unroll
  for (int rr = 0; rr < 2; ++rr) {
    const size_t row = (size_t)u * 8 + 2 * w + rr;
    const float* s = src + row * DM + 16 * lane;
    f32x4 v[4];
    float amax = 0.f;
#pragma unroll
    for (int i = 0; i < 4; ++i) { v[i] = *(const f32x4*)(s + 4 * i); amax = fmaxf(amax, fmaxf(fmaxf(fabsf(v[i][0]), fabsf(v[i][1])), fmaxf(fabsf(v[i][2]), fabsf(v[i][3])))); }
#pragma unroll
    for (int o = 32; o >= 1; o >>= 1) amax = fmaxf(amax, __shfl_xor(amax, o));
    const float sc = amax > 0.f ? amax * (I8 ? 1.f / 127.f : 1.f / 440.f) : 1.f, inv = 1.f / sc;
    u32x4 q;
#pragma unroll
    for (int i = 0; i < 4; ++i) {
      if (I8) {
        q[i] = pack_i8(v[i][0] * inv, v[i][1] * inv, v[i][2] * inv, v[i][3] * inv);
      } else {
        int wd = 0;
        wd = __builtin_amdgcn_cvt_pk_fp8_f32(v[i][0] * inv, v[i][1] * inv, wd, false);
        wd = __builtin_amdgcn_cvt_pk_fp8_f32(v[i][2] * inv, v[i][3] * inv, wd, true);
        q[i] = (unsigned)wd;
      }
    }
    *(u32x4*)(dst + row * DM + 16 * lane) = q;
    if (lane == 0) scale[row] = sc;
  }
}
DI void unit_copy_f4(const float* __restrict__ src, float* __restrict__ dst, int n4) {
  for (int i = threadIdx.x + opaque0(); i < n4; i += NTHREADS) ((f32x4*)dst)[i] = ((const f32x4*)src)[i];
}

DI void phase0_filler(const P& p, int f, char* smem) {
  if (f < U0_TIN) { unit_transpose(p.w_in, w_Wt_in(p), 1024, INW, f / 60, f % 60, smem); }
  else {
    for (int i = threadIdx.x + opaque0(); i < 16 * 128; i += NTHREADS) {
      const int head = i >> 7, d = i & 127;
      int bk = d;
      if (d >= 16) { bk = 16 + (int)(logf((float)d / 16.f) / logf(8.f) * 16.f); bk = bk > 31 ? 31 : bk; }
      w_BIAS(p)[i] = p.rel_table[bk * 16 + head];
    }
  }
}
DI void phase2_filler(const P& p, int f, char* smem) {
  if (f < F2_TOUT) unit_transpose(p.w_out, w_Wt_out(p), 1024, 1024, f / 16, f % 16, smem);
  else if (f < F2_E1) { const int v = f - F2_TOUT; unit_transpose(p.w_query, w_Wt_q(p), 1024, 2048, v / 32, v % 32, smem); }
  else if (f < F2_E2) { const int v = f - F2_E1, g = v >> 3, tt = v & 7; unit_transpose(p.pool_w + (size_t)g * 128 * 256, w_PWt(p) + (size_t)g * 256 * 128, 128, 256, tt >> 2, tt & 3, smem); }
  else if (f < F2_E3) { const int b = f - F2_E2; unit_copy_f4(p.cache_k + ((size_t)b * 128 + 1) * 128, p.out + O_KWS + (size_t)b * 128 * 128, 127 * 128 / 4); }
  else if (f < F2_E4) { const int b = f - F2_E3; unit_copy_f4(p.cache_v + ((size_t)b * 128 + 1) * 128, p.out + O_VWS + (size_t)b * 128 * 128, 127 * 128 / 4); }
  else { const int b = f - F2_E4; unit_copy_f4(p.state_pool + ((size_t)b * 15 + 1) * 512, p.out + O_PS + (size_t)b * 15 * 512, 14 * 512 / 4); }
}

DI void norm_row(const P& p, int token, int which) {
  const int lane = (threadIdx.x + opaque0()) & 63;
  const float* src = which == 0 ? xrow(p, token) : w_X1(p) + (size_t)token * DM;
  const float* g = which == 0 ? p.norm1_g : p.norm2_g;
  const float* mod = w_MOD(p) + (size_t)cond_row(token) * 6144 + (which == 0 ? 0 : 3072);
  f32x4 v[4];
  float ss = 0.f;
#pragma unroll
  for (int i = 0; i < 4; ++i) { v[i] = *(const f32x4*)(src + 4 * lane + 256 * i); ss += v[i][0] * v[i][0] + v[i][1] * v[i][1] + v[i][2] * v[i][2] + v[i][3] * v[i][3]; }
  ss = wave_sum(ss);
  const float rstd = rsqrtf(ss * (1.f / DM) + EPS);
#pragma unroll
  for (int i = 0; i < 4; ++i) {
    const int c = 4 * lane + 256 * i;
    const f32x4 gg = *(const f32x4*)(g + c), sh = *(const f32x4*)(mod + c), sc = *(const f32x4*)(mod + 1024 + c);
    bf16x4 o;
#pragma unroll
    for (int j = 0; j < 4; ++j) { v[i][j] = (v[i][j] * rstd * gg[j]) * (1.f + sc[j]) + sh[j]; o[j] = (bf16)v[i][j]; }
    *(bf16x4*)(w_H(p) + (size_t)token * DM + c) = o;
  }
  if (which == 1) {
    float amax = 0.f;
#pragma unroll
    for (int i = 0; i < 4; ++i) amax = fmaxf(amax, fmaxf(fmaxf(fabsf(v[i][0]), fabsf(v[i][1])), fmaxf(fabsf(v[i][2]), fabsf(v[i][3]))));
#pragma unroll
    for (int o = 32; o >= 1; o >>= 1) amax = fmaxf(amax, __shfl_xor(amax, o));
    const float qs = amax > 0.f ? amax * (1.f / 127.f) : 1.f, inv = 1.f / qs;
#pragma unroll
    for (int i = 0; i < 4; ++i) *(unsigned*)(w_H8(p) + (size_t)token * DM + 4 * lane + 256 * i) = pack_i8(v[i][0] * inv, v[i][1] * inv, v[i][2] * inv, v[i][3] * inv);
    if (lane == 0) w_HS(p)[token] = qs;
  }
}

constexpr int LDSK = 72;
constexpr int GT = 128 * 64 * 2;
constexpr int GBUF = 2 * GT;
typedef __attribute__((address_space(3))) unsigned lds_u32;
typedef const __attribute__((address_space(1))) unsigned glb_u32;
DI void glds16(const void* g, char* l) { __builtin_amdgcn_global_load_lds((glb_u32*)g, (lds_u32*)l, 16, 0, 0); }
DI void gemm_first(const bf16* __restrict__ Wt, const bf16* __restrict__ X, int K, int n0, int m0, char* smem) {
  const int t = threadIdx.x + opaque0(), lane = t & 63;
  const int w = __builtin_amdgcn_readfirstlane(t >> 6);
  const int swz = (lane & 7) ^ ((4 * w + (lane >> 4)) & 7);
  const bf16* ga = Wt + (size_t)(n0 + 8 * w + (lane >> 3)) * K + swz * 8;
  const bf16* gb = X + (size_t)(m0 + 8 * w + (lane >> 3)) * K + swz * 8;
#pragma unroll
  for (int q = 0; q < 4; ++q) { glds16(ga + (size_t)(32 * q) * K, smem + 1024 * (w + 4 * q)); glds16(gb + (size_t)(32 * q) * K, smem + GT + 1024 * (w + 4 * q)); }
}
DI void gemm_main(const bf16* __restrict__ Wt, const bf16* __restrict__ X, int K, int n0, int m0, char* smem, f32x16 (&acc)[4]) {
  const int t = threadIdx.x + opaque0(), lane = t & 63, r = lane & 31, h = lane >> 5;
  const int w = __builtin_amdgcn_readfirstlane(t >> 6);
#pragma unroll
  for (int i = 0; i < 4; ++i) acc[i] = zero16();
  const int swz = (lane & 7) ^ ((4 * w + (lane >> 4)) & 7);
  const bf16* ga = Wt + (size_t)(n0 + 8 * w + (lane >> 3)) * K + swz * 8;
  const bf16* gb = X + (size_t)(m0 + 8 * w + (lane >> 3)) * K + swz * 8;
  const int sw = (r >> 1) & 7;
  const int KT = K >> 6;
  asm volatile("s_waitcnt vmcnt(0)" ::: "memory");
  __syncthreads();
  for (int kt = 0; kt < KT; ++kt) {
    const char* As = smem + (kt & 1) * GBUF;
    const char* Bs = As + GT;
    if (kt + 1 < KT) {
      char* An = smem + ((kt + 1) & 1) * GBUF;
      const int k0 = (kt + 1) * 64;
#pragma unroll
      for (int q = 0; q < 4; ++q) { glds16(ga + (size_t)(32 * q) * K + k0, An + 1024 * (w + 4 * q)); glds16(gb + (size_t)(32 * q) * K + k0, An + GT + 1024 * (w + 4 * q)); }
    }
#pragma unroll
    for (int s = 0; s < 4; ++s) {
      const int co = ((2 * s + h) ^ sw) * 16;
      const bf16x8 bfr = *(const bf16x8*)(Bs + (32 * w + r) * 128 + co);
#pragma unroll
      for (int i = 0; i < 4; ++i) {
        const bf16x8 afr = *(const bf16x8*)(As + (32 * i + r) * 128 + co);
        acc[i] = MFMA(afr, bfr, acc[i]);
      }
    }
    asm volatile("s_waitcnt vmcnt(0)" ::: "memory");
    __syncthreads();
  }
}

DI float sigmoid_f(float x) { return __builtin_amdgcn_rcpf(1.f + __expf(-x)); }

DI void unit_gemm1(const P& p, int u, int un, char* smem) {
  const int mt = u / 30, nt = u % 30;
  const int n0 = nt * 128, m0 = mt * 128;
  f32x16 acc[4];
  gemm_main(w_Wt_in(p), w_H(p), 1024, n0, m0, smem, acc);
  if (un >= 0) gemm_first(w_Wt_in(p), w_H(p), 1024, (un % 30) * 128, (un / 30) * 128, smem);
  const int tz = threadIdx.x + opaque0();
  const int lane = tz & 63, w = tz >> 6, r = lane & 31, h = lane >> 5;
  const int token = m0 + 32 * w + r;
  bf16* tw = (bf16*)(smem + GBUF + (tz >> 6) * 8704) + r * 136;
  const bool is_prompt = token < NPR;
  const int b = is_prompt ? (token >> 11) : (token - NPR), pos = token & (SEQ - 1);
  if (n0 < C_V) {
    const float* gn = n0 < C_K ? p.q_norm_g : p.k_norm_g;
    const float post = n0 < C_K ? 0.125f : 1.f;
#pragma unroll
    for (int hh = 0; hh < 2; ++hh) {
      float ss = 0.f;
#pragma unroll
      for (int i = 0; i < 2; ++i)
#pragma unroll
        for (int j = 0; j < 16; ++j) ss += acc[2 * hh + i][j] * acc[2 * hh + i][j];
      ss += __shfl_xor(ss, 32);
      const float rstd = rsqrtf(ss * (1.f / 64.f) + EPS);
#pragma unroll
      for (int i = 0; i < 2; ++i)
#pragma unroll
        for (int q4 = 0; q4 < 4; ++q4) {
          const int d = 32 * i + 8 * q4 + 4 * h;
          const f32x4 gg = *(const f32x4*)(gn + d);
          f32x4 v;
#pragma unroll
          for (int j = 0; j < 4; ++j) v[j] = acc[2 * hh + i][4 * q4 + j] * rstd * gg[j];
          bf16x4 o;
#pragma unroll
          for (int j = 0; j < 4; ++j) o[j] = (bf16)(v[j] * post);
          *(bf16x4*)(tw + 64 * hh + d) = o;
          if (n0 == C_K) {
            if (is_prompt) { if (pos >= SEQ - 128) *(f32x4*)(p.out + O_KWP + ((size_t)b * 128 + (pos - (SEQ - 128))) * 128 + 64 * hh + d) = v; }
            else *(f32x4*)(p.out + O_KWS + ((size_t)b * 128 + 127) * 128 + 64 * hh + d) = v;
          }
        }
    }
  } else if (n0 == C_V) {
#pragma unroll
    for (int i = 0; i < 4; ++i)
#pragma unroll
      for (int q4 = 0; q4 < 4; ++q4) {
        const int f = 32 * i + 8 * q4 + 4 * h;
        f32x4 v;
#pragma unroll
        for (int j = 0; j < 4; ++j) v[j] = acc[i][4 * q4 + j];
        if (is_prompt) {
#pragma unroll
          for (int j = 0; j < 4; ++j) w_VT(p)[((size_t)b * 128 + f + j) * SEQ + pos] = (bf16)v[j];
          if (pos >= SEQ - 128) *(f32x4*)(p.out + O_VWP + ((size_t)b * 128 + (pos - (SEQ - 128))) * 128 + f) = v;
        } else *(f32x4*)(p.out + O_VWS + ((size_t)b * 128 + 127) * 128 + f) = v;
      }
  } else if (n0 < C_GA) {
#pragma unroll
    for (int i = 0; i < 4; ++i)
#pragma unroll
      for (int q4 = 0; q4 < 4; ++q4) {
        const int f = n0 + 32 * i + 8 * q4 + 4 * h;
        f32x4 v; bf16x4 o;
#pragma unroll
        for (int j = 0; j < 4; ++j) { v[j] = acc[i][4 * q4 + j]; o[j] = (bf16)v[j]; }
        *(bf16x4*)(tw + (f - n0)) = o;
        if (is_prompt) { if (pos >= SEQ - 15) *(f32x4*)(p.out + O_PP + ((size_t)b * 15 + (pos - (SEQ - 15))) * 512 + (f - C_PIN)) = v; }
        else *(f32x4*)(p.out + O_PS + ((size_t)b * 15 + 14) * 512 + (f - C_PIN)) = v;
      }
  } else {
#pragma unroll
    for (int i = 0; i < 4; ++i)
#pragma unroll
      for (int q4 = 0; q4 < 4; ++q4) {
        const int f = n0 + 32 * i + 8 * q4 + 4 * h;
        bf16x4 o;
#pragma unroll
        for (int j = 0; j < 4; ++j) o[j] = (bf16)sigmoid_f(acc[i][4 * q4 + j]);
        *(bf16x4*)(tw + (f - n0)) = o;
      }
  }
  if (n0 != C_V) {
    LDS_WAIT();
    const bf16* tr = (const bf16*)(smem + GBUF + (tz >> 6) * 8704);
    bf16* pg = w_PROJ(p) + (size_t)(m0 + 32 * w + (lane >> 4)) * INW + n0 + (lane & 15) * 8;
#pragma unroll
    for (int it = 0; it < 8; ++it) *(u32x4*)(pg + (size_t)(4 * it) * INW) = *(const u32x4*)(tr + ((lane >> 4) + 4 * it) * 136 + (lane & 15) * 8);
  }
}

constexpr int VTS = 260;
constexpr int RS = 136;
DI void attn_head(const P& p, int head, int blk, int w, int r, int h, size_t tokq, const bf16* Ks, const bf16* VTs, const float* bsh, bf16x8 (&ob)[4]) {
  const int qi = 32 * w + r;
  bf16x8 qf[4];
#pragma unroll
  for (int s = 0; s < 4; ++s) qf[s] = *(const bf16x8*)(w_PROJ(p) + tokq * INW + head * 64 + 16 * s + 8 * h);
  f32x16 st[5];
#pragma unroll
  for (int tt = 0; tt < 5; ++tt) {
    st[tt] = zero16();
#pragma unroll
    for (int s = 0; s < 4; ++s) {
      const bf16x8 a = *(const bf16x8*)(Ks + (32 * (w + tt) + r) * LDSK + 16 * s + 8 * h);
      st[tt] = MFMA(a, qf[s], st[tt]);
    }
  }
  const float sink = p.sinks[head];
  float m = -INFINITY;
  {
    const int x = 31 - r + 4 * h;
    const float* bl = bsh + x;
#pragma unroll
    for (int tt = 0; tt < 5; ++tt)
#pragma unroll
      for (int j = 0; j < 16; ++j) {
        const int c = 32 * tt + (j & 3) + 8 * (j >> 2);
        const float s = st[tt][j] + bl[c];
        st[tt][j] = s;
        m = fmaxf(m, s);
      }
    if (blk == 0) {
      m = -INFINITY;
#pragma unroll
      for (int tt = 0; tt < 5; ++tt)
#pragma unroll
        for (int j = 0; j < 16; ++j) {
          const int c = 32 * tt + (j & 3) + 8 * (j >> 2);
          const float s = (159 - (x + c) > qi) ? -INFINITY : st[tt][j];
          st[tt][j] = s;
          m = fmaxf(m, s);
        }
    }
  }
  m = fmaxf(m, __shfl_xor(m, 32));
  m = fmaxf(m, sink);
  float sum = 0.f;
#pragma unroll
  for (int tt = 0; tt < 5; ++tt)
#pragma unroll
    for (int j = 0; j < 16; ++j) { const float e = __expf(st[tt][j] - m); st[tt][j] = e; sum += e; }
  sum += __shfl_xor(sum, 32);
  const float inv = 1.f / (sum + __expf(sink - m));
  f32x16 o[2] = {zero16(), zero16()};
#pragma unroll
  for (int tt = 0; tt < 5; ++tt)
#pragma unroll
    for (int s = 0; s < 2; ++s) {
      const bf16x8 pb = pack_step(st[tt], s);
#pragma unroll
      for (int i = 0; i < 2; ++i) {
        const bf16* vp = VTs + (32 * i + r) * VTS + 32 * (w + tt) + 16 * s + 4 * h;
        const bf16x8 a = cat4(*(const bf16x4*)vp, *(const bf16x4*)(vp + 8));
        o[i] = MFMA(a, pb, o[i]);
      }
    }
#pragma unroll
  for (int i = 0; i < 2; ++i)
#pragma unroll
    for (int j = 0; j < 16; ++j) ob[2 * i + (j >> 3)][j & 7] = (bf16)(o[i][j] * inv);
}
DI void unit_attn_prompt(const P& p, int u, char* smem) {
  const int b = u >> 7, blk = (u >> 3) & 15, hp = u & 7, hk = hp >> 2, g = hp >> 1, win = 2 << g;
  const int qpos0 = blk * 128;
  const int t = threadIdx.x + opaque0(), lane = t & 63, w = t >> 6, r = lane & 31, h = lane >> 5;
  bf16* Ks = (bf16*)smem;
  bf16* VTs = Ks + 256 * LDSK;
  float* bs = (float*)(VTs + 64 * VTS);
  bf16* Rs = Ks;
  __syncthreads();
#pragma unroll
  for (int i = 0; i < 8; ++i) {
    const int c = t + 256 * i, row = c >> 3, c16 = c & 7, kp = qpos0 - 128 + row;
    u32x4 v = {0u, 0u, 0u, 0u};
    if (kp >= 0) v = *(const u32x4*)(w_PROJ(p) + ((size_t)b * SEQ + kp) * INW + C_K + hk * 64 + c16 * 8);
    *(u32x4*)(Ks + row * LDSK + c16 * 8) = v;
  }
#pragma unroll
  for (int i = 0; i < 8; ++i) {
    const int c = t + 256 * i, drow = c >> 5, c16 = c & 31, kp0 = qpos0 - 128 + c16 * 8;
    u32x4 v = {0u, 0u, 0u, 0u};
    if (kp0 >= 0) v = *(const u32x4*)(w_VT(p) + ((size_t)(b * 2 + hk) * 64 + drow) * SEQ + kp0);
    u32x2* d2 = (u32x2*)(VTs + drow * VTS + c16 * 8);
    d2[0] = (u32x2){v[0], v[1]}; d2[1] = (u32x2){v[2], v[3]};
  }
  for (int i = t; i < 384; i += NTHREADS) { const int hh = i >= 192, j = i - 192 * hh, dist = 159 - j; bs[i] = (dist >= 0 && dist < 128) ? w_BIAS(p)[(2 * hp + hh) * 128 + dist] : -INFINITY; }
  const size_t tokq = (size_t)b * SEQ + qpos0 + 32 * w + r;
  __syncthreads();
  bf16x8 ob0[4], ob1[4];
  attn_head(p, 2 * hp, blk, w, r, h, tokq, Ks, VTs, bs, ob0);
  __builtin_amdgcn_sched_barrier(0);
  attn_head(p, 2 * hp + 1, blk, w, r, h, tokq, Ks, VTs, bs + 192, ob1);
  __builtin_amdgcn_sched_barrier(0);
  __syncthreads();
  {
    const int tk = t >> 4, cc = t & 15;
    const int p0 = qpos0 + tk * 8;
    const bf16* pin = w_PROJ(p) + (size_t)b * SEQ * INW + C_PIN + g * 128 + cc * 8;
    float S[8];
#pragma unroll
    for (int j = 0; j < 8; ++j) S[j] = 0.f;
    for (int i = 0; i < win; ++i) {
      const int pp = p0 - i;
      if (pp >= 0) { const bf16x8 v = *(const bf16x8*)(pin + (size_t)pp * INW);
#pragma unroll
        for (int j = 0; j < 8; ++j) S[j] += bf2f(v[j]); }
    }
    for (int i = 0; i < 8; ++i) {
      const int pos = p0 + i;
      const bf16x8 cur = *(const bf16x8*)(pin + (size_t)pos * INW);
      if (i > 0) {
#pragma unroll
        for (int j = 0; j < 8; ++j) S[j] += bf2f(cur[j]);
        if (pos - win >= 0) { const bf16x8 old = *(const bf16x8*)(pin + (size_t)(pos - win) * INW);
#pragma unroll
          for (int j = 0; j < 8; ++j) S[j] -= bf2f(old[j]); }
      }
      const float icnt = 1.f / (float)(win < pos + 1 ? win : pos + 1);
      bf16x8 rr;
#pragma unroll
      for (int j = 0; j < 8; ++j) rr[j] = (bf16)(S[j] * icnt - bf2f(cur[j]));
      *(bf16x8*)(Rs + (tk * 8 + i) * RS + cc * 8) = rr;
    }
  }
  __syncthreads();
  const bf16* prow = w_PROJ(p) + tokq * INW;
#pragma unroll
  for (int hh = 0; hh < 2; ++hh) {
    const int head = 2 * hp + hh;
    f32x16 pa[2] = {zero16(), zero16()};
#pragma unroll
    for (int s = 0; s < 8; ++s) {
      const bf16x8 bfr = *(const bf16x8*)(Rs + (32 * w + r) * RS + 16 * s + 8 * h);
#pragma unroll
      for (int i = 0; i < 2; ++i) {
        const bf16x8 a = *(const bf16x8*)(w_PWt(p) + ((size_t)g * 256 + (head & 3) * 64 + 32 * i + r) * 128 + 16 * s + 8 * h);
        pa[i] = MFMA(a, bfr, pa[i]);
      }
    }
#pragma unroll
    for (int i = 0; i < 2; ++i)
#pragma unroll
      for (int q4 = 0; q4 < 4; ++q4) {
        const int f = head * 64 + 32 * i + 8 * q4 + 4 * h;
        const bf16x4 ga = *(const bf16x4*)(prow + C_GA + f), gb = *(const bf16x4*)(prow + C_GB + f);
        const f32x4 ps = *(const f32x4*)(p.pool_scale + f);
        bf16x4 ov;
#pragma unroll
        for (int j = 0; j < 4; ++j) { const bf16 av = hh ? ob1[2 * i + (q4 >> 1)][4 * (q4 & 1) + j] : ob0[2 * i + (q4 >> 1)][4 * (q4 & 1) + j];
          ov[j] = (bf16)(bf2f(ga[j]) * bf2f(av) + bf2f(gb[j]) * (pa[i][4 * q4 + j] * ps[j])); }
        *(bf16x4*)(w_MIXED(p) + tokq * DM + f) = ov;
      }
    __builtin_amdgcn_sched_barrier(0);
  }
}

DI void unit_attn_sample(const P& p, int u, char* smem) {
  const int b = u >> 1, hk = u & 1;
  const int t = threadIdx.x + opaque0(), g8 = t >> 5, l32 = t & 31;
  float* ks = (float*)smem;
  float* vs = ks + 128 * 65;
  float* qs = vs + 128 * 64;
  float* ps = qs + 512;
  float* os = ps + 1024;
  float* rs = os + 512;
  const size_t token = (size_t)NPR + b;
  __syncthreads();
  const float* kw = p.out + O_KWS + (size_t)b * 128 * 128 + hk * 64;
  const float* vw = p.out + O_VWS + (size_t)b * 128 * 128 + hk * 64;
#pragma unroll 4
  for (int i = t; i < 128 * 64; i += NTHREADS) { const int j = i >> 6, d = i & 63; ks[j * 65 + d] = kw[(size_t)j * 128 + d]; vs[j * 64 + d] = vw[(size_t)j * 128 + d]; }
#pragma unroll 1
  for (int i = t; i < 512; i += NTHREADS) qs[i] = bf2f(w_PROJ(p)[token * INW + hk * 512 + i]);
  {
    const int gi = t >> 7, ch = t & 127, g = 2 * hk + gi, win = 2 << g;
    const float cur = p.out[O_PS + ((size_t)b * 15 + 14) * 512 + g * 128 + ch];
    float tot = cur;
#pragma unroll 1
    for (int i = 1; i < win; ++i) tot += p.state_pool[((size_t)b * 15 + 15 - i) * 512 + g * 128 + ch];
    rs[gi * 128 + ch] = tot / (float)win - cur;
  }
  __syncthreads();
  const int head = hk * 8 + g8;
  float s[4];
  float m = p.sinks[head];
#pragma unroll
  for (int i = 0; i < 4; ++i) {
    const int j = l32 + 32 * i;
    float a = 0.f;
#pragma unroll 8
    for (int d = 0; d < 64; ++d) a += qs[g8 * 64 + d] * ks[j * 65 + d];
    s[i] = a + w_BIAS(p)[head * 128 + 127 - j];
    m = fmaxf(m, s[i]);
  }
  for (int o = 16; o >= 1; o >>= 1) m = fmaxf(m, __shfl_xor(m, o));
  float sum = 0.f;
#pragma unroll
  for (int i = 0; i < 4; ++i) { s[i] = __expf(s[i] - m); sum += s[i]; }
  for (int o = 16; o >= 1; o >>= 1) sum += __shfl_xor(sum, o);
  const float inv = 1.f / (sum + __expf(p.sinks[head] - m));
#pragma unroll
  for (int i = 0; i < 4; ++i) ps[g8 * 128 + l32 + 32 * i] = s[i] * inv;
  __syncthreads();
#pragma unroll
  for (int i = 0; i < 2; ++i) {
    const int d = l32 + 32 * i;
    float a = 0.f;
#pragma unroll 8
    for (int j = 0; j < 128; ++j) a += ps[g8 * 128 + j] * vs[j * 64 + d];
    os[g8 * 64 + d] = a;
  }
  __syncthreads();
#pragma unroll
  for (int i = 0; i < 2; ++i) {
    const int fl = t + 256 * i, f = hk * 512 + fl, g = f >> 8, gi = g - 2 * hk, oc = f & 255;
    float pl = 0.f;
    const float* pw = p.pool_w + (size_t)g * 128 * 256 + oc;
#pragma unroll 8
    for (int ch = 0; ch < 128; ++ch) pl += rs[gi * 128 + ch] * pw[(size_t)ch * 256];
    pl *= p.pool_scale[f];
    const float ga = bf2f(w_PROJ(p)[token * INW + C_GA + f]), gb = bf2f(w_PROJ(p)[token * INW + C_GB + f]);
    w_MIXED(p)[token * DM + f] = (bf16)(ga * os[fl] + gb * pl);
  }
}

DI void unit_gemm2(const P& p, int u, int un, char* smem) {
  const int mt = u >> 3, nt = u & 7;
  const int n0 = nt * 128, m0 = mt * 128;
  f32x16 acc[4];
  gemm_main(w_Wt_out(p), w_MIXED(p), 1024, n0, m0, smem, acc);
  if (un >= 0) gemm_first(w_Wt_out(p), w_MIXED(p), 1024, (un & 7) * 128, (un >> 3) * 128, smem);
  const int tz = threadIdx.x + opaque0();
  const int lane = tz & 63, w = tz >> 6, r = lane & 31, h = lane >> 5;
  float* tbase = (float*)(smem + GBUF + w * 8704);
#pragma unroll
  for (int hf = 0; hf < 2; ++hf) {
    if (hf) LDS_WAIT();
#pragma unroll
    for (int ii = 0; ii < 2; ++ii)
#pragma unroll
      for (int q4 = 0; q4 < 4; ++q4) {
        f32x4 v;
#pragma unroll
        for (int j = 0; j < 4; ++j) v[j] = acc[2 * hf + ii][4 * q4 + j];
        *(f32x4*)(tbase + r * 68 + 32 * ii + 8 * q4 + 4 * h) = v;
      }
    LDS_WAIT();
    const int fc = (lane & 15) * 4, tsub = lane >> 4;
#pragma unroll
    for (int it = 0; it < 8; ++it) {
      const int tl = 4 * it + tsub, token = m0 + 32 * w + tl, f = n0 + 64 * hf + fc;
      const f32x4 a = *(const f32x4*)(tbase + tl * 68 + fc);
      const f32x4 xv = *(const f32x4*)(xrow(p, token) + f), gv = *(const f32x4*)(w_MOD(p) + (size_t)cond_row(token) * 6144 + 2048 + f);
      f32x4 o;
#pragma unroll
      for (int j = 0; j < 4; ++j) o[j] = xv[j] + gv[j] * a[j];
      *(f32x4*)(w_X1(p) + (size_t)token * DM + f) = o;
    }
  }
}

DI unsigned f2ord(float f) { const unsigned u = __float_as_uint(f); return (u & 0x80000000u) ? ~u : (u | 0x80000000u); }
DI float ord2f(unsigned u) { return __uint_as_float((u & 0x80000000u) ? (u & 0x7fffffffu) : ~u); }
DI unsigned umin_(unsigned a, unsigned b) { return a < b ? a : b; }
DI unsigned umax_(unsigned a, unsigned b) { return a > b ? a : b; }
template <int OFF> DI void sort16_desc(unsigned (&a)[64]) {
#pragma unroll
  for (int lk = 1; lk <= 4; ++lk)
#pragma unroll
    for (int lj = lk - 1; lj >= 0; --lj)
#pragma unroll
      for (int i = 0; i < 16; ++i) {
        const int k = 1 << lk, j = 1 << lj, l = i ^ j;
        if (l > i) {
          const unsigned lo = umin_(a[OFF + i], a[OFF + l]), hi = umax_(a[OFF + i], a[OFF + l]);
          const bool desc = (i & k) == 0;
          a[OFF + i] = desc ? hi : lo; a[OFF + l] = desc ? lo : hi;
        }
      }
}
DI void merge16_desc(unsigned (&a)[16]) {
#pragma unroll
  for (int lj = 3; lj >= 0; --lj)
#pragma unroll
    for (int i = 0; i < 16; ++i) {
      const int j = 1 << lj, l = i ^ j;
      if (l > i) { const unsigned lo = umin_(a[i], a[l]), hi = umax_(a[i], a[l]); a[i] = hi; a[l] = lo; }
    }
}
DI void top16_of_64(unsigned (&a)[64], unsigned (&out)[16]) {
  sort16_desc<0>(a); sort16_desc<16>(a); sort16_desc<32>(a); sort16_desc<48>(a);
  unsigned x[16], y[16];
#pragma unroll
  for (int i = 0; i < 16; ++i) { x[i] = umax_(a[i], a[31 - i]); y[i] = umax_(a[32 + i], a[63 - i]); }
  merge16_desc(x); merge16_desc(y);
#pragma unroll
  for (int i = 0; i < 16; ++i) out[i] = umax_(x[i], y[15 - i]);
  merge16_desc(out);
}
__device__ constexpr int COFF[16] = {0, 16, 24, 29, 33, 36, 38, 40, 42, 43, 44, 45, 46, 47, 48, 49};
DI unsigned umax3(unsigned a, unsigned b, unsigned c) { const unsigned m = a > b ? a : b; return m > c ? m : c; }

DI void unit_peer_route(const P& p, int u, int un, char* smem) {
  const int mt = u >> 3, hd = u & 7;
  const int m0 = mt * 128;
  const int t = threadIdx.x + opaque0(), lane = t & 63, w = t >> 6, r = lane & 31, h = lane >> 5;
  unsigned char* myidx = (unsigned char*)smem + 2 * GBUF + t * 32;
  unsigned top[2][16];
#pragma unroll
  for (int pp = 0; pp < 2; ++pp) {
    f32x16 acc[4];
    gemm_main(w_Wt_q(p), w_H(p), 1024, hd * 256 + pp * 128, m0, smem, acc);
    if (pp == 0) gemm_first(w_Wt_q(p), w_H(p), 1024, hd * 256 + 128, m0, smem);
    else if (un >= 0) gemm_first(w_Wt_q(p), w_H(p), 1024, (un & 7) * 256, (un >> 3) * 128, smem);
    f32x16 sc[4] = {zero16(), zero16(), zero16(), zero16()};
    {
      const bf16* skb = w_SK(p) + (size_t)(hd * 2 + pp) * 128 * 128;
      const int wu = __builtin_amdgcn_readfirstlane(w);
#pragma unroll
      for (int q = 0; q < 8; ++q) {
        const int j = wu + 4 * q, row = 4 * j + (lane >> 4);
        glds16(skb + (size_t)row * 128 + (((lane & 15) ^ (row & 15)) * 8), smem + GBUF + 1024 * j);
      }
      asm volatile("s_waitcnt vmcnt(0)" ::: "memory");
      __syncthreads();
    }
    bf16x8 bqs[8];
#pragma unroll
    for (int i = 0; i < 4; ++i)
#pragma unroll
      for (int s = 0; s < 2; ++s) bqs[2 * i + s] = pack_step(acc[i], s);
#pragma unroll
    for (int i = 0; i < 4; ++i)
#pragma unroll
      for (int s = 0; s < 2; ++s) {
        const bf16x8 bq = bqs[2 * i + s];
#pragma unroll
        for (int kt = 0; kt < 4; ++kt) {
          const int row = 32 * kt + r, cc = 4 * i + 2 * s;
          const char* rp = smem + GBUF + row * 256 + 8 * h;
          const bf16x8 a = cat4(*(const bf16x4*)(rp + ((cc ^ (row & 15)) * 16)), *(const bf16x4*)(rp + (((cc + 1) ^ (row & 15)) * 16)));
          sc[kt] = MFMA(a, bq, sc[kt]);
        }
      }
    unsigned pk[64];
#pragma unroll
    for (int kt = 0; kt < 4; ++kt)
#pragma unroll
      for (int j = 0; j < 16; ++j) { const int key = 32 * kt + crow(j, h); pk[kt * 16 + j] = (f2ord(sc[kt][j]) & ~127u) | (unsigned)(127 - key); }
    unsigned mine[16];
    top16_of_64(pk, mine);
#pragma unroll
    for (int i = 0; i < 16; ++i) top[pp][i] = (unsigned)__shfl_xor((int)mine[15 - i], 32);
#pragma unroll
    for (int i = 0; i < 16; ++i) top[pp][i] = umax_(top[pp][i], mine[i]);
    merge16_desc(top[pp]);
  }
  float v0[16], v1[16];
#pragma unroll
  for (int a = 0; a < 16; ++a) {
    v0[a] = ord2f(top[0][a] & ~127u); v1[a] = ord2f(top[1][a] & ~127u);
    myidx[a] = (unsigned char)(127u - (top[0][a] & 127u)); myidx[16 + a] = (unsigned char)(127u - (top[1][a] & 127u));
  }
  unsigned cand[64];
#pragma unroll
  for (int i = 50; i < 64; ++i) cand[i] = 0u;
#pragma unroll
  for (int a = 0; a < 16; ++a)
#pragma unroll
    for (int bb = 0; bb < 16 / (a + 1); ++bb)
      cand[COFF[a] + bb] = (f2ord(v0[a] + v1[bb]) & ~255u) | (unsigned)(255 - (a * 16 + bb));
  unsigned best[16];
  top16_of_64(cand, best);
  const float smax = ord2f(best[0] & ~255u);
  float e[16], esum = 0.f;
#pragma unroll
  for (int i = 0; i < 16; ++i) { e[i] = __expf(ord2f(best[i] & ~255u) - smax); esum += e[i]; }
  const float einv = 1.f / esum;
  const size_t token = (size_t)m0 + 32 * w + r;
  int* ip = w_IDX(p) + token * 128 + hd * 16 + 8 * h;
  float* gp = w_GATE(p) + token * 128 + hd * 16 + 8 * h;
  const unsigned hmask = 0u - (unsigned)h;
#pragma unroll
  for (int i = 0; i < 8; ++i) {
    const unsigned bsel = best[i] ^ ((best[i] ^ best[8 + i]) & hmask);
    const float esel = __uint_as_float(__float_as_uint(e[i]) ^ ((__float_as_uint(e[i]) ^ __float_as_uint(e[8 + i])) & hmask));
    const unsigned code = 255u - (bsel & 255u);
    const int a = code >> 4, bb = code & 15;
    ip[i] = (int)myidx[a] * 128 + (int)myidx[16 + bb];
    gp[i] = esel * einv;
  }
}

DI float gelu_fast(float v) {
  const float av = fabsf(v), tt = __builtin_amdgcn_rcpf(av * 0.2316418882f + 1.0f);
  float q = tt * 0.5307027145f - 0.7265760135f; q = q * tt + 0.7107068705f; q = q * tt - 0.142248368f; q = q * tt + 0.127414796f; q = q * tt;
  const float e = __builtin_amdgcn_exp2f(v * v * -0.72134752044f);
  const float m = v * (q * e);
  return v < 0.f ? m : v - m;
}
DI float dot2bf(unsigned a, unsigned b, float acc) { return __builtin_amdgcn_fdot2_f32_bf16(__builtin_bit_cast(bf16x2, a), __builtin_bit_cast(bf16x2, b), acc, false); }
DI unsigned pkbf(f32x2 v) { bf16x2 r; r[0] = (bf16)v[0]; r[1] = (bf16)v[1]; return __builtin_bit_cast(unsigned, r); }
DI int dot16i(u32x4 u8, u32x4 x8, int d) {
#pragma unroll
  for (int m = 0; m < 4; ++m) d = __builtin_amdgcn_sdot4((int)u8[m], (int)x8[m], d, false);
  return d;
}
DI void axpy16p(f32x2* o, u32x4 v8, f32x2 c2) {
#pragma unroll
  for (int m = 0; m < 4; ++m) {
    const int wd = (int)v8[m];
    o[2 * m] = __builtin_elementwise_fma(c2, __builtin_amdgcn_cvt_pk_f32_fp8(wd, false), o[2 * m]);
    o[2 * m + 1] = __builtin_elementwise_fma(c2, __builtin_amdgcn_cvt_pk_f32_fp8(wd, true), o[2 * m + 1]);
  }
}
DI int dpp_add16i(int v) {
  v += __builtin_amdgcn_update_dpp(0, v, 0x140, 0xf, 0xf, true);
  v += __builtin_amdgcn_update_dpp(0, v, 0x141, 0xf, 0xf, true);
  v += __builtin_amdgcn_update_dpp(0, v, 0x4e, 0xf, 0xf, true);
  v += __builtin_amdgcn_update_dpp(0, v, 0xb1, 0xf, 0xf, true);
  return v;
}
DI float dot16(u32x4 u8, u32x4 xlo, u32x4 xhi, float d) {
#pragma unroll
  for (int m = 0; m < 4; ++m) {
    const int wd = (int)u8[m];
    const unsigned p01 = pkbf(__builtin_amdgcn_cvt_pk_f32_fp8(wd, false)), p23 = pkbf(__builtin_amdgcn_cvt_pk_f32_fp8(wd, true));
    const unsigned x01 = m < 2 ? xlo[2 * m] : xhi[2 * m - 4], x23 = m < 2 ? xlo[2 * m + 1] : xhi[2 * m - 3];
    d = dot2bf(p01, x01, d); d = dot2bf(p23, x23, d);
  }
  return d;
}
DI void axpy16(float* o, u32x4 v8, float c) {
#pragma unroll
  for (int m = 0; m < 4; ++m) {
    const int wd = (int)v8[m];
    const f32x2 a = __builtin_amdgcn_cvt_pk_f32_fp8(wd, false), b = __builtin_amdgcn_cvt_pk_f32_fp8(wd, true);
    o[4 * m] += c * a[0]; o[4 * m + 1] += c * a[1]; o[4 * m + 2] += c * b[0]; o[4 * m + 3] += c * b[1];
  }
}
DI float reduce4(const float (&d)[4], int lane) {
  const int h = lane >> 5, b4 = (lane >> 4) & 1;
  float a0 = h ? d[2] : d[0], a1 = h ? d[3] : d[1];
  const float s0 = h ? d[0] : d[2], s1 = h ? d[1] : d[3];
  a0 += __shfl_xor(s0, 32); a1 += __shfl_xor(s1, 32);
  float k = b4 ? a1 : a0;
  const float s = b4 ? a0 : a1;
  k += __shfl_xor(s, 16);
  k += __shfl_xor(k, 8); k += __shfl_xor(k, 4); k += __shfl_xor(k, 2); k += __shfl_xor(k, 1);
  return k;
}
DI float dpp_add16(float v) {
  v += __int_as_float(__builtin_amdgcn_update_dpp(0, __float_as_int(v), 0x140, 0xf, 0xf, true));
  v += __int_as_float(__builtin_amdgcn_update_dpp(0, __float_as_int(v), 0x141, 0xf, 0xf, true));
  v += __int_as_float(__builtin_amdgcn_update_dpp(0, __float_as_int(v), 0x4e, 0xf, 0xf, true));
  v += __int_as_float(__builtin_amdgcn_update_dpp(0, __float_as_int(v), 0xb1, 0xf, 0xf, true));
  return v;
}
constexpr int PEER_GLDS = 512 + 128 * 16;
constexpr int PEER_WLDS = 4 * PEER_GLDS;
DI void peer_wave4(const P& p, int g, char* wl) {
  const int lane = (threadIdx.x + opaque0()) & 63, q = lane >> 4, j16 = lane & 15;
  unsigned* hist = (unsigned*)(wl + q * PEER_GLDS);
  u32x4* list = (u32x4*)(wl + q * PEER_GLDS + 512);
  const int token = 4 * g + q;
  u32x4 x[4];
  {
    const unsigned char* hrow = w_H8(p) + (size_t)token * DM + 16 * j16;
#pragma unroll
    for (int i = 0; i < 4; ++i) x[i] = *(const u32x4*)(hrow + 256 * i);
  }
  const float xs = w_HS(p)[token];
  {
    int ids[8]; float gts[8], su[8];
#pragma unroll
    for (int i = 0; i < 8; ++i) { const size_t o = (size_t)token * 128 + j16 + 16 * i; ids[i] = w_IDX(p)[o]; gts[i] = w_GATE(p)[o]; }
#pragma unroll
    for (int i = 0; i < 8; ++i) { su[i] = w_SU(p)[ids[i]] * xs; gts[i] *= w_SV(p)[ids[i]]; }
    LDS_WAIT();
    *(u32x4*)(hist + 8 * j16) = (u32x4){0u, 0u, 0u, 0u}; *(u32x4*)(hist + 8 * j16 + 4) = (u32x4){0u, 0u, 0u, 0u};
    LDS_WAIT();
#pragma unroll
    for (int i = 0; i < 8; ++i) (void)__hip_atomic_fetch_add(&hist[ids[i] >> 7], 1u, __ATOMIC_RELAXED, __HIP_MEMORY_SCOPE_WAVEFRONT);
    LDS_WAIT();
    const u32x4 ca = *(const u32x4*)(hist + 8 * j16), cb = *(const u32x4*)(hist + 8 * j16 + 4);
    const unsigned tot = ca[0] + ca[1] + ca[2] + ca[3] + cb[0] + cb[1] + cb[2] + cb[3];
    unsigned scan = tot;
#pragma unroll
    for (int o = 1; o < 16; o <<= 1) { const unsigned tv = (unsigned)__shfl_up((int)scan, o, 16); if (j16 >= o) scan += tv; }
    unsigned e0 = scan - tot;
    u32x4 pa, pb;
    pa[0] = e0; e0 += ca[0]; pa[1] = e0; e0 += ca[1]; pa[2] = e0; e0 += ca[2]; pa[3] = e0; e0 += ca[3];
    pb[0] = e0; e0 += cb[0]; pb[1] = e0; e0 += cb[1]; pb[2] = e0; e0 += cb[2]; pb[3] = e0;
    LDS_WAIT();
    *(u32x4*)(hist + 8 * j16) = pa; *(u32x4*)(hist + 8 * j16 + 4) = pb;
    LDS_WAIT();
#pragma unroll
    for (int i = 0; i < 8; ++i) {
      const unsigned pos = __hip_atomic_fetch_add(&hist[ids[i] >> 7], 1u, __ATOMIC_RELAXED, __HIP_MEMORY_SCOPE_WAVEFRONT);
      list[pos] = (u32x4){(unsigned)ids[i], __float_as_uint(su[i]), __float_as_uint(gts[i]), 0u};
    }
    LDS_WAIT();
  }
  const unsigned char* Ub = w_Ub(p) + 16 * j16;
  const unsigned char* Vb = w_Vb(p) + 16 * j16;
  {
    u32x4 uA[4], uB[4];
    u32x4 eA = list[0], eB = list[1];
#pragma unroll
    for (int i = 0; i < 4; ++i) uA[i] = *(const u32x4*)(Ub + (size_t)eA[0] * DM + 256 * i);
#pragma unroll
    for (int i = 0; i < 4; ++i) uB[i] = *(const u32x4*)(Ub + (size_t)eB[0] * DM + 256 * i);
#define PEER_USTEP(U, E, K)                                                                                            \
    {                                                                                                                  \
      const float su = __uint_as_float(E[1]), gsv = __uint_as_float(E[2]);                                             \
      int d0 = 0, d1 = 0;                                                                                              \
      d0 = dot16i(U[0], x[0], d0); d1 = dot16i(U[1], x[1], d1); d0 = dot16i(U[2], x[2], d0); d1 = dot16i(U[3], x[3], d1); \
      E = list[(K) + 2 < 128 ? (K) + 2 : 127];                       \
      _Pragma("unroll") for (int i = 0; i < 4; ++i) U[i] = *(const u32x4*)(Ub + (size_t)E[0] * DM + 256 * i);          \
      const float c = gsv * gelu_fast(su * (float)dpp_add16i(d0 + d1));                                                \
      if (j16 == 0) ((float*)&list[K])[3] = c;                                                                          \
    }
#pragma unroll 1
    for (int k = 0; k < 128; k += 2) {
      PEER_USTEP(uA, eA, k)
      PEER_USTEP(uB, eB, k + 1)
    }
  }
  LDS_WAIT();
  f32x2 acc[32];
#pragma unroll
  for (int i = 0; i < 32; ++i) acc[i] = (f32x2){0.f, 0.f};
  {
    u32x4 vA[4], vB[4];
    u32x4 eA = list[0], eB = list[1];
#pragma unroll
    for (int i = 0; i < 4; ++i) vA[i] = *(const u32x4*)(Vb + (size_t)eA[0] * DM + 256 * i);
#pragma unroll
    for (int i = 0; i < 4; ++i) vB[i] = *(const u32x4*)(Vb + (size_t)eB[0] * DM + 256 * i);
#define PEER_VSTEP(V, E, K)                                                                                            \
    {                                                                                                                  \
      const float c = __uint_as_float(E[3]);                                                                           \
      const f32x2 c2 = {c, c};                                                                                         \
      _Pragma("unroll") for (int i = 0; i < 4; ++i) axpy16p(acc + 8 * i, V[i], c2);                                    \
      E = list[(K) + 2 < 128 ? (K) + 2 : 127];                                                                         \
      _Pragma("unroll") for (int i = 0; i < 4; ++i) V[i] = *(const u32x4*)(Vb + (size_t)E[0] * DM + 256 * i);          \
    }
#pragma unroll 1
    for (int k = 0; k < 128; k += 2) {
      PEER_VSTEP(vA, eA, k)
      PEER_VSTEP(vB, eB, k + 1)
    }
  }
  const float* x1 = w_X1(p) + (size_t)token * DM + 16 * j16;
  const float* g2 = w_MOD(p) + (size_t)cond_row(token) * 6144 + 5120 + 16 * j16;
  float* y = p.out + O_YP + (size_t)token * DM + 16 * j16;
#pragma unroll
  for (int i = 0; i < 4; ++i)
#pragma unroll
    for (int mm = 0; mm < 4; ++mm) {
      const int c0 = 256 * i + 4 * mm;
      const f32x4 xv = *(const f32x4*)(x1 + c0), gv = *(const f32x4*)(g2 + c0);
      f32x4 yv;
#pragma unroll
      for (int j = 0; j < 4; ++j) yv[j] = xv[j] + gv[j] * acc[8 * i + 2 * mm + (j >> 1)][j & 1];
      *(f32x4*)(y + c0) = yv;
    }
}
DI void peer_token_block(const P& p, int token, char* smem) {
  const int t = threadIdx.x + opaque0(), lane = t & 63, w = t >> 6;
  float* red = (float*)smem;
  const u32x4 x8 = *(const u32x4*)(w_H8(p) + (size_t)token * DM + 16 * lane);
  const int myid = w_IDX(p)[(size_t)token * 128 + 32 * w + (lane & 31)];
  const float mysu = w_SU(p)[myid] * w_HS(p)[token];
  const float mygs = w_GATE(p)[(size_t)token * 128 + 32 * w + (lane & 31)] * w_SV(p)[myid];
  float o[16];
#pragma unroll
  for (int i = 0; i < 16; ++i) o[i] = 0.f;
#pragma unroll 1
  for (int e0 = 0; e0 < 32; e0 += 4) {
    u32x4 u8[4], v8[4];
#pragma unroll
    for (int qq = 0; qq < 4; ++qq) {
      const size_t ro = (size_t)__builtin_amdgcn_readlane(myid, e0 + qq) * DM + 16 * lane;
      u8[qq] = *(const u32x4*)(w_Ub(p) + ro); v8[qq] = *(const u32x4*)(w_Vb(p) + ro);
    }
    float d[4];
#pragma unroll
    for (int qq = 0; qq < 4; ++qq) d[qq] = (float)dot16i(u8[qq], x8, 0);
    const float kv = reduce4(d, lane);
#pragma unroll
    for (int qq = 0; qq < 4; ++qq) {
      const float a = __int_as_float(__builtin_amdgcn_readlane(__float_as_int(kv), 16 * qq)) * __int_as_float(__builtin_amdgcn_readlane(__float_as_int(mysu), e0 + qq));
      const float c = __int_as_float(__builtin_amdgcn_readlane(__float_as_int(mygs), e0 + qq)) * gelu_fast(a);
      axpy16(o, v8[qq], c);
    }
  }
  __syncthreads();
#pragma unroll
  for (int i = 0; i < 16; ++i) red[w * 1024 + 16 * lane + i] = o[i];
  __syncthreads();
  if (w == 0) {
    const float* x1 = w_X1(p) + (size_t)token * DM + 16 * lane;
    const float* g2 = w_MOD(p) + (size_t)cond_row(token) * 6144 + 5120 + 16 * lane;
    float* y = p.out + O_YP + (size_t)token * DM + 16 * lane;
#pragma unroll
    for (int mm = 0; mm < 4; ++mm) {
      const f32x4 xv = *(const f32x4*)(x1 + 4 * mm), gv = *(const f32x4*)(g2 + 4 * mm);
      f32x4 yv;
#pragma unroll
      for (int j = 0; j < 4; ++j) { const int c = 16 * lane + 4 * mm + j; yv[j] = xv[j] + gv[j] * (red[c] + red[1024 + c] + red[2048 + c] + red[3072 + c]); }
      *(f32x4*)(y + 4 * mm) = yv;
    }
  }
}

constexpr int NPHASE = 8;

#ifdef PROBE_ATTN
DI int probe_token(int i) { return (i * 131 + 3) % NPR; }
DI float block_sum_p(float v, float* red) {
  __syncthreads();
  v = wave_sum(v);
  if ((threadIdx.x & 63) == 0) red[threadIdx.x >> 6] = v;
  __syncthreads();
  return red[0] + red[1] + red[2] + red[3];
}
DI float block_max_p(float v, float* red) {
  __syncthreads();
  for (int o = 32; o >= 1; o >>= 1) v = fmaxf(v, __shfl_xor(v, o));
  if ((threadIdx.x & 63) == 0) red[threadIdx.x >> 6] = v;
  __syncthreads();
  return fmaxf(fmaxf(red[0], red[1]), fmaxf(red[2], red[3]));
}
DI void probe_attn(const P& p, int i, char* smem) {
  float* red = (float*)smem;
  float* pr = red + 4;
  float* attn = pr + 128;
  float* rr = attn + 1024;
  const int token = probe_token(i), b = token >> 11, pos = token & 2047, t = threadIdx.x;
  const bf16* prow = w_PROJ(p) + (size_t)token * INW;
  for (int head = 0; head < 16; ++head) {
    const int hk = head >> 3;
    float s = -INFINITY;
    const int kp = pos - 127 + (t & 127);
    if (t < 128 && kp >= 0) {
      float a = 0.f;
      const bf16* kr = w_PROJ(p) + ((size_t)b * SEQ + kp) * INW + C_K + hk * 64;
      for (int d = 0; d < 64; ++d) a += bf2f(prow[head * 64 + d]) * bf2f(kr[d]);
      s = a + w_BIAS(p)[head * 128 + (pos - kp)];
    }
    float m = block_max_p(s, red);
    m = fmaxf(m, p.sinks[head]);
    const float e = (t < 128 && kp >= 0) ? __expf(s - m) : 0.f;
    const float den = block_sum_p(e, red) + __expf(p.sinks[head] - m);
    if (t < 128) pr[t] = e / den;
    __syncthreads();
    if (t < 64) {
      float o = 0.f;
      for (int j = 0; j < 128; ++j) { const int kq = pos - 127 + j; if (kq >= 0) o += pr[j] * bf2f(w_VT(p)[((size_t)(b * 2 + hk) * 64 + t) * SEQ + kq]); }
      attn[head * 64 + t] = o;
    }
    __syncthreads();
  }
  for (int c = t; c < 512; c += 256) {
    const int g = c >> 7, win = 2 << g;
    float tot = 0.f;
    for (int j = 0; j < win; ++j) if (pos - j >= 0) tot += bf2f(w_PROJ(p)[((size_t)b * SEQ + pos - j) * INW + C_PIN + c]);
    const float cnt = (float)(win < pos + 1 ? win : pos + 1);
    rr[c] = bf2f((bf16)(tot / cnt - bf2f(prow[C_PIN + c])));
  }
  __syncthreads();
  for (int f = t; f < 1024; f += 256) {
    const int g = f >> 8;
    float pl = 0.f;
    for (int ch = 0; ch < 128; ++ch) pl += rr[g * 128 + ch] * bf2f(w_PWt(p)[((size_t)g * 256 + (f & 255)) * 128 + ch]);
    const float naive = bf2f(prow[C_GA + f]) * attn[f] + bf2f(prow[C_GB + f]) * (pl * p.pool_scale[f]);
    const float fast = bf2f(w_MIXED(p)[(size_t)token * DM + f]);
    p.out[O_KWP + (size_t)i * DM + f] += (float)(PROBE_ATTN) * (fast - naive);
  }
  __syncthreads();
}
#endif
template <class First, class Main, class Fill> DI void run_with_filler(int G, int bid, int nmain, int nfill, First firstf, Main mainf, Fill fillf) {
  if (bid < nmain) { __syncthreads(); firstf(bid); }
  for (int u = bid; u < nmain; u += G) mainf(u, u + G < nmain ? u + G : -1);
  const int rem = nmain % G;
  if (rem == 0) { for (int f = bid; f < nfill; f += G) fillf(f); }
  else if (bid >= rem) { for (int f = bid - rem; f < nfill; f += G - rem) fillf(f); }
}
template <int PH> DI void run_phase(const P& p, char* smem) {
  const int G = gridDim.x, bid = blockIdx.x, w = __builtin_amdgcn_readfirstlane(threadIdx.x >> 6);
  if constexpr (PH == 0) { run_with_filler(G, bid, U0_MOD, F0_TOTAL, [&](int) {}, [&](int u, int) { unit_mod(p, u, smem); }, [&](int f) { phase0_filler(p, f, smem); }); }
  if constexpr (PH == 1) { for (int tk = bid * 4 + w; tk < NTOK; tk += G * 4) norm_row(p, tk, 0); }
  if constexpr (PH == 2) {
    run_with_filler(G, bid, 129 * 30, F2_TOTAL, [&](int u) { gemm_first(w_Wt_in(p), w_H(p), 1024, (u % 30) * 128, (u / 30) * 128, smem); },
                    [&](int u, int un) { unit_gemm1(p, u, un, smem); }, [&](int f) { phase2_filler(p, f, smem); });
  }
  if constexpr (PH == 3) { for (int u = bid; u < 1024; u += G) unit_attn_prompt(p, u, smem);
                           for (int u = bid; u < 256; u += G) unit_attn_sample(p, u, smem); }
  if constexpr (PH == 4) {
    run_with_filler(G, bid, 129 * 8, F4_TOTAL, [&](int u) { gemm_first(w_Wt_out(p), w_MIXED(p), 1024, (u & 7) * 128, (u >> 3) * 128, smem); },
                    [&](int u, int un) { unit_gemm2(p, u, un, smem); }, [&](int f) { if (f < F4_QU) unit_quant_rows<true>(p.peer_u, w_Ub(p), w_SU(p), f); else unit_convert(p.sub_keys, w_SK(p), f - F4_QU); });
  }
  if constexpr (PH == 5) { for (int tk = bid * 4 + w; tk < NTOK; tk += G * 4) norm_row(p, tk, 1); }
  if constexpr (PH == 6) {
    run_with_filler(G, bid, 129 * 8, F6_QV, [&](int u) { gemm_first(w_Wt_q(p), w_H(p), 1024, (u & 7) * 256, (u >> 3) * 128, smem); },
                    [&](int u, int un) { unit_peer_route(p, u, un, smem); }, [&](int f) { unit_quant_rows<false>(p.peer_v, w_Vb(p), w_SV(p), f); });
  }
  if constexpr (PH == 7) {
    for (int g = bid * 4 + w; g < NPR / 4; g += G * 4) peer_wave4(p, g, smem + w * PEER_WLDS);
    for (int s = bid; s < NS; s += G) peer_token_block(p, NPR + s, smem + 4 * PEER_WLDS);
  }
}
#if ONE_LAUNCH
__global__ void __launch_bounds__(NTHREADS, 2) mega(P p) {
  __shared__ __attribute__((aligned(16))) char smem[SMEM_BYTES + 16];
  volatile unsigned* st = (volatile unsigned*)(smem + SMEM_BYTES);
  if (threadIdx.x == 0) { st[0] = 0u; st[1] = 0u; }
  __syncthreads();
  const unsigned xcc = xb_xcc_id();
  if (threadIdx.x == 0) (void)xb_add(&w_bar(p)[XB_XCNT(xcc)], 1u);
#ifndef REPEAT_MASK
#define REPEAT_MASK 0
#endif
#define RUN_PH(k) do { run_phase<k>(p, smem); if ((REPEAT_MASK >> k) & 1) { xcd_barrier(w_bar(p), xcc, st); run_phase<k>(p, smem); } } while (0)
  RUN_PH(0); xcd_barrier(w_bar(p), xcc, st);
  RUN_PH(1); xcd_barrier(w_bar(p), xcc, st);
  RUN_PH(2); xcd_barrier(w_bar(p), xcc, st);
  RUN_PH(3); xcd_barrier(w_bar(p), xcc, st);
#ifdef PROBE_ATTN
  for (int i = blockIdx.x; i < 128; i += gridDim.x) probe_attn(p, i, smem);
  xcd_barrier(w_bar(p), xcc, st);
#endif
  RUN_PH(4); xcd_barrier(w_bar(p), xcc, st);
  RUN_PH(5); xcd_barrier(w_bar(p), xcc, st);
  RUN_PH(6); xcd_barrier(w_bar(p), xcc, st);
  RUN_PH(7);
}
#else
template <int PH> __global__ void __launch_bounds__(NTHREADS, 2) mega(P p) {
  __shared__ __attribute__((aligned(16))) char smem[SMEM_BYTES];
  run_phase<PH>(p, smem);
}
#endif


extern "C" void kernel_launch(void* const* d_in, const int* in_sizes, int n_in, void* d_out, int out_size, void* d_ws, size_t ws_size, hipStream_t stream) {
  P p{};
  const float* const* in = (const float* const*)d_in;
  p.x_prompt = in[0]; p.x_sample = in[1]; p.cache_k = in[2]; p.cache_v = in[3]; p.state_pool = in[4]; p.c_prompt = in[5]; p.c_sample = in[6];
  p.rel_table = in[7]; p.ada_w = in[8]; p.ada_b = in[9]; p.norm1_g = in[10]; p.w_in = in[11]; p.q_norm_g = in[12]; p.k_norm_g = in[13]; p.sinks = in[14];
  p.pool_w = in[15]; p.pool_scale = in[16]; p.w_out = in[17]; p.norm2_g = in[18]; p.w_query = in[19]; p.sub_keys = in[20]; p.peer_u = in[21]; p.peer_v = in[22];
  p.out = (float*)d_out;
  p.ws = (char*)d_ws;
  if (WS_NEED > ws_size) { fprintf(stderr, "workspace too small: need %zu have %zu\n", (size_t)WS_NEED, ws_size); return; }

  static int grid_blocks = 0;
  if (!grid_blocks) {
    int dev = 0, cus = 0, per_cu = 0;
    (void)hipGetDevice(&dev);
    (void)hipDeviceGetAttribute(&cus, hipDeviceAttributeMultiprocessorCount, dev);
#if ONE_LAUNCH
    (void)hipOccupancyMaxActiveBlocksPerMultiprocessor(&per_cu, mega, NTHREADS, 0);
#else
    per_cu = 2;
#endif
    if (per_cu > 2) per_cu = 2;
    if (per_cu < 1) per_cu = 1;
    if (cus < 1) cus = 256;
    grid_blocks = cus * per_cu;
  }
#if ONE_LAUNCH
  (void)hipMemsetAsync(p.ws + OFF_BAR, 0, XCD_BAR_WORDS * 4, stream);
  hipLaunchKernelGGL(mega, dim3(grid_blocks), dim3(NTHREADS), 0, stream, p);
#else
  hipLaunchKernelGGL(mega<0>, dim3(grid_blocks), dim3(NTHREADS), 0, stream, p);
  hipLaunchKernelGGL(mega<1>, dim3(grid_blocks), dim3(NTHREADS), 0, stream, p);
  hipLaunchKernelGGL(mega<2>, dim3(grid_blocks), dim3(NTHREADS), 0, stream, p);
  hipLaunchKernelGGL(mega<3>, dim3(grid_blocks), dim3(NTHREADS), 0, stream, p);
  hipLaunchKernelGGL(mega<4>, dim3(grid_blocks), dim3(NTHREADS), 0, stream, p);
  hipLaunchKernelGGL(mega<5>, dim3(grid_blocks), dim3(NTHREADS), 0, stream, p);
  hipLaunchKernelGGL(mega<6>, dim3(grid_blocks), dim3(NTHREADS), 0, stream, p);
  hipLaunchKernelGGL(mega<7>, dim3(grid_blocks), dim3(NTHREADS), 0, stream, p);
#endif

}
```

```cpp
#include <hip/hip_runtime.h>
#include <stdint.h>
#include <stdio.h>

#ifndef ONE_LAUNCH
#define ONE_LAUNCH 1
#endif

typedef __bf16 bf16;
typedef __bf16 bf16x2 __attribute__((ext_vector_type(2)));
typedef __bf16 bf16x4 __attribute__((ext_vector_type(4)));
typedef __bf16 bf16x8 __attribute__((ext_vector_type(8)));
typedef float f32x2 __attribute__((ext_vector_type(2)));
typedef float f32x4 __attribute__((ext_vector_type(4)));
typedef float f32x16 __attribute__((ext_vector_type(16)));
typedef unsigned u32x2 __attribute__((ext_vector_type(2)));
typedef unsigned u32x4 __attribute__((ext_vector_type(4)));

#define DI __device__ __forceinline__
#define MFMA(a, b, c) __builtin_amdgcn_mfma_f32_32x32x16_bf16((a), (b), (c), 0, 0, 0)

constexpr int DM = 1024, NB = 8, SEQ = 2048, NS = 128, NPR = NB * SEQ, NTOK = NPR + NS;
constexpr int INW = 3840, NMOD = NB + NS;
constexpr int C_K = 1024, C_V = 1152, C_PIN = 1280, C_GA = 1792, C_GB = 2816;
constexpr int NEXP = 16384;
constexpr float EPS = 1e-6f;
constexpr size_t O_YP = 0, O_KWP = 16908288, O_VWP = 17039360, O_PP = 17170432, O_KWS = 17231872, O_VWS = 19329024, O_PS = 21426176;

constexpr int SMEM_BYTES = 77824;
constexpr int NTHREADS = 256;

struct P {
  const float *x_prompt, *x_sample, *cache_k, *cache_v, *state_pool, *c_prompt, *c_sample, *rel_table, *ada_w, *ada_b, *norm1_g, *w_in,
      *q_norm_g, *k_norm_g, *sinks, *pool_w, *pool_scale, *w_out, *norm2_g, *w_query, *sub_keys, *peer_u, *peer_v;
  float* out;
  char* ws;
};
constexpr size_t al256(size_t x) { return (x + 255) & ~(size_t)255; }
constexpr size_t OFF_BAR = 0;
constexpr size_t OFF_WTIN = OFF_BAR + al256(4096 * 4);
constexpr size_t OFF_WTOUT = OFF_WTIN + al256((size_t)INW * 1024 * 2);
constexpr size_t OFF_WTQ = OFF_WTOUT + al256((size_t)1024 * 1024 * 2);
constexpr size_t OFF_SK = OFF_WTQ + al256((size_t)2048 * 1024 * 2);
constexpr size_t OFF_PWT = OFF_SK + al256((size_t)16 * 128 * 128 * 2);
constexpr size_t OFF_UB = OFF_PWT + al256((size_t)4 * 256 * 128 * 2);
constexpr size_t OFF_VB = OFF_UB + al256((size_t)NEXP * DM);
constexpr size_t OFF_SU = OFF_VB + al256((size_t)NEXP * DM);
constexpr size_t OFF_SV = OFF_SU + al256((size_t)NEXP * 4);
constexpr size_t OFF_H8 = OFF_SV + al256((size_t)NEXP * 4);
constexpr size_t OFF_HS = OFF_H8 + al256((size_t)NTOK * DM);
constexpr size_t OFF_MOD = OFF_HS + al256((size_t)NTOK * 4);
constexpr size_t OFF_BIAS = OFF_MOD + al256((size_t)NMOD * 6144 * 4);
constexpr size_t OFF_VT = OFF_BIAS + al256(16 * 128 * 4);
constexpr size_t OFF_H = OFF_VT + al256((size_t)NB * 128 * SEQ * 2);
constexpr size_t OFF_MIXED = OFF_H;
constexpr size_t OFF_PROJ = OFF_H + al256((size_t)NTOK * DM * 2);
constexpr size_t OFF_X1 = OFF_PROJ;
constexpr size_t OFF_IDX = OFF_X1 + (size_t)NTOK * DM * 4;
constexpr size_t OFF_GATE = OFF_IDX + (size_t)NTOK * 128 * 4;
constexpr size_t WS_NEED = OFF_PROJ + al256((size_t)NTOK * INW * 2);
static_assert(OFF_GATE + (size_t)NTOK * 128 * 4 <= WS_NEED, "overlay fits");
static_assert(WS_NEED <= (size_t)256 * 1024 * 1024, "workspace budget");
#define WS_PTR(T, name, OFF) __device__ __forceinline__ T* name(const P& p) { return (T*)(p.ws + (OFF)); }
WS_PTR(unsigned, w_bar, OFF_BAR) WS_PTR(bf16, w_Wt_in, OFF_WTIN) WS_PTR(bf16, w_Wt_out, OFF_WTOUT) WS_PTR(bf16, w_Wt_q, OFF_WTQ) WS_PTR(bf16, w_SK, OFF_SK)
WS_PTR(bf16, w_PWt, OFF_PWT) WS_PTR(unsigned char, w_Ub, OFF_UB) WS_PTR(unsigned char, w_Vb, OFF_VB) WS_PTR(float, w_SU, OFF_SU) WS_PTR(float, w_SV, OFF_SV) WS_PTR(unsigned char, w_H8, OFF_H8) WS_PTR(float, w_HS, OFF_HS) WS_PTR(float, w_MOD, OFF_MOD) WS_PTR(float, w_BIAS, OFF_BIAS)
WS_PTR(bf16, w_VT, OFF_VT) WS_PTR(bf16, w_H, OFF_H) WS_PTR(bf16, w_MIXED, OFF_MIXED) WS_PTR(bf16, w_PROJ, OFF_PROJ) WS_PTR(float, w_X1, OFF_X1)
WS_PTR(int, w_IDX, OFF_IDX) WS_PTR(float, w_GATE, OFF_GATE)

DI int cond_row(int token) { return token < NPR ? (token >> 11) : (NB + token - NPR); }
DI int crow(int reg, int h) { return (reg & 3) + 8 * (reg >> 2) + 4 * h; }
DI const float* xrow(const P& p, int token) { return token < NPR ? p.x_prompt + (size_t)token * DM : p.x_sample + (size_t)(token - NPR) * DM; }

#define LDS_WAIT() asm volatile("s_waitcnt lgkmcnt(0)" ::: "memory")
DI int opaque0() { int z = 0; asm volatile("" : "+v"(z)); return z; }
DI float bf2f(bf16 v) { return (float)v; }
DI f32x16 zero16() { f32x16 z; for (int i = 0; i < 16; ++i) z[i] = 0.f; return z; }
DI bf16x8 pack_step(const f32x16& x, int s) { bf16x8 v; for (int j = 0; j < 8; ++j) v[j] = (bf16)x[8 * s + j]; return v; }
DI bf16x8 cat4(bf16x4 lo, bf16x4 hi) { return __builtin_shufflevector(lo, hi, 0, 1, 2, 3, 4, 5, 6, 7); }
DI float wave_sum(float v) { for (int o = 32; o >= 1; o >>= 1) v += __shfl_xor(v, o); return v; }

#define XB_TMO 128
#define XB_XCNT(j) (256 + 64 * (j))
#define XB_XSUB(j) (1280 + 64 * (j))
#define XB_XGEN(j) (2304 + 64 * (j))
#define XB_TOP 3328
#define XB_TOPGEN 3392
#define XCD_BAR_WORDS 3456
#define XB_SPIN_CAP (1u << 22)
DI unsigned xb_ld(unsigned* p) { return __hip_atomic_load(p, __ATOMIC_RELAXED, __HIP_MEMORY_SCOPE_AGENT); }
DI unsigned xb_add(unsigned* p, unsigned v) { return __hip_atomic_fetch_add(p, v, __ATOMIC_RELAXED, __HIP_MEMORY_SCOPE_AGENT); }
DI unsigned xb_xcc_id() { return (unsigned)__builtin_amdgcn_s_getreg((3 << 11) | 20) & 0xFu; }
#define XB_SPIN(cond, bar) do { unsigned _sp = 0; while (cond) { __builtin_amdgcn_s_sleep(1); \
    if ((++_sp & 255u) == 0u) { if (xb_ld(&(bar)[XB_TMO])) break; if (_sp > XB_SPIN_CAP) { atomicAdd(&(bar)[XB_TMO], 1u); break; } } } } while (0)

DI void xcd_barrier_complete(unsigned* bar, unsigned x, unsigned& nloc, unsigned& nx) {
  const unsigned G = gridDim.x;
  unsigned sum, cnt, mine, sp = 0u;
  for (;;) {
    sum = 0u; cnt = 0u; mine = 0u;
#pragma unroll
    for (unsigned j = 0; j < 16; ++j) { const unsigned c = xb_ld(&bar[XB_XCNT(j)]); sum += c; cnt += (c > 0u) ? 1u : 0u; mine = (j == x) ? c : mine; }
    if (sum == G) break;
    __builtin_amdgcn_s_sleep(1);
    if ((++sp & 255u) == 0u) { if (xb_ld(&bar[XB_TMO])) break; if (sp > XB_SPIN_CAP) { atomicAdd(&bar[XB_TMO], 1u); break; } }
  }
  nloc = mine > 0u ? mine : 1u; nx = cnt > 0u ? cnt : 1u;
}
DI void xcd_barrier(unsigned* bar, unsigned x, volatile unsigned* st) {
  asm volatile("s_waitcnt vmcnt(0)" ::: "memory");
  __syncthreads();
  if (threadIdx.x == 0) {
    __builtin_amdgcn_s_waitcnt(0);
    unsigned nloc = st[0], nx = st[1];
    if (nloc == 0u) { xcd_barrier_complete(bar, x, nloc, nx); st[0] = nloc; st[1] = nx; }
    const unsigned old = xb_add(&bar[XB_XSUB(x)], 1u);
    const unsigned gen = old / nloc;
    if (old + 1u == (gen + 1u) * nloc) {
      __builtin_amdgcn_fence(__ATOMIC_RELEASE, "agent");
      asm volatile("s_waitcnt vmcnt(0)" ::: "memory");
      const unsigned og = xb_add(&bar[XB_TOP], 1u);
      const unsigned tg = og / nx;
      if (og + 1u == (tg + 1u) * nx) xb_add(&bar[XB_TOPGEN], 1u);
      else XB_SPIN(xb_ld(&bar[XB_TOPGEN]) == tg, bar);
      xb_add(&bar[XB_XGEN(x)], 1u);
      __builtin_amdgcn_fence(__ATOMIC_ACQUIRE, "agent");
      asm volatile("s_waitcnt vmcnt(0)" ::: "memory");
    } else {
      XB_SPIN(xb_ld(&bar[XB_XGEN(x)]) == gen, bar);
      __builtin_amdgcn_fence(__ATOMIC_ACQUIRE, "agent");
      asm volatile("s_waitcnt vmcnt(0)" ::: "memory");
    }
  }
  __syncthreads();
}

constexpr int U0_MOD = 192;
constexpr int U0_TIN = (1024 / 64) * (INW / 64);
constexpr int F0_TOTAL = U0_TIN + 1;
constexpr int U0_TPW = 4 * 2 * 4;
constexpr int U0_CSK = 32;
constexpr int U0_KW = 128, U0_VW = 128, U0_PW = 128;
constexpr int F2_TOUT = 16 * 16, F2_TQ = 16 * 32, F2_E1 = F2_TOUT + F2_TQ, F2_E2 = F2_E1 + U0_TPW, F2_E3 = F2_E2 + U0_KW, F2_E4 = F2_E3 + U0_VW,
              F2_TOTAL = F2_E4 + U0_PW;
constexpr int F4_QU = 2048, F4_TOTAL = F4_QU + U0_CSK;
constexpr int F6_QV = 2048;

DI float silu_f(float x) { return x * __builtin_amdgcn_rcpf(1.f + __expf(-x)); }

DI void unit_mod(const P& p, int u, char* smem) {
  const int t = threadIdx.x + opaque0(), lane = t & 63, w = t >> 6, r = lane & 31, h = lane >> 5;
  const int f0 = u * 32;
  f32x16 acc[5];
#pragma unroll
  for (int i = 0; i < 5; ++i) acc[i] = zero16();
  const float* wp = p.ada_w + (size_t)(w * 256 + 8 * h) * 6144 + f0 + r;
  const float* cp[5];
#pragma unroll
  for (int i = 0; i < 5; ++i) { const int m = 32 * i + r, mm = m < NMOD ? m : 0; cp[i] = (mm < NB ? p.c_prompt + (size_t)mm * DM : p.c_sample + (size_t)(mm - NB) * DM) + w * 256 + 8 * h; }
  float wv[8]; f32x4 cv[5][2];
#pragma unroll
  for (int j = 0; j < 8; ++j) wv[j] = wp[(size_t)j * 6144];
#pragma unroll
  for (int i = 0; i < 5; ++i) { cv[i][0] = *(const f32x4*)cp[i]; cv[i][1] = *(const f32x4*)(cp[i] + 4); }
#pragma unroll 1
  for (int ks = 0; ks < 16; ++ks) {
    bf16x8 bfr, afr[5];
#pragma unroll
    for (int j = 0; j < 8; ++j) bfr[j] = (bf16)wv[j];
#pragma unroll
    for (int i = 0; i < 5; ++i) {
      const bool ok = 32 * i + r < NMOD;
#pragma unroll
      for (int j = 0; j < 8; ++j) afr[i][j] = (bf16)(ok ? silu_f(cv[i][j >> 2][j & 3]) : 0.f);
    }
    const int kn = ks + 1 < 16 ? ks + 1 : 15;
#pragma unroll
    for (int j = 0; j < 8; ++j) wv[j] = wp[(size_t)(kn * 16 + j) * 6144];
#pragma unroll
    for (int i = 0; i < 5; ++i) { cv[i][0] = *(const f32x4*)(cp[i] + kn * 16); cv[i][1] = *(const f32x4*)(cp[i] + kn * 16 + 4); }
#pragma unroll
    for (int i = 0; i < 5; ++i) acc[i] = MFMA(afr[i], bfr, acc[i]);
  }
  float* red = (float*)smem;
  __syncthreads();
  if (w > 0) {
#pragma unroll
    for (int i = 0; i < 5; ++i)
#pragma unroll
      for (int j = 0; j < 16; ++j) red[((w - 1) * 80 + i * 16 + j) * 64 + lane] = acc[i][j];
  }
  __syncthreads();
  if (w == 0) {
    const float bias = p.ada_b[f0 + r];
#pragma unroll
    for (int i = 0; i < 5; ++i)
#pragma unroll
      for (int j = 0; j < 16; ++j) {
        const int m = 32 * i + crow(j, h);
        const float v = acc[i][j] + red[(0 * 80 + i * 16 + j) * 64 + lane] + red[(1 * 80 + i * 16 + j) * 64 + lane] + red[(2 * 80 + i * 16 + j) * 64 + lane] + bias;
        if (m < NMOD) w_MOD(p)[(size_t)m * 6144 + f0 + r] = v;
      }
  }
}

DI void unit_transpose(const float* __restrict__ src, bf16* __restrict__ dst, int R, int C, int tr, int tc, char* smem) {
  float* tile = (float*)smem;
  const int t = threadIdx.x + opaque0();
  __syncthreads();
#pragma unroll
  for (int i = 0; i < 4; ++i) {
    const int rr = (t >> 4) + 16 * i, cc = (t & 15) * 4;
    const f32x4 v = *(const f32x4*)(src + (size_t)(tr * 64 + rr) * C + tc * 64 + cc);
    tile[rr * 65 + cc] = v[0]; tile[rr * 65 + cc + 1] = v[1]; tile[rr * 65 + cc + 2] = v[2]; tile[rr * 65 + cc + 3] = v[3];
  }
  __syncthreads();
#pragma unroll
  for (int i = 0; i < 2; ++i) {
    const int orow = (t >> 3) + 32 * i, seg = (t & 7) * 8;
    bf16x8 v;
#pragma unroll
    for (int j = 0; j < 8; ++j) v[j] = (bf16)tile[(seg + j) * 65 + orow];
    *(bf16x8*)(dst + (size_t)(tc * 64 + orow) * R + tr * 64 + seg) = v;
  }
}
DI void unit_convert(const float* __restrict__ src, bf16* __restrict__ dst, int u) {
  const size_t base = (size_t)u * 8192 + (threadIdx.x + opaque0()) * 8;
#pragma unroll
  for (int i = 0; i < 4; ++i) {
    const size_t o = base + (size_t)i * 2048;
    const f32x4 a = *(const f32x4*)(src + o), b = *(const f32x4*)(src + o + 4);
    bf16x8 v; v[0] = (bf16)a[0]; v[1] = (bf16)a[1]; v[2] = (bf16)a[2]; v[3] = (bf16)a[3]; v[4] = (bf16)b[0]; v[5] = (bf16)b[1]; v[6] = (bf16)b[2]; v[7] = (bf16)b[3];
    *(bf16x8*)(dst + o) = v;
  }
}
DI unsigned pack_i8(float a, float b, float c, float d) {
  const int ia = max(-127, min(127, __float2int_rn(a))), ib = max(-127, min(127, __float2int_rn(b))), ic = max(-127, min(127, __float2int_rn(c))), id = max(-127, min(127, __float2int_rn(d)));
  return (unsigned)(ia & 255) | ((unsigned)(ib & 255) << 8) | ((unsigned)(ic & 255) << 16) | ((unsigned)(id & 255) << 24);
}
template <bool I8>
DI void unit_quant_rows(const float* __restrict__ src, unsigned char* __restrict__ dst, float* __restrict__ scale, int u) {
  const int t = threadIdx.x + opaque0(), lane = t & 63, w = t >> 6;
#pragma unroll
  for (int rr = 0; rr < 2; ++rr) {
    const size_t row = (size_t)u * 8 + 2 * w + rr;
    const float* s = src + row * DM + 16 * lane;
    f32x4 v[4];
    float amax = 0.f;
#pragma unroll
    for (int i = 0; i < 4; ++i) { v[i] = *(const f32x4*)(s + 4 * i); amax = fmaxf(amax, fmaxf(fmaxf(fabsf(v[i][0]), fabsf(v[i][1])), fmaxf(fabsf(v[i][2]), fabsf(v[i][3])))); }
#pragma unroll
    for (int o = 32; o >= 1; o >>= 1) amax = fmaxf(amax, __shfl_xor(amax, o));
    const float sc = amax > 0.f ? amax * (I8 ? 1.f / 127.f : 1.f / 440.f) : 1.f, inv = 1.f / sc;
    u32x4 q;
#pragma unroll
    for (int i = 0; i < 4; ++i) {
      if (I8) {
        q[i] = pack_i8(v[i][0] * inv, v[i][1] * inv, v[i][2] * inv, v[i][3] * inv);
      } else {
        int wd = 0;
        wd = __builtin_amdgcn_cvt_pk_fp8_f32(v[i][0] * inv, v[i][1] * inv, wd, false);
        wd = __builtin_amdgcn_cvt_pk_fp8_f32(v[i][2] * inv, v[i][3] * inv, wd, true);
        q[i] = (unsigned)wd;
      }
    }
    *(u32x4*)(dst + row * DM + 16 * lane) = q;
    if (lane == 0) scale[row] = sc;
  }
}
DI void unit_copy_f4(const float* __restrict__ src, float* __restrict__ dst, int n4) {
  for (int i = threadIdx.x + opaque0(); i < n4; i += NTHREADS) ((f32x4*)dst)[i] = ((const f32x4*)src)[i];
}

DI void phase0_filler(const P& p, int f, char* smem) {
  if (f < U0_TIN) { unit_transpose(p.w_in, w_Wt_in(p), 1024, INW, f / 60, f % 60, smem); }
  else {
    for (int i = threadIdx.x + opaque0(); i < 16 * 128; i += NTHREADS) {
      const int head = i >> 7, d = i & 127;
      int bk = d;
      if (d >= 16) { bk = 16 + (int)(logf((float)d / 16.f) / logf(8.f) * 16.f); bk = bk > 31 ? 31 : bk; }
      w_BIAS(p)[i] = p.rel_table[bk * 16 + head];
    }
  }
}
DI void phase2_filler(const P& p, int f, char* smem) {
  if (f < F2_TOUT) unit_transpose(p.w_out, w_Wt_out(p), 1024, 1024, f / 16, f % 16, smem);
  else if (f < F2_E1) { const int v = f - F2_TOUT; unit_transpose(p.w_query, w_Wt_q(p), 1024, 2048, v / 32, v % 32, smem); }
  else if (f < F2_E2) { const int v = f - F2_E1, g = v >> 3, tt = v & 7; unit_transpose(p.pool_w + (size_t)g * 128 * 256, w_PWt(p) + (size_t)g * 256 * 128, 128, 256, tt >> 2, tt & 3, smem); }
  else if (f < F2_E3) { const int b = f - F2_E2; unit_copy_f4(p.cache_k + ((size_t)b * 128 + 1) * 128, p.out + O_KWS + (size_t)b * 128 * 128, 127 * 128 / 4); }
  else if (f < F2_E4) { const int b = f - F2_E3; unit_copy_f4(p.cache_v + ((size_t)b * 128 + 1) * 128, p.out + O_VWS + (size_t)b * 128 * 128, 127 * 128 / 4); }
  else { const int b = f - F2_E4; unit_copy_f4(p.state_pool + ((size_t)b * 15 + 1) * 512, p.out + O_PS + (size_t)b * 15 * 512, 14 * 512 / 4); }
}

DI void norm_row(const P& p, int token, int which) {
  const int lane = (threadIdx.x + opaque0()) & 63;
  const float* src = which == 0 ? xrow(p, token) : w_X1(p) + (size_t)token * DM;
  const float* g = which == 0 ? p.norm1_g : p.norm2_g;
  const float* mod = w_MOD(p) + (size_t)cond_row(token) * 6144 + (which == 0 ? 0 : 3072);
  f32x4 v[4];
  float ss = 0.f;
#pragma unroll
  for (int i = 0; i < 4; ++i) { v[i] = *(const f32x4*)(src + 4 * lane + 256 * i); ss += v[i][0] * v[i][0] + v[i][1] * v[i][1] + v[i][2] * v[i][2] + v[i][3] * v[i][3]; }
  ss = wave_sum(ss);
  const float rstd = rsqrtf(ss * (1.f / DM) + EPS);
#pragma unroll
  for (int i = 0; i < 4; ++i) {
    const int c = 4 * lane + 256 * i;
    const f32x4 gg = *(const f32x4*)(g + c), sh = *(const f32x4*)(mod + c), sc = *(const f32x4*)(mod + 1024 + c);
    bf16x4 o;
#pragma unroll
    for (int j = 0; j < 4; ++j) { v[i][j] = (v[i][j] * rstd * gg[j]) * (1.f + sc[j]) + sh[j]; o[j] = (bf16)v[i][j]; }
    *(bf16x4*)(w_H(p) + (size_t)token * DM + c) = o;
  }
  if (which == 1) {
    float amax = 0.f;
#pragma unroll
    for (int i = 0; i < 4; ++i) amax = fmaxf(amax, fmaxf(fmaxf(fabsf(v[i][0]), fabsf(v[i][1])), fmaxf(fabsf(v[i][2]), fabsf(v[i][3]))));
#pragma unroll
    for (int o = 32; o >= 1; o >>= 1) amax = fmaxf(amax, __shfl_xor(amax, o));
    const float qs = amax > 0.f ? amax * (1.f / 127.f) : 1.f, inv = 1.f / qs;
#pragma unroll
    for (int i = 0; i < 4; ++i) *(unsigned*)(w_H8(p) + (size_t)token * DM + 4 * lane + 256 * i) = pack_i8(v[i][0] * inv, v[i][1] * inv, v[i][2] * inv, v[i][3] * inv);
    if (lane == 0) w_HS(p)[token] = qs;
  }
}

constexpr int LDSK = 72;
constexpr int GT = 128 * 64 * 2;
constexpr int GBUF = 2 * GT;
typedef __attribute__((address_space(3))) unsigned lds_u32;
typedef const __attribute__((address_space(1))) unsigned glb_u32;
DI void glds16(const void* g, char* l) { __builtin_amdgcn_global_load_lds((glb_u32*)g, (lds_u32*)l, 16, 0, 0); }
DI void gemm_first(const bf16* __restrict__ Wt, const bf16* __restrict__ X, int K, int n0, int m0, char* smem) {
  const int t = threadIdx.x + opaque0(), lane = t & 63;
  const int w = __builtin_amdgcn_readfirstlane(t >> 6);
  const int swz = (lane & 7) ^ ((4 * w + (lane >> 4)) & 7);
  const bf16* ga = Wt + (size_t)(n0 + 8 * w + (lane >> 3)) * K + swz * 8;
  const bf16* gb = X + (size_t)(m0 + 8 * w + (lane >> 3)) * K + swz * 8;
#pragma unroll
  for (int q = 0; q < 4; ++q) { glds16(ga + (size_t)(32 * q) * K, smem + 1024 * (w + 4 * q)); glds16(gb + (size_t)(32 * q) * K, smem + GT + 1024 * (w + 4 * q)); }
}
DI void gemm_main(const bf16* __restrict__ Wt, const bf16* __restrict__ X, int K, int n0, int m0, char* smem, f32x16 (&acc)[4]) {
  const int t = threadIdx.x + opaque0(), lane = t & 63, r = lane & 31, h = lane >> 5;
  const int w = __builtin_amdgcn_readfirstlane(t >> 6);
#pragma unroll
  for (int i = 0; i < 4; ++i) acc[i] = zero16();
  const int swz = (lane & 7) ^ ((4 * w + (lane >> 4)) & 7);
  const bf16* ga = Wt + (size_t)(n0 + 8 * w + (lane >> 3)) * K + swz * 8;
  const bf16* gb = X + (size_t)(m0 + 8 * w + (lane >> 3)) * K + swz * 8;
  const int sw = (r >> 1) & 7;
  const int KT = K >> 6;
  asm volatile("s_waitcnt vmcnt(0)" ::: "memory");
  __syncthreads();
  for (int kt = 0; kt < KT; ++kt) {
    const char* As = smem + (kt & 1) * GBUF;
    const char* Bs = As + GT;
    if (kt + 1 < KT) {
      char* An = smem + ((kt + 1) & 1) * GBUF;
      const int k0 = (kt + 1) * 64;
#pragma unroll
      for (int q = 0; q < 4; ++q) { glds16(ga + (size_t)(32 * q) * K + k0, An + 1024 * (w + 4 * q)); glds16(gb + (size_t)(32 * q) * K + k0, An + GT + 1024 * (w + 4 * q)); }
    }
#pragma unroll
    for (int s = 0; s < 4; ++s) {
      const int co = ((2 * s + h) ^ sw) * 16;
      const bf16x8 bfr = *(const bf16x8*)(Bs + (32 * w + r) * 128 + co);
#pragma unroll
      for (int i = 0; i < 4; ++i) {
        const bf16x8 afr = *(const bf16x8*)(As + (32 * i + r) * 128 + co);
        acc[i] = MFMA(afr, bfr, acc[i]);
      }
    }
    asm volatile("s_waitcnt vmcnt(0)" ::: "memory");
    __syncthreads();
  }
}

DI float sigmoid_f(float x) { return __builtin_amdgcn_rcpf(1.f + __expf(-x)); }

DI void unit_gemm1(const P& p, int u, int un, char* smem) {
  const int mt = u / 30, nt = u % 30;
  const int n0 = nt * 128, m0 = mt * 128;
  f32x16 acc[4];
  gemm_main(w_Wt_in(p), w_H(p), 1024, n0, m0, smem, acc);
  if (un >= 0) gemm_first(w_Wt_in(p), w_H(p), 1024, (un % 30) * 128, (un / 30) * 128, smem);
  const int tz = threadIdx.x + opaque0();
  const int lane = tz & 63, w = tz >> 6, r = lane & 31, h = lane >> 5;
  const int token = m0 + 32 * w + r;
  bf16* tw = (bf16*)(smem + GBUF + (tz >> 6) * 8704) + r * 136;
  const bool is_prompt = token < NPR;
  const int b = is_prompt ? (token >> 11) : (token - NPR), pos = token & (SEQ - 1);
  if (n0 < C_V) {
    const float* gn = n0 < C_K ? p.q_norm_g : p.k_norm_g;
    const float post = n0 < C_K ? 0.125f : 1.f;
#pragma unroll
    for (int hh = 0; hh < 2; ++hh) {
      float ss = 0.f;
#pragma unroll
      for (int i = 0; i < 2; ++i)
#pragma unroll
        for (int j = 0; j < 16; ++j) ss += acc[2 * hh + i][j] * acc[2 * hh + i][j];
      ss += __shfl_xor(ss, 32);
      const float rstd = rsqrtf(ss * (1.f / 64.f) + EPS);
#pragma unroll
      for (int i = 0; i < 2; ++i)
#pragma unroll
        for (int q4 = 0; q4 < 4; ++q4) {
          const int d = 32 * i + 8 * q4 + 4 * h;
          const f32x4 gg = *(const f32x4*)(gn + d);
          f32x4 v;
#pragma unroll
          for (int j = 0; j < 4; ++j) v[j] = acc[2 * hh + i][4 * q4 + j] * rstd * gg[j];
          bf16x4 o;
#pragma unroll
          for (int j = 0; j < 4; ++j) o[j] = (bf16)(v[j] * post);
          *(bf16x4*)(tw + 64 * hh + d) = o;
          if (n0 == C_K) {
            if (is_prompt) { if (pos >= SEQ - 128) *(f32x4*)(p.out + O_KWP + ((size_t)b * 128 + (pos - (SEQ - 128))) * 128 + 64 * hh + d) = v; }
            else *(f32x4*)(p.out + O_KWS + ((size_t)b * 128 + 127) * 128 + 64 * hh + d) = v;
          }
        }
    }
  } else if (n0 == C_V) {
#pragma unroll
    for (int i = 0; i < 4; ++i)
#pragma unroll
      for (int q4 = 0; q4 < 4; ++q4) {
        const int f = 32 * i + 8 * q4 + 4 * h;
        f32x4 v;
#pragma unroll
        for (int j = 0; j < 4; ++j) v[j] = acc[i][4 * q4 + j];
        if (is_prompt) {
#pragma unroll
          for (int j = 0; j < 4; ++j) w_VT(p)[((size_t)b * 128 + f + j) * SEQ + pos] = (bf16)v[j];
          if (pos >= SEQ - 128) *(f32x4*)(p.out + O_VWP + ((size_t)b * 128 + (pos - (SEQ - 128))) * 128 + f) = v;
        } else *(f32x4*)(p.out + O_VWS + ((size_t)b * 128 + 127) * 128 + f) = v;
      }
  } else if (n0 < C_GA) {
#pragma unroll
    for (int i = 0; i < 4; ++i)
#pragma unroll
      for (int q4 = 0; q4 < 4; ++q4) {
        const int f = n0 + 32 * i + 8 * q4 + 4 * h;
        f32x4 v; bf16x4 o;
#pragma unroll
        for (int j = 0; j < 4; ++j) { v[j] = acc[i][4 * q4 + j]; o[j] = (bf16)v[j]; }
        *(bf16x4*)(tw + (f - n0)) = o;
        if (is_prompt) { if (pos >= SEQ - 15) *(f32x4*)(p.out + O_PP + ((size_t)b * 15 + (pos - (SEQ - 15))) * 512 + (f - C_PIN)) = v; }
        else *(f32x4*)(p.out + O_PS + ((size_t)b * 15 + 14) * 512 + (f - C_PIN)) = v;
      }
  } else {
#pragma unroll
    for (int i = 0; i < 4; ++i)
#pragma unroll
      for (int q4 = 0; q4 < 4; ++q4) {
        const int f = n0 + 32 * i + 8 * q4 + 4 * h;
        bf16x4 o;
#pragma unroll
        for (int j = 0; j < 4; ++j) o[j] = (bf16)sigmoid_f(acc[i][4 * q4 + j]);
        *(bf16x4*)(tw + (f - n0)) = o;
      }
  }
  if (n0 != C_V) {
    LDS_WAIT();
    const bf16* tr = (const bf16*)(smem + GBUF + (tz >> 6) * 8704);
    bf16* pg = w_PROJ(p) + (size_t)(m0 + 32 * w + (lane >> 4)) * INW + n0 + (lane & 15) * 8;
#pragma unroll
    for (int it = 0; it < 8; ++it) *(u32x4*)(pg + (size_t)(4 * it) * INW) = *(const u32x4*)(tr + ((lane >> 4) + 4 * it) * 136 + (lane & 15) * 8);
  }
}

constexpr int VTS = 260;
constexpr int RS = 136;
DI void attn_head(const P& p, int head, int blk, int w, int r, int h, size_t tokq, const bf16* Ks, const bf16* VTs, const float* bsh, bf16x8 (&ob)[4]) {
  const int qi = 32 * w + r;
  bf16x8 qf[4];
#pragma unroll
  for (int s = 0; s < 4; ++s) qf[s] = *(const bf16x8*)(w_PROJ(p) + tokq * INW + head * 64 + 16 * s + 8 * h);
  f32x16 st[5];
#pragma unroll
  for (int tt = 0; tt < 5; ++tt) {
    st[tt] = zero16();
#pragma unroll
    for (int s = 0; s < 4; ++s) {
      const bf16x8 a = *(const bf16x8*)(Ks + (32 * (w + tt) + r) * LDSK + 16 * s + 8 * h);
      st[tt] = MFMA(a, qf[s], st[tt]);
    }
  }
  const float sink = p.sinks[head];
  float m = -INFINITY;
  {
    const int x = 31 - r + 4 * h;
    const float* bl = bsh + x;
#pragma unroll
    for (int tt = 0; tt < 5; ++tt)
#pragma unroll
      for (int j = 0; j < 16; ++j) {
        const int c = 32 * tt + (j & 3) + 8 * (j >> 2);
        const float s = st[tt][j] + bl[c];
        st[tt][j] = s;
        m = fmaxf(m, s);
      }
    if (blk == 0) {
      m = -INFINITY;
#pragma unroll
      for (int tt = 0; tt < 5; ++tt)
#pragma unroll
        for (int j = 0; j < 16; ++j) {
          const int c = 32 * tt + (j & 3) + 8 * (j >> 2);
          const float s = (159 - (x + c) > qi) ? -INFINITY : st[tt][j];
          st[tt][j] = s;
          m = fmaxf(m, s);
        }
    }
  }
  m = fmaxf(m, __shfl_xor(m, 32));
  m = fmaxf(m, sink);
  float sum = 0.f;
#pragma unroll
  for (int tt = 0; tt < 5; ++tt)
#pragma unroll
    for (int j = 0; j < 16; ++j) { const float e = __expf(st[tt][j] - m); st[tt][j] = e; sum += e; }
  sum += __shfl_xor(sum, 32);
  const float inv = 1.f / (sum + __expf(sink - m));
  f32x16 o[2] = {zero16(), zero16()};
#pragma unroll
  for (int tt = 0; tt < 5; ++tt)
#pragma unroll
    for (int s = 0; s < 2; ++s) {
      const bf16x8 pb = pack_step(st[tt], s);
#pragma unroll
      for (int i = 0; i < 2; ++i) {
        const bf16* vp = VTs + (32 * i + r) * VTS + 32 * (w + tt) + 16 * s + 4 * h;
        const bf16x8 a = cat4(*(const bf16x4*)vp, *(const bf16x4*)(vp + 8));
        o[i] = MFMA(a, pb, o[i]);
      }
    }
#pragma unroll
  for (int i = 0; i < 2; ++i)
#pragma unroll
    for (int j = 0; j < 16; ++j) ob[2 * i + (j >> 3)][j & 7] = (bf16)(o[i][j] * inv);
}
DI void unit_attn_prompt(const P& p, int u, char* smem) {
  const int b = u >> 7, blk = (u >> 3) & 15, hp = u & 7, hk = hp >> 2, g = hp >> 1, win = 2 << g;
  const int qpos0 = blk * 128;
  const int t = threadIdx.x + opaque0(), lane = t & 63, w = t >> 6, r = lane & 31, h = lane >> 5;
  bf16* Ks = (bf16*)smem;
  bf16* VTs = Ks + 256 * LDSK;
  float* bs = (float*)(VTs + 64 * VTS);
  bf16* Rs = Ks;
  __syncthreads();
#pragma unroll
  for (int i = 0; i < 8; ++i) {
    const int c = t + 256 * i, row = c >> 3, c16 = c & 7, kp = qpos0 - 128 + row;
    u32x4 v = {0u, 0u, 0u, 0u};
    if (kp >= 0) v = *(const u32x4*)(w_PROJ(p) + ((size_t)b * SEQ + kp) * INW + C_K + hk * 64 + c16 * 8);
    *(u32x4*)(Ks + row * LDSK + c16 * 8) = v;
  }
#pragma unroll
  for (int i = 0; i < 8; ++i) {
    const int c = t + 256 * i, drow = c >> 5, c16 = c & 31, kp0 = qpos0 - 128 + c16 * 8;
    u32x4 v = {0u, 0u, 0u, 0u};
    if (kp0 >= 0) v = *(const u32x4*)(w_VT(p) + ((size_t)(b * 2 + hk) * 64 + drow) * SEQ + kp0);
    u32x2* d2 = (u32x2*)(VTs + drow * VTS + c16 * 8);
    d2[0] = (u32x2){v[0], v[1]}; d2[1] = (u32x2){v[2], v[3]};
  }
  for (int i = t; i < 384; i += NTHREADS) { const int hh = i >= 192, j = i - 192 * hh, dist = 159 - j; bs[i] = (dist >= 0 && dist < 128) ? w_BIAS(p)[(2 * hp + hh) * 128 + dist] : -INFINITY; }
  const size_t tokq = (size_t)b * SEQ + qpos0 + 32 * w + r;
  __syncthreads();
  bf16x8 ob0[4], ob1[4];
  attn_head(p, 2 * hp, blk, w, r, h, tokq, Ks, VTs, bs, ob0);
  __builtin_amdgcn_sched_barrier(0);
  attn_head(p, 2 * hp + 1, blk, w, r, h, tokq, Ks, VTs, bs + 192, ob1);
  __builtin_amdgcn_sched_barrier(0);
  __syncthreads();
  {
    const int tk = t >> 4, cc = t & 15;
    const int p0 = qpos0 + tk * 8;
    const bf16* pin = w_PROJ(p) + (size_t)b * SEQ * INW + C_PIN + g * 128 + cc * 8;
    float S[8];
#pragma unroll
    for (int j = 0; j < 8; ++j) S[j] = 0.f;
    for (int i = 0; i < win; ++i) {
      const int pp = p0 - i;
      if (pp >= 0) { const bf16x8 v = *(const bf16x8*)(pin + (size_t)pp * INW);
#pragma unroll
        for (int j = 0; j < 8; ++j) S[j] += bf2f(v[j]); }
    }
    for (int i = 0; i < 8; ++i) {
      const int pos = p0 + i;
      const bf16x8 cur = *(const bf16x8*)(pin + (size_t)pos * INW);
      if (i > 0) {
#pragma unroll
        for (int j = 0; j < 8; ++j) S[j] += bf2f(cur[j]);
        if (pos - win >= 0) { const bf16x8 old = *(const bf16x8*)(pin + (size_t)(pos - win) * INW);
#pragma unroll
          for (int j = 0; j < 8; ++j) S[j] -= bf2f(old[j]); }
      }
      const float icnt = 1.f / (float)(win < pos + 1 ? win : pos + 1);
      bf16x8 rr;
#pragma unroll
      for (int j = 0; j < 8; ++j) rr[j] = (bf16)(S[j] * icnt - bf2f(cur[j]));
      *(bf16x8*)(Rs + (tk * 8 + i) * RS + cc * 8) = rr;
    }
  }
  __syncthreads();
  const bf16* prow = w_PROJ(p) + tokq * INW;
#pragma unroll
  for (int hh = 0; hh < 2; ++hh) {
    const int head = 2 * hp + hh;
    f32x16 pa[2] = {zero16(), zero16()};
#pragma unroll
    for (int s = 0; s < 8; ++s) {
      const bf16x8 bfr = *(const bf16x8*)(Rs + (32 * w + r) * RS + 16 * s + 8 * h);
#pragma unroll
      for (int i = 0; i < 2; ++i) {
        const bf16x8 a = *(const bf16x8*)(w_PWt(p) + ((size_t)g * 256 + (head & 3) * 64 + 32 * i + r) * 128 + 16 * s + 8 * h);
        pa[i] = MFMA(a, bfr, pa[i]);
      }
    }
#pragma unroll
    for (int i = 0; i < 2; ++i)
#pragma unroll
      for (int q4 = 0; q4 < 4; ++q4) {
        const int f = head * 64 + 32 * i + 8 * q4 + 4 * h;
        const bf16x4 ga = *(const bf16x4*)(prow + C_GA + f), gb = *(const bf16x4*)(prow + C_GB + f);
        const f32x4 ps = *(const f32x4*)(p.pool_scale + f);
        bf16x4 ov;
#pragma unroll
        for (int j = 0; j < 4; ++j) { const bf16 av = hh ? ob1[2 * i + (q4 >> 1)][4 * (q4 & 1) + j] : ob0[2 * i + (q4 >> 1)][4 * (q4 & 1) + j];
          ov[j] = (bf16)(bf2f(ga[j]) * bf2f(av) + bf2f(gb[j]) * (pa[i][4 * q4 + j] * ps[j])); }
        *(bf16x4*)(w_MIXED(p) + tokq * DM + f) = ov;
      }
    __builtin_amdgcn_sched_barrier(0);
  }
}

DI void unit_attn_sample(const P& p, int u, char* smem) {
  const int b = u >> 2, g = u & 3, hk = g >> 1;
  const int t = threadIdx.x + opaque0(), lane = t & 63, w = t >> 6;
  float* ks = (float*)smem;
  float* vs = ks + 128 * 65;
  float* qs = vs + 128 * 64;
  float* ps = qs + 256;
  float* os = ps + 512;
  float* rs = os + 256;
  const size_t token = (size_t)NPR + b;
  __syncthreads();
  const float* kw = p.out + O_KWS + (size_t)b * 128 * 128 + hk * 64;
  const float* vw = p.out + O_VWS + (size_t)b * 128 * 128 + hk * 64;
#pragma unroll 4
  for (int i = t; i < 128 * 64; i += NTHREADS) { const int j = i >> 6, d = i & 63; ks[j * 65 + d] = kw[(size_t)j * 128 + d]; vs[j * 64 + d] = vw[(size_t)j * 128 + d]; }
  qs[t] = bf2f(w_PROJ(p)[token * INW + g * 256 + t]);
  if (t < 128) {
    const int win = 2 << g;
    const float cur = p.out[O_PS + ((size_t)b * 15 + 14) * 512 + g * 128 + t];
    float tot = cur;
#pragma unroll 1
    for (int i = 1; i < win; ++i) tot += p.state_pool[((size_t)b * 15 + 15 - i) * 512 + g * 128 + t];
    rs[t] = tot / (float)win - cur;
  }
  __syncthreads();
  const int head = 4 * g + w;
  const float sink = p.sinks[head];
  float s[2];
  float m = sink;
#pragma unroll
  for (int i = 0; i < 2; ++i) {
    const int j = lane + 64 * i;
    float a = 0.f;
#pragma unroll 8
    for (int d = 0; d < 64; ++d) a += qs[w * 64 + d] * ks[j * 65 + d];
    s[i] = a + w_BIAS(p)[head * 128 + 127 - j];
    m = fmaxf(m, s[i]);
  }
  for (int o = 32; o >= 1; o >>= 1) m = fmaxf(m, __shfl_xor(m, o));
  float sum = 0.f;
#pragma unroll
  for (int i = 0; i < 2; ++i) { s[i] = __expf(s[i] - m); sum += s[i]; }
  sum = wave_sum(sum);
  const float inv = 1.f / (sum + __expf(sink - m));
#pragma unroll
  for (int i = 0; i < 2; ++i) ps[w * 128 + lane + 64 * i] = s[i] * inv;
  LDS_WAIT();
  {
    float a = 0.f;
#pragma unroll 8
    for (int j = 0; j < 128; ++j) a += ps[w * 128 + j] * vs[j * 64 + lane];
    os[w * 64 + lane] = a;
  }
  const int f = g * 256 + t;
  float pl = 0.f;
  const float* pw = p.pool_w + (size_t)g * 128 * 256 + t;
#pragma unroll 8
  for (int ch = 0; ch < 128; ++ch) pl += rs[ch] * pw[(size_t)ch * 256];
  pl *= p.pool_scale[f];
  const float ga = bf2f(w_PROJ(p)[token * INW + C_GA + f]), gb = bf2f(w_PROJ(p)[token * INW + C_GB + f]);
  LDS_WAIT();
  w_MIXED(p)[token * DM + f] = (bf16)(ga * os[t] + gb * pl);
}

DI void unit8_map(int u, int& mt, int& nt) {
  if (u < 1024) { const int xcd = u & 7, slot = (u >> 3) & 63, S = (u >> 9) * 8 + xcd; mt = S * 8 + (slot & 7); nt = slot >> 3; }
  else { mt = 128; nt = u - 1024; }
}
DI void unit_gemm2(const P& p, int u, int un, char* smem) {
  int mt, nt; unit8_map(u, mt, nt);
  const int n0 = nt * 128, m0 = mt * 128;
  f32x16 acc[4];
  gemm_main(w_Wt_out(p), w_MIXED(p), 1024, n0, m0, smem, acc);
  if (un >= 0) { int mn, nn; unit8_map(un, mn, nn); gemm_first(w_Wt_out(p), w_MIXED(p), 1024, nn * 128, mn * 128, smem); }
  const int tz = threadIdx.x + opaque0();
  const int lane = tz & 63, w = tz >> 6, r = lane & 31, h = lane >> 5;
  float* tbase = (float*)(smem + GBUF + w * 8704);
#pragma unroll
  for (int hf = 0; hf < 2; ++hf) {
    if (hf) LDS_WAIT();
#pragma unroll
    for (int ii = 0; ii < 2; ++ii)
#pragma unroll
      for (int q4 = 0; q4 < 4; ++q4) {
        f32x4 v;
#pragma unroll
        for (int j = 0; j < 4; ++j) v[j] = acc[2 * hf + ii][4 * q4 + j];
        *(f32x4*)(tbase + r * 68 + 32 * ii + 8 * q4 + 4 * h) = v;
      }
    LDS_WAIT();
    const int fc = (lane & 15) * 4, tsub = lane >> 4;
#pragma unroll
    for (int it = 0; it < 8; ++it) {
      const int tl = 4 * it + tsub, token = m0 + 32 * w + tl, f = n0 + 64 * hf + fc;
      const f32x4 a = *(const f32x4*)(tbase + tl * 68 + fc);
      const f32x4 xv = *(const f32x4*)(xrow(p, token) + f), gv = *(const f32x4*)(w_MOD(p) + (size_t)cond_row(token) * 6144 + 2048 + f);
      f32x4 o;
#pragma unroll
      for (int j = 0; j < 4; ++j) o[j] = xv[j] + gv[j] * a[j];
      *(f32x4*)(w_X1(p) + (size_t)token * DM + f) = o;
    }
  }
}

DI unsigned f2ord(float f) { const unsigned u = __float_as_uint(f); return (u & 0x80000000u) ? ~u : (u | 0x80000000u); }
DI float ord2f(unsigned u) { return __uint_as_float((u & 0x80000000u) ? (u & 0x7fffffffu) : ~u); }
DI unsigned umin_(unsigned a, unsigned b) { return a < b ? a : b; }
DI unsigned umax_(unsigned a, unsigned b) { return a > b ? a : b; }
template <int OFF> DI void sort16_desc(unsigned (&a)[64]) {
#pragma unroll
  for (int lk = 1; lk <= 4; ++lk)
#pragma unroll
    for (int lj = lk - 1; lj >= 0; --lj)
#pragma unroll
      for (int i = 0; i < 16; ++i) {
        const int k = 1 << lk, j = 1 << lj, l = i ^ j;
        if (l > i) {
          const unsigned lo = umin_(a[OFF + i], a[OFF + l]), hi = umax_(a[OFF + i], a[OFF + l]);
          const bool desc = (i & k) == 0;
          a[OFF + i] = desc ? hi : lo; a[OFF + l] = desc ? lo : hi;
        }
      }
}
DI void merge16_desc(unsigned (&a)[16]) {
#pragma unroll
  for (int lj = 3; lj >= 0; --lj)
#pragma unroll
    for (int i = 0; i < 16; ++i) {
      const int j = 1 << lj, l = i ^ j;
      if (l > i) { const unsigned lo = umin_(a[i], a[l]), hi = umax_(a[i], a[l]); a[i] = hi; a[l] = lo; }
    }
}
DI void top16_of_64(unsigned (&a)[64], unsigned (&out)[16]) {
  sort16_desc<0>(a); sort16_desc<16>(a); sort16_desc<32>(a); sort16_desc<48>(a);
  unsigned x[16], y[16];
#pragma unroll
  for (int i = 0; i < 16; ++i) { x[i] = umax_(a[i], a[31 - i]); y[i] = umax_(a[32 + i], a[63 - i]); }
  merge16_desc(x); merge16_desc(y);
#pragma unroll
  for (int i = 0; i < 16; ++i) out[i] = umax_(x[i], y[15 - i]);
  merge16_desc(out);
}
__device__ constexpr int COFF[16] = {0, 16, 24, 29, 33, 36, 38, 40, 42, 43, 44, 45, 46, 47, 48, 49};
DI unsigned umax3(unsigned a, unsigned b, unsigned c) { const unsigned m = a > b ? a : b; return m > c ? m : c; }

DI void unit_peer_route(const P& p, int u, int un, char* smem) {
  int mt, hd; unit8_map(u, mt, hd);
  const int m0 = mt * 128;
  const int t = threadIdx.x + opaque0(), lane = t & 63, w = t >> 6, r = lane & 31, h = lane >> 5;
  unsigned char* myidx = (unsigned char*)smem + 2 * GBUF + t * 32;
  unsigned top[2][16];
#pragma unroll
  for (int pp = 0; pp < 2; ++pp) {
    f32x16 acc[4];
    gemm_main(w_Wt_q(p), w_H(p), 1024, hd * 256 + pp * 128, m0, smem, acc);
    if (pp == 0) gemm_first(w_Wt_q(p), w_H(p), 1024, hd * 256 + 128, m0, smem);
    else if (un >= 0) { int mn, hn; unit8_map(un, mn, hn); gemm_first(w_Wt_q(p), w_H(p), 1024, hn * 256, mn * 128, smem); }
    f32x16 sc[4] = {zero16(), zero16(), zero16(), zero16()};
    {
      const bf16* skb = w_SK(p) + (size_t)(hd * 2 + pp) * 128 * 128;
      const int wu = __builtin_amdgcn_readfirstlane(w);
#pragma unroll
      for (int q = 0; q < 8; ++q) {
        const int j = wu + 4 * q, row = 4 * j + (lane >> 4);
        glds16(skb + (size_t)row * 128 + (((lane & 15) ^ (row & 15)) * 8), smem + GBUF + 1024 * j);
      }
      asm volatile("s_waitcnt vmcnt(0)" ::: "memory");
      __syncthreads();
    }
    bf16x8 bqs[8];
#pragma unroll
    for (int i = 0; i < 4; ++i)
#pragma unroll
      for (int s = 0; s < 2; ++s) bqs[2 * i + s] = pack_step(acc[i], s);
#pragma unroll
    for (int i = 0; i < 4; ++i)
#pragma unroll
      for (int s = 0; s < 2; ++s) {
        const bf16x8 bq = bqs[2 * i + s];
#pragma unroll
        for (int kt = 0; kt < 4; ++kt) {
          const int row = 32 * kt + r, cc = 4 * i + 2 * s;
          const char* rp = smem + GBUF + row * 256 + 8 * h;
          const bf16x8 a = cat4(*(const bf16x4*)(rp + ((cc ^ (row & 15)) * 16)), *(const bf16x4*)(rp + (((cc + 1) ^ (row & 15)) * 16)));
          sc[kt] = MFMA(a, bq, sc[kt]);
        }
      }
    unsigned pk[64];
#pragma unroll
    for (int kt = 0; kt < 4; ++kt)
#pragma unroll
      for (int j = 0; j < 16; ++j) { const int key = 32 * kt + crow(j, h); pk[kt * 16 + j] = (f2ord(sc[kt][j]) & ~127u) | (unsigned)(127 - key); }
    unsigned mine[16];
    top16_of_64(pk, mine);
#pragma unroll
    for (int i = 0; i < 16; ++i) top[pp][i] = (unsigned)__shfl_xor((int)mine[15 - i], 32);
#pragma unroll
    for (int i = 0; i < 16; ++i) top[pp][i] = umax_(top[pp][i], mine[i]);
    merge16_desc(top[pp]);
  }
  float v0[16], v1[16];
#pragma unroll
  for (int a = 0; a < 16; ++a) {
    v0[a] = ord2f(top[0][a] & ~127u); v1[a] = ord2f(top[1][a] & ~127u);
    myidx[a] = (unsigned char)(127u - (top[0][a] & 127u)); myidx[16 + a] = (unsigned char)(127u - (top[1][a] & 127u));
  }
  unsigned cand[64];
#pragma unroll
  for (int i = 50; i < 64; ++i) cand[i] = 0u;
#pragma unroll
  for (int a = 0; a < 16; ++a)
#pragma unroll
    for (int bb = 0; bb < 16 / (a + 1); ++bb)
      cand[COFF[a] + bb] = (f2ord(v0[a] + v1[bb]) & ~255u) | (unsigned)(255 - (a * 16 + bb));
  unsigned best[16];
  top16_of_64(cand, best);
  const float smax = ord2f(best[0] & ~255u);
  float e[16], esum = 0.f;
#pragma unroll
  for (int i = 0; i < 16; ++i) { e[i] = __expf(ord2f(best[i] & ~255u) - smax); esum += e[i]; }
  const float einv = 1.f / esum;
  const size_t token = (size_t)m0 + 32 * w + r;
  int* ip = w_IDX(p) + token * 128 + hd * 16 + 8 * h;
  float* gp = w_GATE(p) + token * 128 + hd * 16 + 8 * h;
  const unsigned hmask = 0u - (unsigned)h;
#pragma unroll
  for (int i = 0; i < 8; ++i) {
    const unsigned bsel = best[i] ^ ((best[i] ^ best[8 + i]) & hmask);
    const float esel = __uint_as_float(__float_as_uint(e[i]) ^ ((__float_as_uint(e[i]) ^ __float_as_uint(e[8 + i])) & hmask));
    const unsigned code = 255u - (bsel & 255u);
    const int a = code >> 4, bb = code & 15;
    ip[i] = (int)myidx[a] * 128 + (int)myidx[16 + bb];
    gp[i] = esel * einv;
  }
}

DI float gelu_fast(float v) {
  const float av = fabsf(v), tt = __builtin_amdgcn_rcpf(av * 0.2316418882f + 1.0f);
  float q = tt * 0.5307027145f - 0.7265760135f; q = q * tt + 0.7107068705f; q = q * tt - 0.142248368f; q = q * tt + 0.127414796f; q = q * tt;
  const float e = __builtin_amdgcn_exp2f(v * v * -0.72134752044f);
  const float m = v * (q * e);
  return v < 0.f ? m : v - m;
}
DI float dot2bf(unsigned a, unsigned b, float acc) { return __builtin_amdgcn_fdot2_f32_bf16(__builtin_bit_cast(bf16x2, a), __builtin_bit_cast(bf16x2, b), acc, false); }
DI unsigned pkbf(f32x2 v) { bf16x2 r; r[0] = (bf16)v[0]; r[1] = (bf16)v[1]; return __builtin_bit_cast(unsigned, r); }
DI int dot16i(u32x4 u8, u32x4 x8, int d) {
#pragma unroll
  for (int m = 0; m < 4; ++m) d = __builtin_amdgcn_sdot4((int)u8[m], (int)x8[m], d, false);
  return d;
}
DI void axpy16p(f32x2* o, u32x4 v8, f32x2 c2) {
#pragma unroll
  for (int m = 0; m < 4; ++m) {
    const int wd = (int)v8[m];
    o[2 * m] = __builtin_elementwise_fma(c2, __builtin_amdgcn_cvt_pk_f32_fp8(wd, false), o[2 * m]);
    o[2 * m + 1] = __builtin_elementwise_fma(c2, __builtin_amdgcn_cvt_pk_f32_fp8(wd, true), o[2 * m + 1]);
  }
}
DI int dpp_add16i(int v) {
  v += __builtin_amdgcn_update_dpp(0, v, 0x140, 0xf, 0xf, true);
  v += __builtin_amdgcn_update_dpp(0, v, 0x141, 0xf, 0xf, true);
  v += __builtin_amdgcn_update_dpp(0, v, 0x4e, 0xf, 0xf, true);
  v += __builtin_amdgcn_update_dpp(0, v, 0xb1, 0xf, 0xf, true);
  return v;
}
DI float dot16(u32x4 u8, u32x4 xlo, u32x4 xhi, float d) {
#pragma unroll
  for (int m = 0; m < 4; ++m) {
    const int wd = (int)u8[m];
    const unsigned p01 = pkbf(__builtin_amdgcn_cvt_pk_f32_fp8(wd, false)), p23 = pkbf(__builtin_amdgcn_cvt_pk_f32_fp8(wd, true));
    const unsigned x01 = m < 2 ? xlo[2 * m] : xhi[2 * m - 4], x23 = m < 2 ? xlo[2 * m + 1] : xhi[2 * m - 3];
    d = dot2bf(p01, x01, d); d = dot2bf(p23, x23, d);
  }
  return d;
}
DI void axpy16(float* o, u32x4 v8, float c) {
#pragma unroll
  for (int m = 0; m < 4; ++m) {
    const int wd = (int)v8[m];
    const f32x2 a = __builtin_amdgcn_cvt_pk_f32_fp8(wd, false), b = __builtin_amdgcn_cvt_pk_f32_fp8(wd, true);
    o[4 * m] += c * a[0]; o[4 * m + 1] += c * a[1]; o[4 * m + 2] += c * b[0]; o[4 * m + 3] += c * b[1];
  }
}
DI float reduce4(const float (&d)[4], int lane) {
  const int h = lane >> 5, b4 = (lane >> 4) & 1;
  float a0 = h ? d[2] : d[0], a1 = h ? d[3] : d[1];
  const float s0 = h ? d[0] : d[2], s1 = h ? d[1] : d[3];
  a0 += __shfl_xor(s0, 32); a1 += __shfl_xor(s1, 32);
  float k = b4 ? a1 : a0;
  const float s = b4 ? a0 : a1;
  k += __shfl_xor(s, 16);
  k += __shfl_xor(k, 8); k += __shfl_xor(k, 4); k += __shfl_xor(k, 2); k += __shfl_xor(k, 1);
  return k;
}
DI float dpp_add16(float v) {
  v += __int_as_float(__builtin_amdgcn_update_dpp(0, __float_as_int(v), 0x140, 0xf, 0xf, true));
  v += __int_as_float(__builtin_amdgcn_update_dpp(0, __float_as_int(v), 0x141, 0xf, 0xf, true));
  v += __int_as_float(__builtin_amdgcn_update_dpp(0, __float_as_int(v), 0x4e, 0xf, 0xf, true));
  v += __int_as_float(__builtin_amdgcn_update_dpp(0, __float_as_int(v), 0xb1, 0xf, 0xf, true));
  return v;
}
constexpr int PEER_GLDS = 512 + 128 * 16;
constexpr int PEER_WLDS = 4 * PEER_GLDS;
DI void peer_wave4(const P& p, int g, char* wl) {
  const int lane = (threadIdx.x + opaque0()) & 63, q = lane >> 4, j16 = lane & 15;
  unsigned* hist = (unsigned*)(wl + q * PEER_GLDS);
  u32x4* list = (u32x4*)(wl + q * PEER_GLDS + 512);
  const int token = 4 * g + q;
  u32x4 x[4];
  {
    const unsigned char* hrow = w_H8(p) + (size_t)token * DM + 16 * j16;
#pragma unroll
    for (int i = 0; i < 4; ++i) x[i] = *(const u32x4*)(hrow + 256 * i);
  }
  const float xs = w_HS(p)[token];
  {
    int ids[8]; float gts[8], su[8];
#pragma unroll
    for (int i = 0; i < 8; ++i) { const size_t o = (size_t)token * 128 + j16 + 16 * i; ids[i] = w_IDX(p)[o]; gts[i] = w_GATE(p)[o]; }
#pragma unroll
    for (int i = 0; i < 8; ++i) { su[i] = w_SU(p)[ids[i]] * xs; gts[i] *= w_SV(p)[ids[i]]; }
    LDS_WAIT();
    *(u32x4*)(hist + 8 * j16) = (u32x4){0u, 0u, 0u, 0u}; *(u32x4*)(hist + 8 * j16 + 4) = (u32x4){0u, 0u, 0u, 0u};
    LDS_WAIT();
#pragma unroll
    for (int i = 0; i < 8; ++i) (void)__hip_atomic_fetch_add(&hist[ids[i] >> 7], 1u, __ATOMIC_RELAXED, __HIP_MEMORY_SCOPE_WAVEFRONT);
    LDS_WAIT();
    const u32x4 ca = *(const u32x4*)(hist + 8 * j16), cb = *(const u32x4*)(hist + 8 * j16 + 4);
    const unsigned tot = ca[0] + ca[1] + ca[2] + ca[3] + cb[0] + cb[1] + cb[2] + cb[3];
    unsigned scan = tot;
#pragma unroll
    for (int o = 1; o < 16; o <<= 1) { const unsigned tv = (unsigned)__shfl_up((int)scan, o, 16); if (j16 >= o) scan += tv; }
    unsigned e0 = scan - tot;
    u32x4 pa, pb;
    pa[0] = e0; e0 += ca[0]; pa[1] = e0; e0 += ca[1]; pa[2] = e0; e0 += ca[2]; pa[3] = e0; e0 += ca[3];
    pb[0] = e0; e0 += cb[0]; pb[1] = e0; e0 += cb[1]; pb[2] = e0; e0 += cb[2]; pb[3] = e0;
    LDS_WAIT();
    *(u32x4*)(hist + 8 * j16) = pa; *(u32x4*)(hist + 8 * j16 + 4) = pb;
    LDS_WAIT();
#pragma unroll
    for (int i = 0; i < 8; ++i) {
      const unsigned pos = __hip_atomic_fetch_add(&hist[ids[i] >> 7], 1u, __ATOMIC_RELAXED, __HIP_MEMORY_SCOPE_WAVEFRONT);
      list[pos] = (u32x4){(unsigned)ids[i], __float_as_uint(su[i]), __float_as_uint(gts[i]), 0u};
    }
    LDS_WAIT();
  }
  const unsigned char* Ub = w_Ub(p) + 16 * j16;
  const unsigned char* Vb = w_Vb(p) + 16 * j16;
  {
    u32x4 uA[4], uB[4];
    u32x4 eA = list[0], eB = list[1];
#pragma unroll
    for (int i = 0; i < 4; ++i) uA[i] = *(const u32x4*)(Ub + (size_t)eA[0] * DM + 256 * i);
#pragma unroll
    for (int i = 0; i < 4; ++i) uB[i] = *(const u32x4*)(Ub + (size_t)eB[0] * DM + 256 * i);
#define PEER_USTEP(U, E, K)                                                                                            \
    {                                                                                                                  \
      const float su = __uint_as_float(E[1]), gsv = __uint_as_float(E[2]);                                             \
      int d0 = 0, d1 = 0;                                                                                              \
      d0 = dot16i(U[0], x[0], d0); d1 = dot16i(U[1], x[1], d1); d0 = dot16i(U[2], x[2], d0); d1 = dot16i(U[3], x[3], d1); \
      E = list[(K) + 2 < 128 ? (K) + 2 : 127];                       \
      _Pragma("unroll") for (int i = 0; i < 4; ++i) U[i] = *(const u32x4*)(Ub + (size_t)E[0] * DM + 256 * i);          \
      const float c = gsv * gelu_fast(su * (float)dpp_add16i(d0 + d1));                                                \
      if (j16 == 0) ((float*)&list[K])[3] = c;                                                                          \
    }
#pragma unroll 1
    for (int k = 0; k < 128; k += 2) {
      PEER_USTEP(uA, eA, k)
      PEER_USTEP(uB, eB, k + 1)
    }
  }
  LDS_WAIT();
  f32x2 acc[32];
#pragma unroll
  for (int i = 0; i < 32; ++i) acc[i] = (f32x2){0.f, 0.f};
  {
    u32x4 vA[4], vB[4];
    u32x4 eA = list[0], eB = list[1];
#pragma unroll
    for (int i = 0; i < 4; ++i) vA[i] = *(const u32x4*)(Vb + (size_t)eA[0] * DM + 256 * i);
#pragma unroll
    for (int i = 0; i < 4; ++i) vB[i] = *(const u32x4*)(Vb + (size_t)eB[0] * DM + 256 * i);
#define PEER_VSTEP(V, E, K)                                                                                            \
    {                                                                                                                  \
      const float c = __uint_as_float(E[3]);                                                                           \
      const f32x2 c2 = {c, c};                                                                                         \
      _Pragma("unroll") for (int i = 0; i < 4; ++i) axpy16p(acc + 8 * i, V[i], c2);                                    \
      E = list[(K) + 2 < 128 ? (K) + 2 : 127];                                                                         \
      _Pragma("unroll") for (int i = 0; i < 4; ++i) V[i] = *(const u32x4*)(Vb + (size_t)E[0] * DM + 256 * i);          \
    }
#pragma unroll 1
    for (int k = 0; k < 128; k += 2) {
      PEER_VSTEP(vA, eA, k)
      PEER_VSTEP(vB, eB, k + 1)
    }
  }
  const float* x1 = w_X1(p) + (size_t)token * DM + 16 * j16;
  const float* g2 = w_MOD(p) + (size_t)cond_row(token) * 6144 + 5120 + 16 * j16;
  float* y = p.out + O_YP + (size_t)token * DM + 16 * j16;
#pragma unroll
  for (int i = 0; i < 4; ++i)
#pragma unroll
    for (int mm = 0; mm < 4; ++mm) {
      const int c0 = 256 * i + 4 * mm;
      const f32x4 xv = *(const f32x4*)(x1 + c0), gv = *(const f32x4*)(g2 + c0);
      f32x4 yv;
#pragma unroll
      for (int j = 0; j < 4; ++j) yv[j] = xv[j] + gv[j] * acc[8 * i + 2 * mm + (j >> 1)][j & 1];
      *(f32x4*)(y + c0) = yv;
    }
}
DI void peer_token_block(const P& p, int token, char* smem) {
  const int t = threadIdx.x + opaque0(), lane = t & 63, w = t >> 6;
  float* red = (float*)smem;
  const u32x4 x8 = *(const u32x4*)(w_H8(p) + (size_t)token * DM + 16 * lane);
  const int myid = w_IDX(p)[(size_t)token * 128 + 32 * w + (lane & 31)];
  const float mysu = w_SU(p)[myid] * w_HS(p)[token];
  const float mygs = w_GATE(p)[(size_t)token * 128 + 32 * w + (lane & 31)] * w_SV(p)[myid];
  float o[16];
#pragma unroll
  for (int i = 0; i < 16; ++i) o[i] = 0.f;
#pragma unroll 1
  for (int e0 = 0; e0 < 32; e0 += 8) {
    u32x4 u8[8], v8[8];
#pragma unroll
    for (int qq = 0; qq < 8; ++qq) {
      const size_t ro = (size_t)__builtin_amdgcn_readlane(myid, e0 + qq) * DM + 16 * lane;
      u8[qq] = *(const u32x4*)(w_Ub(p) + ro); v8[qq] = *(const u32x4*)(w_Vb(p) + ro);
    }
#pragma unroll
    for (int hb = 0; hb < 2; ++hb) {
      float d[4];
#pragma unroll
      for (int qq = 0; qq < 4; ++qq) d[qq] = (float)dot16i(u8[4 * hb + qq], x8, 0);
      const float kv = reduce4(d, lane);
#pragma unroll
      for (int qq = 0; qq < 4; ++qq) {
        const int e = e0 + 4 * hb + qq;
        const float a = __int_as_float(__builtin_amdgcn_readlane(__float_as_int(kv), 16 * qq)) * __int_as_float(__builtin_amdgcn_readlane(__float_as_int(mysu), e));
        const float c = __int_as_float(__builtin_amdgcn_readlane(__float_as_int(mygs), e)) * gelu_fast(a);
        axpy16(o, v8[4 * hb + qq], c);
      }
    }
  }
  __syncthreads();
#pragma unroll
  for (int i = 0; i < 16; ++i) red[w * 1024 + 16 * lane + i] = o[i];
  __syncthreads();
  if (w == 0) {
    const float* x1 = w_X1(p) + (size_t)token * DM + 16 * lane;
    const float* g2 = w_MOD(p) + (size_t)cond_row(token) * 6144 + 5120 + 16 * lane;
    float* y = p.out + O_YP + (size_t)token * DM + 16 * lane;
#pragma unroll
    for (int mm = 0; mm < 4; ++mm) {
      const f32x4 xv = *(const f32x4*)(x1 + 4 * mm), gv = *(const f32x4*)(g2 + 4 * mm);
      f32x4 yv;
#pragma unroll
      for (int j = 0; j < 4; ++j) { const int c = 16 * lane + 4 * mm + j; yv[j] = xv[j] + gv[j] * (red[c] + red[1024 + c] + red[2048 + c] + red[3072 + c]); }
      *(f32x4*)(y + 4 * mm) = yv;
    }
  }
}

constexpr int NPHASE = 8;

#if defined(PROBE_ATTN) || defined(PROBE_SAMP)
DI int probe_token(int i) { return (i * 131 + 3) % NPR; }
DI float block_sum_p(float v, float* red) {
  __syncthreads();
  v = wave_sum(v);
  if ((threadIdx.x & 63) == 0) red[threadIdx.x >> 6] = v;
  __syncthreads();
  return red[0] + red[1] + red[2] + red[3];
}
DI float block_max_p(float v, float* red) {
  __syncthreads();
  for (int o = 32; o >= 1; o >>= 1) v = fmaxf(v, __shfl_xor(v, o));
  if ((threadIdx.x & 63) == 0) red[threadIdx.x >> 6] = v;
  __syncthreads();
  return fmaxf(fmaxf(red[0], red[1]), fmaxf(red[2], red[3]));
}
#endif
#ifdef PROBE_ATTN
DI void probe_attn(const P& p, int i, char* smem) {
  float* red = (float*)smem;
  float* pr = red + 4;
  float* attn = pr + 128;
  float* rr = attn + 1024;
  const int token = probe_token(i), b = token >> 11, pos = token & 2047, t = threadIdx.x;
  const bf16* prow = w_PROJ(p) + (size_t)token * INW;
  for (int head = 0; head < 16; ++head) {
    const int hk = head >> 3;
    float s = -INFINITY;
    const int kp = pos - 127 + (t & 127);
    if (t < 128 && kp >= 0) {
      float a = 0.f;
      const bf16* kr = w_PROJ(p) + ((size_t)b * SEQ + kp) * INW + C_K + hk * 64;
      for (int d = 0; d < 64; ++d) a += bf2f(prow[head * 64 + d]) * bf2f(kr[d]);
      s = a + w_BIAS(p)[head * 128 + (pos - kp)];
    }
    float m = block_max_p(s, red);
    m = fmaxf(m, p.sinks[head]);
    const float e = (t < 128 && kp >= 0) ? __expf(s - m) : 0.f;
    const float den = block_sum_p(e, red) + __expf(p.sinks[head] - m);
    if (t < 128) pr[t] = e / den;
    __syncthreads();
    if (t < 64) {
      float o = 0.f;
      for (int j = 0; j < 128; ++j) { const int kq = pos - 127 + j; if (kq >= 0) o += pr[j] * bf2f(w_VT(p)[((size_t)(b * 2 + hk) * 64 + t) * SEQ + kq]); }
      attn[head * 64 + t] = o;
    }
    __syncthreads();
  }
  for (int c = t; c < 512; c += 256) {
    const int g = c >> 7, win = 2 << g;
    float tot = 0.f;
    for (int j = 0; j < win; ++j) if (pos - j >= 0) tot += bf2f(w_PROJ(p)[((size_t)b * SEQ + pos - j) * INW + C_PIN + c]);
    const float cnt = (float)(win < pos + 1 ? win : pos + 1);
    rr[c] = bf2f((bf16)(tot / cnt - bf2f(prow[C_PIN + c])));
  }
  __syncthreads();
  for (int f = t; f < 1024; f += 256) {
    const int g = f >> 8;
    float pl = 0.f;
    for (int ch = 0; ch < 128; ++ch) pl += rr[g * 128 + ch] * bf2f(w_PWt(p)[((size_t)g * 256 + (f & 255)) * 128 + ch]);
    const float naive = bf2f(prow[C_GA + f]) * attn[f] + bf2f(prow[C_GB + f]) * (pl * p.pool_scale[f]);
    const float fast = bf2f(w_MIXED(p)[(size_t)token * DM + f]);
    p.out[O_KWP + (size_t)i * DM + f] += (float)(PROBE_ATTN) * (fast - naive);
  }
  __syncthreads();
}
#endif

#ifdef PROBE_SAMP
DI void probe_samp(const P& p, int b, char* smem) {
  float* red = (float*)smem;
  float* pr = red + 4;
  float* attn = pr + 128;
  float* rr = attn + 1024;
  const int t = threadIdx.x;
  const size_t token = (size_t)NPR + b;
  const bf16* prow = w_PROJ(p) + token * INW;
  for (int head = 0; head < 16; ++head) {
    const int hk = head >> 3;
    float s = -INFINITY;
    if (t < 128) {
      const float* kr = t < 127 ? p.cache_k + (((size_t)b * 128 + t + 1) * 2 + hk) * 64 : p.out + O_KWS + (((size_t)b * 128 + 127) * 2 + hk) * 64;
      float a = 0.f;
      for (int d = 0; d < 64; ++d) a += bf2f(prow[head * 64 + d]) * kr[d];
      s = a + p.rel_table[(127 - t < 16 ? 127 - t : min(31, 16 + (int)(logf((float)(127 - t) / 16.f) / logf(8.f) * 16.f))) * 16 + head];
    }
    float m = block_max_p(s, red);
    m = fmaxf(m, p.sinks[head]);
    const float e = t < 128 ? __expf(s - m) : 0.f;
    const float den = block_sum_p(e, red) + __expf(p.sinks[head] - m);
    if (t < 128) pr[t] = e / den;
    __syncthreads();
    if (t < 64) {
      float o = 0.f;
      for (int j = 0; j < 128; ++j) { const float* vr = j < 127 ? p.cache_v + (((size_t)b * 128 + j + 1) * 2 + hk) * 64 : p.out + O_VWS + (((size_t)b * 128 + 127) * 2 + hk) * 64; o += pr[j] * vr[t]; }
      attn[head * 64 + t] = o;
    }
    __syncthreads();
  }
  for (int c = t; c < 512; c += 256) {
    const int g = c >> 7, win = 2 << g;
    const float cur = p.out[O_PS + ((size_t)b * 15 + 14) * 512 + c];
    float tot = cur;
    for (int j = 1; j < win; ++j) tot += p.state_pool[((size_t)b * 15 + 15 - j) * 512 + c];
    rr[c] = tot / (float)win - cur;
  }
  __syncthreads();
  for (int f = t; f < 1024; f += 256) {
    const int g = f >> 8;
    float pl = 0.f;
    for (int ch = 0; ch < 128; ++ch) pl += rr[g * 128 + ch] * p.pool_w[((size_t)g * 128 + ch) * 256 + (f & 255)];
    const float naive = bf2f(prow[C_GA + f]) * attn[f] + bf2f(prow[C_GB + f]) * (pl * p.pool_scale[f]);
    const float fast = bf2f(w_MIXED(p)[token * DM + f]);
    p.out[O_KWP + (size_t)b * DM + f] += (float)(PROBE_SAMP) * (fast - naive);
  }
  __syncthreads();
}
#endif
template <class First, class Main, class Fill> DI void run_with_filler(int G, int bid, int nmain, int nfill, First firstf, Main mainf, Fill fillf) {
  if (bid < nmain) { __syncthreads(); firstf(bid); }
  for (int u = bid; u < nmain; u += G) mainf(u, u + G < nmain ? u + G : -1);
  const int rem = nmain % G;
  if (rem == 0) { for (int f = bid; f < nfill; f += G) fillf(f); }
  else if (bid >= rem) { for (int f = bid - rem; f < nfill; f += G - rem) fillf(f); }
}
template <int PH> DI void run_phase(const P& p, char* smem) {
  const int G = gridDim.x, bid = blockIdx.x, w = __builtin_amdgcn_readfirstlane(threadIdx.x >> 6);
  if constexpr (PH == 0) { run_with_filler(G, bid, U0_MOD, F0_TOTAL, [&](int) {}, [&](int u, int) { unit_mod(p, u, smem); }, [&](int f) { phase0_filler(p, f, smem); }); }
  if constexpr (PH == 1) { for (int tk = bid * 4 + w; tk < NTOK; tk += G * 4) norm_row(p, tk, 0); }
  if constexpr (PH == 2) {
    run_with_filler(G, bid, 129 * 30, F2_TOTAL, [&](int u) { gemm_first(w_Wt_in(p), w_H(p), 1024, (u % 30) * 128, (u / 30) * 128, smem); },
                    [&](int u, int un) { unit_gemm1(p, u, un, smem); }, [&](int f) { phase2_filler(p, f, smem); });
  }
  if constexpr (PH == 3) { for (int u = bid; u < 1024; u += G) unit_attn_prompt(p, u, smem);
                           for (int u = bid; u < 512; u += G) unit_attn_sample(p, u, smem); }
  if constexpr (PH == 4) {
    run_with_filler(G, bid, 129 * 8, F4_TOTAL, [&](int u) { int mt, nt; unit8_map(u, mt, nt); gemm_first(w_Wt_out(p), w_MIXED(p), 1024, nt * 128, mt * 128, smem); },
                    [&](int u, int un) { unit_gemm2(p, u, un, smem); }, [&](int f) { if (f < F4_QU) unit_quant_rows<true>(p.peer_u, w_Ub(p), w_SU(p), f); else unit_convert(p.sub_keys, w_SK(p), f - F4_QU); });
  }
  if constexpr (PH == 5) { for (int tk = bid * 4 + w; tk < NTOK; tk += G * 4) norm_row(p, tk, 1); }
  if constexpr (PH == 6) {
    run_with_filler(G, bid, 129 * 8, F6_QV, [&](int u) { int mt, hd; unit8_map(u, mt, hd); gemm_first(w_Wt_q(p), w_H(p), 1024, hd * 256, mt * 128, smem); },
                    [&](int u, int un) { unit_peer_route(p, u, un, smem); }, [&](int f) { unit_quant_rows<false>(p.peer_v, w_Vb(p), w_SV(p), f); });
  }
  if constexpr (PH == 7) {
    for (int g = bid * 4 + w; g < NPR / 4; g += G * 4) peer_wave4(p, g, smem + w * PEER_WLDS);
    for (int s = bid; s < NS; s += G) peer_token_block(p, NPR + s, smem + 4 * PEER_WLDS);
  }
}
#if ONE_LAUNCH
__global__ void __launch_bounds__(NTHREADS, 2) mega(P p) {
  __shared__ __attribute__((aligned(16))) char smem[SMEM_BYTES + 16];
  volatile unsigned* st = (volatile unsigned*)(smem + SMEM_BYTES);
  if (threadIdx.x == 0) { st[0] = 0u; st[1] = 0u; }
  __syncthreads();
  const unsigned xcc = xb_xcc_id();
  if (threadIdx.x == 0) (void)xb_add(&w_bar(p)[XB_XCNT(xcc)], 1u);
#ifndef REPEAT_MASK
#define REPEAT_MASK 0
#endif
#define RUN_PH(k) do { run_phase<k>(p, smem); if ((REPEAT_MASK >> k) & 1) { xcd_barrier(w_bar(p), xcc, st); run_phase<k>(p, smem); } } while (0)
  RUN_PH(0); xcd_barrier(w_bar(p), xcc, st);
  RUN_PH(1); xcd_barrier(w_bar(p), xcc, st);
  RUN_PH(2); xcd_barrier(w_bar(p), xcc, st);
  RUN_PH(3); xcd_barrier(w_bar(p), xcc, st);
#ifdef PROBE_ATTN
  for (int i = blockIdx.x; i < 128; i += gridDim.x) probe_attn(p, i, smem);
  xcd_barrier(w_bar(p), xcc, st);
#endif
#ifdef PROBE_SAMP
  for (int i = blockIdx.x; i < 128; i += gridDim.x) probe_samp(p, i, smem);
  xcd_barrier(w_bar(p), xcc, st);
#endif
  RUN_PH(4); xcd_barrier(w_bar(p), xcc, st);
  RUN_PH(5); xcd_barrier(w_bar(p), xcc, st);
  RUN_PH(6); xcd_barrier(w_bar(p), xcc, st);
  RUN_PH(7);
}
#else
template <int PH> __global__ void __launch_bounds__(NTHREADS, 2) mega(P p) {
  __shared__ __attribute__((aligned(16))) char smem[SMEM_BYTES];
  run_phase<PH>(p, smem);
}
#endif


extern "C" void kernel_launch(void* const* d_in, const int* in_sizes, int n_in, void* d_out, int out_size, void* d_ws, size_t ws_size, hipStream_t stream) {
  P p{};
  const float* const* in = (const float* const*)d_in;
  p.x_prompt = in[0]; p.x_sample = in[1]; p.cache_k = in[2]; p.cache_v = in[3]; p.state_pool = in[4]; p.c_prompt = in[5]; p.c_sample = in[6];
  p.rel_table = in[7]; p.ada_w = in[8]; p.ada_b = in[9]; p.norm1_g = in[10]; p.w_in = in[11]; p.q_norm_g = in[12]; p.k_norm_g = in[13]; p.sinks = in[14];
  p.pool_w = in[15]; p.pool_scale = in[16]; p.w_out = in[17]; p.norm2_g = in[18]; p.w_query = in[19]; p.sub_keys = in[20]; p.peer_u = in[21]; p.peer_v = in[22];
  p.out = (float*)d_out;
  p.ws = (char*)d_ws;
  if (WS_NEED > ws_size) { fprintf(stderr, "workspace too small: need %zu have %zu\n", (size_t)WS_NEED, ws_size); return; }

  static int grid_blocks = 0;
  if (!grid_blocks) {
    int dev = 0, cus = 0, per_cu = 0;
    (void)hipGetDevice(&dev);
    (void)hipDeviceGetAttribute(&cus, hipDeviceAttributeMultiprocessorCount, dev);
#if ONE_LAUNCH
    (void)hipOccupancyMaxActiveBlocksPerMultiprocessor(&per_cu, mega, NTHREADS, 0);
#else
    per_cu = 2;
#endif
    if (per_cu > 2) per_cu = 2;
    if (per_cu < 1) per_cu = 1;
    if (cus < 1) cus = 256;
    grid_blocks = cus * per_cu;
  }
#if ONE_LAUNCH
  (void)hipMemsetAsync(p.ws + OFF_BAR, 0, XCD_BAR_WORDS * 4, stream);
  hipLaunchKernelGGL(mega, dim3(grid_blocks), dim3(NTHREADS), 0, stream, p);
#else
  hipLaunchKernelGGL(mega<0>, dim3(grid_blocks), dim3(NTHREADS), 0, stream, p);
  hipLaunchKernelGGL(mega<1>, dim3(grid_blocks), dim3(NTHREADS), 0, stream, p);
  hipLaunchKernelGGL(mega<2>, dim3(grid_blocks), dim3(NTHREADS), 0, stream, p);
  hipLaunchKernelGGL(mega<3>, dim3(grid_blocks), dim3(NTHREADS), 0, stream, p);
  hipLaunchKernelGGL(mega<4>, dim3(grid_blocks), dim3(NTHREADS), 0, stream, p);
  hipLaunchKernelGGL(mega<5>, dim3(grid_blocks), dim3(NTHREADS), 0, stream, p);
  hipLaunchKernelGGL(mega<6>, dim3(grid_blocks), dim3(NTHREADS), 0, stream, p);
  hipLaunchKernelGGL(mega<7>, dim3(grid_blocks), dim3(NTHREADS), 0, stream, p);
#endif

}
```

```cpp
#include <hip/hip_runtime.h>
#include <stdint.h>
#include <stdio.h>

#ifndef ONE_LAUNCH
#define ONE_LAUNCH 1
#endif

typedef __bf16 bf16;
typedef __bf16 bf16x2 __attribute__((ext_vector_type(2)));
typedef __bf16 bf16x4 __attribute__((ext_vector_type(4)));
typedef __bf16 bf16x8 __attribute__((ext_vector_type(8)));
typedef float f32x2 __attribute__((ext_vector_type(2)));
typedef float f32x4 __attribute__((ext_vector_type(4)));
typedef float f32x16 __attribute__((ext_vector_type(16)));
typedef unsigned u32x2 __attribute__((ext_vector_type(2)));
typedef unsigned u32x4 __attribute__((ext_vector_type(4)));

#define DI __device__ __forceinline__
#define MFMA(a, b, c) __builtin_amdgcn_mfma_f32_32x32x16_bf16((a), (b), (c), 0, 0, 0)

constexpr int DM = 1024, NB = 8, SEQ = 2048, NS = 128, NPR = NB * SEQ, NTOK = NPR + NS;
constexpr int INW = 3840, NMOD = NB + NS;
constexpr int C_K = 1024, C_V = 1152, C_PIN = 1280, C_GA = 1792, C_GB = 2816;
constexpr int NEXP = 16384;
constexpr float EPS = 1e-6f;
constexpr size_t O_YP = 0, O_KWP = 16908288, O_VWP = 17039360, O_PP = 17170432, O_KWS = 17231872, O_VWS = 19329024, O_PS = 21426176;

constexpr int SMEM_BYTES = 77824;
constexpr int NTHREADS = 256;

struct P {
  const float *x_prompt, *x_sample, *cache_k, *cache_v, *state_pool, *c_prompt, *c_sample, *rel_table, *ada_w, *ada_b, *norm1_g, *w_in,
      *q_norm_g, *k_norm_g, *sinks, *pool_w, *pool_scale, *w_out, *norm2_g, *w_query, *sub_keys, *peer_u, *peer_v;
  float* out;
  char* ws;
};
constexpr size_t al256(size_t x) { return (x + 255) & ~(size_t)255; }
constexpr size_t OFF_BAR = 0;
constexpr size_t OFF_WTIN = OFF_BAR + al256(4096 * 4);
constexpr size_t OFF_WTOUT = OFF_WTIN + al256((size_t)INW * 1024 * 2);
constexpr size_t OFF_WTQ = OFF_WTOUT + al256((size_t)1024 * 1024 * 2);
constexpr size_t OFF_SK = OFF_WTQ + al256((size_t)2048 * 1024 * 2);
constexpr size_t OFF_PWT = OFF_SK + al256((size_t)16 * 128 * 128 * 2);
constexpr size_t OFF_UB = OFF_PWT + al256((size_t)4 * 256 * 128 * 2);
constexpr size_t OFF_VB = OFF_UB + al256((size_t)NEXP * DM);
constexpr size_t OFF_SU = OFF_VB + al256((size_t)NEXP * DM);
constexpr size_t OFF_SV = OFF_SU + al256((size_t)NEXP * 4);
constexpr size_t OFF_H8 = OFF_SV + al256((size_t)NEXP * 4);
constexpr size_t OFF_HS = OFF_H8 + al256((size_t)NTOK * DM);
constexpr size_t OFF_PART = OFF_HS + al256((size_t)NTOK * 4);
constexpr size_t OFF_MOD = OFF_PART + al256((size_t)4 * NS * DM * 4);
constexpr size_t OFF_BIAS = OFF_MOD + al256((size_t)NMOD * 6144 * 4);
constexpr size_t OFF_VT = OFF_BIAS + al256(16 * 128 * 4);
constexpr size_t OFF_H = OFF_VT + al256((size_t)NB * 128 * SEQ * 2);
constexpr size_t OFF_MIXED = OFF_H;
constexpr size_t OFF_PROJ = OFF_H + al256((size_t)NTOK * DM * 2);
constexpr size_t OFF_X1 = OFF_PROJ;
constexpr size_t OFF_IDX = OFF_X1 + (size_t)NTOK * DM * 4;
constexpr size_t OFF_GATE = OFF_IDX + (size_t)NTOK * 128 * 4;
constexpr size_t WS_NEED = OFF_PROJ + al256((size_t)NTOK * INW * 2);
static_assert(OFF_GATE + (size_t)NTOK * 128 * 4 <= WS_NEED, "overlay fits");
static_assert(WS_NEED <= (size_t)256 * 1024 * 1024, "workspace budget");
#define WS_PTR(T, name, OFF) __device__ __forceinline__ T* name(const P& p) { return (T*)(p.ws + (OFF)); }
WS_PTR(unsigned, w_bar, OFF_BAR) WS_PTR(bf16, w_Wt_in, OFF_WTIN) WS_PTR(bf16, w_Wt_out, OFF_WTOUT) WS_PTR(bf16, w_Wt_q, OFF_WTQ) WS_PTR(bf16, w_SK, OFF_SK)
WS_PTR(bf16, w_PWt, OFF_PWT) WS_PTR(unsigned char, w_Ub, OFF_UB) WS_PTR(unsigned char, w_Vb, OFF_VB) WS_PTR(float, w_SU, OFF_SU) WS_PTR(float, w_SV, OFF_SV) WS_PTR(unsigned char, w_H8, OFF_H8) WS_PTR(float, w_HS, OFF_HS) WS_PTR(float, w_PART, OFF_PART) WS_PTR(float, w_MOD, OFF_MOD) WS_PTR(float, w_BIAS, OFF_BIAS)
WS_PTR(bf16, w_VT, OFF_VT) WS_PTR(bf16, w_H, OFF_H) WS_PTR(bf16, w_MIXED, OFF_MIXED) WS_PTR(bf16, w_PROJ, OFF_PROJ) WS_PTR(float, w_X1, OFF_X1)
WS_PTR(int, w_IDX, OFF_IDX) WS_PTR(float, w_GATE, OFF_GATE)

DI int cond_row(int token) { return token < NPR ? (token >> 11) : (NB + token - NPR); }
DI int crow(int reg, int h) { return (reg & 3) + 8 * (reg >> 2) + 4 * h; }
DI const float* xrow(const P& p, int token) { return token < NPR ? p.x_prompt + (size_t)token * DM : p.x_sample + (size_t)(token - NPR) * DM; }

#define LDS_WAIT() asm volatile("s_waitcnt lgkmcnt(0)" ::: "memory")
DI int opaque0() { int z = 0; asm volatile("" : "+v"(z)); return z; }
DI float bf2f(bf16 v) { return (float)v; }
DI f32x16 zero16() { f32x16 z; for (int i = 0; i < 16; ++i) z[i] = 0.f; return z; }
DI bf16x8 pack_step(const f32x16& x, int s) { bf16x8 v; for (int j = 0; j < 8; ++j) v[j] = (bf16)x[8 * s + j]; return v; }
DI bf16x8 cat4(bf16x4 lo, bf16x4 hi) { return __builtin_shufflevector(lo, hi, 0, 1, 2, 3, 4, 5, 6, 7); }
DI float wave_sum(float v) { for (int o = 32; o >= 1; o >>= 1) v += __shfl_xor(v, o); return v; }

#define XB_TMO 128
#define XB_XCNT(j) (256 + 64 * (j))
#define XB_XSUB(j) (1280 + 64 * (j))
#define XB_XGEN(j) (2304 + 64 * (j))
#define XB_TOP 3328
#define XB_TOPGEN 3392
#define XCD_BAR_WORDS 3456
#define XB_SPIN_CAP (1u << 22)
DI unsigned xb_ld(unsigned* p) { return __hip_atomic_load(p, __ATOMIC_RELAXED, __HIP_MEMORY_SCOPE_AGENT); }
DI unsigned xb_add(unsigned* p, unsigned v) { return __hip_atomic_fetch_add(p, v, __ATOMIC_RELAXED, __HIP_MEMORY_SCOPE_AGENT); }
DI unsigned xb_xcc_id() { return (unsigned)__builtin_amdgcn_s_getreg((3 << 11) | 20) & 0xFu; }
#define XB_SPIN(cond, bar) do { unsigned _sp = 0; while (cond) { __builtin_amdgcn_s_sleep(1); \
    if ((++_sp & 255u) == 0u) { if (xb_ld(&(bar)[XB_TMO])) break; if (_sp > XB_SPIN_CAP) { atomicAdd(&(bar)[XB_TMO], 1u); break; } } } } while (0)

DI void xcd_barrier_complete(unsigned* bar, unsigned x, unsigned& nloc, unsigned& nx) {
  const unsigned G = gridDim.x;
  unsigned sum, cnt, mine, sp = 0u;
  for (;;) {
    sum = 0u; cnt = 0u; mine = 0u;
#pragma unroll
    for (unsigned j = 0; j < 16; ++j) { const unsigned c = xb_ld(&bar[XB_XCNT(j)]); sum += c; cnt += (c > 0u) ? 1u : 0u; mine = (j == x) ? c : mine; }
    if (sum == G) break;
    __builtin_amdgcn_s_sleep(1);
    if ((++sp & 255u) == 0u) { if (xb_ld(&bar[XB_TMO])) break; if (sp > XB_SPIN_CAP) { atomicAdd(&bar[XB_TMO], 1u); break; } }
  }
  nloc = mine > 0u ? mine : 1u; nx = cnt > 0u ? cnt : 1u;
}
DI void xcd_barrier(unsigned* bar, unsigned x, volatile unsigned* st) {
  asm volatile("s_waitcnt vmcnt(0)" ::: "memory");
  __syncthreads();
  if (threadIdx.x == 0) {
    __builtin_amdgcn_s_waitcnt(0);
    unsigned nloc = st[0], nx = st[1];
    if (nloc == 0u) { xcd_barrier_complete(bar, x, nloc, nx); st[0] = nloc; st[1] = nx; }
    const unsigned old = xb_add(&bar[XB_XSUB(x)], 1u);
    const unsigned gen = old / nloc;
    if (old + 1u == (gen + 1u) * nloc) {
      __builtin_amdgcn_fence(__ATOMIC_RELEASE, "agent");
      asm volatile("s_waitcnt vmcnt(0)" ::: "memory");
      const unsigned og = xb_add(&bar[XB_TOP], 1u);
      const unsigned tg = og / nx;
      if (og + 1u == (tg + 1u) * nx) xb_add(&bar[XB_TOPGEN], 1u);
      else XB_SPIN(xb_ld(&bar[XB_TOPGEN]) == tg, bar);
      xb_add(&bar[XB_XGEN(x)], 1u);
      __builtin_amdgcn_fence(__ATOMIC_ACQUIRE, "agent");
      asm volatile("s_waitcnt vmcnt(0)" ::: "memory");
    } else {
      XB_SPIN(xb_ld(&bar[XB_XGEN(x)]) == gen, bar);
      __builtin_amdgcn_fence(__ATOMIC_ACQUIRE, "agent");
      asm volatile("s_waitcnt vmcnt(0)" ::: "memory");
    }
  }
  __syncthreads();
}

constexpr int U0_MOD = 192;
constexpr int U0_TIN = (1024 / 64) * (INW / 64);
constexpr int F0_TOTAL = U0_TIN + 1;
constexpr int U0_TPW = 4 * 2 * 4;
constexpr int U0_CSK = 32;
constexpr int U0_KW = 128, U0_VW = 128, U0_PW = 128;
constexpr int F2_TOUT = 16 * 16, F2_TQ = 16 * 32, F2_E1 = F2_TOUT + F2_TQ, F2_E2 = F2_E1 + U0_TPW, F2_E3 = F2_E2 + U0_KW, F2_E4 = F2_E3 + U0_VW,
              F2_TOTAL = F2_E4 + U0_PW;
constexpr int F4_TOTAL = U0_CSK;
constexpr int F6_QU = 2048, F6_QV = 2048, F6_TOTAL = F6_QU + F6_QV;

DI float silu_f(float x) { return x * __builtin_amdgcn_rcpf(1.f + __expf(-x)); }

DI void unit_mod(const P& p, int u, char* smem) {
  const int t = threadIdx.x + opaque0(), lane = t & 63, w = t >> 6, r = lane & 31, h = lane >> 5;
  const int f0 = u * 32;
  f32x16 acc[5];
#pragma unroll
  for (int i = 0; i < 5; ++i) acc[i] = zero16();
  const float* wp = p.ada_w + (size_t)(w * 256 + 8 * h) * 6144 + f0 + r;
  const float* cp[5];
#pragma unroll
  for (int i = 0; i < 5; ++i) { const int m = 32 * i + r, mm = m < NMOD ? m : 0; cp[i] = (mm < NB ? p.c_prompt + (size_t)mm * DM : p.c_sample + (size_t)(mm - NB) * DM) + w * 256 + 8 * h; }
  float wv[8]; f32x4 cv[5][2];
#pragma unroll
  for (int j = 0; j < 8; ++j) wv[j] = wp[(size_t)j * 6144];
#pragma unroll
  for (int i = 0; i < 5; ++i) { cv[i][0] = *(const f32x4*)cp[i]; cv[i][1] = *(const f32x4*)(cp[i] + 4); }
#pragma unroll 1
  for (int ks = 0; ks < 16; ++ks) {
    bf16x8 bfr, afr[5];
#pragma unroll
    for (int j = 0; j < 8; ++j) bfr[j] = (bf16)wv[j];
#pragma unroll
    for (int i = 0; i < 5; ++i) {
      const bool ok = 32 * i + r < NMOD;
#pragma unroll
      for (int j = 0; j < 8; ++j) afr[i][j] = (bf16)(ok ? silu_f(cv[i][j >> 2][j & 3]) : 0.f);
    }
    const int kn = ks + 1 < 16 ? ks + 1 : 15;
#pragma unroll
    for (int j = 0; j < 8; ++j) wv[j] = wp[(size_t)(kn * 16 + j) * 6144];
#pragma unroll
    for (int i = 0; i < 5; ++i) { cv[i][0] = *(const f32x4*)(cp[i] + kn * 16); cv[i][1] = *(const f32x4*)(cp[i] + kn * 16 + 4); }
#pragma unroll
    for (int i = 0; i < 5; ++i) acc[i] = MFMA(afr[i], bfr, acc[i]);
  }
  float* red = (float*)smem;
  __syncthreads();
  if (w > 0) {
#pragma unroll
    for (int i = 0; i < 5; ++i)
#pragma unroll
      for (int j = 0; j < 16; ++j) red[((w - 1) * 80 + i * 16 + j) * 64 + lane] = acc[i][j];
  }
  __syncthreads();
  if (w == 0) {
    const float bias = p.ada_b[f0 + r];
#pragma unroll
    for (int i = 0; i < 5; ++i)
#pragma unroll
      for (int j = 0; j < 16; ++j) {
        const int m = 32 * i + crow(j, h);
        const float v = acc[i][j] + red[(0 * 80 + i * 16 + j) * 64 + lane] + red[(1 * 80 + i * 16 + j) * 64 + lane] + red[(2 * 80 + i * 16 + j) * 64 + lane] + bias;
        if (m < NMOD) w_MOD(p)[(size_t)m * 6144 + f0 + r] = v;
      }
  }
}

DI void unit_transpose(const float* __restrict__ src, bf16* __restrict__ dst, int R, int C, int tr, int tc, char* smem) {
  float* tile = (float*)smem;
  const int t = threadIdx.x + opaque0();
  __syncthreads();
#pragma unroll
  for (int i = 0; i < 4; ++i) {
    const int rr = (t >> 4) + 16 * i, cc = (t & 15) * 4;
    const f32x4 v = *(const f32x4*)(src + (size_t)(tr * 64 + rr) * C + tc * 64 + cc);
    tile[rr * 65 + cc] = v[0]; tile[rr * 65 + cc + 1] = v[1]; tile[rr * 65 + cc + 2] = v[2]; tile[rr * 65 + cc + 3] = v[3];
  }
  __syncthreads();
#pragma unroll
  for (int i = 0; i < 2; ++i) {
    const int orow = (t >> 3) + 32 * i, seg = (t & 7) * 8;
    bf16x8 v;
#pragma unroll
    for (int j = 0; j < 8; ++j) v[j] = (bf16)tile[(seg + j) * 65 + orow];
    *(bf16x8*)(dst + (size_t)(tc * 64 + orow) * R + tr * 64 + seg) = v;
  }
}
DI void unit_convert(const float* __restrict__ src, bf16* __restrict__ dst, int u) {
  const size_t base = (size_t)u * 8192 + (threadIdx.x + opaque0()) * 8;
#pragma unroll
  for (int i = 0; i < 4; ++i) {
    const size_t o = base + (size_t)i * 2048;
    const f32x4 a = *(const f32x4*)(src + o), b = *(const f32x4*)(src + o + 4);
    bf16x8 v; v[0] = (bf16)a[0]; v[1] = (bf16)a[1]; v[2] = (bf16)a[2]; v[3] = (bf16)a[3]; v[4] = (bf16)b[0]; v[5] = (bf16)b[1]; v[6] = (bf16)b[2]; v[7] = (bf16)b[3];
    *(bf16x8*)(dst + o) = v;
  }
}
DI unsigned pack_i8(float a, float b, float c, float d) {
  const int ia = max(-127, min(127, __float2int_rn(a))), ib = max(-127, min(127, __float2int_rn(b))), ic = max(-127, min(127, __float2int_rn(c))), id = max(-127, min(127, __float2int_rn(d)));
  return (unsigned)(ia & 255) | ((unsigned)(ib & 255) << 8) | ((unsigned)(ic & 255) << 16) | ((unsigned)(id & 255) << 24);
}
template <bool I8>
DI void unit_quant_rows(const float* __restrict__ src, unsigned char* __restrict__ dst, float* __restrict__ scale, int u) {
  const int t = threadIdx.x + opaque0(), lane = t & 63, w = t >> 6;
#pragma unroll
  for (int rr = 0; rr < 2; ++rr) {
    const size_t row = (size_t)u * 8 + 2 * w + rr;
    const float* s = src + row * DM + 16 * lane;
    f32x4 v[4];
    float amax = 0.f;
#pragma unroll
    for (int i = 0; i < 4; ++i) { v[i] = *(const f32x4*)(s + 4 * i); amax = fmaxf(amax, fmaxf(fmaxf(fabsf(v[i][0]), fabsf(v[i][1])), fmaxf(fabsf(v[i][2]), fabsf(v[i][3])))); }
#pragma unroll
    for (int o = 32; o >= 1; o >>= 1) amax = fmaxf(amax, __shfl_xor(amax, o));
    const float sc = amax > 0.f ? amax * (I8 ? 1.f / 127.f : 1.f / 440.f) : 1.f, inv = 1.f / sc;
    u32x4 q;
#pragma unroll
    for (int i = 0; i < 4; ++i) {
      if (I8) {
        q[i] = pack_i8(v[i][0] * inv, v[i][1] * inv, v[i][2] * inv, v[i][3] * inv);
      } else {
        int wd = 0;
        wd = __builtin_amdgcn_cvt_pk_fp8_f32(v[i][0] * inv, v[i][1] * inv, wd, false);
        wd = __builtin_amdgcn_cvt_pk_fp8_f32(v[i][2] * inv, v[i][3] * inv, wd, true);
        q[i] = (unsigned)wd;
      }
    }
    *(u32x4*)(dst + row * DM + 16 * lane) = q;
    if (lane == 0) scale[row] = sc;
  }
}
DI void unit_copy_f4(const float* __restrict__ src, float* __restrict__ dst, int n4) {
  for (int i = threadIdx.x + opaque0(); i < n4; i += NTHREADS) ((f32x4*)dst)[i] = ((const f32x4*)src)[i];
}

DI void phase0_filler(const P& p, int f, char* smem) {
  if (f < U0_TIN) { unit_transpose(p.w_in, w_Wt_in(p), 1024, INW, f / 60, f % 60, smem); }
  else {
    for (int i = threadIdx.x + opaque0(); i < 16 * 128; i += NTHREADS) {
      const int head = i >> 7, d = i & 127;
      int bk = d;
      if (d >= 16) { bk = 16 + (int)(logf((float)d / 16.f) / logf(8.f) * 16.f); bk = bk > 31 ? 31 : bk; }
      w_BIAS(p)[i] = p.rel_table[bk * 16 + head];
    }
  }
}
DI void phase2_filler(const P& p, int f, char* smem) {
  if (f < F2_TOUT) unit_transpose(p.w_out, w_Wt_out(p), 1024, 1024, f / 16, f % 16, smem);
  else if (f < F2_E1) { const int v = f - F2_TOUT; unit_transpose(p.w_query, w_Wt_q(p), 1024, 2048, v / 32, v % 32, smem); }
  else if (f < F2_E2) { const int v = f - F2_E1, g = v >> 3, tt = v & 7; unit_transpose(p.pool_w + (size_t)g * 128 * 256, w_PWt(p) + (size_t)g * 256 * 128, 128, 256, tt >> 2, tt & 3, smem); }
  else if (f < F2_E3) { const int b = f - F2_E2; unit_copy_f4(p.cache_k + ((size_t)b * 128 + 1) * 128, p.out + O_KWS + (size_t)b * 128 * 128, 127 * 128 / 4); }
  else if (f < F2_E4) { const int b = f - F2_E3; unit_copy_f4(p.cache_v + ((size_t)b * 128 + 1) * 128, p.out + O_VWS + (size_t)b * 128 * 128, 127 * 128 / 4); }
  else { const int b = f - F2_E4; unit_copy_f4(p.state_pool + ((size_t)b * 15 + 1) * 512, p.out + O_PS + (size_t)b * 15 * 512, 14 * 512 / 4); }
}

DI void norm_row(const P& p, int token, int which) {
  const int lane = (threadIdx.x + opaque0()) & 63;
  const float* src = which == 0 ? xrow(p, token) : w_X1(p) + (size_t)token * DM;
  const float* g = which == 0 ? p.norm1_g : p.norm2_g;
  const float* mod = w_MOD(p) + (size_t)cond_row(token) * 6144 + (which == 0 ? 0 : 3072);
  f32x4 v[4];
  float ss = 0.f;
  if (which == 1 && token >= NPR) {
    const float* g1 = w_MOD(p) + (size_t)cond_row(token) * 6144 + 2048;
#pragma unroll
    for (int i = 0; i < 4; ++i) {
      const int c = 4 * lane + 256 * i;
      const size_t po = (size_t)(token - NPR) * DM + c;
      const f32x4 xv = *(const f32x4*)(xrow(p, token) + c), gv = *(const f32x4*)(g1 + c);
      const f32x4 pa = *(const f32x4*)(w_PART(p) + po), pb = *(const f32x4*)(w_PART(p) + (size_t)NS * DM + po), pc = *(const f32x4*)(w_PART(p) + (size_t)2 * NS * DM + po), pd = *(const f32x4*)(w_PART(p) + (size_t)3 * NS * DM + po);
#pragma unroll
      for (int j = 0; j < 4; ++j) v[i][j] = xv[j] + gv[j] * ((pa[j] + pb[j]) + (pc[j] + pd[j]));
      *(f32x4*)(w_X1(p) + (size_t)token * DM + c) = v[i];
      ss += v[i][0] * v[i][0] + v[i][1] * v[i][1] + v[i][2] * v[i][2] + v[i][3] * v[i][3];
    }
  } else {
#pragma unroll
  for (int i = 0; i < 4; ++i) { v[i] = *(const f32x4*)(src + 4 * lane + 256 * i); ss += v[i][0] * v[i][0] + v[i][1] * v[i][1] + v[i][2] * v[i][2] + v[i][3] * v[i][3]; }
  }
  ss = wave_sum(ss);
  const float rstd = rsqrtf(ss * (1.f / DM) + EPS);
#pragma unroll
  for (int i = 0; i < 4; ++i) {
    const int c = 4 * lane + 256 * i;
    const f32x4 gg = *(const f32x4*)(g + c), sh = *(const f32x4*)(mod + c), sc = *(const f32x4*)(mod + 1024 + c);
    bf16x4 o;
#pragma unroll
    for (int j = 0; j < 4; ++j) { v[i][j] = (v[i][j] * rstd * gg[j]) * (1.f + sc[j]) + sh[j]; o[j] = (bf16)v[i][j]; }
    *(bf16x4*)(w_H(p) + (size_t)token * DM + c) = o;
  }
  if (which == 1) {
    float amax = 0.f;
#pragma unroll
    for (int i = 0; i < 4; ++i) amax = fmaxf(amax, fmaxf(fmaxf(fabsf(v[i][0]), fabsf(v[i][1])), fmaxf(fabsf(v[i][2]), fabsf(v[i][3]))));
#pragma unroll
    for (int o = 32; o >= 1; o >>= 1) amax = fmaxf(amax, __shfl_xor(amax, o));
    const float qs = amax > 0.f ? amax * (1.f / 127.f) : 1.f, inv = 1.f / qs;
#pragma unroll
    for (int i = 0; i < 4; ++i) *(unsigned*)(w_H8(p) + (size_t)token * DM + 4 * lane + 256 * i) = pack_i8(v[i][0] * inv, v[i][1] * inv, v[i][2] * inv, v[i][3] * inv);
    if (lane == 0) w_HS(p)[token] = qs;
  }
}

constexpr int LDSK = 72;
constexpr int GT = 128 * 64 * 2;
constexpr int GBUF = 2 * GT;
typedef __attribute__((address_space(3))) unsigned lds_u32;
typedef const __attribute__((address_space(1))) unsigned glb_u32;
DI void glds16(const void* g, char* l) { __builtin_amdgcn_global_load_lds((glb_u32*)g, (lds_u32*)l, 16, 0, 0); }
DI void gemm_first(const bf16* __restrict__ Wt, const bf16* __restrict__ X, int ld, int n0, int m0, char* smem) {
  const int t = threadIdx.x + opaque0(), lane = t & 63;
  const int w = __builtin_amdgcn_readfirstlane(t >> 6);
  const int swz = (lane & 7) ^ ((4 * w + (lane >> 4)) & 7);
  const bf16* ga = Wt + (size_t)(n0 + 8 * w + (lane >> 3)) * ld + swz * 8;
  const bf16* gb = X + (size_t)(m0 + 8 * w + (lane >> 3)) * ld + swz * 8;
#pragma unroll
  for (int q = 0; q < 4; ++q) { glds16(ga + (size_t)(32 * q) * ld, smem + 1024 * (w + 4 * q)); glds16(gb + (size_t)(32 * q) * ld, smem + GT + 1024 * (w + 4 * q)); }
}
DI void gemm_main(const bf16* __restrict__ Wt, const bf16* __restrict__ X, int ld, int K, int n0, int m0, char* smem, f32x16 (&acc)[4]) {
  const int t = threadIdx.x + opaque0(), lane = t & 63, r = lane & 31, h = lane >> 5;
  const int w = __builtin_amdgcn_readfirstlane(t >> 6);
#pragma unroll
  for (int i = 0; i < 4; ++i) acc[i] = zero16();
  const int swz = (lane & 7) ^ ((4 * w + (lane >> 4)) & 7);
  const bf16* ga = Wt + (size_t)(n0 + 8 * w + (lane >> 3)) * ld + swz * 8;
  const bf16* gb = X + (size_t)(m0 + 8 * w + (lane >> 3)) * ld + swz * 8;
  const int sw = (r >> 1) & 7;
  const int KT = K >> 6;
  asm volatile("s_waitcnt vmcnt(0)" ::: "memory");
  __syncthreads();
  for (int kt = 0; kt < KT; ++kt) {
    const char* As = smem + (kt & 1) * GBUF;
    const char* Bs = As + GT;
    if (kt + 1 < KT) {
      char* An = smem + ((kt + 1) & 1) * GBUF;
      const int k0 = (kt + 1) * 64;
#pragma unroll
      for (int q = 0; q < 4; ++q) { glds16(ga + (size_t)(32 * q) * ld + k0, An + 1024 * (w + 4 * q)); glds16(gb + (size_t)(32 * q) * ld + k0, An + GT + 1024 * (w + 4 * q)); }
    }
#pragma unroll
    for (int s = 0; s < 4; ++s) {
      const int co = ((2 * s + h) ^ sw) * 16;
      const bf16x8 bfr = *(const bf16x8*)(Bs + (32 * w + r) * 128 + co);
#pragma unroll
      for (int i = 0; i < 4; ++i) {
        const bf16x8 afr = *(const bf16x8*)(As + (32 * i + r) * 128 + co);
        acc[i] = MFMA(afr, bfr, acc[i]);
      }
    }
    asm volatile("s_waitcnt vmcnt(0)" ::: "memory");
    __syncthreads();
  }
}

DI float sigmoid_f(float x) { return __builtin_amdgcn_rcpf(1.f + __expf(-x)); }

DI void unit_gemm1(const P& p, int u, int un, char* smem) {
  const int mt = u / 30, nt = u % 30;
  const int n0 = nt * 128, m0 = mt * 128;
  f32x16 acc[4];
  gemm_main(w_Wt_in(p), w_H(p), 1024, 1024, n0, m0, smem, acc);
  if (un >= 0) gemm_first(w_Wt_in(p), w_H(p), 1024, (un % 30) * 128, (un / 30) * 128, smem);
  const int tz = threadIdx.x + opaque0();
  const int lane = tz & 63, w = tz >> 6, r = lane & 31, h = lane >> 5;
  const int token = m0 + 32 * w + r;
  bf16* tw = (bf16*)(smem + GBUF + (tz >> 6) * 8704) + r * 136;
  const bool is_prompt = token < NPR;
  const int b = is_prompt ? (token >> 11) : (token - NPR), pos = token & (SEQ - 1);
  if (n0 < C_V) {
    const float* gn = n0 < C_K ? p.q_norm_g : p.k_norm_g;
    const float post = n0 < C_K ? 0.125f : 1.f;
#pragma unroll
    for (int hh = 0; hh < 2; ++hh) {
      float ss = 0.f;
#pragma unroll
      for (int i = 0; i < 2; ++i)
#pragma unroll
        for (int j = 0; j < 16; ++j) ss += acc[2 * hh + i][j] * acc[2 * hh + i][j];
      ss += __shfl_xor(ss, 32);
      const float rstd = rsqrtf(ss * (1.f / 64.f) + EPS);
#pragma unroll
      for (int i = 0; i < 2; ++i)
#pragma unroll
        for (int q4 = 0; q4 < 4; ++q4) {
          const int d = 32 * i + 8 * q4 + 4 * h;
          const f32x4 gg = *(const f32x4*)(gn + d);
          f32x4 v;
#pragma unroll
          for (int j = 0; j < 4; ++j) v[j] = acc[2 * hh + i][4 * q4 + j] * rstd * gg[j];
          bf16x4 o;
#pragma unroll
          for (int j = 0; j < 4; ++j) o[j] = (bf16)(v[j] * post);
          *(bf16x4*)(tw + 64 * hh + d) = o;
          if (n0 == C_K) {
            if (is_prompt) { if (pos >= SEQ - 128) *(f32x4*)(p.out + O_KWP + ((size_t)b * 128 + (pos - (SEQ - 128))) * 128 + 64 * hh + d) = v; }
            else *(f32x4*)(p.out + O_KWS + ((size_t)b * 128 + 127) * 128 + 64 * hh + d) = v;
          }
        }
    }
  } else if (n0 == C_V) {
#pragma unroll
    for (int i = 0; i < 4; ++i)
#pragma unroll
      for (int q4 = 0; q4 < 4; ++q4) {
        const int f = 32 * i + 8 * q4 + 4 * h;
        f32x4 v;
#pragma unroll
        for (int j = 0; j < 4; ++j) v[j] = acc[i][4 * q4 + j];
        if (is_prompt) {
#pragma unroll
          for (int j = 0; j < 4; ++j) w_VT(p)[((size_t)b * 128 + f + j) * SEQ + pos] = (bf16)v[j];
          if (pos >= SEQ - 128) *(f32x4*)(p.out + O_VWP + ((size_t)b * 128 + (pos - (SEQ - 128))) * 128 + f) = v;
        } else *(f32x4*)(p.out + O_VWS + ((size_t)b * 128 + 127) * 128 + f) = v;
      }
  } else if (n0 < C_GA) {
#pragma unroll
    for (int i = 0; i < 4; ++i)
#pragma unroll
      for (int q4 = 0; q4 < 4; ++q4) {
        const int f = n0 + 32 * i + 8 * q4 + 4 * h;
        f32x4 v; bf16x4 o;
#pragma unroll
        for (int j = 0; j < 4; ++j) { v[j] = acc[i][4 * q4 + j]; o[j] = (bf16)v[j]; }
        *(bf16x4*)(tw + (f - n0)) = o;
        if (is_prompt) { if (pos >= SEQ - 15) *(f32x4*)(p.out + O_PP + ((size_t)b * 15 + (pos - (SEQ - 15))) * 512 + (f - C_PIN)) = v; }
        else *(f32x4*)(p.out + O_PS + ((size_t)b * 15 + 14) * 512 + (f - C_PIN)) = v;
      }
  } else {
#pragma unroll
    for (int i = 0; i < 4; ++i)
#pragma unroll
      for (int q4 = 0; q4 < 4; ++q4) {
        const int f = n0 + 32 * i + 8 * q4 + 4 * h;
        bf16x4 o;
#pragma unroll
        for (int j = 0; j < 4; ++j) o[j] = (bf16)sigmoid_f(acc[i][4 * q4 + j]);
        *(bf16x4*)(tw + (f - n0)) = o;
      }
  }
  if (n0 != C_V) {
    LDS_WAIT();
    const bf16* tr = (const bf16*)(smem + GBUF + (tz >> 6) * 8704);
    bf16* pg = w_PROJ(p) + (size_t)(m0 + 32 * w + (lane >> 4)) * INW + n0 + (lane & 15) * 8;
#pragma unroll
    for (int it = 0; it < 8; ++it) *(u32x4*)(pg + (size_t)(4 * it) * INW) = *(const u32x4*)(tr + ((lane >> 4) + 4 * it) * 136 + (lane & 15) * 8);
  }
}

constexpr int VTS = 260;
constexpr int RS = 136;
DI void attn_head(const P& p, int head, int blk, int w, int r, int h, size_t tokq, const bf16* Ks, const bf16* VTs, const float* bsh, bf16x8 (&ob)[4]) {
  const int qi = 32 * w + r;
  bf16x8 qf[4];
#pragma unroll
  for (int s = 0; s < 4; ++s) qf[s] = *(const bf16x8*)(w_PROJ(p) + tokq * INW + head * 64 + 16 * s + 8 * h);
  f32x16 st[5];
#pragma unroll
  for (int tt = 0; tt < 5; ++tt) {
    st[tt] = zero16();
#pragma unroll
    for (int s = 0; s < 4; ++s) {
      const bf16x8 a = *(const bf16x8*)(Ks + (32 * (w + tt) + r) * LDSK + 16 * s + 8 * h);
      st[tt] = MFMA(a, qf[s], st[tt]);
    }
  }
  const float sink = p.sinks[head];
  float m = -INFINITY;
  {
    const int x = 31 - r + 4 * h;
    const float* bl = bsh + x;
#pragma unroll
    for (int tt = 0; tt < 5; ++tt)
#pragma unroll
      for (int j = 0; j < 16; ++j) {
        const int c = 32 * tt + (j & 3) + 8 * (j >> 2);
        const float s = st[tt][j] + bl[c];
        st[tt][j] = s;
        m = fmaxf(m, s);
      }
    if (blk == 0) {
      m = -INFINITY;
#pragma unroll
      for (int tt = 0; tt < 5; ++tt)
#pragma unroll
        for (int j = 0; j < 16; ++j) {
          const int c = 32 * tt + (j & 3) + 8 * (j >> 2);
          const float s = (159 - (x + c) > qi) ? -INFINITY : st[tt][j];
          st[tt][j] = s;
          m = fmaxf(m, s);
        }
    }
  }
  m = fmaxf(m, __shfl_xor(m, 32));
  m = fmaxf(m, sink);
  float sum = 0.f;
#pragma unroll
  for (int tt = 0; tt < 5; ++tt)
#pragma unroll
    for (int j = 0; j < 16; ++j) { const float e = __expf(st[tt][j] - m); st[tt][j] = e; sum += e; }
  sum += __shfl_xor(sum, 32);
  const float inv = 1.f / (sum + __expf(sink - m));
  f32x16 o[2] = {zero16(), zero16()};
#pragma unroll
  for (int tt = 0; tt < 5; ++tt)
#pragma unroll
    for (int s = 0; s < 2; ++s) {
      const bf16x8 pb = pack_step(st[tt], s);
#pragma unroll
      for (int i = 0; i < 2; ++i) {
        const bf16* vp = VTs + (32 * i + r) * VTS + 32 * (w + tt) + 16 * s + 4 * h;
        const bf16x8 a = cat4(*(const bf16x4*)vp, *(const bf16x4*)(vp + 8));
        o[i] = MFMA(a, pb, o[i]);
      }
    }
#pragma unroll
  for (int i = 0; i < 2; ++i)
#pragma unroll
    for (int j = 0; j < 16; ++j) ob[2 * i + (j >> 3)][j & 7] = (bf16)(o[i][j] * inv);
}
DI void unit_attn_prompt(const P& p, int u, char* smem) {
  const int b = u >> 7, blk = (u >> 3) & 15, hp = u & 7, hk = hp >> 2, g = hp >> 1, win = 2 << g;
  const int qpos0 = blk * 128;
  const int t = threadIdx.x + opaque0(), lane = t & 63, w = t >> 6, r = lane & 31, h = lane >> 5;
  bf16* Ks = (bf16*)smem;
  bf16* VTs = Ks + 256 * LDSK;
  float* bs = (float*)(VTs + 64 * VTS);
  bf16* Rs = Ks;
  __syncthreads();
#pragma unroll
  for (int i = 0; i < 8; ++i) {
    const int c = t + 256 * i, row = c >> 3, c16 = c & 7, kp = qpos0 - 128 + row;
    u32x4 v = {0u, 0u, 0u, 0u};
    if (kp >= 0) v = *(const u32x4*)(w_PROJ(p) + ((size_t)b * SEQ + kp) * INW + C_K + hk * 64 + c16 * 8);
    *(u32x4*)(Ks + row * LDSK + c16 * 8) = v;
  }
#pragma unroll
  for (int i = 0; i < 8; ++i) {
    const int c = t + 256 * i, drow = c >> 5, c16 = c & 31, kp0 = qpos0 - 128 + c16 * 8;
    u32x4 v = {0u, 0u, 0u, 0u};
    if (kp0 >= 0) v = *(const u32x4*)(w_VT(p) + ((size_t)(b * 2 + hk) * 64 + drow) * SEQ + kp0);
    u32x2* d2 = (u32x2*)(VTs + drow * VTS + c16 * 8);
    d2[0] = (u32x2){v[0], v[1]}; d2[1] = (u32x2){v[2], v[3]};
  }
  for (int i = t; i < 384; i += NTHREADS) { const int hh = i >= 192, j = i - 192 * hh, dist = 159 - j; bs[i] = (dist >= 0 && dist < 128) ? w_BIAS(p)[(2 * hp + hh) * 128 + dist] : -INFINITY; }
  const size_t tokq = (size_t)b * SEQ + qpos0 + 32 * w + r;
  __syncthreads();
  bf16x8 ob0[4], ob1[4];
  attn_head(p, 2 * hp, blk, w, r, h, tokq, Ks, VTs, bs, ob0);
  __builtin_amdgcn_sched_barrier(0);
  attn_head(p, 2 * hp + 1, blk, w, r, h, tokq, Ks, VTs, bs + 192, ob1);
  __builtin_amdgcn_sched_barrier(0);
  __syncthreads();
  {
    const int tk = t >> 4, cc = t & 15;
    const int p0 = qpos0 + tk * 8;
    const bf16* pin = w_PROJ(p) + (size_t)b * SEQ * INW + C_PIN + g * 128 + cc * 8;
    float S[8];
#pragma unroll
    for (int j = 0; j < 8; ++j) S[j] = 0.f;
    for (int i = 0; i < win; ++i) {
      const int pp = p0 - i;
      if (pp >= 0) { const bf16x8 v = *(const bf16x8*)(pin + (size_t)pp * INW);
#pragma unroll
        for (int j = 0; j < 8; ++j) S[j] += bf2f(v[j]); }
    }
    for (int i = 0; i < 8; ++i) {
      const int pos = p0 + i;
      const bf16x8 cur = *(const bf16x8*)(pin + (size_t)pos * INW);
      if (i > 0) {
#pragma unroll
        for (int j = 0; j < 8; ++j) S[j] += bf2f(cur[j]);
        if (pos - win >= 0) { const bf16x8 old = *(const bf16x8*)(pin + (size_t)(pos - win) * INW);
#pragma unroll
          for (int j = 0; j < 8; ++j) S[j] -= bf2f(old[j]); }
      }
      const float icnt = 1.f / (float)(win < pos + 1 ? win : pos + 1);
      bf16x8 rr;
#pragma unroll
      for (int j = 0; j < 8; ++j) rr[j] = (bf16)(S[j] * icnt - bf2f(cur[j]));
      *(bf16x8*)(Rs + (tk * 8 + i) * RS + cc * 8) = rr;
    }
  }
  __syncthreads();
  const bf16* prow = w_PROJ(p) + tokq * INW;
#pragma unroll
  for (int hh = 0; hh < 2; ++hh) {
    const int head = 2 * hp + hh;
    f32x16 pa[2] = {zero16(), zero16()};
#pragma unroll
    for (int s = 0; s < 8; ++s) {
      const bf16x8 bfr = *(const bf16x8*)(Rs + (32 * w + r) * RS + 16 * s + 8 * h);
#pragma unroll
      for (int i = 0; i < 2; ++i) {
        const bf16x8 a = *(const bf16x8*)(w_PWt(p) + ((size_t)g * 256 + (head & 3) * 64 + 32 * i + r) * 128 + 16 * s + 8 * h);
        pa[i] = MFMA(a, bfr, pa[i]);
      }
    }
#pragma unroll
    for (int i = 0; i < 2; ++i)
#pragma unroll
      for (int q4 = 0; q4 < 4; ++q4) {
        const int f = head * 64 + 32 * i + 8 * q4 + 4 * h;
        const bf16x4 ga = *(const bf16x4*)(prow + C_GA + f), gb = *(const bf16x4*)(prow + C_GB + f);
        const f32x4 ps = *(const f32x4*)(p.pool_scale + f);
        bf16x4 ov;
#pragma unroll
        for (int j = 0; j < 4; ++j) { const bf16 av = hh ? ob1[2 * i + (q4 >> 1)][4 * (q4 & 1) + j] : ob0[2 * i + (q4 >> 1)][4 * (q4 & 1) + j];
          ov[j] = (bf16)(bf2f(ga[j]) * bf2f(av) + bf2f(gb[j]) * (pa[i][4 * q4 + j] * ps[j])); }
        *(bf16x4*)(w_MIXED(p) + tokq * DM + f) = ov;
      }
    __builtin_amdgcn_sched_barrier(0);
  }
}

DI void unit_attn_sample(const P& p, int u, char* smem) {
  const int b = u >> 2, g = u & 3, hk = g >> 1;
  const int t = threadIdx.x + opaque0(), lane = t & 63, w = t >> 6;
  float* ks = (float*)smem;
  float* vs = ks + 128 * 65;
  float* qs = vs + 128 * 64;
  float* ps = qs + 256;
  float* os = ps + 512;
  float* rs = os + 256;
  const size_t token = (size_t)NPR + b;
  __syncthreads();
  const float* kw = p.out + O_KWS + (size_t)b * 128 * 128 + hk * 64;
  const float* vw = p.out + O_VWS + (size_t)b * 128 * 128 + hk * 64;
#pragma unroll 4
  for (int i = t; i < 128 * 64; i += NTHREADS) { const int j = i >> 6, d = i & 63; ks[j * 65 + d] = kw[(size_t)j * 128 + d]; vs[j * 64 + d] = vw[(size_t)j * 128 + d]; }
  qs[t] = bf2f(w_PROJ(p)[token * INW + g * 256 + t]);
  if (t < 128) {
    const int win = 2 << g;
    const float cur = p.out[O_PS + ((size_t)b * 15 + 14) * 512 + g * 128 + t];
    float tot = cur;
#pragma unroll 1
    for (int i = 1; i < win; ++i) tot += p.state_pool[((size_t)b * 15 + 15 - i) * 512 + g * 128 + t];
    rs[t] = tot / (float)win - cur;
  }
  __syncthreads();
  const int head = 4 * g + w;
  const float sink = p.sinks[head];
  float s[2];
  float m = sink;
#pragma unroll
  for (int i = 0; i < 2; ++i) {
    const int j = lane + 64 * i;
    float a = 0.f;
#pragma unroll 8
    for (int d = 0; d < 64; ++d) a += qs[w * 64 + d] * ks[j * 65 + d];
    s[i] = a + w_BIAS(p)[head * 128 + 127 - j];
    m = fmaxf(m, s[i]);
  }
  for (int o = 32; o >= 1; o >>= 1) m = fmaxf(m, __shfl_xor(m, o));
  float sum = 0.f;
#pragma unroll
  for (int i = 0; i < 2; ++i) { s[i] = __expf(s[i] - m); sum += s[i]; }
  sum = wave_sum(sum);
  const float inv = 1.f / (sum + __expf(sink - m));
#pragma unroll
  for (int i = 0; i < 2; ++i) ps[w * 128 + lane + 64 * i] = s[i] * inv;
  LDS_WAIT();
  {
    float a = 0.f;
#pragma unroll 8
    for (int j = 0; j < 128; ++j) a += ps[w * 128 + j] * vs[j * 64 + lane];
    os[w * 64 + lane] = a;
  }
  const int f = g * 256 + t;
  float pl = 0.f;
  const float* pw = p.pool_w + (size_t)g * 128 * 256 + t;
#pragma unroll 8
  for (int ch = 0; ch < 128; ++ch) pl += rs[ch] * pw[(size_t)ch * 256];
  pl *= p.pool_scale[f];
  const float ga = bf2f(w_PROJ(p)[token * INW + C_GA + f]), gb = bf2f(w_PROJ(p)[token * INW + C_GB + f]);
  LDS_WAIT();
  w_MIXED(p)[token * DM + f] = (bf16)(ga * os[t] + gb * pl);
}

DI void unit8_map(int u, int& mt, int& nt) {
  if (u < 1024) { const int xcd = u & 7, slot = (u >> 3) & 63, S = (u >> 9) * 8 + xcd; mt = S * 8 + (slot & 7); nt = slot >> 3; }
  else { mt = 128; nt = u - 1024; }
}
constexpr int G2_UNITS = 1024 + 32;
DI void gemm2_map(int u, int& mt, int& nt, int& kq) {
  if (u < 1024) { unit8_map(u, mt, nt); kq = -1; }
  else { mt = 128; nt = (u - 1024) & 7; kq = (u - 1024) >> 3; }
}
DI void gemm2_first(const P& p, int u, char* smem) {
  int mt, nt, kq; gemm2_map(u, mt, nt, kq);
  const int kb = kq < 0 ? 0 : 256 * kq;
  gemm_first(w_Wt_out(p) + kb, w_MIXED(p) + kb, 1024, nt * 128, mt * 128, smem);
}
DI void unit_gemm2(const P& p, int u, int un, char* smem) {
  int mt, nt, kq; gemm2_map(u, mt, nt, kq);
  const int n0 = nt * 128, m0 = mt * 128, kb = kq < 0 ? 0 : 256 * kq;
  f32x16 acc[4];
  gemm_main(w_Wt_out(p) + kb, w_MIXED(p) + kb, 1024, kq < 0 ? 1024 : 256, n0, m0, smem, acc);
  if (un >= 0) gemm2_first(p, un, smem);
  const int tz = threadIdx.x + opaque0();
  const int lane = tz & 63, w = tz >> 6, r = lane & 31, h = lane >> 5;
  float* tbase = (float*)(smem + GBUF + w * 8704);
#pragma unroll
  for (int hf = 0; hf < 2; ++hf) {
    if (hf) LDS_WAIT();
#pragma unroll
    for (int ii = 0; ii < 2; ++ii)
#pragma unroll
      for (int q4 = 0; q4 < 4; ++q4) {
        f32x4 v;
#pragma unroll
        for (int j = 0; j < 4; ++j) v[j] = acc[2 * hf + ii][4 * q4 + j];
        *(f32x4*)(tbase + r * 68 + 32 * ii + 8 * q4 + 4 * h) = v;
      }
    LDS_WAIT();
    const int fc = (lane & 15) * 4, tsub = lane >> 4;
#pragma unroll
    for (int it = 0; it < 8; ++it) {
      const int tl = 4 * it + tsub, token = m0 + 32 * w + tl, f = n0 + 64 * hf + fc;
      const f32x4 a = *(const f32x4*)(tbase + tl * 68 + fc);
      if (kq >= 0) { *(f32x4*)(w_PART(p) + ((size_t)kq * NS + (token - NPR)) * DM + f) = a; continue; }
      const f32x4 xv = *(const f32x4*)(xrow(p, token) + f), gv = *(const f32x4*)(w_MOD(p) + (size_t)cond_row(token) * 6144 + 2048 + f);
      f32x4 o;
#pragma unroll
      for (int j = 0; j < 4; ++j) o[j] = xv[j] + gv[j] * a[j];
      *(f32x4*)(w_X1(p) + (size_t)token * DM + f) = o;
    }
  }
}

DI unsigned f2ord(float f) { const unsigned u = __float_as_uint(f); return (u & 0x80000000u) ? ~u : (u | 0x80000000u); }
DI float ord2f(unsigned u) { return __uint_as_float((u & 0x80000000u) ? (u & 0x7fffffffu) : ~u); }
DI unsigned umin_(unsigned a, unsigned b) { return a < b ? a : b; }
DI unsigned umax_(unsigned a, unsigned b) { return a > b ? a : b; }
template <int OFF> DI void sort16_desc(unsigned (&a)[64]) {
#pragma unroll
  for (int lk = 1; lk <= 4; ++lk)
#pragma unroll
    for (int lj = lk - 1; lj >= 0; --lj)
#pragma unroll
      for (int i = 0; i < 16; ++i) {
        const int k = 1 << lk, j = 1 << lj, l = i ^ j;
        if (l > i) {
          const unsigned lo = umin_(a[OFF + i], a[OFF + l]), hi = umax_(a[OFF + i], a[OFF + l]);
          const bool desc = (i & k) == 0;
          a[OFF + i] = desc ? hi : lo; a[OFF + l] = desc ? lo : hi;
        }
      }
}
DI void merge16_desc(unsigned (&a)[16]) {
#pragma unroll
  for (int lj = 3; lj >= 0; --lj)
#pragma unroll
    for (int i = 0; i < 16; ++i) {
      const int j = 1 << lj, l = i ^ j;
      if (l > i) { const unsigned lo = umin_(a[i], a[l]), hi = umax_(a[i], a[l]); a[i] = hi; a[l] = lo; }
    }
}
DI void top16_of_64(unsigned (&a)[64], unsigned (&out)[16]) {
  sort16_desc<0>(a); sort16_desc<16>(a); sort16_desc<32>(a); sort16_desc<48>(a);
  unsigned x[16], y[16];
#pragma unroll
  for (int i = 0; i < 16; ++i) { x[i] = umax_(a[i], a[31 - i]); y[i] = umax_(a[32 + i], a[63 - i]); }
  merge16_desc(x); merge16_desc(y);
#pragma unroll
  for (int i = 0; i < 16; ++i) out[i] = umax_(x[i], y[15 - i]);
  merge16_desc(out);
}
__device__ constexpr int COFF[16] = {0, 16, 24, 29, 33, 36, 38, 40, 42, 43, 44, 45, 46, 47, 48, 49};
DI unsigned umax3(unsigned a, unsigned b, unsigned c) { const unsigned m = a > b ? a : b; return m > c ? m : c; }

DI void unit_peer_route(const P& p, int u, int un, char* smem) {
  int mt, hd; unit8_map(u, mt, hd);
  const int m0 = mt * 128;
  const int t = threadIdx.x + opaque0(), lane = t & 63, w = t >> 6, r = lane & 31, h = lane >> 5;
  unsigned char* myidx = (unsigned char*)smem + 2 * GBUF + t * 32;
  unsigned top[2][16];
#pragma unroll
  for (int pp = 0; pp < 2; ++pp) {
    f32x16 acc[4];
    gemm_main(w_Wt_q(p), w_H(p), 1024, 1024, hd * 256 + pp * 128, m0, smem, acc);
    if (pp == 0) gemm_first(w_Wt_q(p), w_H(p), 1024, hd * 256 + 128, m0, smem);
    else if (un >= 0) { int mn, hn; unit8_map(un, mn, hn); gemm_first(w_Wt_q(p), w_H(p), 1024, hn * 256, mn * 128, smem); }
    f32x16 sc[4] = {zero16(), zero16(), zero16(), zero16()};
    {
      const bf16* skb = w_SK(p) + (size_t)(hd * 2 + pp) * 128 * 128;
      const int wu = __builtin_amdgcn_readfirstlane(w);
#pragma unroll
      for (int q = 0; q < 8; ++q) {
        const int j = wu + 4 * q, row = 4 * j + (lane >> 4);
        glds16(skb + (size_t)row * 128 + (((lane & 15) ^ (row & 15)) * 8), smem + GBUF + 1024 * j);
      }
      asm volatile("s_waitcnt vmcnt(0)" ::: "memory");
      __syncthreads();
    }
    bf16x8 bqs[8];
#pragma unroll
    for (int i = 0; i < 4; ++i)
#pragma unroll
      for (int s = 0; s < 2; ++s) bqs[2 * i + s] = pack_step(acc[i], s);
#pragma unroll
    for (int i = 0; i < 4; ++i)
#pragma unroll
      for (int s = 0; s < 2; ++s) {
        const bf16x8 bq = bqs[2 * i + s];
#pragma unroll
        for (int kt = 0; kt < 4; ++kt) {
          const int row = 32 * kt + r, cc = 4 * i + 2 * s;
          const char* rp = smem + GBUF + row * 256 + 8 * h;
          const bf16x8 a = cat4(*(const bf16x4*)(rp + ((cc ^ (row & 15)) * 16)), *(const bf16x4*)(rp + (((cc + 1) ^ (row & 15)) * 16)));
          sc[kt] = MFMA(a, bq, sc[kt]);
        }
      }
    unsigned pk[64];
#pragma unroll
    for (int kt = 0; kt < 4; ++kt)
#pragma unroll
      for (int j = 0; j < 16; ++j) { const int key = 32 * kt + crow(j, h); pk[kt * 16 + j] = (f2ord(sc[kt][j]) & ~127u) | (unsigned)(127 - key); }
    unsigned mine[16];
    top16_of_64(pk, mine);
#pragma unroll
    for (int i = 0; i < 16; ++i) top[pp][i] = (unsigned)__shfl_xor((int)mine[15 - i], 32);
#pragma unroll
    for (int i = 0; i < 16; ++i) top[pp][i] = umax_(top[pp][i], mine[i]);
    merge16_desc(top[pp]);
  }
  float v0[16], v1[16];
#pragma unroll
  for (int a = 0; a < 16; ++a) {
    v0[a] = ord2f(top[0][a] & ~127u); v1[a] = ord2f(top[1][a] & ~127u);
    myidx[a] = (unsigned char)(127u - (top[0][a] & 127u)); myidx[16 + a] = (unsigned char)(127u - (top[1][a] & 127u));
  }
  unsigned cand[64];
#pragma unroll
  for (int i = 50; i < 64; ++i) cand[i] = 0u;
#pragma unroll
  for (int a = 0; a < 16; ++a)
#pragma unroll
    for (int bb = 0; bb < 16 / (a + 1); ++bb)
      cand[COFF[a] + bb] = (f2ord(v0[a] + v1[bb]) & ~255u) | (unsigned)(255 - (a * 16 + bb));
  unsigned best[16];
  top16_of_64(cand, best);
  const float smax = ord2f(best[0] & ~255u);
  float e[16], esum = 0.f;
#pragma unroll
  for (int i = 0; i < 16; ++i) { e[i] = __expf(ord2f(best[i] & ~255u) - smax); esum += e[i]; }
  const float einv = 1.f / esum;
  const size_t token = (size_t)m0 + 32 * w + r;
  int* ip = w_IDX(p) + token * 128 + hd * 16 + 8 * h;
  float* gp = w_GATE(p) + token * 128 + hd * 16 + 8 * h;
  const unsigned hmask = 0u - (unsigned)h;
#pragma unroll
  for (int i = 0; i < 8; ++i) {
    const unsigned bsel = best[i] ^ ((best[i] ^ best[8 + i]) & hmask);
    const float esel = __uint_as_float(__float_as_uint(e[i]) ^ ((__float_as_uint(e[i]) ^ __float_as_uint(e[8 + i])) & hmask));
    const unsigned code = 255u - (bsel & 255u);
    const int a = code >> 4, bb = code & 15;
    ip[i] = (int)myidx[a] * 128 + (int)myidx[16 + bb];
    gp[i] = esel * einv;
  }
}

DI float gelu_fast(float v) {
  const float av = fabsf(v), tt = __builtin_amdgcn_rcpf(av * 0.2316418882f + 1.0f);
  float q = tt * 0.5307027145f - 0.7265760135f; q = q * tt + 0.7107068705f; q = q * tt - 0.142248368f; q = q * tt + 0.127414796f; q = q * tt;
  const float e = __builtin_amdgcn_exp2f(v * v * -0.72134752044f);
  const float m = v * (q * e);
  return v < 0.f ? m : v - m;
}
DI float dot2bf(unsigned a, unsigned b, float acc) { return __builtin_amdgcn_fdot2_f32_bf16(__builtin_bit_cast(bf16x2, a), __builtin_bit_cast(bf16x2, b), acc, false); }
DI unsigned pkbf(f32x2 v) { bf16x2 r; r[0] = (bf16)v[0]; r[1] = (bf16)v[1]; return __builtin_bit_cast(unsigned, r); }
DI int dot16i(u32x4 u8, u32x4 x8, int d) {
#pragma unroll
  for (int m = 0; m < 4; ++m) d = __builtin_amdgcn_sdot4((int)u8[m], (int)x8[m], d, false);
  return d;
}
DI void axpy16p(f32x2* o, u32x4 v8, f32x2 c2) {
#pragma unroll
  for (int m = 0; m < 4; ++m) {
    const int wd = (int)v8[m];
    o[2 * m] = __builtin_elementwise_fma(c2, __builtin_amdgcn_cvt_pk_f32_fp8(wd, false), o[2 * m]);
    o[2 * m + 1] = __builtin_elementwise_fma(c2, __builtin_amdgcn_cvt_pk_f32_fp8(wd, true), o[2 * m + 1]);
  }
}
DI int dpp_add16i(int v) {
  v += __builtin_amdgcn_update_dpp(0, v, 0x140, 0xf, 0xf, true);
  v += __builtin_amdgcn_update_dpp(0, v, 0x141, 0xf, 0xf, true);
  v += __builtin_amdgcn_update_dpp(0, v, 0x4e, 0xf, 0xf, true);
  v += __builtin_amdgcn_update_dpp(0, v, 0xb1, 0xf, 0xf, true);
  return v;
}
DI float dot16(u32x4 u8, u32x4 xlo, u32x4 xhi, float d) {
#pragma unroll
  for (int m = 0; m < 4; ++m) {
    const int wd = (int)u8[m];
    const unsigned p01 = pkbf(__builtin_amdgcn_cvt_pk_f32_fp8(wd, false)), p23 = pkbf(__builtin_amdgcn_cvt_pk_f32_fp8(wd, true));
    const unsigned x01 = m < 2 ? xlo[2 * m] : xhi[2 * m - 4], x23 = m < 2 ? xlo[2 * m + 1] : xhi[2 * m - 3];
    d = dot2bf(p01, x01, d); d = dot2bf(p23, x23, d);
  }
  return d;
}
DI void axpy16(float* o, u32x4 v8, float c) {
#pragma unroll
  for (int m = 0; m < 4; ++m) {
    const int wd = (int)v8[m];
    const f32x2 a = __builtin_amdgcn_cvt_pk_f32_fp8(wd, false), b = __builtin_amdgcn_cvt_pk_f32_fp8(wd, true);
    o[4 * m] += c * a[0]; o[4 * m + 1] += c * a[1]; o[4 * m + 2] += c * b[0]; o[4 * m + 3] += c * b[1];
  }
}
DI float reduce4(const float (&d)[4], int lane) {
  const int h = lane >> 5, b4 = (lane >> 4) & 1;
  float a0 = h ? d[2] : d[0], a1 = h ? d[3] : d[1];
  const float s0 = h ? d[0] : d[2], s1 = h ? d[1] : d[3];
  a0 += __shfl_xor(s0, 32); a1 += __shfl_xor(s1, 32);
  float k = b4 ? a1 : a0;
  const float s = b4 ? a0 : a1;
  k += __shfl_xor(s, 16);
  k += __shfl_xor(k, 8); k += __shfl_xor(k, 4); k += __shfl_xor(k, 2); k += __shfl_xor(k, 1);
  return k;
}
DI float dpp_add16(float v) {
  v += __int_as_float(__builtin_amdgcn_update_dpp(0, __float_as_int(v), 0x140, 0xf, 0xf, true));
  v += __int_as_float(__builtin_amdgcn_update_dpp(0, __float_as_int(v), 0x141, 0xf, 0xf, true));
  v += __int_as_float(__builtin_amdgcn_update_dpp(0, __float_as_int(v), 0x4e, 0xf, 0xf, true));
  v += __int_as_float(__builtin_amdgcn_update_dpp(0, __float_as_int(v), 0xb1, 0xf, 0xf, true));
  return v;
}
constexpr int PEER_GLDS = 512 + 128 * 16;
constexpr int PEER_WLDS = 4 * PEER_GLDS;
DI void peer_wave4(const P& p, int g, char* wl) {
  const int lane = (threadIdx.x + opaque0()) & 63, q = lane >> 4, j16 = lane & 15;
  unsigned* hist = (unsigned*)(wl + q * PEER_GLDS);
  u32x4* list = (u32x4*)(wl + q * PEER_GLDS + 512);
  const int token = 4 * g + q;
  u32x4 x[4];
  {
    const unsigned char* hrow = w_H8(p) + (size_t)token * DM + 16 * j16;
#pragma unroll
    for (int i = 0; i < 4; ++i) x[i] = *(const u32x4*)(hrow + 256 * i);
  }
  const float xs = w_HS(p)[token];
  {
    int ids[8]; float gts[8], su[8];
#pragma unroll
    for (int i = 0; i < 8; ++i) { const size_t o = (size_t)token * 128 + j16 + 16 * i; ids[i] = w_IDX(p)[o]; gts[i] = w_GATE(p)[o]; }
#pragma unroll
    for (int i = 0; i < 8; ++i) { su[i] = w_SU(p)[ids[i]] * xs; gts[i] *= w_SV(p)[ids[i]]; }
    LDS_WAIT();
    *(u32x4*)(hist + 8 * j16) = (u32x4){0u, 0u, 0u, 0u}; *(u32x4*)(hist + 8 * j16 + 4) = (u32x4){0u, 0u, 0u, 0u};
    LDS_WAIT();
#pragma unroll
    for (int i = 0; i < 8; ++i) (void)__hip_atomic_fetch_add(&hist[ids[i] >> 7], 1u, __ATOMIC_RELAXED, __HIP_MEMORY_SCOPE_WAVEFRONT);
    LDS_WAIT();
    const u32x4 ca = *(const u32x4*)(hist + 8 * j16), cb = *(const u32x4*)(hist + 8 * j16 + 4);
    const unsigned tot = ca[0] + ca[1] + ca[2] + ca[3] + cb[0] + cb[1] + cb[2] + cb[3];
    unsigned scan = tot;
#pragma unroll
    for (int o = 1; o < 16; o <<= 1) { const unsigned tv = (unsigned)__shfl_up((int)scan, o, 16); if (j16 >= o) scan += tv; }
    unsigned e0 = scan - tot;
    u32x4 pa, pb;
    pa[0] = e0; e0 += ca[0]; pa[1] = e0; e0 += ca[1]; pa[2] = e0; e0 += ca[2]; pa[3] = e0; e0 += ca[3];
    pb[0] = e0; e0 += cb[0]; pb[1] = e0; e0 += cb[1]; pb[2] = e0; e0 += cb[2]; pb[3] = e0;
    LDS_WAIT();
    *(u32x4*)(hist + 8 * j16) = pa; *(u32x4*)(hist + 8 * j16 + 4) = pb;
    LDS_WAIT();
#pragma unroll
    for (int i = 0; i < 8; ++i) {
      const unsigned pos = __hip_atomic_fetch_add(&hist[ids[i] >> 7], 1u, __ATOMIC_RELAXED, __HIP_MEMORY_SCOPE_WAVEFRONT);
      list[pos] = (u32x4){(unsigned)ids[i], __float_as_uint(su[i]), __float_as_uint(gts[i]), 0u};
    }
    LDS_WAIT();
  }
  const unsigned char* Ub = w_Ub(p) + 16 * j16;
  const unsigned char* Vb = w_Vb(p) + 16 * j16;
  {
    u32x4 uA[4], uB[4];
    u32x4 eA = list[0], eB = list[1];
#pragma unroll
    for (int i = 0; i < 4; ++i) uA[i] = *(const u32x4*)(Ub + (size_t)eA[0] * DM + 256 * i);
#pragma unroll
    for (int i = 0; i < 4; ++i) uB[i] = *(const u32x4*)(Ub + (size_t)eB[0] * DM + 256 * i);
#define PEER_USTEP(U, E, K)                                                                                            \
    {                                                                                                                  \
      const float su = __uint_as_float(E[1]), gsv = __uint_as_float(E[2]);                                             \
      int d0 = 0, d1 = 0;                                                                                              \
      d0 = dot16i(U[0], x[0], d0); d1 = dot16i(U[1], x[1], d1); d0 = dot16i(U[2], x[2], d0); d1 = dot16i(U[3], x[3], d1); \
      E = list[(K) + 2 < 128 ? (K) + 2 : 127];                       \
      _Pragma("unroll") for (int i = 0; i < 4; ++i) U[i] = *(const u32x4*)(Ub + (size_t)E[0] * DM + 256 * i);          \
      const float c = gsv * gelu_fast(su * (float)dpp_add16i(d0 + d1));                                                \
      if (j16 == 0) ((float*)&list[K])[3] = c;                                                                          \
    }
#pragma unroll 1
    for (int k = 0; k < 128; k += 2) {
      PEER_USTEP(uA, eA, k)
      PEER_USTEP(uB, eB, k + 1)
    }
  }
  LDS_WAIT();
  f32x2 acc[32];
#pragma unroll
  for (int i = 0; i < 32; ++i) acc[i] = (f32x2){0.f, 0.f};
  {
    u32x4 vA[4], vB[4];
    u32x4 eA = list[0], eB = list[1];
#pragma unroll
    for (int i = 0; i < 4; ++i) vA[i] = *(const u32x4*)(Vb + (size_t)eA[0] * DM + 256 * i);
#pragma unroll
    for (int i = 0; i < 4; ++i) vB[i] = *(const u32x4*)(Vb + (size_t)eB[0] * DM + 256 * i);
#define PEER_VSTEP(V, E, K)                                                                                            \
    {                                                                                                                  \
      const float c = __uint_as_float(E[3]);                                                                           \
      const f32x2 c2 = {c, c};                                                                                         \
      _Pragma("unroll") for (int i = 0; i < 4; ++i) axpy16p(acc + 8 * i, V[i], c2);                                    \
      E = list[(K) + 2 < 128 ? (K) + 2 : 127];                                                                         \
      _Pragma("unroll") for (int i = 0; i < 4; ++i) V[i] = *(const u32x4*)(Vb + (size_t)E[0] * DM + 256 * i);          \
    }
#pragma unroll 1
    for (int k = 0; k < 128; k += 2) {
      PEER_VSTEP(vA, eA, k)
      PEER_VSTEP(vB, eB, k + 1)
    }
  }
  const float* x1 = w_X1(p) + (size_t)token * DM + 16 * j16;
  const float* g2 = w_MOD(p) + (size_t)cond_row(token) * 6144 + 5120 + 16 * j16;
  float* y = p.out + O_YP + (size_t)token * DM + 16 * j16;
#pragma unroll
  for (int i = 0; i < 4; ++i)
#pragma unroll
    for (int mm = 0; mm < 4; ++mm) {
      const int c0 = 256 * i + 4 * mm;
      const f32x4 xv = *(const f32x4*)(x1 + c0), gv = *(const f32x4*)(g2 + c0);
      f32x4 yv;
#pragma unroll
      for (int j = 0; j < 4; ++j) yv[j] = xv[j] + gv[j] * acc[8 * i + 2 * mm + (j >> 1)][j & 1];
      *(f32x4*)(y + c0) = yv;
    }
}
DI void peer_token_block(const P& p, int token, char* smem) {
  const int t = threadIdx.x + opaque0(), lane = t & 63, w = t >> 6;
  float* red = (float*)smem;
  const u32x4 x8 = *(const u32x4*)(w_H8(p) + (size_t)token * DM + 16 * lane);
  const int myid = w_IDX(p)[(size_t)token * 128 + 32 * w + (lane & 31)];
  const float mysu = w_SU(p)[myid] * w_HS(p)[token];
  const float mygs = w_GATE(p)[(size_t)token * 128 + 32 * w + (lane & 31)] * w_SV(p)[myid];
  float o[16];
#pragma unroll
  for (int i = 0; i < 16; ++i) o[i] = 0.f;
#pragma unroll 1
  for (int e0 = 0; e0 < 32; e0 += 8) {
    u32x4 u8[8], v8[8];
#pragma unroll
    for (int qq = 0; qq < 8; ++qq) {
      const size_t ro = (size_t)__builtin_amdgcn_readlane(myid, e0 + qq) * DM + 16 * lane;
      u8[qq] = *(const u32x4*)(w_Ub(p) + ro); v8[qq] = *(const u32x4*)(w_Vb(p) + ro);
    }
#pragma unroll
    for (int hb = 0; hb < 2; ++hb) {
      float d[4];
#pragma unroll
      for (int qq = 0; qq < 4; ++qq) d[qq] = (float)dot16i(u8[4 * hb + qq], x8, 0);
      const float kv = reduce4(d, lane);
#pragma unroll
      for (int qq = 0; qq < 4; ++qq) {
        const int e = e0 + 4 * hb + qq;
        const float a = __int_as_float(__builtin_amdgcn_readlane(__float_as_int(kv), 16 * qq)) * __int_as_float(__builtin_amdgcn_readlane(__float_as_int(mysu), e));
        const float c = __int_as_float(__builtin_amdgcn_readlane(__float_as_int(mygs), e)) * gelu_fast(a);
        axpy16(o, v8[4 * hb + qq], c);
      }
    }
  }
  __syncthreads();
#pragma unroll
  for (int i = 0; i < 16; ++i) red[w * 1024 + 16 * lane + i] = o[i];
  __syncthreads();
  if (w == 0) {
    const float* x1 = w_X1(p) + (size_t)token * DM + 16 * lane;
    const float* g2 = w_MOD(p) + (size_t)cond_row(token) * 6144 + 5120 + 16 * lane;
    float* y = p.out + O_YP + (size_t)token * DM + 16 * lane;
#pragma unroll
    for (int mm = 0; mm < 4; ++mm) {
      const f32x4 xv = *(const f32x4*)(x1 + 4 * mm), gv = *(const f32x4*)(g2 + 4 * mm);
      f32x4 yv;
#pragma unroll
      for (int j = 0; j < 4; ++j) { const int c = 16 * lane + 4 * mm + j; yv[j] = xv[j] + gv[j] * (red[c] + red[1024 + c] + red[2048 + c] + red[3072 + c]); }
      *(f32x4*)(y + 4 * mm) = yv;
    }
  }
}

constexpr int NPHASE = 8;

#if defined(PROBE_ATTN) || defined(PROBE_SAMP)
DI int probe_token(int i) { return (i * 131 + 3) % NPR; }
DI float block_sum_p(float v, float* red) {
  __syncthreads();
  v = wave_sum(v);
  if ((threadIdx.x & 63) == 0) red[threadIdx.x >> 6] = v;
  __syncthreads();
  return red[0] + red[1] + red[2] + red[3];
}
DI float block_max_p(float v, float* red) {
  __syncthreads();
  for (int o = 32; o >= 1; o >>= 1) v = fmaxf(v, __shfl_xor(v, o));
  if ((threadIdx.x & 63) == 0) red[threadIdx.x >> 6] = v;
  __syncthreads();
  return fmaxf(fmaxf(red[0], red[1]), fmaxf(red[2], red[3]));
}
#endif
#ifdef PROBE_ATTN
DI void probe_attn(const P& p, int i, char* smem) {
  float* red = (float*)smem;
  float* pr = red + 4;
  float* attn = pr + 128;
  float* rr = attn + 1024;
  const int token = probe_token(i), b = token >> 11, pos = token & 2047, t = threadIdx.x;
  const bf16* prow = w_PROJ(p) + (size_t)token * INW;
  for (int head = 0; head < 16; ++head) {
    const int hk = head >> 3;
    float s = -INFINITY;
    const int kp = pos - 127 + (t & 127);
    if (t < 128 && kp >= 0) {
      float a = 0.f;
      const bf16* kr = w_PROJ(p) + ((size_t)b * SEQ + kp) * INW + C_K + hk * 64;
      for (int d = 0; d < 64; ++d) a += bf2f(prow[head * 64 + d]) * bf2f(kr[d]);
      s = a + w_BIAS(p)[head * 128 + (pos - kp)];
    }
    float m = block_max_p(s, red);
    m = fmaxf(m, p.sinks[head]);
    const float e = (t < 128 && kp >= 0) ? __expf(s - m) : 0.f;
    const float den = block_sum_p(e, red) + __expf(p.sinks[head] - m);
    if (t < 128) pr[t] = e / den;
    __syncthreads();
    if (t < 64) {
      float o = 0.f;
      for (int j = 0; j < 128; ++j) { const int kq = pos - 127 + j; if (kq >= 0) o += pr[j] * bf2f(w_VT(p)[((size_t)(b * 2 + hk) * 64 + t) * SEQ + kq]); }
      attn[head * 64 + t] = o;
    }
    __syncthreads();
  }
  for (int c = t; c < 512; c += 256) {
    const int g = c >> 7, win = 2 << g;
    float tot = 0.f;
    for (int j = 0; j < win; ++j) if (pos - j >= 0) tot += bf2f(w_PROJ(p)[((size_t)b * SEQ + pos - j) * INW + C_PIN + c]);
    const float cnt = (float)(win < pos + 1 ? win : pos + 1);
    rr[c] = bf2f((bf16)(tot / cnt - bf2f(prow[C_PIN + c])));
  }
  __syncthreads();
  for (int f = t; f < 1024; f += 256) {
    const int g = f >> 8;
    float pl = 0.f;
    for (int ch = 0; ch < 128; ++ch) pl += rr[g * 128 + ch] * bf2f(w_PWt(p)[((size_t)g * 256 + (f & 255)) * 128 + ch]);
    const float naive = bf2f(prow[C_GA + f]) * attn[f] + bf2f(prow[C_GB + f]) * (pl * p.pool_scale[f]);
    const float fast = bf2f(w_MIXED(p)[(size_t)token * DM + f]);
    p.out[O_KWP + (size_t)i * DM + f] += (float)(PROBE_ATTN) * (fast - naive);
  }
  __syncthreads();
}
#endif

#ifdef PROBE_SAMP
DI void probe_samp(const P& p, int b, char* smem) {
  float* red = (float*)smem;
  float* pr = red + 4;
  float* attn = pr + 128;
  float* rr = attn + 1024;
  const int t = threadIdx.x;
  const size_t token = (size_t)NPR + b;
  const bf16* prow = w_PROJ(p) + token * INW;
  for (int head = 0; head < 16; ++head) {
    const int hk = head >> 3;
    float s = -INFINITY;
    if (t < 128) {
      const float* kr = t < 127 ? p.cache_k + (((size_t)b * 128 + t + 1) * 2 + hk) * 64 : p.out + O_KWS + (((size_t)b * 128 + 127) * 2 + hk) * 64;
      float a = 0.f;
      for (int d = 0; d < 64; ++d) a += bf2f(prow[head * 64 + d]) * kr[d];
      s = a + p.rel_table[(127 - t < 16 ? 127 - t : min(31, 16 + (int)(logf((float)(127 - t) / 16.f) / logf(8.f) * 16.f))) * 16 + head];
    }
    float m = block_max_p(s, red);
    m = fmaxf(m, p.sinks[head]);
    const float e = t < 128 ? __expf(s - m) : 0.f;
    const float den = block_sum_p(e, red) + __expf(p.sinks[head] - m);
    if (t < 128) pr[t] = e / den;
    __syncthreads();
    if (t < 64) {
      float o = 0.f;
      for (int j = 0; j < 128; ++j) { const float* vr = j < 127 ? p.cache_v + (((size_t)b * 128 + j + 1) * 2 + hk) * 64 : p.out + O_VWS + (((size_t)b * 128 + 127) * 2 + hk) * 64; o += pr[j] * vr[t]; }
      attn[head * 64 + t] = o;
    }
    __syncthreads();
  }
  for (int c = t; c < 512; c += 256) {
    const int g = c >> 7, win = 2 << g;
    const float cur = p.out[O_PS + ((size_t)b * 15 + 14) * 512 + c];
    float tot = cur;
    for (int j = 1; j < win; ++j) tot += p.state_pool[((size_t)b * 15 + 15 - j) * 512 + c];
    rr[c] = tot / (float)win - cur;
  }
  __syncthreads();
  for (int f = t; f < 1024; f += 256) {
    const int g = f >> 8;
    float pl = 0.f;
    for (int ch = 0; ch < 128; ++ch) pl += rr[g * 128 + ch] * p.pool_w[((size_t)g * 128 + ch) * 256 + (f & 255)];
    const float naive = bf2f(prow[C_GA + f]) * attn[f] + bf2f(prow[C_GB + f]) * (pl * p.pool_scale[f]);
    const float fast = bf2f(w_MIXED(p)[token * DM + f]);
    p.out[O_KWP + (size_t)b * DM + f] += (float)(PROBE_SAMP) * (fast - naive);
  }
  __syncthreads();
}
#endif
template <class First, class Main, class Fill> DI void run_with_filler(int G, int bid, int nmain, int nfill, First firstf, Main mainf, Fill fillf) {
  if (bid < nmain) { __syncthreads(); firstf(bid); }
  for (int u = bid; u < nmain; u += G) mainf(u, u + G < nmain ? u + G : -1);
  const int rem = nmain % G;
  if (rem == 0) { for (int f = bid; f < nfill; f += G) fillf(f); }
  else if (bid >= rem) { for (int f = bid - rem; f < nfill; f += G - rem) fillf(f); }
}
template <int PH> DI void run_phase(const P& p, char* smem) {
  const int G = gridDim.x, bid = blockIdx.x, w = __builtin_amdgcn_readfirstlane(threadIdx.x >> 6);
  if constexpr (PH == 0) { run_with_filler(G, bid, U0_MOD, F0_TOTAL, [&](int) {}, [&](int u, int) { unit_mod(p, u, smem); }, [&](int f) { phase0_filler(p, f, smem); }); }
  if constexpr (PH == 1) { for (int tk = bid * 4 + w; tk < NTOK; tk += G * 4) norm_row(p, tk, 0); }
  if constexpr (PH == 2) {
    run_with_filler(G, bid, 129 * 30, F2_TOTAL, [&](int u) { gemm_first(w_Wt_in(p), w_H(p), 1024, (u % 30) * 128, (u / 30) * 128, smem); },
                    [&](int u, int un) { unit_gemm1(p, u, un, smem); }, [&](int f) { phase2_filler(p, f, smem); });
  }
  if constexpr (PH == 3) { for (int u = bid; u < 1024; u += G) unit_attn_prompt(p, u, smem);
                           for (int u = bid; u < 512; u += G) unit_attn_sample(p, u, smem); }
  if constexpr (PH == 4) {
    run_with_filler(G, bid, G2_UNITS, F4_TOTAL, [&](int u) { gemm2_first(p, u, smem); },
                    [&](int u, int un) { unit_gemm2(p, u, un, smem); }, [&](int f) { unit_convert(p.sub_keys, w_SK(p), f); });
  }
  if constexpr (PH == 5) { for (int tk = bid * 4 + w; tk < NTOK; tk += G * 4) norm_row(p, tk, 1); }
  if constexpr (PH == 6) {
    run_with_filler(G, bid, 129 * 8, F6_TOTAL, [&](int u) { int mt, hd; unit8_map(u, mt, hd); gemm_first(w_Wt_q(p), w_H(p), 1024, hd * 256, mt * 128, smem); },
                    [&](int u, int un) { unit_peer_route(p, u, un, smem); }, [&](int f) { if (f < F6_QU) unit_quant_rows<true>(p.peer_u, w_Ub(p), w_SU(p), f); else unit_quant_rows<false>(p.peer_v, w_Vb(p), w_SV(p), f - F6_QU); });
  }
  if constexpr (PH == 7) {
    for (int g = bid * 4 + w; g < NPR / 4; g += G * 4) peer_wave4(p, g, smem + w * PEER_WLDS);
    for (int s = bid; s < NS; s += G) peer_token_block(p, NPR + s, smem + 4 * PEER_WLDS);
  }
}
#if ONE_LAUNCH
__global__ void __launch_bounds__(NTHREADS, 2) mega(P p) {
  __shared__ __attribute__((aligned(16))) char smem[SMEM_BYTES + 16];
  volatile unsigned* st = (volatile unsigned*)(smem + SMEM_BYTES);
  if (threadIdx.x == 0) { st[0] = 0u; st[1] = 0u; }
  __syncthreads();
  const unsigned xcc = xb_xcc_id();
  if (threadIdx.x == 0) (void)xb_add(&w_bar(p)[XB_XCNT(xcc)], 1u);
#ifndef REPEAT_MASK
#define REPEAT_MASK 0
#endif
#define RUN_PH(k) do { run_phase<k>(p, smem); if ((REPEAT_MASK >> k) & 1) { xcd_barrier(w_bar(p), xcc, st); run_phase<k>(p, smem); } } while (0)
  RUN_PH(0); xcd_barrier(w_bar(p), xcc, st);
  RUN_PH(1); xcd_barrier(w_bar(p), xcc, st);
  RUN_PH(2); xcd_barrier(w_bar(p), xcc, st);
  RUN_PH(3); xcd_barrier(w_bar(p), xcc, st);
#ifdef PROBE_ATTN
  for (int i = blockIdx.x; i < 128; i += gridDim.x) probe_attn(p, i, smem);
  xcd_barrier(w_bar(p), xcc, st);
#endif
#ifdef PROBE_SAMP
  for (int i = blockIdx.x; i < 128; i += gridDim.x) probe_samp(p, i, smem);
  xcd_barrier(w_bar(p), xcc, st);
#endif
  RUN_PH(4); xcd_barrier(w_bar(p), xcc, st);
  RUN_PH(5); xcd_barrier(w_bar(p), xcc, st);
  RUN_PH(6); xcd_barrier(w_bar(p), xcc, st);
  RUN_PH(7);
}
#else
template <int PH> __global__ void __launch_bounds__(NTHREADS, 2) mega(P p) {
  __shared__ __attribute__((aligned(16))) char smem[SMEM_BYTES];
  run_phase<PH>(p, smem);
}
#endif


extern "C" void kernel_launch(void* const* d_in, const int* in_sizes, int n_in, void* d_out, int out_size, void* d_ws, size_t ws_size, hipStream_t stream) {
  P p{};
  const float* const* in = (const float* const*)d_in;
  p.x_prompt = in[0]; p.x_sample = in[1]; p.cache_k = in[2]; p.cache_v = in[3]; p.state_pool = in[4]; p.c_prompt = in[5]; p.c_sample = in[6];
  p.rel_table = in[7]; p.ada_w = in[8]; p.ada_b = in[9]; p.norm1_g = in[10]; p.w_in = in[11]; p.q_norm_g = in[12]; p.k_norm_g = in[13]; p.sinks = in[14];
  p.pool_w = in[15]; p.pool_scale = in[16]; p.w_out = in[17]; p.norm2_g = in[18]; p.w_query = in[19]; p.sub_keys = in[20]; p.peer_u = in[21]; p.peer_v = in[22];
  p.out = (float*)d_out;
  p.ws = (char*)d_ws;
  if (WS_NEED > ws_size) { fprintf(stderr, "workspace too small: need %zu have %zu\n", (size_t)WS_NEED, ws_size); return; }

  static int grid_blocks = 0;
  if (!grid_blocks) {
    int dev = 0, cus = 0, per_cu = 0;
    (void)hipGetDevice(&dev);
    (void)hipDeviceGetAttribute(&cus, hipDeviceAttributeMultiprocessorCount, dev);
#if ONE_LAUNCH
    (void)hipOccupancyMaxActiveBlocksPerMultiprocessor(&per_cu, mega, NTHREADS, 0);
#else
    per_cu = 2;
#endif
    if (per_cu > 2) per_cu = 2;
    if (per_cu < 1) per_cu = 1;
    if (cus < 1) cus = 256;
    grid_blocks = cus * per_cu;
  }
#if ONE_LAUNCH
  (void)hipMemsetAsync(p.ws + OFF_BAR, 0, XCD_BAR_WORDS * 4, stream);
  hipLaunchKernelGGL(mega, dim3(grid_blocks), dim3(NTHREADS), 0, stream, p);
#else
  hipLaunchKernelGGL(mega<0>, dim3(grid_blocks), dim3(NTHREADS), 0, stream, p);
  hipLaunchKernelGGL(mega<1>, dim3(grid_blocks), dim3(NTHREADS), 0, stream, p);
  hipLaunchKernelGGL(mega<2>, dim3(grid_blocks), dim3(NTHREADS), 0, stream, p);
  hipLaunchKernelGGL(mega<3>, dim3(grid_blocks), dim3(NTHREADS), 0, stream, p);
  hipLaunchKernelGGL(mega<4>, dim3(grid_blocks), dim3(NTHREADS), 0, stream, p);
  hipLaunchKernelGGL(mega<5>, dim3(grid_blocks), dim3(NTHREADS), 0, stream, p);
  hipLaunchKernelGGL(mega<6>, dim3(grid_blocks), dim3(NTHREADS), 0, stream, p);
  hipLaunchKernelGGL(mega<7>, dim3(grid_blocks), dim3(NTHREADS), 0, stream, p);
#endif

}
```

```cpp
#include <hip/hip_runtime.h>
#include <stdint.h>
#include <stdio.h>

#ifndef ONE_LAUNCH
#define ONE_LAUNCH 1
#endif

typedef __bf16 bf16;
typedef __bf16 bf16x2 __attribute__((ext_vector_type(2)));
typedef __bf16 bf16x4 __attribute__((ext_vector_type(4)));
typedef __bf16 bf16x8 __attribute__((ext_vector_type(8)));
typedef float f32x2 __attribute__((ext_vector_type(2)));
typedef float f32x4 __attribute__((ext_vector_type(4)));
typedef float f32x16 __attribute__((ext_vector_type(16)));
typedef unsigned u32x2 __attribute__((ext_vector_type(2)));
typedef unsigned u32x4 __attribute__((ext_vector_type(4)));

#define DI __device__ __forceinline__
#define MFMA(a, b, c) __builtin_amdgcn_mfma_f32_32x32x16_bf16((a), (b), (c), 0, 0, 0)

constexpr int DM = 1024, NB = 8, SEQ = 2048, NS = 128, NPR = NB * SEQ, NTOK = NPR + NS;
constexpr int INW = 3840, NMOD = NB + NS;
constexpr int C_K = 1024, C_V = 1152, C_PIN = 1280, C_GA = 1792, C_GB = 2816;
constexpr int NEXP = 16384;
constexpr float EPS = 1e-6f;
constexpr size_t O_YP = 0, O_KWP = 16908288, O_VWP = 17039360, O_PP = 17170432, O_KWS = 17231872, O_VWS = 19329024, O_PS = 21426176;

constexpr int SMEM_BYTES = 77824;
constexpr int NTHREADS = 256;

struct P {
  const float *x_prompt, *x_sample, *cache_k, *cache_v, *state_pool, *c_prompt, *c_sample, *rel_table, *ada_w, *ada_b, *norm1_g, *w_in,
      *q_norm_g, *k_norm_g, *sinks, *pool_w, *pool_scale, *w_out, *norm2_g, *w_query, *sub_keys, *peer_u, *peer_v;
  float* out;
  char* ws;
};
constexpr size_t al256(size_t x) { return (x + 255) & ~(size_t)255; }
constexpr size_t OFF_BAR = 0;
constexpr size_t OFF_WTIN = OFF_BAR + al256(4096 * 4);
constexpr size_t OFF_WTOUT = OFF_WTIN + al256((size_t)INW * 1024 * 2);
constexpr size_t OFF_WTQ = OFF_WTOUT + al256((size_t)1024 * 1024 * 2);
constexpr size_t OFF_SK = OFF_WTQ + al256((size_t)2048 * 1024 * 2);
constexpr size_t OFF_PWT = OFF_SK + al256((size_t)16 * 128 * 128 * 2);
constexpr size_t OFF_UB = OFF_PWT + al256((size_t)4 * 256 * 128 * 2);
constexpr size_t OFF_VB = OFF_UB + al256((size_t)NEXP * DM);
constexpr size_t OFF_SU = OFF_VB + al256((size_t)NEXP * DM);
constexpr size_t OFF_SV = OFF_SU + al256((size_t)NEXP * 4);
constexpr size_t OFF_H8 = OFF_SV + al256((size_t)NEXP * 4);
constexpr size_t OFF_HS = OFF_H8 + al256((size_t)NTOK * DM);
constexpr size_t OFF_PART = OFF_HS + al256((size_t)NTOK * 4);
constexpr size_t OFF_MOD = OFF_PART + al256((size_t)4 * NS * DM * 4);
constexpr size_t OFF_BIAS = OFF_MOD + al256((size_t)NMOD * 6144 * 4);
constexpr size_t OFF_VT = OFF_BIAS + al256(16 * 128 * 4);
constexpr size_t OFF_H = OFF_VT + al256((size_t)NB * 128 * SEQ * 2);
constexpr size_t OFF_MIXED = OFF_H;
constexpr size_t OFF_PROJ = OFF_H + al256((size_t)NTOK * DM * 2);
constexpr size_t OFF_X1 = OFF_PROJ;
constexpr size_t OFF_IDX = OFF_X1 + (size_t)NTOK * DM * 4;
constexpr size_t OFF_GATE = OFF_IDX + (size_t)NTOK * 128 * 4;
constexpr size_t WS_NEED = OFF_PROJ + al256((size_t)NTOK * INW * 2);
static_assert(OFF_GATE + (size_t)NTOK * 128 * 4 <= WS_NEED, "overlay fits");
static_assert(WS_NEED <= (size_t)256 * 1024 * 1024, "workspace budget");
#define WS_PTR(T, name, OFF) __device__ __forceinline__ T* name(const P& p) { return (T*)(p.ws + (OFF)); }
WS_PTR(unsigned, w_bar, OFF_BAR) WS_PTR(bf16, w_Wt_in, OFF_WTIN) WS_PTR(bf16, w_Wt_out, OFF_WTOUT) WS_PTR(bf16, w_Wt_q, OFF_WTQ) WS_PTR(bf16, w_SK, OFF_SK)
WS_PTR(bf16, w_PWt, OFF_PWT) WS_PTR(unsigned char, w_Ub, OFF_UB) WS_PTR(unsigned char, w_Vb, OFF_VB) WS_PTR(float, w_SU, OFF_SU) WS_PTR(float, w_SV, OFF_SV) WS_PTR(unsigned char, w_H8, OFF_H8) WS_PTR(float, w_HS, OFF_HS) WS_PTR(float, w_PART, OFF_PART) WS_PTR(float, w_MOD, OFF_MOD) WS_PTR(float, w_BIAS, OFF_BIAS)
WS_PTR(bf16, w_VT, OFF_VT) WS_PTR(bf16, w_H, OFF_H) WS_PTR(bf16, w_MIXED, OFF_MIXED) WS_PTR(bf16, w_PROJ, OFF_PROJ) WS_PTR(float, w_X1, OFF_X1)
WS_PTR(int, w_IDX, OFF_IDX) WS_PTR(float, w_GATE, OFF_GATE)

DI int cond_row(int token) { return token < NPR ? (token >> 11) : (NB + token - NPR); }
DI int crow(int reg, int h) { return (reg & 3) + 8 * (reg >> 2) + 4 * h; }
DI const float* xrow(const P& p, int token) { return token < NPR ? p.x_prompt + (size_t)token * DM : p.x_sample + (size_t)(token - NPR) * DM; }

#define LDS_WAIT() asm volatile("s_waitcnt lgkmcnt(0)" ::: "memory")
DI int opaque0() { int z = 0; asm volatile("" : "+v"(z)); return z; }
DI float bf2f(bf16 v) { return (float)v; }
DI f32x16 zero16() { f32x16 z; for (int i = 0; i < 16; ++i) z[i] = 0.f; return z; }
DI bf16x8 pack_step(const f32x16& x, int s) { bf16x8 v; for (int j = 0; j < 8; ++j) v[j] = (bf16)x[8 * s + j]; return v; }
DI bf16x8 cat4(bf16x4 lo, bf16x4 hi) { return __builtin_shufflevector(lo, hi, 0, 1, 2, 3, 4, 5, 6, 7); }
DI float wave_sum(float v) { for (int o = 32; o >= 1; o >>= 1) v += __shfl_xor(v, o); return v; }

#define XB_TMO 128
#define XB_XCNT(j) (256 + 64 * (j))
#define XB_XSUB(j) (1280 + 64 * (j))
#define XB_XGEN(j) (2304 + 64 * (j))
#define XB_TOP 3328
#define XB_TOPGEN 3392
#define XCD_BAR_WORDS 3456
#define XB_SPIN_CAP (1u << 22)
DI unsigned xb_ld(unsigned* p) { return __hip_atomic_load(p, __ATOMIC_RELAXED, __HIP_MEMORY_SCOPE_AGENT); }
DI unsigned xb_add(unsigned* p, unsigned v) { return __hip_atomic_fetch_add(p, v, __ATOMIC_RELAXED, __HIP_MEMORY_SCOPE_AGENT); }
DI unsigned xb_xcc_id() { return (unsigned)__builtin_amdgcn_s_getreg((3 << 11) | 20) & 0xFu; }
#define XB_SPIN(cond, bar) do { unsigned _sp = 0; while (cond) { __builtin_amdgcn_s_sleep(1); \
    if ((++_sp & 255u) == 0u) { if (xb_ld(&(bar)[XB_TMO])) break; if (_sp > XB_SPIN_CAP) { atomicAdd(&(bar)[XB_TMO], 1u); break; } } } } while (0)

DI void xcd_barrier_complete(unsigned* bar, unsigned x, unsigned& nloc, unsigned& nx) {
  const unsigned G = gridDim.x;
  unsigned sum, cnt, mine, sp = 0u;
  for (;;) {
    sum = 0u; cnt = 0u; mine = 0u;
#pragma unroll
    for (unsigned j = 0; j < 16; ++j) { const unsigned c = xb_ld(&bar[XB_XCNT(j)]); sum += c; cnt += (c > 0u) ? 1u : 0u; mine = (j == x) ? c : mine; }
    if (sum == G) break;
    __builtin_amdgcn_s_sleep(1);
    if ((++sp & 255u) == 0u) { if (xb_ld(&bar[XB_TMO])) break; if (sp > XB_SPIN_CAP) { atomicAdd(&bar[XB_TMO], 1u); break; } }
  }
  nloc = mine > 0u ? mine : 1u; nx = cnt > 0u ? cnt : 1u;
}
DI void xcd_barrier(unsigned* bar, unsigned x, volatile unsigned* st) {
  asm volatile("s_waitcnt vmcnt(0)" ::: "memory");
  __syncthreads();
  if (threadIdx.x == 0) {
    __builtin_amdgcn_s_waitcnt(0);
    unsigned nloc = st[0], nx = st[1];
    if (nloc == 0u) { xcd_barrier_complete(bar, x, nloc, nx); st[0] = nloc; st[1] = nx; }
    const unsigned old = xb_add(&bar[XB_XSUB(x)], 1u);
    const unsigned gen = old / nloc;
    if (old + 1u == (gen + 1u) * nloc) {
      __builtin_amdgcn_fence(__ATOMIC_RELEASE, "agent");
      asm volatile("s_waitcnt vmcnt(0)" ::: "memory");
      const unsigned og = xb_add(&bar[XB_TOP], 1u);
      const unsigned tg = og / nx;
      if (og + 1u == (tg + 1u) * nx) xb_add(&bar[XB_TOPGEN], 1u);
      else XB_SPIN(xb_ld(&bar[XB_TOPGEN]) == tg, bar);
      xb_add(&bar[XB_XGEN(x)], 1u);
      __builtin_amdgcn_fence(__ATOMIC_ACQUIRE, "agent");
      asm volatile("s_waitcnt vmcnt(0)" ::: "memory");
    } else {
      XB_SPIN(xb_ld(&bar[XB_XGEN(x)]) == gen, bar);
      __builtin_amdgcn_fence(__ATOMIC_ACQUIRE, "agent");
      asm volatile("s_waitcnt vmcnt(0)" ::: "memory");
    }
  }
  __syncthreads();
}

constexpr int U0_MOD = 192;
constexpr int U0_TIN = (1024 / 64) * (INW / 64);
constexpr int F0_TOTAL = U0_TIN + 1;
constexpr int U0_TPW = 4 * 2 * 4;
constexpr int U0_CSK = 32;
constexpr int U0_KW = 128, U0_VW = 128, U0_PW = 128;
constexpr int F2_TOUT = 16 * 16, F2_TQ = 16 * 32, F2_E1 = F2_TOUT + F2_TQ, F2_E2 = F2_E1 + U0_TPW, F2_E3 = F2_E2 + U0_KW, F2_E4 = F2_E3 + U0_VW,
              F2_TOTAL = F2_E4 + U0_PW;
constexpr int F4_TOTAL = U0_CSK;
constexpr int F6_QU = 2048, F6_QV = 2048, F6_TOTAL = F6_QU + F6_QV;

DI float silu_f(float x) { return x * __builtin_amdgcn_rcpf(1.f + __expf(-x)); }

DI void unit_mod(const P& p, int u, char* smem) {
  const int t = threadIdx.x + opaque0(), lane = t & 63, w = t >> 6, r = lane & 31, h = lane >> 5;
  const int f0 = u * 32;
  f32x16 acc[5];
#pragma unroll
  for (int i = 0; i < 5; ++i) acc[i] = zero16();
  const float* wp = p.ada_w + (size_t)(w * 256 + 8 * h) * 6144 + f0 + r;
  const float* cp[5];
#pragma unroll
  for (int i = 0; i < 5; ++i) { const int m = 32 * i + r, mm = m < NMOD ? m : 0; cp[i] = (mm < NB ? p.c_prompt + (size_t)mm * DM : p.c_sample + (size_t)(mm - NB) * DM) + w * 256 + 8 * h; }
  float wv[8]; f32x4 cv[5][2];
#pragma unroll
  for (int j = 0; j < 8; ++j) wv[j] = wp[(size_t)j * 6144];
#pragma unroll
  for (int i = 0; i < 5; ++i) { cv[i][0] = *(const f32x4*)cp[i]; cv[i][1] = *(const f32x4*)(cp[i] + 4); }
#pragma unroll 1
  for (int ks = 0; ks < 16; ++ks) {
    bf16x8 bfr, afr[5];
#pragma unroll
    for (int j = 0; j < 8; ++j) bfr[j] = (bf16)wv[j];
#pragma unroll
    for (int i = 0; i < 5; ++i) {
      const bool ok = 32 * i + r < NMOD;
#pragma unroll
      for (int j = 0; j < 8; ++j) afr[i][j] = (bf16)(ok ? silu_f(cv[i][j >> 2][j & 3]) : 0.f);
    }
    const int kn = ks + 1 < 16 ? ks + 1 : 15;
#pragma unroll
    for (int j = 0; j < 8; ++j) wv[j] = wp[(size_t)(kn * 16 + j) * 6144];
#pragma unroll
    for (int i = 0; i < 5; ++i) { cv[i][0] = *(const f32x4*)(cp[i] + kn * 16); cv[i][1] = *(const f32x4*)(cp[i] + kn * 16 + 4); }
#pragma unroll
    for (int i = 0; i < 5; ++i) acc[i] = MFMA(afr[i], bfr, acc[i]);
  }
  float* red = (float*)smem;
  __syncthreads();
  if (w > 0) {
#pragma unroll
    for (int i = 0; i < 5; ++i)
#pragma unroll
      for (int j = 0; j < 16; ++j) red[((w - 1) * 80 + i * 16 + j) * 64 + lane] = acc[i][j];
  }
  __syncthreads();
  if (w == 0) {
    const float bias = p.ada_b[f0 + r];
#pragma unroll
    for (int i = 0; i < 5; ++i)
#pragma unroll
      for (int j = 0; j < 16; ++j) {
        const int m = 32 * i + crow(j, h);
        const float v = acc[i][j] + red[(0 * 80 + i * 16 + j) * 64 + lane] + red[(1 * 80 + i * 16 + j) * 64 + lane] + red[(2 * 80 + i * 16 + j) * 64 + lane] + bias;
        if (m < NMOD) w_MOD(p)[(size_t)m * 6144 + f0 + r] = v;
      }
  }
}

DI void unit_transpose(const float* __restrict__ src, bf16* __restrict__ dst, int R, int C, int tr, int tc, char* smem) {
  float* tile = (float*)smem;
  const int t = threadIdx.x + opaque0();
  __syncthreads();
#pragma unroll
  for (int i = 0; i < 4; ++i) {
    const int rr = (t >> 4) + 16 * i, cc = (t & 15) * 4;
    const f32x4 v = *(const f32x4*)(src + (size_t)(tr * 64 + rr) * C + tc * 64 + cc);
    tile[rr * 65 + cc] = v[0]; tile[rr * 65 + cc + 1] = v[1]; tile[rr * 65 + cc + 2] = v[2]; tile[rr * 65 + cc + 3] = v[3];
  }
  __syncthreads();
#pragma unroll
  for (int i = 0; i < 2; ++i) {
    const int orow = (t >> 3) + 32 * i, seg = (t & 7) * 8;
    bf16x8 v;
#pragma unroll
    for (int j = 0; j < 8; ++j) v[j] = (bf16)tile[(seg + j) * 65 + orow];
    *(bf16x8*)(dst + (size_t)(tc * 64 + orow) * R + tr * 64 + seg) = v;
  }
}
DI void unit_convert(const float* __restrict__ src, bf16* __restrict__ dst, int u) {
  const size_t base = (size_t)u * 8192 + (threadIdx.x + opaque0()) * 8;
#pragma unroll
  for (int i = 0; i < 4; ++i) {
    const size_t o = base + (size_t)i * 2048;
    const f32x4 a = *(const f32x4*)(src + o), b = *(const f32x4*)(src + o + 4);
    bf16x8 v; v[0] = (bf16)a[0]; v[1] = (bf16)a[1]; v[2] = (bf16)a[2]; v[3] = (bf16)a[3]; v[4] = (bf16)b[0]; v[5] = (bf16)b[1]; v[6] = (bf16)b[2]; v[7] = (bf16)b[3];
    *(bf16x8*)(dst + o) = v;
  }
}
DI unsigned pack_i8(float a, float b, float c, float d) {
  const int ia = max(-127, min(127, __float2int_rn(a))), ib = max(-127, min(127, __float2int_rn(b))), ic = max(-127, min(127, __float2int_rn(c))), id = max(-127, min(127, __float2int_rn(d)));
  return (unsigned)(ia & 255) | ((unsigned)(ib & 255) << 8) | ((unsigned)(ic & 255) << 16) | ((unsigned)(id & 255) << 24);
}
template <bool I8>
DI void unit_quant_rows(const float* __restrict__ src, unsigned char* __restrict__ dst, float* __restrict__ scale, int u) {
  const int t = threadIdx.x + opaque0(), lane = t & 63, w = t >> 6;
#pragma unroll
  for (int rr = 0; rr < 2; ++rr) {
    const size_t row = (size_t)u * 8 + 2 * w + rr;
    const float* s = src + row * DM + 16 * lane;
    f32x4 v[4];
    float amax = 0.f;
#pragma unroll
    for (int i = 0; i < 4; ++i) { v[i] = *(const f32x4*)(s + 4 * i); amax = fmaxf(amax, fmaxf(fmaxf(fabsf(v[i][0]), fabsf(v[i][1])), fmaxf(fabsf(v[i][2]), fabsf(v[i][3])))); }
#pragma unroll
    for (int o = 32; o >= 1; o >>= 1) amax = fmaxf(amax, __shfl_xor(amax, o));
    const float sc = amax > 0.f ? amax * (I8 ? 1.f / 127.f : 1.f / 440.f) : 1.f, inv = 1.f / sc;
    u32x4 q;
#pragma unroll
    for (int i = 0; i < 4; ++i) {
      if (I8) {
        q[i] = pack_i8(v[i][0] * inv, v[i][1] * inv, v[i][2] * inv, v[i][3] * inv);
      } else {
        int wd = 0;
        wd = __builtin_amdgcn_cvt_pk_fp8_f32(v[i][0] * inv, v[i][1] * inv, wd, false);
        wd = __builtin_amdgcn_cvt_pk_fp8_f32(v[i][2] * inv, v[i][3] * inv, wd, true);
        q[i] = (unsigned)wd;
      }
    }
    *(u32x4*)(dst + row * DM + 16 * lane) = q;
    if (lane == 0) scale[row] = sc;
  }
}
DI void unit_copy_f4(const float* __restrict__ src, float* __restrict__ dst, int n4) {
  for (int i = threadIdx.x + opaque0(); i < n4; i += NTHREADS) ((f32x4*)dst)[i] = ((const f32x4*)src)[i];
}

DI void phase0_filler(const P& p, int f, char* smem) {
  if (f < U0_TIN) { unit_transpose(p.w_in, w_Wt_in(p), 1024, INW, f / 60, f % 60, smem); }
  else {
    for (int i = threadIdx.x + opaque0(); i < 16 * 128; i += NTHREADS) {
      const int head = i >> 7, d = i & 127;
      int bk = d;
      if (d >= 16) { bk = 16 + (int)(logf((float)d / 16.f) / logf(8.f) * 16.f); bk = bk > 31 ? 31 : bk; }
      w_BIAS(p)[i] = p.rel_table[bk * 16 + head];
    }
  }
}
DI void phase2_filler(const P& p, int f, char* smem) {
  if (f < F2_TOUT) unit_transpose(p.w_out, w_Wt_out(p), 1024, 1024, f / 16, f % 16, smem);
  else if (f < F2_E1) { const int v = f - F2_TOUT; unit_transpose(p.w_query, w_Wt_q(p), 1024, 2048, v / 32, v % 32, smem); }
  else if (f < F2_E2) { const int v = f - F2_E1, g = v >> 3, tt = v & 7; unit_transpose(p.pool_w + (size_t)g * 128 * 256, w_PWt(p) + (size_t)g * 256 * 128, 128, 256, tt >> 2, tt & 3, smem); }
  else if (f < F2_E3) { const int b = f - F2_E2; unit_copy_f4(p.cache_k + ((size_t)b * 128 + 1) * 128, p.out + O_KWS + (size_t)b * 128 * 128, 127 * 128 / 4); }
  else if (f < F2_E4) { const int b = f - F2_E3; unit_copy_f4(p.cache_v + ((size_t)b * 128 + 1) * 128, p.out + O_VWS + (size_t)b * 128 * 128, 127 * 128 / 4); }
  else { const int b = f - F2_E4; unit_copy_f4(p.state_pool + ((size_t)b * 15 + 1) * 512, p.out + O_PS + (size_t)b * 15 * 512, 14 * 512 / 4); }
}

DI void norm_row(const P& p, int token, int which) {
  const int lane = (threadIdx.x + opaque0()) & 63;
  const float* src = which == 0 ? xrow(p, token) : w_X1(p) + (size_t)token * DM;
  const float* g = which == 0 ? p.norm1_g : p.norm2_g;
  const float* mod = w_MOD(p) + (size_t)cond_row(token) * 6144 + (which == 0 ? 0 : 3072);
  f32x4 v[4];
  float ss = 0.f;
  if (which == 1 && token >= NPR) {
    const float* g1 = w_MOD(p) + (size_t)cond_row(token) * 6144 + 2048;
#pragma unroll
    for (int i = 0; i < 4; ++i) {
      const int c = 4 * lane + 256 * i;
      const size_t po = (size_t)(token - NPR) * DM + c;
      const f32x4 xv = *(const f32x4*)(xrow(p, token) + c), gv = *(const f32x4*)(g1 + c);
      const f32x4 pa = *(const f32x4*)(w_PART(p) + po), pb = *(const f32x4*)(w_PART(p) + (size_t)NS * DM + po), pc = *(const f32x4*)(w_PART(p) + (size_t)2 * NS * DM + po), pd = *(const f32x4*)(w_PART(p) + (size_t)3 * NS * DM + po);
#pragma unroll
      for (int j = 0; j < 4; ++j) v[i][j] = xv[j] + gv[j] * ((pa[j] + pb[j]) + (pc[j] + pd[j]));
      *(f32x4*)(w_X1(p) + (size_t)token * DM + c) = v[i];
      ss += v[i][0] * v[i][0] + v[i][1] * v[i][1] + v[i][2] * v[i][2] + v[i][3] * v[i][3];
    }
  } else {
#pragma unroll
  for (int i = 0; i < 4; ++i) { v[i] = *(const f32x4*)(src + 4 * lane + 256 * i); ss += v[i][0] * v[i][0] + v[i][1] * v[i][1] + v[i][2] * v[i][2] + v[i][3] * v[i][3]; }
  }
  ss = wave_sum(ss);
  const float rstd = rsqrtf(ss * (1.f / DM) + EPS);
#pragma unroll
  for (int i = 0; i < 4; ++i) {
    const int c = 4 * lane + 256 * i;
    const f32x4 gg = *(const f32x4*)(g + c), sh = *(const f32x4*)(mod + c), sc = *(const f32x4*)(mod + 1024 + c);
    bf16x4 o;
#pragma unroll
    for (int j = 0; j < 4; ++j) { v[i][j] = (v[i][j] * rstd * gg[j]) * (1.f + sc[j]) + sh[j]; o[j] = (bf16)v[i][j]; }
    *(bf16x4*)(w_H(p) + (size_t)token * DM + c) = o;
  }
  if (which == 1) {
    float amax = 0.f;
#pragma unroll
    for (int i = 0; i < 4; ++i) amax = fmaxf(amax, fmaxf(fmaxf(fabsf(v[i][0]), fabsf(v[i][1])), fmaxf(fabsf(v[i][2]), fabsf(v[i][3]))));
#pragma unroll
    for (int o = 32; o >= 1; o >>= 1) amax = fmaxf(amax, __shfl_xor(amax, o));
    const float qs = amax > 0.f ? amax * (1.f / 127.f) : 1.f, inv = 1.f / qs;
#pragma unroll
    for (int i = 0; i < 4; ++i) *(unsigned*)(w_H8(p) + (size_t)token * DM + 4 * lane + 256 * i) = pack_i8(v[i][0] * inv, v[i][1] * inv, v[i][2] * inv, v[i][3] * inv);
    if (lane == 0) w_HS(p)[token] = qs;
  }
}

constexpr int LDSK = 72;
constexpr int GT = 128 * 64 * 2;
constexpr int GBUF = 2 * GT;
typedef __attribute__((address_space(3))) unsigned lds_u32;
typedef const __attribute__((address_space(1))) unsigned glb_u32;
DI void glds16(const void* g, char* l) { __builtin_amdgcn_global_load_lds((glb_u32*)g, (lds_u32*)l, 16, 0, 0); }
DI void gemm_first(const bf16* __restrict__ Wt, const bf16* __restrict__ X, int ld, int n0, int m0, char* smem) {
  const int t = threadIdx.x + opaque0(), lane = t & 63;
  const int w = __builtin_amdgcn_readfirstlane(t >> 6);
  const int swz = (lane & 7) ^ ((4 * w + (lane >> 4)) & 7);
  const bf16* ga = Wt + (size_t)(n0 + 8 * w + (lane >> 3)) * ld + swz * 8;
  const bf16* gb = X + (size_t)(m0 + 8 * w + (lane >> 3)) * ld + swz * 8;
#pragma unroll
  for (int q = 0; q < 4; ++q) { glds16(ga + (size_t)(32 * q) * ld, smem + 1024 * (w + 4 * q)); glds16(gb + (size_t)(32 * q) * ld, smem + GT + 1024 * (w + 4 * q)); }
}
DI void gemm_main(const bf16* __restrict__ Wt, const bf16* __restrict__ X, int ld, int K, int n0, int m0, char* smem, f32x16 (&acc)[4]) {
  const int t = threadIdx.x + opaque0(), lane = t & 63, r = lane & 31, h = lane >> 5;
  const int w = __builtin_amdgcn_readfirstlane(t >> 6);
#pragma unroll
  for (int i = 0; i < 4; ++i) acc[i] = zero16();
  const int swz = (lane & 7) ^ ((4 * w + (lane >> 4)) & 7);
  const bf16* ga = Wt + (size_t)(n0 + 8 * w + (lane >> 3)) * ld + swz * 8;
  const bf16* gb = X + (size_t)(m0 + 8 * w + (lane >> 3)) * ld + swz * 8;
  const int sw = (r >> 1) & 7;
  const int KT = K >> 6;
  asm volatile("s_waitcnt vmcnt(0)" ::: "memory");
  __syncthreads();
  for (int kt = 0; kt < KT; ++kt) {
    const char* As = smem + (kt & 1) * GBUF;
    const char* Bs = As + GT;
    if (kt + 1 < KT) {
      char* An = smem + ((kt + 1) & 1) * GBUF;
      const int k0 = (kt + 1) * 64;
#pragma unroll
      for (int q = 0; q < 4; ++q) { glds16(ga + (size_t)(32 * q) * ld + k0, An + 1024 * (w + 4 * q)); glds16(gb + (size_t)(32 * q) * ld + k0, An + GT + 1024 * (w + 4 * q)); }
    }
#pragma unroll
    for (int s = 0; s < 4; ++s) {
      const int co = ((2 * s + h) ^ sw) * 16;
      const bf16x8 bfr = *(const bf16x8*)(Bs + (32 * w + r) * 128 + co);
#pragma unroll
      for (int i = 0; i < 4; ++i) {
        const bf16x8 afr = *(const bf16x8*)(As + (32 * i + r) * 128 + co);
        acc[i] = MFMA(afr, bfr, acc[i]);
      }
    }
    asm volatile("s_waitcnt vmcnt(0)" ::: "memory");
    __syncthreads();
  }
}

DI float sigmoid_f(float x) { return __builtin_amdgcn_rcpf(1.f + __expf(-x)); }

DI void unit_gemm1(const P& p, int u, int un, char* smem) {
  const int mt = u / 30, nt = u % 30;
  const int n0 = nt * 128, m0 = mt * 128;
  f32x16 acc[4];
  gemm_main(w_Wt_in(p), w_H(p), 1024, 1024, n0, m0, smem, acc);
  if (un >= 0) gemm_first(w_Wt_in(p), w_H(p), 1024, (un % 30) * 128, (un / 30) * 128, smem);
  const int tz = threadIdx.x + opaque0();
  const int lane = tz & 63, w = tz >> 6, r = lane & 31, h = lane >> 5;
  const int token = m0 + 32 * w + r;
  bf16* tw = (bf16*)(smem + GBUF + (tz >> 6) * 8704) + r * 136;
  const bool is_prompt = token < NPR;
  const int b = is_prompt ? (token >> 11) : (token - NPR), pos = token & (SEQ - 1);
  if (n0 < C_V) {
    const float* gn = n0 < C_K ? p.q_norm_g : p.k_norm_g;
    const float post = n0 < C_K ? 0.125f : 1.f;
#pragma unroll
    for (int hh = 0; hh < 2; ++hh) {
      float ss = 0.f;
#pragma unroll
      for (int i = 0; i < 2; ++i)
#pragma unroll
        for (int j = 0; j < 16; ++j) ss += acc[2 * hh + i][j] * acc[2 * hh + i][j];
      ss += __shfl_xor(ss, 32);
      const float rstd = rsqrtf(ss * (1.f / 64.f) + EPS);
#pragma unroll
      for (int i = 0; i < 2; ++i)
#pragma unroll
        for (int q4 = 0; q4 < 4; ++q4) {
          const int d = 32 * i + 8 * q4 + 4 * h;
          const f32x4 gg = *(const f32x4*)(gn + d);
          f32x4 v;
#pragma unroll
          for (int j = 0; j < 4; ++j) v[j] = acc[2 * hh + i][4 * q4 + j] * rstd * gg[j];
          bf16x4 o;
#pragma unroll
          for (int j = 0; j < 4; ++j) o[j] = (bf16)(v[j] * post);
          *(bf16x4*)(tw + 64 * hh + d) = o;
          if (n0 == C_K) {
            if (is_prompt) { if (pos >= SEQ - 128) *(f32x4*)(p.out + O_KWP + ((size_t)b * 128 + (pos - (SEQ - 128))) * 128 + 64 * hh + d) = v; }
            else *(f32x4*)(p.out + O_KWS + ((size_t)b * 128 + 127) * 128 + 64 * hh + d) = v;
          }
        }
    }
  } else if (n0 == C_V) {
#pragma unroll
    for (int i = 0; i < 4; ++i)
#pragma unroll
      for (int q4 = 0; q4 < 4; ++q4) {
        const int f = 32 * i + 8 * q4 + 4 * h;
        f32x4 v;
#pragma unroll
        for (int j = 0; j < 4; ++j) v[j] = acc[i][4 * q4 + j];
        if (is_prompt) {
#pragma unroll
          for (int j = 0; j < 4; ++j) w_VT(p)[((size_t)b * 128 + f + j) * SEQ + pos] = (bf16)v[j];
          if (pos >= SEQ - 128) *(f32x4*)(p.out + O_VWP + ((size_t)b * 128 + (pos - (SEQ - 128))) * 128 + f) = v;
        } else *(f32x4*)(p.out + O_VWS + ((size_t)b * 128 + 127) * 128 + f) = v;
      }
  } else if (n0 < C_GA) {
#pragma unroll
    for (int i = 0; i < 4; ++i)
#pragma unroll
      for (int q4 = 0; q4 < 4; ++q4) {
        const int f = n0 + 32 * i + 8 * q4 + 4 * h;
        f32x4 v; bf16x4 o;
#pragma unroll
        for (int j = 0; j < 4; ++j) { v[j] = acc[i][4 * q4 + j]; o[j] = (bf16)v[j]; }
        *(bf16x4*)(tw + (f - n0)) = o;
        if (is_prompt) { if (pos >= SEQ - 15) *(f32x4*)(p.out + O_PP + ((size_t)b * 15 + (pos - (SEQ - 15))) * 512 + (f - C_PIN)) = v; }
        else *(f32x4*)(p.out + O_PS + ((size_t)b * 15 + 14) * 512 + (f - C_PIN)) = v;
      }
  } else {
#pragma unroll
    for (int i = 0; i < 4; ++i)
#pragma unroll
      for (int q4 = 0; q4 < 4; ++q4) {
        const int f = n0 + 32 * i + 8 * q4 + 4 * h;
        bf16x4 o;
#pragma unroll
        for (int j = 0; j < 4; ++j) o[j] = (bf16)sigmoid_f(acc[i][4 * q4 + j]);
        *(bf16x4*)(tw + (f - n0)) = o;
      }
  }
  if (n0 != C_V) {
    LDS_WAIT();
    const bf16* tr = (const bf16*)(smem + GBUF + (tz >> 6) * 8704);
    bf16* pg = w_PROJ(p) + (size_t)(m0 + 32 * w + (lane >> 4)) * INW + n0 + (lane & 15) * 8;
#pragma unroll
    for (int it = 0; it < 8; ++it) *(u32x4*)(pg + (size_t)(4 * it) * INW) = *(const u32x4*)(tr + ((lane >> 4) + 4 * it) * 136 + (lane & 15) * 8);
  }
}

constexpr int VTS = 260;
constexpr int RS = 136;
DI void attn_head(const P& p, int head, int blk, int w, int r, int h, const bf16x8 (&qf)[4], const bf16* Ks, const bf16* VTs, const float* bsh, bf16x8 (&ob)[4]) {
  const int qi = 32 * w + r;
  f32x16 st[5];
#pragma unroll
  for (int tt = 0; tt < 5; ++tt) {
    st[tt] = zero16();
#pragma unroll
    for (int s = 0; s < 4; ++s) {
      const bf16x8 a = *(const bf16x8*)(Ks + (32 * (w + tt) + r) * LDSK + 16 * s + 8 * h);
      st[tt] = MFMA(a, qf[s], st[tt]);
    }
  }
  const float sink = p.sinks[head];
  float m = -INFINITY;
  {
    const int x = 31 - r + 4 * h;
    const float* bl = bsh + x;
#pragma unroll
    for (int tt = 0; tt < 5; ++tt)
#pragma unroll
      for (int j = 0; j < 16; ++j) {
        const int c = 32 * tt + (j & 3) + 8 * (j >> 2);
        const float s = st[tt][j] + bl[c];
        st[tt][j] = s;
        m = fmaxf(m, s);
      }
    if (blk == 0) {
      m = -INFINITY;
#pragma unroll
      for (int tt = 0; tt < 5; ++tt)
#pragma unroll
        for (int j = 0; j < 16; ++j) {
          const int c = 32 * tt + (j & 3) + 8 * (j >> 2);
          const float s = (159 - (x + c) > qi) ? -INFINITY : st[tt][j];
          st[tt][j] = s;
          m = fmaxf(m, s);
        }
    }
  }
  m = fmaxf(m, __shfl_xor(m, 32));
  m = fmaxf(m, sink);
  float sum = 0.f;
#pragma unroll
  for (int tt = 0; tt < 5; ++tt)
#pragma unroll
    for (int j = 0; j < 16; ++j) { const float e = __expf(st[tt][j] - m); st[tt][j] = e; sum += e; }
  sum += __shfl_xor(sum, 32);
  const float inv = 1.f / (sum + __expf(sink - m));
  f32x16 o[2] = {zero16(), zero16()};
#pragma unroll
  for (int tt = 0; tt < 5; ++tt)
#pragma unroll
    for (int s = 0; s < 2; ++s) {
      const bf16x8 pb = pack_step(st[tt], s);
#pragma unroll
      for (int i = 0; i < 2; ++i) {
        const bf16* vp = VTs + (32 * i + r) * VTS + 32 * (w + tt) + 16 * s + 4 * h;
        const bf16x8 a = cat4(*(const bf16x4*)vp, *(const bf16x4*)(vp + 8));
        o[i] = MFMA(a, pb, o[i]);
      }
    }
#pragma unroll
  for (int i = 0; i < 2; ++i)
#pragma unroll
    for (int j = 0; j < 16; ++j) ob[2 * i + (j >> 3)][j & 7] = (bf16)(o[i][j] * inv);
}
DI void unit_attn_prompt(const P& p, int u, char* smem) {
  const int b = u >> 7, blk = (u >> 3) & 15, hp = u & 7, hk = hp >> 2, g = hp >> 1, win = 2 << g;
  const int qpos0 = blk * 128;
  const int t = threadIdx.x + opaque0(), lane = t & 63, w = t >> 6, r = lane & 31, h = lane >> 5;
  bf16* Ks = (bf16*)smem;
  bf16* VTs = Ks + 256 * LDSK;
  float* bs = (float*)(VTs + 64 * VTS);
  bf16* Rs = Ks;
  __syncthreads();
#pragma unroll
  for (int i = 0; i < 8; ++i) {
    const int c = t + 256 * i, row = c >> 3, c16 = c & 7, kp = qpos0 - 128 + row;
    u32x4 v = {0u, 0u, 0u, 0u};
    if (kp >= 0) v = *(const u32x4*)(w_PROJ(p) + ((size_t)b * SEQ + kp) * INW + C_K + hk * 64 + c16 * 8);
    *(u32x4*)(Ks + row * LDSK + c16 * 8) = v;
  }
#pragma unroll
  for (int i = 0; i < 8; ++i) {
    const int c = t + 256 * i, drow = c >> 5, c16 = c & 31, kp0 = qpos0 - 128 + c16 * 8;
    u32x4 v = {0u, 0u, 0u, 0u};
    if (kp0 >= 0) v = *(const u32x4*)(w_VT(p) + ((size_t)(b * 2 + hk) * 64 + drow) * SEQ + kp0);
    u32x2* d2 = (u32x2*)(VTs + drow * VTS + c16 * 8);
    d2[0] = (u32x2){v[0], v[1]}; d2[1] = (u32x2){v[2], v[3]};
  }
  for (int i = t; i < 384; i += NTHREADS) { const int hh = i >= 192, j = i - 192 * hh, dist = 159 - j; bs[i] = (dist >= 0 && dist < 128) ? w_BIAS(p)[(2 * hp + hh) * 128 + dist] : -INFINITY; }
  const size_t tokq = (size_t)b * SEQ + qpos0 + 32 * w + r;
  bf16x8 qf0[4], qf1[4];
#pragma unroll
  for (int s = 0; s < 4; ++s) { qf0[s] = *(const bf16x8*)(w_PROJ(p) + tokq * INW + (2 * hp) * 64 + 16 * s + 8 * h); qf1[s] = *(const bf16x8*)(w_PROJ(p) + tokq * INW + (2 * hp + 1) * 64 + 16 * s + 8 * h); }
  __syncthreads();
  bf16x8 ob0[4], ob1[4];
  attn_head(p, 2 * hp, blk, w, r, h, qf0, Ks, VTs, bs, ob0);
  __builtin_amdgcn_sched_barrier(0);
  attn_head(p, 2 * hp + 1, blk, w, r, h, qf1, Ks, VTs, bs + 192, ob1);
  __builtin_amdgcn_sched_barrier(0);
  __syncthreads();
  {
    const int tk = t >> 4, cc = t & 15;
    const int p0 = qpos0 + tk * 8;
    const bf16* pin = w_PROJ(p) + (size_t)b * SEQ * INW + C_PIN + g * 128 + cc * 8;
    float S[8];
#pragma unroll
    for (int j = 0; j < 8; ++j) S[j] = 0.f;
    for (int i = 0; i < win; ++i) {
      const int pp = p0 - i;
      if (pp >= 0) { const bf16x8 v = *(const bf16x8*)(pin + (size_t)pp * INW);
#pragma unroll
        for (int j = 0; j < 8; ++j) S[j] += bf2f(v[j]); }
    }
    for (int i = 0; i < 8; ++i) {
      const int pos = p0 + i;
      const bf16x8 cur = *(const bf16x8*)(pin + (size_t)pos * INW);
      if (i > 0) {
#pragma unroll
        for (int j = 0; j < 8; ++j) S[j] += bf2f(cur[j]);
        if (pos - win >= 0) { const bf16x8 old = *(const bf16x8*)(pin + (size_t)(pos - win) * INW);
#pragma unroll
          for (int j = 0; j < 8; ++j) S[j] -= bf2f(old[j]); }
      }
      const float icnt = 1.f / (float)(win < pos + 1 ? win : pos + 1);
      bf16x8 rr;
#pragma unroll
      for (int j = 0; j < 8; ++j) rr[j] = (bf16)(S[j] * icnt - bf2f(cur[j]));
      *(bf16x8*)(Rs + (tk * 8 + i) * RS + cc * 8) = rr;
    }
  }
  __syncthreads();
  const bf16* prow = w_PROJ(p) + tokq * INW;
#pragma unroll
  for (int hh = 0; hh < 2; ++hh) {
    const int head = 2 * hp + hh;
    f32x16 pa[2] = {zero16(), zero16()};
#pragma unroll
    for (int s = 0; s < 8; ++s) {
      const bf16x8 bfr = *(const bf16x8*)(Rs + (32 * w + r) * RS + 16 * s + 8 * h);
#pragma unroll
      for (int i = 0; i < 2; ++i) {
        const bf16x8 a = *(const bf16x8*)(w_PWt(p) + ((size_t)g * 256 + (head & 3) * 64 + 32 * i + r) * 128 + 16 * s + 8 * h);
        pa[i] = MFMA(a, bfr, pa[i]);
      }
    }
#pragma unroll
    for (int i = 0; i < 2; ++i)
#pragma unroll
      for (int q4 = 0; q4 < 4; ++q4) {
        const int f = head * 64 + 32 * i + 8 * q4 + 4 * h;
        const bf16x4 ga = *(const bf16x4*)(prow + C_GA + f), gb = *(const bf16x4*)(prow + C_GB + f);
        const f32x4 ps = *(const f32x4*)(p.pool_scale + f);
        bf16x4 ov;
#pragma unroll
        for (int j = 0; j < 4; ++j) { const bf16 av = hh ? ob1[2 * i + (q4 >> 1)][4 * (q4 & 1) + j] : ob0[2 * i + (q4 >> 1)][4 * (q4 & 1) + j];
          ov[j] = (bf16)(bf2f(ga[j]) * bf2f(av) + bf2f(gb[j]) * (pa[i][4 * q4 + j] * ps[j])); }
        *(bf16x4*)(w_MIXED(p) + tokq * DM + f) = ov;
      }
    __builtin_amdgcn_sched_barrier(0);
  }
}

DI void unit_attn_sample(const P& p, int u, char* smem) {
  const int b = u >> 2, g = u & 3, hk = g >> 1;
  const int t = threadIdx.x + opaque0(), lane = t & 63, w = t >> 6;
  float* ks = (float*)smem;
  float* vs = ks + 128 * 65;
  float* qs = vs + 128 * 64;
  float* ps = qs + 256;
  float* os = ps + 512;
  float* rs = os + 256;
  const size_t token = (size_t)NPR + b;
  __syncthreads();
  const float* kw = p.out + O_KWS + (size_t)b * 128 * 128 + hk * 64;
  const float* vw = p.out + O_VWS + (size_t)b * 128 * 128 + hk * 64;
#pragma unroll 4
  for (int i = t; i < 128 * 64; i += NTHREADS) { const int j = i >> 6, d = i & 63; ks[j * 65 + d] = kw[(size_t)j * 128 + d]; vs[j * 64 + d] = vw[(size_t)j * 128 + d]; }
  qs[t] = bf2f(w_PROJ(p)[token * INW + g * 256 + t]);
  if (t < 128) {
    const int win = 2 << g;
    const float cur = p.out[O_PS + ((size_t)b * 15 + 14) * 512 + g * 128 + t];
    float tot = cur;
#pragma unroll 1
    for (int i = 1; i < win; ++i) tot += p.state_pool[((size_t)b * 15 + 15 - i) * 512 + g * 128 + t];
    rs[t] = tot / (float)win - cur;
  }
  __syncthreads();
  const int head = 4 * g + w;
  const float sink = p.sinks[head];
  float s[2];
  float m = sink;
#pragma unroll
  for (int i = 0; i < 2; ++i) {
    const int j = lane + 64 * i;
    float a = 0.f;
#pragma unroll 8
    for (int d = 0; d < 64; ++d) a += qs[w * 64 + d] * ks[j * 65 + d];
    s[i] = a + w_BIAS(p)[head * 128 + 127 - j];
    m = fmaxf(m, s[i]);
  }
  for (int o = 32; o >= 1; o >>= 1) m = fmaxf(m, __shfl_xor(m, o));
  float sum = 0.f;
#pragma unroll
  for (int i = 0; i < 2; ++i) { s[i] = __expf(s[i] - m); sum += s[i]; }
  sum = wave_sum(sum);
  const float inv = 1.f / (sum + __expf(sink - m));
#pragma unroll
  for (int i = 0; i < 2; ++i) ps[w * 128 + lane + 64 * i] = s[i] * inv;
  LDS_WAIT();
  {
    float a = 0.f;
#pragma unroll 8
    for (int j = 0; j < 128; ++j) a += ps[w * 128 + j] * vs[j * 64 + lane];
    os[w * 64 + lane] = a;
  }
  const int f = g * 256 + t;
  float pl = 0.f;
  const float* pw = p.pool_w + (size_t)g * 128 * 256 + t;
#pragma unroll 8
  for (int ch = 0; ch < 128; ++ch) pl += rs[ch] * pw[(size_t)ch * 256];
  pl *= p.pool_scale[f];
  const float ga = bf2f(w_PROJ(p)[token * INW + C_GA + f]), gb = bf2f(w_PROJ(p)[token * INW + C_GB + f]);
  LDS_WAIT();
  w_MIXED(p)[token * DM + f] = (bf16)(ga * os[t] + gb * pl);
}

DI void unit8_map(int u, int& mt, int& nt) {
  if (u < 1024) { const int xcd = u & 7, slot = (u >> 3) & 63, S = (u >> 9) * 8 + xcd; mt = S * 8 + (slot & 7); nt = slot >> 3; }
  else { mt = 128; nt = u - 1024; }
}
constexpr int G2_UNITS = 1024 + 32;
DI void gemm2_map(int u, int& mt, int& nt, int& kq) {
  if (u < 1024) { unit8_map(u, mt, nt); kq = -1; }
  else { mt = 128; nt = (u - 1024) & 7; kq = (u - 1024) >> 3; }
}
DI void gemm2_first(const P& p, int u, char* smem) {
  int mt, nt, kq; gemm2_map(u, mt, nt, kq);
  const int kb = kq < 0 ? 0 : 256 * kq;
  gemm_first(w_Wt_out(p) + kb, w_MIXED(p) + kb, 1024, nt * 128, mt * 128, smem);
}
DI void unit_gemm2(const P& p, int u, int un, char* smem) {
  int mt, nt, kq; gemm2_map(u, mt, nt, kq);
  const int n0 = nt * 128, m0 = mt * 128, kb = kq < 0 ? 0 : 256 * kq;
  f32x16 acc[4];
  gemm_main(w_Wt_out(p) + kb, w_MIXED(p) + kb, 1024, kq < 0 ? 1024 : 256, n0, m0, smem, acc);
  if (un >= 0) gemm2_first(p, un, smem);
  const int tz = threadIdx.x + opaque0();
  const int lane = tz & 63, w = tz >> 6, r = lane & 31, h = lane >> 5;
  float* tbase = (float*)(smem + GBUF + w * 8704);
#pragma unroll
  for (int hf = 0; hf < 2; ++hf) {
    if (hf) LDS_WAIT();
#pragma unroll
    for (int ii = 0; ii < 2; ++ii)
#pragma unroll
      for (int q4 = 0; q4 < 4; ++q4) {
        f32x4 v;
#pragma unroll
        for (int j = 0; j < 4; ++j) v[j] = acc[2 * hf + ii][4 * q4 + j];
        *(f32x4*)(tbase + r * 68 + 32 * ii + 8 * q4 + 4 * h) = v;
      }
    LDS_WAIT();
    const int fc = (lane & 15) * 4, tsub = lane >> 4;
#pragma unroll
    for (int it = 0; it < 8; ++it) {
      const int tl = 4 * it + tsub, token = m0 + 32 * w + tl, f = n0 + 64 * hf + fc;
      const f32x4 a = *(const f32x4*)(tbase + tl * 68 + fc);
      if (kq >= 0) { *(f32x4*)(w_PART(p) + ((size_t)kq * NS + (token - NPR)) * DM + f) = a; continue; }
      const f32x4 xv = *(const f32x4*)(xrow(p, token) + f), gv = *(const f32x4*)(w_MOD(p) + (size_t)cond_row(token) * 6144 + 2048 + f);
      f32x4 o;
#pragma unroll
      for (int j = 0; j < 4; ++j) o[j] = xv[j] + gv[j] * a[j];
      *(f32x4*)(w_X1(p) + (size_t)token * DM + f) = o;
    }
  }
}

DI unsigned f2ord(float f) { const unsigned u = __float_as_uint(f); return (u & 0x80000000u) ? ~u : (u | 0x80000000u); }
DI float ord2f(unsigned u) { return __uint_as_float((u & 0x80000000u) ? (u & 0x7fffffffu) : ~u); }
DI unsigned umin_(unsigned a, unsigned b) { return a < b ? a : b; }
DI unsigned umax_(unsigned a, unsigned b) { return a > b ? a : b; }
template <int OFF> DI void sort16_desc(unsigned (&a)[64]) {
#pragma unroll
  for (int lk = 1; lk <= 4; ++lk)
#pragma unroll
    for (int lj = lk - 1; lj >= 0; --lj)
#pragma unroll
      for (int i = 0; i < 16; ++i) {
        const int k = 1 << lk, j = 1 << lj, l = i ^ j;
        if (l > i) {
          const unsigned lo = umin_(a[OFF + i], a[OFF + l]), hi = umax_(a[OFF + i], a[OFF + l]);
          const bool desc = (i & k) == 0;
          a[OFF + i] = desc ? hi : lo; a[OFF + l] = desc ? lo : hi;
        }
      }
}
DI void merge16_desc(unsigned (&a)[16]) {
#pragma unroll
  for (int lj = 3; lj >= 0; --lj)
#pragma unroll
    for (int i = 0; i < 16; ++i) {
      const int j = 1 << lj, l = i ^ j;
      if (l > i) { const unsigned lo = umin_(a[i], a[l]), hi = umax_(a[i], a[l]); a[i] = hi; a[l] = lo; }
    }
}
DI void top16_of_64(unsigned (&a)[64], unsigned (&out)[16]) {
  sort16_desc<0>(a); sort16_desc<16>(a); sort16_desc<32>(a); sort16_desc<48>(a);
  unsigned x[16], y[16];
#pragma unroll
  for (int i = 0; i < 16; ++i) { x[i] = umax_(a[i], a[31 - i]); y[i] = umax_(a[32 + i], a[63 - i]); }
  merge16_desc(x); merge16_desc(y);
#pragma unroll
  for (int i = 0; i < 16; ++i) out[i] = umax_(x[i], y[15 - i]);
  merge16_desc(out);
}
__device__ constexpr int COFF[16] = {0, 16, 24, 29, 33, 36, 38, 40, 42, 43, 44, 45, 46, 47, 48, 49};
DI unsigned umax3(unsigned a, unsigned b, unsigned c) { const unsigned m = a > b ? a : b; return m > c ? m : c; }

DI void unit_peer_route(const P& p, int u, int un, char* smem) {
  int mt, hd; unit8_map(u, mt, hd);
  const int m0 = mt * 128;
  const int t = threadIdx.x + opaque0(), lane = t & 63, w = t >> 6, r = lane & 31, h = lane >> 5;
  unsigned char* myidx = (unsigned char*)smem + 2 * GBUF + t * 32;
  unsigned top[2][16];
#pragma unroll
  for (int pp = 0; pp < 2; ++pp) {
    f32x16 acc[4];
    gemm_main(w_Wt_q(p), w_H(p), 1024, 1024, hd * 256 + pp * 128, m0, smem, acc);
    if (pp == 0) gemm_first(w_Wt_q(p), w_H(p), 1024, hd * 256 + 128, m0, smem);
    else if (un >= 0) { int mn, hn; unit8_map(un, mn, hn); gemm_first(w_Wt_q(p), w_H(p), 1024, hn * 256, mn * 128, smem); }
    f32x16 sc[4] = {zero16(), zero16(), zero16(), zero16()};
    {
      const bf16* skb = w_SK(p) + (size_t)(hd * 2 + pp) * 128 * 128;
      const int wu = __builtin_amdgcn_readfirstlane(w);
#pragma unroll
      for (int q = 0; q < 8; ++q) {
        const int j = wu + 4 * q, row = 4 * j + (lane >> 4);
        glds16(skb + (size_t)row * 128 + (((lane & 15) ^ (row & 15)) * 8), smem + GBUF + 1024 * j);
      }
      asm volatile("s_waitcnt vmcnt(0)" ::: "memory");
      __syncthreads();
    }
    bf16x8 bqs[8];
#pragma unroll
    for (int i = 0; i < 4; ++i)
#pragma unroll
      for (int s = 0; s < 2; ++s) bqs[2 * i + s] = pack_step(acc[i], s);
#pragma unroll
    for (int i = 0; i < 4; ++i)
#pragma unroll
      for (int s = 0; s < 2; ++s) {
        const bf16x8 bq = bqs[2 * i + s];
#pragma unroll
        for (int kt = 0; kt < 4; ++kt) {
          const int row = 32 * kt + r, cc = 4 * i + 2 * s;
          const char* rp = smem + GBUF + row * 256 + 8 * h;
          const bf16x8 a = cat4(*(const bf16x4*)(rp + ((cc ^ (row & 15)) * 16)), *(const bf16x4*)(rp + (((cc + 1) ^ (row & 15)) * 16)));
          sc[kt] = MFMA(a, bq, sc[kt]);
        }
      }
    unsigned pk[64];
#pragma unroll
    for (int kt = 0; kt < 4; ++kt)
#pragma unroll
      for (int j = 0; j < 16; ++j) { const int key = 32 * kt + crow(j, h); pk[kt * 16 + j] = (f2ord(sc[kt][j]) & ~127u) | (unsigned)(127 - key); }
    unsigned mine[16];
    top16_of_64(pk, mine);
#pragma unroll
    for (int i = 0; i < 16; ++i) top[pp][i] = (unsigned)__shfl_xor((int)mine[15 - i], 32);
#pragma unroll
    for (int i = 0; i < 16; ++i) top[pp][i] = umax_(top[pp][i], mine[i]);
    merge16_desc(top[pp]);
  }
  float v0[16], v1[16];
#pragma unroll
  for (int a = 0; a < 16; ++a) {
    v0[a] = ord2f(top[0][a] & ~127u); v1[a] = ord2f(top[1][a] & ~127u);
    myidx[a] = (unsigned char)(127u - (top[0][a] & 127u)); myidx[16 + a] = (unsigned char)(127u - (top[1][a] & 127u));
  }
  unsigned cand[64];
#pragma unroll
  for (int i = 50; i < 64; ++i) cand[i] = 0u;
#pragma unroll
  for (int a = 0; a < 16; ++a)
#pragma unroll
    for (int bb = 0; bb < 16 / (a + 1); ++bb)
      cand[COFF[a] + bb] = (f2ord(v0[a] + v1[bb]) & ~255u) | (unsigned)(255 - (a * 16 + bb));
  unsigned best[16];
  top16_of_64(cand, best);
  const float smax = ord2f(best[0] & ~255u);
  float e[16], esum = 0.f;
#pragma unroll
  for (int i = 0; i < 16; ++i) { e[i] = __expf(ord2f(best[i] & ~255u) - smax); esum += e[i]; }
  const float einv = 1.f / esum;
  const size_t token = (size_t)m0 + 32 * w + r;
  int* ip = w_IDX(p) + token * 128 + hd * 16 + 8 * h;
  float* gp = w_GATE(p) + token * 128 + hd * 16 + 8 * h;
  const unsigned hmask = 0u - (unsigned)h;
#pragma unroll
  for (int i = 0; i < 8; ++i) {
    const unsigned bsel = best[i] ^ ((best[i] ^ best[8 + i]) & hmask);
    const float esel = __uint_as_float(__float_as_uint(e[i]) ^ ((__float_as_uint(e[i]) ^ __float_as_uint(e[8 + i])) & hmask));
    const unsigned code = 255u - (bsel & 255u);
    const int a = code >> 4, bb = code & 15;
    ip[i] = (int)myidx[a] * 128 + (int)myidx[16 + bb];
    gp[i] = esel * einv;
  }
}

DI float gelu_fast(float v) {
  const float av = fabsf(v), tt = __builtin_amdgcn_rcpf(av * 0.2316418882f + 1.0f);
  float q = tt * 0.5307027145f - 0.7265760135f; q = q * tt + 0.7107068705f; q = q * tt - 0.142248368f; q = q * tt + 0.127414796f; q = q * tt;
  const float e = __builtin_amdgcn_exp2f(v * v * -0.72134752044f);
  const float m = v * (q * e);
  return v < 0.f ? m : v - m;
}
DI float dot2bf(unsigned a, unsigned b, float acc) { return __builtin_amdgcn_fdot2_f32_bf16(__builtin_bit_cast(bf16x2, a), __builtin_bit_cast(bf16x2, b), acc, false); }
DI unsigned pkbf(f32x2 v) { bf16x2 r; r[0] = (bf16)v[0]; r[1] = (bf16)v[1]; return __builtin_bit_cast(unsigned, r); }
DI int dot16i(u32x4 u8, u32x4 x8, int d) {
#pragma unroll
  for (int m = 0; m < 4; ++m) d = __builtin_amdgcn_sdot4((int)u8[m], (int)x8[m], d, false);
  return d;
}
DI void axpy16p(f32x2* o, u32x4 v8, f32x2 c2) {
#pragma unroll
  for (int m = 0; m < 4; ++m) {
    const int wd = (int)v8[m];
    o[2 * m] = __builtin_elementwise_fma(c2, __builtin_amdgcn_cvt_pk_f32_fp8(wd, false), o[2 * m]);
    o[2 * m + 1] = __builtin_elementwise_fma(c2, __builtin_amdgcn_cvt_pk_f32_fp8(wd, true), o[2 * m + 1]);
  }
}
DI int dpp_add16i(int v) {
  v += __builtin_amdgcn_update_dpp(0, v, 0x140, 0xf, 0xf, true);
  v += __builtin_amdgcn_update_dpp(0, v, 0x141, 0xf, 0xf, true);
  v += __builtin_amdgcn_update_dpp(0, v, 0x4e, 0xf, 0xf, true);
  v += __builtin_amdgcn_update_dpp(0, v, 0xb1, 0xf, 0xf, true);
  return v;
}
DI float dot16(u32x4 u8, u32x4 xlo, u32x4 xhi, float d) {
#pragma unroll
  for (int m = 0; m < 4; ++m) {
    const int wd = (int)u8[m];
    const unsigned p01 = pkbf(__builtin_amdgcn_cvt_pk_f32_fp8(wd, false)), p23 = pkbf(__builtin_amdgcn_cvt_pk_f32_fp8(wd, true));
    const unsigned x01 = m < 2 ? xlo[2 * m] : xhi[2 * m - 4], x23 = m < 2 ? xlo[2 * m + 1] : xhi[2 * m - 3];
    d = dot2bf(p01, x01, d); d = dot2bf(p23, x23, d);
  }
  return d;
}
DI void axpy16(float* o, u32x4 v8, float c) {
#pragma unroll
  for (int m = 0; m < 4; ++m) {
    const int wd = (int)v8[m];
    const f32x2 a = __builtin_amdgcn_cvt_pk_f32_fp8(wd, false), b = __builtin_amdgcn_cvt_pk_f32_fp8(wd, true);
    o[4 * m] += c * a[0]; o[4 * m + 1] += c * a[1]; o[4 * m + 2] += c * b[0]; o[4 * m + 3] += c * b[1];
  }
}
DI float reduce4(const float (&d)[4], int lane) {
  const int h = lane >> 5, b4 = (lane >> 4) & 1;
  float a0 = h ? d[2] : d[0], a1 = h ? d[3] : d[1];
  const float s0 = h ? d[0] : d[2], s1 = h ? d[1] : d[3];
  a0 += __shfl_xor(s0, 32); a1 += __shfl_xor(s1, 32);
  float k = b4 ? a1 : a0;
  const float s = b4 ? a0 : a1;
  k += __shfl_xor(s, 16);
  k += __shfl_xor(k, 8); k += __shfl_xor(k, 4); k += __shfl_xor(k, 2); k += __shfl_xor(k, 1);
  return k;
}
DI float dpp_add16(float v) {
  v += __int_as_float(__builtin_amdgcn_update_dpp(0, __float_as_int(v), 0x140, 0xf, 0xf, true));
  v += __int_as_float(__builtin_amdgcn_update_dpp(0, __float_as_int(v), 0x141, 0xf, 0xf, true));
  v += __int_as_float(__builtin_amdgcn_update_dpp(0, __float_as_int(v), 0x4e, 0xf, 0xf, true));
  v += __int_as_float(__builtin_amdgcn_update_dpp(0, __float_as_int(v), 0xb1, 0xf, 0xf, true));
  return v;
}
constexpr int PEER_GLDS = 512 + 128 * 16;
constexpr int PEER_WLDS = 4 * PEER_GLDS;
DI void peer_wave4(const P& p, int g, char* wl) {
  const int lane = (threadIdx.x + opaque0()) & 63, q = lane >> 4, j16 = lane & 15;
  unsigned* hist = (unsigned*)(wl + q * PEER_GLDS);
  u32x4* list = (u32x4*)(wl + q * PEER_GLDS + 512);
  const int token = 4 * g + q;
  u32x4 x[4];
  {
    const unsigned char* hrow = w_H8(p) + (size_t)token * DM + 16 * j16;
#pragma unroll
    for (int i = 0; i < 4; ++i) x[i] = *(const u32x4*)(hrow + 256 * i);
  }
  const float xs = w_HS(p)[token];
  {
    int ids[8]; float gts[8], su[8];
#pragma unroll
    for (int i = 0; i < 8; ++i) { const size_t o = (size_t)token * 128 + j16 + 16 * i; ids[i] = w_IDX(p)[o]; gts[i] = w_GATE(p)[o]; }
#pragma unroll
    for (int i = 0; i < 8; ++i) { su[i] = w_SU(p)[ids[i]] * xs; gts[i] *= w_SV(p)[ids[i]]; }
    LDS_WAIT();
    *(u32x4*)(hist + 8 * j16) = (u32x4){0u, 0u, 0u, 0u}; *(u32x4*)(hist + 8 * j16 + 4) = (u32x4){0u, 0u, 0u, 0u};
    LDS_WAIT();
#pragma unroll
    for (int i = 0; i < 8; ++i) (void)__hip_atomic_fetch_add(&hist[ids[i] >> 7], 1u, __ATOMIC_RELAXED, __HIP_MEMORY_SCOPE_WAVEFRONT);
    LDS_WAIT();
    const u32x4 ca = *(const u32x4*)(hist + 8 * j16), cb = *(const u32x4*)(hist + 8 * j16 + 4);
    const unsigned tot = ca[0] + ca[1] + ca[2] + ca[3] + cb[0] + cb[1] + cb[2] + cb[3];
    unsigned scan = tot;
#pragma unroll
    for (int o = 1; o < 16; o <<= 1) { const unsigned tv = (unsigned)__shfl_up((int)scan, o, 16); if (j16 >= o) scan += tv; }
    unsigned e0 = scan - tot;
    u32x4 pa, pb;
    pa[0] = e0; e0 += ca[0]; pa[1] = e0; e0 += ca[1]; pa[2] = e0; e0 += ca[2]; pa[3] = e0; e0 += ca[3];
    pb[0] = e0; e0 += cb[0]; pb[1] = e0; e0 += cb[1]; pb[2] = e0; e0 += cb[2]; pb[3] = e0;
    LDS_WAIT();
    *(u32x4*)(hist + 8 * j16) = pa; *(u32x4*)(hist + 8 * j16 + 4) = pb;
    LDS_WAIT();
#pragma unroll
    for (int i = 0; i < 8; ++i) {
      const unsigned pos = __hip_atomic_fetch_add(&hist[ids[i] >> 7], 1u, __ATOMIC_RELAXED, __HIP_MEMORY_SCOPE_WAVEFRONT);
      list[pos] = (u32x4){(unsigned)ids[i], __float_as_uint(su[i]), __float_as_uint(gts[i]), 0u};
    }
    LDS_WAIT();
  }
  const unsigned char* Ub = w_Ub(p) + 16 * j16;
  const unsigned char* Vb = w_Vb(p) + 16 * j16;
  {
    u32x4 uA[4], uB[4];
    u32x4 eA = list[0], eB = list[1];
#pragma unroll
    for (int i = 0; i < 4; ++i) uA[i] = *(const u32x4*)(Ub + (size_t)eA[0] * DM + 256 * i);
#pragma unroll
    for (int i = 0; i < 4; ++i) uB[i] = *(const u32x4*)(Ub + (size_t)eB[0] * DM + 256 * i);
#define PEER_USTEP(U, E, K)                                                                                            \
    {                                                                                                                  \
      const float su = __uint_as_float(E[1]), gsv = __uint_as_float(E[2]);                                             \
      int d0 = 0, d1 = 0;                                                                                              \
      d0 = dot16i(U[0], x[0], d0); d1 = dot16i(U[1], x[1], d1); d0 = dot16i(U[2], x[2], d0); d1 = dot16i(U[3], x[3], d1); \
      E = list[(K) + 2 < 128 ? (K) + 2 : 127];                       \
      _Pragma("unroll") for (int i = 0; i < 4; ++i) U[i] = *(const u32x4*)(Ub + (size_t)E[0] * DM + 256 * i);          \
      const float c = gsv * gelu_fast(su * (float)dpp_add16i(d0 + d1));                                                \
      if (j16 == 0) ((float*)&list[K])[3] = c;                                                                          \
    }
#pragma unroll 1
    for (int k = 0; k < 128; k += 2) {
      PEER_USTEP(uA, eA, k)
      PEER_USTEP(uB, eB, k + 1)
    }
  }
  LDS_WAIT();
  f32x2 acc[32];
#pragma unroll
  for (int i = 0; i < 32; ++i) acc[i] = (f32x2){0.f, 0.f};
  {
    u32x4 vA[4], vB[4];
    u32x4 eA = list[0], eB = list[1];
#pragma unroll
    for (int i = 0; i < 4; ++i) vA[i] = *(const u32x4*)(Vb + (size_t)eA[0] * DM + 256 * i);
#pragma unroll
    for (int i = 0; i < 4; ++i) vB[i] = *(const u32x4*)(Vb + (size_t)eB[0] * DM + 256 * i);
#define PEER_VSTEP(V, E, K)                                                                                            \
    {                                                                                                                  \
      const float c = __uint_as_float(E[3]);                                                                           \
      const f32x2 c2 = {c, c};                                                                                         \
      _Pragma("unroll") for (int i = 0; i < 4; ++i) axpy16p(acc + 8 * i, V[i], c2);                                    \
      E = list[(K) + 2 < 128 ? (K) + 2 : 127];                                                                         \
      _Pragma("unroll") for (int i = 0; i < 4; ++i) V[i] = *(const u32x4*)(Vb + (size_t)E[0] * DM + 256 * i);          \
    }
#pragma unroll 1
    for (int k = 0; k < 128; k += 2) {
      PEER_VSTEP(vA, eA, k)
      PEER_VSTEP(vB, eB, k + 1)
    }
  }
  const float* x1 = w_X1(p) + (size_t)token * DM + 16 * j16;
  const float* g2 = w_MOD(p) + (size_t)cond_row(token) * 6144 + 5120 + 16 * j16;
  float* y = p.out + O_YP + (size_t)token * DM + 16 * j16;
#pragma unroll
  for (int i = 0; i < 4; ++i)
#pragma unroll
    for (int mm = 0; mm < 4; ++mm) {
      const int c0 = 256 * i + 4 * mm;
      const f32x4 xv = *(const f32x4*)(x1 + c0), gv = *(const f32x4*)(g2 + c0);
      f32x4 yv;
#pragma unroll
      for (int j = 0; j < 4; ++j) yv[j] = xv[j] + gv[j] * acc[8 * i + 2 * mm + (j >> 1)][j & 1];
      *(f32x4*)(y + c0) = yv;
    }
}
DI void peer_token_block(const P& p, int token, char* smem) {
  const int t = threadIdx.x + opaque0(), lane = t & 63, w = t >> 6;
  float* red = (float*)smem;
  const u32x4 x8 = *(const u32x4*)(w_H8(p) + (size_t)token * DM + 16 * lane);
  const int myid = w_IDX(p)[(size_t)token * 128 + 32 * w + (lane & 31)];
  const float mysu = w_SU(p)[myid] * w_HS(p)[token];
  const float mygs = w_GATE(p)[(size_t)token * 128 + 32 * w + (lane & 31)] * w_SV(p)[myid];
  float o[16];
#pragma unroll
  for (int i = 0; i < 16; ++i) o[i] = 0.f;
#pragma unroll 1
  for (int e0 = 0; e0 < 32; e0 += 8) {
    u32x4 u8[8], v8[8];
#pragma unroll
    for (int qq = 0; qq < 8; ++qq) {
      const size_t ro = (size_t)__builtin_amdgcn_readlane(myid, e0 + qq) * DM + 16 * lane;
      u8[qq] = *(const u32x4*)(w_Ub(p) + ro); v8[qq] = *(const u32x4*)(w_Vb(p) + ro);
    }
#pragma unroll
    for (int hb = 0; hb < 2; ++hb) {
      float d[4];
#pragma unroll
      for (int qq = 0; qq < 4; ++qq) d[qq] = (float)dot16i(u8[4 * hb + qq], x8, 0);
      const float kv = reduce4(d, lane);
#pragma unroll
      for (int qq = 0; qq < 4; ++qq) {
        const int e = e0 + 4 * hb + qq;
        const float a = __int_as_float(__builtin_amdgcn_readlane(__float_as_int(kv), 16 * qq)) * __int_as_float(__builtin_amdgcn_readlane(__float_as_int(mysu), e));
        const float c = __int_as_float(__builtin_amdgcn_readlane(__float_as_int(mygs), e)) * gelu_fast(a);
        axpy16(o, v8[4 * hb + qq], c);
      }
    }
  }
  __syncthreads();
#pragma unroll
  for (int i = 0; i < 16; ++i) red[w * 1024 + 16 * lane + i] = o[i];
  __syncthreads();
  if (w == 0) {
    const float* x1 = w_X1(p) + (size_t)token * DM + 16 * lane;
    const float* g2 = w_MOD(p) + (size_t)cond_row(token) * 6144 + 5120 + 16 * lane;
    float* y = p.out + O_YP + (size_t)token * DM + 16 * lane;
#pragma unroll
    for (int mm = 0; mm < 4; ++mm) {
      const f32x4 xv = *(const f32x4*)(x1 + 4 * mm), gv = *(const f32x4*)(g2 + 4 * mm);
      f32x4 yv;
#pragma unroll
      for (int j = 0; j < 4; ++j) { const int c = 16 * lane + 4 * mm + j; yv[j] = xv[j] + gv[j] * (red[c] + red[1024 + c] + red[2048 + c] + red[3072 + c]); }
      *(f32x4*)(y + 4 * mm) = yv;
    }
  }
}

constexpr int NPHASE = 8;

#if defined(PROBE_ATTN) || defined(PROBE_SAMP)
DI int probe_token(int i) { return (i * 131 + 3) % NPR; }
DI float block_sum_p(float v, float* red) {
  __syncthreads();
  v = wave_sum(v);
  if ((threadIdx.x & 63) == 0) red[threadIdx.x >> 6] = v;
  __syncthreads();
  return red[0] + red[1] + red[2] + red[3];
}
DI float block_max_p(float v, float* red) {
  __syncthreads();
  for (int o = 32; o >= 1; o >>= 1) v = fmaxf(v, __shfl_xor(v, o));
  if ((threadIdx.x & 63) == 0) red[threadIdx.x >> 6] = v;
  __syncthreads();
  return fmaxf(fmaxf(red[0], red[1]), fmaxf(red[2], red[3]));
}
#endif
#ifdef PROBE_ATTN
DI void probe_attn(const P& p, int i, char* smem) {
  float* red = (float*)smem;
  float* pr = red + 4;
  float* attn = pr + 128;
  float* rr = attn + 1024;
  const int token = probe_token(i), b = token >> 11, pos = token & 2047, t = threadIdx.x;
  const bf16* prow = w_PROJ(p) + (size_t)token * INW;
  for (int head = 0; head < 16; ++head) {
    const int hk = head >> 3;
    float s = -INFINITY;
    const int kp = pos - 127 + (t & 127);
    if (t < 128 && kp >= 0) {
      float a = 0.f;
      const bf16* kr = w_PROJ(p) + ((size_t)b * SEQ + kp) * INW + C_K + hk * 64;
      for (int d = 0; d < 64; ++d) a += bf2f(prow[head * 64 + d]) * bf2f(kr[d]);
      s = a + w_BIAS(p)[head * 128 + (pos - kp)];
    }
    float m = block_max_p(s, red);
    m = fmaxf(m, p.sinks[head]);
    const float e = (t < 128 && kp >= 0) ? __expf(s - m) : 0.f;
    const float den = block_sum_p(e, red) + __expf(p.sinks[head] - m);
    if (t < 128) pr[t] = e / den;
    __syncthreads();
    if (t < 64) {
      float o = 0.f;
      for (int j = 0; j < 128; ++j) { const int kq = pos - 127 + j; if (kq >= 0) o += pr[j] * bf2f(w_VT(p)[((size_t)(b * 2 + hk) * 64 + t) * SEQ + kq]); }
      attn[head * 64 + t] = o;
    }
    __syncthreads();
  }
  for (int c = t; c < 512; c += 256) {
    const int g = c >> 7, win = 2 << g;
    float tot = 0.f;
    for (int j = 0; j < win; ++j) if (pos - j >= 0) tot += bf2f(w_PROJ(p)[((size_t)b * SEQ + pos - j) * INW + C_PIN + c]);
    const float cnt = (float)(win < pos + 1 ? win : pos + 1);
    rr[c] = bf2f((bf16)(tot / cnt - bf2f(prow[C_PIN + c])));
  }
  __syncthreads();
  for (int f = t; f < 1024; f += 256) {
    const int g = f >> 8;
    float pl = 0.f;
    for (int ch = 0; ch < 128; ++ch) pl += rr[g * 128 + ch] * bf2f(w_PWt(p)[((size_t)g * 256 + (f & 255)) * 128 + ch]);
    const float naive = bf2f(prow[C_GA + f]) * attn[f] + bf2f(prow[C_GB + f]) * (pl * p.pool_scale[f]);
    const float fast = bf2f(w_MIXED(p)[(size_t)token * DM + f]);
    p.out[O_KWP + (size_t)i * DM + f] += (float)(PROBE_ATTN) * (fast - naive);
  }
  __syncthreads();
}
#endif

#ifdef PROBE_SAMP
DI void probe_samp(const P& p, int b, char* smem) {
  float* red = (float*)smem;
  float* pr = red + 4;
  float* attn = pr + 128;
  float* rr = attn + 1024;
  const int t = threadIdx.x;
  const size_t token = (size_t)NPR + b;
  const bf16* prow = w_PROJ(p) + token * INW;
  for (int head = 0; head < 16; ++head) {
    const int hk = head >> 3;
    float s = -INFINITY;
    if (t < 128) {
      const float* kr = t < 127 ? p.cache_k + (((size_t)b * 128 + t + 1) * 2 + hk) * 64 : p.out + O_KWS + (((size_t)b * 128 + 127) * 2 + hk) * 64;
      float a = 0.f;
      for (int d = 0; d < 64; ++d) a += bf2f(prow[head * 64 + d]) * kr[d];
      s = a + p.rel_table[(127 - t < 16 ? 127 - t : min(31, 16 + (int)(logf((float)(127 - t) / 16.f) / logf(8.f) * 16.f))) * 16 + head];
    }
    float m = block_max_p(s, red);
    m = fmaxf(m, p.sinks[head]);
    const float e = t < 128 ? __expf(s - m) : 0.f;
    const float den = block_sum_p(e, red) + __expf(p.sinks[head] - m);
    if (t < 128) pr[t] = e / den;
    __syncthreads();
    if (t < 64) {
      float o = 0.f;
      for (int j = 0; j < 128; ++j) { const float* vr = j < 127 ? p.cache_v + (((size_t)b * 128 + j + 1) * 2 + hk) * 64 : p.out + O_VWS + (((size_t)b * 128 + 127) * 2 + hk) * 64; o += pr[j] * vr[t]; }
      attn[head * 64 + t] = o;
    }
    __syncthreads();
  }
  for (int c = t; c < 512; c += 256) {
    const int g = c >> 7, win = 2 << g;
    const float cur = p.out[O_PS + ((size_t)b * 15 + 14) * 512 + c];
    float tot = cur;
    for (int j = 1; j < win; ++j) tot += p.state_pool[((size_t)b * 15 + 15 - j) * 512 + c];
    rr[c] = tot / (float)win - cur;
  }
  __syncthreads();
  for (int f = t; f < 1024; f += 256) {
    const int g = f >> 8;
    float pl = 0.f;
    for (int ch = 0; ch < 128; ++ch) pl += rr[g * 128 + ch] * p.pool_w[((size_t)g * 128 + ch) * 256 + (f & 255)];
    const float naive = bf2f(prow[C_GA + f]) * attn[f] + bf2f(prow[C_GB + f]) * (pl * p.pool_scale[f]);
    const float fast = bf2f(w_MIXED(p)[token * DM + f]);
    p.out[O_KWP + (size_t)b * DM + f] += (float)(PROBE_SAMP) * (fast - naive);
  }
  __syncthreads();
}
#endif
template <class First, class Main, class Fill> DI void run_with_filler(int G, int bid, int nmain, int nfill, First firstf, Main mainf, Fill fillf) {
  if (bid < nmain) { __syncthreads(); firstf(bid); }
  for (int u = bid; u < nmain; u += G) mainf(u, u + G < nmain ? u + G : -1);
  const int rem = nmain % G;
  if (rem == 0) { for (int f = bid; f < nfill; f += G) fillf(f); }
  else if (bid >= rem) { for (int f = bid - rem; f < nfill; f += G - rem) fillf(f); }
}
template <int PH> DI void run_phase(const P& p, char* smem) {
  const int G = gridDim.x, bid = blockIdx.x, w = __builtin_amdgcn_readfirstlane(threadIdx.x >> 6);
  if constexpr (PH == 0) { run_with_filler(G, bid, U0_MOD, F0_TOTAL, [&](int) {}, [&](int u, int) { unit_mod(p, u, smem); }, [&](int f) { phase0_filler(p, f, smem); }); }
  if constexpr (PH == 1) { for (int tk = bid * 4 + w; tk < NTOK; tk += G * 4) norm_row(p, tk, 0); }
  if constexpr (PH == 2) {
    run_with_filler(G, bid, 129 * 30, F2_TOTAL, [&](int u) { gemm_first(w_Wt_in(p), w_H(p), 1024, (u % 30) * 128, (u / 30) * 128, smem); },
                    [&](int u, int un) { unit_gemm1(p, u, un, smem); }, [&](int f) { phase2_filler(p, f, smem); });
  }
  if constexpr (PH == 3) { for (int u = bid; u < 1024; u += G) unit_attn_prompt(p, u, smem);
                           for (int u = bid; u < 512; u += G) unit_attn_sample(p, u, smem); }
  if constexpr (PH == 4) {
    run_with_filler(G, bid, G2_UNITS, F4_TOTAL, [&](int u) { gemm2_first(p, u, smem); },
                    [&](int u, int un) { unit_gemm2(p, u, un, smem); }, [&](int f) { unit_convert(p.sub_keys, w_SK(p), f); });
  }
  if constexpr (PH == 5) { for (int tk = bid * 4 + w; tk < NTOK; tk += G * 4) norm_row(p, tk, 1); }
  if constexpr (PH == 6) {
    run_with_filler(G, bid, 129 * 8, F6_TOTAL, [&](int u) { int mt, hd; unit8_map(u, mt, hd); gemm_first(w_Wt_q(p), w_H(p), 1024, hd * 256, mt * 128, smem); },
                    [&](int u, int un) { unit_peer_route(p, u, un, smem); }, [&](int f) { if (f < F6_QU) unit_quant_rows<true>(p.peer_u, w_Ub(p), w_SU(p), f); else unit_quant_rows<false>(p.peer_v, w_Vb(p), w_SV(p), f - F6_QU); });
  }
  if constexpr (PH == 7) {
    for (int g = bid * 4 + w; g < NPR / 4; g += G * 4) peer_wave4(p, g, smem + w * PEER_WLDS);
    for (int s = bid; s < NS; s += G) peer_token_block(p, NPR + s, smem + 4 * PEER_WLDS);
  }
}
#if ONE_LAUNCH
__global__ void __launch_bounds__(NTHREADS, 2) mega(P p) {
  __shared__ __attribute__((aligned(16))) char smem[SMEM_BYTES + 16];
  volatile unsigned* st = (volatile unsigned*)(smem + SMEM_BYTES);
  if (threadIdx.x == 0) { st[0] = 0u; st[1] = 0u; }
  __syncthreads();
  const unsigned xcc = xb_xcc_id();
  if (threadIdx.x == 0) (void)xb_add(&w_bar(p)[XB_XCNT(xcc)], 1u);
#ifndef REPEAT_MASK
#define REPEAT_MASK 0
#endif
#define RUN_PH(k) do { run_phase<k>(p, smem); if ((REPEAT_MASK >> k) & 1) { xcd_barrier(w_bar(p), xcc, st); run_phase<k>(p, smem); } } while (0)
  RUN_PH(0); xcd_barrier(w_bar(p), xcc, st);
  RUN_PH(1); xcd_barrier(w_bar(p), xcc, st);
  RUN_PH(2); xcd_barrier(w_bar(p), xcc, st);
  RUN_PH(3); xcd_barrier(w_bar(p), xcc, st);
#ifdef PROBE_ATTN
  for (int i = blockIdx.x; i < 128; i += gridDim.x) probe_attn(p, i, smem);
  xcd_barrier(w_bar(p), xcc, st);
#endif
#ifdef PROBE_SAMP
  for (int i = blockIdx.x; i < 128; i += gridDim.x) probe_samp(p, i, smem);
  xcd_barrier(w_bar(p), xcc, st);
#endif
  RUN_PH(4); xcd_barrier(w_bar(p), xcc, st);
  RUN_PH(5); xcd_barrier(w_bar(p), xcc, st);
  RUN_PH(6); xcd_barrier(w_bar(p), xcc, st);
  RUN_PH(7);
}
#else
template <int PH> __global__ void __launch_bounds__(NTHREADS, 2) mega(P p) {
  __shared__ __attribute__((aligned(16))) char smem[SMEM_BYTES];
  run_phase<PH>(p, smem);
}
#endif


extern "C" void kernel_launch(void* const* d_in, const int* in_sizes, int n_in, void* d_out, int out_size, void* d_ws, size_t ws_size, hipStream_t stream) {
  P p{};
  const float* const* in = (const float* const*)d_in;
  p.x_prompt = in[0]; p.x_sample = in[1]; p.cache_k = in[2]; p.cache_v = in[3]; p.state_pool = in[4]; p.c_prompt = in[5]; p.c_sample = in[6];
  p.rel_table = in[7]; p.ada_w = in[8]; p.ada_b = in[9]; p.norm1_g = in[10]; p.w_in = in[11]; p.q_norm_g = in[12]; p.k_norm_g = in[13]; p.sinks = in[14];
  p.pool_w = in[15]; p.pool_scale = in[16]; p.w_out = in[17]; p.norm2_g = in[18]; p.w_query = in[19]; p.sub_keys = in[20]; p.peer_u = in[21]; p.peer_v = in[22];
  p.out = (float*)d_out;
  p.ws = (char*)d_ws;
  if (WS_NEED > ws_size) { fprintf(stderr, "workspace too small: need %zu have %zu\n", (size_t)WS_NEED, ws_size); return; }

  static int grid_blocks = 0;
  if (!grid_blocks) {
    int dev = 0, cus = 0, per_cu = 0;
    (void)hipGetDevice(&dev);
    (void)hipDeviceGetAttribute(&cus, hipDeviceAttributeMultiprocessorCount, dev);
#if ONE_LAUNCH
    (void)hipOccupancyMaxActiveBlocksPerMultiprocessor(&per_cu, mega, NTHREADS, 0);
#else
    per_cu = 2;
#endif
    if (per_cu > 2) per_cu = 2;
    if (per_cu < 1) per_cu = 1;
    if (cus < 1) cus = 256;
    grid_blocks = cus * per_cu;
  }
#if ONE_LAUNCH
  (void)hipMemsetAsync(p.ws + OFF_BAR, 0, XCD_BAR_WORDS * 4, stream);
  hipLaunchKernelGGL(mega, dim3(grid_blocks), dim3(NTHREADS), 0, stream, p);
#else
  hipLaunchKernelGGL(mega<0>, dim3(grid_blocks), dim3(NTHREADS), 0, stream, p);
  hipLaunchKernelGGL(mega<1>, dim3(grid_blocks), dim3(NTHREADS), 0, stream, p);
  hipLaunchKernelGGL(mega<2>, dim3(grid_blocks), dim3(NTHREADS), 0, stream, p);
  hipLaunchKernelGGL(mega<3>, dim3(grid_blocks), dim3(NTHREADS), 0, stream, p);
  hipLaunchKernelGGL(mega<4>, dim3(grid_blocks), dim3(NTHREADS), 0, stream, p);
  hipLaunchKernelGGL(mega<5>, dim3(grid_blocks), dim3(NTHREADS), 0, stream, p);
  hipLaunchKernelGGL(mega<6>, dim3(grid_blocks), dim3(NTHREADS), 0, stream, p);
  hipLaunchKernelGGL(mega<7>, dim3(grid_blocks), dim3(NTHREADS), 0, stream, p);
#endif

}
```

```cpp
#include <hip/hip_runtime.h>
#include <stdint.h>
#include <stdio.h>

#ifndef ONE_LAUNCH
#define ONE_LAUNCH 1
#endif
#ifndef PEER_ALIGN
#define PEER_ALIGN 1
#endif

typedef __bf16 bf16;
typedef __bf16 bf16x2 __attribute__((ext_vector_type(2)));
typedef __bf16 bf16x4 __attribute__((ext_vector_type(4)));
typedef __bf16 bf16x8 __attribute__((ext_vector_type(8)));
typedef float f32x2 __attribute__((ext_vector_type(2)));
typedef float f32x4 __attribute__((ext_vector_type(4)));
typedef float f32x16 __attribute__((ext_vector_type(16)));
typedef unsigned u32x2 __attribute__((ext_vector_type(2)));
typedef unsigned u32x4 __attribute__((ext_vector_type(4)));

#define DI __device__ __forceinline__
#define MFMA(a, b, c) __builtin_amdgcn_mfma_f32_32x32x16_bf16((a), (b), (c), 0, 0, 0)

constexpr int DM = 1024, NB = 8, SEQ = 2048, NS = 128, NPR = NB * SEQ, NTOK = NPR + NS;
constexpr int INW = 3840, NMOD = NB + NS;
constexpr int C_K = 1024, C_V = 1152, C_PIN = 1280, C_GA = 1792, C_GB = 2816;
constexpr int NEXP = 16384;
constexpr float EPS = 1e-6f;
constexpr size_t O_YP = 0, O_KWP = 16908288, O_VWP = 17039360, O_PP = 17170432, O_KWS = 17231872, O_VWS = 19329024, O_PS = 21426176;

constexpr int SMEM_BYTES = 77824;
constexpr int NTHREADS = 256;

struct P {
  const float *x_prompt, *x_sample, *cache_k, *cache_v, *state_pool, *c_prompt, *c_sample, *rel_table, *ada_w, *ada_b, *norm1_g, *w_in,
      *q_norm_g, *k_norm_g, *sinks, *pool_w, *pool_scale, *w_out, *norm2_g, *w_query, *sub_keys, *peer_u, *peer_v;
  float* out;
  char* ws;
};
constexpr size_t al256(size_t x) { return (x + 255) & ~(size_t)255; }
constexpr size_t OFF_BAR = 0;
constexpr size_t OFF_WTIN = OFF_BAR + al256(4096 * 4);
constexpr size_t OFF_WTOUT = OFF_WTIN + al256((size_t)INW * 1024 * 2);
constexpr size_t OFF_WTQ = OFF_WTOUT + al256((size_t)1024 * 1024 * 2);
constexpr size_t OFF_SK = OFF_WTQ + al256((size_t)2048 * 1024 * 2);
constexpr size_t OFF_PWT = OFF_SK + al256((size_t)16 * 128 * 128 * 2);
constexpr size_t OFF_UB = OFF_PWT + al256((size_t)4 * 256 * 128 * 2);
constexpr size_t OFF_VB = OFF_UB + al256((size_t)NEXP * DM);
constexpr size_t OFF_SU = OFF_VB + al256((size_t)NEXP * DM);
constexpr size_t OFF_SV = OFF_SU + al256((size_t)NEXP * 4);
constexpr size_t OFF_H8 = OFF_SV + al256((size_t)NEXP * 4);
constexpr size_t OFF_HS = OFF_H8 + al256((size_t)NTOK * DM);
constexpr size_t OFF_PART = OFF_HS + al256((size_t)NTOK * 4);
constexpr size_t OFF_MOD = OFF_PART + al256((size_t)4 * NS * DM * 4);
constexpr size_t OFF_BIAS = OFF_MOD + al256((size_t)NMOD * 6144 * 4);
constexpr size_t OFF_VT = OFF_BIAS + al256(16 * 128 * 4);
constexpr size_t OFF_H = OFF_VT + al256((size_t)NB * 128 * SEQ * 2);
constexpr size_t OFF_MIXED = OFF_H;
constexpr size_t OFF_PROJ = OFF_H + al256((size_t)NTOK * DM * 2);
constexpr size_t OFF_X1 = OFF_PROJ;
constexpr size_t OFF_IDX = OFF_X1 + (size_t)NTOK * DM * 4;
constexpr size_t OFF_GATE = OFF_IDX + (size_t)NTOK * 128 * 4;
constexpr size_t WS_NEED = OFF_PROJ + al256((size_t)NTOK * INW * 2);
static_assert(OFF_GATE + (size_t)NTOK * 128 * 4 <= WS_NEED, "overlay fits");
static_assert(WS_NEED <= (size_t)256 * 1024 * 1024, "workspace budget");
#define WS_PTR(T, name, OFF) __device__ __forceinline__ T* name(const P& p) { return (T*)(p.ws + (OFF)); }
WS_PTR(unsigned, w_bar, OFF_BAR) WS_PTR(bf16, w_Wt_in, OFF_WTIN) WS_PTR(bf16, w_Wt_out, OFF_WTOUT) WS_PTR(bf16, w_Wt_q, OFF_WTQ) WS_PTR(bf16, w_SK, OFF_SK)
WS_PTR(bf16, w_PWt, OFF_PWT) WS_PTR(unsigned char, w_Ub, OFF_UB) WS_PTR(unsigned char, w_Vb, OFF_VB) WS_PTR(float, w_SU, OFF_SU) WS_PTR(float, w_SV, OFF_SV) WS_PTR(unsigned char, w_H8, OFF_H8) WS_PTR(float, w_HS, OFF_HS) WS_PTR(float, w_PART, OFF_PART) WS_PTR(float, w_MOD, OFF_MOD) WS_PTR(float, w_BIAS, OFF_BIAS)
WS_PTR(bf16, w_VT, OFF_VT) WS_PTR(bf16, w_H, OFF_H) WS_PTR(bf16, w_MIXED, OFF_MIXED) WS_PTR(bf16, w_PROJ, OFF_PROJ) WS_PTR(float, w_X1, OFF_X1)
WS_PTR(int, w_IDX, OFF_IDX) WS_PTR(float, w_GATE, OFF_GATE)

DI int cond_row(int token) { return token < NPR ? (token >> 11) : (NB + token - NPR); }
DI int crow(int reg, int h) { return (reg & 3) + 8 * (reg >> 2) + 4 * h; }
DI const float* xrow(const P& p, int token) { return token < NPR ? p.x_prompt + (size_t)token * DM : p.x_sample + (size_t)(token - NPR) * DM; }

#define LDS_WAIT() asm volatile("s_waitcnt lgkmcnt(0)" ::: "memory")
DI int opaque0() { int z = 0; asm volatile("" : "+v"(z)); return z; }
DI float bf2f(bf16 v) { return (float)v; }
DI f32x16 zero16() { f32x16 z; for (int i = 0; i < 16; ++i) z[i] = 0.f; return z; }
DI bf16x8 pack_step(const f32x16& x, int s) { bf16x8 v; for (int j = 0; j < 8; ++j) v[j] = (bf16)x[8 * s + j]; return v; }
DI bf16x8 cat4(bf16x4 lo, bf16x4 hi) { return __builtin_shufflevector(lo, hi, 0, 1, 2, 3, 4, 5, 6, 7); }
DI float wave_sum(float v) { for (int o = 32; o >= 1; o >>= 1) v += __shfl_xor(v, o); return v; }

#define XB_TMO 128
#define XB_XCNT(j) (256 + 64 * (j))
#define XB_XSUB(j) (1280 + 64 * (j))
#define XB_XGEN(j) (2304 + 64 * (j))
#define XB_TOP 3328
#define XB_TOPGEN 3392
#define XCD_BAR_WORDS 3456
#define XB_SPIN_CAP (1u << 22)
DI unsigned xb_ld(unsigned* p) { return __hip_atomic_load(p, __ATOMIC_RELAXED, __HIP_MEMORY_SCOPE_AGENT); }
DI unsigned xb_add(unsigned* p, unsigned v) { return __hip_atomic_fetch_add(p, v, __ATOMIC_RELAXED, __HIP_MEMORY_SCOPE_AGENT); }
DI unsigned xb_xcc_id() { return (unsigned)__builtin_amdgcn_s_getreg((3 << 11) | 20) & 0xFu; }
#define XB_SPIN(cond, bar) do { unsigned _sp = 0; while (cond) { __builtin_amdgcn_s_sleep(1); \
    if ((++_sp & 255u) == 0u) { if (xb_ld(&(bar)[XB_TMO])) break; if (_sp > XB_SPIN_CAP) { atomicAdd(&(bar)[XB_TMO], 1u); break; } } } } while (0)

DI void xcd_barrier_complete(unsigned* bar, unsigned x, unsigned& nloc, unsigned& nx) {
  const unsigned G = gridDim.x;
  unsigned sum, cnt, mine, sp = 0u;
  for (;;) {
    sum = 0u; cnt = 0u; mine = 0u;
#pragma unroll
    for (unsigned j = 0; j < 16; ++j) { const unsigned c = xb_ld(&bar[XB_XCNT(j)]); sum += c; cnt += (c > 0u) ? 1u : 0u; mine = (j == x) ? c : mine; }
    if (sum == G) break;
    __builtin_amdgcn_s_sleep(1);
    if ((++sp & 255u) == 0u) { if (xb_ld(&bar[XB_TMO])) break; if (sp > XB_SPIN_CAP) { atomicAdd(&bar[XB_TMO], 1u); break; } }
  }
  nloc = mine > 0u ? mine : 1u; nx = cnt > 0u ? cnt : 1u;
}
DI void xcd_barrier(unsigned* bar, unsigned x, volatile unsigned* st) {
  asm volatile("s_waitcnt vmcnt(0)" ::: "memory");
  __syncthreads();
  if (threadIdx.x == 0) {
    __builtin_amdgcn_s_waitcnt(0);
    unsigned nloc = st[0], nx = st[1];
    if (nloc == 0u) { xcd_barrier_complete(bar, x, nloc, nx); st[0] = nloc; st[1] = nx; }
    const unsigned old = xb_add(&bar[XB_XSUB(x)], 1u);
    const unsigned gen = old / nloc;
    if (old + 1u == (gen + 1u) * nloc) {
      __builtin_amdgcn_fence(__ATOMIC_RELEASE, "agent");
      asm volatile("s_waitcnt vmcnt(0)" ::: "memory");
      const unsigned og = xb_add(&bar[XB_TOP], 1u);
      const unsigned tg = og / nx;
      if (og + 1u == (tg + 1u) * nx) xb_add(&bar[XB_TOPGEN], 1u);
      else XB_SPIN(xb_ld(&bar[XB_TOPGEN]) == tg, bar);
      xb_add(&bar[XB_XGEN(x)], 1u);
      __builtin_amdgcn_fence(__ATOMIC_ACQUIRE, "agent");
      asm volatile("s_waitcnt vmcnt(0)" ::: "memory");
    } else {
      XB_SPIN(xb_ld(&bar[XB_XGEN(x)]) == gen, bar);
      __builtin_amdgcn_fence(__ATOMIC_ACQUIRE, "agent");
      asm volatile("s_waitcnt vmcnt(0)" ::: "memory");
    }
  }
  __syncthreads();
}

constexpr int U0_MOD = 192;
constexpr int U0_TIN = (1024 / 64) * (INW / 64);
constexpr int F0_TOTAL = U0_TIN + 1;
constexpr int U0_TPW = 4 * 2 * 4;
constexpr int U0_CSK = 32;
constexpr int U0_KW = 128, U0_VW = 128, U0_PW = 128;
constexpr int F2_TOUT = 16 * 16, F2_TQ = 16 * 32, F2_E1 = F2_TOUT + F2_TQ, F2_E2 = F2_E1 + U0_TPW, F2_E3 = F2_E2 + U0_KW, F2_E4 = F2_E3 + U0_VW,
              F2_TOTAL = F2_E4 + U0_PW;
constexpr int F4_TOTAL = U0_CSK;
constexpr int F6_QU = 2048, F6_QV = 2048, F6_TOTAL = F6_QU + F6_QV;

DI float silu_f(float x) { return x * __builtin_amdgcn_rcpf(1.f + __expf(-x)); }

DI void unit_mod(const P& p, int u, char* smem) {
  const int t = threadIdx.x + opaque0(), lane = t & 63, w = t >> 6, r = lane & 31, h = lane >> 5;
  const int f0 = u * 32;
  f32x16 acc[5];
#pragma unroll
  for (int i = 0; i < 5; ++i) acc[i] = zero16();
  const float* wp = p.ada_w + (size_t)(w * 256 + 8 * h) * 6144 + f0 + r;
  const float* cp[5];
#pragma unroll
  for (int i = 0; i < 5; ++i) { const int m = 32 * i + r, mm = m < NMOD ? m : 0; cp[i] = (mm < NB ? p.c_prompt + (size_t)mm * DM : p.c_sample + (size_t)(mm - NB) * DM) + w * 256 + 8 * h; }
  float wv[8]; f32x4 cv[5][2];
#pragma unroll
  for (int j = 0; j < 8; ++j) wv[j] = wp[(size_t)j * 6144];
#pragma unroll
  for (int i = 0; i < 5; ++i) { cv[i][0] = *(const f32x4*)cp[i]; cv[i][1] = *(const f32x4*)(cp[i] + 4); }
#pragma unroll 1
  for (int ks = 0; ks < 16; ++ks) {
    bf16x8 bfr, afr[5];
#pragma unroll
    for (int j = 0; j < 8; ++j) bfr[j] = (bf16)wv[j];
#pragma unroll
    for (int i = 0; i < 5; ++i) {
      const bool ok = 32 * i + r < NMOD;
#pragma unroll
      for (int j = 0; j < 8; ++j) afr[i][j] = (bf16)(ok ? silu_f(cv[i][j >> 2][j & 3]) : 0.f);
    }
    const int kn = ks + 1 < 16 ? ks + 1 : 15;
#pragma unroll
    for (int j = 0; j < 8; ++j) wv[j] = wp[(size_t)(kn * 16 + j) * 6144];
#pragma unroll
    for (int i = 0; i < 5; ++i) { cv[i][0] = *(const f32x4*)(cp[i] + kn * 16); cv[i][1] = *(const f32x4*)(cp[i] + kn * 16 + 4); }
#pragma unroll
    for (int i = 0; i < 5; ++i) acc[i] = MFMA(afr[i], bfr, acc[i]);
  }
  float* red = (float*)smem;
  __syncthreads();
  if (w > 0) {
#pragma unroll
    for (int i = 0; i < 5; ++i)
#pragma unroll
      for (int j = 0; j < 16; ++j) red[((w - 1) * 80 + i * 16 + j) * 64 + lane] = acc[i][j];
  }
  __syncthreads();
  if (w == 0) {
    const float bias = p.ada_b[f0 + r];
#pragma unroll
    for (int i = 0; i < 5; ++i)
#pragma unroll
      for (int j = 0; j < 16; ++j) {
        const int m = 32 * i + crow(j, h);
        const float v = acc[i][j] + red[(0 * 80 + i * 16 + j) * 64 + lane] + red[(1 * 80 + i * 16 + j) * 64 + lane] + red[(2 * 80 + i * 16 + j) * 64 + lane] + bias;
        if (m < NMOD) w_MOD(p)[(size_t)m * 6144 + f0 + r] = v;
      }
  }
}

DI void unit_transpose(const float* __restrict__ src, bf16* __restrict__ dst, int R, int C, int tr, int tc, char* smem) {
  float* tile = (float*)smem;
  const int t = threadIdx.x + opaque0();
  __syncthreads();
#pragma unroll
  for (int i = 0; i < 4; ++i) {
    const int rr = (t >> 4) + 16 * i, cc = (t & 15) * 4;
    const f32x4 v = *(const f32x4*)(src + (size_t)(tr * 64 + rr) * C + tc * 64 + cc);
    tile[rr * 65 + cc] = v[0]; tile[rr * 65 + cc + 1] = v[1]; tile[rr * 65 + cc + 2] = v[2]; tile[rr * 65 + cc + 3] = v[3];
  }
  __syncthreads();
#pragma unroll
  for (int i = 0; i < 2; ++i) {
    const int orow = (t >> 3) + 32 * i, seg = (t & 7) * 8;
    bf16x8 v;
#pragma unroll
    for (int j = 0; j < 8; ++j) v[j] = (bf16)tile[(seg + j) * 65 + orow];
    *(bf16x8*)(dst + (size_t)(tc * 64 + orow) * R + tr * 64 + seg) = v;
  }
}
DI void unit_convert(const float* __restrict__ src, bf16* __restrict__ dst, int u) {
  const size_t base = (size_t)u * 8192 + (threadIdx.x + opaque0()) * 8;
#pragma unroll
  for (int i = 0; i < 4; ++i) {
    const size_t o = base + (size_t)i * 2048;
    const f32x4 a = *(const f32x4*)(src + o), b = *(const f32x4*)(src + o + 4);
    bf16x8 v; v[0] = (bf16)a[0]; v[1] = (bf16)a[1]; v[2] = (bf16)a[2]; v[3] = (bf16)a[3]; v[4] = (bf16)b[0]; v[5] = (bf16)b[1]; v[6] = (bf16)b[2]; v[7] = (bf16)b[3];
    *(bf16x8*)(dst + o) = v;
  }
}
DI unsigned pack_i8(float a, float b, float c, float d) {
  const int ia = max(-127, min(127, __float2int_rn(a))), ib = max(-127, min(127, __float2int_rn(b))), ic = max(-127, min(127, __float2int_rn(c))), id = max(-127, min(127, __float2int_rn(d)));
  return (unsigned)(ia & 255) | ((unsigned)(ib & 255) << 8) | ((unsigned)(ic & 255) << 16) | ((unsigned)(id & 255) << 24);
}
template <bool I8>
DI void unit_quant_rows(const float* __restrict__ src, unsigned char* __restrict__ dst, float* __restrict__ scale, int u) {
  const int t = threadIdx.x + opaque0(), lane = t & 63, w = t >> 6;
#pragma unroll
  for (int rr = 0; rr < 2; ++rr) {
    const size_t row = (size_t)u * 8 + 2 * w + rr;
    const float* s = src + row * DM + 16 * lane;
    f32x4 v[4];
    float amax = 0.f;
#pragma unroll
    for (int i = 0; i < 4; ++i) { v[i] = *(const f32x4*)(s + 4 * i); amax = fmaxf(amax, fmaxf(fmaxf(fabsf(v[i][0]), fabsf(v[i][1])), fmaxf(fabsf(v[i][2]), fabsf(v[i][3])))); }
#pragma unroll
    for (int o = 32; o >= 1; o >>= 1) amax = fmaxf(amax, __shfl_xor(amax, o));
    const float sc = amax > 0.f ? amax * (I8 ? 1.f / 127.f : 1.f / 440.f) : 1.f, inv = 1.f / sc;
    u32x4 q;
#pragma unroll
    for (int i = 0; i < 4; ++i) {
      if (I8) {
        q[i] = pack_i8(v[i][0] * inv, v[i][1] * inv, v[i][2] * inv, v[i][3] * inv);
      } else {
        int wd = 0;
        wd = __builtin_amdgcn_cvt_pk_fp8_f32(v[i][0] * inv, v[i][1] * inv, wd, false);
        wd = __builtin_amdgcn_cvt_pk_fp8_f32(v[i][2] * inv, v[i][3] * inv, wd, true);
        q[i] = (unsigned)wd;
      }
    }
    *(u32x4*)(dst + row * DM + 16 * lane) = q;
    if (lane == 0) scale[row] = sc;
  }
}
DI void unit_copy_f4(const float* __restrict__ src, float* __restrict__ dst, int n4) {
  for (int i = threadIdx.x + opaque0(); i < n4; i += NTHREADS) ((f32x4*)dst)[i] = ((const f32x4*)src)[i];
}

DI void phase0_filler(const P& p, int f, char* smem) {
  if (f < U0_TIN) { unit_transpose(p.w_in, w_Wt_in(p), 1024, INW, f / 60, f % 60, smem); }
  else {
    for (int i = threadIdx.x + opaque0(); i < 16 * 128; i += NTHREADS) {
      const int head = i >> 7, d = i & 127;
      int bk = d;
      if (d >= 16) { bk = 16 + (int)(logf((float)d / 16.f) / logf(8.f) * 16.f); bk = bk > 31 ? 31 : bk; }
      w_BIAS(p)[i] = p.rel_table[bk * 16 + head];
    }
  }
}
DI void phase2_filler(const P& p, int f, char* smem) {
  if (f < F2_TOUT) unit_transpose(p.w_out, w_Wt_out(p), 1024, 1024, f / 16, f % 16, smem);
  else if (f < F2_E1) { const int v = f - F2_TOUT; unit_transpose(p.w_query, w_Wt_q(p), 1024, 2048, v / 32, v % 32, smem); }
  else if (f < F2_E2) { const int v = f - F2_E1, g = v >> 3, tt = v & 7; unit_transpose(p.pool_w + (size_t)g * 128 * 256, w_PWt(p) + (size_t)g * 256 * 128, 128, 256, tt >> 2, tt & 3, smem); }
  else if (f < F2_E3) { const int b = f - F2_E2; unit_copy_f4(p.cache_k + ((size_t)b * 128 + 1) * 128, p.out + O_KWS + (size_t)b * 128 * 128, 127 * 128 / 4); }
  else if (f < F2_E4) { const int b = f - F2_E3; unit_copy_f4(p.cache_v + ((size_t)b * 128 + 1) * 128, p.out + O_VWS + (size_t)b * 128 * 128, 127 * 128 / 4); }
  else { const int b = f - F2_E4; unit_copy_f4(p.state_pool + ((size_t)b * 15 + 1) * 512, p.out + O_PS + (size_t)b * 15 * 512, 14 * 512 / 4); }
}

DI void norm_row(const P& p, int token, int which) {
  const int lane = (threadIdx.x + opaque0()) & 63;
  const float* src = which == 0 ? xrow(p, token) : w_X1(p) + (size_t)token * DM;
  const float* g = which == 0 ? p.norm1_g : p.norm2_g;
  const float* mod = w_MOD(p) + (size_t)cond_row(token) * 6144 + (which == 0 ? 0 : 3072);
  f32x4 v[4];
  float ss = 0.f;
  if (which == 1 && token >= NPR) {
    const float* g1 = w_MOD(p) + (size_t)cond_row(token) * 6144 + 2048;
#pragma unroll
    for (int i = 0; i < 4; ++i) {
      const int c = 4 * lane + 256 * i;
      const size_t po = (size_t)(token - NPR) * DM + c;
      const f32x4 xv = *(const f32x4*)(xrow(p, token) + c), gv = *(const f32x4*)(g1 + c);
      const f32x4 pa = *(const f32x4*)(w_PART(p) + po), pb = *(const f32x4*)(w_PART(p) + (size_t)NS * DM + po), pc = *(const f32x4*)(w_PART(p) + (size_t)2 * NS * DM + po), pd = *(const f32x4*)(w_PART(p) + (size_t)3 * NS * DM + po);
#pragma unroll
      for (int j = 0; j < 4; ++j) v[i][j] = xv[j] + gv[j] * ((pa[j] + pb[j]) + (pc[j] + pd[j]));
      *(f32x4*)(w_X1(p) + (size_t)token * DM + c) = v[i];
      ss += v[i][0] * v[i][0] + v[i][1] * v[i][1] + v[i][2] * v[i][2] + v[i][3] * v[i][3];
    }
  } else {
#pragma unroll
  for (int i = 0; i < 4; ++i) { v[i] = *(const f32x4*)(src + 4 * lane + 256 * i); ss += v[i][0] * v[i][0] + v[i][1] * v[i][1] + v[i][2] * v[i][2] + v[i][3] * v[i][3]; }
  }
  ss = wave_sum(ss);
  const float rstd = rsqrtf(ss * (1.f / DM) + EPS);
#pragma unroll
  for (int i = 0; i < 4; ++i) {
    const int c = 4 * lane + 256 * i;
    const f32x4 gg = *(const f32x4*)(g + c), sh = *(const f32x4*)(mod + c), sc = *(const f32x4*)(mod + 1024 + c);
    bf16x4 o;
#pragma unroll
    for (int j = 0; j < 4; ++j) { v[i][j] = (v[i][j] * rstd * gg[j]) * (1.f + sc[j]) + sh[j]; o[j] = (bf16)v[i][j]; }
    *(bf16x4*)(w_H(p) + (size_t)token * DM + c) = o;
  }
  if (which == 1) {
    float amax = 0.f;
#pragma unroll
    for (int i = 0; i < 4; ++i) amax = fmaxf(amax, fmaxf(fmaxf(fabsf(v[i][0]), fabsf(v[i][1])), fmaxf(fabsf(v[i][2]), fabsf(v[i][3]))));
#pragma unroll
    for (int o = 32; o >= 1; o >>= 1) amax = fmaxf(amax, __shfl_xor(amax, o));
    const float qs = amax > 0.f ? amax * (1.f / 127.f) : 1.f, inv = 1.f / qs;
#pragma unroll
    for (int i = 0; i < 4; ++i) *(unsigned*)(w_H8(p) + (size_t)token * DM + 4 * lane + 256 * i) = pack_i8(v[i][0] * inv, v[i][1] * inv, v[i][2] * inv, v[i][3] * inv);
    if (lane == 0) w_HS(p)[token] = qs;
  }
}

constexpr int LDSK = 72;
constexpr int GT = 128 * 64 * 2;
constexpr int GBUF = 2 * GT;
typedef __attribute__((address_space(3))) unsigned lds_u32;
typedef const __attribute__((address_space(1))) unsigned glb_u32;
DI void glds16(const void* g, char* l) { __builtin_amdgcn_global_load_lds((glb_u32*)g, (lds_u32*)l, 16, 0, 0); }
DI void gemm_first(const bf16* __restrict__ Wt, const bf16* __restrict__ X, int ld, int n0, int m0, char* smem) {
  const int t = threadIdx.x + opaque0(), lane = t & 63;
  const int w = __builtin_amdgcn_readfirstlane(t >> 6);
  const int swz = (lane & 7) ^ ((4 * w + (lane >> 4)) & 7);
  const bf16* ga = Wt + (size_t)(n0 + 8 * w + (lane >> 3)) * ld + swz * 8;
  const bf16* gb = X + (size_t)(m0 + 8 * w + (lane >> 3)) * ld + swz * 8;
#pragma unroll
  for (int q = 0; q < 4; ++q) { glds16(ga + (size_t)(32 * q) * ld, smem + 1024 * (w + 4 * q)); glds16(gb + (size_t)(32 * q) * ld, smem + GT + 1024 * (w + 4 * q)); }
}
DI void gemm_main(const bf16* __restrict__ Wt, const bf16* __restrict__ X, int ld, int K, int n0, int m0, char* smem, f32x16 (&acc)[4]) {
  const int t = threadIdx.x + opaque0(), lane = t & 63, r = lane & 31, h = lane >> 5;
  const int w = __builtin_amdgcn_readfirstlane(t >> 6);
#pragma unroll
  for (int i = 0; i < 4; ++i) acc[i] = zero16();
  const int swz = (lane & 7) ^ ((4 * w + (lane >> 4)) & 7);
  const bf16* ga = Wt + (size_t)(n0 + 8 * w + (lane >> 3)) * ld + swz * 8;
  const bf16* gb = X + (size_t)(m0 + 8 * w + (lane >> 3)) * ld + swz * 8;
  const int sw = (r >> 1) & 7;
  const int KT = K >> 6;
  asm volatile("s_waitcnt vmcnt(0)" ::: "memory");
  __syncthreads();
  for (int kt = 0; kt < KT; ++kt) {
    const char* As = smem + (kt & 1) * GBUF;
    const char* Bs = As + GT;
    if (kt + 1 < KT) {
      char* An = smem + ((kt + 1) & 1) * GBUF;
      const int k0 = (kt + 1) * 64;
#pragma unroll
      for (int q = 0; q < 4; ++q) { glds16(ga + (size_t)(32 * q) * ld + k0, An + 1024 * (w + 4 * q)); glds16(gb + (size_t)(32 * q) * ld + k0, An + GT + 1024 * (w + 4 * q)); }
    }
#pragma unroll
    for (int s = 0; s < 4; ++s) {
      const int co = ((2 * s + h) ^ sw) * 16;
      const bf16x8 bfr = *(const bf16x8*)(Bs + (32 * w + r) * 128 + co);
#pragma unroll
      for (int i = 0; i < 4; ++i) {
        const bf16x8 afr = *(const bf16x8*)(As + (32 * i + r) * 128 + co);
        acc[i] = MFMA(afr, bfr, acc[i]);
      }
    }
    asm volatile("s_waitcnt vmcnt(0)" ::: "memory");
    __syncthreads();
  }
}

DI float sigmoid_f(float x) { return __builtin_amdgcn_rcpf(1.f + __expf(-x)); }

DI void unit_gemm1(const P& p, int u, int un, char* smem) {
  const int mt = u / 30, nt = u % 30;
  const int n0 = nt * 128, m0 = mt * 128;
  f32x16 acc[4];
  gemm_main(w_Wt_in(p), w_H(p), 1024, 1024, n0, m0, smem, acc);
  if (un >= 0) gemm_first(w_Wt_in(p), w_H(p), 1024, (un % 30) * 128, (un / 30) * 128, smem);
  const int tz = threadIdx.x + opaque0();
  const int lane = tz & 63, w = tz >> 6, r = lane & 31, h = lane >> 5;
  const int token = m0 + 32 * w + r;
  bf16* tw = (bf16*)(smem + GBUF + (tz >> 6) * 8704) + r * 136;
  const bool is_prompt = token < NPR;
  const int b = is_prompt ? (token >> 11) : (token - NPR), pos = token & (SEQ - 1);
  if (n0 < C_V) {
    const float* gn = n0 < C_K ? p.q_norm_g : p.k_norm_g;
    const float post = n0 < C_K ? 0.125f : 1.f;
#pragma unroll
    for (int hh = 0; hh < 2; ++hh) {
      float ss = 0.f;
#pragma unroll
      for (int i = 0; i < 2; ++i)
#pragma unroll
        for (int j = 0; j < 16; ++j) ss += acc[2 * hh + i][j] * acc[2 * hh + i][j];
      ss += __shfl_xor(ss, 32);
      const float rstd = rsqrtf(ss * (1.f / 64.f) + EPS);
#pragma unroll
      for (int i = 0; i < 2; ++i)
#pragma unroll
        for (int q4 = 0; q4 < 4; ++q4) {
          const int d = 32 * i + 8 * q4 + 4 * h;
          const f32x4 gg = *(const f32x4*)(gn + d);
          f32x4 v;
#pragma unroll
          for (int j = 0; j < 4; ++j) v[j] = acc[2 * hh + i][4 * q4 + j] * rstd * gg[j];
          bf16x4 o;
#pragma unroll
          for (int j = 0; j < 4; ++j) o[j] = (bf16)(v[j] * post);
          *(bf16x4*)(tw + 64 * hh + d) = o;
          if (n0 == C_K) {
            if (is_prompt) { if (pos >= SEQ - 128) *(f32x4*)(p.out + O_KWP + ((size_t)b * 128 + (pos - (SEQ - 128))) * 128 + 64 * hh + d) = v; }
            else *(f32x4*)(p.out + O_KWS + ((size_t)b * 128 + 127) * 128 + 64 * hh + d) = v;
          }
        }
    }
  } else if (n0 == C_V) {
#pragma unroll
    for (int i = 0; i < 4; ++i)
#pragma unroll
      for (int q4 = 0; q4 < 4; ++q4) {
        const int f = 32 * i + 8 * q4 + 4 * h;
        f32x4 v;
#pragma unroll
        for (int j = 0; j < 4; ++j) v[j] = acc[i][4 * q4 + j];
        if (is_prompt) {
#pragma unroll
          for (int j = 0; j < 4; ++j) w_VT(p)[((size_t)b * 128 + f + j) * SEQ + pos] = (bf16)v[j];
          if (pos >= SEQ - 128) *(f32x4*)(p.out + O_VWP + ((size_t)b * 128 + (pos - (SEQ - 128))) * 128 + f) = v;
        } else *(f32x4*)(p.out + O_VWS + ((size_t)b * 128 + 127) * 128 + f) = v;
      }
  } else if (n0 < C_GA) {
#pragma unroll
    for (int i = 0; i < 4; ++i)
#pragma unroll
      for (int q4 = 0; q4 < 4; ++q4) {
        const int f = n0 + 32 * i + 8 * q4 + 4 * h;
        f32x4 v; bf16x4 o;
#pragma unroll
        for (int j = 0; j < 4; ++j) { v[j] = acc[i][4 * q4 + j]; o[j] = (bf16)v[j]; }
        *(bf16x4*)(tw + (f - n0)) = o;
        if (is_prompt) { if (pos >= SEQ - 15) *(f32x4*)(p.out + O_PP + ((size_t)b * 15 + (pos - (SEQ - 15))) * 512 + (f - C_PIN)) = v; }
        else *(f32x4*)(p.out + O_PS + ((size_t)b * 15 + 14) * 512 + (f - C_PIN)) = v;
      }
  } else {
#pragma unroll
    for (int i = 0; i < 4; ++i)
#pragma unroll
      for (int q4 = 0; q4 < 4; ++q4) {
        const int f = n0 + 32 * i + 8 * q4 + 4 * h;
        bf16x4 o;
#pragma unroll
        for (int j = 0; j < 4; ++j) o[j] = (bf16)sigmoid_f(acc[i][4 * q4 + j]);
        *(bf16x4*)(tw + (f - n0)) = o;
      }
  }
  if (n0 != C_V) {
    LDS_WAIT();
    const bf16* tr = (const bf16*)(smem + GBUF + (tz >> 6) * 8704);
    bf16* pg = w_PROJ(p) + (size_t)(m0 + 32 * w + (lane >> 4)) * INW + n0 + (lane & 15) * 8;
#pragma unroll
    for (int it = 0; it < 8; ++it) *(u32x4*)(pg + (size_t)(4 * it) * INW) = *(const u32x4*)(tr + ((lane >> 4) + 4 * it) * 136 + (lane & 15) * 8);
  }
}

constexpr int VTS = 260;
constexpr int RS = 136;
DI void attn_head(const P& p, int head, int blk, int w, int r, int h, const bf16x8 (&qf)[4], const bf16* Ks, const bf16* VTs, const float* bsh, bf16x8 (&ob)[4]) {
  const int qi = 32 * w + r;
  f32x16 st[5];
#pragma unroll
  for (int tt = 0; tt < 5; ++tt) {
    st[tt] = zero16();
#pragma unroll
    for (int s = 0; s < 4; ++s) {
      const bf16x8 a = *(const bf16x8*)(Ks + (32 * (w + tt) + r) * LDSK + 16 * s + 8 * h);
      st[tt] = MFMA(a, qf[s], st[tt]);
    }
  }
  const float sink = p.sinks[head];
  float m = -INFINITY;
  {
    const int x = 31 - r + 4 * h;
    const float* bl = bsh + x;
#pragma unroll
    for (int tt = 0; tt < 5; ++tt)
#pragma unroll
      for (int j = 0; j < 16; ++j) {
        const int c = 32 * tt + (j & 3) + 8 * (j >> 2);
        const float s = st[tt][j] + bl[c];
        st[tt][j] = s;
        m = fmaxf(m, s);
      }
    if (blk == 0) {
      m = -INFINITY;
#pragma unroll
      for (int tt = 0; tt < 5; ++tt)
#pragma unroll
        for (int j = 0; j < 16; ++j) {
          const int c = 32 * tt + (j & 3) + 8 * (j >> 2);
          const float s = (159 - (x + c) > qi) ? -INFINITY : st[tt][j];
          st[tt][j] = s;
          m = fmaxf(m, s);
        }
    }
  }
  m = fmaxf(m, __shfl_xor(m, 32));
  m = fmaxf(m, sink);
  float sum = 0.f;
#pragma unroll
  for (int tt = 0; tt < 5; ++tt)
#pragma unroll
    for (int j = 0; j < 16; ++j) { const float e = __expf(st[tt][j] - m); st[tt][j] = e; sum += e; }
  sum += __shfl_xor(sum, 32);
  const float inv = 1.f / (sum + __expf(sink - m));
  f32x16 o[2] = {zero16(), zero16()};
#pragma unroll
  for (int tt = 0; tt < 5; ++tt)
#pragma unroll
    for (int s = 0; s < 2; ++s) {
      const bf16x8 pb = pack_step(st[tt], s);
#pragma unroll
      for (int i = 0; i < 2; ++i) {
        const bf16* vp = VTs + (32 * i + r) * VTS + 32 * (w + tt) + 16 * s + 4 * h;
        const bf16x8 a = cat4(*(const bf16x4*)vp, *(const bf16x4*)(vp + 8));
        o[i] = MFMA(a, pb, o[i]);
      }
    }
#pragma unroll
  for (int i = 0; i < 2; ++i)
#pragma unroll
    for (int j = 0; j < 16; ++j) ob[2 * i + (j >> 3)][j & 7] = (bf16)(o[i][j] * inv);
}
DI void unit_attn_prompt(const P& p, int u, char* smem) {
  const int b = u >> 7, blk = (u >> 3) & 15, hp = u & 7, hk = hp >> 2, g = hp >> 1, win = 2 << g;
  const int qpos0 = blk * 128;
  const int t = threadIdx.x + opaque0(), lane = t & 63, w = t >> 6, r = lane & 31, h = lane >> 5;
  bf16* Ks = (bf16*)smem;
  bf16* VTs = Ks + 256 * LDSK;
  float* bs = (float*)(VTs + 64 * VTS);
  bf16* Rs = Ks;
  __syncthreads();
#pragma unroll
  for (int i = 0; i < 8; ++i) {
    const int c = t + 256 * i, row = c >> 3, c16 = c & 7, kp = qpos0 - 128 + row;
    u32x4 v = {0u, 0u, 0u, 0u};
    if (kp >= 0) v = *(const u32x4*)(w_PROJ(p) + ((size_t)b * SEQ + kp) * INW + C_K + hk * 64 + c16 * 8);
    *(u32x4*)(Ks + row * LDSK + c16 * 8) = v;
  }
#pragma unroll
  for (int i = 0; i < 8; ++i) {
    const int c = t + 256 * i, drow = c >> 5, c16 = c & 31, kp0 = qpos0 - 128 + c16 * 8;
    u32x4 v = {0u, 0u, 0u, 0u};
    if (kp0 >= 0) v = *(const u32x4*)(w_VT(p) + ((size_t)(b * 2 + hk) * 64 + drow) * SEQ + kp0);
    u32x2* d2 = (u32x2*)(VTs + drow * VTS + c16 * 8);
    d2[0] = (u32x2){v[0], v[1]}; d2[1] = (u32x2){v[2], v[3]};
  }
  for (int i = t; i < 384; i += NTHREADS) { const int hh = i >= 192, j = i - 192 * hh, dist = 159 - j; bs[i] = (dist >= 0 && dist < 128) ? w_BIAS(p)[(2 * hp + hh) * 128 + dist] : -INFINITY; }
  const size_t tokq = (size_t)b * SEQ + qpos0 + 32 * w + r;
  bf16x8 qf0[4], qf1[4];
#pragma unroll
  for (int s = 0; s < 4; ++s) { qf0[s] = *(const bf16x8*)(w_PROJ(p) + tokq * INW + (2 * hp) * 64 + 16 * s + 8 * h); qf1[s] = *(const bf16x8*)(w_PROJ(p) + tokq * INW + (2 * hp + 1) * 64 + 16 * s + 8 * h); }
  __syncthreads();
  bf16x8 ob0[4], ob1[4];
  attn_head(p, 2 * hp, blk, w, r, h, qf0, Ks, VTs, bs, ob0);
  __builtin_amdgcn_sched_barrier(0);
  attn_head(p, 2 * hp + 1, blk, w, r, h, qf1, Ks, VTs, bs + 192, ob1);
  __builtin_amdgcn_sched_barrier(0);
  __syncthreads();
  {
    const int tk = t >> 4, cc = t & 15;
    const int p0 = qpos0 + tk * 8;
    const bf16* pin = w_PROJ(p) + (size_t)b * SEQ * INW + C_PIN + g * 128 + cc * 8;
    float S[8];
#pragma unroll
    for (int j = 0; j < 8; ++j) S[j] = 0.f;
    for (int i = 0; i < win; ++i) {
      const int pp = p0 - i;
      if (pp >= 0) { const bf16x8 v = *(const bf16x8*)(pin + (size_t)pp * INW);
#pragma unroll
        for (int j = 0; j < 8; ++j) S[j] += bf2f(v[j]); }
    }
    for (int i = 0; i < 8; ++i) {
      const int pos = p0 + i;
      const bf16x8 cur = *(const bf16x8*)(pin + (size_t)pos * INW);
      if (i > 0) {
#pragma unroll
        for (int j = 0; j < 8; ++j) S[j] += bf2f(cur[j]);
        if (pos - win >= 0) { const bf16x8 old = *(const bf16x8*)(pin + (size_t)(pos - win) * INW);
#pragma unroll
          for (int j = 0; j < 8; ++j) S[j] -= bf2f(old[j]); }
      }
      const float icnt = 1.f / (float)(win < pos + 1 ? win : pos + 1);
      bf16x8 rr;
#pragma unroll
      for (int j = 0; j < 8; ++j) rr[j] = (bf16)(S[j] * icnt - bf2f(cur[j]));
      *(bf16x8*)(Rs + (tk * 8 + i) * RS + cc * 8) = rr;
    }
  }
  __syncthreads();
  const bf16* prow = w_PROJ(p) + tokq * INW;
#pragma unroll
  for (int hh = 0; hh < 2; ++hh) {
    const int head = 2 * hp + hh;
    f32x16 pa[2] = {zero16(), zero16()};
#pragma unroll
    for (int s = 0; s < 8; ++s) {
      const bf16x8 bfr = *(const bf16x8*)(Rs + (32 * w + r) * RS + 16 * s + 8 * h);
#pragma unroll
      for (int i = 0; i < 2; ++i) {
        const bf16x8 a = *(const bf16x8*)(w_PWt(p) + ((size_t)g * 256 + (head & 3) * 64 + 32 * i + r) * 128 + 16 * s + 8 * h);
        pa[i] = MFMA(a, bfr, pa[i]);
      }
    }
#pragma unroll
    for (int i = 0; i < 2; ++i)
#pragma unroll
      for (int q4 = 0; q4 < 4; ++q4) {
        const int f = head * 64 + 32 * i + 8 * q4 + 4 * h;
        const bf16x4 ga = *(const bf16x4*)(prow + C_GA + f), gb = *(const bf16x4*)(prow + C_GB + f);
        const f32x4 ps = *(const f32x4*)(p.pool_scale + f);
        bf16x4 ov;
#pragma unroll
        for (int j = 0; j < 4; ++j) { const bf16 av = hh ? ob1[2 * i + (q4 >> 1)][4 * (q4 & 1) + j] : ob0[2 * i + (q4 >> 1)][4 * (q4 & 1) + j];
          ov[j] = (bf16)(bf2f(ga[j]) * bf2f(av) + bf2f(gb[j]) * (pa[i][4 * q4 + j] * ps[j])); }
        *(bf16x4*)(w_MIXED(p) + tokq * DM + f) = ov;
      }
    __builtin_amdgcn_sched_barrier(0);
  }
}

DI void unit_attn_sample(const P& p, int u, char* smem) {
  const int b = u >> 2, g = u & 3, hk = g >> 1;
  const int t = threadIdx.x + opaque0(), lane = t & 63, w = t >> 6;
  float* ks = (float*)smem;
  float* vs = ks + 128 * 65;
  float* qs = vs + 128 * 64;
  float* ps = qs + 256;
  float* os = ps + 512;
  float* rs = os + 256;
  const size_t token = (size_t)NPR + b;
  __syncthreads();
  const float* kw = p.out + O_KWS + (size_t)b * 128 * 128 + hk * 64;
  const float* vw = p.out + O_VWS + (size_t)b * 128 * 128 + hk * 64;
#pragma unroll 4
  for (int i = t; i < 128 * 64; i += NTHREADS) { const int j = i >> 6, d = i & 63; ks[j * 65 + d] = kw[(size_t)j * 128 + d]; vs[j * 64 + d] = vw[(size_t)j * 128 + d]; }
  qs[t] = bf2f(w_PROJ(p)[token * INW + g * 256 + t]);
  if (t < 128) {
    const int win = 2 << g;
    const float cur = p.out[O_PS + ((size_t)b * 15 + 14) * 512 + g * 128 + t];
    float tot = cur;
#pragma unroll 1
    for (int i = 1; i < win; ++i) tot += p.state_pool[((size_t)b * 15 + 15 - i) * 512 + g * 128 + t];
    rs[t] = tot / (float)win - cur;
  }
  __syncthreads();
  const int head = 4 * g + w;
  const float sink = p.sinks[head];
  float s[2];
  float m = sink;
#pragma unroll
  for (int i = 0; i < 2; ++i) {
    const int j = lane + 64 * i;
    float a = 0.f;
#pragma unroll 8
    for (int d = 0; d < 64; ++d) a += qs[w * 64 + d] * ks[j * 65 + d];
    s[i] = a + w_BIAS(p)[head * 128 + 127 - j];
    m = fmaxf(m, s[i]);
  }
  for (int o = 32; o >= 1; o >>= 1) m = fmaxf(m, __shfl_xor(m, o));
  float sum = 0.f;
#pragma unroll
  for (int i = 0; i < 2; ++i) { s[i] = __expf(s[i] - m); sum += s[i]; }
  sum = wave_sum(sum);
  const float inv = 1.f / (sum + __expf(sink - m));
#pragma unroll
  for (int i = 0; i < 2; ++i) ps[w * 128 + lane + 64 * i] = s[i] * inv;
  LDS_WAIT();
  {
    float a = 0.f;
#pragma unroll 8
    for (int j = 0; j < 128; ++j) a += ps[w * 128 + j] * vs[j * 64 + lane];
    os[w * 64 + lane] = a;
  }
  const int f = g * 256 + t;
  float pl = 0.f;
  const float* pw = p.pool_w + (size_t)g * 128 * 256 + t;
#pragma unroll 8
  for (int ch = 0; ch < 128; ++ch) pl += rs[ch] * pw[(size_t)ch * 256];
  pl *= p.pool_scale[f];
  const float ga = bf2f(w_PROJ(p)[token * INW + C_GA + f]), gb = bf2f(w_PROJ(p)[token * INW + C_GB + f]);
  LDS_WAIT();
  w_MIXED(p)[token * DM + f] = (bf16)(ga * os[t] + gb * pl);
}

DI void unit8_map(int u, int& mt, int& nt) {
  if (u < 1024) { const int xcd = u & 7, slot = (u >> 3) & 63, S = (u >> 9) * 8 + xcd; mt = S * 8 + (slot & 7); nt = slot >> 3; }
  else { mt = 128; nt = u - 1024; }
}
constexpr int G2_UNITS = 1024 + 32;
DI void gemm2_map(int u, int& mt, int& nt, int& kq) {
  if (u < 1024) { unit8_map(u, mt, nt); kq = -1; }
  else { mt = 128; nt = (u - 1024) & 7; kq = (u - 1024) >> 3; }
}
DI void gemm2_first(const P& p, int u, char* smem) {
  int mt, nt, kq; gemm2_map(u, mt, nt, kq);
  const int kb = kq < 0 ? 0 : 256 * kq;
  gemm_first(w_Wt_out(p) + kb, w_MIXED(p) + kb, 1024, nt * 128, mt * 128, smem);
}
DI void unit_gemm2(const P& p, int u, int un, char* smem) {
  int mt, nt, kq; gemm2_map(u, mt, nt, kq);
  const int n0 = nt * 128, m0 = mt * 128, kb = kq < 0 ? 0 : 256 * kq;
  f32x16 acc[4];
  gemm_main(w_Wt_out(p) + kb, w_MIXED(p) + kb, 1024, kq < 0 ? 1024 : 256, n0, m0, smem, acc);
  if (un >= 0) gemm2_first(p, un, smem);
  const int tz = threadIdx.x + opaque0();
  const int lane = tz & 63, w = tz >> 6, r = lane & 31, h = lane >> 5;
  float* tbase = (float*)(smem + GBUF + w * 8704);
#pragma unroll
  for (int hf = 0; hf < 2; ++hf) {
    if (hf) LDS_WAIT();
#pragma unroll
    for (int ii = 0; ii < 2; ++ii)
#pragma unroll
      for (int q4 = 0; q4 < 4; ++q4) {
        f32x4 v;
#pragma unroll
        for (int j = 0; j < 4; ++j) v[j] = acc[2 * hf + ii][4 * q4 + j];
        *(f32x4*)(tbase + r * 68 + 32 * ii + 8 * q4 + 4 * h) = v;
      }
    LDS_WAIT();
    const int fc = (lane & 15) * 4, tsub = lane >> 4;
#pragma unroll
    for (int it = 0; it < 8; ++it) {
      const int tl = 4 * it + tsub, token = m0 + 32 * w + tl, f = n0 + 64 * hf + fc;
      const f32x4 a = *(const f32x4*)(tbase + tl * 68 + fc);
      if (kq >= 0) { *(f32x4*)(w_PART(p) + ((size_t)kq * NS + (token - NPR)) * DM + f) = a; continue; }
      const f32x4 xv = *(const f32x4*)(xrow(p, token) + f), gv = *(const f32x4*)(w_MOD(p) + (size_t)cond_row(token) * 6144 + 2048 + f);
      f32x4 o;
#pragma unroll
      for (int j = 0; j < 4; ++j) o[j] = xv[j] + gv[j] * a[j];
      *(f32x4*)(w_X1(p) + (size_t)token * DM + f) = o;
    }
  }
}

DI unsigned f2ord(float f) { const unsigned u = __float_as_uint(f); return (u & 0x80000000u) ? ~u : (u | 0x80000000u); }
DI float ord2f(unsigned u) { return __uint_as_float((u & 0x80000000u) ? (u & 0x7fffffffu) : ~u); }
DI unsigned umin_(unsigned a, unsigned b) { return a < b ? a : b; }
DI unsigned umax_(unsigned a, unsigned b) { return a > b ? a : b; }
template <int OFF> DI void sort16_desc(unsigned (&a)[64]) {
#pragma unroll
  for (int lk = 1; lk <= 4; ++lk)
#pragma unroll
    for (int lj = lk - 1; lj >= 0; --lj)
#pragma unroll
      for (int i = 0; i < 16; ++i) {
        const int k = 1 << lk, j = 1 << lj, l = i ^ j;
        if (l > i) {
          const unsigned lo = umin_(a[OFF + i], a[OFF + l]), hi = umax_(a[OFF + i], a[OFF + l]);
          const bool desc = (i & k) == 0;
          a[OFF + i] = desc ? hi : lo; a[OFF + l] = desc ? lo : hi;
        }
      }
}
DI void merge16_desc(unsigned (&a)[16]) {
#pragma unroll
  for (int lj = 3; lj >= 0; --lj)
#pragma unroll
    for (int i = 0; i < 16; ++i) {
      const int j = 1 << lj, l = i ^ j;
      if (l > i) { const unsigned lo = umin_(a[i], a[l]), hi = umax_(a[i], a[l]); a[i] = hi; a[l] = lo; }
    }
}
DI void top16_of_64(unsigned (&a)[64], unsigned (&out)[16]) {
  sort16_desc<0>(a); sort16_desc<16>(a); sort16_desc<32>(a); sort16_desc<48>(a);
  unsigned x[16], y[16];
#pragma unroll
  for (int i = 0; i < 16; ++i) { x[i] = umax_(a[i], a[31 - i]); y[i] = umax_(a[32 + i], a[63 - i]); }
  merge16_desc(x); merge16_desc(y);
#pragma unroll
  for (int i = 0; i < 16; ++i) out[i] = umax_(x[i], y[15 - i]);
  merge16_desc(out);
}
__device__ constexpr int COFF[16] = {0, 16, 24, 29, 33, 36, 38, 40, 42, 43, 44, 45, 46, 47, 48, 49};
DI unsigned umax3(unsigned a, unsigned b, unsigned c) { const unsigned m = a > b ? a : b; return m > c ? m : c; }

DI void unit_peer_route(const P& p, int u, int un, char* smem) {
  int mt, hd; unit8_map(u, mt, hd);
  const int m0 = mt * 128;
  const int t = threadIdx.x + opaque0(), lane = t & 63, w = t >> 6, r = lane & 31, h = lane >> 5;
  unsigned char* myidx = (unsigned char*)smem + 2 * GBUF + t * 32;
  unsigned top[2][16];
#pragma unroll
  for (int pp = 0; pp < 2; ++pp) {
    f32x16 acc[4];
    gemm_main(w_Wt_q(p), w_H(p), 1024, 1024, hd * 256 + pp * 128, m0, smem, acc);
    if (pp == 0) gemm_first(w_Wt_q(p), w_H(p), 1024, hd * 256 + 128, m0, smem);
    else if (un >= 0) { int mn, hn; unit8_map(un, mn, hn); gemm_first(w_Wt_q(p), w_H(p), 1024, hn * 256, mn * 128, smem); }
    f32x16 sc[4] = {zero16(), zero16(), zero16(), zero16()};
    {
      const bf16* skb = w_SK(p) + (size_t)(hd * 2 + pp) * 128 * 128;
      const int wu = __builtin_amdgcn_readfirstlane(w);
#pragma unroll
      for (int q = 0; q < 8; ++q) {
        const int j = wu + 4 * q, row = 4 * j + (lane >> 4);
        glds16(skb + (size_t)row * 128 + (((lane & 15) ^ (row & 15)) * 8), smem + GBUF + 1024 * j);
      }
      asm volatile("s_waitcnt vmcnt(0)" ::: "memory");
      __syncthreads();
    }
    bf16x8 bqs[8];
#pragma unroll
    for (int i = 0; i < 4; ++i)
#pragma unroll
      for (int s = 0; s < 2; ++s) bqs[2 * i + s] = pack_step(acc[i], s);
#pragma unroll
    for (int i = 0; i < 4; ++i)
#pragma unroll
      for (int s = 0; s < 2; ++s) {
        const bf16x8 bq = bqs[2 * i + s];
#pragma unroll
        for (int kt = 0; kt < 4; ++kt) {
          const int row = 32 * kt + r, cc = 4 * i + 2 * s;
          const char* rp = smem + GBUF + row * 256 + 8 * h;
          const bf16x8 a = cat4(*(const bf16x4*)(rp + ((cc ^ (row & 15)) * 16)), *(const bf16x4*)(rp + (((cc + 1) ^ (row & 15)) * 16)));
          sc[kt] = MFMA(a, bq, sc[kt]);
        }
      }
    unsigned pk[64];
#pragma unroll
    for (int kt = 0; kt < 4; ++kt)
#pragma unroll
      for (int j = 0; j < 16; ++j) { const int key = 32 * kt + crow(j, h); pk[kt * 16 + j] = (f2ord(sc[kt][j]) & ~127u) | (unsigned)(127 - key); }
    unsigned mine[16];
    top16_of_64(pk, mine);
#pragma unroll
    for (int i = 0; i < 16; ++i) top[pp][i] = (unsigned)__shfl_xor((int)mine[15 - i], 32);
#pragma unroll
    for (int i = 0; i < 16; ++i) top[pp][i] = umax_(top[pp][i], mine[i]);
    merge16_desc(top[pp]);
  }
  float v0[16], v1[16];
#pragma unroll
  for (int a = 0; a < 16; ++a) {
    v0[a] = ord2f(top[0][a] & ~127u); v1[a] = ord2f(top[1][a] & ~127u);
    myidx[a] = (unsigned char)(127u - (top[0][a] & 127u)); myidx[16 + a] = (unsigned char)(127u - (top[1][a] & 127u));
  }
  unsigned cand[64];
#pragma unroll
  for (int i = 50; i < 64; ++i) cand[i] = 0u;
#pragma unroll
  for (int a = 0; a < 16; ++a)
#pragma unroll
    for (int bb = 0; bb < 16 / (a + 1); ++bb)
      cand[COFF[a] + bb] = (f2ord(v0[a] + v1[bb]) & ~255u) | (unsigned)(255 - (a * 16 + bb));
  unsigned best[16];
  top16_of_64(cand, best);
  const float smax = ord2f(best[0] & ~255u);
  float e[16], esum = 0.f;
#pragma unroll
  for (int i = 0; i < 16; ++i) { e[i] = __expf(ord2f(best[i] & ~255u) - smax); esum += e[i]; }
  const float einv = 1.f / esum;
  const size_t token = (size_t)m0 + 32 * w + r;
  int* ip = w_IDX(p) + token * 128 + hd * 16 + 8 * h;
  float* gp = w_GATE(p) + token * 128 + hd * 16 + 8 * h;
  const unsigned hmask = 0u - (unsigned)h;
#pragma unroll
  for (int i = 0; i < 8; ++i) {
    const unsigned bsel = best[i] ^ ((best[i] ^ best[8 + i]) & hmask);
    const float esel = __uint_as_float(__float_as_uint(e[i]) ^ ((__float_as_uint(e[i]) ^ __float_as_uint(e[8 + i])) & hmask));
    const unsigned code = 255u - (bsel & 255u);
    const int a = code >> 4, bb = code & 15;
    ip[i] = (int)myidx[a] * 128 + (int)myidx[16 + bb];
    gp[i] = esel * einv;
  }
}

DI float gelu_fast(float v) {
  const float av = fabsf(v), tt = __builtin_amdgcn_rcpf(av * 0.2316418882f + 1.0f);
  float q = tt * 0.5307027145f - 0.7265760135f; q = q * tt + 0.7107068705f; q = q * tt - 0.142248368f; q = q * tt + 0.127414796f; q = q * tt;
  const float e = __builtin_amdgcn_exp2f(v * v * -0.72134752044f);
  const float m = v * (q * e);
  return v < 0.f ? m : v - m;
}
DI float dot2bf(unsigned a, unsigned b, float acc) { return __builtin_amdgcn_fdot2_f32_bf16(__builtin_bit_cast(bf16x2, a), __builtin_bit_cast(bf16x2, b), acc, false); }
DI unsigned pkbf(f32x2 v) { bf16x2 r; r[0] = (bf16)v[0]; r[1] = (bf16)v[1]; return __builtin_bit_cast(unsigned, r); }
DI int dot16i(u32x4 u8, u32x4 x8, int d) {
#pragma unroll
  for (int m = 0; m < 4; ++m) d = __builtin_amdgcn_sdot4((int)u8[m], (int)x8[m], d, false);
  return d;
}
DI void axpy16p(f32x2* o, u32x4 v8, f32x2 c2) {
#pragma unroll
  for (int m = 0; m < 4; ++m) {
    const int wd = (int)v8[m];
    o[2 * m] = __builtin_elementwise_fma(c2, __builtin_amdgcn_cvt_pk_f32_fp8(wd, false), o[2 * m]);
    o[2 * m + 1] = __builtin_elementwise_fma(c2, __builtin_amdgcn_cvt_pk_f32_fp8(wd, true), o[2 * m + 1]);
  }
}
DI int dpp_add16i(int v) {
  v += __builtin_amdgcn_update_dpp(0, v, 0x140, 0xf, 0xf, true);
  v += __builtin_amdgcn_update_dpp(0, v, 0x141, 0xf, 0xf, true);
  v += __builtin_amdgcn_update_dpp(0, v, 0x4e, 0xf, 0xf, true);
  v += __builtin_amdgcn_update_dpp(0, v, 0xb1, 0xf, 0xf, true);
  return v;
}
DI float dot16(u32x4 u8, u32x4 xlo, u32x4 xhi, float d) {
#pragma unroll
  for (int m = 0; m < 4; ++m) {
    const int wd = (int)u8[m];
    const unsigned p01 = pkbf(__builtin_amdgcn_cvt_pk_f32_fp8(wd, false)), p23 = pkbf(__builtin_amdgcn_cvt_pk_f32_fp8(wd, true));
    const unsigned x01 = m < 2 ? xlo[2 * m] : xhi[2 * m - 4], x23 = m < 2 ? xlo[2 * m + 1] : xhi[2 * m - 3];
    d = dot2bf(p01, x01, d); d = dot2bf(p23, x23, d);
  }
  return d;
}
DI void axpy16(float* o, u32x4 v8, float c) {
#pragma unroll
  for (int m = 0; m < 4; ++m) {
    const int wd = (int)v8[m];
    const f32x2 a = __builtin_amdgcn_cvt_pk_f32_fp8(wd, false), b = __builtin_amdgcn_cvt_pk_f32_fp8(wd, true);
    o[4 * m] += c * a[0]; o[4 * m + 1] += c * a[1]; o[4 * m + 2] += c * b[0]; o[4 * m + 3] += c * b[1];
  }
}
DI float reduce4(const float (&d)[4], int lane) {
  const int h = lane >> 5, b4 = (lane >> 4) & 1;
  float a0 = h ? d[2] : d[0], a1 = h ? d[3] : d[1];
  const float s0 = h ? d[0] : d[2], s1 = h ? d[1] : d[3];
  a0 += __shfl_xor(s0, 32); a1 += __shfl_xor(s1, 32);
  float k = b4 ? a1 : a0;
  const float s = b4 ? a0 : a1;
  k += __shfl_xor(s, 16);
  k += __shfl_xor(k, 8); k += __shfl_xor(k, 4); k += __shfl_xor(k, 2); k += __shfl_xor(k, 1);
  return k;
}
DI float dpp_add16(float v) {
  v += __int_as_float(__builtin_amdgcn_update_dpp(0, __float_as_int(v), 0x140, 0xf, 0xf, true));
  v += __int_as_float(__builtin_amdgcn_update_dpp(0, __float_as_int(v), 0x141, 0xf, 0xf, true));
  v += __int_as_float(__builtin_amdgcn_update_dpp(0, __float_as_int(v), 0x4e, 0xf, 0xf, true));
  v += __int_as_float(__builtin_amdgcn_update_dpp(0, __float_as_int(v), 0xb1, 0xf, 0xf, true));
  return v;
}
constexpr int PEER_GLDS = 512 + 128 * 16;
constexpr int PEER_WLDS = 4 * PEER_GLDS;
template <int PART>
DI void peer_wave4(const P& p, int g, char* wl) {
  const int lane = (threadIdx.x + opaque0()) & 63, q = lane >> 4, j16 = lane & 15;
  unsigned* hist = (unsigned*)(wl + q * PEER_GLDS);
  u32x4* list = (u32x4*)(wl + q * PEER_GLDS + 512);
  const int token = 4 * g + q;
  if constexpr (PART != 2) {
  u32x4 x[4];
  {
    const unsigned char* hrow = w_H8(p) + (size_t)token * DM + 16 * j16;
#pragma unroll
    for (int i = 0; i < 4; ++i) x[i] = *(const u32x4*)(hrow + 256 * i);
  }
  const float xs = w_HS(p)[token];
  {
    int ids[8]; float gts[8], su[8];
#pragma unroll
    for (int i = 0; i < 8; ++i) { const size_t o = (size_t)token * 128 + j16 + 16 * i; ids[i] = w_IDX(p)[o]; gts[i] = w_GATE(p)[o]; }
#pragma unroll
    for (int i = 0; i < 8; ++i) { su[i] = w_SU(p)[ids[i]] * xs; gts[i] *= w_SV(p)[ids[i]]; }
    LDS_WAIT();
    *(u32x4*)(hist + 8 * j16) = (u32x4){0u, 0u, 0u, 0u}; *(u32x4*)(hist + 8 * j16 + 4) = (u32x4){0u, 0u, 0u, 0u};
    LDS_WAIT();
#pragma unroll
    for (int i = 0; i < 8; ++i) (void)__hip_atomic_fetch_add(&hist[ids[i] >> 7], 1u, __ATOMIC_RELAXED, __HIP_MEMORY_SCOPE_WAVEFRONT);
    LDS_WAIT();
    const u32x4 ca = *(const u32x4*)(hist + 8 * j16), cb = *(const u32x4*)(hist + 8 * j16 + 4);
    const unsigned tot = ca[0] + ca[1] + ca[2] + ca[3] + cb[0] + cb[1] + cb[2] + cb[3];
    unsigned scan = tot;
#pragma unroll
    for (int o = 1; o < 16; o <<= 1) { const unsigned tv = (unsigned)__shfl_up((int)scan, o, 16); if (j16 >= o) scan += tv; }
    unsigned e0 = scan - tot;
    u32x4 pa, pb;
    pa[0] = e0; e0 += ca[0]; pa[1] = e0; e0 += ca[1]; pa[2] = e0; e0 += ca[2]; pa[3] = e0; e0 += ca[3];
    pb[0] = e0; e0 += cb[0]; pb[1] = e0; e0 += cb[1]; pb[2] = e0; e0 += cb[2]; pb[3] = e0;
    LDS_WAIT();
    *(u32x4*)(hist + 8 * j16) = pa; *(u32x4*)(hist + 8 * j16 + 4) = pb;
    LDS_WAIT();
#pragma unroll
    for (int i = 0; i < 8; ++i) {
      const unsigned pos = __hip_atomic_fetch_add(&hist[ids[i] >> 7], 1u, __ATOMIC_RELAXED, __HIP_MEMORY_SCOPE_WAVEFRONT);
      list[pos] = (u32x4){(unsigned)ids[i], __float_as_uint(su[i]), __float_as_uint(gts[i]), 0u};
    }
    LDS_WAIT();
  }
  const unsigned char* Ub = w_Ub(p) + 16 * j16;
  {
    u32x4 uA[4], uB[4];
    u32x4 eA = list[0], eB = list[1];
#pragma unroll
    for (int i = 0; i < 4; ++i) uA[i] = *(const u32x4*)(Ub + (size_t)eA[0] * DM + 256 * i);
#pragma unroll
    for (int i = 0; i < 4; ++i) uB[i] = *(const u32x4*)(Ub + (size_t)eB[0] * DM + 256 * i);
#define PEER_USTEP(U, E, K)                                                                                            \
    {                                                                                                                  \
      const float su = __uint_as_float(E[1]), gsv = __uint_as_float(E[2]);                                             \
      int d0 = 0, d1 = 0;                                                                                              \
      d0 = dot16i(U[0], x[0], d0); d1 = dot16i(U[1], x[1], d1); d0 = dot16i(U[2], x[2], d0); d1 = dot16i(U[3], x[3], d1); \
      E = list[(K) + 2 < 128 ? (K) + 2 : 127];                       \
      _Pragma("unroll") for (int i = 0; i < 4; ++i) U[i] = *(const u32x4*)(Ub + (size_t)E[0] * DM + 256 * i);          \
      const float c = gsv * gelu_fast(su * (float)dpp_add16i(d0 + d1));                                                \
      if (j16 == 0) ((float*)&list[K])[3] = c;                                                                          \
    }
#pragma unroll 1
    for (int k = 0; k < 128; k += 2) {
      PEER_USTEP(uA, eA, k)
      PEER_USTEP(uB, eB, k + 1)
    }
  }
  }
  if constexpr (PART != 1) {
  LDS_WAIT();
  const unsigned char* Vb = w_Vb(p) + 16 * j16;
  f32x2 acc[32];
#pragma unroll
  for (int i = 0; i < 32; ++i) acc[i] = (f32x2){0.f, 0.f};
  {
    u32x4 vA[4], vB[4];
    u32x4 eA = list[0], eB = list[1];
#pragma unroll
    for (int i = 0; i < 4; ++i) vA[i] = *(const u32x4*)(Vb + (size_t)eA[0] * DM + 256 * i);
#pragma unroll
    for (int i = 0; i < 4; ++i) vB[i] = *(const u32x4*)(Vb + (size_t)eB[0] * DM + 256 * i);
#define PEER_VSTEP(V, E, K)                                                                                            \
    {                                                                                                                  \
      const float c = __uint_as_float(E[3]);                                                                           \
      const f32x2 c2 = {c, c};                                                                                         \
      _Pragma("unroll") for (int i = 0; i < 4; ++i) axpy16p(acc + 8 * i, V[i], c2);                                    \
      E = list[(K) + 2 < 128 ? (K) + 2 : 127];                                                                         \
      _Pragma("unroll") for (int i = 0; i < 4; ++i) V[i] = *(const u32x4*)(Vb + (size_t)E[0] * DM + 256 * i);          \
    }
#pragma unroll 1
    for (int k = 0; k < 128; k += 2) {
      PEER_VSTEP(vA, eA, k)
      PEER_VSTEP(vB, eB, k + 1)
    }
  }
  const float* x1 = w_X1(p) + (size_t)token * DM + 16 * j16;
  const float* g2 = w_MOD(p) + (size_t)cond_row(token) * 6144 + 5120 + 16 * j16;
  float* y = p.out + O_YP + (size_t)token * DM + 16 * j16;
#pragma unroll
  for (int i = 0; i < 4; ++i)
#pragma unroll
    for (int mm = 0; mm < 4; ++mm) {
      const int c0 = 256 * i + 4 * mm;
      const f32x4 xv = *(const f32x4*)(x1 + c0), gv = *(const f32x4*)(g2 + c0);
      f32x4 yv;
#pragma unroll
      for (int j = 0; j < 4; ++j) yv[j] = xv[j] + gv[j] * acc[8 * i + 2 * mm + (j >> 1)][j & 1];
      *(f32x4*)(y + c0) = yv;
    }
  }
}
DI void peer_token_block(const P& p, int token, char* smem) {
  const int t = threadIdx.x + opaque0(), lane = t & 63, w = t >> 6;
  float* red = (float*)smem;
  const u32x4 x8 = *(const u32x4*)(w_H8(p) + (size_t)token * DM + 16 * lane);
  const int myid = w_IDX(p)[(size_t)token * 128 + 32 * w + (lane & 31)];
  const float mysu = w_SU(p)[myid] * w_HS(p)[token];
  const float mygs = w_GATE(p)[(size_t)token * 128 + 32 * w + (lane & 31)] * w_SV(p)[myid];
  float o[16];
#pragma unroll
  for (int i = 0; i < 16; ++i) o[i] = 0.f;
#pragma unroll 1
  for (int e0 = 0; e0 < 32; e0 += 8) {
    u32x4 u8[8], v8[8];
#pragma unroll
    for (int qq = 0; qq < 8; ++qq) {
      const size_t ro = (size_t)__builtin_amdgcn_readlane(myid, e0 + qq) * DM + 16 * lane;
      u8[qq] = *(const u32x4*)(w_Ub(p) + ro); v8[qq] = *(const u32x4*)(w_Vb(p) + ro);
    }
#pragma unroll
    for (int hb = 0; hb < 2; ++hb) {
      float d[4];
#pragma unroll
      for (int qq = 0; qq < 4; ++qq) d[qq] = (float)dot16i(u8[4 * hb + qq], x8, 0);
      const float kv = reduce4(d, lane);
#pragma unroll
      for (int qq = 0; qq < 4; ++qq) {
        const int e = e0 + 4 * hb + qq;
        const float a = __int_as_float(__builtin_amdgcn_readlane(__float_as_int(kv), 16 * qq)) * __int_as_float(__builtin_amdgcn_readlane(__float_as_int(mysu), e));
        const float c = __int_as_float(__builtin_amdgcn_readlane(__float_as_int(mygs), e)) * gelu_fast(a);
        axpy16(o, v8[4 * hb + qq], c);
      }
    }
  }
  __syncthreads();
#pragma unroll
  for (int i = 0; i < 16; ++i) red[w * 1024 + 16 * lane + i] = o[i];
  __syncthreads();
  if (w == 0) {
    const float* x1 = w_X1(p) + (size_t)token * DM + 16 * lane;
    const float* g2 = w_MOD(p) + (size_t)cond_row(token) * 6144 + 5120 + 16 * lane;
    float* y = p.out + O_YP + (size_t)token * DM + 16 * lane;
#pragma unroll
    for (int mm = 0; mm < 4; ++mm) {
      const f32x4 xv = *(const f32x4*)(x1 + 4 * mm), gv = *(const f32x4*)(g2 + 4 * mm);
      f32x4 yv;
#pragma unroll
      for (int j = 0; j < 4; ++j) { const int c = 16 * lane + 4 * mm + j; yv[j] = xv[j] + gv[j] * (red[c] + red[1024 + c] + red[2048 + c] + red[3072 + c]); }
      *(f32x4*)(y + 4 * mm) = yv;
    }
  }
}

constexpr int NPHASE = 8;

#if defined(PROBE_ATTN) || defined(PROBE_SAMP)
DI int probe_token(int i) { return (i * 131 + 3) % NPR; }
DI float block_sum_p(float v, float* red) {
  __syncthreads();
  v = wave_sum(v);
  if ((threadIdx.x & 63) == 0) red[threadIdx.x >> 6] = v;
  __syncthreads();
  return red[0] + red[1] + red[2] + red[3];
}
DI float block_max_p(float v, float* red) {
  __syncthreads();
  for (int o = 32; o >= 1; o >>= 1) v = fmaxf(v, __shfl_xor(v, o));
  if ((threadIdx.x & 63) == 0) red[threadIdx.x >> 6] = v;
  __syncthreads();
  return fmaxf(fmaxf(red[0], red[1]), fmaxf(red[2], red[3]));
}
#endif
#ifdef PROBE_ATTN
DI void probe_attn(const P& p, int i, char* smem) {
  float* red = (float*)smem;
  float* pr = red + 4;
  float* attn = pr + 128;
  float* rr = attn + 1024;
  const int token = probe_token(i), b = token >> 11, pos = token & 2047, t = threadIdx.x;
  const bf16* prow = w_PROJ(p) + (size_t)token * INW;
  for (int head = 0; head < 16; ++head) {
    const int hk = head >> 3;
    float s = -INFINITY;
    const int kp = pos - 127 + (t & 127);
    if (t < 128 && kp >= 0) {
      float a = 0.f;
      const bf16* kr = w_PROJ(p) + ((size_t)b * SEQ + kp) * INW + C_K + hk * 64;
      for (int d = 0; d < 64; ++d) a += bf2f(prow[head * 64 + d]) * bf2f(kr[d]);
      s = a + w_BIAS(p)[head * 128 + (pos - kp)];
    }
    float m = block_max_p(s, red);
    m = fmaxf(m, p.sinks[head]);
    const float e = (t < 128 && kp >= 0) ? __expf(s - m) : 0.f;
    const float den = block_sum_p(e, red) + __expf(p.sinks[head] - m);
    if (t < 128) pr[t] = e / den;
    __syncthreads();
    if (t < 64) {
      float o = 0.f;
      for (int j = 0; j < 128; ++j) { const int kq = pos - 127 + j; if (kq >= 0) o += pr[j] * bf2f(w_VT(p)[((size_t)(b * 2 + hk) * 64 + t) * SEQ + kq]); }
      attn[head * 64 + t] = o;
    }
    __syncthreads();
  }
  for (int c = t; c < 512; c += 256) {
    const int g = c >> 7, win = 2 << g;
    float tot = 0.f;
    for (int j = 0; j < win; ++j) if (pos - j >= 0) tot += bf2f(w_PROJ(p)[((size_t)b * SEQ + pos - j) * INW + C_PIN + c]);
    const float cnt = (float)(win < pos + 1 ? win : pos + 1);
    rr[c] = bf2f((bf16)(tot / cnt - bf2f(prow[C_PIN + c])));
  }
  __syncthreads();
  for (int f = t; f < 1024; f += 256) {
    const int g = f >> 8;
    float pl = 0.f;
    for (int ch = 0; ch < 128; ++ch) pl += rr[g * 128 + ch] * bf2f(w_PWt(p)[((size_t)g * 256 + (f & 255)) * 128 + ch]);
    const float naive = bf2f(prow[C_GA + f]) * attn[f] + bf2f(prow[C_GB + f]) * (pl * p.pool_scale[f]);
    const float fast = bf2f(w_MIXED(p)[(size_t)token * DM + f]);
    p.out[O_KWP + (size_t)i * DM + f] += (float)(PROBE_ATTN) * (fast - naive);
  }
  __syncthreads();
}
#endif

#ifdef PROBE_SAMP
DI void probe_samp(const P& p, int b, char* smem) {
  float* red = (float*)smem;
  float* pr = red + 4;
  float* attn = pr + 128;
  float* rr = attn + 1024;
  const int t = threadIdx.x;
  const size_t token = (size_t)NPR + b;
  const bf16* prow = w_PROJ(p) + token * INW;
  for (int head = 0; head < 16; ++head) {
    const int hk = head >> 3;
    float s = -INFINITY;
    if (t < 128) {
      const float* kr = t < 127 ? p.cache_k + (((size_t)b * 128 + t + 1) * 2 + hk) * 64 : p.out + O_KWS + (((size_t)b * 128 + 127) * 2 + hk) * 64;
      float a = 0.f;
      for (int d = 0; d < 64; ++d) a += bf2f(prow[head * 64 + d]) * kr[d];
      s = a + p.rel_table[(127 - t < 16 ? 127 - t : min(31, 16 + (int)(logf((float)(127 - t) / 16.f) / logf(8.f) * 16.f))) * 16 + head];
    }
    float m = block_max_p(s, red);
    m = fmaxf(m, p.sinks[head]);
    const float e = t < 128 ? __expf(s - m) : 0.f;
    const float den = block_sum_p(e, red) + __expf(p.sinks[head] - m);
    if (t < 128) pr[t] = e / den;
    __syncthreads();
    if (t < 64) {
      float o = 0.f;
      for (int j = 0; j < 128; ++j) { const float* vr = j < 127 ? p.cache_v + (((size_t)b * 128 + j + 1) * 2 + hk) * 64 : p.out + O_VWS + (((size_t)b * 128 + 127) * 2 + hk) * 64; o += pr[j] * vr[t]; }
      attn[head * 64 + t] = o;
    }
    __syncthreads();
  }
  for (int c = t; c < 512; c += 256) {
    const int g = c >> 7, win = 2 << g;
    const float cur = p.out[O_PS + ((size_t)b * 15 + 14) * 512 + c];
    float tot = cur;
    for (int j = 1; j < win; ++j) tot += p.state_pool[((size_t)b * 15 + 15 - j) * 512 + c];
    rr[c] = tot / (float)win - cur;
  }
  __syncthreads();
  for (int f = t; f < 1024; f += 256) {
    const int g = f >> 8;
    float pl = 0.f;
    for (int ch = 0; ch < 128; ++ch) pl += rr[g * 128 + ch] * p.pool_w[((size_t)g * 128 + ch) * 256 + (f & 255)];
    const float naive = bf2f(prow[C_GA + f]) * attn[f] + bf2f(prow[C_GB + f]) * (pl * p.pool_scale[f]);
    const float fast = bf2f(w_MIXED(p)[token * DM + f]);
    p.out[O_KWP + (size_t)b * DM + f] += (float)(PROBE_SAMP) * (fast - naive);
  }
  __syncthreads();
}
#endif
template <class First, class Main, class Fill> DI void run_with_filler(int G, int bid, int nmain, int nfill, First firstf, Main mainf, Fill fillf) {
  if (bid < nmain) { __syncthreads(); firstf(bid); }
  for (int u = bid; u < nmain; u += G) mainf(u, u + G < nmain ? u + G : -1);
  const int rem = nmain % G;
  if (rem == 0) { for (int f = bid; f < nfill; f += G) fillf(f); }
  else if (bid >= rem) { for (int f = bid - rem; f < nfill; f += G - rem) fillf(f); }
}
template <int PH> DI void run_phase(const P& p, char* smem) {
  const int G = gridDim.x, bid = blockIdx.x, w = __builtin_amdgcn_readfirstlane(threadIdx.x >> 6);
  if constexpr (PH == 0) { run_with_filler(G, bid, U0_MOD, F0_TOTAL, [&](int) {}, [&](int u, int) { unit_mod(p, u, smem); }, [&](int f) { phase0_filler(p, f, smem); }); }
  if constexpr (PH == 1) { for (int tk = bid * 4 + w; tk < NTOK; tk += G * 4) norm_row(p, tk, 0); }
  if constexpr (PH == 2) {
    run_with_filler(G, bid, 129 * 30, F2_TOTAL, [&](int u) { gemm_first(w_Wt_in(p), w_H(p), 1024, (u % 30) * 128, (u / 30) * 128, smem); },
                    [&](int u, int un) { unit_gemm1(p, u, un, smem); }, [&](int f) { phase2_filler(p, f, smem); });
  }
  if constexpr (PH == 3) { for (int u = bid; u < 1024; u += G) unit_attn_prompt(p, u, smem);
                           for (int u = bid; u < 512; u += G) unit_attn_sample(p, u, smem); }
  if constexpr (PH == 4) {
    run_with_filler(G, bid, G2_UNITS, F4_TOTAL, [&](int u) { gemm2_first(p, u, smem); },
                    [&](int u, int un) { unit_gemm2(p, u, un, smem); }, [&](int f) { unit_convert(p.sub_keys, w_SK(p), f); });
  }
  if constexpr (PH == 5) { for (int tk = bid * 4 + w; tk < NTOK; tk += G * 4) norm_row(p, tk, 1); }
  if constexpr (PH == 6) {
    run_with_filler(G, bid, 129 * 8, F6_TOTAL, [&](int u) { int mt, hd; unit8_map(u, mt, hd); gemm_first(w_Wt_q(p), w_H(p), 1024, hd * 256, mt * 128, smem); },
                    [&](int u, int un) { unit_peer_route(p, u, un, smem); }, [&](int f) { if (f < F6_QU) unit_quant_rows<true>(p.peer_u, w_Ub(p), w_SU(p), f); else unit_quant_rows<false>(p.peer_v, w_Vb(p), w_SV(p), f - F6_QU); });
  }
  if constexpr (PH == 7) {
    for (int g = bid * 4 + w; g < NPR / 4; g += G * 4) peer_wave4<0>(p, g, smem + w * PEER_WLDS);
    for (int s = bid; s < NS; s += G) peer_token_block(p, NPR + s, smem + 4 * PEER_WLDS);
  }
}
#if ONE_LAUNCH
__global__ void __launch_bounds__(NTHREADS, 2) mega(P p) {
  __shared__ __attribute__((aligned(16))) char smem[SMEM_BYTES + 16];
  volatile unsigned* st = (volatile unsigned*)(smem + SMEM_BYTES);
  if (threadIdx.x == 0) { st[0] = 0u; st[1] = 0u; }
  __syncthreads();
  const unsigned xcc = xb_xcc_id();
  if (threadIdx.x == 0) (void)xb_add(&w_bar(p)[XB_XCNT(xcc)], 1u);
#ifndef REPEAT_MASK
#define REPEAT_MASK 0
#endif
#define RUN_PH(k) do { run_phase<k>(p, smem); if ((REPEAT_MASK >> k) & 1) { xcd_barrier(w_bar(p), xcc, st); run_phase<k>(p, smem); } } while (0)
  RUN_PH(0); xcd_barrier(w_bar(p), xcc, st);
  RUN_PH(1); xcd_barrier(w_bar(p), xcc, st);
  RUN_PH(2); xcd_barrier(w_bar(p), xcc, st);
  RUN_PH(3); xcd_barrier(w_bar(p), xcc, st);
#ifdef PROBE_ATTN
  for (int i = blockIdx.x; i < 128; i += gridDim.x) probe_attn(p, i, smem);
  xcd_barrier(w_bar(p), xcc, st);
#endif
#ifdef PROBE_SAMP
  for (int i = blockIdx.x; i < 128; i += gridDim.x) probe_samp(p, i, smem);
  xcd_barrier(w_bar(p), xcc, st);
#endif
  RUN_PH(4); xcd_barrier(w_bar(p), xcc, st);
  RUN_PH(5); xcd_barrier(w_bar(p), xcc, st);
  RUN_PH(6); xcd_barrier(w_bar(p), xcc, st);
#if PEER_ALIGN
  { const int G = gridDim.x, bid = blockIdx.x, w = __builtin_amdgcn_readfirstlane(threadIdx.x >> 6);
    for (int g = bid * 4 + w, it = 0; it < (NPR / 4 + G * 4 - 1) / (G * 4); g += G * 4, ++it) {
      if (it > 0) xcd_barrier(w_bar(p), xcc, st);
      if (g < NPR / 4) peer_wave4<1>(p, g, smem + w * PEER_WLDS);
#if PEER_ALIGN > 1
      xcd_barrier(w_bar(p), xcc, st);
#endif
      if (g < NPR / 4) peer_wave4<2>(p, g, smem + w * PEER_WLDS);
    }
    for (int s = bid; s < NS; s += G) peer_token_block(p, NPR + s, smem + 4 * PEER_WLDS); }
#else
  RUN_PH(7);
#endif
}
#else
template <int PH> __global__ void __launch_bounds__(NTHREADS, 2) mega(P p) {
  __shared__ __attribute__((aligned(16))) char smem[SMEM_BYTES];
  run_phase<PH>(p, smem);
}
#endif


extern "C" void kernel_launch(void* const* d_in, const int* in_sizes, int n_in, void* d_out, int out_size, void* d_ws, size_t ws_size, hipStream_t stream) {
  P p{};
  const float* const* in = (const float* const*)d_in;
  p.x_prompt = in[0]; p.x_sample = in[1]; p.cache_k = in[2]; p.cache_v = in[3]; p.state_pool = in[4]; p.c_prompt = in[5]; p.c_sample = in[6];
  p.rel_table = in[7]; p.ada_w = in[8]; p.ada_b = in[9]; p.norm1_g = in[10]; p.w_in = in[11]; p.q_norm_g = in[12]; p.k_norm_g = in[13]; p.sinks = in[14];
  p.pool_w = in[15]; p.pool_scale = in[16]; p.w_out = in[17]; p.norm2_g = in[18]; p.w_query = in[19]; p.sub_keys = in[20]; p.peer_u = in[21]; p.peer_v = in[22];
  p.out = (float*)d_out;
  p.ws = (char*)d_ws;
  if (WS_NEED > ws_size) { fprintf(stderr, "workspace too small: need %zu have %zu\n", (size_t)WS_NEED, ws_size); return; }

  static int grid_blocks = 0;
  if (!grid_blocks) {
    int dev = 0, cus = 0, per_cu = 0;
    (void)hipGetDevice(&dev);
    (void)hipDeviceGetAttribute(&cus, hipDeviceAttributeMultiprocessorCount, dev);
#if ONE_LAUNCH
    (void)hipOccupancyMaxActiveBlocksPerMultiprocessor(&per_cu, mega, NTHREADS, 0);
#else
    per_cu = 2;
#endif
    if (per_cu > 2) per_cu = 2;
    if (per_cu < 1) per_cu = 1;
    if (cus < 1) cus = 256;
    grid_blocks = cus * per_cu;
  }
#if ONE_LAUNCH
  (void)hipMemsetAsync(p.ws + OFF_BAR, 0, XCD_BAR_WORDS * 4, stream);
  hipLaunchKernelGGL(mega, dim3(grid_blocks), dim3(NTHREADS), 0, stream, p);
#else
  hipLaunchKernelGGL(mega<0>, dim3(grid_blocks), dim3(NTHREADS), 0, stream, p);
  hipLaunchKernelGGL(mega<1>, dim3(grid_blocks), dim3(NTHREADS), 0, stream, p);
  hipLaunchKernelGGL(mega<2>, dim3(grid_blocks), dim3(NTHREADS), 0, stream, p);
  hipLaunchKernelGGL(mega<3>, dim3(grid_blocks), dim3(NTHREADS), 0, stream, p);
  hipLaunchKernelGGL(mega<4>, dim3(grid_blocks), dim3(NTHREADS), 0, stream, p);
  hipLaunchKernelGGL(mega<5>, dim3(grid_blocks), dim3(NTHREADS), 0, stream, p);
  hipLaunchKernelGGL(mega<6>, dim3(grid_blocks), dim3(NTHREADS), 0, stream, p);
  hipLaunchKernelGGL(mega<7>, dim3(grid_blocks), dim3(NTHREADS), 0, stream, p);
#endif

}
```

```cpp
#include <hip/hip_runtime.h>
#include <stdint.h>
#include <stdio.h>

#ifndef ONE_LAUNCH
#define ONE_LAUNCH 1
#endif
#ifndef PEER_ALIGN
#define PEER_ALIGN 1
#endif

typedef __bf16 bf16;
typedef __bf16 bf16x2 __attribute__((ext_vector_type(2)));
typedef __bf16 bf16x4 __attribute__((ext_vector_type(4)));
typedef __bf16 bf16x8 __attribute__((ext_vector_type(8)));
typedef float f32x2 __attribute__((ext_vector_type(2)));
typedef float f32x4 __attribute__((ext_vector_type(4)));
typedef float f32x16 __attribute__((ext_vector_type(16)));
typedef unsigned u32x2 __attribute__((ext_vector_type(2)));
typedef unsigned u32x4 __attribute__((ext_vector_type(4)));

#define DI __device__ __forceinline__
#define MFMA(a, b, c) __builtin_amdgcn_mfma_f32_32x32x16_bf16((a), (b), (c), 0, 0, 0)

constexpr int DM = 1024, NB = 8, SEQ = 2048, NS = 128, NPR = NB * SEQ, NTOK = NPR + NS;
constexpr int INW = 3840, NMOD = NB + NS;
constexpr int C_K = 1024, C_V = 1152, C_PIN = 1280, C_GA = 1792, C_GB = 2816;
constexpr int NEXP = 16384;
constexpr float EPS = 1e-6f;
constexpr size_t O_YP = 0, O_KWP = 16908288, O_VWP = 17039360, O_PP = 17170432, O_KWS = 17231872, O_VWS = 19329024, O_PS = 21426176;

constexpr int SMEM_BYTES = 77824;
constexpr int NTHREADS = 256;

struct P {
  const float *x_prompt, *x_sample, *cache_k, *cache_v, *state_pool, *c_prompt, *c_sample, *rel_table, *ada_w, *ada_b, *norm1_g, *w_in,
      *q_norm_g, *k_norm_g, *sinks, *pool_w, *pool_scale, *w_out, *norm2_g, *w_query, *sub_keys, *peer_u, *peer_v;
  float* out;
  char* ws;
};
constexpr size_t al256(size_t x) { return (x + 255) & ~(size_t)255; }
constexpr size_t OFF_BAR = 0;
constexpr size_t OFF_WTIN = OFF_BAR + al256(4096 * 4);
constexpr size_t OFF_WTOUT = OFF_WTIN + al256((size_t)INW * 1024 * 2);
constexpr size_t OFF_WTQ = OFF_WTOUT + al256((size_t)1024 * 1024 * 2);
constexpr size_t OFF_SK = OFF_WTQ + al256((size_t)2048 * 1024 * 2);
constexpr size_t OFF_PWT = OFF_SK + al256((size_t)16 * 128 * 128 * 2);
constexpr size_t OFF_UB = OFF_PWT + al256((size_t)4 * 256 * 128 * 2);
constexpr size_t OFF_VB = OFF_UB + al256((size_t)NEXP * DM);
constexpr size_t OFF_SU = OFF_VB + al256((size_t)NEXP * DM);
constexpr size_t OFF_SV = OFF_SU + al256((size_t)NEXP * 4);
constexpr size_t OFF_H8 = OFF_SV + al256((size_t)NEXP * 4);
constexpr size_t OFF_HS = OFF_H8 + al256((size_t)NTOK * DM);
constexpr size_t OFF_PART = OFF_HS + al256((size_t)NTOK * 4);
constexpr size_t OFF_MOD = OFF_PART + al256((size_t)4 * NS * DM * 4);
constexpr size_t OFF_BIAS = OFF_MOD + al256((size_t)NMOD * 6144 * 4);
constexpr size_t OFF_VT = OFF_BIAS + al256(16 * 128 * 4);
constexpr size_t OFF_H = OFF_VT + al256((size_t)NB * 128 * SEQ * 2);
constexpr size_t OFF_MIXED = OFF_H;
constexpr size_t OFF_PROJ = OFF_H + al256((size_t)NTOK * DM * 2);
constexpr size_t OFF_X1 = OFF_PROJ;
constexpr size_t OFF_IDX = OFF_X1 + (size_t)NTOK * DM * 4;
constexpr size_t OFF_GATE = OFF_IDX + (size_t)NTOK * 128 * 4;
constexpr size_t WS_NEED = OFF_PROJ + al256((size_t)NTOK * INW * 2);
static_assert(OFF_GATE + (size_t)NTOK * 128 * 4 <= WS_NEED, "overlay fits");
static_assert(WS_NEED <= (size_t)256 * 1024 * 1024, "workspace budget");
#define WS_PTR(T, name, OFF) __device__ __forceinline__ T* name(const P& p) { return (T*)(p.ws + (OFF)); }
WS_PTR(unsigned, w_bar, OFF_BAR) WS_PTR(bf16, w_Wt_in, OFF_WTIN) WS_PTR(bf16, w_Wt_out, OFF_WTOUT) WS_PTR(bf16, w_Wt_q, OFF_WTQ) WS_PTR(bf16, w_SK, OFF_SK)
WS_PTR(bf16, w_PWt, OFF_PWT) WS_PTR(unsigned char, w_Ub, OFF_UB) WS_PTR(unsigned char, w_Vb, OFF_VB) WS_PTR(float, w_SU, OFF_SU) WS_PTR(float, w_SV, OFF_SV) WS_PTR(unsigned char, w_H8, OFF_H8) WS_PTR(float, w_HS, OFF_HS) WS_PTR(float, w_PART, OFF_PART) WS_PTR(float, w_MOD, OFF_MOD) WS_PTR(float, w_BIAS, OFF_BIAS)
WS_PTR(bf16, w_VT, OFF_VT) WS_PTR(bf16, w_H, OFF_H) WS_PTR(bf16, w_MIXED, OFF_MIXED) WS_PTR(bf16, w_PROJ, OFF_PROJ) WS_PTR(float, w_X1, OFF_X1)
WS_PTR(int, w_IDX, OFF_IDX) WS_PTR(float, w_GATE, OFF_GATE)

DI int cond_row(int token) { return token < NPR ? (token >> 11) : (NB + token - NPR); }
DI int crow(int reg, int h) { return (reg & 3) + 8 * (reg >> 2) + 4 * h; }
DI const float* xrow(const P& p, int token) { return token < NPR ? p.x_prompt + (size_t)token * DM : p.x_sample + (size_t)(token - NPR) * DM; }

#define LDS_WAIT() asm volatile("s_waitcnt lgkmcnt(0)" ::: "memory")
DI int opaque0() { int z = 0; asm volatile("" : "+v"(z)); return z; }
DI float bf2f(bf16 v) { return (float)v; }
DI f32x16 zero16() { f32x16 z; for (int i = 0; i < 16; ++i) z[i] = 0.f; return z; }
DI bf16x8 pack_step(const f32x16& x, int s) { bf16x8 v; for (int j = 0; j < 8; ++j) v[j] = (bf16)x[8 * s + j]; return v; }
DI bf16x8 cat4(bf16x4 lo, bf16x4 hi) { return __builtin_shufflevector(lo, hi, 0, 1, 2, 3, 4, 5, 6, 7); }
DI float wave_sum(float v) { for (int o = 32; o >= 1; o >>= 1) v += __shfl_xor(v, o); return v; }

#define XB_TMO 128
#define XB_XCNT(j) (256 + 64 * (j))
#define XB_XSUB(j) (1280 + 64 * (j))
#define XB_XGEN(j) (2304 + 64 * (j))
#define XB_TOP 3328
#define XB_TOPGEN 3392
#define XCD_BAR_WORDS 3456
#define XB_SPIN_CAP (1u << 22)
DI unsigned xb_ld(unsigned* p) { return __hip_atomic_load(p, __ATOMIC_RELAXED, __HIP_MEMORY_SCOPE_AGENT); }
DI unsigned xb_add(unsigned* p, unsigned v) { return __hip_atomic_fetch_add(p, v, __ATOMIC_RELAXED, __HIP_MEMORY_SCOPE_AGENT); }
DI unsigned xb_xcc_id() { return (unsigned)__builtin_amdgcn_s_getreg((3 << 11) | 20) & 0xFu; }
#define XB_SPIN(cond, bar) do { unsigned _sp = 0; while (cond) { __builtin_amdgcn_s_sleep(1); \
    if ((++_sp & 255u) == 0u) { if (xb_ld(&(bar)[XB_TMO])) break; if (_sp > XB_SPIN_CAP) { atomicAdd(&(bar)[XB_TMO], 1u); break; } } } } while (0)

DI void xcd_barrier_complete(unsigned* bar, unsigned x, unsigned& nloc, unsigned& nx) {
  const unsigned G = gridDim.x;
  unsigned sum, cnt, mine, sp = 0u;
  for (;;) {
    sum = 0u; cnt = 0u; mine = 0u;
#pragma unroll
    for (unsigned j = 0; j < 16; ++j) { const unsigned c = xb_ld(&bar[XB_XCNT(j)]); sum += c; cnt += (c > 0u) ? 1u : 0u; mine = (j == x) ? c : mine; }
    if (sum == G) break;
    __builtin_amdgcn_s_sleep(1);
    if ((++sp & 255u) == 0u) { if (xb_ld(&bar[XB_TMO])) break; if (sp > XB_SPIN_CAP) { atomicAdd(&bar[XB_TMO], 1u); break; } }
  }
  nloc = mine > 0u ? mine : 1u; nx = cnt > 0u ? cnt : 1u;
}
DI void xcd_barrier(unsigned* bar, unsigned x, volatile unsigned* st) {
  asm volatile("s_waitcnt vmcnt(0)" ::: "memory");
  __syncthreads();
  if (threadIdx.x == 0) {
    __builtin_amdgcn_s_waitcnt(0);
    unsigned nloc = st[0], nx = st[1];
    if (nloc == 0u) { xcd_barrier_complete(bar, x, nloc, nx); st[0] = nloc; st[1] = nx; }
    const unsigned old = xb_add(&bar[XB_XSUB(x)], 1u);
    const unsigned gen = old / nloc;
    if (old + 1u == (gen + 1u) * nloc) {
      __builtin_amdgcn_fence(__ATOMIC_RELEASE, "agent");
      asm volatile("s_waitcnt vmcnt(0)" ::: "memory");
      const unsigned og = xb_add(&bar[XB_TOP], 1u);
      const unsigned tg = og / nx;
      if (og + 1u == (tg + 1u) * nx) xb_add(&bar[XB_TOPGEN], 1u);
      else XB_SPIN(xb_ld(&bar[XB_TOPGEN]) == tg, bar);
      xb_add(&bar[XB_XGEN(x)], 1u);
      __builtin_amdgcn_fence(__ATOMIC_ACQUIRE, "agent");
      asm volatile("s_waitcnt vmcnt(0)" ::: "memory");
    } else {
      XB_SPIN(xb_ld(&bar[XB_XGEN(x)]) == gen, bar);
      __builtin_amdgcn_fence(__ATOMIC_ACQUIRE, "agent");
      asm volatile("s_waitcnt vmcnt(0)" ::: "memory");
    }
  }
  __syncthreads();
}

constexpr int U0_MOD = 192;
constexpr int U0_TIN = (1024 / 64) * (INW / 64);
constexpr int F0_TOTAL = U0_TIN + 1;
constexpr int U0_TPW = 4 * 2 * 4;
constexpr int U0_CSK = 32;
constexpr int U0_KW = 128, U0_VW = 128, U0_PW = 128;
constexpr int F2_TOUT = 16 * 16, F2_TQ = 16 * 32, F2_E1 = F2_TOUT + F2_TQ, F2_E2 = F2_E1 + U0_TPW, F2_E3 = F2_E2 + U0_KW, F2_E4 = F2_E3 + U0_VW,
              F2_TOTAL = F2_E4 + U0_PW;
constexpr int F4_TOTAL = U0_CSK;
constexpr int F6_QU = 2048, F6_QV = 2048, F6_TOTAL = F6_QU + F6_QV;

DI float silu_f(float x) { return x * __builtin_amdgcn_rcpf(1.f + __expf(-x)); }

DI void unit_mod(const P& p, int u, char* smem) {
  const int t = threadIdx.x + opaque0(), lane = t & 63, w = t >> 6, r = lane & 31, h = lane >> 5;
  const int f0 = u * 32;
  f32x16 acc[5];
#pragma unroll
  for (int i = 0; i < 5; ++i) acc[i] = zero16();
  const float* wp = p.ada_w + (size_t)(w * 256 + 8 * h) * 6144 + f0 + r;
  const float* cp[5];
#pragma unroll
  for (int i = 0; i < 5; ++i) { const int m = 32 * i + r, mm = m < NMOD ? m : 0; cp[i] = (mm < NB ? p.c_prompt + (size_t)mm * DM : p.c_sample + (size_t)(mm - NB) * DM) + w * 256 + 8 * h; }
  float wv[8]; f32x4 cv[5][2];
#pragma unroll
  for (int j = 0; j < 8; ++j) wv[j] = wp[(size_t)j * 6144];
#pragma unroll
  for (int i = 0; i < 5; ++i) { cv[i][0] = *(const f32x4*)cp[i]; cv[i][1] = *(const f32x4*)(cp[i] + 4); }
#pragma unroll 1
  for (int ks = 0; ks < 16; ++ks) {
    bf16x8 bfr, afr[5];
#pragma unroll
    for (int j = 0; j < 8; ++j) bfr[j] = (bf16)wv[j];
#pragma unroll
    for (int i = 0; i < 5; ++i) {
      const bool ok = 32 * i + r < NMOD;
#pragma unroll
      for (int j = 0; j < 8; ++j) afr[i][j] = (bf16)(ok ? silu_f(cv[i][j >> 2][j & 3]) : 0.f);
    }
    const int kn = ks + 1 < 16 ? ks + 1 : 15;
#pragma unroll
    for (int j = 0; j < 8; ++j) wv[j] = wp[(size_t)(kn * 16 + j) * 6144];
#pragma unroll
    for (int i = 0; i < 5; ++i) { cv[i][0] = *(const f32x4*)(cp[i] + kn * 16); cv[i][1] = *(const f32x4*)(cp[i] + kn * 16 + 4); }
#pragma unroll
    for (int i = 0; i < 5; ++i) acc[i] = MFMA(afr[i], bfr, acc[i]);
  }
  float* red = (float*)smem;
  __syncthreads();
  if (w > 0) {
#pragma unroll
    for (int i = 0; i < 5; ++i)
#pragma unroll
      for (int j = 0; j < 16; ++j) red[((w - 1) * 80 + i * 16 + j) * 64 + lane] = acc[i][j];
  }
  __syncthreads();
  if (w == 0) {
    const float bias = p.ada_b[f0 + r];
#pragma unroll
    for (int i = 0; i < 5; ++i)
#pragma unroll
      for (int j = 0; j < 16; ++j) {
        const int m = 32 * i + crow(j, h);
        const float v = acc[i][j] + red[(0 * 80 + i * 16 + j) * 64 + lane] + red[(1 * 80 + i * 16 + j) * 64 + lane] + red[(2 * 80 + i * 16 + j) * 64 + lane] + bias;
        if (m < NMOD) w_MOD(p)[(size_t)m * 6144 + f0 + r] = v;
      }
  }
}

DI void unit_transpose(const float* __restrict__ src, bf16* __restrict__ dst, int R, int C, int tr, int tc, char* smem) {
  float* tile = (float*)smem;
  const int t = threadIdx.x + opaque0();
  __syncthreads();
#pragma unroll
  for (int i = 0; i < 4; ++i) {
    const int rr = (t >> 4) + 16 * i, cc = (t & 15) * 4;
    const f32x4 v = *(const f32x4*)(src + (size_t)(tr * 64 + rr) * C + tc * 64 + cc);
    tile[rr * 65 + cc] = v[0]; tile[rr * 65 + cc + 1] = v[1]; tile[rr * 65 + cc + 2] = v[2]; tile[rr * 65 + cc + 3] = v[3];
  }
  __syncthreads();
#pragma unroll
  for (int i = 0; i < 2; ++i) {
    const int orow = (t >> 3) + 32 * i, seg = (t & 7) * 8;
    bf16x8 v;
#pragma unroll
    for (int j = 0; j < 8; ++j) v[j] = (bf16)tile[(seg + j) * 65 + orow];
    *(bf16x8*)(dst + (size_t)(tc * 64 + orow) * R + tr * 64 + seg) = v;
  }
}
DI void unit_convert(const float* __restrict__ src, bf16* __restrict__ dst, int u) {
  const size_t base = (size_t)u * 8192 + (threadIdx.x + opaque0()) * 8;
#pragma unroll
  for (int i = 0; i < 4; ++i) {
    const size_t o = base + (size_t)i * 2048;
    const f32x4 a = *(const f32x4*)(src + o), b = *(const f32x4*)(src + o + 4);
    bf16x8 v; v[0] = (bf16)a[0]; v[1] = (bf16)a[1]; v[2] = (bf16)a[2]; v[3] = (bf16)a[3]; v[4] = (bf16)b[0]; v[5] = (bf16)b[1]; v[6] = (bf16)b[2]; v[7] = (bf16)b[3];
    *(bf16x8*)(dst + o) = v;
  }
}
DI unsigned pack_i8(float a, float b, float c, float d) {
  const int ia = max(-127, min(127, __float2int_rn(a))), ib = max(-127, min(127, __float2int_rn(b))), ic = max(-127, min(127, __float2int_rn(c))), id = max(-127, min(127, __float2int_rn(d)));
  return (unsigned)(ia & 255) | ((unsigned)(ib & 255) << 8) | ((unsigned)(ic & 255) << 16) | ((unsigned)(id & 255) << 24);
}
template <bool I8>
DI void unit_quant_rows(const float* __restrict__ src, unsigned char* __restrict__ dst, float* __restrict__ scale, int u) {
  const int t = threadIdx.x + opaque0(), lane = t & 63, w = t >> 6;
#pragma unroll
  for (int rr = 0; rr < 2; ++rr) {
    const size_t row = (size_t)u * 8 + 2 * w + rr;
    const float* s = src + row * DM + 16 * lane;
    f32x4 v[4];
    float amax = 0.f;
#pragma unroll
    for (int i = 0; i < 4; ++i) { v[i] = *(const f32x4*)(s + 4 * i); amax = fmaxf(amax, fmaxf(fmaxf(fabsf(v[i][0]), fabsf(v[i][1])), fmaxf(fabsf(v[i][2]), fabsf(v[i][3])))); }
#pragma unroll
    for (int o = 32; o >= 1; o >>= 1) amax = fmaxf(amax, __shfl_xor(amax, o));
    const float sc = amax > 0.f ? amax * (I8 ? 1.f / 127.f : 1.f / 440.f) : 1.f, inv = 1.f / sc;
    u32x4 q;
#pragma unroll
    for (int i = 0; i < 4; ++i) {
      if (I8) {
        q[i] = pack_i8(v[i][0] * inv, v[i][1] * inv, v[i][2] * inv, v[i][3] * inv);
      } else {
        int wd = 0;
        wd = __builtin_amdgcn_cvt_pk_fp8_f32(v[i][0] * inv, v[i][1] * inv, wd, false);
        wd = __builtin_amdgcn_cvt_pk_fp8_f32(v[i][2] * inv, v[i][3] * inv, wd, true);
        q[i] = (unsigned)wd;
      }
    }
    *(u32x4*)(dst + row * DM + 16 * lane) = q;
    if (lane == 0) scale[row] = sc;
  }
}
DI void unit_copy_f4(const float* __restrict__ src, float* __restrict__ dst, int n4) {
  for (int i = threadIdx.x + opaque0(); i < n4; i += NTHREADS) ((f32x4*)dst)[i] = ((const f32x4*)src)[i];
}

DI void phase0_filler(const P& p, int f, char* smem) {
  if (f < U0_TIN) { unit_transpose(p.w_in, w_Wt_in(p), 1024, INW, f / 60, f % 60, smem); }
  else {
    for (int i = threadIdx.x + opaque0(); i < 16 * 128; i += NTHREADS) {
      const int head = i >> 7, d = i & 127;
      int bk = d;
      if (d >= 16) { bk = 16 + (int)(logf((float)d / 16.f) / logf(8.f) * 16.f); bk = bk > 31 ? 31 : bk; }
      w_BIAS(p)[i] = p.rel_table[bk * 16 + head];
    }
  }
}
DI void phase2_filler(const P& p, int f, char* smem) {
  if (f < F2_TOUT) unit_transpose(p.w_out, w_Wt_out(p), 1024, 1024, f / 16, f % 16, smem);
  else if (f < F2_E1) { const int v = f - F2_TOUT; unit_transpose(p.w_query, w_Wt_q(p), 1024, 2048, v / 32, v % 32, smem); }
  else if (f < F2_E2) { const int v = f - F2_E1, g = v >> 3, tt = v & 7; unit_transpose(p.pool_w + (size_t)g * 128 * 256, w_PWt(p) + (size_t)g * 256 * 128, 128, 256, tt >> 2, tt & 3, smem); }
  else if (f < F2_E3) { const int b = f - F2_E2; unit_copy_f4(p.cache_k + ((size_t)b * 128 + 1) * 128, p.out + O_KWS + (size_t)b * 128 * 128, 127 * 128 / 4); }
  else if (f < F2_E4) { const int b = f - F2_E3; unit_copy_f4(p.cache_v + ((size_t)b * 128 + 1) * 128, p.out + O_VWS + (size_t)b * 128 * 128, 127 * 128 / 4); }
  else { const int b = f - F2_E4; unit_copy_f4(p.state_pool + ((size_t)b * 15 + 1) * 512, p.out + O_PS + (size_t)b * 15 * 512, 14 * 512 / 4); }
}

DI void norm_row(const P& p, int token, int which) {
  const int lane = (threadIdx.x + opaque0()) & 63;
  const float* src = which == 0 ? xrow(p, token) : w_X1(p) + (size_t)token * DM;
  const float* g = which == 0 ? p.norm1_g : p.norm2_g;
  const float* mod = w_MOD(p) + (size_t)cond_row(token) * 6144 + (which == 0 ? 0 : 3072);
  f32x4 v[4];
  float ss = 0.f;
  if (which == 1 && token >= NPR) {
    const float* g1 = w_MOD(p) + (size_t)cond_row(token) * 6144 + 2048;
#pragma unroll
    for (int i = 0; i < 4; ++i) {
      const int c = 4 * lane + 256 * i;
      const size_t po = (size_t)(token - NPR) * DM + c;
      const f32x4 xv = *(const f32x4*)(xrow(p, token) + c), gv = *(const f32x4*)(g1 + c);
      const f32x4 pa = *(const f32x4*)(w_PART(p) + po), pb = *(const f32x4*)(w_PART(p) + (size_t)NS * DM + po), pc = *(const f32x4*)(w_PART(p) + (size_t)2 * NS * DM + po), pd = *(const f32x4*)(w_PART(p) + (size_t)3 * NS * DM + po);
#pragma unroll
      for (int j = 0; j < 4; ++j) v[i][j] = xv[j] + gv[j] * ((pa[j] + pb[j]) + (pc[j] + pd[j]));
      *(f32x4*)(w_X1(p) + (size_t)token * DM + c) = v[i];
      ss += v[i][0] * v[i][0] + v[i][1] * v[i][1] + v[i][2] * v[i][2] + v[i][3] * v[i][3];
    }
  } else {
#pragma unroll
  for (int i = 0; i < 4; ++i) { v[i] = *(const f32x4*)(src + 4 * lane + 256 * i); ss += v[i][0] * v[i][0] + v[i][1] * v[i][1] + v[i][2] * v[i][2] + v[i][3] * v[i][3]; }
  }
  ss = wave_sum(ss);
  const float rstd = rsqrtf(ss * (1.f / DM) + EPS);
#pragma unroll
  for (int i = 0; i < 4; ++i) {
    const int c = 4 * lane + 256 * i;
    const f32x4 gg = *(const f32x4*)(g + c), sh = *(const f32x4*)(mod + c), sc = *(const f32x4*)(mod + 1024 + c);
    bf16x4 o;
#pragma unroll
    for (int j = 0; j < 4; ++j) { v[i][j] = (v[i][j] * rstd * gg[j]) * (1.f + sc[j]) + sh[j]; o[j] = (bf16)v[i][j]; }
    *(bf16x4*)(w_H(p) + (size_t)token * DM + c) = o;
  }
  if (which == 1) {
    float amax = 0.f;
#pragma unroll
    for (int i = 0; i < 4; ++i) amax = fmaxf(amax, fmaxf(fmaxf(fabsf(v[i][0]), fabsf(v[i][1])), fmaxf(fabsf(v[i][2]), fabsf(v[i][3]))));
#pragma unroll
    for (int o = 32; o >= 1; o >>= 1) amax = fmaxf(amax, __shfl_xor(amax, o));
    const float qs = amax > 0.f ? amax * (1.f / 127.f) : 1.f, inv = 1.f / qs;
#pragma unroll
    for (int i = 0; i < 4; ++i) *(unsigned*)(w_H8(p) + (size_t)token * DM + 4 * lane + 256 * i) = pack_i8(v[i][0] * inv, v[i][1] * inv, v[i][2] * inv, v[i][3] * inv);
    if (lane == 0) w_HS(p)[token] = qs;
  }
}

constexpr int LDSK = 72;
constexpr int GT = 128 * 64 * 2;
constexpr int GBUF = 2 * GT;
typedef __attribute__((address_space(3))) unsigned lds_u32;
typedef const __attribute__((address_space(1))) unsigned glb_u32;
DI void glds16(const void* g, char* l) { __builtin_amdgcn_global_load_lds((glb_u32*)g, (lds_u32*)l, 16, 0, 0); }
DI void gemm_first(const bf16* __restrict__ Wt, const bf16* __restrict__ X, int ld, int n0, int m0, char* smem) {
  const int t = threadIdx.x + opaque0(), lane = t & 63;
  const int w = __builtin_amdgcn_readfirstlane(t >> 6);
  const int swz = (lane & 7) ^ ((4 * w + (lane >> 4)) & 7);
  const bf16* ga = Wt + (size_t)(n0 + 8 * w + (lane >> 3)) * ld + swz * 8;
  const bf16* gb = X + (size_t)(m0 + 8 * w + (lane >> 3)) * ld + swz * 8;
#pragma unroll
  for (int q = 0; q < 4; ++q) { glds16(ga + (size_t)(32 * q) * ld, smem + 1024 * (w + 4 * q)); glds16(gb + (size_t)(32 * q) * ld, smem + GT + 1024 * (w + 4 * q)); }
}
DI void gemm_main(const bf16* __restrict__ Wt, const bf16* __restrict__ X, int ld, int K, int n0, int m0, char* smem, f32x16 (&acc)[4]) {
  const int t = threadIdx.x + opaque0(), lane = t & 63, r = lane & 31, h = lane >> 5;
  const int w = __builtin_amdgcn_readfirstlane(t >> 6);
#pragma unroll
  for (int i = 0; i < 4; ++i) acc[i] = zero16();
  const int swz = (lane & 7) ^ ((4 * w + (lane >> 4)) & 7);
  const bf16* ga = Wt + (size_t)(n0 + 8 * w + (lane >> 3)) * ld + swz * 8;
  const bf16* gb = X + (size_t)(m0 + 8 * w + (lane >> 3)) * ld + swz * 8;
  const int sw = (r >> 1) & 7;
  const int KT = K >> 6;
  asm volatile("s_waitcnt vmcnt(0)" ::: "memory");
  __syncthreads();
  for (int kt = 0; kt < KT; ++kt) {
    const char* As = smem + (kt & 1) * GBUF;
    const char* Bs = As + GT;
    if (kt + 1 < KT) {
      char* An = smem + ((kt + 1) & 1) * GBUF;
      const int k0 = (kt + 1) * 64;
#pragma unroll
      for (int q = 0; q < 4; ++q) { glds16(ga + (size_t)(32 * q) * ld + k0, An + 1024 * (w + 4 * q)); glds16(gb + (size_t)(32 * q) * ld + k0, An + GT + 1024 * (w + 4 * q)); }
    }
#pragma unroll
    for (int s = 0; s < 4; ++s) {
      const int co = ((2 * s + h) ^ sw) * 16;
      const bf16x8 bfr = *(const bf16x8*)(Bs + (32 * w + r) * 128 + co);
#pragma unroll
      for (int i = 0; i < 4; ++i) {
        const bf16x8 afr = *(const bf16x8*)(As + (32 * i + r) * 128 + co);
        acc[i] = MFMA(afr, bfr, acc[i]);
      }
    }
    asm volatile("s_waitcnt vmcnt(0)" ::: "memory");
    __syncthreads();
  }
}

DI float sigmoid_f(float x) { return __builtin_amdgcn_rcpf(1.f + __expf(-x)); }

DI void gemm1_map(int u, int& mt, int& nt) {
  const int v = u < 3584 ? (u & ~511) + (u & 7) * 64 + ((u >> 3) & 63) : u;
  mt = v / 30; nt = v % 30;
}
DI void unit_gemm1(const P& p, int u, int un, char* smem) {
  int mt, nt; gemm1_map(u, mt, nt);
  const int n0 = nt * 128, m0 = mt * 128;
  f32x16 acc[4];
  gemm_main(w_Wt_in(p), w_H(p), 1024, 1024, n0, m0, smem, acc);
  if (un >= 0) { int mn, nn; gemm1_map(un, mn, nn); gemm_first(w_Wt_in(p), w_H(p), 1024, nn * 128, mn * 128, smem); }
  const int tz = threadIdx.x + opaque0();
  const int lane = tz & 63, w = tz >> 6, r = lane & 31, h = lane >> 5;
  const int token = m0 + 32 * w + r;
  bf16* tw = (bf16*)(smem + GBUF + (tz >> 6) * 8704) + r * 136;
  const bool is_prompt = token < NPR;
  const int b = is_prompt ? (token >> 11) : (token - NPR), pos = token & (SEQ - 1);
  if (n0 < C_V) {
    const float* gn = n0 < C_K ? p.q_norm_g : p.k_norm_g;
    const float post = n0 < C_K ? 0.125f : 1.f;
#pragma unroll
    for (int hh = 0; hh < 2; ++hh) {
      float ss = 0.f;
#pragma unroll
      for (int i = 0; i < 2; ++i)
#pragma unroll
        for (int j = 0; j < 16; ++j) ss += acc[2 * hh + i][j] * acc[2 * hh + i][j];
      ss += __shfl_xor(ss, 32);
      const float rstd = rsqrtf(ss * (1.f / 64.f) + EPS);
#pragma unroll
      for (int i = 0; i < 2; ++i)
#pragma unroll
        for (int q4 = 0; q4 < 4; ++q4) {
          const int d = 32 * i + 8 * q4 + 4 * h;
          const f32x4 gg = *(const f32x4*)(gn + d);
          f32x4 v;
#pragma unroll
          for (int j = 0; j < 4; ++j) v[j] = acc[2 * hh + i][4 * q4 + j] * rstd * gg[j];
          bf16x4 o;
#pragma unroll
          for (int j = 0; j < 4; ++j) o[j] = (bf16)(v[j] * post);
          *(bf16x4*)(tw + 64 * hh + d) = o;
          if (n0 == C_K) {
            if (is_prompt) { if (pos >= SEQ - 128) *(f32x4*)(p.out + O_KWP + ((size_t)b * 128 + (pos - (SEQ - 128))) * 128 + 64 * hh + d) = v; }
            else *(f32x4*)(p.out + O_KWS + ((size_t)b * 128 + 127) * 128 + 64 * hh + d) = v;
          }
        }
    }
  } else if (n0 == C_V) {
#pragma unroll
    for (int i = 0; i < 4; ++i)
#pragma unroll
      for (int q4 = 0; q4 < 4; ++q4) {
        const int f = 32 * i + 8 * q4 + 4 * h;
        f32x4 v;
#pragma unroll
        for (int j = 0; j < 4; ++j) v[j] = acc[i][4 * q4 + j];
        if (is_prompt) {
#pragma unroll
          for (int j = 0; j < 4; ++j) w_VT(p)[((size_t)b * 128 + f + j) * SEQ + pos] = (bf16)v[j];
          if (pos >= SEQ - 128) *(f32x4*)(p.out + O_VWP + ((size_t)b * 128 + (pos - (SEQ - 128))) * 128 + f) = v;
        } else *(f32x4*)(p.out + O_VWS + ((size_t)b * 128 + 127) * 128 + f) = v;
      }
  } else if (n0 < C_GA) {
#pragma unroll
    for (int i = 0; i < 4; ++i)
#pragma unroll
      for (int q4 = 0; q4 < 4; ++q4) {
        const int f = n0 + 32 * i + 8 * q4 + 4 * h;
        f32x4 v; bf16x4 o;
#pragma unroll
        for (int j = 0; j < 4; ++j) { v[j] = acc[i][4 * q4 + j]; o[j] = (bf16)v[j]; }
        *(bf16x4*)(tw + (f - n0)) = o;
        if (is_prompt) { if (pos >= SEQ - 15) *(f32x4*)(p.out + O_PP + ((size_t)b * 15 + (pos - (SEQ - 15))) * 512 + (f - C_PIN)) = v; }
        else *(f32x4*)(p.out + O_PS + ((size_t)b * 15 + 14) * 512 + (f - C_PIN)) = v;
      }
  } else {
#pragma unroll
    for (int i = 0; i < 4; ++i)
#pragma unroll
      for (int q4 = 0; q4 < 4; ++q4) {
        const int f = n0 + 32 * i + 8 * q4 + 4 * h;
        bf16x4 o;
#pragma unroll
        for (int j = 0; j < 4; ++j) o[j] = (bf16)sigmoid_f(acc[i][4 * q4 + j]);
        *(bf16x4*)(tw + (f - n0)) = o;
      }
  }
  if (n0 != C_V) {
    LDS_WAIT();
    const bf16* tr = (const bf16*)(smem + GBUF + (tz >> 6) * 8704);
    bf16* pg = w_PROJ(p) + (size_t)(m0 + 32 * w + (lane >> 4)) * INW + n0 + (lane & 15) * 8;
#pragma unroll
    for (int it = 0; it < 8; ++it) *(u32x4*)(pg + (size_t)(4 * it) * INW) = *(const u32x4*)(tr + ((lane >> 4) + 4 * it) * 136 + (lane & 15) * 8);
  }
}

constexpr int VTS = 260;
constexpr int RS = 136;
DI void attn_head(const P& p, int head, int blk, int w, int r, int h, const bf16x8 (&qf)[4], const bf16* Ks, const bf16* VTs, const float* bsh, bf16x8 (&ob)[4]) {
  const int qi = 32 * w + r;
  f32x16 st[5];
#pragma unroll
  for (int tt = 0; tt < 5; ++tt) {
    st[tt] = zero16();
#pragma unroll
    for (int s = 0; s < 4; ++s) {
      const bf16x8 a = *(const bf16x8*)(Ks + (32 * (w + tt) + r) * LDSK + 16 * s + 8 * h);
      st[tt] = MFMA(a, qf[s], st[tt]);
    }
  }
  const float sink = p.sinks[head];
  float m = -INFINITY;
  {
    const int x = 31 - r + 4 * h;
    const float* bl = bsh + x;
#pragma unroll
    for (int tt = 0; tt < 5; ++tt)
#pragma unroll
      for (int j = 0; j < 16; ++j) {
        const int c = 32 * tt + (j & 3) + 8 * (j >> 2);
        const float s = st[tt][j] + bl[c];
        st[tt][j] = s;
        m = fmaxf(m, s);
      }
    if (blk == 0) {
      m = -INFINITY;
#pragma unroll
      for (int tt = 0; tt < 5; ++tt)
#pragma unroll
        for (int j = 0; j < 16; ++j) {
          const int c = 32 * tt + (j & 3) + 8 * (j >> 2);
          const float s = (159 - (x + c) > qi) ? -INFINITY : st[tt][j];
          st[tt][j] = s;
          m = fmaxf(m, s);
        }
    }
  }
  m = fmaxf(m, __shfl_xor(m, 32));
  m = fmaxf(m, sink);
  float sum = 0.f;
#pragma unroll
  for (int tt = 0; tt < 5; ++tt)
#pragma unroll
    for (int j = 0; j < 16; ++j) { const float e = __expf(st[tt][j] - m); st[tt][j] = e; sum += e; }
  sum += __shfl_xor(sum, 32);
  const float inv = 1.f / (sum + __expf(sink - m));
  f32x16 o[2] = {zero16(), zero16()};
#pragma unroll
  for (int tt = 0; tt < 5; ++tt)
#pragma unroll
    for (int s = 0; s < 2; ++s) {
      const bf16x8 pb = pack_step(st[tt], s);
#pragma unroll
      for (int i = 0; i < 2; ++i) {
        const bf16* vp = VTs + (32 * i + r) * VTS + 32 * (w + tt) + 16 * s + 4 * h;
        const bf16x8 a = cat4(*(const bf16x4*)vp, *(const bf16x4*)(vp + 8));
        o[i] = MFMA(a, pb, o[i]);
      }
    }
#pragma unroll
  for (int i = 0; i < 2; ++i)
#pragma unroll
    for (int j = 0; j < 16; ++j) ob[2 * i + (j >> 3)][j & 7] = (bf16)(o[i][j] * inv);
}
DI void unit_attn_prompt(const P& p, int u0, char* smem) {
  const int u = (u0 & ~511) + (u0 & 7) * 64 + ((u0 >> 3) & 63);
  const int b = u >> 7, blk = (u >> 3) & 15, hp = u & 7, hk = hp >> 2, g = hp >> 1, win = 2 << g;
  const int qpos0 = blk * 128;
  const int t = threadIdx.x + opaque0(), lane = t & 63, w = t >> 6, r = lane & 31, h = lane >> 5;
  bf16* Ks = (bf16*)smem;
  bf16* VTs = Ks + 256 * LDSK;
  float* bs = (float*)(VTs + 64 * VTS);
  bf16* Rs = Ks;
  __syncthreads();
#pragma unroll
  for (int i = 0; i < 8; ++i) {
    const int c = t + 256 * i, row = c >> 3, c16 = c & 7, kp = qpos0 - 128 + row;
    u32x4 v = {0u, 0u, 0u, 0u};
    if (kp >= 0) v = *(const u32x4*)(w_PROJ(p) + ((size_t)b * SEQ + kp) * INW + C_K + hk * 64 + c16 * 8);
    *(u32x4*)(Ks + row * LDSK + c16 * 8) = v;
  }
#pragma unroll
  for (int i = 0; i < 8; ++i) {
    const int c = t + 256 * i, drow = c >> 5, c16 = c & 31, kp0 = qpos0 - 128 + c16 * 8;
    u32x4 v = {0u, 0u, 0u, 0u};
    if (kp0 >= 0) v = *(const u32x4*)(w_VT(p) + ((size_t)(b * 2 + hk) * 64 + drow) * SEQ + kp0);
    u32x2* d2 = (u32x2*)(VTs + drow * VTS + c16 * 8);
    d2[0] = (u32x2){v[0], v[1]}; d2[1] = (u32x2){v[2], v[3]};
  }
  for (int i = t; i < 384; i += NTHREADS) { const int hh = i >= 192, j = i - 192 * hh, dist = 159 - j; bs[i] = (dist >= 0 && dist < 128) ? w_BIAS(p)[(2 * hp + hh) * 128 + dist] : -INFINITY; }
  const size_t tokq = (size_t)b * SEQ + qpos0 + 32 * w + r;
  bf16x8 qf0[4], qf1[4];
#pragma unroll
  for (int s = 0; s < 4; ++s) { qf0[s] = *(const bf16x8*)(w_PROJ(p) + tokq * INW + (2 * hp) * 64 + 16 * s + 8 * h); qf1[s] = *(const bf16x8*)(w_PROJ(p) + tokq * INW + (2 * hp + 1) * 64 + 16 * s + 8 * h); }
  __syncthreads();
  bf16x8 ob0[4], ob1[4];
  attn_head(p, 2 * hp, blk, w, r, h, qf0, Ks, VTs, bs, ob0);
  __builtin_amdgcn_sched_barrier(0);
  attn_head(p, 2 * hp + 1, blk, w, r, h, qf1, Ks, VTs, bs + 192, ob1);
  __builtin_amdgcn_sched_barrier(0);
  __syncthreads();
  {
    const int tk = t >> 4, cc = t & 15;
    const int p0 = qpos0 + tk * 8;
    const bf16* pin = w_PROJ(p) + (size_t)b * SEQ * INW + C_PIN + g * 128 + cc * 8;
    float S[8];
#pragma unroll
    for (int j = 0; j < 8; ++j) S[j] = 0.f;
    for (int i = 0; i < win; ++i) {
      const int pp = p0 - i;
      if (pp >= 0) { const bf16x8 v = *(const bf16x8*)(pin + (size_t)pp * INW);
#pragma unroll
        for (int j = 0; j < 8; ++j) S[j] += bf2f(v[j]); }
    }
    for (int i = 0; i < 8; ++i) {
      const int pos = p0 + i;
      const bf16x8 cur = *(const bf16x8*)(pin + (size_t)pos * INW);
      if (i > 0) {
#pragma unroll
        for (int j = 0; j < 8; ++j) S[j] += bf2f(cur[j]);
        if (pos - win >= 0) { const bf16x8 old = *(const bf16x8*)(pin + (size_t)(pos - win) * INW);
#pragma unroll
          for (int j = 0; j < 8; ++j) S[j] -= bf2f(old[j]); }
      }
      const float icnt = 1.f / (float)(win < pos + 1 ? win : pos + 1);
      bf16x8 rr;
#pragma unroll
      for (int j = 0; j < 8; ++j) rr[j] = (bf16)(S[j] * icnt - bf2f(cur[j]));
      *(bf16x8*)(Rs + (tk * 8 + i) * RS + cc * 8) = rr;
    }
  }
  __syncthreads();
  const bf16* prow = w_PROJ(p) + tokq * INW;
#pragma unroll
  for (int hh = 0; hh < 2; ++hh) {
    const int head = 2 * hp + hh;
    f32x16 pa[2] = {zero16(), zero16()};
#pragma unroll
    for (int s = 0; s < 8; ++s) {
      const bf16x8 bfr = *(const bf16x8*)(Rs + (32 * w + r) * RS + 16 * s + 8 * h);
#pragma unroll
      for (int i = 0; i < 2; ++i) {
        const bf16x8 a = *(const bf16x8*)(w_PWt(p) + ((size_t)g * 256 + (head & 3) * 64 + 32 * i + r) * 128 + 16 * s + 8 * h);
        pa[i] = MFMA(a, bfr, pa[i]);
      }
    }
#pragma unroll
    for (int i = 0; i < 2; ++i)
#pragma unroll
      for (int q4 = 0; q4 < 4; ++q4) {
        const int f = head * 64 + 32 * i + 8 * q4 + 4 * h;
        const bf16x4 ga = *(const bf16x4*)(prow + C_GA + f), gb = *(const bf16x4*)(prow + C_GB + f);
        const f32x4 ps = *(const f32x4*)(p.pool_scale + f);
        bf16x4 ov;
#pragma unroll
        for (int j = 0; j < 4; ++j) { const bf16 av = hh ? ob1[2 * i + (q4 >> 1)][4 * (q4 & 1) + j] : ob0[2 * i + (q4 >> 1)][4 * (q4 & 1) + j];
          ov[j] = (bf16)(bf2f(ga[j]) * bf2f(av) + bf2f(gb[j]) * (pa[i][4 * q4 + j] * ps[j])); }
        *(bf16x4*)(w_MIXED(p) + tokq * DM + f) = ov;
      }
    __builtin_amdgcn_sched_barrier(0);
  }
}

DI void unit_attn_sample(const P& p, int u, char* smem) {
  const int b = u >> 2, g = u & 3, hk = g >> 1;
  const int t = threadIdx.x + opaque0(), lane = t & 63, w = t >> 6;
  float* ks = (float*)smem;
  float* vs = ks + 128 * 65;
  float* qs = vs + 128 * 64;
  float* ps = qs + 256;
  float* os = ps + 512;
  float* rs = os + 256;
  const size_t token = (size_t)NPR + b;
  __syncthreads();
  const float* kw = p.out + O_KWS + (size_t)b * 128 * 128 + hk * 64;
  const float* vw = p.out + O_VWS + (size_t)b * 128 * 128 + hk * 64;
#pragma unroll 4
  for (int i = t; i < 128 * 64; i += NTHREADS) { const int j = i >> 6, d = i & 63; ks[j * 65 + d] = kw[(size_t)j * 128 + d]; vs[j * 64 + d] = vw[(size_t)j * 128 + d]; }
  qs[t] = bf2f(w_PROJ(p)[token * INW + g * 256 + t]);
  if (t < 128) {
    const int win = 2 << g;
    const float cur = p.out[O_PS + ((size_t)b * 15 + 14) * 512 + g * 128 + t];
    float tot = cur;
#pragma unroll 1
    for (int i = 1; i < win; ++i) tot += p.state_pool[((size_t)b * 15 + 15 - i) * 512 + g * 128 + t];
    rs[t] = tot / (float)win - cur;
  }
  __syncthreads();
  const int head = 4 * g + w;
  const float sink = p.sinks[head];
  float s[2];
  float m = sink;
#pragma unroll
  for (int i = 0; i < 2; ++i) {
    const int j = lane + 64 * i;
    float a = 0.f;
#pragma unroll 8
    for (int d = 0; d < 64; ++d) a += qs[w * 64 + d] * ks[j * 65 + d];
    s[i] = a + w_BIAS(p)[head * 128 + 127 - j];
    m = fmaxf(m, s[i]);
  }
  for (int o = 32; o >= 1; o >>= 1) m = fmaxf(m, __shfl_xor(m, o));
  float sum = 0.f;
#pragma unroll
  for (int i = 0; i < 2; ++i) { s[i] = __expf(s[i] - m); sum += s[i]; }
  sum = wave_sum(sum);
  const float inv = 1.f / (sum + __expf(sink - m));
#pragma unroll
  for (int i = 0; i < 2; ++i) ps[w * 128 + lane + 64 * i] = s[i] * inv;
  LDS_WAIT();
  {
    float a = 0.f;
#pragma unroll 8
    for (int j = 0; j < 128; ++j) a += ps[w * 128 + j] * vs[j * 64 + lane];
    os[w * 64 + lane] = a;
  }
  const int f = g * 256 + t;
  float pl = 0.f;
  const float* pw = p.pool_w + (size_t)g * 128 * 256 + t;
#pragma unroll 8
  for (int ch = 0; ch < 128; ++ch) pl += rs[ch] * pw[(size_t)ch * 256];
  pl *= p.pool_scale[f];
  const float ga = bf2f(w_PROJ(p)[token * INW + C_GA + f]), gb = bf2f(w_PROJ(p)[token * INW + C_GB + f]);
  LDS_WAIT();
  w_MIXED(p)[token * DM + f] = (bf16)(ga * os[t] + gb * pl);
}

DI void unit8_map(int u, int& mt, int& nt) {
  if (u < 1024) { const int xcd = u & 7, slot = (u >> 3) & 63, S = (u >> 9) * 8 + xcd; mt = S * 8 + (slot & 7); nt = slot >> 3; }
  else { mt = 128; nt = u - 1024; }
}
constexpr int G2_UNITS = 1024 + 32;
DI void gemm2_map(int u, int& mt, int& nt, int& kq) {
  if (u < 1024) { unit8_map(u, mt, nt); kq = -1; }
  else { mt = 128; nt = (u - 1024) & 7; kq = (u - 1024) >> 3; }
}
DI void gemm2_first(const P& p, int u, char* smem) {
  int mt, nt, kq; gemm2_map(u, mt, nt, kq);
  const int kb = kq < 0 ? 0 : 256 * kq;
  gemm_first(w_Wt_out(p) + kb, w_MIXED(p) + kb, 1024, nt * 128, mt * 128, smem);
}
DI void unit_gemm2(const P& p, int u, int un, char* smem) {
  int mt, nt, kq; gemm2_map(u, mt, nt, kq);
  const int n0 = nt * 128, m0 = mt * 128, kb = kq < 0 ? 0 : 256 * kq;
  f32x16 acc[4];
  gemm_main(w_Wt_out(p) + kb, w_MIXED(p) + kb, 1024, kq < 0 ? 1024 : 256, n0, m0, smem, acc);
  if (un >= 0) gemm2_first(p, un, smem);
  const int tz = threadIdx.x + opaque0();
  const int lane = tz & 63, w = tz >> 6, r = lane & 31, h = lane >> 5;
  float* tbase = (float*)(smem + GBUF + w * 8704);
#pragma unroll
  for (int hf = 0; hf < 2; ++hf) {
    if (hf) LDS_WAIT();
#pragma unroll
    for (int ii = 0; ii < 2; ++ii)
#pragma unroll
      for (int q4 = 0; q4 < 4; ++q4) {
        f32x4 v;
#pragma unroll
        for (int j = 0; j < 4; ++j) v[j] = acc[2 * hf + ii][4 * q4 + j];
        *(f32x4*)(tbase + r * 68 + 32 * ii + 8 * q4 + 4 * h) = v;
      }
    LDS_WAIT();
    const int fc = (lane & 15) * 4, tsub = lane >> 4;
#pragma unroll
    for (int it = 0; it < 8; ++it) {
      const int tl = 4 * it + tsub, token = m0 + 32 * w + tl, f = n0 + 64 * hf + fc;
      const f32x4 a = *(const f32x4*)(tbase + tl * 68 + fc);
      if (kq >= 0) { *(f32x4*)(w_PART(p) + ((size_t)kq * NS + (token - NPR)) * DM + f) = a; continue; }
      const f32x4 xv = *(const f32x4*)(xrow(p, token) + f), gv = *(const f32x4*)(w_MOD(p) + (size_t)cond_row(token) * 6144 + 2048 + f);
      f32x4 o;
#pragma unroll
      for (int j = 0; j < 4; ++j) o[j] = xv[j] + gv[j] * a[j];
      *(f32x4*)(w_X1(p) + (size_t)token * DM + f) = o;
    }
  }
}

DI unsigned f2ord(float f) { const unsigned u = __float_as_uint(f); return (u & 0x80000000u) ? ~u : (u | 0x80000000u); }
DI float ord2f(unsigned u) { return __uint_as_float((u & 0x80000000u) ? (u & 0x7fffffffu) : ~u); }
DI unsigned umin_(unsigned a, unsigned b) { return a < b ? a : b; }
DI unsigned umax_(unsigned a, unsigned b) { return a > b ? a : b; }
template <int OFF> DI void sort16_desc(unsigned (&a)[64]) {
#pragma unroll
  for (int lk = 1; lk <= 4; ++lk)
#pragma unroll
    for (int lj = lk - 1; lj >= 0; --lj)
#pragma unroll
      for (int i = 0; i < 16; ++i) {
        const int k = 1 << lk, j = 1 << lj, l = i ^ j;
        if (l > i) {
          const unsigned lo = umin_(a[OFF + i], a[OFF + l]), hi = umax_(a[OFF + i], a[OFF + l]);
          const bool desc = (i & k) == 0;
          a[OFF + i] = desc ? hi : lo; a[OFF + l] = desc ? lo : hi;
        }
      }
}
DI void merge16_desc(unsigned (&a)[16]) {
#pragma unroll
  for (int lj = 3; lj >= 0; --lj)
#pragma unroll
    for (int i = 0; i < 16; ++i) {
      const int j = 1 << lj, l = i ^ j;
      if (l > i) { const unsigned lo = umin_(a[i], a[l]), hi = umax_(a[i], a[l]); a[i] = hi; a[l] = lo; }
    }
}
DI void top16_of_64(unsigned (&a)[64], unsigned (&out)[16]) {
  sort16_desc<0>(a); sort16_desc<16>(a); sort16_desc<32>(a); sort16_desc<48>(a);
  unsigned x[16], y[16];
#pragma unroll
  for (int i = 0; i < 16; ++i) { x[i] = umax_(a[i], a[31 - i]); y[i] = umax_(a[32 + i], a[63 - i]); }
  merge16_desc(x); merge16_desc(y);
#pragma unroll
  for (int i = 0; i < 16; ++i) out[i] = umax_(x[i], y[15 - i]);
  merge16_desc(out);
}
__device__ constexpr int COFF[16] = {0, 16, 24, 29, 33, 36, 38, 40, 42, 43, 44, 45, 46, 47, 48, 49};
DI unsigned umax3(unsigned a, unsigned b, unsigned c) { const unsigned m = a > b ? a : b; return m > c ? m : c; }

DI void unit_peer_route(const P& p, int u, int un, char* smem) {
  int mt, hd; unit8_map(u, mt, hd);
  const int m0 = mt * 128;
  const int t = threadIdx.x + opaque0(), lane = t & 63, w = t >> 6, r = lane & 31, h = lane >> 5;
  unsigned char* myidx = (unsigned char*)smem + 2 * GBUF + t * 32;
  unsigned top[2][16];
#pragma unroll
  for (int pp = 0; pp < 2; ++pp) {
    f32x16 acc[4];
    gemm_main(w_Wt_q(p), w_H(p), 1024, 1024, hd * 256 + pp * 128, m0, smem, acc);
    if (pp == 0) gemm_first(w_Wt_q(p), w_H(p), 1024, hd * 256 + 128, m0, smem);
    else if (un >= 0) { int mn, hn; unit8_map(un, mn, hn); gemm_first(w_Wt_q(p), w_H(p), 1024, hn * 256, mn * 128, smem); }
    f32x16 sc[4] = {zero16(), zero16(), zero16(), zero16()};
    {
      const bf16* skb = w_SK(p) + (size_t)(hd * 2 + pp) * 128 * 128;
      const int wu = __builtin_amdgcn_readfirstlane(w);
#pragma unroll
      for (int q = 0; q < 8; ++q) {
        const int j = wu + 4 * q, row = 4 * j + (lane >> 4);
        glds16(skb + (size_t)row * 128 + (((lane & 15) ^ (row & 15)) * 8), smem + GBUF + 1024 * j);
      }
      asm volatile("s_waitcnt vmcnt(0)" ::: "memory");
      __syncthreads();
    }
    bf16x8 bqs[8];
#pragma unroll
    for (int i = 0; i < 4; ++i)
#pragma unroll
      for (int s = 0; s < 2; ++s) bqs[2 * i + s] = pack_step(acc[i], s);
#pragma unroll
    for (int i = 0; i < 4; ++i)
#pragma unroll
      for (int s = 0; s < 2; ++s) {
        const bf16x8 bq = bqs[2 * i + s];
#pragma unroll
        for (int kt = 0; kt < 4; ++kt) {
          const int row = 32 * kt + r, cc = 4 * i + 2 * s;
          const char* rp = smem + GBUF + row * 256 + 8 * h;
          const bf16x8 a = cat4(*(const bf16x4*)(rp + ((cc ^ (row & 15)) * 16)), *(const bf16x4*)(rp + (((cc + 1) ^ (row & 15)) * 16)));
          sc[kt] = MFMA(a, bq, sc[kt]);
        }
      }
    unsigned pk[64];
#pragma unroll
    for (int kt = 0; kt < 4; ++kt)
#pragma unroll
      for (int j = 0; j < 16; ++j) { const int key = 32 * kt + crow(j, h); pk[kt * 16 + j] = (f2ord(sc[kt][j]) & ~127u) | (unsigned)(127 - key); }
    unsigned mine[16];
    top16_of_64(pk, mine);
#pragma unroll
    for (int i = 0; i < 16; ++i) top[pp][i] = (unsigned)__shfl_xor((int)mine[15 - i], 32);
#pragma unroll
    for (int i = 0; i < 16; ++i) top[pp][i] = umax_(top[pp][i], mine[i]);
    merge16_desc(top[pp]);
  }
  float v0[16], v1[16];
#pragma unroll
  for (int a = 0; a < 16; ++a) {
    v0[a] = ord2f(top[0][a] & ~127u); v1[a] = ord2f(top[1][a] & ~127u);
    myidx[a] = (unsigned char)(127u - (top[0][a] & 127u)); myidx[16 + a] = (unsigned char)(127u - (top[1][a] & 127u));
  }
  unsigned cand[64];
#pragma unroll
  for (int i = 50; i < 64; ++i) cand[i] = 0u;
#pragma unroll
  for (int a = 0; a < 16; ++a)
#pragma unroll
    for (int bb = 0; bb < 16 / (a + 1); ++bb)
      cand[COFF[a] + bb] = (f2ord(v0[a] + v1[bb]) & ~255u) | (unsigned)(255 - (a * 16 + bb));
  unsigned best[16];
  top16_of_64(cand, best);
  const float smax = ord2f(best[0] & ~255u);
  float e[16], esum = 0.f;
#pragma unroll
  for (int i = 0; i < 16; ++i) { e[i] = __expf(ord2f(best[i] & ~255u) - smax); esum += e[i]; }
  const float einv = 1.f / esum;
  const size_t token = (size_t)m0 + 32 * w + r;
  int* ip = w_IDX(p) + token * 128 + hd * 16 + 8 * h;
  float* gp = w_GATE(p) + token * 128 + hd * 16 + 8 * h;
  const unsigned hmask = 0u - (unsigned)h;
#pragma unroll
  for (int i = 0; i < 8; ++i) {
    const unsigned bsel = best[i] ^ ((best[i] ^ best[8 + i]) & hmask);
    const float esel = __uint_as_float(__float_as_uint(e[i]) ^ ((__float_as_uint(e[i]) ^ __float_as_uint(e[8 + i])) & hmask));
    const unsigned code = 255u - (bsel & 255u);
    const int a = code >> 4, bb = code & 15;
    ip[i] = (int)myidx[a] * 128 + (int)myidx[16 + bb];
    gp[i] = esel * einv;
  }
}

DI float gelu_fast(float v) {
  const float av = fabsf(v), tt = __builtin_amdgcn_rcpf(av * 0.2316418882f + 1.0f);
  float q = tt * 0.5307027145f - 0.7265760135f; q = q * tt + 0.7107068705f; q = q * tt - 0.142248368f; q = q * tt + 0.127414796f; q = q * tt;
  const float e = __builtin_amdgcn_exp2f(v * v * -0.72134752044f);
  const float m = v * (q * e);
  return v < 0.f ? m : v - m;
}
DI float dot2bf(unsigned a, unsigned b, float acc) { return __builtin_amdgcn_fdot2_f32_bf16(__builtin_bit_cast(bf16x2, a), __builtin_bit_cast(bf16x2, b), acc, false); }
DI unsigned pkbf(f32x2 v) { bf16x2 r; r[0] = (bf16)v[0]; r[1] = (bf16)v[1]; return __builtin_bit_cast(unsigned, r); }
DI int dot16i(u32x4 u8, u32x4 x8, int d) {
#pragma unroll
  for (int m = 0; m < 4; ++m) d = __builtin_amdgcn_sdot4((int)u8[m], (int)x8[m], d, false);
  return d;
}
DI void axpy16p(f32x2* o, u32x4 v8, f32x2 c2) {
#pragma unroll
  for (int m = 0; m < 4; ++m) {
    const int wd = (int)v8[m];
    o[2 * m] = __builtin_elementwise_fma(c2, __builtin_amdgcn_cvt_pk_f32_fp8(wd, false), o[2 * m]);
    o[2 * m + 1] = __builtin_elementwise_fma(c2, __builtin_amdgcn_cvt_pk_f32_fp8(wd, true), o[2 * m + 1]);
  }
}
DI int dpp_add16i(int v) {
  v += __builtin_amdgcn_update_dpp(0, v, 0x140, 0xf, 0xf, true);
  v += __builtin_amdgcn_update_dpp(0, v, 0x141, 0xf, 0xf, true);
  v += __builtin_amdgcn_update_dpp(0, v, 0x4e, 0xf, 0xf, true);
  v += __builtin_amdgcn_update_dpp(0, v, 0xb1, 0xf, 0xf, true);
  return v;
}
DI float dot16(u32x4 u8, u32x4 xlo, u32x4 xhi, float d) {
#pragma unroll
  for (int m = 0; m < 4; ++m) {
    const int wd = (int)u8[m];
    const unsigned p01 = pkbf(__builtin_amdgcn_cvt_pk_f32_fp8(wd, false)), p23 = pkbf(__builtin_amdgcn_cvt_pk_f32_fp8(wd, true));
    const unsigned x01 = m < 2 ? xlo[2 * m] : xhi[2 * m - 4], x23 = m < 2 ? xlo[2 * m + 1] : xhi[2 * m - 3];
    d = dot2bf(p01, x01, d); d = dot2bf(p23, x23, d);
  }
  return d;
}
DI void axpy16(float* o, u32x4 v8, float c) {
#pragma unroll
  for (int m = 0; m < 4; ++m) {
    const int wd = (int)v8[m];
    const f32x2 a = __builtin_amdgcn_cvt_pk_f32_fp8(wd, false), b = __builtin_amdgcn_cvt_pk_f32_fp8(wd, true);
    o[4 * m] += c * a[0]; o[4 * m + 1] += c * a[1]; o[4 * m + 2] += c * b[0]; o[4 * m + 3] += c * b[1];
  }
}
DI float reduce4(const float (&d)[4], int lane) {
  const int h = lane >> 5, b4 = (lane >> 4) & 1;
  float a0 = h ? d[2] : d[0], a1 = h ? d[3] : d[1];
  const float s0 = h ? d[0] : d[2], s1 = h ? d[1] : d[3];
  a0 += __shfl_xor(s0, 32); a1 += __shfl_xor(s1, 32);
  float k = b4 ? a1 : a0;
  const float s = b4 ? a0 : a1;
  k += __shfl_xor(s, 16);
  k += __shfl_xor(k, 8); k += __shfl_xor(k, 4); k += __shfl_xor(k, 2); k += __shfl_xor(k, 1);
  return k;
}
DI float dpp_add16(float v) {
  v += __int_as_float(__builtin_amdgcn_update_dpp(0, __float_as_int(v), 0x140, 0xf, 0xf, true));
  v += __int_as_float(__builtin_amdgcn_update_dpp(0, __float_as_int(v), 0x141, 0xf, 0xf, true));
  v += __int_as_float(__builtin_amdgcn_update_dpp(0, __float_as_int(v), 0x4e, 0xf, 0xf, true));
  v += __int_as_float(__builtin_amdgcn_update_dpp(0, __float_as_int(v), 0xb1, 0xf, 0xf, true));
  return v;
}
constexpr int PEER_GLDS = 512 + 128 * 16;
constexpr int PEER_WLDS = 4 * PEER_GLDS;
template <int PART>
DI void peer_wave4(const P& p, int g, char* wl) {
  const int lane = (threadIdx.x + opaque0()) & 63, q = lane >> 4, j16 = lane & 15;
  unsigned* hist = (unsigned*)(wl + q * PEER_GLDS);
  u32x4* list = (u32x4*)(wl + q * PEER_GLDS + 512);
  const int token = 4 * g + q;
  if constexpr (PART != 2) {
  u32x4 x[4];
  {
    const unsigned char* hrow = w_H8(p) + (size_t)token * DM + 16 * j16;
#pragma unroll
    for (int i = 0; i < 4; ++i) x[i] = *(const u32x4*)(hrow + 256 * i);
  }
  const float xs = w_HS(p)[token];
  {
    int ids[8]; float gts[8], su[8];
#pragma unroll
    for (int i = 0; i < 8; ++i) { const size_t o = (size_t)token * 128 + j16 + 16 * i; ids[i] = w_IDX(p)[o]; gts[i] = w_GATE(p)[o]; }
#pragma unroll
    for (int i = 0; i < 8; ++i) { su[i] = w_SU(p)[ids[i]] * xs; gts[i] *= w_SV(p)[ids[i]]; }
    LDS_WAIT();
    *(u32x4*)(hist + 8 * j16) = (u32x4){0u, 0u, 0u, 0u}; *(u32x4*)(hist + 8 * j16 + 4) = (u32x4){0u, 0u, 0u, 0u};
    LDS_WAIT();
#pragma unroll
    for (int i = 0; i < 8; ++i) (void)__hip_atomic_fetch_add(&hist[ids[i] >> 7], 1u, __ATOMIC_RELAXED, __HIP_MEMORY_SCOPE_WAVEFRONT);
    LDS_WAIT();
    const u32x4 ca = *(const u32x4*)(hist + 8 * j16), cb = *(const u32x4*)(hist + 8 * j16 + 4);
    const unsigned tot = ca[0] + ca[1] + ca[2] + ca[3] + cb[0] + cb[1] + cb[2] + cb[3];
    unsigned scan = tot;
#pragma unroll
    for (int o = 1; o < 16; o <<= 1) { const unsigned tv = (unsigned)__shfl_up((int)scan, o, 16); if (j16 >= o) scan += tv; }
    unsigned e0 = scan - tot;
    u32x4 pa, pb;
    pa[0] = e0; e0 += ca[0]; pa[1] = e0; e0 += ca[1]; pa[2] = e0; e0 += ca[2]; pa[3] = e0; e0 += ca[3];
    pb[0] = e0; e0 += cb[0]; pb[1] = e0; e0 += cb[1]; pb[2] = e0; e0 += cb[2]; pb[3] = e0;
    LDS_WAIT();
    *(u32x4*)(hist + 8 * j16) = pa; *(u32x4*)(hist + 8 * j16 + 4) = pb;
    LDS_WAIT();
#pragma unroll
    for (int i = 0; i < 8; ++i) {
      const unsigned pos = __hip_atomic_fetch_add(&hist[ids[i] >> 7], 1u, __ATOMIC_RELAXED, __HIP_MEMORY_SCOPE_WAVEFRONT);
      list[pos] = (u32x4){(unsigned)ids[i], __float_as_uint(su[i]), __float_as_uint(gts[i]), 0u};
    }
    LDS_WAIT();
  }
  const unsigned char* Ub = w_Ub(p) + 16 * j16;
  {
    u32x4 uA[4], uB[4];
    u32x4 eA = list[0], eB = list[1];
#pragma unroll
    for (int i = 0; i < 4; ++i) uA[i] = *(const u32x4*)(Ub + (size_t)eA[0] * DM + 256 * i);
#pragma unroll
    for (int i = 0; i < 4; ++i) uB[i] = *(const u32x4*)(Ub + (size_t)eB[0] * DM + 256 * i);
#define PEER_USTEP(U, E, K)                                                                                            \
    {                                                                                                                  \
      const float su = __uint_as_float(E[1]), gsv = __uint_as_float(E[2]);                                             \
      int d0 = 0, d1 = 0;                                                                                              \
      d0 = dot16i(U[0], x[0], d0); d1 = dot16i(U[1], x[1], d1); d0 = dot16i(U[2], x[2], d0); d1 = dot16i(U[3], x[3], d1); \
      E = list[(K) + 2 < 128 ? (K) + 2 : 127];                       \
      _Pragma("unroll") for (int i = 0; i < 4; ++i) U[i] = *(const u32x4*)(Ub + (size_t)E[0] * DM + 256 * i);          \
      const float c = gsv * gelu_fast(su * (float)dpp_add16i(d0 + d1));                                                \
      if (j16 == 0) ((float*)&list[K])[3] = c;                                                                          \
    }
#pragma unroll 1
    for (int k = 0; k < 128; k += 2) {
      PEER_USTEP(uA, eA, k)
      PEER_USTEP(uB, eB, k + 1)
    }
  }
  }
  if constexpr (PART != 1) {
  LDS_WAIT();
  const unsigned char* Vb = w_Vb(p) + 16 * j16;
  f32x2 acc[32];
#pragma unroll
  for (int i = 0; i < 32; ++i) acc[i] = (f32x2){0.f, 0.f};
  {
    u32x4 vA[4], vB[4];
    u32x4 eA = list[0], eB = list[1];
#pragma unroll
    for (int i = 0; i < 4; ++i) vA[i] = *(const u32x4*)(Vb + (size_t)eA[0] * DM + 256 * i);
#pragma unroll
    for (int i = 0; i < 4; ++i) vB[i] = *(const u32x4*)(Vb + (size_t)eB[0] * DM + 256 * i);
#define PEER_VSTEP(V, E, K)                                                                                            \
    {                                                                                                                  \
      const float c = __uint_as_float(E[3]);                                                                           \
      const f32x2 c2 = {c, c};                                                                                         \
      _Pragma("unroll") for (int i = 0; i < 4; ++i) axpy16p(acc + 8 * i, V[i], c2);                                    \
      E = list[(K) + 2 < 128 ? (K) + 2 : 127];                                                                         \
      _Pragma("unroll") for (int i = 0; i < 4; ++i) V[i] = *(const u32x4*)(Vb + (size_t)E[0] * DM + 256 * i);          \
    }
#pragma unroll 1
    for (int k = 0; k < 128; k += 2) {
      PEER_VSTEP(vA, eA, k)
      PEER_VSTEP(vB, eB, k + 1)
    }
  }
  const float* x1 = w_X1(p) + (size_t)token * DM + 16 * j16;
  const float* g2 = w_MOD(p) + (size_t)cond_row(token) * 6144 + 5120 + 16 * j16;
  float* y = p.out + O_YP + (size_t)token * DM + 16 * j16;
#pragma unroll
  for (int i = 0; i < 4; ++i)
#pragma unroll
    for (int mm = 0; mm < 4; ++mm) {
      const int c0 = 256 * i + 4 * mm;
      const f32x4 xv = *(const f32x4*)(x1 + c0), gv = *(const f32x4*)(g2 + c0);
      f32x4 yv;
#pragma unroll
      for (int j = 0; j < 4; ++j) yv[j] = xv[j] + gv[j] * acc[8 * i + 2 * mm + (j >> 1)][j & 1];
      *(f32x4*)(y + c0) = yv;
    }
  }
}
DI void peer_token_block(const P& p, int token, char* smem) {
  const int t = threadIdx.x + opaque0(), lane = t & 63, w = t >> 6;
  float* red = (float*)smem;
  const u32x4 x8 = *(const u32x4*)(w_H8(p) + (size_t)token * DM + 16 * lane);
  const int myid = w_IDX(p)[(size_t)token * 128 + 32 * w + (lane & 31)];
  const float mysu = w_SU(p)[myid] * w_HS(p)[token];
  const float mygs = w_GATE(p)[(size_t)token * 128 + 32 * w + (lane & 31)] * w_SV(p)[myid];
  float o[16];
#pragma unroll
  for (int i = 0; i < 16; ++i) o[i] = 0.f;
#pragma unroll 1
  for (int e0 = 0; e0 < 32; e0 += 8) {
    u32x4 u8[8], v8[8];
#pragma unroll
    for (int qq = 0; qq < 8; ++qq) {
      const size_t ro = (size_t)__builtin_amdgcn_readlane(myid, e0 + qq) * DM + 16 * lane;
      u8[qq] = *(const u32x4*)(w_Ub(p) + ro); v8[qq] = *(const u32x4*)(w_Vb(p) + ro);
    }
#pragma unroll
    for (int hb = 0; hb < 2; ++hb) {
      float d[4];
#pragma unroll
      for (int qq = 0; qq < 4; ++qq) d[qq] = (float)dot16i(u8[4 * hb + qq], x8, 0);
      const float kv = reduce4(d, lane);
#pragma unroll
      for (int qq = 0; qq < 4; ++qq) {
        const int e = e0 + 4 * hb + qq;
        const float a = __int_as_float(__builtin_amdgcn_readlane(__float_as_int(kv), 16 * qq)) * __int_as_float(__builtin_amdgcn_readlane(__float_as_int(mysu), e));
        const float c = __int_as_float(__builtin_amdgcn_readlane(__float_as_int(mygs), e)) * gelu_fast(a);
        axpy16(o, v8[4 * hb + qq], c);
      }
    }
  }
  __syncthreads();
#pragma unroll
  for (int i = 0; i < 16; ++i) red[w * 1024 + 16 * lane + i] = o[i];
  __syncthreads();
  if (w == 0) {
    const float* x1 = w_X1(p) + (size_t)token * DM + 16 * lane;
    const float* g2 = w_MOD(p) + (size_t)cond_row(token) * 6144 + 5120 + 16 * lane;
    float* y = p.out + O_YP + (size_t)token * DM + 16 * lane;
#pragma unroll
    for (int mm = 0; mm < 4; ++mm) {
      const f32x4 xv = *(const f32x4*)(x1 + 4 * mm), gv = *(const f32x4*)(g2 + 4 * mm);
      f32x4 yv;
#pragma unroll
      for (int j = 0; j < 4; ++j) { const int c = 16 * lane + 4 * mm + j; yv[j] = xv[j] + gv[j] * (red[c] + red[1024 + c] + red[2048 + c] + red[3072 + c]); }
      *(f32x4*)(y + 4 * mm) = yv;
    }
  }
}

constexpr int NPHASE = 8;

#if defined(PROBE_ATTN) || defined(PROBE_SAMP)
DI int probe_token(int i) { return (i * 131 + 3) % NPR; }
DI float block_sum_p(float v, float* red) {
  __syncthreads();
  v = wave_sum(v);
  if ((threadIdx.x & 63) == 0) red[threadIdx.x >> 6] = v;
  __syncthreads();
  return red[0] + red[1] + red[2] + red[3];
}
DI float block_max_p(float v, float* red) {
  __syncthreads();
  for (int o = 32; o >= 1; o >>= 1) v = fmaxf(v, __shfl_xor(v, o));
  if ((threadIdx.x & 63) == 0) red[threadIdx.x >> 6] = v;
  __syncthreads();
  return fmaxf(fmaxf(red[0], red[1]), fmaxf(red[2], red[3]));
}
#endif
#ifdef PROBE_ATTN
DI void probe_attn(const P& p, int i, char* smem) {
  float* red = (float*)smem;
  float* pr = red + 4;
  float* attn = pr + 128;
  float* rr = attn + 1024;
  const int token = probe_token(i), b = token >> 11, pos = token & 2047, t = threadIdx.x;
  const bf16* prow = w_PROJ(p) + (size_t)token * INW;
  for (int head = 0; head < 16; ++head) {
    const int hk = head >> 3;
    float s = -INFINITY;
    const int kp = pos - 127 + (t & 127);
    if (t < 128 && kp >= 0) {
      float a = 0.f;
      const bf16* kr = w_PROJ(p) + ((size_t)b * SEQ + kp) * INW + C_K + hk * 64;
      for (int d = 0; d < 64; ++d) a += bf2f(prow[head * 64 + d]) * bf2f(kr[d]);
      s = a + w_BIAS(p)[head * 128 + (pos - kp)];
    }
    float m = block_max_p(s, red);
    m = fmaxf(m, p.sinks[head]);
    const float e = (t < 128 && kp >= 0) ? __expf(s - m) : 0.f;
    const float den = block_sum_p(e, red) + __expf(p.sinks[head] - m);
    if (t < 128) pr[t] = e / den;
    __syncthreads();
    if (t < 64) {
      float o = 0.f;
      for (int j = 0; j < 128; ++j) { const int kq = pos - 127 + j; if (kq >= 0) o += pr[j] * bf2f(w_VT(p)[((size_t)(b * 2 + hk) * 64 + t) * SEQ + kq]); }
      attn[head * 64 + t] = o;
    }
    __syncthreads();
  }
  for (int c = t; c < 512; c += 256) {
    const int g = c >> 7, win = 2 << g;
    float tot = 0.f;
    for (int j = 0; j < win; ++j) if (pos - j >= 0) tot += bf2f(w_PROJ(p)[((size_t)b * SEQ + pos - j) * INW + C_PIN + c]);
    const float cnt = (float)(win < pos + 1 ? win : pos + 1);
    rr[c] = bf2f((bf16)(tot / cnt - bf2f(prow[C_PIN + c])));
  }
  __syncthreads();
  for (int f = t; f < 1024; f += 256) {
    const int g = f >> 8;
    float pl = 0.f;
    for (int ch = 0; ch < 128; ++ch) pl += rr[g * 128 + ch] * bf2f(w_PWt(p)[((size_t)g * 256 + (f & 255)) * 128 + ch]);
    const float naive = bf2f(prow[C_GA + f]) * attn[f] + bf2f(prow[C_GB + f]) * (pl * p.pool_scale[f]);
    const float fast = bf2f(w_MIXED(p)[(size_t)token * DM + f]);
    p.out[O_KWP + (size_t)i * DM + f] += (float)(PROBE_ATTN) * (fast - naive);
  }
  __syncthreads();
}
#endif

#ifdef PROBE_SAMP
DI void probe_samp(const P& p, int b, char* smem) {
  float* red = (float*)smem;
  float* pr = red + 4;
  float* attn = pr + 128;
  float* rr = attn + 1024;
  const int t = threadIdx.x;
  const size_t token = (size_t)NPR + b;
  const bf16* prow = w_PROJ(p) + token * INW;
  for (int head = 0; head < 16; ++head) {
    const int hk = head >> 3;
    float s = -INFINITY;
    if (t < 128) {
      const float* kr = t < 127 ? p.cache_k + (((size_t)b * 128 + t + 1) * 2 + hk) * 64 : p.out + O_KWS + (((size_t)b * 128 + 127) * 2 + hk) * 64;
      float a = 0.f;
      for (int d = 0; d < 64; ++d) a += bf2f(prow[head * 64 + d]) * kr[d];
      s = a + p.rel_table[(127 - t < 16 ? 127 - t : min(31, 16 + (int)(logf((float)(127 - t) / 16.f) / logf(8.f) * 16.f))) * 16 + head];
    }
    float m = block_max_p(s, red);
    m = fmaxf(m, p.sinks[head]);
    const float e = t < 128 ? __expf(s - m) : 0.f;
    const float den = block_sum_p(e, red) + __expf(p.sinks[head] - m);
    if (t < 128) pr[t] = e / den;
    __syncthreads();
    if (t < 64) {
      float o = 0.f;
      for (int j = 0; j < 128; ++j) { const float* vr = j < 127 ? p.cache_v + (((size_t)b * 128 + j + 1) * 2 + hk) * 64 : p.out + O_VWS + (((size_t)b * 128 + 127) * 2 + hk) * 64; o += pr[j] * vr[t]; }
      attn[head * 64 + t] = o;
    }
    __syncthreads();
  }
  for (int c = t; c < 512; c += 256) {
    const int g = c >> 7, win = 2 << g;
    const float cur = p.out[O_PS + ((size_t)b * 15 + 14) * 512 + c];
    float tot = cur;
    for (int j = 1; j < win; ++j) tot += p.state_pool[((size_t)b * 15 + 15 - j) * 512 + c];
    rr[c] = tot / (float)win - cur;
  }
  __syncthreads();
  for (int f = t; f < 1024; f += 256) {
    const int g = f >> 8;
    float pl = 0.f;
    for (int ch = 0; ch < 128; ++ch) pl += rr[g * 128 + ch] * p.pool_w[((size_t)g * 128 + ch) * 256 + (f & 255)];
    const float naive = bf2f(prow[C_GA + f]) * attn[f] + bf2f(prow[C_GB + f]) * (pl * p.pool_scale[f]);
    const float fast = bf2f(w_MIXED(p)[token * DM + f]);
    p.out[O_KWP + (size_t)b * DM + f] += (float)(PROBE_SAMP) * (fast - naive);
  }
  __syncthreads();
}
#endif
template <class First, class Main, class Fill> DI void run_with_filler(int G, int bid, int nmain, int nfill, First firstf, Main mainf, Fill fillf) {
  if (bid < nmain) { __syncthreads(); firstf(bid); }
  for (int u = bid; u < nmain; u += G) mainf(u, u + G < nmain ? u + G : -1);
  const int rem = nmain % G;
  if (rem == 0) { for (int f = bid; f < nfill; f += G) fillf(f); }
  else if (bid >= rem) { for (int f = bid - rem; f < nfill; f += G - rem) fillf(f); }
}
template <int PH> DI void run_phase(const P& p, char* smem) {
  const int G = gridDim.x, bid = blockIdx.x, w = __builtin_amdgcn_readfirstlane(threadIdx.x >> 6);
  if constexpr (PH == 0) { run_with_filler(G, bid, U0_MOD, F0_TOTAL, [&](int) {}, [&](int u, int) { unit_mod(p, u, smem); }, [&](int f) { phase0_filler(p, f, smem); }); }
  if constexpr (PH == 1) { for (int tk = bid * 4 + w; tk < NTOK; tk += G * 4) norm_row(p, tk, 0); }
  if constexpr (PH == 2) {
    run_with_filler(G, bid, 129 * 30, F2_TOTAL, [&](int u) { int mt, nt; gemm1_map(u, mt, nt); gemm_first(w_Wt_in(p), w_H(p), 1024, nt * 128, mt * 128, smem); },
                    [&](int u, int un) { unit_gemm1(p, u, un, smem); }, [&](int f) { phase2_filler(p, f, smem); });
  }
  if constexpr (PH == 3) { for (int u = bid; u < 1024; u += G) unit_attn_prompt(p, u, smem);
                           for (int u = bid; u < 512; u += G) unit_attn_sample(p, u, smem); }
  if constexpr (PH == 4) {
    run_with_filler(G, bid, G2_UNITS, F4_TOTAL, [&](int u) { gemm2_first(p, u, smem); },
                    [&](int u, int un) { unit_gemm2(p, u, un, smem); }, [&](int f) { unit_convert(p.sub_keys, w_SK(p), f); });
  }
  if constexpr (PH == 5) { for (int tk = bid * 4 + w; tk < NTOK; tk += G * 4) norm_row(p, tk, 1); }
  if constexpr (PH == 6) {
    run_with_filler(G, bid, 129 * 8, F6_TOTAL, [&](int u) { int mt, hd; unit8_map(u, mt, hd); gemm_first(w_Wt_q(p), w_H(p), 1024, hd * 256, mt * 128, smem); },
                    [&](int u, int un) { unit_peer_route(p, u, un, smem); }, [&](int f) { if (f < F6_QU) unit_quant_rows<true>(p.peer_u, w_Ub(p), w_SU(p), f); else unit_quant_rows<false>(p.peer_v, w_Vb(p), w_SV(p), f - F6_QU); });
  }
  if constexpr (PH == 7) {
    for (int g = bid * 4 + w; g < NPR / 4; g += G * 4) peer_wave4<0>(p, g, smem + w * PEER_WLDS);
    for (int s = bid; s < NS; s += G) peer_token_block(p, NPR + s, smem + 4 * PEER_WLDS);
  }
}
#if ONE_LAUNCH
__global__ void __launch_bounds__(NTHREADS, 2) mega(P p) {
  __shared__ __attribute__((aligned(16))) char smem[SMEM_BYTES + 16];
  volatile unsigned* st = (volatile unsigned*)(smem + SMEM_BYTES);
  if (threadIdx.x == 0) { st[0] = 0u; st[1] = 0u; }
  __syncthreads();
  const unsigned xcc = xb_xcc_id();
  if (threadIdx.x == 0) (void)xb_add(&w_bar(p)[XB_XCNT(xcc)], 1u);
#ifndef REPEAT_MASK
#define REPEAT_MASK 0
#endif
#define RUN_PH(k) do { run_phase<k>(p, smem); if ((REPEAT_MASK >> k) & 1) { xcd_barrier(w_bar(p), xcc, st); run_phase<k>(p, smem); } } while (0)
  RUN_PH(0); xcd_barrier(w_bar(p), xcc, st);
  RUN_PH(1); xcd_barrier(w_bar(p), xcc, st);
  RUN_PH(2); xcd_barrier(w_bar(p), xcc, st);
  RUN_PH(3); xcd_barrier(w_bar(p), xcc, st);
#ifdef PROBE_ATTN
  for (int i = blockIdx.x; i < 128; i += gridDim.x) probe_attn(p, i, smem);
  xcd_barrier(w_bar(p), xcc, st);
#endif
#ifdef PROBE_SAMP
  for (int i = blockIdx.x; i < 128; i += gridDim.x) probe_samp(p, i, smem);
  xcd_barrier(w_bar(p), xcc, st);
#endif
  RUN_PH(4); xcd_barrier(w_bar(p), xcc, st);
  RUN_PH(5); xcd_barrier(w_bar(p), xcc, st);
  RUN_PH(6); xcd_barrier(w_bar(p), xcc, st);
#if PEER_ALIGN
  { const int G = gridDim.x, bid = blockIdx.x, w = __builtin_amdgcn_readfirstlane(threadIdx.x >> 6);
    for (int g = bid * 4 + w, it = 0; it < (NPR / 4 + G * 4 - 1) / (G * 4); g += G * 4, ++it) {
      if (it > 0) xcd_barrier(w_bar(p), xcc, st);
      if (g < NPR / 4) peer_wave4<1>(p, g, smem + w * PEER_WLDS);
#if PEER_ALIGN > 1
      xcd_barrier(w_bar(p), xcc, st);
#endif
      if (g < NPR / 4) peer_wave4<2>(p, g, smem + w * PEER_WLDS);
    }
    for (int s = bid; s < NS; s += G) peer_token_block(p, NPR + s, smem + 4 * PEER_WLDS); }
#else
  RUN_PH(7);
#endif
}
#else
template <int PH> __global__ void __launch_bounds__(NTHREADS, 2) mega(P p) {
  __shared__ __attribute__((aligned(16))) char smem[SMEM_BYTES];
  run_phase<PH>(p, smem);
}
#endif


extern "C" void kernel_launch(void* const* d_in, const int* in_sizes, int n_in, void* d_out, int out_size, void* d_ws, size_t ws_size, hipStream_t stream) {
  P p{};
  const float* const* in = (const float* const*)d_in;
  p.x_prompt = in[0]; p.x_sample = in[1]; p.cache_k = in[2]; p.cache_v = in[3]; p.state_pool = in[4]; p.c_prompt = in[5]; p.c_sample = in[6];
  p.rel_table = in[7]; p.ada_w = in[8]; p.ada_b = in[9]; p.norm1_g = in[10]; p.w_in = in[11]; p.q_norm_g = in[12]; p.k_norm_g = in[13]; p.sinks = in[14];
  p.pool_w = in[15]; p.pool_scale = in[16]; p.w_out = in[17]; p.norm2_g = in[18]; p.w_query = in[19]; p.sub_keys = in[20]; p.peer_u = in[21]; p.peer_v = in[22];
  p.out = (float*)d_out;
  p.ws = (char*)d_ws;
  if (WS_NEED > ws_size) { fprintf(stderr, "workspace too small: need %zu have %zu\n", (size_t)WS_NEED, ws_size); return; }

  static int grid_blocks = 0;
  if (!grid_blocks) {
    int dev = 0, cus = 0, per_cu = 0;
    (void)hipGetDevice(&dev);
    (void)hipDeviceGetAttribute(&cus, hipDeviceAttributeMultiprocessorCount, dev);
#if ONE_LAUNCH
    (void)hipOccupancyMaxActiveBlocksPerMultiprocessor(&per_cu, mega, NTHREADS, 0);
#else
    per_cu = 2;
#endif
    if (per_cu > 2) per_cu = 2;
    if (per_cu < 1) per_cu = 1;
    if (cus < 1) cus = 256;
    grid_blocks = cus * per_cu;
  }
#if ONE_LAUNCH
  (void)hipMemsetAsync(p.ws + OFF_BAR, 0, XCD_BAR_WORDS * 4, stream);
  hipLaunchKernelGGL(mega, dim3(grid_blocks), dim3(NTHREADS), 0, stream, p);
#else
  hipLaunchKernelGGL(mega<0>, dim3(grid_blocks), dim3(NTHREADS), 0, stream, p);
  hipLaunchKernelGGL(mega<1>, dim3(grid_blocks), dim3(NTHREADS), 0, stream, p);
  hipLaunchKernelGGL(mega<2>, dim3(grid_blocks), dim3(NTHREADS), 0, stream, p);
  hipLaunchKernelGGL(mega<3>, dim3(grid_blocks), dim3(NTHREADS), 0, stream, p);
  hipLaunchKernelGGL(mega<4>, dim3(grid_blocks), dim3(NTHREADS), 0, stream, p);
  hipLaunchKernelGGL(mega<5>, dim3(grid_blocks), dim3(NTHREADS), 0, stream, p);
  hipLaunchKernelGGL(mega<6>, dim3(grid_blocks), dim3(NTHREADS), 0, stream, p);
  hipLaunchKernelGGL(mega<7>, dim3(grid_blocks), dim3(NTHREADS), 0, stream, p);
#endif

}
```

```cpp
#include <hip/hip_runtime.h>
#include <stdint.h>
#include <stdio.h>

#ifndef ONE_LAUNCH
#define ONE_LAUNCH 1
#endif
#ifndef EARLY_INV
#define EARLY_INV 1
#endif
#ifndef PEER_ALIGN
#define PEER_ALIGN 1
#endif

typedef __bf16 bf16;
typedef __bf16 bf16x2 __attribute__((ext_vector_type(2)));
typedef __bf16 bf16x4 __attribute__((ext_vector_type(4)));
typedef __bf16 bf16x8 __attribute__((ext_vector_type(8)));
typedef float f32x2 __attribute__((ext_vector_type(2)));
typedef float f32x4 __attribute__((ext_vector_type(4)));
typedef float f32x16 __attribute__((ext_vector_type(16)));
typedef unsigned u32x2 __attribute__((ext_vector_type(2)));
typedef unsigned u32x4 __attribute__((ext_vector_type(4)));

#define DI __device__ __forceinline__
#define MFMA(a, b, c) __builtin_amdgcn_mfma_f32_32x32x16_bf16((a), (b), (c), 0, 0, 0)

constexpr int DM = 1024, NB = 8, SEQ = 2048, NS = 128, NPR = NB * SEQ, NTOK = NPR + NS;
constexpr int INW = 3840, NMOD = NB + NS;
constexpr int C_K = 1024, C_V = 1152, C_PIN = 1280, C_GA = 1792, C_GB = 2816;
constexpr int NEXP = 16384;
constexpr float EPS = 1e-6f;
constexpr size_t O_YP = 0, O_KWP = 16908288, O_VWP = 17039360, O_PP = 17170432, O_KWS = 17231872, O_VWS = 19329024, O_PS = 21426176;

constexpr int SMEM_BYTES = 77824;
constexpr int NTHREADS = 256;

struct P {
  const float *x_prompt, *x_sample, *cache_k, *cache_v, *state_pool, *c_prompt, *c_sample, *rel_table, *ada_w, *ada_b, *norm1_g, *w_in,
      *q_norm_g, *k_norm_g, *sinks, *pool_w, *pool_scale, *w_out, *norm2_g, *w_query, *sub_keys, *peer_u, *peer_v;
  float* out;
  char* ws;
};
constexpr size_t al256(size_t x) { return (x + 255) & ~(size_t)255; }
constexpr size_t OFF_BAR = 0;
constexpr size_t OFF_WTIN = OFF_BAR + al256(4096 * 4);
constexpr size_t OFF_WTOUT = OFF_WTIN + al256((size_t)INW * 1024 * 2);
constexpr size_t OFF_WTQ = OFF_WTOUT + al256((size_t)1024 * 1024 * 2);
constexpr size_t OFF_SK = OFF_WTQ + al256((size_t)2048 * 1024 * 2);
constexpr size_t OFF_PWT = OFF_SK + al256((size_t)16 * 128 * 128 * 2);
constexpr size_t OFF_UB = OFF_PWT + al256((size_t)4 * 256 * 128 * 2);
constexpr size_t OFF_VB = OFF_UB + al256((size_t)NEXP * DM);
constexpr size_t OFF_SU = OFF_VB + al256((size_t)NEXP * DM);
constexpr size_t OFF_SV = OFF_SU + al256((size_t)NEXP * 4);
constexpr size_t OFF_H8 = OFF_SV + al256((size_t)NEXP * 4);
constexpr size_t OFF_HS = OFF_H8 + al256((size_t)NTOK * DM);
constexpr size_t OFF_PART = OFF_HS + al256((size_t)NTOK * 4);
constexpr size_t OFF_MOD = OFF_PART + al256((size_t)4 * NS * DM * 4);
constexpr size_t OFF_BIAS = OFF_MOD + al256((size_t)NMOD * 6144 * 4);
constexpr size_t OFF_VT = OFF_BIAS + al256(16 * 128 * 4);
constexpr size_t OFF_H = OFF_VT + al256((size_t)NB * 128 * SEQ * 2);
constexpr size_t OFF_MIXED = OFF_H;
constexpr size_t OFF_PROJ = OFF_H + al256((size_t)NTOK * DM * 2);
constexpr size_t OFF_X1 = OFF_PROJ;
constexpr size_t OFF_IDX = OFF_X1 + (size_t)NTOK * DM * 4;
constexpr size_t OFF_GATE = OFF_IDX + (size_t)NTOK * 128 * 4;
constexpr size_t WS_NEED = OFF_PROJ + al256((size_t)NTOK * INW * 2);
static_assert(OFF_GATE + (size_t)NTOK * 128 * 4 <= WS_NEED, "overlay fits");
static_assert(WS_NEED <= (size_t)256 * 1024 * 1024, "workspace budget");
#define WS_PTR(T, name, OFF) __device__ __forceinline__ T* name(const P& p) { return (T*)(p.ws + (OFF)); }
WS_PTR(unsigned, w_bar, OFF_BAR) WS_PTR(bf16, w_Wt_in, OFF_WTIN) WS_PTR(bf16, w_Wt_out, OFF_WTOUT) WS_PTR(bf16, w_Wt_q, OFF_WTQ) WS_PTR(bf16, w_SK, OFF_SK)
WS_PTR(bf16, w_PWt, OFF_PWT) WS_PTR(unsigned char, w_Ub, OFF_UB) WS_PTR(unsigned char, w_Vb, OFF_VB) WS_PTR(float, w_SU, OFF_SU) WS_PTR(float, w_SV, OFF_SV) WS_PTR(unsigned char, w_H8, OFF_H8) WS_PTR(float, w_HS, OFF_HS) WS_PTR(float, w_PART, OFF_PART) WS_PTR(float, w_MOD, OFF_MOD) WS_PTR(float, w_BIAS, OFF_BIAS)
WS_PTR(bf16, w_VT, OFF_VT) WS_PTR(bf16, w_H, OFF_H) WS_PTR(bf16, w_MIXED, OFF_MIXED) WS_PTR(bf16, w_PROJ, OFF_PROJ) WS_PTR(float, w_X1, OFF_X1)
WS_PTR(int, w_IDX, OFF_IDX) WS_PTR(float, w_GATE, OFF_GATE)

DI int cond_row(int token) { return token < NPR ? (token >> 11) : (NB + token - NPR); }
DI int crow(int reg, int h) { return (reg & 3) + 8 * (reg >> 2) + 4 * h; }
DI const float* xrow(const P& p, int token) { return token < NPR ? p.x_prompt + (size_t)token * DM : p.x_sample + (size_t)(token - NPR) * DM; }

#define LDS_WAIT() asm volatile("s_waitcnt lgkmcnt(0)" ::: "memory")
DI int opaque0() { int z = 0; asm volatile("" : "+v"(z)); return z; }
DI float bf2f(bf16 v) { return (float)v; }
DI f32x16 zero16() { f32x16 z; for (int i = 0; i < 16; ++i) z[i] = 0.f; return z; }
DI bf16x8 pack_step(const f32x16& x, int s) { bf16x8 v; for (int j = 0; j < 8; ++j) v[j] = (bf16)x[8 * s + j]; return v; }
DI bf16x8 cat4(bf16x4 lo, bf16x4 hi) { return __builtin_shufflevector(lo, hi, 0, 1, 2, 3, 4, 5, 6, 7); }
DI float wave_sum(float v) { for (int o = 32; o >= 1; o >>= 1) v += __shfl_xor(v, o); return v; }

#define XB_TMO 128
#define XB_XCNT(j) (256 + 64 * (j))
#define XB_XSUB(j) (1280 + 64 * (j))
#define XB_XGEN(j) (2304 + 64 * (j))
#define XB_TOP 3328
#define XB_TOPGEN 3392
#define XCD_BAR_WORDS 3456
#define XB_SPIN_CAP (1u << 22)
DI unsigned xb_ld(unsigned* p) { return __hip_atomic_load(p, __ATOMIC_RELAXED, __HIP_MEMORY_SCOPE_AGENT); }
DI unsigned xb_add(unsigned* p, unsigned v) { return __hip_atomic_fetch_add(p, v, __ATOMIC_RELAXED, __HIP_MEMORY_SCOPE_AGENT); }
DI unsigned xb_xcc_id() { return (unsigned)__builtin_amdgcn_s_getreg((3 << 11) | 20) & 0xFu; }
#define XB_SPIN(cond, bar) do { unsigned _sp = 0; while (cond) { __builtin_amdgcn_s_sleep(1); \
    if ((++_sp & 255u) == 0u) { if (xb_ld(&(bar)[XB_TMO])) break; if (_sp > XB_SPIN_CAP) { atomicAdd(&(bar)[XB_TMO], 1u); break; } } } } while (0)

DI void xcd_barrier_complete(unsigned* bar, unsigned x, unsigned& nloc, unsigned& nx) {
  const unsigned G = gridDim.x;
  unsigned sum, cnt, mine, sp = 0u;
  for (;;) {
    sum = 0u; cnt = 0u; mine = 0u;
#pragma unroll
    for (unsigned j = 0; j < 16; ++j) { const unsigned c = xb_ld(&bar[XB_XCNT(j)]); sum += c; cnt += (c > 0u) ? 1u : 0u; mine = (j == x) ? c : mine; }
    if (sum == G) break;
    __builtin_amdgcn_s_sleep(1);
    if ((++sp & 255u) == 0u) { if (xb_ld(&bar[XB_TMO])) break; if (sp > XB_SPIN_CAP) { atomicAdd(&bar[XB_TMO], 1u); break; } }
  }
  nloc = mine > 0u ? mine : 1u; nx = cnt > 0u ? cnt : 1u;
}
DI void xcd_barrier(unsigned* bar, unsigned x, volatile unsigned* st) {
  asm volatile("s_waitcnt vmcnt(0)" ::: "memory");
  __syncthreads();
  if (threadIdx.x == 0) {
    __builtin_amdgcn_s_waitcnt(0);
    unsigned nloc = st[0], nx = st[1];
    if (nloc == 0u) { xcd_barrier_complete(bar, x, nloc, nx); st[0] = nloc; st[1] = nx; }
    const unsigned old = xb_add(&bar[XB_XSUB(x)], 1u);
    const unsigned gen = old / nloc;
    const bool leader = old + 1u == (gen + 1u) * nloc;
    if (leader) {
      __builtin_amdgcn_fence(__ATOMIC_RELEASE, "agent");
      asm volatile("s_waitcnt vmcnt(0)" ::: "memory");
    }
    if (leader) {
      const unsigned og = xb_add(&bar[XB_TOP], 1u);
      const unsigned tg = og / nx;
      if (og + 1u == (tg + 1u) * nx) xb_add(&bar[XB_TOPGEN], 1u);
      else XB_SPIN(xb_ld(&bar[XB_TOPGEN]) == tg, bar);
      xb_add(&bar[XB_XGEN(x)], 1u);
      __builtin_amdgcn_fence(__ATOMIC_ACQUIRE, "agent");
    } else {
#if EARLY_INV
      __builtin_amdgcn_fence(__ATOMIC_ACQUIRE, "agent");
#endif
      XB_SPIN(xb_ld(&bar[XB_XGEN(x)]) == gen, bar);
#if !EARLY_INV
      __builtin_amdgcn_fence(__ATOMIC_ACQUIRE, "agent");
#endif
    }
    asm volatile("s_waitcnt vmcnt(0)" ::: "memory");
  }
  __syncthreads();
}

constexpr int U0_MOD = 192;
constexpr int U0_TIN = (1024 / 64) * (INW / 64);
constexpr int F0_TOTAL = U0_TIN + 1;
constexpr int U0_TPW = 4 * 2 * 4;
constexpr int U0_CSK = 32;
constexpr int U0_KW = 128, U0_VW = 128, U0_PW = 128;
constexpr int F2_TOUT = 16 * 16, F2_TQ = 16 * 32, F2_E1 = F2_TOUT + F2_TQ, F2_E2 = F2_E1 + U0_TPW, F2_E3 = F2_E2 + U0_KW, F2_E4 = F2_E3 + U0_VW,
              F2_TOTAL = F2_E4 + U0_PW;
constexpr int F4_TOTAL = U0_CSK;
constexpr int F6_QU = 2048, F6_QV = 2048, F6_TOTAL = F6_QU + F6_QV;

DI float silu_f(float x) { return x * __builtin_amdgcn_rcpf(1.f + __expf(-x)); }

DI void unit_mod(const P& p, int u, char* smem) {
  const int t = threadIdx.x + opaque0(), lane = t & 63, w = t >> 6, r = lane & 31, h = lane >> 5;
  const int f0 = u * 32;
  f32x16 acc[5];
#pragma unroll
  for (int i = 0; i < 5; ++i) acc[i] = zero16();
  const float* wp = p.ada_w + (size_t)(w * 256 + 8 * h) * 6144 + f0 + r;
  const float* cp[5];
#pragma unroll
  for (int i = 0; i < 5; ++i) { const int m = 32 * i + r, mm = m < NMOD ? m : 0; cp[i] = (mm < NB ? p.c_prompt + (size_t)mm * DM : p.c_sample + (size_t)(mm - NB) * DM) + w * 256 + 8 * h; }
  float wv[8]; f32x4 cv[5][2];
#pragma unroll
  for (int j = 0; j < 8; ++j) wv[j] = wp[(size_t)j * 6144];
#pragma unroll
  for (int i = 0; i < 5; ++i) { cv[i][0] = *(const f32x4*)cp[i]; cv[i][1] = *(const f32x4*)(cp[i] + 4); }
#pragma unroll 1
  for (int ks = 0; ks < 16; ++ks) {
    bf16x8 bfr, afr[5];
#pragma unroll
    for (int j = 0; j < 8; ++j) bfr[j] = (bf16)wv[j];
#pragma unroll
    for (int i = 0; i < 5; ++i) {
      const bool ok = 32 * i + r < NMOD;
#pragma unroll
      for (int j = 0; j < 8; ++j) afr[i][j] = (bf16)(ok ? silu_f(cv[i][j >> 2][j & 3]) : 0.f);
    }
    const int kn = ks + 1 < 16 ? ks + 1 : 15;
#pragma unroll
    for (int j = 0; j < 8; ++j) wv[j] = wp[(size_t)(kn * 16 + j) * 6144];
#pragma unroll
    for (int i = 0; i < 5; ++i) { cv[i][0] = *(const f32x4*)(cp[i] + kn * 16); cv[i][1] = *(const f32x4*)(cp[i] + kn * 16 + 4); }
#pragma unroll
    for (int i = 0; i < 5; ++i) acc[i] = MFMA(afr[i], bfr, acc[i]);
  }
  float* red = (float*)smem;
  __syncthreads();
  if (w > 0) {
#pragma unroll
    for (int i = 0; i < 5; ++i)
#pragma unroll
      for (int j = 0; j < 16; ++j) red[((w - 1) * 80 + i * 16 + j) * 64 + lane] = acc[i][j];
  }
  __syncthreads();
  if (w == 0) {
    const float bias = p.ada_b[f0 + r];
#pragma unroll
    for (int i = 0; i < 5; ++i)
#pragma unroll
      for (int j = 0; j < 16; ++j) {
        const int m = 32 * i + crow(j, h);
        const float v = acc[i][j] + red[(0 * 80 + i * 16 + j) * 64 + lane] + red[(1 * 80 + i * 16 + j) * 64 + lane] + red[(2 * 80 + i * 16 + j) * 64 + lane] + bias;
        if (m < NMOD) w_MOD(p)[(size_t)m * 6144 + f0 + r] = v;
      }
  }
}

DI void unit_transpose(const float* __restrict__ src, bf16* __restrict__ dst, int R, int C, int tr, int tc, char* smem) {
  float* tile = (float*)smem;
  const int t = threadIdx.x + opaque0();
  __syncthreads();
#pragma unroll
  for (int i = 0; i < 4; ++i) {
    const int rr = (t >> 4) + 16 * i, cc = (t & 15) * 4;
    const f32x4 v = *(const f32x4*)(src + (size_t)(tr * 64 + rr) * C + tc * 64 + cc);
    tile[rr * 65 + cc] = v[0]; tile[rr * 65 + cc + 1] = v[1]; tile[rr * 65 + cc + 2] = v[2]; tile[rr * 65 + cc + 3] = v[3];
  }
  __syncthreads();
#pragma unroll
  for (int i = 0; i < 2; ++i) {
    const int orow = (t >> 3) + 32 * i, seg = (t & 7) * 8;
    bf16x8 v;
#pragma unroll
    for (int j = 0; j < 8; ++j) v[j] = (bf16)tile[(seg + j) * 65 + orow];
    *(bf16x8*)(dst + (size_t)(tc * 64 + orow) * R + tr * 64 + seg) = v;
  }
}
DI void unit_convert(const float* __restrict__ src, bf16* __restrict__ dst, int u) {
  const size_t base = (size_t)u * 8192 + (threadIdx.x + opaque0()) * 8;
#pragma unroll
  for (int i = 0; i < 4; ++i) {
    const size_t o = base + (size_t)i * 2048;
    const f32x4 a = *(const f32x4*)(src + o), b = *(const f32x4*)(src + o + 4);
    bf16x8 v; v[0] = (bf16)a[0]; v[1] = (bf16)a[1]; v[2] = (bf16)a[2]; v[3] = (bf16)a[3]; v[4] = (bf16)b[0]; v[5] = (bf16)b[1]; v[6] = (bf16)b[2]; v[7] = (bf16)b[3];
    *(bf16x8*)(dst + o) = v;
  }
}
DI unsigned pack_i8(float a, float b, float c, float d) {
  const int ia = max(-127, min(127, __float2int_rn(a))), ib = max(-127, min(127, __float2int_rn(b))), ic = max(-127, min(127, __float2int_rn(c))), id = max(-127, min(127, __float2int_rn(d)));
  return (unsigned)(ia & 255) | ((unsigned)(ib & 255) << 8) | ((unsigned)(ic & 255) << 16) | ((unsigned)(id & 255) << 24);
}
template <bool I8>
DI void unit_quant_rows(const float* __restrict__ src, unsigned char* __restrict__ dst, float* __restrict__ scale, int u) {
  const int t = threadIdx.x + opaque0(), lane = t & 63, w = t >> 6;
#pragma unroll
  for (int rr = 0; rr < 2; ++rr) {
    const size_t row = (size_t)u * 8 + 2 * w + rr;
    const float* s = src + row * DM + 16 * lane;
    f32x4 v[4];
    float amax = 0.f;
#pragma unroll
    for (int i = 0; i < 4; ++i) { v[i] = *(const f32x4*)(s + 4 * i); amax = fmaxf(amax, fmaxf(fmaxf(fabsf(v[i][0]), fabsf(v[i][1])), fmaxf(fabsf(v[i][2]), fabsf(v[i][3])))); }
#pragma unroll
    for (int o = 32; o >= 1; o >>= 1) amax = fmaxf(amax, __shfl_xor(amax, o));
    const float sc = amax > 0.f ? amax * (I8 ? 1.f / 127.f : 1.f / 440.f) : 1.f, inv = 1.f / sc;
    u32x4 q;
#pragma unroll
    for (int i = 0; i < 4; ++i) {
      if (I8) {
        q[i] = pack_i8(v[i][0] * inv, v[i][1] * inv, v[i][2] * inv, v[i][3] * inv);
      } else {
        int wd = 0;
        wd = __builtin_amdgcn_cvt_pk_fp8_f32(v[i][0] * inv, v[i][1] * inv, wd, false);
        wd = __builtin_amdgcn_cvt_pk_fp8_f32(v[i][2] * inv, v[i][3] * inv, wd, true);
        q[i] = (unsigned)wd;
      }
    }
    *(u32x4*)(dst + row * DM + 16 * lane) = q;
    if (lane == 0) scale[row] = sc;
  }
}
DI void unit_copy_f4(const float* __restrict__ src, float* __restrict__ dst, int n4) {
  for (int i = threadIdx.x + opaque0(); i < n4; i += NTHREADS) ((f32x4*)dst)[i] = ((const f32x4*)src)[i];
}

DI void phase0_filler(const P& p, int f, char* smem) {
  if (f < U0_TIN) { unit_transpose(p.w_in, w_Wt_in(p), 1024, INW, f / 60, f % 60, smem); }
  else {
    for (int i = threadIdx.x + opaque0(); i < 16 * 128; i += NTHREADS) {
      const int head = i >> 7, d = i & 127;
      int bk = d;
      if (d >= 16) { bk = 16 + (int)(logf((float)d / 16.f) / logf(8.f) * 16.f); bk = bk > 31 ? 31 : bk; }
      w_BIAS(p)[i] = p.rel_table[bk * 16 + head];
    }
  }
}
DI void phase2_filler(const P& p, int f, char* smem) {
  if (f < F2_TOUT) unit_transpose(p.w_out, w_Wt_out(p), 1024, 1024, f / 16, f % 16, smem);
  else if (f < F2_E1) { const int v = f - F2_TOUT; unit_transpose(p.w_query, w_Wt_q(p), 1024, 2048, v / 32, v % 32, smem); }
  else if (f < F2_E2) { const int v = f - F2_E1, g = v >> 3, tt = v & 7; unit_transpose(p.pool_w + (size_t)g * 128 * 256, w_PWt(p) + (size_t)g * 256 * 128, 128, 256, tt >> 2, tt & 3, smem); }
  else if (f < F2_E3) { const int b = f - F2_E2; unit_copy_f4(p.cache_k + ((size_t)b * 128 + 1) * 128, p.out + O_KWS + (size_t)b * 128 * 128, 127 * 128 / 4); }
  else if (f < F2_E4) { const int b = f - F2_E3; unit_copy_f4(p.cache_v + ((size_t)b * 128 + 1) * 128, p.out + O_VWS + (size_t)b * 128 * 128, 127 * 128 / 4); }
  else { const int b = f - F2_E4; unit_copy_f4(p.state_pool + ((size_t)b * 15 + 1) * 512, p.out + O_PS + (size_t)b * 15 * 512, 14 * 512 / 4); }
}

DI void norm_row(const P& p, int token, int which) {
  const int lane = (threadIdx.x + opaque0()) & 63;
  const float* src = which == 0 ? xrow(p, token) : w_X1(p) + (size_t)token * DM;
  const float* g = which == 0 ? p.norm1_g : p.norm2_g;
  const float* mod = w_MOD(p) + (size_t)cond_row(token) * 6144 + (which == 0 ? 0 : 3072);
  f32x4 v[4];
  float ss = 0.f;
  if (which == 1 && token >= NPR) {
    const float* g1 = w_MOD(p) + (size_t)cond_row(token) * 6144 + 2048;
#pragma unroll
    for (int i = 0; i < 4; ++i) {
      const int c = 4 * lane + 256 * i;
      const size_t po = (size_t)(token - NPR) * DM + c;
      const f32x4 xv = *(const f32x4*)(xrow(p, token) + c), gv = *(const f32x4*)(g1 + c);
      const f32x4 pa = *(const f32x4*)(w_PART(p) + po), pb = *(const f32x4*)(w_PART(p) + (size_t)NS * DM + po), pc = *(const f32x4*)(w_PART(p) + (size_t)2 * NS * DM + po), pd = *(const f32x4*)(w_PART(p) + (size_t)3 * NS * DM + po);
#pragma unroll
      for (int j = 0; j < 4; ++j) v[i][j] = xv[j] + gv[j] * ((pa[j] + pb[j]) + (pc[j] + pd[j]));
      *(f32x4*)(w_X1(p) + (size_t)token * DM + c) = v[i];
      ss += v[i][0] * v[i][0] + v[i][1] * v[i][1] + v[i][2] * v[i][2] + v[i][3] * v[i][3];
    }
  } else {
#pragma unroll
  for (int i = 0; i < 4; ++i) { v[i] = *(const f32x4*)(src + 4 * lane + 256 * i); ss += v[i][0] * v[i][0] + v[i][1] * v[i][1] + v[i][2] * v[i][2] + v[i][3] * v[i][3]; }
  }
  ss = wave_sum(ss);
  const float rstd = rsqrtf(ss * (1.f / DM) + EPS);
#pragma unroll
  for (int i = 0; i < 4; ++i) {
    const int c = 4 * lane + 256 * i;
    const f32x4 gg = *(const f32x4*)(g + c), sh = *(const f32x4*)(mod + c), sc = *(const f32x4*)(mod + 1024 + c);
    bf16x4 o;
#pragma unroll
    for (int j = 0; j < 4; ++j) { v[i][j] = (v[i][j] * rstd * gg[j]) * (1.f + sc[j]) + sh[j]; o[j] = (bf16)v[i][j]; }
    *(bf16x4*)(w_H(p) + (size_t)token * DM + c) = o;
  }
  if (which == 1) {
    float amax = 0.f;
#pragma unroll
    for (int i = 0; i < 4; ++i) amax = fmaxf(amax, fmaxf(fmaxf(fabsf(v[i][0]), fabsf(v[i][1])), fmaxf(fabsf(v[i][2]), fabsf(v[i][3]))));
#pragma unroll
    for (int o = 32; o >= 1; o >>= 1) amax = fmaxf(amax, __shfl_xor(amax, o));
    const float qs = amax > 0.f ? amax * (1.f / 127.f) : 1.f, inv = 1.f / qs;
#pragma unroll
    for (int i = 0; i < 4; ++i) *(unsigned*)(w_H8(p) + (size_t)token * DM + 4 * lane + 256 * i) = pack_i8(v[i][0] * inv, v[i][1] * inv, v[i][2] * inv, v[i][3] * inv);
    if (lane == 0) w_HS(p)[token] = qs;
  }
}

constexpr int LDSK = 72;
constexpr int GT = 128 * 64 * 2;
constexpr int GBUF = 2 * GT;
typedef __attribute__((address_space(3))) unsigned lds_u32;
typedef const __attribute__((address_space(1))) unsigned glb_u32;
DI void glds16(const void* g, char* l) { __builtin_amdgcn_global_load_lds((glb_u32*)g, (lds_u32*)l, 16, 0, 0); }
DI void gemm_first(const bf16* __restrict__ Wt, const bf16* __restrict__ X, int ld, int n0, int m0, char* smem) {
  const int t = threadIdx.x + opaque0(), lane = t & 63;
  const int w = __builtin_amdgcn_readfirstlane(t >> 6);
  const int swz = (lane & 7) ^ ((4 * w + (lane >> 4)) & 7);
  const bf16* ga = Wt + (size_t)(n0 + 8 * w + (lane >> 3)) * ld + swz * 8;
  const bf16* gb = X + (size_t)(m0 + 8 * w + (lane >> 3)) * ld + swz * 8;
#pragma unroll
  for (int q = 0; q < 4; ++q) { glds16(ga + (size_t)(32 * q) * ld, smem + 1024 * (w + 4 * q)); glds16(gb + (size_t)(32 * q) * ld, smem + GT + 1024 * (w + 4 * q)); }
}
DI void gemm_main(const bf16* __restrict__ Wt, const bf16* __restrict__ X, int ld, int K, int n0, int m0, char* smem, f32x16 (&acc)[4]) {
  const int t = threadIdx.x + opaque0(), lane = t & 63, r = lane & 31, h = lane >> 5;
  const int w = __builtin_amdgcn_readfirstlane(t >> 6);
#pragma unroll
  for (int i = 0; i < 4; ++i) acc[i] = zero16();
  const int swz = (lane & 7) ^ ((4 * w + (lane >> 4)) & 7);
  const bf16* ga = Wt + (size_t)(n0 + 8 * w + (lane >> 3)) * ld + swz * 8;
  const bf16* gb = X + (size_t)(m0 + 8 * w + (lane >> 3)) * ld + swz * 8;
  const int sw = (r >> 1) & 7;
  const int KT = K >> 6;
  asm volatile("s_waitcnt vmcnt(0)" ::: "memory");
  __syncthreads();
  for (int kt = 0; kt < KT; ++kt) {
    const char* As = smem + (kt & 1) * GBUF;
    const char* Bs = As + GT;
    if (kt + 1 < KT) {
      char* An = smem + ((kt + 1) & 1) * GBUF;
      const int k0 = (kt + 1) * 64;
#pragma unroll
      for (int q = 0; q < 4; ++q) { glds16(ga + (size_t)(32 * q) * ld + k0, An + 1024 * (w + 4 * q)); glds16(gb + (size_t)(32 * q) * ld + k0, An + GT + 1024 * (w + 4 * q)); }
    }
#pragma unroll
    for (int s = 0; s < 4; ++s) {
      const int co = ((2 * s + h) ^ sw) * 16;
      const bf16x8 bfr = *(const bf16x8*)(Bs + (32 * w + r) * 128 + co);
#pragma unroll
      for (int i = 0; i < 4; ++i) {
        const bf16x8 afr = *(const bf16x8*)(As + (32 * i + r) * 128 + co);
        acc[i] = MFMA(afr, bfr, acc[i]);
      }
    }
    asm volatile("s_waitcnt vmcnt(0)" ::: "memory");
    __syncthreads();
  }
}

DI float sigmoid_f(float x) { return __builtin_amdgcn_rcpf(1.f + __expf(-x)); }

DI void gemm1_map(int u, int& mt, int& nt) {
  const int v = u < 3584 ? (u & ~511) + (u & 7) * 64 + ((u >> 3) & 63) : u;
  mt = v / 30; nt = v % 30;
}
DI void unit_gemm1(const P& p, int u, int un, char* smem) {
  int mt, nt; gemm1_map(u, mt, nt);
  const int n0 = nt * 128, m0 = mt * 128;
  f32x16 acc[4];
  gemm_main(w_Wt_in(p), w_H(p), 1024, 1024, n0, m0, smem, acc);
  if (un >= 0) { int mn, nn; gemm1_map(un, mn, nn); gemm_first(w_Wt_in(p), w_H(p), 1024, nn * 128, mn * 128, smem); }
  const int tz = threadIdx.x + opaque0();
  const int lane = tz & 63, w = tz >> 6, r = lane & 31, h = lane >> 5;
  const int token = m0 + 32 * w + r;
  bf16* tw = (bf16*)(smem + GBUF + (tz >> 6) * 8704) + r * 136;
  const bool is_prompt = token < NPR;
  const int b = is_prompt ? (token >> 11) : (token - NPR), pos = token & (SEQ - 1);
  if (n0 < C_V) {
    const float* gn = n0 < C_K ? p.q_norm_g : p.k_norm_g;
    const float post = n0 < C_K ? 0.125f : 1.f;
#pragma unroll
    for (int hh = 0; hh < 2; ++hh) {
      float ss = 0.f;
#pragma unroll
      for (int i = 0; i < 2; ++i)
#pragma unroll
        for (int j = 0; j < 16; ++j) ss += acc[2 * hh + i][j] * acc[2 * hh + i][j];
      ss += __shfl_xor(ss, 32);
      const float rstd = rsqrtf(ss * (1.f / 64.f) + EPS);
#pragma unroll
      for (int i = 0; i < 2; ++i)
#pragma unroll
        for (int q4 = 0; q4 < 4; ++q4) {
          const int d = 32 * i + 8 * q4 + 4 * h;
          const f32x4 gg = *(const f32x4*)(gn + d);
          f32x4 v;
#pragma unroll
          for (int j = 0; j < 4; ++j) v[j] = acc[2 * hh + i][4 * q4 + j] * rstd * gg[j];
          bf16x4 o;
#pragma unroll
          for (int j = 0; j < 4; ++j) o[j] = (bf16)(v[j] * post);
          *(bf16x4*)(tw + 64 * hh + d) = o;
          if (n0 == C_K) {
            if (is_prompt) { if (pos >= SEQ - 128) *(f32x4*)(p.out + O_KWP + ((size_t)b * 128 + (pos - (SEQ - 128))) * 128 + 64 * hh + d) = v; }
            else *(f32x4*)(p.out + O_KWS + ((size_t)b * 128 + 127) * 128 + 64 * hh + d) = v;
          }
        }
    }
  } else if (n0 == C_V) {
#pragma unroll
    for (int i = 0; i < 4; ++i)
#pragma unroll
      for (int q4 = 0; q4 < 4; ++q4) {
        const int f = 32 * i + 8 * q4 + 4 * h;
        f32x4 v;
#pragma unroll
        for (int j = 0; j < 4; ++j) v[j] = acc[i][4 * q4 + j];
        if (is_prompt) {
#pragma unroll
          for (int j = 0; j < 4; ++j) w_VT(p)[((size_t)b * 128 + f + j) * SEQ + pos] = (bf16)v[j];
          if (pos >= SEQ - 128) *(f32x4*)(p.out + O_VWP + ((size_t)b * 128 + (pos - (SEQ - 128))) * 128 + f) = v;
        } else *(f32x4*)(p.out + O_VWS + ((size_t)b * 128 + 127) * 128 + f) = v;
      }
  } else if (n0 < C_GA) {
#pragma unroll
    for (int i = 0; i < 4; ++i)
#pragma unroll
      for (int q4 = 0; q4 < 4; ++q4) {
        const int f = n0 + 32 * i + 8 * q4 + 4 * h;
        f32x4 v; bf16x4 o;
#pragma unroll
        for (int j = 0; j < 4; ++j) { v[j] = acc[i][4 * q4 + j]; o[j] = (bf16)v[j]; }
        *(bf16x4*)(tw + (f - n0)) = o;
        if (is_prompt) { if (pos >= SEQ - 15) *(f32x4*)(p.out + O_PP + ((size_t)b * 15 + (pos - (SEQ - 15))) * 512 + (f - C_PIN)) = v; }
        else *(f32x4*)(p.out + O_PS + ((size_t)b * 15 + 14) * 512 + (f - C_PIN)) = v;
      }
  } else {
#pragma unroll
    for (int i = 0; i < 4; ++i)
#pragma unroll
      for (int q4 = 0; q4 < 4; ++q4) {
        const int f = n0 + 32 * i + 8 * q4 + 4 * h;
        bf16x4 o;
#pragma unroll
        for (int j = 0; j < 4; ++j) o[j] = (bf16)sigmoid_f(acc[i][4 * q4 + j]);
        *(bf16x4*)(tw + (f - n0)) = o;
      }
  }
  if (n0 != C_V) {
    LDS_WAIT();
    const bf16* tr = (const bf16*)(smem + GBUF + (tz >> 6) * 8704);
    bf16* pg = w_PROJ(p) + (size_t)(m0 + 32 * w + (lane >> 4)) * INW + n0 + (lane & 15) * 8;
#pragma unroll
    for (int it = 0; it < 8; ++it) *(u32x4*)(pg + (size_t)(4 * it) * INW) = *(const u32x4*)(tr + ((lane >> 4) + 4 * it) * 136 + (lane & 15) * 8);
  }
}

constexpr int VTS = 260;
constexpr int RS = 136;
DI void attn_head(const P& p, int head, int blk, int w, int r, int h, const bf16x8 (&qf)[4], const bf16* Ks, const bf16* VTs, const float* bsh, bf16x8 (&ob)[4]) {
  const int qi = 32 * w + r;
  f32x16 st[5];
#pragma unroll
  for (int tt = 0; tt < 5; ++tt) {
    st[tt] = zero16();
#pragma unroll
    for (int s = 0; s < 4; ++s) {
      const bf16x8 a = *(const bf16x8*)(Ks + (32 * (w + tt) + r) * LDSK + 16 * s + 8 * h);
      st[tt] = MFMA(a, qf[s], st[tt]);
    }
  }
  const float sink = p.sinks[head];
  float m = -INFINITY;
  {
    const int x = 31 - r + 4 * h;
    const float* bl = bsh + x;
#pragma unroll
    for (int tt = 0; tt < 5; ++tt)
#pragma unroll
      for (int j = 0; j < 16; ++j) {
        const int c = 32 * tt + (j & 3) + 8 * (j >> 2);
        const float s = st[tt][j] + bl[c];
        st[tt][j] = s;
        m = fmaxf(m, s);
      }
    if (blk == 0) {
      m = -INFINITY;
#pragma unroll
      for (int tt = 0; tt < 5; ++tt)
#pragma unroll
        for (int j = 0; j < 16; ++j) {
          const int c = 32 * tt + (j & 3) + 8 * (j >> 2);
          const float s = (159 - (x + c) > qi) ? -INFINITY : st[tt][j];
          st[tt][j] = s;
          m = fmaxf(m, s);
        }
    }
  }
  m = fmaxf(m, __shfl_xor(m, 32));
  m = fmaxf(m, sink);
  float sum = 0.f;
#pragma unroll
  for (int tt = 0; tt < 5; ++tt)
#pragma unroll
    for (int j = 0; j < 16; ++j) { const float e = __expf(st[tt][j] - m); st[tt][j] = e; sum += e; }
  sum += __shfl_xor(sum, 32);
  const float inv = 1.f / (sum + __expf(sink - m));
  f32x16 o[2] = {zero16(), zero16()};
#pragma unroll
  for (int tt = 0; tt < 5; ++tt)
#pragma unroll
    for (int s = 0; s < 2; ++s) {
      const bf16x8 pb = pack_step(st[tt], s);
#pragma unroll
      for (int i = 0; i < 2; ++i) {
        const bf16* vp = VTs + (32 * i + r) * VTS + 32 * (w + tt) + 16 * s + 4 * h;
        const bf16x8 a = cat4(*(const bf16x4*)vp, *(const bf16x4*)(vp + 8));
        o[i] = MFMA(a, pb, o[i]);
      }
    }
#pragma unroll
  for (int i = 0; i < 2; ++i)
#pragma unroll
    for (int j = 0; j < 16; ++j) ob[2 * i + (j >> 3)][j & 7] = (bf16)(o[i][j] * inv);
}
DI void unit_attn_prompt(const P& p, int u0, char* smem) {
  const int u = (u0 & ~511) + (u0 & 7) * 64 + ((u0 >> 3) & 63);
  const int b = u >> 7, blk = (u >> 3) & 15, hp = u & 7, hk = hp >> 2, g = hp >> 1, win = 2 << g;
  const int qpos0 = blk * 128;
  const int t = threadIdx.x + opaque0(), lane = t & 63, w = t >> 6, r = lane & 31, h = lane >> 5;
  bf16* Ks = (bf16*)smem;
  bf16* VTs = Ks + 256 * LDSK;
  float* bs = (float*)(VTs + 64 * VTS);
  bf16* Rs = Ks;
  __syncthreads();
#pragma unroll
  for (int i = 0; i < 8; ++i) {
    const int c = t + 256 * i, row = c >> 3, c16 = c & 7, kp = qpos0 - 128 + row;
    u32x4 v = {0u, 0u, 0u, 0u};
    if (kp >= 0) v = *(const u32x4*)(w_PROJ(p) + ((size_t)b * SEQ + kp) * INW + C_K + hk * 64 + c16 * 8);
    *(u32x4*)(Ks + row * LDSK + c16 * 8) = v;
  }
#pragma unroll
  for (int i = 0; i < 8; ++i) {
    const int c = t + 256 * i, drow = c >> 5, c16 = c & 31, kp0 = qpos0 - 128 + c16 * 8;
    u32x4 v = {0u, 0u, 0u, 0u};
    if (kp0 >= 0) v = *(const u32x4*)(w_VT(p) + ((size_t)(b * 2 + hk) * 64 + drow) * SEQ + kp0);
    u32x2* d2 = (u32x2*)(VTs + drow * VTS + c16 * 8);
    d2[0] = (u32x2){v[0], v[1]}; d2[1] = (u32x2){v[2], v[3]};
  }
  for (int i = t; i < 384; i += NTHREADS) { const int hh = i >= 192, j = i - 192 * hh, dist = 159 - j; bs[i] = (dist >= 0 && dist < 128) ? w_BIAS(p)[(2 * hp + hh) * 128 + dist] : -INFINITY; }
  const size_t tokq = (size_t)b * SEQ + qpos0 + 32 * w + r;
  bf16x8 qf0[4], qf1[4];
#pragma unroll
  for (int s = 0; s < 4; ++s) { qf0[s] = *(const bf16x8*)(w_PROJ(p) + tokq * INW + (2 * hp) * 64 + 16 * s + 8 * h); qf1[s] = *(const bf16x8*)(w_PROJ(p) + tokq * INW + (2 * hp + 1) * 64 + 16 * s + 8 * h); }
  __syncthreads();
  bf16x8 ob0[4], ob1[4];
  attn_head(p, 2 * hp, blk, w, r, h, qf0, Ks, VTs, bs, ob0);
  __builtin_amdgcn_sched_barrier(0);
  attn_head(p, 2 * hp + 1, blk, w, r, h, qf1, Ks, VTs, bs + 192, ob1);
  __builtin_amdgcn_sched_barrier(0);
  __syncthreads();
  {
    const int tk = t >> 4, cc = t & 15;
    const int p0 = qpos0 + tk * 8;
    const bf16* pin = w_PROJ(p) + (size_t)b * SEQ * INW + C_PIN + g * 128 + cc * 8;
    float S[8];
#pragma unroll
    for (int j = 0; j < 8; ++j) S[j] = 0.f;
    for (int i = 0; i < win; ++i) {
      const int pp = p0 - i;
      if (pp >= 0) { const bf16x8 v = *(const bf16x8*)(pin + (size_t)pp * INW);
#pragma unroll
        for (int j = 0; j < 8; ++j) S[j] += bf2f(v[j]); }
    }
    for (int i = 0; i < 8; ++i) {
      const int pos = p0 + i;
      const bf16x8 cur = *(const bf16x8*)(pin + (size_t)pos * INW);
      if (i > 0) {
#pragma unroll
        for (int j = 0; j < 8; ++j) S[j] += bf2f(cur[j]);
        if (pos - win >= 0) { const bf16x8 old = *(const bf16x8*)(pin + (size_t)(pos - win) * INW);
#pragma unroll
          for (int j = 0; j < 8; ++j) S[j] -= bf2f(old[j]); }
      }
      const float icnt = 1.f / (float)(win < pos + 1 ? win : pos + 1);
      bf16x8 rr;
#pragma unroll
      for (int j = 0; j < 8; ++j) rr[j] = (bf16)(S[j] * icnt - bf2f(cur[j]));
      *(bf16x8*)(Rs + (tk * 8 + i) * RS + cc * 8) = rr;
    }
  }
  __syncthreads();
  const bf16* prow = w_PROJ(p) + tokq * INW;
#pragma unroll
  for (int hh = 0; hh < 2; ++hh) {
    const int head = 2 * hp + hh;
    f32x16 pa[2] = {zero16(), zero16()};
#pragma unroll
    for (int s = 0; s < 8; ++s) {
      const bf16x8 bfr = *(const bf16x8*)(Rs + (32 * w + r) * RS + 16 * s + 8 * h);
#pragma unroll
      for (int i = 0; i < 2; ++i) {
        const bf16x8 a = *(const bf16x8*)(w_PWt(p) + ((size_t)g * 256 + (head & 3) * 64 + 32 * i + r) * 128 + 16 * s + 8 * h);
        pa[i] = MFMA(a, bfr, pa[i]);
      }
    }
#pragma unroll
    for (int i = 0; i < 2; ++i)
#pragma unroll
      for (int q4 = 0; q4 < 4; ++q4) {
        const int f = head * 64 + 32 * i + 8 * q4 + 4 * h;
        const bf16x4 ga = *(const bf16x4*)(prow + C_GA + f), gb = *(const bf16x4*)(prow + C_GB + f);
        const f32x4 ps = *(const f32x4*)(p.pool_scale + f);
        bf16x4 ov;
#pragma unroll
        for (int j = 0; j < 4; ++j) { const bf16 av = hh ? ob1[2 * i + (q4 >> 1)][4 * (q4 & 1) + j] : ob0[2 * i + (q4 >> 1)][4 * (q4 & 1) + j];
          ov[j] = (bf16)(bf2f(ga[j]) * bf2f(av) + bf2f(gb[j]) * (pa[i][4 * q4 + j] * ps[j])); }
        *(bf16x4*)(w_MIXED(p) + tokq * DM + f) = ov;
      }
    __builtin_amdgcn_sched_barrier(0);
  }
}

DI void unit_attn_sample(const P& p, int u, char* smem) {
  const int b = u >> 2, g = u & 3, hk = g >> 1;
  const int t = threadIdx.x + opaque0(), lane = t & 63, w = t >> 6;
  float* ks = (float*)smem;
  float* vs = ks + 128 * 65;
  float* qs = vs + 128 * 64;
  float* ps = qs + 256;
  float* os = ps + 512;
  float* rs = os + 256;
  const size_t token = (size_t)NPR + b;
  __syncthreads();
  const float* kw = p.out + O_KWS + (size_t)b * 128 * 128 + hk * 64;
  const float* vw = p.out + O_VWS + (size_t)b * 128 * 128 + hk * 64;
#pragma unroll 4
  for (int i = t; i < 128 * 64; i += NTHREADS) { const int j = i >> 6, d = i & 63; ks[j * 65 + d] = kw[(size_t)j * 128 + d]; vs[j * 64 + d] = vw[(size_t)j * 128 + d]; }
  qs[t] = bf2f(w_PROJ(p)[token * INW + g * 256 + t]);
  if (t < 128) {
    const int win = 2 << g;
    const float cur = p.out[O_PS + ((size_t)b * 15 + 14) * 512 + g * 128 + t];
    float tot = cur;
#pragma unroll 1
    for (int i = 1; i < win; ++i) tot += p.state_pool[((size_t)b * 15 + 15 - i) * 512 + g * 128 + t];
    rs[t] = tot / (float)win - cur;
  }
  __syncthreads();
  const int head = 4 * g + w;
  const float sink = p.sinks[head];
  float s[2];
  float m = sink;
#pragma unroll
  for (int i = 0; i < 2; ++i) {
    const int j = lane + 64 * i;
    float a = 0.f;
#pragma unroll 8
    for (int d = 0; d < 64; ++d) a += qs[w * 64 + d] * ks[j * 65 + d];
    s[i] = a + w_BIAS(p)[head * 128 + 127 - j];
    m = fmaxf(m, s[i]);
  }
  for (int o = 32; o >= 1; o >>= 1) m = fmaxf(m, __shfl_xor(m, o));
  float sum = 0.f;
#pragma unroll
  for (int i = 0; i < 2; ++i) { s[i] = __expf(s[i] - m); sum += s[i]; }
  sum = wave_sum(sum);
  const float inv = 1.f / (sum + __expf(sink - m));
#pragma unroll
  for (int i = 0; i < 2; ++i) ps[w * 128 + lane + 64 * i] = s[i] * inv;
  LDS_WAIT();
  {
    float a = 0.f;
#pragma unroll 8
    for (int j = 0; j < 128; ++j) a += ps[w * 128 + j] * vs[j * 64 + lane];
    os[w * 64 + lane] = a;
  }
  const int f = g * 256 + t;
  float pl = 0.f;
  const float* pw = p.pool_w + (size_t)g * 128 * 256 + t;
#pragma unroll 8
  for (int ch = 0; ch < 128; ++ch) pl += rs[ch] * pw[(size_t)ch * 256];
  pl *= p.pool_scale[f];
  const float ga = bf2f(w_PROJ(p)[token * INW + C_GA + f]), gb = bf2f(w_PROJ(p)[token * INW + C_GB + f]);
  LDS_WAIT();
  w_MIXED(p)[token * DM + f] = (bf16)(ga * os[t] + gb * pl);
}

DI void unit8_map(int u, int& mt, int& nt) {
  if (u < 1024) { const int xcd = u & 7, slot = (u >> 3) & 63, S = (u >> 9) * 8 + xcd; mt = S * 8 + (slot & 7); nt = slot >> 3; }
  else { mt = 128; nt = u - 1024; }
}
constexpr int G2_UNITS = 1024 + 32;
DI void gemm2_map(int u, int& mt, int& nt, int& kq) {
  if (u < 1024) { unit8_map(u, mt, nt); kq = -1; }
  else { mt = 128; nt = (u - 1024) & 7; kq = (u - 1024) >> 3; }
}
DI void gemm2_first(const P& p, int u, char* smem) {
  int mt, nt, kq; gemm2_map(u, mt, nt, kq);
  const int kb = kq < 0 ? 0 : 256 * kq;
  gemm_first(w_Wt_out(p) + kb, w_MIXED(p) + kb, 1024, nt * 128, mt * 128, smem);
}
DI void unit_gemm2(const P& p, int u, int un, char* smem) {
  int mt, nt, kq; gemm2_map(u, mt, nt, kq);
  const int n0 = nt * 128, m0 = mt * 128, kb = kq < 0 ? 0 : 256 * kq;
  f32x16 acc[4];
  gemm_main(w_Wt_out(p) + kb, w_MIXED(p) + kb, 1024, kq < 0 ? 1024 : 256, n0, m0, smem, acc);
  if (un >= 0) gemm2_first(p, un, smem);
  const int tz = threadIdx.x + opaque0();
  const int lane = tz & 63, w = tz >> 6, r = lane & 31, h = lane >> 5;
  float* tbase = (float*)(smem + GBUF + w * 8704);
#pragma unroll
  for (int hf = 0; hf < 2; ++hf) {
    if (hf) LDS_WAIT();
#pragma unroll
    for (int ii = 0; ii < 2; ++ii)
#pragma unroll
      for (int q4 = 0; q4 < 4; ++q4) {
        f32x4 v;
#pragma unroll
        for (int j = 0; j < 4; ++j) v[j] = acc[2 * hf + ii][4 * q4 + j];
        *(f32x4*)(tbase + r * 68 + 32 * ii + 8 * q4 + 4 * h) = v;
      }
    LDS_WAIT();
    const int fc = (lane & 15) * 4, tsub = lane >> 4;
#pragma unroll
    for (int it = 0; it < 8; ++it) {
      const int tl = 4 * it + tsub, token = m0 + 32 * w + tl, f = n0 + 64 * hf + fc;
      const f32x4 a = *(const f32x4*)(tbase + tl * 68 + fc);
      if (kq >= 0) { *(f32x4*)(w_PART(p) + ((size_t)kq * NS + (token - NPR)) * DM + f) = a; continue; }
      const f32x4 xv = *(const f32x4*)(xrow(p, token) + f), gv = *(const f32x4*)(w_MOD(p) + (size_t)cond_row(token) * 6144 + 2048 + f);
      f32x4 o;
#pragma unroll
      for (int j = 0; j < 4; ++j) o[j] = xv[j] + gv[j] * a[j];
      *(f32x4*)(w_X1(p) + (size_t)token * DM + f) = o;
    }
  }
}

DI unsigned f2ord(float f) { const unsigned u = __float_as_uint(f); return (u & 0x80000000u) ? ~u : (u | 0x80000000u); }
DI float ord2f(unsigned u) { return __uint_as_float((u & 0x80000000u) ? (u & 0x7fffffffu) : ~u); }
DI unsigned umin_(unsigned a, unsigned b) { return a < b ? a : b; }
DI unsigned umax_(unsigned a, unsigned b) { return a > b ? a : b; }
template <int OFF> DI void sort16_desc(unsigned (&a)[64]) {
#pragma unroll
  for (int lk = 1; lk <= 4; ++lk)
#pragma unroll
    for (int lj = lk - 1; lj >= 0; --lj)
#pragma unroll
      for (int i = 0; i < 16; ++i) {
        const int k = 1 << lk, j = 1 << lj, l = i ^ j;
        if (l > i) {
          const unsigned lo = umin_(a[OFF + i], a[OFF + l]), hi = umax_(a[OFF + i], a[OFF + l]);
          const bool desc = (i & k) == 0;
          a[OFF + i] = desc ? hi : lo; a[OFF + l] = desc ? lo : hi;
        }
      }
}
DI void merge16_desc(unsigned (&a)[16]) {
#pragma unroll
  for (int lj = 3; lj >= 0; --lj)
#pragma unroll
    for (int i = 0; i < 16; ++i) {
      const int j = 1 << lj, l = i ^ j;
      if (l > i) { const unsigned lo = umin_(a[i], a[l]), hi = umax_(a[i], a[l]); a[i] = hi; a[l] = lo; }
    }
}
DI void top16_of_64(unsigned (&a)[64], unsigned (&out)[16]) {
  sort16_desc<0>(a); sort16_desc<16>(a); sort16_desc<32>(a); sort16_desc<48>(a);
  unsigned x[16], y[16];
#pragma unroll
  for (int i = 0; i < 16; ++i) { x[i] = umax_(a[i], a[31 - i]); y[i] = umax_(a[32 + i], a[63 - i]); }
  merge16_desc(x); merge16_desc(y);
#pragma unroll
  for (int i = 0; i < 16; ++i) out[i] = umax_(x[i], y[15 - i]);
  merge16_desc(out);
}
__device__ constexpr int COFF[16] = {0, 16, 24, 29, 33, 36, 38, 40, 42, 43, 44, 45, 46, 47, 48, 49};
DI unsigned umax3(unsigned a, unsigned b, unsigned c) { const unsigned m = a > b ? a : b; return m > c ? m : c; }

DI void unit_peer_route(const P& p, int u, int un, char* smem) {
  int mt, hd; unit8_map(u, mt, hd);
  const int m0 = mt * 128;
  const int t = threadIdx.x + opaque0(), lane = t & 63, w = t >> 6, r = lane & 31, h = lane >> 5;
  unsigned char* myidx = (unsigned char*)smem + 2 * GBUF + t * 32;
  unsigned top[2][16];
#pragma unroll
  for (int pp = 0; pp < 2; ++pp) {
    f32x16 acc[4];
    gemm_main(w_Wt_q(p), w_H(p), 1024, 1024, hd * 256 + pp * 128, m0, smem, acc);
    if (pp == 0) gemm_first(w_Wt_q(p), w_H(p), 1024, hd * 256 + 128, m0, smem);
    else if (un >= 0) { int mn, hn; unit8_map(un, mn, hn); gemm_first(w_Wt_q(p), w_H(p), 1024, hn * 256, mn * 128, smem); }
    f32x16 sc[4] = {zero16(), zero16(), zero16(), zero16()};
    {
      const bf16* skb = w_SK(p) + (size_t)(hd * 2 + pp) * 128 * 128;
      const int wu = __builtin_amdgcn_readfirstlane(w);
#pragma unroll
      for (int q = 0; q < 8; ++q) {
        const int j = wu + 4 * q, row = 4 * j + (lane >> 4);
        glds16(skb + (size_t)row * 128 + (((lane & 15) ^ (row & 15)) * 8), smem + GBUF + 1024 * j);
      }
      asm volatile("s_waitcnt vmcnt(0)" ::: "memory");
      __syncthreads();
    }
    bf16x8 bqs[8];
#pragma unroll
    for (int i = 0; i < 4; ++i)
#pragma unroll
      for (int s = 0; s < 2; ++s) bqs[2 * i + s] = pack_step(acc[i], s);
#pragma unroll
    for (int i = 0; i < 4; ++i)
#pragma unroll
      for (int s = 0; s < 2; ++s) {
        const bf16x8 bq = bqs[2 * i + s];
#pragma unroll
        for (int kt = 0; kt < 4; ++kt) {
          const int row = 32 * kt + r, cc = 4 * i + 2 * s;
          const char* rp = smem + GBUF + row * 256 + 8 * h;
          const bf16x8 a = cat4(*(const bf16x4*)(rp + ((cc ^ (row & 15)) * 16)), *(const bf16x4*)(rp + (((cc + 1) ^ (row & 15)) * 16)));
          sc[kt] = MFMA(a, bq, sc[kt]);
        }
      }
    unsigned pk[64];
#pragma unroll
    for (int kt = 0; kt < 4; ++kt)
#pragma unroll
      for (int j = 0; j < 16; ++j) { const int key = 32 * kt + crow(j, h); pk[kt * 16 + j] = (f2ord(sc[kt][j]) & ~127u) | (unsigned)(127 - key); }
    unsigned mine[16];
    top16_of_64(pk, mine);
#pragma unroll
    for (int i = 0; i < 16; ++i) top[pp][i] = (unsigned)__shfl_xor((int)mine[15 - i], 32);
#pragma unroll
    for (int i = 0; i < 16; ++i) top[pp][i] = umax_(top[pp][i], mine[i]);
    merge16_desc(top[pp]);
  }
  float v0[16], v1[16];
#pragma unroll
  for (int a = 0; a < 16; ++a) {
    v0[a] = ord2f(top[0][a] & ~127u); v1[a] = ord2f(top[1][a] & ~127u);
    myidx[a] = (unsigned char)(127u - (top[0][a] & 127u)); myidx[16 + a] = (unsigned char)(127u - (top[1][a] & 127u));
  }
  unsigned cand[64];
#pragma unroll
  for (int i = 50; i < 64; ++i) cand[i] = 0u;
#pragma unroll
  for (int a = 0; a < 16; ++a)
#pragma unroll
    for (int bb = 0; bb < 16 / (a + 1); ++bb)
      cand[COFF[a] + bb] = (f2ord(v0[a] + v1[bb]) & ~255u) | (unsigned)(255 - (a * 16 + bb));
  unsigned best[16];
  top16_of_64(cand, best);
  const float smax = ord2f(best[0] & ~255u);
  float e[16], esum = 0.f;
#pragma unroll
  for (int i = 0; i < 16; ++i) { e[i] = __expf(ord2f(best[i] & ~255u) - smax); esum += e[i]; }
  const float einv = 1.f / esum;
  const size_t token = (size_t)m0 + 32 * w + r;
  int* ip = w_IDX(p) + token * 128 + hd * 16 + 8 * h;
  float* gp = w_GATE(p) + token * 128 + hd * 16 + 8 * h;
  const unsigned hmask = 0u - (unsigned)h;
#pragma unroll
  for (int i = 0; i < 8; ++i) {
    const unsigned bsel = best[i] ^ ((best[i] ^ best[8 + i]) & hmask);
    const float esel = __uint_as_float(__float_as_uint(e[i]) ^ ((__float_as_uint(e[i]) ^ __float_as_uint(e[8 + i])) & hmask));
    const unsigned code = 255u - (bsel & 255u);
    const int a = code >> 4, bb = code & 15;
    ip[i] = (int)myidx[a] * 128 + (int)myidx[16 + bb];
    gp[i] = esel * einv;
  }
}

DI float gelu_fast(float v) {
  const float av = fabsf(v), tt = __builtin_amdgcn_rcpf(av * 0.2316418882f + 1.0f);
  float q = tt * 0.5307027145f - 0.7265760135f; q = q * tt + 0.7107068705f; q = q * tt - 0.142248368f; q = q * tt + 0.127414796f; q = q * tt;
  const float e = __builtin_amdgcn_exp2f(v * v * -0.72134752044f);
  const float m = v * (q * e);
  return v < 0.f ? m : v - m;
}
DI float dot2bf(unsigned a, unsigned b, float acc) { return __builtin_amdgcn_fdot2_f32_bf16(__builtin_bit_cast(bf16x2, a), __builtin_bit_cast(bf16x2, b), acc, false); }
DI unsigned pkbf(f32x2 v) { bf16x2 r; r[0] = (bf16)v[0]; r[1] = (bf16)v[1]; return __builtin_bit_cast(unsigned, r); }
DI int dot16i(u32x4 u8, u32x4 x8, int d) {
#pragma unroll
  for (int m = 0; m < 4; ++m) d = __builtin_amdgcn_sdot4((int)u8[m], (int)x8[m], d, false);
  return d;
}
DI void axpy16p(f32x2* o, u32x4 v8, f32x2 c2) {
#pragma unroll
  for (int m = 0; m < 4; ++m) {
    const int wd = (int)v8[m];
    o[2 * m] = __builtin_elementwise_fma(c2, __builtin_amdgcn_cvt_pk_f32_fp8(wd, false), o[2 * m]);
    o[2 * m + 1] = __builtin_elementwise_fma(c2, __builtin_amdgcn_cvt_pk_f32_fp8(wd, true), o[2 * m + 1]);
  }
}
DI int dpp_add16i(int v) {
  v += __builtin_amdgcn_update_dpp(0, v, 0x140, 0xf, 0xf, true);
  v += __builtin_amdgcn_update_dpp(0, v, 0x141, 0xf, 0xf, true);
  v += __builtin_amdgcn_update_dpp(0, v, 0x4e, 0xf, 0xf, true);
  v += __builtin_amdgcn_update_dpp(0, v, 0xb1, 0xf, 0xf, true);
  return v;
}
DI float dot16(u32x4 u8, u32x4 xlo, u32x4 xhi, float d) {
#pragma unroll
  for (int m = 0; m < 4; ++m) {
    const int wd = (int)u8[m];
    const unsigned p01 = pkbf(__builtin_amdgcn_cvt_pk_f32_fp8(wd, false)), p23 = pkbf(__builtin_amdgcn_cvt_pk_f32_fp8(wd, true));
    const unsigned x01 = m < 2 ? xlo[2 * m] : xhi[2 * m - 4], x23 = m < 2 ? xlo[2 * m + 1] : xhi[2 * m - 3];
    d = dot2bf(p01, x01, d); d = dot2bf(p23, x23, d);
  }
  return d;
}
DI void axpy16(float* o, u32x4 v8, float c) {
#pragma unroll
  for (int m = 0; m < 4; ++m) {
    const int wd = (int)v8[m];
    const f32x2 a = __builtin_amdgcn_cvt_pk_f32_fp8(wd, false), b = __builtin_amdgcn_cvt_pk_f32_fp8(wd, true);
    o[4 * m] += c * a[0]; o[4 * m + 1] += c * a[1]; o[4 * m + 2] += c * b[0]; o[4 * m + 3] += c * b[1];
  }
}
DI float reduce4(const float (&d)[4], int lane) {
  const int h = lane >> 5, b4 = (lane >> 4) & 1;
  float a0 = h ? d[2] : d[0], a1 = h ? d[3] : d[1];
  const float s0 = h ? d[0] : d[2], s1 = h ? d[1] : d[3];
  a0 += __shfl_xor(s0, 32); a1 += __shfl_xor(s1, 32);
  float k = b4 ? a1 : a0;
  const float s = b4 ? a0 : a1;
  k += __shfl_xor(s, 16);
  k += __shfl_xor(k, 8); k += __shfl_xor(k, 4); k += __shfl_xor(k, 2); k += __shfl_xor(k, 1);
  return k;
}
DI float dpp_add16(float v) {
  v += __int_as_float(__builtin_amdgcn_update_dpp(0, __float_as_int(v), 0x140, 0xf, 0xf, true));
  v += __int_as_float(__builtin_amdgcn_update_dpp(0, __float_as_int(v), 0x141, 0xf, 0xf, true));
  v += __int_as_float(__builtin_amdgcn_update_dpp(0, __float_as_int(v), 0x4e, 0xf, 0xf, true));
  v += __int_as_float(__builtin_amdgcn_update_dpp(0, __float_as_int(v), 0xb1, 0xf, 0xf, true));
  return v;
}
constexpr int PEER_GLDS = 512 + 128 * 16;
constexpr int PEER_WLDS = 4 * PEER_GLDS;
template <int PART>
DI void peer_wave4(const P& p, int g, char* wl) {
  const int lane = (threadIdx.x + opaque0()) & 63, q = lane >> 4, j16 = lane & 15;
  unsigned* hist = (unsigned*)(wl + q * PEER_GLDS);
  u32x4* list = (u32x4*)(wl + q * PEER_GLDS + 512);
  const int token = 4 * g + q;
  if constexpr (PART != 2) {
  u32x4 x[4];
  {
    const unsigned char* hrow = w_H8(p) + (size_t)token * DM + 16 * j16;
#pragma unroll
    for (int i = 0; i < 4; ++i) x[i] = *(const u32x4*)(hrow + 256 * i);
  }
  const float xs = w_HS(p)[token];
  {
    int ids[8]; float gts[8], su[8];
#pragma unroll
    for (int i = 0; i < 8; ++i) { const size_t o = (size_t)token * 128 + j16 + 16 * i; ids[i] = w_IDX(p)[o]; gts[i] = w_GATE(p)[o]; }
#pragma unroll
    for (int i = 0; i < 8; ++i) { su[i] = w_SU(p)[ids[i]] * xs; gts[i] *= w_SV(p)[ids[i]]; }
    LDS_WAIT();
    *(u32x4*)(hist + 8 * j16) = (u32x4){0u, 0u, 0u, 0u}; *(u32x4*)(hist + 8 * j16 + 4) = (u32x4){0u, 0u, 0u, 0u};
    LDS_WAIT();
#pragma unroll
    for (int i = 0; i < 8; ++i) (void)__hip_atomic_fetch_add(&hist[ids[i] >> 7], 1u, __ATOMIC_RELAXED, __HIP_MEMORY_SCOPE_WAVEFRONT);
    LDS_WAIT();
    const u32x4 ca = *(const u32x4*)(hist + 8 * j16), cb = *(const u32x4*)(hist + 8 * j16 + 4);
    const unsigned tot = ca[0] + ca[1] + ca[2] + ca[3] + cb[0] + cb[1] + cb[2] + cb[3];
    unsigned scan = tot;
#pragma unroll
    for (int o = 1; o < 16; o <<= 1) { const unsigned tv = (unsigned)__shfl_up((int)scan, o, 16); if (j16 >= o) scan += tv; }
    unsigned e0 = scan - tot;
    u32x4 pa, pb;
    pa[0] = e0; e0 += ca[0]; pa[1] = e0; e0 += ca[1]; pa[2] = e0; e0 += ca[2]; pa[3] = e0; e0 += ca[3];
    pb[0] = e0; e0 += cb[0]; pb[1] = e0; e0 += cb[1]; pb[2] = e0; e0 += cb[2]; pb[3] = e0;
    LDS_WAIT();
    *(u32x4*)(hist + 8 * j16) = pa; *(u32x4*)(hist + 8 * j16 + 4) = pb;
    LDS_WAIT();
#pragma unroll
    for (int i = 0; i < 8; ++i) {
      const unsigned pos = __hip_atomic_fetch_add(&hist[ids[i] >> 7], 1u, __ATOMIC_RELAXED, __HIP_MEMORY_SCOPE_WAVEFRONT);
      list[pos] = (u32x4){(unsigned)ids[i], __float_as_uint(su[i]), __float_as_uint(gts[i]), 0u};
    }
    LDS_WAIT();
  }
  const unsigned char* Ub = w_Ub(p) + 16 * j16;
  {
    u32x4 uA[4], uB[4];
    u32x4 eA = list[0], eB = list[1];
#pragma unroll
    for (int i = 0; i < 4; ++i) uA[i] = *(const u32x4*)(Ub + (size_t)eA[0] * DM + 256 * i);
#pragma unroll
    for (int i = 0; i < 4; ++i) uB[i] = *(const u32x4*)(Ub + (size_t)eB[0] * DM + 256 * i);
#define PEER_USTEP(U, E, K)                                                                                            \
    {                                                                                                                  \
      const float su = __uint_as_float(E[1]), gsv = __uint_as_float(E[2]);                                             \
      int d0 = 0, d1 = 0;                                                                                              \
      d0 = dot16i(U[0], x[0], d0); d1 = dot16i(U[1], x[1], d1); d0 = dot16i(U[2], x[2], d0); d1 = dot16i(U[3], x[3], d1); \
      E = list[(K) + 2 < 128 ? (K) + 2 : 127];                       \
      _Pragma("unroll") for (int i = 0; i < 4; ++i) U[i] = *(const u32x4*)(Ub + (size_t)E[0] * DM + 256 * i);          \
      const float c = gsv * gelu_fast(su * (float)dpp_add16i(d0 + d1));                                                \
      if (j16 == 0) ((float*)&list[K])[3] = c;                                                                          \
    }
#pragma unroll 1
    for (int k = 0; k < 128; k += 2) {
      PEER_USTEP(uA, eA, k)
      PEER_USTEP(uB, eB, k + 1)
    }
  }
  }
  if constexpr (PART != 1) {
  LDS_WAIT();
  const unsigned char* Vb = w_Vb(p) + 16 * j16;
  f32x2 acc[32];
#pragma unroll
  for (int i = 0; i < 32; ++i) acc[i] = (f32x2){0.f, 0.f};
  {
    u32x4 vA[4], vB[4];
    u32x4 eA = list[0], eB = list[1];
#pragma unroll
    for (int i = 0; i < 4; ++i) vA[i] = *(const u32x4*)(Vb + (size_t)eA[0] * DM + 256 * i);
#pragma unroll
    for (int i = 0; i < 4; ++i) vB[i] = *(const u32x4*)(Vb + (size_t)eB[0] * DM + 256 * i);
#define PEER_VSTEP(V, E, K)                                                                                            \
    {                                                                                                                  \
      const float c = __uint_as_float(E[3]);                                                                           \
      const f32x2 c2 = {c, c};                                                                                         \
      _Pragma("unroll") for (int i = 0; i < 4; ++i) axpy16p(acc + 8 * i, V[i], c2);                                    \
      E = list[(K) + 2 < 128 ? (K) + 2 : 127];                                                                         \
      _Pragma("unroll") for (int i = 0; i < 4; ++i) V[i] = *(const u32x4*)(Vb + (size_t)E[0] * DM + 256 * i);          \
    }
#pragma unroll 1
    for (int k = 0; k < 128; k += 2) {
      PEER_VSTEP(vA, eA, k)
      PEER_VSTEP(vB, eB, k + 1)
    }
  }
  const float* x1 = w_X1(p) + (size_t)token * DM + 16 * j16;
  const float* g2 = w_MOD(p) + (size_t)cond_row(token) * 6144 + 5120 + 16 * j16;
  float* y = p.out + O_YP + (size_t)token * DM + 16 * j16;
#pragma unroll
  for (int i = 0; i < 4; ++i)
#pragma unroll
    for (int mm = 0; mm < 4; ++mm) {
      const int c0 = 256 * i + 4 * mm;
      const f32x4 xv = *(const f32x4*)(x1 + c0), gv = *(const f32x4*)(g2 + c0);
      f32x4 yv;
#pragma unroll
      for (int j = 0; j < 4; ++j) yv[j] = xv[j] + gv[j] * acc[8 * i + 2 * mm + (j >> 1)][j & 1];
      *(f32x4*)(y + c0) = yv;
    }
  }
}
DI void peer_token_block(const P& p, int token, char* smem) {
  const int t = threadIdx.x + opaque0(), lane = t & 63, w = t >> 6;
  float* red = (float*)smem;
  const u32x4 x8 = *(const u32x4*)(w_H8(p) + (size_t)token * DM + 16 * lane);
  const int myid = w_IDX(p)[(size_t)token * 128 + 32 * w + (lane & 31)];
  const float mysu = w_SU(p)[myid] * w_HS(p)[token];
  const float mygs = w_GATE(p)[(size_t)token * 128 + 32 * w + (lane & 31)] * w_SV(p)[myid];
  float o[16];
#pragma unroll
  for (int i = 0; i < 16; ++i) o[i] = 0.f;
#pragma unroll 1
  for (int e0 = 0; e0 < 32; e0 += 8) {
    u32x4 u8[8], v8[8];
#pragma unroll
    for (int qq = 0; qq < 8; ++qq) {
      const size_t ro = (size_t)__builtin_amdgcn_readlane(myid, e0 + qq) * DM + 16 * lane;
      u8[qq] = *(const u32x4*)(w_Ub(p) + ro); v8[qq] = *(const u32x4*)(w_Vb(p) + ro);
    }
#pragma unroll
    for (int hb = 0; hb < 2; ++hb) {
      float d[4];
#pragma unroll
      for (int qq = 0; qq < 4; ++qq) d[qq] = (float)dot16i(u8[4 * hb + qq], x8, 0);
      const float kv = reduce4(d, lane);
#pragma unroll
      for (int qq = 0; qq < 4; ++qq) {
        const int e = e0 + 4 * hb + qq;
        const float a = __int_as_float(__builtin_amdgcn_readlane(__float_as_int(kv), 16 * qq)) * __int_as_float(__builtin_amdgcn_readlane(__float_as_int(mysu), e));
        const float c = __int_as_float(__builtin_amdgcn_readlane(__float_as_int(mygs), e)) * gelu_fast(a);
        axpy16(o, v8[4 * hb + qq], c);
      }
    }
  }
  __syncthreads();
#pragma unroll
  for (int i = 0; i < 16; ++i) red[w * 1024 + 16 * lane + i] = o[i];
  __syncthreads();
  if (w == 0) {
    const float* x1 = w_X1(p) + (size_t)token * DM + 16 * lane;
    const float* g2 = w_MOD(p) + (size_t)cond_row(token) * 6144 + 5120 + 16 * lane;
    float* y = p.out + O_YP + (size_t)token * DM + 16 * lane;
#pragma unroll
    for (int mm = 0; mm < 4; ++mm) {
      const f32x4 xv = *(const f32x4*)(x1 + 4 * mm), gv = *(const f32x4*)(g2 + 4 * mm);
      f32x4 yv;
#pragma unroll
      for (int j = 0; j < 4; ++j) { const int c = 16 * lane + 4 * mm + j; yv[j] = xv[j] + gv[j] * (red[c] + red[1024 + c] + red[2048 + c] + red[3072 + c]); }
      *(f32x4*)(y + 4 * mm) = yv;
    }
  }
}

constexpr int NPHASE = 8;

#if defined(PROBE_ATTN) || defined(PROBE_SAMP)
DI int probe_token(int i) { return (i * 131 + 3) % NPR; }
DI float block_sum_p(float v, float* red) {
  __syncthreads();
  v = wave_sum(v);
  if ((threadIdx.x & 63) == 0) red[threadIdx.x >> 6] = v;
  __syncthreads();
  return red[0] + red[1] + red[2] + red[3];
}
DI float block_max_p(float v, float* red) {
  __syncthreads();
  for (int o = 32; o >= 1; o >>= 1) v = fmaxf(v, __shfl_xor(v, o));
  if ((threadIdx.x & 63) == 0) red[threadIdx.x >> 6] = v;
  __syncthreads();
  return fmaxf(fmaxf(red[0], red[1]), fmaxf(red[2], red[3]));
}
#endif
#ifdef PROBE_ATTN
DI void probe_attn(const P& p, int i, char* smem) {
  float* red = (float*)smem;
  float* pr = red + 4;
  float* attn = pr + 128;
  float* rr = attn + 1024;
  const int token = probe_token(i), b = token >> 11, pos = token & 2047, t = threadIdx.x;
  const bf16* prow = w_PROJ(p) + (size_t)token * INW;
  for (int head = 0; head < 16; ++head) {
    const int hk = head >> 3;
    float s = -INFINITY;
    const int kp = pos - 127 + (t & 127);
    if (t < 128 && kp >= 0) {
      float a = 0.f;
      const bf16* kr = w_PROJ(p) + ((size_t)b * SEQ + kp) * INW + C_K + hk * 64;
      for (int d = 0; d < 64; ++d) a += bf2f(prow[head * 64 + d]) * bf2f(kr[d]);
      s = a + w_BIAS(p)[head * 128 + (pos - kp)];
    }
    float m = block_max_p(s, red);
    m = fmaxf(m, p.sinks[head]);
    const float e = (t < 128 && kp >= 0) ? __expf(s - m) : 0.f;
    const float den = block_sum_p(e, red) + __expf(p.sinks[head] - m);
    if (t < 128) pr[t] = e / den;
    __syncthreads();
    if (t < 64) {
      float o = 0.f;
      for (int j = 0; j < 128; ++j) { const int kq = pos - 127 + j; if (kq >= 0) o += pr[j] * bf2f(w_VT(p)[((size_t)(b * 2 + hk) * 64 + t) * SEQ + kq]); }
      attn[head * 64 + t] = o;
    }
    __syncthreads();
  }
  for (int c = t; c < 512; c += 256) {
    const int g = c >> 7, win = 2 << g;
    float tot = 0.f;
    for (int j = 0; j < win; ++j) if (pos - j >= 0) tot += bf2f(w_PROJ(p)[((size_t)b * SEQ + pos - j) * INW + C_PIN + c]);
    const float cnt = (float)(win < pos + 1 ? win : pos + 1);
    rr[c] = bf2f((bf16)(tot / cnt - bf2f(prow[C_PIN + c])));
  }
  __syncthreads();
  for (int f = t; f < 1024; f += 256) {
    const int g = f >> 8;
    float pl = 0.f;
    for (int ch = 0; ch < 128; ++ch) pl += rr[g * 128 + ch] * bf2f(w_PWt(p)[((size_t)g * 256 + (f & 255)) * 128 + ch]);
    const float naive = bf2f(prow[C_GA + f]) * attn[f] + bf2f(prow[C_GB + f]) * (pl * p.pool_scale[f]);
    const float fast = bf2f(w_MIXED(p)[(size_t)token * DM + f]);
    p.out[O_KWP + (size_t)i * DM + f] += (float)(PROBE_ATTN) * (fast - naive);
  }
  __syncthreads();
}
#endif

#ifdef PROBE_SAMP
DI void probe_samp(const P& p, int b, char* smem) {
  float* red = (float*)smem;
  float* pr = red + 4;
  float* attn = pr + 128;
  float* rr = attn + 1024;
  const int t = threadIdx.x;
  const size_t token = (size_t)NPR + b;
  const bf16* prow = w_PROJ(p) + token * INW;
  for (int head = 0; head < 16; ++head) {
    const int hk = head >> 3;
    float s = -INFINITY;
    if (t < 128) {
      const float* kr = t < 127 ? p.cache_k + (((size_t)b * 128 + t + 1) * 2 + hk) * 64 : p.out + O_KWS + (((size_t)b * 128 + 127) * 2 + hk) * 64;
      float a = 0.f;
      for (int d = 0; d < 64; ++d) a += bf2f(prow[head * 64 + d]) * kr[d];
      s = a + p.rel_table[(127 - t < 16 ? 127 - t : min(31, 16 + (int)(logf((float)(127 - t) / 16.f) / logf(8.f) * 16.f))) * 16 + head];
    }
    float m = block_max_p(s, red);
    m = fmaxf(m, p.sinks[head]);
    const float e = t < 128 ? __expf(s - m) : 0.f;
    const float den = block_sum_p(e, red) + __expf(p.sinks[head] - m);
    if (t < 128) pr[t] = e / den;
    __syncthreads();
    if (t < 64) {
      float o = 0.f;
      for (int j = 0; j < 128; ++j) { const float* vr = j < 127 ? p.cache_v + (((size_t)b * 128 + j + 1) * 2 + hk) * 64 : p.out + O_VWS + (((size_t)b * 128 + 127) * 2 + hk) * 64; o += pr[j] * vr[t]; }
      attn[head * 64 + t] = o;
    }
    __syncthreads();
  }
  for (int c = t; c < 512; c += 256) {
    const int g = c >> 7, win = 2 << g;
    const float cur = p.out[O_PS + ((size_t)b * 15 + 14) * 512 + c];
    float tot = cur;
    for (int j = 1; j < win; ++j) tot += p.state_pool[((size_t)b * 15 + 15 - j) * 512 + c];
    rr[c] = tot / (float)win - cur;
  }
  __syncthreads();
  for (int f = t; f < 1024; f += 256) {
    const int g = f >> 8;
    float pl = 0.f;
    for (int ch = 0; ch < 128; ++ch) pl += rr[g * 128 + ch] * p.pool_w[((size_t)g * 128 + ch) * 256 + (f & 255)];
    const float naive = bf2f(prow[C_GA + f]) * attn[f] + bf2f(prow[C_GB + f]) * (pl * p.pool_scale[f]);
    const float fast = bf2f(w_MIXED(p)[token * DM + f]);
    p.out[O_KWP + (size_t)b * DM + f] += (float)(PROBE_SAMP) * (fast - naive);
  }
  __syncthreads();
}
#endif
template <class First, class Main, class Fill> DI void run_with_filler(int G, int bid, int nmain, int nfill, First firstf, Main mainf, Fill fillf) {
  if (bid < nmain) { __syncthreads(); firstf(bid); }
  for (int u = bid; u < nmain; u += G) mainf(u, u + G < nmain ? u + G : -1);
  const int rem = nmain % G;
  if (rem == 0) { for (int f = bid; f < nfill; f += G) fillf(f); }
  else if (bid >= rem) { for (int f = bid - rem; f < nfill; f += G - rem) fillf(f); }
}
template <int PH> DI void run_phase(const P& p, char* smem) {
  const int G = gridDim.x, bid = blockIdx.x, w = __builtin_amdgcn_readfirstlane(threadIdx.x >> 6);
  if constexpr (PH == 0) { run_with_filler(G, bid, U0_MOD, F0_TOTAL, [&](int) {}, [&](int u, int) { unit_mod(p, u, smem); }, [&](int f) { phase0_filler(p, f, smem); }); }
  if constexpr (PH == 1) { for (int tk = bid * 4 + w; tk < NTOK; tk += G * 4) norm_row(p, tk, 0); }
  if constexpr (PH == 2) {
    run_with_filler(G, bid, 129 * 30, F2_TOTAL, [&](int u) { int mt, nt; gemm1_map(u, mt, nt); gemm_first(w_Wt_in(p), w_H(p), 1024, nt * 128, mt * 128, smem); },
                    [&](int u, int un) { unit_gemm1(p, u, un, smem); }, [&](int f) { phase2_filler(p, f, smem); });
  }
  if constexpr (PH == 3) { for (int u = bid; u < 1024; u += G) unit_attn_prompt(p, u, smem);
                           for (int u = bid; u < 512; u += G) unit_attn_sample(p, u, smem); }
  if constexpr (PH == 4) {
    run_with_filler(G, bid, G2_UNITS, F4_TOTAL, [&](int u) { gemm2_first(p, u, smem); },
                    [&](int u, int un) { unit_gemm2(p, u, un, smem); }, [&](int f) { unit_convert(p.sub_keys, w_SK(p), f); });
  }
  if constexpr (PH == 5) { for (int tk = bid * 4 + w; tk < NTOK; tk += G * 4) norm_row(p, tk, 1); }
  if constexpr (PH == 6) {
    run_with_filler(G, bid, 129 * 8, F6_TOTAL, [&](int u) { int mt, hd; unit8_map(u, mt, hd); gemm_first(w_Wt_q(p), w_H(p), 1024, hd * 256, mt * 128, smem); },
                    [&](int u, int un) { unit_peer_route(p, u, un, smem); }, [&](int f) { if (f < F6_QU) unit_quant_rows<true>(p.peer_u, w_Ub(p), w_SU(p), f); else unit_quant_rows<false>(p.peer_v, w_Vb(p), w_SV(p), f - F6_QU); });
  }
  if constexpr (PH == 7) {
    for (int g = bid * 4 + w; g < NPR / 4; g += G * 4) peer_wave4<0>(p, g, smem + w * PEER_WLDS);
    for (int s = bid; s < NS; s += G) peer_token_block(p, NPR + s, smem + 4 * PEER_WLDS);
  }
}
#if ONE_LAUNCH
__global__ void __launch_bounds__(NTHREADS, 2) mega(P p) {
  __shared__ __attribute__((aligned(16))) char smem[SMEM_BYTES + 16];
  volatile unsigned* st = (volatile unsigned*)(smem + SMEM_BYTES);
  if (threadIdx.x == 0) { st[0] = 0u; st[1] = 0u; }
  __syncthreads();
  const unsigned xcc = xb_xcc_id();
  if (threadIdx.x == 0) (void)xb_add(&w_bar(p)[XB_XCNT(xcc)], 1u);
#ifndef REPEAT_MASK
#define REPEAT_MASK 0
#endif
#define RUN_PH(k) do { run_phase<k>(p, smem); if ((REPEAT_MASK >> k) & 1) { xcd_barrier(w_bar(p), xcc, st); run_phase<k>(p, smem); } } while (0)
  RUN_PH(0); xcd_barrier(w_bar(p), xcc, st);
  RUN_PH(1); xcd_barrier(w_bar(p), xcc, st);
  RUN_PH(2); xcd_barrier(w_bar(p), xcc, st);
  RUN_PH(3); xcd_barrier(w_bar(p), xcc, st);
#ifdef PROBE_ATTN
  for (int i = blockIdx.x; i < 128; i += gridDim.x) probe_attn(p, i, smem);
  xcd_barrier(w_bar(p), xcc, st);
#endif
#ifdef PROBE_SAMP
  for (int i = blockIdx.x; i < 128; i += gridDim.x) probe_samp(p, i, smem);
  xcd_barrier(w_bar(p), xcc, st);
#endif
  RUN_PH(4); xcd_barrier(w_bar(p), xcc, st);
  RUN_PH(5); xcd_barrier(w_bar(p), xcc, st);
  RUN_PH(6); xcd_barrier(w_bar(p), xcc, st);
#if PEER_ALIGN
  { const int G = gridDim.x, bid = blockIdx.x, w = __builtin_amdgcn_readfirstlane(threadIdx.x >> 6);
    for (int g = bid * 4 + w, it = 0; it < (NPR / 4 + G * 4 - 1) / (G * 4); g += G * 4, ++it) {
      if (it > 0) xcd_barrier(w_bar(p), xcc, st);
      if (g < NPR / 4) peer_wave4<1>(p, g, smem + w * PEER_WLDS);
#if PEER_ALIGN > 1
      xcd_barrier(w_bar(p), xcc, st);
#endif
      if (g < NPR / 4) peer_wave4<2>(p, g, smem + w * PEER_WLDS);
    }
    for (int s = bid; s < NS; s += G) peer_token_block(p, NPR + s, smem + 4 * PEER_WLDS); }
#else
  RUN_PH(7);
#endif
}
#else
template <int PH> __global__ void __launch_bounds__(NTHREADS, 2) mega(P p) {
  __shared__ __attribute__((aligned(16))) char smem[SMEM_BYTES];
  run_phase<PH>(p, smem);
}
#endif


extern "C" void kernel_launch(void* const* d_in, const int* in_sizes, int n_in, void* d_out, int out_size, void* d_ws, size_t ws_size, hipStream_t stream) {
  P p{};
  const float* const* in = (const float* const*)d_in;
  p.x_prompt = in[0]; p.x_sample = in[1]; p.cache_k = in[2]; p.cache_v = in[3]; p.state_pool = in[4]; p.c_prompt = in[5]; p.c_sample = in[6];
  p.rel_table = in[7]; p.ada_w = in[8]; p.ada_b = in[9]; p.norm1_g = in[10]; p.w_in = in[11]; p.q_norm_g = in[12]; p.k_norm_g = in[13]; p.sinks = in[14];
  p.pool_w = in[15]; p.pool_scale = in[16]; p.w_out = in[17]; p.norm2_g = in[18]; p.w_query = in[19]; p.sub_keys = in[20]; p.peer_u = in[21]; p.peer_v = in[22];
  p.out = (float*)d_out;
  p.ws = (char*)d_ws;
  if (WS_NEED > ws_size) { fprintf(stderr, "workspace too small: need %zu have %zu\n", (size_t)WS_NEED, ws_size); return; }

  static int grid_blocks = 0;
  if (!grid_blocks) {
    int dev = 0, cus = 0, per_cu = 0;
    (void)hipGetDevice(&dev);
    (void)hipDeviceGetAttribute(&cus, hipDeviceAttributeMultiprocessorCount, dev);
#if ONE_LAUNCH
    (void)hipOccupancyMaxActiveBlocksPerMultiprocessor(&per_cu, mega, NTHREADS, 0);
#else
    per_cu = 2;
#endif
    if (per_cu > 2) per_cu = 2;
    if (per_cu < 1) per_cu = 1;
    if (cus < 1) cus = 256;
    grid_blocks = cus * per_cu;
  }
#if ONE_LAUNCH
  (void)hipMemsetAsync(p.ws + OFF_BAR, 0, XCD_BAR_WORDS * 4, stream);
  hipLaunchKernelGGL(mega, dim3(grid_blocks), dim3(NTHREADS), 0, stream, p);
#else
  hipLaunchKernelGGL(mega<0>, dim3(grid_blocks), dim3(NTHREADS), 0, stream, p);
  hipLaunchKernelGGL(mega<1>, dim3(grid_blocks), dim3(NTHREADS), 0, stream, p);
  hipLaunchKernelGGL(mega<2>, dim3(grid_blocks), dim3(NTHREADS), 0, stream, p);
  hipLaunchKernelGGL(mega<3>, dim3(grid_blocks), dim3(NTHREADS), 0, stream, p);
  hipLaunchKernelGGL(mega<4>, dim3(grid_blocks), dim3(NTHREADS), 0, stream, p);
  hipLaunchKernelGGL(mega<5>, dim3(grid_blocks), dim3(NTHREADS), 0, stream, p);
  hipLaunchKernelGGL(mega<6>, dim3(grid_blocks), dim3(NTHREADS), 0, stream, p);
  hipLaunchKernelGGL(mega<7>, dim3(grid_blocks), dim3(NTHREADS), 0, stream, p);
#endif

}
```

```cpp
#include <hip/hip_runtime.h>
#include <stdint.h>
#include <stdio.h>

#ifndef ONE_LAUNCH
#define ONE_LAUNCH 1
#endif
#ifndef EARLY_INV
#define EARLY_INV 1
#endif
#ifndef PEER_ALIGN
#define PEER_ALIGN 1
#endif

typedef __bf16 bf16;
typedef __bf16 bf16x2 __attribute__((ext_vector_type(2)));
typedef __bf16 bf16x4 __attribute__((ext_vector_type(4)));
typedef __bf16 bf16x8 __attribute__((ext_vector_type(8)));
typedef float f32x2 __attribute__((ext_vector_type(2)));
typedef float f32x4 __attribute__((ext_vector_type(4)));
typedef float f32x16 __attribute__((ext_vector_type(16)));
typedef unsigned u32x2 __attribute__((ext_vector_type(2)));
typedef unsigned u32x4 __attribute__((ext_vector_type(4)));

#define DI __device__ __forceinline__
#define MFMA(a, b, c) __builtin_amdgcn_mfma_f32_32x32x16_bf16((a), (b), (c), 0, 0, 0)

constexpr int DM = 1024, NB = 8, SEQ = 2048, NS = 128, NPR = NB * SEQ, NTOK = NPR + NS;
constexpr int INW = 3840, NMOD = NB + NS;
constexpr int C_K = 1024, C_V = 1152, C_PIN = 1280, C_GA = 1792, C_GB = 2816;
constexpr int NEXP = 16384;
constexpr float EPS = 1e-6f;
constexpr size_t O_YP = 0, O_KWP = 16908288, O_VWP = 17039360, O_PP = 17170432, O_KWS = 17231872, O_VWS = 19329024, O_PS = 21426176;

constexpr int SMEM_BYTES = 77824;
constexpr int NTHREADS = 256;

struct P {
  const float *x_prompt, *x_sample, *cache_k, *cache_v, *state_pool, *c_prompt, *c_sample, *rel_table, *ada_w, *ada_b, *norm1_g, *w_in,
      *q_norm_g, *k_norm_g, *sinks, *pool_w, *pool_scale, *w_out, *norm2_g, *w_query, *sub_keys, *peer_u, *peer_v;
  float* out;
  char* ws;
};
constexpr size_t al256(size_t x) { return (x + 255) & ~(size_t)255; }
constexpr size_t OFF_BAR = 0;
constexpr size_t OFF_WTIN = OFF_BAR + al256(4096 * 4);
constexpr size_t OFF_WTOUT = OFF_WTIN + al256((size_t)INW * 1024 * 2);
constexpr size_t OFF_WTQ = OFF_WTOUT + al256((size_t)1024 * 1024 * 2);
constexpr size_t OFF_SK = OFF_WTQ + al256((size_t)2048 * 1024 * 2);
constexpr size_t OFF_PWT = OFF_SK + al256((size_t)16 * 128 * 128 * 2);
constexpr size_t OFF_UB = OFF_PWT + al256((size_t)4 * 256 * 128 * 2);
constexpr size_t OFF_VB = OFF_UB + al256((size_t)NEXP * DM);
constexpr size_t OFF_SU = OFF_VB + al256((size_t)NEXP * DM);
constexpr size_t OFF_SV = OFF_SU + al256((size_t)NEXP * 4);
constexpr size_t OFF_H8 = OFF_SV + al256((size_t)NEXP * 4);
constexpr size_t OFF_HS = OFF_H8 + al256((size_t)NTOK * DM);
constexpr size_t OFF_PART = OFF_HS + al256((size_t)NTOK * 4);
constexpr size_t OFF_MOD = OFF_PART + al256((size_t)4 * NS * DM * 4);
constexpr size_t OFF_BIAS = OFF_MOD + al256((size_t)NMOD * 6144 * 4);
constexpr size_t OFF_VT = OFF_BIAS + al256(16 * 128 * 4);
constexpr size_t OFF_H = OFF_VT + al256((size_t)NB * 128 * SEQ * 2);
constexpr size_t OFF_MIXED = OFF_H;
constexpr size_t OFF_PROJ = OFF_H + al256((size_t)NTOK * DM * 2);
constexpr size_t OFF_X1 = OFF_PROJ;
constexpr size_t OFF_IDX = OFF_X1 + (size_t)NTOK * DM * 4;
constexpr size_t OFF_GATE = OFF_IDX + (size_t)NTOK * 128 * 4;
constexpr size_t WS_NEED = OFF_PROJ + al256((size_t)NTOK * INW * 2);
static_assert(OFF_GATE + (size_t)NTOK * 128 * 4 <= WS_NEED, "overlay fits");
static_assert(WS_NEED <= (size_t)256 * 1024 * 1024, "workspace budget");
#define WS_PTR(T, name, OFF) __device__ __forceinline__ T* name(const P& p) { return (T*)(p.ws + (OFF)); }
WS_PTR(unsigned, w_bar, OFF_BAR) WS_PTR(bf16, w_Wt_in, OFF_WTIN) WS_PTR(bf16, w_Wt_out, OFF_WTOUT) WS_PTR(bf16, w_Wt_q, OFF_WTQ) WS_PTR(bf16, w_SK, OFF_SK)
WS_PTR(bf16, w_PWt, OFF_PWT) WS_PTR(unsigned char, w_Ub, OFF_UB) WS_PTR(unsigned char, w_Vb, OFF_VB) WS_PTR(float, w_SU, OFF_SU) WS_PTR(float, w_SV, OFF_SV) WS_PTR(unsigned char, w_H8, OFF_H8) WS_PTR(float, w_HS, OFF_HS) WS_PTR(float, w_PART, OFF_PART) WS_PTR(float, w_MOD, OFF_MOD) WS_PTR(float, w_BIAS, OFF_BIAS)
WS_PTR(bf16, w_VT, OFF_VT) WS_PTR(bf16, w_H, OFF_H) WS_PTR(bf16, w_MIXED, OFF_MIXED) WS_PTR(bf16, w_PROJ, OFF_PROJ) WS_PTR(float, w_X1, OFF_X1)
WS_PTR(int, w_IDX, OFF_IDX) WS_PTR(float, w_GATE, OFF_GATE)

DI int cond_row(int token) { return token < NPR ? (token >> 11) : (NB + token - NPR); }
DI int crow(int reg, int h) { return (reg & 3) + 8 * (reg >> 2) + 4 * h; }
DI const float* xrow(const P& p, int token) { return token < NPR ? p.x_prompt + (size_t)token * DM : p.x_sample + (size_t)(token - NPR) * DM; }

#define LDS_WAIT() asm volatile("s_waitcnt lgkmcnt(0)" ::: "memory")
DI int opaque0() { int z = 0; asm volatile("" : "+v"(z)); return z; }
DI float bf2f(bf16 v) { return (float)v; }
DI f32x16 zero16() { f32x16 z; for (int i = 0; i < 16; ++i) z[i] = 0.f; return z; }
DI bf16x8 pack_step(const f32x16& x, int s) { bf16x8 v; for (int j = 0; j < 8; ++j) v[j] = (bf16)x[8 * s + j]; return v; }
DI bf16x8 cat4(bf16x4 lo, bf16x4 hi) { return __builtin_shufflevector(lo, hi, 0, 1, 2, 3, 4, 5, 6, 7); }
DI float wave_sum(float v) { for (int o = 32; o >= 1; o >>= 1) v += __shfl_xor(v, o); return v; }

#define XB_TMO 128
#define XB_XCNT(j) (256 + 64 * (j))
#define XB_XSUB(j) (1280 + 64 * (j))
#define XB_XGEN(j) (2304 + 64 * (j))
#define XB_TOP 3328
#define XB_TOPGEN 3392
#define XCD_BAR_WORDS 3456
#define XB_SPIN_CAP (1u << 22)
DI unsigned xb_ld(unsigned* p) { return __hip_atomic_load(p, __ATOMIC_RELAXED, __HIP_MEMORY_SCOPE_AGENT); }
DI unsigned xb_add(unsigned* p, unsigned v) { return __hip_atomic_fetch_add(p, v, __ATOMIC_RELAXED, __HIP_MEMORY_SCOPE_AGENT); }
DI unsigned xb_xcc_id() { return (unsigned)__builtin_amdgcn_s_getreg((3 << 11) | 20) & 0xFu; }
#define XB_SPIN(cond, bar) do { unsigned _sp = 0; while (cond) { __builtin_amdgcn_s_sleep(1); \
    if ((++_sp & 255u) == 0u) { if (xb_ld(&(bar)[XB_TMO])) break; if (_sp > XB_SPIN_CAP) { atomicAdd(&(bar)[XB_TMO], 1u); break; } } } } while (0)

DI void xcd_barrier_complete(unsigned* bar, unsigned x, unsigned& nloc, unsigned& nx) {
  const unsigned G = gridDim.x;
  unsigned sum, cnt, mine, sp = 0u;
  for (;;) {
    sum = 0u; cnt = 0u; mine = 0u;
#pragma unroll
    for (unsigned j = 0; j < 16; ++j) { const unsigned c = xb_ld(&bar[XB_XCNT(j)]); sum += c; cnt += (c > 0u) ? 1u : 0u; mine = (j == x) ? c : mine; }
    if (sum == G) break;
    __builtin_amdgcn_s_sleep(1);
    if ((++sp & 255u) == 0u) { if (xb_ld(&bar[XB_TMO])) break; if (sp > XB_SPIN_CAP) { atomicAdd(&bar[XB_TMO], 1u); break; } }
  }
  nloc = mine > 0u ? mine : 1u; nx = cnt > 0u ? cnt : 1u;
}
DI void xcd_barrier(unsigned* bar, unsigned x, volatile unsigned* st) {
  asm volatile("s_waitcnt vmcnt(0)" ::: "memory");
  __syncthreads();
  if (threadIdx.x == 0) {
    __builtin_amdgcn_s_waitcnt(0);
    unsigned nloc = st[0], nx = st[1];
    if (nloc == 0u) { xcd_barrier_complete(bar, x, nloc, nx); st[0] = nloc; st[1] = nx; }
    const unsigned old = xb_add(&bar[XB_XSUB(x)], 1u);
    const unsigned gen = old / nloc;
    const bool leader = old + 1u == (gen + 1u) * nloc;
    if (leader) {
      __builtin_amdgcn_fence(__ATOMIC_RELEASE, "agent");
      asm volatile("s_waitcnt vmcnt(0)" ::: "memory");
    }
    if (leader) {
      const unsigned og = xb_add(&bar[XB_TOP], 1u);
      const unsigned tg = og / nx;
      if (og + 1u == (tg + 1u) * nx) xb_add(&bar[XB_TOPGEN], 1u);
      else XB_SPIN(xb_ld(&bar[XB_TOPGEN]) == tg, bar);
      xb_add(&bar[XB_XGEN(x)], 1u);
      __builtin_amdgcn_fence(__ATOMIC_ACQUIRE, "agent");
    } else {
#if EARLY_INV
      __builtin_amdgcn_fence(__ATOMIC_ACQUIRE, "agent");
#endif
      XB_SPIN(xb_ld(&bar[XB_XGEN(x)]) == gen, bar);
#if !EARLY_INV
      __builtin_amdgcn_fence(__ATOMIC_ACQUIRE, "agent");
#endif
    }
    asm volatile("s_waitcnt vmcnt(0)" ::: "memory");
  }
  __syncthreads();
}

constexpr int U0_MOD = 192;
constexpr int U0_TIN = (1024 / 64) * (INW / 64);
constexpr int F0_TOTAL = U0_TIN + 1;
constexpr int U0_TPW = 4 * 2 * 4;
constexpr int U0_CSK = 32;
constexpr int U0_KW = 128, U0_VW = 128, U0_PW = 128;
constexpr int F2_TOUT = 16 * 16, F2_TQ = 16 * 32, F2_E1 = F2_TOUT + F2_TQ, F2_E2 = F2_E1 + U0_TPW, F2_E3 = F2_E2 + U0_KW, F2_E4 = F2_E3 + U0_VW,
              F2_TOTAL = F2_E4 + U0_PW;
constexpr int F4_TOTAL = U0_CSK;
constexpr int F6_QU = 2048, F6_QV = 2048, F6_TOTAL = F6_QU + F6_QV;

DI float silu_f(float x) { return x * __builtin_amdgcn_rcpf(1.f + __expf(-x)); }

DI void unit_mod(const P& p, int u, char* smem) {
  const int t = threadIdx.x + opaque0(), lane = t & 63, w = t >> 6, r = lane & 31, h = lane >> 5;
  const int f0 = u * 32;
  f32x16 acc[5];
#pragma unroll
  for (int i = 0; i < 5; ++i) acc[i] = zero16();
  const float* wp = p.ada_w + (size_t)(w * 256 + 8 * h) * 6144 + f0 + r;
  const float* cp[5];
#pragma unroll
  for (int i = 0; i < 5; ++i) { const int m = 32 * i + r, mm = m < NMOD ? m : 0; cp[i] = (mm < NB ? p.c_prompt + (size_t)mm * DM : p.c_sample + (size_t)(mm - NB) * DM) + w * 256 + 8 * h; }
  float wv[8]; f32x4 cv[5][2];
#pragma unroll
  for (int j = 0; j < 8; ++j) wv[j] = wp[(size_t)j * 6144];
#pragma unroll
  for (int i = 0; i < 5; ++i) { cv[i][0] = *(const f32x4*)cp[i]; cv[i][1] = *(const f32x4*)(cp[i] + 4); }
#pragma unroll 1
  for (int ks = 0; ks < 16; ++ks) {
    bf16x8 bfr, afr[5];
#pragma unroll
    for (int j = 0; j < 8; ++j) bfr[j] = (bf16)wv[j];
#pragma unroll
    for (int i = 0; i < 5; ++i) {
      const bool ok = 32 * i + r < NMOD;
#pragma unroll
      for (int j = 0; j < 8; ++j) afr[i][j] = (bf16)(ok ? silu_f(cv[i][j >> 2][j & 3]) : 0.f);
    }
    const int kn = ks + 1 < 16 ? ks + 1 : 15;
#pragma unroll
    for (int j = 0; j < 8; ++j) wv[j] = wp[(size_t)(kn * 16 + j) * 6144];
#pragma unroll
    for (int i = 0; i < 5; ++i) { cv[i][0] = *(const f32x4*)(cp[i] + kn * 16); cv[i][1] = *(const f32x4*)(cp[i] + kn * 16 + 4); }
#pragma unroll
    for (int i = 0; i < 5; ++i) acc[i] = MFMA(afr[i], bfr, acc[i]);
  }
  float* red = (float*)smem;
  __syncthreads();
  if (w > 0) {
#pragma unroll
    for (int i = 0; i < 5; ++i)
#pragma unroll
      for (int j = 0; j < 16; ++j) red[((w - 1) * 80 + i * 16 + j) * 64 + lane] = acc[i][j];
  }
  __syncthreads();
  if (w == 0) {
    const float bias = p.ada_b[f0 + r];
#pragma unroll
    for (int i = 0; i < 5; ++i)
#pragma unroll
      for (int j = 0; j < 16; ++j) {
        const int m = 32 * i + crow(j, h);
        const float v = acc[i][j] + red[(0 * 80 + i * 16 + j) * 64 + lane] + red[(1 * 80 + i * 16 + j) * 64 + lane] + red[(2 * 80 + i * 16 + j) * 64 + lane] + bias;
        if (m < NMOD) w_MOD(p)[(size_t)m * 6144 + f0 + r] = v;
      }
  }
}

DI void unit_transpose(const float* __restrict__ src, bf16* __restrict__ dst, int R, int C, int tr, int tc, char* smem) {
  float* tile = (float*)smem;
  const int t = threadIdx.x + opaque0();
  __syncthreads();
#pragma unroll
  for (int i = 0; i < 4; ++i) {
    const int rr = (t >> 4) + 16 * i, cc = (t & 15) * 4;
    const f32x4 v = *(const f32x4*)(src + (size_t)(tr * 64 + rr) * C + tc * 64 + cc);
    tile[rr * 65 + cc] = v[0]; tile[rr * 65 + cc + 1] = v[1]; tile[rr * 65 + cc + 2] = v[2]; tile[rr * 65 + cc + 3] = v[3];
  }
  __syncthreads();
#pragma unroll
  for (int i = 0; i < 2; ++i) {
    const int orow = (t >> 3) + 32 * i, seg = (t & 7) * 8;
    bf16x8 v;
#pragma unroll
    for (int j = 0; j < 8; ++j) v[j] = (bf16)tile[(seg + j) * 65 + orow];
    *(bf16x8*)(dst + (size_t)(tc * 64 + orow) * R + tr * 64 + seg) = v;
  }
}
DI void unit_convert(const float* __restrict__ src, bf16* __restrict__ dst, int u) {
  const size_t base = (size_t)u * 8192 + (threadIdx.x + opaque0()) * 8;
  f32x4 av[4], bv[4];
#pragma unroll
  for (int i = 0; i < 4; ++i) { const size_t o = base + (size_t)i * 2048; av[i] = *(const f32x4*)(src + o); bv[i] = *(const f32x4*)(src + o + 4); }
#pragma unroll
  for (int i = 0; i < 4; ++i) {
    const size_t o = base + (size_t)i * 2048;
    const f32x4 a = av[i], b = bv[i];
    bf16x8 v; v[0] = (bf16)a[0]; v[1] = (bf16)a[1]; v[2] = (bf16)a[2]; v[3] = (bf16)a[3]; v[4] = (bf16)b[0]; v[5] = (bf16)b[1]; v[6] = (bf16)b[2]; v[7] = (bf16)b[3];
    *(bf16x8*)(dst + o) = v;
  }
}
DI unsigned pack_i8(float a, float b, float c, float d) {
  const int ia = max(-127, min(127, __float2int_rn(a))), ib = max(-127, min(127, __float2int_rn(b))), ic = max(-127, min(127, __float2int_rn(c))), id = max(-127, min(127, __float2int_rn(d)));
  return (unsigned)(ia & 255) | ((unsigned)(ib & 255) << 8) | ((unsigned)(ic & 255) << 16) | ((unsigned)(id & 255) << 24);
}
template <bool I8>
DI void unit_quant_rows(const float* __restrict__ src, unsigned char* __restrict__ dst, float* __restrict__ scale, int u) {
  const int t = threadIdx.x + opaque0(), lane = t & 63, w = t >> 6;
  f32x4 vv[2][4];
#pragma unroll
  for (int rr = 0; rr < 2; ++rr)
#pragma unroll
    for (int i = 0; i < 4; ++i) vv[rr][i] = *(const f32x4*)(src + ((size_t)u * 8 + 2 * w + rr) * DM + 16 * lane + 4 * i);
#pragma unroll
  for (int rr = 0; rr < 2; ++rr) {
    const size_t row = (size_t)u * 8 + 2 * w + rr;
    f32x4 v[4];
    float amax = 0.f;
#pragma unroll
    for (int i = 0; i < 4; ++i) { v[i] = vv[rr][i]; amax = fmaxf(amax, fmaxf(fmaxf(fabsf(v[i][0]), fabsf(v[i][1])), fmaxf(fabsf(v[i][2]), fabsf(v[i][3])))); }
#pragma unroll
    for (int o = 32; o >= 1; o >>= 1) amax = fmaxf(amax, __shfl_xor(amax, o));
    const float sc = amax > 0.f ? amax * (I8 ? 1.f / 127.f : 1.f / 440.f) : 1.f, inv = 1.f / sc;
    u32x4 q;
#pragma unroll
    for (int i = 0; i < 4; ++i) {
      if (I8) {
        q[i] = pack_i8(v[i][0] * inv, v[i][1] * inv, v[i][2] * inv, v[i][3] * inv);
      } else {
        int wd = 0;
        wd = __builtin_amdgcn_cvt_pk_fp8_f32(v[i][0] * inv, v[i][1] * inv, wd, false);
        wd = __builtin_amdgcn_cvt_pk_fp8_f32(v[i][2] * inv, v[i][3] * inv, wd, true);
        q[i] = (unsigned)wd;
      }
    }
    *(u32x4*)(dst + row * DM + 16 * lane) = q;
    if (lane == 0) scale[row] = sc;
  }
}
DI void unit_copy_f4(const float* __restrict__ src, float* __restrict__ dst, int n4) {
  for (int i0 = threadIdx.x + opaque0(); i0 < n4; i0 += 8 * NTHREADS) {
    f32x4 v[8];
#pragma unroll
    for (int k = 0; k < 8; ++k) { const int i = i0 + k * NTHREADS; v[k] = ((const f32x4*)src)[i < n4 ? i : n4 - 1]; }
#pragma unroll
    for (int k = 0; k < 8; ++k) { const int i = i0 + k * NTHREADS; if (i < n4) ((f32x4*)dst)[i] = v[k]; }
  }
}

DI void phase0_filler(const P& p, int f, char* smem) {
  if (f < U0_TIN) { unit_transpose(p.w_in, w_Wt_in(p), 1024, INW, f / 60, f % 60, smem); }
  else {
    for (int i = threadIdx.x + opaque0(); i < 16 * 128; i += NTHREADS) {
      const int head = i >> 7, d = i & 127;
      int bk = d;
      if (d >= 16) { bk = 16 + (int)(logf((float)d / 16.f) / logf(8.f) * 16.f); bk = bk > 31 ? 31 : bk; }
      w_BIAS(p)[i] = p.rel_table[bk * 16 + head];
    }
  }
}
DI void phase2_filler(const P& p, int f, char* smem) {
  if (f < F2_TOUT) unit_transpose(p.w_out, w_Wt_out(p), 1024, 1024, f / 16, f % 16, smem);
  else if (f < F2_E1) { const int v = f - F2_TOUT; unit_transpose(p.w_query, w_Wt_q(p), 1024, 2048, v / 32, v % 32, smem); }
  else if (f < F2_E2) { const int v = f - F2_E1, g = v >> 3, tt = v & 7; unit_transpose(p.pool_w + (size_t)g * 128 * 256, w_PWt(p) + (size_t)g * 256 * 128, 128, 256, tt >> 2, tt & 3, smem); }
  else if (f < F2_E3) { const int b = f - F2_E2; unit_copy_f4(p.cache_k + ((size_t)b * 128 + 1) * 128, p.out + O_KWS + (size_t)b * 128 * 128, 127 * 128 / 4); }
  else if (f < F2_E4) { const int b = f - F2_E3; unit_copy_f4(p.cache_v + ((size_t)b * 128 + 1) * 128, p.out + O_VWS + (size_t)b * 128 * 128, 127 * 128 / 4); }
  else { const int b = f - F2_E4; unit_copy_f4(p.state_pool + ((size_t)b * 15 + 1) * 512, p.out + O_PS + (size_t)b * 15 * 512, 14 * 512 / 4); }
}

template <int NR>
DI void norm_rows(const P& p, int tok0, int tstride, int which) {
  const int lane = (threadIdx.x + opaque0()) & 63;
  const float* g = which == 0 ? p.norm1_g : p.norm2_g;
  f32x4 v[NR][4], gg[4], sh[NR][4], sc[NR][4];
  float ss[NR];
#pragma unroll
  for (int i = 0; i < 4; ++i) gg[i] = *(const f32x4*)(g + 4 * lane + 256 * i);
#pragma unroll
  for (int k = 0; k < NR; ++k) {
    const int token = tok0 + k * tstride;
    const float* mod = w_MOD(p) + (size_t)cond_row(token) * 6144 + (which == 0 ? 0 : 3072);
#pragma unroll
    for (int i = 0; i < 4; ++i) { const int c = 4 * lane + 256 * i; sh[k][i] = *(const f32x4*)(mod + c); sc[k][i] = *(const f32x4*)(mod + 1024 + c); }
  }
  bool assembled = false;
  if constexpr (NR == 1) {
    if (which == 1 && tok0 >= NPR) {
      assembled = true;
      const int token = tok0;
      const float* g1 = w_MOD(p) + (size_t)cond_row(token) * 6144 + 2048;
      f32x4 xv[4], gv[4], pa[4], pb[4], pc[4], pd[4];
#pragma unroll
      for (int i = 0; i < 4; ++i) {
        const int c = 4 * lane + 256 * i;
        const size_t po = (size_t)(token - NPR) * DM + c;
        xv[i] = *(const f32x4*)(xrow(p, token) + c); gv[i] = *(const f32x4*)(g1 + c);
        pa[i] = *(const f32x4*)(w_PART(p) + po); pb[i] = *(const f32x4*)(w_PART(p) + (size_t)NS * DM + po);
        pc[i] = *(const f32x4*)(w_PART(p) + (size_t)2 * NS * DM + po); pd[i] = *(const f32x4*)(w_PART(p) + (size_t)3 * NS * DM + po);
      }
      ss[0] = 0.f;
#pragma unroll
      for (int i = 0; i < 4; ++i) {
#pragma unroll
        for (int j = 0; j < 4; ++j) v[0][i][j] = xv[i][j] + gv[i][j] * ((pa[i][j] + pb[i][j]) + (pc[i][j] + pd[i][j]));
        ss[0] += v[0][i][0] * v[0][i][0] + v[0][i][1] * v[0][i][1] + v[0][i][2] * v[0][i][2] + v[0][i][3] * v[0][i][3];
      }
#pragma unroll
      for (int i = 0; i < 4; ++i) *(f32x4*)(w_X1(p) + (size_t)token * DM + 4 * lane + 256 * i) = v[0][i];
    }
  }
  if (!assembled) {
#pragma unroll
    for (int k = 0; k < NR; ++k) {
      const int token = tok0 + k * tstride;
      const float* src = which == 0 ? xrow(p, token) : w_X1(p) + (size_t)token * DM;
#pragma unroll
      for (int i = 0; i < 4; ++i) v[k][i] = *(const f32x4*)(src + 4 * lane + 256 * i);
    }
#pragma unroll
    for (int k = 0; k < NR; ++k) {
      ss[k] = 0.f;
#pragma unroll
      for (int i = 0; i < 4; ++i) ss[k] += v[k][i][0] * v[k][i][0] + v[k][i][1] * v[k][i][1] + v[k][i][2] * v[k][i][2] + v[k][i][3] * v[k][i][3];
    }
  }
#pragma unroll
  for (int k = 0; k < NR; ++k) {
    const int token = tok0 + k * tstride;
    const float rstd = rsqrtf(wave_sum(ss[k]) * (1.f / DM) + EPS);
#pragma unroll
    for (int i = 0; i < 4; ++i) {
      const int c = 4 * lane + 256 * i;
      bf16x4 o;
#pragma unroll
      for (int j = 0; j < 4; ++j) { v[k][i][j] = (v[k][i][j] * rstd * gg[i][j]) * (1.f + sc[k][i][j]) + sh[k][i][j]; o[j] = (bf16)v[k][i][j]; }
      *(bf16x4*)(w_H(p) + (size_t)token * DM + c) = o;
    }
    if (which == 1) {
      float amax = 0.f;
#pragma unroll
      for (int i = 0; i < 4; ++i) amax = fmaxf(amax, fmaxf(fmaxf(fabsf(v[k][i][0]), fabsf(v[k][i][1])), fmaxf(fabsf(v[k][i][2]), fabsf(v[k][i][3]))));
#pragma unroll
      for (int o = 32; o >= 1; o >>= 1) amax = fmaxf(amax, __shfl_xor(amax, o));
      const float qs = amax > 0.f ? amax * (1.f / 127.f) : 1.f, inv = 1.f / qs;
#pragma unroll
      for (int i = 0; i < 4; ++i) *(unsigned*)(w_H8(p) + (size_t)token * DM + 4 * lane + 256 * i) = pack_i8(v[k][i][0] * inv, v[k][i][1] * inv, v[k][i][2] * inv, v[k][i][3] * inv);
      if (lane == 0) w_HS(p)[token] = qs;
    }
  }
}
DI void norm_phase(const P& p, int which) {
  const int G = gridDim.x, bid = blockIdx.x, w = __builtin_amdgcn_readfirstlane(threadIdx.x >> 6);
  int tk = bid * 4 + w;
  for (; tk + G * 4 < NPR; tk += 2 * G * 4) norm_rows<2>(p, tk, G * 4, which);
  for (; tk < NTOK; tk += G * 4) norm_rows<1>(p, tk, 0, which);
}

constexpr int LDSK = 72;
constexpr int GT = 128 * 64 * 2;
constexpr int GBUF = 2 * GT;
typedef __attribute__((address_space(3))) unsigned lds_u32;
typedef const __attribute__((address_space(1))) unsigned glb_u32;
DI void glds16(const void* g, char* l) { __builtin_amdgcn_global_load_lds((glb_u32*)g, (lds_u32*)l, 16, 0, 0); }
DI void gemm_first(const bf16* __restrict__ Wt, const bf16* __restrict__ X, int ld, int n0, int m0, char* smem) {
  const int t = threadIdx.x + opaque0(), lane = t & 63;
  const int w = __builtin_amdgcn_readfirstlane(t >> 6);
  const int swz = (lane & 7) ^ ((4 * w + (lane >> 4)) & 7);
  const bf16* ga = Wt + (size_t)(n0 + 8 * w + (lane >> 3)) * ld + swz * 8;
  const bf16* gb = X + (size_t)(m0 + 8 * w + (lane >> 3)) * ld + swz * 8;
#pragma unroll
  for (int q = 0; q < 4; ++q) { glds16(ga + (size_t)(32 * q) * ld, smem + 1024 * (w + 4 * q)); glds16(gb + (size_t)(32 * q) * ld, smem + GT + 1024 * (w + 4 * q)); }
}
DI void gemm_main(const bf16* __restrict__ Wt, const bf16* __restrict__ X, int ld, int K, int n0, int m0, char* smem, f32x16 (&acc)[4]) {
  const int t = threadIdx.x + opaque0(), lane = t & 63, r = lane & 31, h = lane >> 5;
  const int w = __builtin_amdgcn_readfirstlane(t >> 6);
#pragma unroll
  for (int i = 0; i < 4; ++i) acc[i] = zero16();
  const int swz = (lane & 7) ^ ((4 * w + (lane >> 4)) & 7);
  const bf16* ga = Wt + (size_t)(n0 + 8 * w + (lane >> 3)) * ld + swz * 8;
  const bf16* gb = X + (size_t)(m0 + 8 * w + (lane >> 3)) * ld + swz * 8;
  const int sw = (r >> 1) & 7;
  const int KT = K >> 6;
  asm volatile("s_waitcnt vmcnt(0)" ::: "memory");
  __syncthreads();
  for (int kt = 0; kt < KT; ++kt) {
    const char* As = smem + (kt & 1) * GBUF;
    const char* Bs = As + GT;
    if (kt + 1 < KT) {
      char* An = smem + ((kt + 1) & 1) * GBUF;
      const int k0 = (kt + 1) * 64;
#pragma unroll
      for (int q = 0; q < 4; ++q) { glds16(ga + (size_t)(32 * q) * ld + k0, An + 1024 * (w + 4 * q)); glds16(gb + (size_t)(32 * q) * ld + k0, An + GT + 1024 * (w + 4 * q)); }
    }
#pragma unroll
    for (int s = 0; s < 4; ++s) {
      const int co = ((2 * s + h) ^ sw) * 16;
      const bf16x8 bfr = *(const bf16x8*)(Bs + (32 * w + r) * 128 + co);
#pragma unroll
      for (int i = 0; i < 4; ++i) {
        const bf16x8 afr = *(const bf16x8*)(As + (32 * i + r) * 128 + co);
        acc[i] = MFMA(afr, bfr, acc[i]);
      }
    }
    asm volatile("s_waitcnt vmcnt(0)" ::: "memory");
    __syncthreads();
  }
}

DI float sigmoid_f(float x) { return __builtin_amdgcn_rcpf(1.f + __expf(-x)); }

DI void gemm1_map(int u, int& mt, int& nt) {
  const int v = u < 3584 ? (u & ~511) + (u & 7) * 64 + ((u >> 3) & 63) : u;
  mt = v / 30; nt = v % 30;
}
DI void unit_gemm1(const P& p, int u, int un, char* smem) {
  int mt, nt; gemm1_map(u, mt, nt);
  const int n0 = nt * 128, m0 = mt * 128;
  f32x16 acc[4];
  gemm_main(w_Wt_in(p), w_H(p), 1024, 1024, n0, m0, smem, acc);
  if (un >= 0) { int mn, nn; gemm1_map(un, mn, nn); gemm_first(w_Wt_in(p), w_H(p), 1024, nn * 128, mn * 128, smem); }
  const int tz = threadIdx.x + opaque0();
  const int lane = tz & 63, w = tz >> 6, r = lane & 31, h = lane >> 5;
  const int token = m0 + 32 * w + r;
  bf16* tw = (bf16*)(smem + GBUF + (tz >> 6) * 8704) + r * 136;
  const bool is_prompt = token < NPR;
  const int b = is_prompt ? (token >> 11) : (token - NPR), pos = token & (SEQ - 1);
  if (n0 < C_V) {
    const float* gn = n0 < C_K ? p.q_norm_g : p.k_norm_g;
    const float post = n0 < C_K ? 0.125f : 1.f;
#pragma unroll
    for (int hh = 0; hh < 2; ++hh) {
      float ss = 0.f;
#pragma unroll
      for (int i = 0; i < 2; ++i)
#pragma unroll
        for (int j = 0; j < 16; ++j) ss += acc[2 * hh + i][j] * acc[2 * hh + i][j];
      ss += __shfl_xor(ss, 32);
      const float rstd = rsqrtf(ss * (1.f / 64.f) + EPS);
#pragma unroll
      for (int i = 0; i < 2; ++i)
#pragma unroll
        for (int q4 = 0; q4 < 4; ++q4) {
          const int d = 32 * i + 8 * q4 + 4 * h;
          const f32x4 gg = *(const f32x4*)(gn + d);
          f32x4 v;
#pragma unroll
          for (int j = 0; j < 4; ++j) v[j] = acc[2 * hh + i][4 * q4 + j] * rstd * gg[j];
          bf16x4 o;
#pragma unroll
          for (int j = 0; j < 4; ++j) o[j] = (bf16)(v[j] * post);
          *(bf16x4*)(tw + 64 * hh + d) = o;
          if (n0 == C_K) {
            if (is_prompt) { if (pos >= SEQ - 128) *(f32x4*)(p.out + O_KWP + ((size_t)b * 128 + (pos - (SEQ - 128))) * 128 + 64 * hh + d) = v; }
            else *(f32x4*)(p.out + O_KWS + ((size_t)b * 128 + 127) * 128 + 64 * hh + d) = v;
          }
        }
    }
  } else if (n0 == C_V) {
#pragma unroll
    for (int i = 0; i < 4; ++i)
#pragma unroll
      for (int q4 = 0; q4 < 4; ++q4) {
        const int f = 32 * i + 8 * q4 + 4 * h;
        f32x4 v;
#pragma unroll
        for (int j = 0; j < 4; ++j) v[j] = acc[i][4 * q4 + j];
        if (is_prompt) {
#pragma unroll
          for (int j = 0; j < 4; ++j) w_VT(p)[((size_t)b * 128 + f + j) * SEQ + pos] = (bf16)v[j];
          if (pos >= SEQ - 128) *(f32x4*)(p.out + O_VWP + ((size_t)b * 128 + (pos - (SEQ - 128))) * 128 + f) = v;
        } else *(f32x4*)(p.out + O_VWS + ((size_t)b * 128 + 127) * 128 + f) = v;
      }
  } else if (n0 < C_GA) {
#pragma unroll
    for (int i = 0; i < 4; ++i)
#pragma unroll
      for (int q4 = 0; q4 < 4; ++q4) {
        const int f = n0 + 32 * i + 8 * q4 + 4 * h;
        f32x4 v; bf16x4 o;
#pragma unroll
        for (int j = 0; j < 4; ++j) { v[j] = acc[i][4 * q4 + j]; o[j] = (bf16)v[j]; }
        *(bf16x4*)(tw + (f - n0)) = o;
        if (is_prompt) { if (pos >= SEQ - 15) *(f32x4*)(p.out + O_PP + ((size_t)b * 15 + (pos - (SEQ - 15))) * 512 + (f - C_PIN)) = v; }
        else *(f32x4*)(p.out + O_PS + ((size_t)b * 15 + 14) * 512 + (f - C_PIN)) = v;
      }
  } else {
#pragma unroll
    for (int i = 0; i < 4; ++i)
#pragma unroll
      for (int q4 = 0; q4 < 4; ++q4) {
        const int f = n0 + 32 * i + 8 * q4 + 4 * h;
        bf16x4 o;
#pragma unroll
        for (int j = 0; j < 4; ++j) o[j] = (bf16)sigmoid_f(acc[i][4 * q4 + j]);
        *(bf16x4*)(tw + (f - n0)) = o;
      }
  }
  if (n0 != C_V) {
    LDS_WAIT();
    const bf16* tr = (const bf16*)(smem + GBUF + (tz >> 6) * 8704);
    bf16* pg = w_PROJ(p) + (size_t)(m0 + 32 * w + (lane >> 4)) * INW + n0 + (lane & 15) * 8;
#pragma unroll
    for (int it = 0; it < 8; ++it) *(u32x4*)(pg + (size_t)(4 * it) * INW) = *(const u32x4*)(tr + ((lane >> 4) + 4 * it) * 136 + (lane & 15) * 8);
  }
}

constexpr int VTS = 260;
constexpr int RS = 136;
DI void attn_head(const P& p, int head, int blk, int w, int r, int h, const bf16x8 (&qf)[4], const bf16* Ks, const bf16* VTs, const float* bsh, bf16x8 (&ob)[4]) {
  const int qi = 32 * w + r;
  f32x16 st[5];
#pragma unroll
  for (int tt = 0; tt < 5; ++tt) {
    st[tt] = zero16();
#pragma unroll
    for (int s = 0; s < 4; ++s) {
      const bf16x8 a = *(const bf16x8*)(Ks + (32 * (w + tt) + r) * LDSK + 16 * s + 8 * h);
      st[tt] = MFMA(a, qf[s], st[tt]);
    }
  }
  const float sink = p.sinks[head];
  float m = -INFINITY;
  {
    const int x = 31 - r + 4 * h;
    const float* bl = bsh + x;
#pragma unroll
    for (int tt = 0; tt < 5; ++tt)
#pragma unroll
      for (int j = 0; j < 16; ++j) {
        const int c = 32 * tt + (j & 3) + 8 * (j >> 2);
        const float s = st[tt][j] + bl[c];
        st[tt][j] = s;
        m = fmaxf(m, s);
      }
    if (blk == 0) {
      m = -INFINITY;
#pragma unroll
      for (int tt = 0; tt < 5; ++tt)
#pragma unroll
        for (int j = 0; j < 16; ++j) {
          const int c = 32 * tt + (j & 3) + 8 * (j >> 2);
          const float s = (159 - (x + c) > qi) ? -INFINITY : st[tt][j];
          st[tt][j] = s;
          m = fmaxf(m, s);
        }
    }
  }
  m = fmaxf(m, __shfl_xor(m, 32));
  m = fmaxf(m, sink);
  float sum = 0.f;
#pragma unroll
  for (int tt = 0; tt < 5; ++tt)
#pragma unroll
    for (int j = 0; j < 16; ++j) { const float e = __expf(st[tt][j] - m); st[tt][j] = e; sum += e; }
  sum += __shfl_xor(sum, 32);
  const float inv = 1.f / (sum + __expf(sink - m));
  f32x16 o[2] = {zero16(), zero16()};
#pragma unroll
  for (int tt = 0; tt < 5; ++tt)
#pragma unroll
    for (int s = 0; s < 2; ++s) {
      const bf16x8 pb = pack_step(st[tt], s);
#pragma unroll
      for (int i = 0; i < 2; ++i) {
        const bf16* vp = VTs + (32 * i + r) * VTS + 32 * (w + tt) + 16 * s + 4 * h;
        const bf16x8 a = cat4(*(const bf16x4*)vp, *(const bf16x4*)(vp + 8));
        o[i] = MFMA(a, pb, o[i]);
      }
    }
#pragma unroll
  for (int i = 0; i < 2; ++i)
#pragma unroll
    for (int j = 0; j < 16; ++j) ob[2 * i + (j >> 3)][j & 7] = (bf16)(o[i][j] * inv);
}
DI void unit_attn_prompt(const P& p, int u0, char* smem) {
  const int u = (u0 & ~511) + (u0 & 7) * 64 + ((u0 >> 3) & 63);
  const int b = u >> 7, blk = (u >> 3) & 15, hp = u & 7, hk = hp >> 2, g = hp >> 1, win = 2 << g;
  const int qpos0 = blk * 128;
  const int t = threadIdx.x + opaque0(), lane = t & 63, w = t >> 6, r = lane & 31, h = lane >> 5;
  bf16* Ks = (bf16*)smem;
  bf16* VTs = Ks + 256 * LDSK;
  float* bs = (float*)(VTs + 64 * VTS);
  bf16* Rs = Ks;
  __syncthreads();
#pragma unroll
  for (int i = 0; i < 8; ++i) {
    const int c = t + 256 * i, row = c >> 3, c16 = c & 7, kp = qpos0 - 128 + row;
    u32x4 v = {0u, 0u, 0u, 0u};
    if (kp >= 0) v = *(const u32x4*)(w_PROJ(p) + ((size_t)b * SEQ + kp) * INW + C_K + hk * 64 + c16 * 8);
    *(u32x4*)(Ks + row * LDSK + c16 * 8) = v;
  }
#pragma unroll
  for (int i = 0; i < 8; ++i) {
    const int c = t + 256 * i, drow = c >> 5, c16 = c & 31, kp0 = qpos0 - 128 + c16 * 8;
    u32x4 v = {0u, 0u, 0u, 0u};
    if (kp0 >= 0) v = *(const u32x4*)(w_VT(p) + ((size_t)(b * 2 + hk) * 64 + drow) * SEQ + kp0);
    u32x2* d2 = (u32x2*)(VTs + drow * VTS + c16 * 8);
    d2[0] = (u32x2){v[0], v[1]}; d2[1] = (u32x2){v[2], v[3]};
  }
  for (int i = t; i < 384; i += NTHREADS) { const int hh = i >= 192, j = i - 192 * hh, dist = 159 - j; bs[i] = (dist >= 0 && dist < 128) ? w_BIAS(p)[(2 * hp + hh) * 128 + dist] : -INFINITY; }
  const size_t tokq = (size_t)b * SEQ + qpos0 + 32 * w + r;
  bf16x8 qf0[4], qf1[4];
#pragma unroll
  for (int s = 0; s < 4; ++s) { qf0[s] = *(const bf16x8*)(w_PROJ(p) + tokq * INW + (2 * hp) * 64 + 16 * s + 8 * h); qf1[s] = *(const bf16x8*)(w_PROJ(p) + tokq * INW + (2 * hp + 1) * 64 + 16 * s + 8 * h); }
  __syncthreads();
  bf16x8 ob0[4], ob1[4];
  attn_head(p, 2 * hp, blk, w, r, h, qf0, Ks, VTs, bs, ob0);
  __builtin_amdgcn_sched_barrier(0);
  attn_head(p, 2 * hp + 1, blk, w, r, h, qf1, Ks, VTs, bs + 192, ob1);
  __builtin_amdgcn_sched_barrier(0);
  __syncthreads();
  {
    const int tk = t >> 4, cc = t & 15;
    const int p0 = qpos0 + tk * 8;
    const bf16* pin = w_PROJ(p) + (size_t)b * SEQ * INW + C_PIN + g * 128 + cc * 8;
    float S[8];
#pragma unroll
    for (int j = 0; j < 8; ++j) S[j] = 0.f;
    for (int i = 0; i < win; ++i) {
      const int pp = p0 - i;
      if (pp >= 0) { const bf16x8 v = *(const bf16x8*)(pin + (size_t)pp * INW);
#pragma unroll
        for (int j = 0; j < 8; ++j) S[j] += bf2f(v[j]); }
    }
    for (int i = 0; i < 8; ++i) {
      const int pos = p0 + i;
      const bf16x8 cur = *(const bf16x8*)(pin + (size_t)pos * INW);
      if (i > 0) {
#pragma unroll
        for (int j = 0; j < 8; ++j) S[j] += bf2f(cur[j]);
        if (pos - win >= 0) { const bf16x8 old = *(const bf16x8*)(pin + (size_t)(pos - win) * INW);
#pragma unroll
          for (int j = 0; j < 8; ++j) S[j] -= bf2f(old[j]); }
      }
      const float icnt = 1.f / (float)(win < pos + 1 ? win : pos + 1);
      bf16x8 rr;
#pragma unroll
      for (int j = 0; j < 8; ++j) rr[j] = (bf16)(S[j] * icnt - bf2f(cur[j]));
      *(bf16x8*)(Rs + (tk * 8 + i) * RS + cc * 8) = rr;
    }
  }
  __syncthreads();
  const bf16* prow = w_PROJ(p) + tokq * INW;
#pragma unroll
  for (int hh = 0; hh < 2; ++hh) {
    const int head = 2 * hp + hh;
    f32x16 pa[2] = {zero16(), zero16()};
#pragma unroll
    for (int s = 0; s < 8; ++s) {
      const bf16x8 bfr = *(const bf16x8*)(Rs + (32 * w + r) * RS + 16 * s + 8 * h);
#pragma unroll
      for (int i = 0; i < 2; ++i) {
        const bf16x8 a = *(const bf16x8*)(w_PWt(p) + ((size_t)g * 256 + (head & 3) * 64 + 32 * i + r) * 128 + 16 * s + 8 * h);
        pa[i] = MFMA(a, bfr, pa[i]);
      }
    }
#pragma unroll
    for (int i = 0; i < 2; ++i)
#pragma unroll
      for (int q4 = 0; q4 < 4; ++q4) {
        const int f = head * 64 + 32 * i + 8 * q4 + 4 * h;
        const bf16x4 ga = *(const bf16x4*)(prow + C_GA + f), gb = *(const bf16x4*)(prow + C_GB + f);
        const f32x4 ps = *(const f32x4*)(p.pool_scale + f);
        bf16x4 ov;
#pragma unroll
        for (int j = 0; j < 4; ++j) { const bf16 av = hh ? ob1[2 * i + (q4 >> 1)][4 * (q4 & 1) + j] : ob0[2 * i + (q4 >> 1)][4 * (q4 & 1) + j];
          ov[j] = (bf16)(bf2f(ga[j]) * bf2f(av) + bf2f(gb[j]) * (pa[i][4 * q4 + j] * ps[j])); }
        *(bf16x4*)(w_MIXED(p) + tokq * DM + f) = ov;
      }
    __builtin_amdgcn_sched_barrier(0);
  }
}

DI void unit_attn_sample(const P& p, int u, char* smem) {
  const int b = u >> 2, g = u & 3, hk = g >> 1;
  const int t = threadIdx.x + opaque0(), lane = t & 63, w = t >> 6;
  float* ks = (float*)smem;
  float* vs = ks + 128 * 65;
  float* qs = vs + 128 * 64;
  float* ps = qs + 256;
  float* os = ps + 512;
  float* rs = os + 256;
  const size_t token = (size_t)NPR + b;
  __syncthreads();
  const float* kw = p.out + O_KWS + (size_t)b * 128 * 128 + hk * 64;
  const float* vw = p.out + O_VWS + (size_t)b * 128 * 128 + hk * 64;
  {
    f32x4 kv[8], vv[8];
#pragma unroll
    for (int k = 0; k < 8; ++k) { const int i = t + NTHREADS * k, j = i >> 4, d4 = (i & 15) * 4; kv[k] = *(const f32x4*)(kw + (size_t)j * 128 + d4); vv[k] = *(const f32x4*)(vw + (size_t)j * 128 + d4); }
    const float qv = bf2f(w_PROJ(p)[token * INW + g * 256 + t]);
    const int win = 2 << g, tc = t & 127;
    const float cur = p.out[O_PS + ((size_t)b * 15 + 14) * 512 + g * 128 + tc];
    float hv[15];
#pragma unroll
    for (int i = 1; i < 16; ++i) hv[i - 1] = p.state_pool[((size_t)b * 15 + 15 - i) * 512 + g * 128 + tc];
#pragma unroll
    for (int k = 0; k < 8; ++k) {
      const int i = t + NTHREADS * k, j = i >> 4, d4 = (i & 15) * 4;
      ks[j * 65 + d4] = kv[k][0]; ks[j * 65 + d4 + 1] = kv[k][1]; ks[j * 65 + d4 + 2] = kv[k][2]; ks[j * 65 + d4 + 3] = kv[k][3];
      *(f32x4*)(vs + j * 64 + d4) = vv[k];
    }
    qs[t] = qv;
    float tot = cur;
#pragma unroll
    for (int i = 1; i < 16; ++i) tot += i < win ? hv[i - 1] : 0.f;
    if (t < 128) rs[t] = tot / (float)win - cur;
  }
  __syncthreads();
  const int head = 4 * g + w;
  const float sink = p.sinks[head];
  float s[2];
  float m = sink;
#pragma unroll
  for (int i = 0; i < 2; ++i) {
    const int j = lane + 64 * i;
    float a = 0.f;
#pragma unroll 8
    for (int d = 0; d < 64; ++d) a += qs[w * 64 + d] * ks[j * 65 + d];
    s[i] = a + w_BIAS(p)[head * 128 + 127 - j];
    m = fmaxf(m, s[i]);
  }
  for (int o = 32; o >= 1; o >>= 1) m = fmaxf(m, __shfl_xor(m, o));
  float sum = 0.f;
#pragma unroll
  for (int i = 0; i < 2; ++i) { s[i] = __expf(s[i] - m); sum += s[i]; }
  sum = wave_sum(sum);
  const float inv = 1.f / (sum + __expf(sink - m));
#pragma unroll
  for (int i = 0; i < 2; ++i) ps[w * 128 + lane + 64 * i] = s[i] * inv;
  LDS_WAIT();
  {
    float a = 0.f;
#pragma unroll 8
    for (int j = 0; j < 128; ++j) a += ps[w * 128 + j] * vs[j * 64 + lane];
    os[w * 64 + lane] = a;
  }
  const int f = g * 256 + t;
  float pl = 0.f;
  const float* pw = p.pool_w + (size_t)g * 128 * 256 + t;
#pragma unroll 32
  for (int ch = 0; ch < 128; ++ch) pl += rs[ch] * pw[(size_t)ch * 256];
  pl *= p.pool_scale[f];
  const float ga = bf2f(w_PROJ(p)[token * INW + C_GA + f]), gb = bf2f(w_PROJ(p)[token * INW + C_GB + f]);
  LDS_WAIT();
  w_MIXED(p)[token * DM + f] = (bf16)(ga * os[t] + gb * pl);
}

DI void unit8_map(int u, int& mt, int& nt) {
  if (u < 1024) { const int xcd = u & 7, slot = (u >> 3) & 63, S = (u >> 9) * 8 + xcd; mt = S * 8 + (slot & 7); nt = slot >> 3; }
  else { mt = 128; nt = u - 1024; }
}
constexpr int G2_UNITS = 1024 + 32;
DI void gemm2_map(int u, int& mt, int& nt, int& kq) {
  if (u < 1024) { unit8_map(u, mt, nt); kq = -1; }
  else { mt = 128; nt = (u - 1024) & 7; kq = (u - 1024) >> 3; }
}
DI void gemm2_first(const P& p, int u, char* smem) {
  int mt, nt, kq; gemm2_map(u, mt, nt, kq);
  const int kb = kq < 0 ? 0 : 256 * kq;
  gemm_first(w_Wt_out(p) + kb, w_MIXED(p) + kb, 1024, nt * 128, mt * 128, smem);
}
DI void unit_gemm2(const P& p, int u, int un, char* smem) {
  int mt, nt, kq; gemm2_map(u, mt, nt, kq);
  const int n0 = nt * 128, m0 = mt * 128, kb = kq < 0 ? 0 : 256 * kq;
  const int tz = threadIdx.x + opaque0();
  const int lane = tz & 63, w = tz >> 6, r = lane & 31, h = lane >> 5;
  const int fc = (lane & 15) * 4, tsub = lane >> 4;
  f32x4 xv[16];
#pragma unroll
  for (int k = 0; k < 16; ++k) { const int token = m0 + 32 * w + 4 * (k & 7) + tsub; xv[k] = *(const f32x4*)(xrow(p, token) + n0 + 64 * (k >> 3) + fc); }
  f32x16 acc[4];
  gemm_main(w_Wt_out(p) + kb, w_MIXED(p) + kb, 1024, kq < 0 ? 1024 : 256, n0, m0, smem, acc);
  if (un >= 0) gemm2_first(p, un, smem);
  float* tbase = (float*)(smem + GBUF + w * 8704);
  f32x4 gv[16];
  if (kq < 0) {
#pragma unroll
    for (int k = 0; k < 16; ++k) { const int token = m0 + 32 * w + 4 * (k & 7) + tsub; gv[k] = *(const f32x4*)(w_MOD(p) + (size_t)cond_row(token) * 6144 + 2048 + n0 + 64 * (k >> 3) + fc); }
  }
#pragma unroll
  for (int hf = 0; hf < 2; ++hf) {
    if (hf) LDS_WAIT();
#pragma unroll
    for (int ii = 0; ii < 2; ++ii)
#pragma unroll
      for (int q4 = 0; q4 < 4; ++q4) {
        f32x4 v;
#pragma unroll
        for (int j = 0; j < 4; ++j) v[j] = acc[2 * hf + ii][4 * q4 + j];
        *(f32x4*)(tbase + r * 68 + 32 * ii + 8 * q4 + 4 * h) = v;
      }
    LDS_WAIT();
    if (kq >= 0) {
#pragma unroll
      for (int it = 0; it < 8; ++it) {
        const int tl = 4 * it + tsub, token = m0 + 32 * w + tl, f = n0 + 64 * hf + fc;
        *(f32x4*)(w_PART(p) + ((size_t)kq * NS + (token - NPR)) * DM + f) = *(const f32x4*)(tbase + tl * 68 + fc);
      }
    } else {
#pragma unroll
      for (int it = 0; it < 8; ++it) {
        const int tl = 4 * it + tsub, token = m0 + 32 * w + tl, f = n0 + 64 * hf + fc;
        const f32x4 a = *(const f32x4*)(tbase + tl * 68 + fc);
        f32x4 o;
#pragma unroll
        for (int j = 0; j < 4; ++j) o[j] = xv[8 * hf + it][j] + gv[8 * hf + it][j] * a[j];
        *(f32x4*)(w_X1(p) + (size_t)token * DM + f) = o;
      }
    }
  }
}

DI unsigned f2ord(float f) { const unsigned u = __float_as_uint(f); return (u & 0x80000000u) ? ~u : (u | 0x80000000u); }
DI float ord2f(unsigned u) { return __uint_as_float((u & 0x80000000u) ? (u & 0x7fffffffu) : ~u); }
DI unsigned umin_(unsigned a, unsigned b) { return a < b ? a : b; }
DI unsigned umax_(unsigned a, unsigned b) { return a > b ? a : b; }
template <int OFF> DI void sort16_desc(unsigned (&a)[64]) {
#pragma unroll
  for (int lk = 1; lk <= 4; ++lk)
#pragma unroll
    for (int lj = lk - 1; lj >= 0; --lj)
#pragma unroll
      for (int i = 0; i < 16; ++i) {
        const int k = 1 << lk, j = 1 << lj, l = i ^ j;
        if (l > i) {
          const unsigned lo = umin_(a[OFF + i], a[OFF + l]), hi = umax_(a[OFF + i], a[OFF + l]);
          const bool desc = (i & k) == 0;
          a[OFF + i] = desc ? hi : lo; a[OFF + l] = desc ? lo : hi;
        }
      }
}
DI void merge16_desc(unsigned (&a)[16]) {
#pragma unroll
  for (int lj = 3; lj >= 0; --lj)
#pragma unroll
    for (int i = 0; i < 16; ++i) {
      const int j = 1 << lj, l = i ^ j;
      if (l > i) { const unsigned lo = umin_(a[i], a[l]), hi = umax_(a[i], a[l]); a[i] = hi; a[l] = lo; }
    }
}
DI void top16_of_64(unsigned (&a)[64], unsigned (&out)[16]) {
  sort16_desc<0>(a); sort16_desc<16>(a); sort16_desc<32>(a); sort16_desc<48>(a);
  unsigned x[16], y[16];
#pragma unroll
  for (int i = 0; i < 16; ++i) { x[i] = umax_(a[i], a[31 - i]); y[i] = umax_(a[32 + i], a[63 - i]); }
  merge16_desc(x); merge16_desc(y);
#pragma unroll
  for (int i = 0; i < 16; ++i) out[i] = umax_(x[i], y[15 - i]);
  merge16_desc(out);
}
__device__ constexpr int COFF[16] = {0, 16, 24, 29, 33, 36, 38, 40, 42, 43, 44, 45, 46, 47, 48, 49};
DI unsigned umax3(unsigned a, unsigned b, unsigned c) { const unsigned m = a > b ? a : b; return m > c ? m : c; }

DI void unit_peer_route(const P& p, int u, int un, char* smem) {
  int mt, hd; unit8_map(u, mt, hd);
  const int m0 = mt * 128;
  const int t = threadIdx.x + opaque0(), lane = t & 63, w = t >> 6, r = lane & 31, h = lane >> 5;
  unsigned char* myidx = (unsigned char*)smem + 2 * GBUF + t * 32;
  unsigned top[2][16];
#pragma unroll
  for (int pp = 0; pp < 2; ++pp) {
    f32x16 acc[4];
    gemm_main(w_Wt_q(p), w_H(p), 1024, 1024, hd * 256 + pp * 128, m0, smem, acc);
    if (pp == 0) gemm_first(w_Wt_q(p), w_H(p), 1024, hd * 256 + 128, m0, smem);
    else if (un >= 0) { int mn, hn; unit8_map(un, mn, hn); gemm_first(w_Wt_q(p), w_H(p), 1024, hn * 256, mn * 128, smem); }
    f32x16 sc[4] = {zero16(), zero16(), zero16(), zero16()};
    {
      const bf16* skb = w_SK(p) + (size_t)(hd * 2 + pp) * 128 * 128;
      const int wu = __builtin_amdgcn_readfirstlane(w);
#pragma unroll
      for (int q = 0; q < 8; ++q) {
        const int j = wu + 4 * q, row = 4 * j + (lane >> 4);
        glds16(skb + (size_t)row * 128 + (((lane & 15) ^ (row & 15)) * 8), smem + GBUF + 1024 * j);
      }
      asm volatile("s_waitcnt vmcnt(0)" ::: "memory");
      __syncthreads();
    }
    bf16x8 bqs[8];
#pragma unroll
    for (int i = 0; i < 4; ++i)
#pragma unroll
      for (int s = 0; s < 2; ++s) bqs[2 * i + s] = pack_step(acc[i], s);
#pragma unroll
    for (int i = 0; i < 4; ++i)
#pragma unroll
      for (int s = 0; s < 2; ++s) {
        const bf16x8 bq = bqs[2 * i + s];
#pragma unroll
        for (int kt = 0; kt < 4; ++kt) {
          const int row = 32 * kt + r, cc = 4 * i + 2 * s;
          const char* rp = smem + GBUF + row * 256 + 8 * h;
          const bf16x8 a = cat4(*(const bf16x4*)(rp + ((cc ^ (row & 15)) * 16)), *(const bf16x4*)(rp + (((cc + 1) ^ (row & 15)) * 16)));
          sc[kt] = MFMA(a, bq, sc[kt]);
        }
      }
    unsigned pk[64];
#pragma unroll
    for (int kt = 0; kt < 4; ++kt)
#pragma unroll
      for (int j = 0; j < 16; ++j) { const int key = 32 * kt + crow(j, h); pk[kt * 16 + j] = (f2ord(sc[kt][j]) & ~127u) | (unsigned)(127 - key); }
    unsigned mine[16];
    top16_of_64(pk, mine);
#pragma unroll
    for (int i = 0; i < 16; ++i) top[pp][i] = (unsigned)__shfl_xor((int)mine[15 - i], 32);
#pragma unroll
    for (int i = 0; i < 16; ++i) top[pp][i] = umax_(top[pp][i], mine[i]);
    merge16_desc(top[pp]);
  }
  float v0[16], v1[16];
#pragma unroll
  for (int a = 0; a < 16; ++a) {
    v0[a] = ord2f(top[0][a] & ~127u); v1[a] = ord2f(top[1][a] & ~127u);
    myidx[a] = (unsigned char)(127u - (top[0][a] & 127u)); myidx[16 + a] = (unsigned char)(127u - (top[1][a] & 127u));
  }
  unsigned cand[64];
#pragma unroll
  for (int i = 50; i < 64; ++i) cand[i] = 0u;
#pragma unroll
  for (int a = 0; a < 16; ++a)
#pragma unroll
    for (int bb = 0; bb < 16 / (a + 1); ++bb)
      cand[COFF[a] + bb] = (f2ord(v0[a] + v1[bb]) & ~255u) | (unsigned)(255 - (a * 16 + bb));
  unsigned best[16];
  top16_of_64(cand, best);
  const float smax = ord2f(best[0] & ~255u);
  float e[16], esum = 0.f;
#pragma unroll
  for (int i = 0; i < 16; ++i) { e[i] = __expf(ord2f(best[i] & ~255u) - smax); esum += e[i]; }
  const float einv = 1.f / esum;
  const size_t token = (size_t)m0 + 32 * w + r;
  int* ip = w_IDX(p) + token * 128 + hd * 16 + 8 * h;
  float* gp = w_GATE(p) + token * 128 + hd * 16 + 8 * h;
  const unsigned hmask = 0u - (unsigned)h;
#pragma unroll
  for (int i = 0; i < 8; ++i) {
    const unsigned bsel = best[i] ^ ((best[i] ^ best[8 + i]) & hmask);
    const float esel = __uint_as_float(__float_as_uint(e[i]) ^ ((__float_as_uint(e[i]) ^ __float_as_uint(e[8 + i])) & hmask));
    const unsigned code = 255u - (bsel & 255u);
    const int a = code >> 4, bb = code & 15;
    ip[i] = (int)myidx[a] * 128 + (int)myidx[16 + bb];
    gp[i] = esel * einv;
  }
}

DI float gelu_fast(float v) {
  const float av = fabsf(v), tt = __builtin_amdgcn_rcpf(av * 0.2316418882f + 1.0f);
  float q = tt * 0.5307027145f - 0.7265760135f; q = q * tt + 0.7107068705f; q = q * tt - 0.142248368f; q = q * tt + 0.127414796f; q = q * tt;
  const float e = __builtin_amdgcn_exp2f(v * v * -0.72134752044f);
  const float m = v * (q * e);
  return v < 0.f ? m : v - m;
}
DI float dot2bf(unsigned a, unsigned b, float acc) { return __builtin_amdgcn_fdot2_f32_bf16(__builtin_bit_cast(bf16x2, a), __builtin_bit_cast(bf16x2, b), acc, false); }
DI unsigned pkbf(f32x2 v) { bf16x2 r; r[0] = (bf16)v[0]; r[1] = (bf16)v[1]; return __builtin_bit_cast(unsigned, r); }
DI int dot16i(u32x4 u8, u32x4 x8, int d) {
#pragma unroll
  for (int m = 0; m < 4; ++m) d = __builtin_amdgcn_sdot4((int)u8[m], (int)x8[m], d, false);
  return d;
}
DI void axpy16p(f32x2* o, u32x4 v8, f32x2 c2) {
#pragma unroll
  for (int m = 0; m < 4; ++m) {
    const int wd = (int)v8[m];
    o[2 * m] = __builtin_elementwise_fma(c2, __builtin_amdgcn_cvt_pk_f32_fp8(wd, false), o[2 * m]);
    o[2 * m + 1] = __builtin_elementwise_fma(c2, __builtin_amdgcn_cvt_pk_f32_fp8(wd, true), o[2 * m + 1]);
  }
}
DI int dpp_add16i(int v) {
  v += __builtin_amdgcn_update_dpp(0, v, 0x140, 0xf, 0xf, true);
  v += __builtin_amdgcn_update_dpp(0, v, 0x141, 0xf, 0xf, true);
  v += __builtin_amdgcn_update_dpp(0, v, 0x4e, 0xf, 0xf, true);
  v += __builtin_amdgcn_update_dpp(0, v, 0xb1, 0xf, 0xf, true);
  return v;
}
DI float dot16(u32x4 u8, u32x4 xlo, u32x4 xhi, float d) {
#pragma unroll
  for (int m = 0; m < 4; ++m) {
    const int wd = (int)u8[m];
    const unsigned p01 = pkbf(__builtin_amdgcn_cvt_pk_f32_fp8(wd, false)), p23 = pkbf(__builtin_amdgcn_cvt_pk_f32_fp8(wd, true));
    const unsigned x01 = m < 2 ? xlo[2 * m] : xhi[2 * m - 4], x23 = m < 2 ? xlo[2 * m + 1] : xhi[2 * m - 3];
    d = dot2bf(p01, x01, d); d = dot2bf(p23, x23, d);
  }
  return d;
}
DI void axpy16(float* o, u32x4 v8, float c) {
#pragma unroll
  for (int m = 0; m < 4; ++m) {
    const int wd = (int)v8[m];
    const f32x2 a = __builtin_amdgcn_cvt_pk_f32_fp8(wd, false), b = __builtin_amdgcn_cvt_pk_f32_fp8(wd, true);
    o[4 * m] += c * a[0]; o[4 * m + 1] += c * a[1]; o[4 * m + 2] += c * b[0]; o[4 * m + 3] += c * b[1];
  }
}
DI float reduce4(const float (&d)[4], int lane) {
  const int h = lane >> 5, b4 = (lane >> 4) & 1;
  float a0 = h ? d[2] : d[0], a1 = h ? d[3] : d[1];
  const float s0 = h ? d[0] : d[2], s1 = h ? d[1] : d[3];
  a0 += __shfl_xor(s0, 32); a1 += __shfl_xor(s1, 32);
  float k = b4 ? a1 : a0;
  const float s = b4 ? a0 : a1;
  k += __shfl_xor(s, 16);
  k += __shfl_xor(k, 8); k += __shfl_xor(k, 4); k += __shfl_xor(k, 2); k += __shfl_xor(k, 1);
  return k;
}
DI float dpp_add16(float v) {
  v += __int_as_float(__builtin_amdgcn_update_dpp(0, __float_as_int(v), 0x140, 0xf, 0xf, true));
  v += __int_as_float(__builtin_amdgcn_update_dpp(0, __float_as_int(v), 0x141, 0xf, 0xf, true));
  v += __int_as_float(__builtin_amdgcn_update_dpp(0, __float_as_int(v), 0x4e, 0xf, 0xf, true));
  v += __int_as_float(__builtin_amdgcn_update_dpp(0, __float_as_int(v), 0xb1, 0xf, 0xf, true));
  return v;
}
constexpr int PEER_GLDS = 512 + 128 * 16;
constexpr int PEER_WLDS = 4 * PEER_GLDS;
template <int PART>
DI void peer_wave4(const P& p, int g, char* wl) {
  const int lane = (threadIdx.x + opaque0()) & 63, q = lane >> 4, j16 = lane & 15;
  unsigned* hist = (unsigned*)(wl + q * PEER_GLDS);
  u32x4* list = (u32x4*)(wl + q * PEER_GLDS + 512);
  const int token = 4 * g + q;
  if constexpr (PART != 2) {
  u32x4 x[4];
  {
    const unsigned char* hrow = w_H8(p) + (size_t)token * DM + 16 * j16;
#pragma unroll
    for (int i = 0; i < 4; ++i) x[i] = *(const u32x4*)(hrow + 256 * i);
  }
  const float xs = w_HS(p)[token];
  {
    int ids[8]; float gts[8], su[8];
#pragma unroll
    for (int i = 0; i < 8; ++i) { const size_t o = (size_t)token * 128 + j16 + 16 * i; ids[i] = w_IDX(p)[o]; gts[i] = w_GATE(p)[o]; }
#pragma unroll
    for (int i = 0; i < 8; ++i) { su[i] = w_SU(p)[ids[i]] * xs; gts[i] *= w_SV(p)[ids[i]]; }
    LDS_WAIT();
    *(u32x4*)(hist + 8 * j16) = (u32x4){0u, 0u, 0u, 0u}; *(u32x4*)(hist + 8 * j16 + 4) = (u32x4){0u, 0u, 0u, 0u};
    LDS_WAIT();
#pragma unroll
    for (int i = 0; i < 8; ++i) (void)__hip_atomic_fetch_add(&hist[ids[i] >> 7], 1u, __ATOMIC_RELAXED, __HIP_MEMORY_SCOPE_WAVEFRONT);
    LDS_WAIT();
    const u32x4 ca = *(const u32x4*)(hist + 8 * j16), cb = *(const u32x4*)(hist + 8 * j16 + 4);
    const unsigned tot = ca[0] + ca[1] + ca[2] + ca[3] + cb[0] + cb[1] + cb[2] + cb[3];
    unsigned scan = tot;
#pragma unroll
    for (int o = 1; o < 16; o <<= 1) { const unsigned tv = (unsigned)__shfl_up((int)scan, o, 16); if (j16 >= o) scan += tv; }
    unsigned e0 = scan - tot;
    u32x4 pa, pb;
    pa[0] = e0; e0 += ca[0]; pa[1] = e0; e0 += ca[1]; pa[2] = e0; e0 += ca[2]; pa[3] = e0; e0 += ca[3];
    pb[0] = e0; e0 += cb[0]; pb[1] = e0; e0 += cb[1]; pb[2] = e0; e0 += cb[2]; pb[3] = e0;
    LDS_WAIT();
    *(u32x4*)(hist + 8 * j16) = pa; *(u32x4*)(hist + 8 * j16 + 4) = pb;
    LDS_WAIT();
#pragma unroll
    for (int i = 0; i < 8; ++i) {
      const unsigned pos = __hip_atomic_fetch_add(&hist[ids[i] >> 7], 1u, __ATOMIC_RELAXED, __HIP_MEMORY_SCOPE_WAVEFRONT);
      list[pos] = (u32x4){(unsigned)ids[i], __float_as_uint(su[i]), __float_as_uint(gts[i]), 0u};
    }
    LDS_WAIT();
  }
  const unsigned char* Ub = w_Ub(p) + 16 * j16;
  {
    u32x4 uA[4], uB[4];
    u32x4 eA = list[0], eB = list[1];
#pragma unroll
    for (int i = 0; i < 4; ++i) uA[i] = *(const u32x4*)(Ub + (size_t)eA[0] * DM + 256 * i);
#pragma unroll
    for (int i = 0; i < 4; ++i) uB[i] = *(const u32x4*)(Ub + (size_t)eB[0] * DM + 256 * i);
#define PEER_USTEP(U, E, K)                                                                                            \
    {                                                                                                                  \
      const float su = __uint_as_float(E[1]), gsv = __uint_as_float(E[2]);                                             \
      int d0 = 0, d1 = 0;                                                                                              \
      d0 = dot16i(U[0], x[0], d0); d1 = dot16i(U[1], x[1], d1); d0 = dot16i(U[2], x[2], d0); d1 = dot16i(U[3], x[3], d1); \
      E = list[(K) + 2 < 128 ? (K) + 2 : 127];                       \
      _Pragma("unroll") for (int i = 0; i < 4; ++i) U[i] = *(const u32x4*)(Ub + (size_t)E[0] * DM + 256 * i);          \
      const float c = gsv * gelu_fast(su * (float)dpp_add16i(d0 + d1));                                                \
      if (j16 == 0) ((float*)&list[K])[3] = c;                                                                          \
    }
#pragma unroll 1
    for (int k = 0; k < 128; k += 2) {
      PEER_USTEP(uA, eA, k)
      PEER_USTEP(uB, eB, k + 1)
    }
  }
  }
  if constexpr (PART != 1) {
  LDS_WAIT();
  const unsigned char* Vb = w_Vb(p) + 16 * j16;
  f32x2 acc[32];
#pragma unroll
  for (int i = 0; i < 32; ++i) acc[i] = (f32x2){0.f, 0.f};
  {
    u32x4 vA[4], vB[4];
    u32x4 eA = list[0], eB = list[1];
#pragma unroll
    for (int i = 0; i < 4; ++i) vA[i] = *(const u32x4*)(Vb + (size_t)eA[0] * DM + 256 * i);
#pragma unroll
    for (int i = 0; i < 4; ++i) vB[i] = *(const u32x4*)(Vb + (size_t)eB[0] * DM + 256 * i);
#define PEER_VSTEP(V, E, K)                                                                                            \
    {                                                                                                                  \
      const float c = __uint_as_float(E[3]);                                                                           \
      const f32x2 c2 = {c, c};                                                                                         \
      _Pragma("unroll") for (int i = 0; i < 4; ++i) axpy16p(acc + 8 * i, V[i], c2);                                    \
      E = list[(K) + 2 < 128 ? (K) + 2 : 127];                                                                         \
      _Pragma("unroll") for (int i = 0; i < 4; ++i) V[i] = *(const u32x4*)(Vb + (size_t)E[0] * DM + 256 * i);          \
    }
#pragma unroll 1
    for (int k = 0; k < 128; k += 2) {
      PEER_VSTEP(vA, eA, k)
      PEER_VSTEP(vB, eB, k + 1)
    }
  }
  const float* x1 = w_X1(p) + (size_t)token * DM + 16 * j16;
  const float* g2 = w_MOD(p) + (size_t)cond_row(token) * 6144 + 5120 + 16 * j16;
  float* y = p.out + O_YP + (size_t)token * DM + 16 * j16;
  f32x4 xv[16], gv[16];
#pragma unroll
  for (int k = 0; k < 16; ++k) { const int c0 = 256 * (k >> 2) + 4 * (k & 3); xv[k] = *(const f32x4*)(x1 + c0); gv[k] = *(const f32x4*)(g2 + c0); }
#pragma unroll
  for (int k = 0; k < 16; ++k) {
    const int c0 = 256 * (k >> 2) + 4 * (k & 3);
    f32x4 yv;
#pragma unroll
    for (int j = 0; j < 4; ++j) yv[j] = xv[k][j] + gv[k][j] * acc[2 * k + (j >> 1)][j & 1];
    *(f32x4*)(y + c0) = yv;
  }
  }
}
DI void peer_token_block(const P& p, int token, char* smem) {
  const int t = threadIdx.x + opaque0(), lane = t & 63, w = t >> 6;
  float* red = (float*)smem;
  const u32x4 x8 = *(const u32x4*)(w_H8(p) + (size_t)token * DM + 16 * lane);
  const int myid = w_IDX(p)[(size_t)token * 128 + 32 * w + (lane & 31)];
  const float mysu = w_SU(p)[myid] * w_HS(p)[token];
  const float mygs = w_GATE(p)[(size_t)token * 128 + 32 * w + (lane & 31)] * w_SV(p)[myid];
  float o[16];
#pragma unroll
  for (int i = 0; i < 16; ++i) o[i] = 0.f;
#pragma unroll 1
  for (int e0 = 0; e0 < 32; e0 += 8) {
    u32x4 u8[8], v8[8];
#pragma unroll
    for (int qq = 0; qq < 8; ++qq) {
      const size_t ro = (size_t)__builtin_amdgcn_readlane(myid, e0 + qq) * DM + 16 * lane;
      u8[qq] = *(const u32x4*)(w_Ub(p) + ro); v8[qq] = *(const u32x4*)(w_Vb(p) + ro);
    }
#pragma unroll
    for (int hb = 0; hb < 2; ++hb) {
      float d[4];
#pragma unroll
      for (int qq = 0; qq < 4; ++qq) d[qq] = (float)dot16i(u8[4 * hb + qq], x8, 0);
      const float kv = reduce4(d, lane);
#pragma unroll
      for (int qq = 0; qq < 4; ++qq) {
        const int e = e0 + 4 * hb + qq;
        const float a = __int_as_float(__builtin_amdgcn_readlane(__float_as_int(kv), 16 * qq)) * __int_as_float(__builtin_amdgcn_readlane(__float_as_int(mysu), e));
        const float c = __int_as_float(__builtin_amdgcn_readlane(__float_as_int(mygs), e)) * gelu_fast(a);
        axpy16(o, v8[4 * hb + qq], c);
      }
    }
  }
  __syncthreads();
#pragma unroll
  for (int i = 0; i < 16; ++i) red[w * 1024 + 16 * lane + i] = o[i];
  __syncthreads();
  if (w == 0) {
    const float* x1 = w_X1(p) + (size_t)token * DM + 16 * lane;
    const float* g2 = w_MOD(p) + (size_t)cond_row(token) * 6144 + 5120 + 16 * lane;
    float* y = p.out + O_YP + (size_t)token * DM + 16 * lane;
    f32x4 xv[4], gv[4];
#pragma unroll
    for (int mm = 0; mm < 4; ++mm) { xv[mm] = *(const f32x4*)(x1 + 4 * mm); gv[mm] = *(const f32x4*)(g2 + 4 * mm); }
#pragma unroll
    for (int mm = 0; mm < 4; ++mm) {
      f32x4 yv;
#pragma unroll
      for (int j = 0; j < 4; ++j) { const int c = 16 * lane + 4 * mm + j; yv[j] = xv[mm][j] + gv[mm][j] * (red[c] + red[1024 + c] + red[2048 + c] + red[3072 + c]); }
      *(f32x4*)(y + 4 * mm) = yv;
    }
  }
}

constexpr int NPHASE = 8;

#if defined(PROBE_ATTN) || defined(PROBE_SAMP)
DI int probe_token(int i) { return (i * 131 + 3) % NPR; }
DI float block_sum_p(float v, float* red) {
  __syncthreads();
  v = wave_sum(v);
  if ((threadIdx.x & 63) == 0) red[threadIdx.x >> 6] = v;
  __syncthreads();
  return red[0] + red[1] + red[2] + red[3];
}
DI float block_max_p(float v, float* red) {
  __syncthreads();
  for (int o = 32; o >= 1; o >>= 1) v = fmaxf(v, __shfl_xor(v, o));
  if ((threadIdx.x & 63) == 0) red[threadIdx.x >> 6] = v;
  __syncthreads();
  return fmaxf(fmaxf(red[0], red[1]), fmaxf(red[2], red[3]));
}
#endif
#ifdef PROBE_ATTN
DI void probe_attn(const P& p, int i, char* smem) {
  float* red = (float*)smem;
  float* pr = red + 4;
  float* attn = pr + 128;
  float* rr = attn + 1024;
  const int token = probe_token(i), b = token >> 11, pos = token & 2047, t = threadIdx.x;
  const bf16* prow = w_PROJ(p) + (size_t)token * INW;
  for (int head = 0; head < 16; ++head) {
    const int hk = head >> 3;
    float s = -INFINITY;
    const int kp = pos - 127 + (t & 127);
    if (t < 128 && kp >= 0) {
      float a = 0.f;
      const bf16* kr = w_PROJ(p) + ((size_t)b * SEQ + kp) * INW + C_K + hk * 64;
      for (int d = 0; d < 64; ++d) a += bf2f(prow[head * 64 + d]) * bf2f(kr[d]);
      s = a + w_BIAS(p)[head * 128 + (pos - kp)];
    }
    float m = block_max_p(s, red);
    m = fmaxf(m, p.sinks[head]);
    const float e = (t < 128 && kp >= 0) ? __expf(s - m) : 0.f;
    const float den = block_sum_p(e, red) + __expf(p.sinks[head] - m);
    if (t < 128) pr[t] = e / den;
    __syncthreads();
    if (t < 64) {
      float o = 0.f;
      for (int j = 0; j < 128; ++j) { const int kq = pos - 127 + j; if (kq >= 0) o += pr[j] * bf2f(w_VT(p)[((size_t)(b * 2 + hk) * 64 + t) * SEQ + kq]); }
      attn[head * 64 + t] = o;
    }
    __syncthreads();
  }
  for (int c = t; c < 512; c += 256) {
    const int g = c >> 7, win = 2 << g;
    float tot = 0.f;
    for (int j = 0; j < win; ++j) if (pos - j >= 0) tot += bf2f(w_PROJ(p)[((size_t)b * SEQ + pos - j) * INW + C_PIN + c]);
    const float cnt = (float)(win < pos + 1 ? win : pos + 1);
    rr[c] = bf2f((bf16)(tot / cnt - bf2f(prow[C_PIN + c])));
  }
  __syncthreads();
  for (int f = t; f < 1024; f += 256) {
    const int g = f >> 8;
    float pl = 0.f;
    for (int ch = 0; ch < 128; ++ch) pl += rr[g * 128 + ch] * bf2f(w_PWt(p)[((size_t)g * 256 + (f & 255)) * 128 + ch]);
    const float naive = bf2f(prow[C_GA + f]) * attn[f] + bf2f(prow[C_GB + f]) * (pl * p.pool_scale[f]);
    const float fast = bf2f(w_MIXED(p)[(size_t)token * DM + f]);
    p.out[O_KWP + (size_t)i * DM + f] += (float)(PROBE_ATTN) * (fast - naive);
  }
  __syncthreads();
}
#endif

#ifdef PROBE_SAMP
DI void probe_samp(const P& p, int b, char* smem) {
  float* red = (float*)smem;
  float* pr = red + 4;
  float* attn = pr + 128;
  float* rr = attn + 1024;
  const int t = threadIdx.x;
  const size_t token = (size_t)NPR + b;
  const bf16* prow = w_PROJ(p) + token * INW;
  for (int head = 0; head < 16; ++head) {
    const int hk = head >> 3;
    float s = -INFINITY;
    if (t < 128) {
      const float* kr = t < 127 ? p.cache_k + (((size_t)b * 128 + t + 1) * 2 + hk) * 64 : p.out + O_KWS + (((size_t)b * 128 + 127) * 2 + hk) * 64;
      float a = 0.f;
      for (int d = 0; d < 64; ++d) a += bf2f(prow[head * 64 + d]) * kr[d];
      s = a + p.rel_table[(127 - t < 16 ? 127 - t : min(31, 16 + (int)(logf((float)(127 - t) / 16.f) / logf(8.f) * 16.f))) * 16 + head];
    }
    float m = block_max_p(s, red);
    m = fmaxf(m, p.sinks[head]);
    const float e = t < 128 ? __expf(s - m) : 0.f;
    const float den = block_sum_p(e, red) + __expf(p.sinks[head] - m);
    if (t < 128) pr[t] = e / den;
    __syncthreads();
    if (t < 64) {
      float o = 0.f;
      for (int j = 0; j < 128; ++j) { const float* vr = j < 127 ? p.cache_v + (((size_t)b * 128 + j + 1) * 2 + hk) * 64 : p.out + O_VWS + (((size_t)b * 128 + 127) * 2 + hk) * 64; o += pr[j] * vr[t]; }
      attn[head * 64 + t] = o;
    }
    __syncthreads();
  }
  for (int c = t; c < 512; c += 256) {
    const int g = c >> 7, win = 2 << g;
    const float cur = p.out[O_PS + ((size_t)b * 15 + 14) * 512 + c];
    float tot = cur;
    for (int j = 1; j < win; ++j) tot += p.state_pool[((size_t)b * 15 + 15 - j) * 512 + c];
    rr[c] = tot / (float)win - cur;
  }
  __syncthreads();
  for (int f = t; f < 1024; f += 256) {
    const int g = f >> 8;
    float pl = 0.f;
    for (int ch = 0; ch < 128; ++ch) pl += rr[g * 128 + ch] * p.pool_w[((size_t)g * 128 + ch) * 256 + (f & 255)];
    const float naive = bf2f(prow[C_GA + f]) * attn[f] + bf2f(prow[C_GB + f]) * (pl * p.pool_scale[f]);
    const float fast = bf2f(w_MIXED(p)[token * DM + f]);
    p.out[O_KWP + (size_t)b * DM + f] += (float)(PROBE_SAMP) * (fast - naive);
  }
  __syncthreads();
}
#endif
template <class First, class Main, class Fill> DI void run_with_filler(int G, int bid, int nmain, int nfill, First firstf, Main mainf, Fill fillf) {
  if (bid < nmain) { __syncthreads(); firstf(bid); }
  for (int u = bid; u < nmain; u += G) mainf(u, u + G < nmain ? u + G : -1);
  const int rem = nmain % G;
  if (rem == 0) { for (int f = bid; f < nfill; f += G) fillf(f); }
  else if (bid >= rem) { for (int f = bid - rem; f < nfill; f += G - rem) fillf(f); }
}
template <int PH> DI void run_phase(const P& p, char* smem) {
  const int G = gridDim.x, bid = blockIdx.x, w = __builtin_amdgcn_readfirstlane(threadIdx.x >> 6);
  if constexpr (PH == 0) { run_with_filler(G, bid, U0_MOD, F0_TOTAL, [&](int) {}, [&](int u, int) { unit_mod(p, u, smem); }, [&](int f) { phase0_filler(p, f, smem); }); }
  if constexpr (PH == 1) norm_phase(p, 0);
  if constexpr (PH == 2) {
    run_with_filler(G, bid, 129 * 30, F2_TOTAL, [&](int u) { int mt, nt; gemm1_map(u, mt, nt); gemm_first(w_Wt_in(p), w_H(p), 1024, nt * 128, mt * 128, smem); },
                    [&](int u, int un) { unit_gemm1(p, u, un, smem); }, [&](int f) { phase2_filler(p, f, smem); });
  }
  if constexpr (PH == 3) { for (int u = bid; u < 1024; u += G) unit_attn_prompt(p, u, smem);
                           for (int u = bid; u < 512; u += G) unit_attn_sample(p, u, smem); }
  if constexpr (PH == 4) {
    run_with_filler(G, bid, G2_UNITS, F4_TOTAL, [&](int u) { gemm2_first(p, u, smem); },
                    [&](int u, int un) { unit_gemm2(p, u, un, smem); }, [&](int f) { unit_convert(p.sub_keys, w_SK(p), f); });
  }
  if constexpr (PH == 5) norm_phase(p, 1);
  if constexpr (PH == 6) {
    run_with_filler(G, bid, 129 * 8, F6_TOTAL, [&](int u) { int mt, hd; unit8_map(u, mt, hd); gemm_first(w_Wt_q(p), w_H(p), 1024, hd * 256, mt * 128, smem); },
                    [&](int u, int un) { unit_peer_route(p, u, un, smem); }, [&](int f) { if (f < F6_QU) unit_quant_rows<true>(p.peer_u, w_Ub(p), w_SU(p), f); else unit_quant_rows<false>(p.peer_v, w_Vb(p), w_SV(p), f - F6_QU); });
  }
  if constexpr (PH == 7) {
    for (int g = bid * 4 + w; g < NPR / 4; g += G * 4) peer_wave4<0>(p, g, smem + w * PEER_WLDS);
    for (int s = bid; s < NS; s += G) peer_token_block(p, NPR + s, smem + 4 * PEER_WLDS);
  }
}
#if ONE_LAUNCH
__global__ void __launch_bounds__(NTHREADS, 2) mega(P p) {
  __shared__ __attribute__((aligned(16))) char smem[SMEM_BYTES + 16];
  volatile unsigned* st = (volatile unsigned*)(smem + SMEM_BYTES);
  if (threadIdx.x == 0) { st[0] = 0u; st[1] = 0u; }
  __syncthreads();
  const unsigned xcc = xb_xcc_id();
  if (threadIdx.x == 0) (void)xb_add(&w_bar(p)[XB_XCNT(xcc)], 1u);
#ifndef REPEAT_MASK
#define REPEAT_MASK 0
#endif
#define RUN_PH(k) do { run_phase<k>(p, smem); if ((REPEAT_MASK >> k) & 1) { xcd_barrier(w_bar(p), xcc, st); run_phase<k>(p, smem); } } while (0)
  RUN_PH(0); xcd_barrier(w_bar(p), xcc, st);
  RUN_PH(1); xcd_barrier(w_bar(p), xcc, st);
  RUN_PH(2); xcd_barrier(w_bar(p), xcc, st);
  RUN_PH(3); xcd_barrier(w_bar(p), xcc, st);
#ifdef PROBE_ATTN
  for (int i = blockIdx.x; i < 128; i += gridDim.x) probe_attn(p, i, smem);
  xcd_barrier(w_bar(p), xcc, st);
#endif
#ifdef PROBE_SAMP
  for (int i = blockIdx.x; i < 128; i += gridDim.x) probe_samp(p, i, smem);
  xcd_barrier(w_bar(p), xcc, st);
#endif
  RUN_PH(4); xcd_barrier(w_bar(p), xcc, st);
  RUN_PH(5); xcd_barrier(w_bar(p), xcc, st);
  RUN_PH(6); xcd_barrier(w_bar(p), xcc, st);
#if PEER_ALIGN
  { const int G = gridDim.x, bid = blockIdx.x, w = __builtin_amdgcn_readfirstlane(threadIdx.x >> 6);
    for (int g = bid * 4 + w, it = 0; it < (NPR / 4 + G * 4 - 1) / (G * 4); g += G * 4, ++it) {
      if (it > 0) xcd_barrier(w_bar(p), xcc, st);
      if (g < NPR / 4) peer_wave4<1>(p, g, smem + w * PEER_WLDS);
#if PEER_ALIGN > 1
      xcd_barrier(w_bar(p), xcc, st);
#endif
      if (g < NPR / 4) peer_wave4<2>(p, g, smem + w * PEER_WLDS);
    }
    for (int s = bid; s < NS; s += G) peer_token_block(p, NPR + s, smem + 4 * PEER_WLDS); }
#else
  RUN_PH(7);
#endif
}
#else
template <int PH> __global__ void __launch_bounds__(NTHREADS, 2) mega(P p) {
  __shared__ __attribute__((aligned(16))) char smem[SMEM_BYTES];
  run_phase<PH>(p, smem);
}
#endif


extern "C" void kernel_launch(void* const* d_in, const int* in_sizes, int n_in, void* d_out, int out_size, void* d_ws, size_t ws_size, hipStream_t stream) {
  P p{};
  const float* const* in = (const float* const*)d_in;
  p.x_prompt = in[0]; p.x_sample = in[1]; p.cache_k = in[2]; p.cache_v = in[3]; p.state_pool = in[4]; p.c_prompt = in[5]; p.c_sample = in[6];
  p.rel_table = in[7]; p.ada_w = in[8]; p.ada_b = in[9]; p.norm1_g = in[10]; p.w_in = in[11]; p.q_norm_g = in[12]; p.k_norm_g = in[13]; p.sinks = in[14];
  p.pool_w = in[15]; p.pool_scale = in[16]; p.w_out = in[17]; p.norm2_g = in[18]; p.w_query = in[19]; p.sub_keys = in[20]; p.peer_u = in[21]; p.peer_v = in[22];
  p.out = (float*)d_out;
  p.ws = (char*)d_ws;
  if (WS_NEED > ws_size) { fprintf(stderr, "workspace too small: need %zu have %zu\n", (size_t)WS_NEED, ws_size); return; }

  static int grid_blocks = 0;
  if (!grid_blocks) {
    int dev = 0, cus = 0, per_cu = 0;
    (void)hipGetDevice(&dev);
    (void)hipDeviceGetAttribute(&cus, hipDeviceAttributeMultiprocessorCount, dev);
#if ONE_LAUNCH
    (void)hipOccupancyMaxActiveBlocksPerMultiprocessor(&per_cu, mega, NTHREADS, 0);
#else
    per_cu = 2;
#endif
    if (per_cu > 2) per_cu = 2;
    if (per_cu < 1) per_cu = 1;
    if (cus < 1) cus = 256;
    grid_blocks = cus * per_cu;
  }
#if ONE_LAUNCH
  (void)hipMemsetAsync(p.ws + OFF_BAR, 0, XCD_BAR_WORDS * 4, stream);
  hipLaunchKernelGGL(mega, dim3(grid_blocks), dim3(NTHREADS), 0, stream, p);
#else
  hipLaunchKernelGGL(mega<0>, dim3(grid_blocks), dim3(NTHREADS), 0, stream, p);
  hipLaunchKernelGGL(mega<1>, dim3(grid_blocks), dim3(NTHREADS), 0, stream, p);
  hipLaunchKernelGGL(mega<2>, dim3(grid_blocks), dim3(NTHREADS), 0, stream, p);
  hipLaunchKernelGGL(mega<3>, dim3(grid_blocks), dim3(NTHREADS), 0, stream, p);
  hipLaunchKernelGGL(mega<4>, dim3(grid_blocks), dim3(NTHREADS), 0, stream, p);
  hipLaunchKernelGGL(mega<5>, dim3(grid_blocks), dim3(NTHREADS), 0, stream, p);
  hipLaunchKernelGGL(mega<6>, dim3(grid_blocks), dim3(NTHREADS), 0, stream, p);
  hipLaunchKernelGGL(mega<7>, dim3(grid_blocks), dim3(NTHREADS), 0, stream, p);
#endif

}
```

```cpp
#include <hip/hip_runtime.h>
#include <stdint.h>
#include <stdio.h>

#ifndef ONE_LAUNCH
#define ONE_LAUNCH 1
#endif
#ifndef EARLY_INV
#define EARLY_INV 1
#endif
#ifndef PEER_ALIGN
#define PEER_ALIGN 1
#endif

typedef __bf16 bf16;
typedef __bf16 bf16x2 __attribute__((ext_vector_type(2)));
typedef __bf16 bf16x4 __attribute__((ext_vector_type(4)));
typedef __bf16 bf16x8 __attribute__((ext_vector_type(8)));
typedef float f32x2 __attribute__((ext_vector_type(2)));
typedef float f32x4 __attribute__((ext_vector_type(4)));
typedef float f32x16 __attribute__((ext_vector_type(16)));
typedef unsigned u32x2 __attribute__((ext_vector_type(2)));
typedef unsigned u32x4 __attribute__((ext_vector_type(4)));

#define DI __device__ __forceinline__
#define MFMA(a, b, c) __builtin_amdgcn_mfma_f32_32x32x16_bf16((a), (b), (c), 0, 0, 0)

constexpr int DM = 1024, NB = 8, SEQ = 2048, NS = 128, NPR = NB * SEQ, NTOK = NPR + NS;
constexpr int INW = 3840, NMOD = NB + NS;
constexpr int C_K = 1024, C_V = 1152, C_PIN = 1280, C_GA = 1792, C_GB = 2816;
constexpr int NEXP = 16384;
constexpr float EPS = 1e-6f;
constexpr size_t O_YP = 0, O_KWP = 16908288, O_VWP = 17039360, O_PP = 17170432, O_KWS = 17231872, O_VWS = 19329024, O_PS = 21426176;

constexpr int SMEM_BYTES = 77824;
constexpr int NTHREADS = 256;

struct P {
  const float *x_prompt, *x_sample, *cache_k, *cache_v, *state_pool, *c_prompt, *c_sample, *rel_table, *ada_w, *ada_b, *norm1_g, *w_in,
      *q_norm_g, *k_norm_g, *sinks, *pool_w, *pool_scale, *w_out, *norm2_g, *w_query, *sub_keys, *peer_u, *peer_v;
  float* out;
  char* ws;
};
constexpr size_t al256(size_t x) { return (x + 255) & ~(size_t)255; }
constexpr size_t OFF_BAR = 0;
constexpr size_t OFF_WTIN = OFF_BAR + al256(4096 * 4);
constexpr size_t OFF_WTOUT = OFF_WTIN + al256((size_t)INW * 1024 * 2);
constexpr size_t OFF_WTQ = OFF_WTOUT + al256((size_t)1024 * 1024 * 2);
constexpr size_t OFF_SK = OFF_WTQ + al256((size_t)2048 * 1024 * 2);
constexpr size_t OFF_PWT = OFF_SK + al256((size_t)16 * 128 * 128 * 2);
constexpr size_t OFF_UB = OFF_PWT + al256((size_t)4 * 256 * 128 * 2);
constexpr size_t OFF_VB = OFF_UB + al256((size_t)NEXP * DM);
constexpr size_t OFF_SU = OFF_VB + al256((size_t)NEXP * DM);
constexpr size_t OFF_SV = OFF_SU + al256((size_t)NEXP * 4);
constexpr size_t OFF_H8 = OFF_SV + al256((size_t)NEXP * 4);
constexpr size_t OFF_HS = OFF_H8 + al256((size_t)NTOK * DM);
constexpr size_t OFF_PART = OFF_HS + al256((size_t)NTOK * 4);
constexpr size_t OFF_MOD = OFF_PART + al256((size_t)4 * NS * DM * 4);
constexpr size_t OFF_BIAS = OFF_MOD + al256((size_t)NMOD * 6144 * 4);
constexpr size_t OFF_VT = OFF_BIAS + al256(16 * 128 * 4);
constexpr size_t OFF_H = OFF_VT + al256((size_t)NB * 128 * SEQ * 2);
constexpr size_t OFF_MIXED = OFF_H;
constexpr size_t OFF_PROJ = OFF_H + al256((size_t)NTOK * DM * 2);
constexpr size_t OFF_X1 = OFF_PROJ;
constexpr size_t OFF_IDX = OFF_X1 + (size_t)NTOK * DM * 4;
constexpr size_t OFF_GATE = OFF_IDX + (size_t)NTOK * 128 * 4;
constexpr size_t WS_NEED = OFF_PROJ + al256((size_t)NTOK * INW * 2);
static_assert(OFF_GATE + (size_t)NTOK * 128 * 4 <= WS_NEED, "overlay fits");
static_assert(WS_NEED <= (size_t)256 * 1024 * 1024, "workspace budget");
#define WS_PTR(T, name, OFF) __device__ __forceinline__ T* name(const P& p) { return (T*)(p.ws + (OFF)); }
WS_PTR(unsigned, w_bar, OFF_BAR) WS_PTR(bf16, w_Wt_in, OFF_WTIN) WS_PTR(bf16, w_Wt_out, OFF_WTOUT) WS_PTR(bf16, w_Wt_q, OFF_WTQ) WS_PTR(bf16, w_SK, OFF_SK)
WS_PTR(bf16, w_PWt, OFF_PWT) WS_PTR(unsigned char, w_Ub, OFF_UB) WS_PTR(unsigned char, w_Vb, OFF_VB) WS_PTR(float, w_SU, OFF_SU) WS_PTR(float, w_SV, OFF_SV) WS_PTR(unsigned char, w_H8, OFF_H8) WS_PTR(float, w_HS, OFF_HS) WS_PTR(float, w_PART, OFF_PART) WS_PTR(float, w_MOD, OFF_MOD) WS_PTR(float, w_BIAS, OFF_BIAS)
WS_PTR(bf16, w_VT, OFF_VT) WS_PTR(bf16, w_H, OFF_H) WS_PTR(bf16, w_MIXED, OFF_MIXED) WS_PTR(bf16, w_PROJ, OFF_PROJ) WS_PTR(float, w_X1, OFF_X1)
WS_PTR(int, w_IDX, OFF_IDX) WS_PTR(float, w_GATE, OFF_GATE)

DI int cond_row(int token) { return token < NPR ? (token >> 11) : (NB + token - NPR); }
DI int crow(int reg, int h) { return (reg & 3) + 8 * (reg >> 2) + 4 * h; }
DI const float* xrow(const P& p, int token) { return token < NPR ? p.x_prompt + (size_t)token * DM : p.x_sample + (size_t)(token - NPR) * DM; }

#define LDS_WAIT() asm volatile("s_waitcnt lgkmcnt(0)" ::: "memory")
DI int opaque0() { int z = 0; asm volatile("" : "+v"(z)); return z; }
DI float bf2f(bf16 v) { return (float)v; }
DI f32x16 zero16() { f32x16 z; for (int i = 0; i < 16; ++i) z[i] = 0.f; return z; }
DI bf16x8 pack_step(const f32x16& x, int s) { bf16x8 v; for (int j = 0; j < 8; ++j) v[j] = (bf16)x[8 * s + j]; return v; }
DI bf16x8 cat4(bf16x4 lo, bf16x4 hi) { return __builtin_shufflevector(lo, hi, 0, 1, 2, 3, 4, 5, 6, 7); }
DI float wave_sum(float v) { for (int o = 32; o >= 1; o >>= 1) v += __shfl_xor(v, o); return v; }

#define XB_TMO 128
#define XB_XCNT(j) (256 + 64 * (j))
#define XB_XSUB(j) (1280 + 64 * (j))
#define XB_XGEN(j) (2304 + 64 * (j))
#define XB_TOP 3328
#define XB_TOPGEN 3392
#define XCD_BAR_WORDS 3456
#define XB_SPIN_CAP (1u << 22)
DI unsigned xb_ld(unsigned* p) { return __hip_atomic_load(p, __ATOMIC_RELAXED, __HIP_MEMORY_SCOPE_AGENT); }
DI unsigned xb_add(unsigned* p, unsigned v) { return __hip_atomic_fetch_add(p, v, __ATOMIC_RELAXED, __HIP_MEMORY_SCOPE_AGENT); }
DI unsigned xb_xcc_id() { return (unsigned)__builtin_amdgcn_s_getreg((3 << 11) | 20) & 0xFu; }
#define XB_SPIN(cond, bar) do { unsigned _sp = 0; while (cond) { __builtin_amdgcn_s_sleep(1); \
    if ((++_sp & 255u) == 0u) { if (xb_ld(&(bar)[XB_TMO])) break; if (_sp > XB_SPIN_CAP) { atomicAdd(&(bar)[XB_TMO], 1u); break; } } } } while (0)

DI void xcd_barrier_complete(unsigned* bar, unsigned x, unsigned& nloc, unsigned& nx) {
  const unsigned G = gridDim.x;
  unsigned sum, cnt, mine, sp = 0u;
  for (;;) {
    sum = 0u; cnt = 0u; mine = 0u;
#pragma unroll
    for (unsigned j = 0; j < 16; ++j) { const unsigned c = xb_ld(&bar[XB_XCNT(j)]); sum += c; cnt += (c > 0u) ? 1u : 0u; mine = (j == x) ? c : mine; }
    if (sum == G) break;
    __builtin_amdgcn_s_sleep(1);
    if ((++sp & 255u) == 0u) { if (xb_ld(&bar[XB_TMO])) break; if (sp > XB_SPIN_CAP) { atomicAdd(&bar[XB_TMO], 1u); break; } }
  }
  nloc = mine > 0u ? mine : 1u; nx = cnt > 0u ? cnt : 1u;
}
DI void xcd_barrier(unsigned* bar, unsigned x, volatile unsigned* st) {
  asm volatile("s_waitcnt vmcnt(0)" ::: "memory");
  __syncthreads();
  if (threadIdx.x == 0) {
    __builtin_amdgcn_s_waitcnt(0);
    unsigned nloc = st[0], nx = st[1];
    if (nloc == 0u) { xcd_barrier_complete(bar, x, nloc, nx); st[0] = nloc; st[1] = nx; }
    const unsigned old = xb_add(&bar[XB_XSUB(x)], 1u);
    const unsigned gen = old / nloc;
    const bool leader = old + 1u == (gen + 1u) * nloc;
    if (leader) {
      __builtin_amdgcn_fence(__ATOMIC_RELEASE, "agent");
      asm volatile("s_waitcnt vmcnt(0)" ::: "memory");
    }
    if (leader) {
      const unsigned og = xb_add(&bar[XB_TOP], 1u);
      const unsigned tg = og / nx;
      if (og + 1u == (tg + 1u) * nx) xb_add(&bar[XB_TOPGEN], 1u);
      else XB_SPIN(xb_ld(&bar[XB_TOPGEN]) == tg, bar);
      xb_add(&bar[XB_XGEN(x)], 1u);
      __builtin_amdgcn_fence(__ATOMIC_ACQUIRE, "agent");
    } else {
#if EARLY_INV
      __builtin_amdgcn_fence(__ATOMIC_ACQUIRE, "agent");
#endif
      XB_SPIN(xb_ld(&bar[XB_XGEN(x)]) == gen, bar);
#if !EARLY_INV
      __builtin_amdgcn_fence(__ATOMIC_ACQUIRE, "agent");
#endif
    }
    asm volatile("s_waitcnt vmcnt(0)" ::: "memory");
  }
  __syncthreads();
}

constexpr int U0_MOD = 192;
constexpr int U0_TIN = (1024 / 64) * (INW / 64);
constexpr int F0_TOTAL = U0_TIN + 1;
constexpr int U0_TPW = 4 * 2 * 4;
constexpr int U0_CSK = 32;
constexpr int U0_KW = 128, U0_VW = 128, U0_PW = 128;
constexpr int F2_TOUT = 16 * 16, F2_TQ = 16 * 32, F2_E1 = F2_TOUT + F2_TQ, F2_E2 = F2_E1 + U0_TPW, F2_E3 = F2_E2 + U0_KW, F2_E4 = F2_E3 + U0_VW,
              F2_TOTAL = F2_E4 + U0_PW;
constexpr int F4_TOTAL = U0_CSK;
constexpr int F6_QU = 2048, F6_QV = 2048, F6_TOTAL = F6_QU + F6_QV;

DI float silu_f(float x) { return x * __builtin_amdgcn_rcpf(1.f + __expf(-x)); }

DI void unit_mod(const P& p, int u, char* smem) {
  const int t = threadIdx.x + opaque0(), lane = t & 63, w = t >> 6, r = lane & 31, h = lane >> 5;
  const int f0 = u * 32;
  f32x16 acc[5];
#pragma unroll
  for (int i = 0; i < 5; ++i) acc[i] = zero16();
  const float* wp = p.ada_w + (size_t)(w * 256 + 8 * h) * 6144 + f0 + r;
  const float* cp[5];
#pragma unroll
  for (int i = 0; i < 5; ++i) { const int m = 32 * i + r, mm = m < NMOD ? m : 0; cp[i] = (mm < NB ? p.c_prompt + (size_t)mm * DM : p.c_sample + (size_t)(mm - NB) * DM) + w * 256 + 8 * h; }
  float wv[8]; f32x4 cv[5][2];
#pragma unroll
  for (int j = 0; j < 8; ++j) wv[j] = wp[(size_t)j * 6144];
#pragma unroll
  for (int i = 0; i < 5; ++i) { cv[i][0] = *(const f32x4*)cp[i]; cv[i][1] = *(const f32x4*)(cp[i] + 4); }
#pragma unroll 1
  for (int ks = 0; ks < 16; ++ks) {
    bf16x8 bfr, afr[5];
#pragma unroll
    for (int j = 0; j < 8; ++j) bfr[j] = (bf16)wv[j];
#pragma unroll
    for (int i = 0; i < 5; ++i) {
      const bool ok = 32 * i + r < NMOD;
#pragma unroll
      for (int j = 0; j < 8; ++j) afr[i][j] = (bf16)(ok ? silu_f(cv[i][j >> 2][j & 3]) : 0.f);
    }
    const int kn = ks + 1 < 16 ? ks + 1 : 15;
#pragma unroll
    for (int j = 0; j < 8; ++j) wv[j] = wp[(size_t)(kn * 16 + j) * 6144];
#pragma unroll
    for (int i = 0; i < 5; ++i) { cv[i][0] = *(const f32x4*)(cp[i] + kn * 16); cv[i][1] = *(const f32x4*)(cp[i] + kn * 16 + 4); }
#pragma unroll
    for (int i = 0; i < 5; ++i) acc[i] = MFMA(afr[i], bfr, acc[i]);
  }
  float* red = (float*)smem;
  __syncthreads();
  if (w > 0) {
#pragma unroll
    for (int i = 0; i < 5; ++i)
#pragma unroll
      for (int j = 0; j < 16; ++j) red[((w - 1) * 80 + i * 16 + j) * 64 + lane] = acc[i][j];
  }
  __syncthreads();
  if (w == 0) {
    const float bias = p.ada_b[f0 + r];
#pragma unroll
    for (int i = 0; i < 5; ++i)
#pragma unroll
      for (int j = 0; j < 16; ++j) {
        const int m = 32 * i + crow(j, h);
        const float v = acc[i][j] + red[(0 * 80 + i * 16 + j) * 64 + lane] + red[(1 * 80 + i * 16 + j) * 64 + lane] + red[(2 * 80 + i * 16 + j) * 64 + lane] + bias;
        if (m < NMOD) w_MOD(p)[(size_t)m * 6144 + f0 + r] = v;
      }
  }
}

DI void unit_transpose(const float* __restrict__ src, bf16* __restrict__ dst, int R, int C, int tr, int tc, char* smem) {
  float* tile = (float*)smem;
  const int t = threadIdx.x + opaque0();
  __syncthreads();
#pragma unroll
  for (int i = 0; i < 4; ++i) {
    const int rr = (t >> 4) + 16 * i, cc = (t & 15) * 4;
    const f32x4 v = *(const f32x4*)(src + (size_t)(tr * 64 + rr) * C + tc * 64 + cc);
    tile[rr * 65 + cc] = v[0]; tile[rr * 65 + cc + 1] = v[1]; tile[rr * 65 + cc + 2] = v[2]; tile[rr * 65 + cc + 3] = v[3];
  }
  __syncthreads();
#pragma unroll
  for (int i = 0; i < 2; ++i) {
    const int orow = (t >> 3) + 32 * i, seg = (t & 7) * 8;
    bf16x8 v;
#pragma unroll
    for (int j = 0; j < 8; ++j) v[j] = (bf16)tile[(seg + j) * 65 + orow];
    *(bf16x8*)(dst + (size_t)(tc * 64 + orow) * R + tr * 64 + seg) = v;
  }
}
DI void unit_convert(const float* __restrict__ src, bf16* __restrict__ dst, int u) {
  const size_t base = (size_t)u * 8192 + (threadIdx.x + opaque0()) * 8;
  f32x4 av[4], bv[4];
#pragma unroll
  for (int i = 0; i < 4; ++i) { const size_t o = base + (size_t)i * 2048; av[i] = *(const f32x4*)(src + o); bv[i] = *(const f32x4*)(src + o + 4); }
#pragma unroll
  for (int i = 0; i < 4; ++i) {
    const size_t o = base + (size_t)i * 2048;
    const f32x4 a = av[i], b = bv[i];
    bf16x8 v; v[0] = (bf16)a[0]; v[1] = (bf16)a[1]; v[2] = (bf16)a[2]; v[3] = (bf16)a[3]; v[4] = (bf16)b[0]; v[5] = (bf16)b[1]; v[6] = (bf16)b[2]; v[7] = (bf16)b[3];
    *(bf16x8*)(dst + o) = v;
  }
}
DI unsigned pack_i8(float a, float b, float c, float d) {
  const int ia = max(-127, min(127, __float2int_rn(a))), ib = max(-127, min(127, __float2int_rn(b))), ic = max(-127, min(127, __float2int_rn(c))), id = max(-127, min(127, __float2int_rn(d)));
  return (unsigned)(ia & 255) | ((unsigned)(ib & 255) << 8) | ((unsigned)(ic & 255) << 16) | ((unsigned)(id & 255) << 24);
}
template <bool I8>
DI void unit_quant_rows(const float* __restrict__ src, unsigned char* __restrict__ dst, float* __restrict__ scale, int u) {
  const int t = threadIdx.x + opaque0(), lane = t & 63, w = t >> 6;
  f32x4 vv[2][4];
#pragma unroll
  for (int rr = 0; rr < 2; ++rr)
#pragma unroll
    for (int i = 0; i < 4; ++i) vv[rr][i] = *(const f32x4*)(src + ((size_t)u * 8 + 2 * w + rr) * DM + 16 * lane + 4 * i);
#pragma unroll
  for (int rr = 0; rr < 2; ++rr) {
    const size_t row = (size_t)u * 8 + 2 * w + rr;
    f32x4 v[4];
    float amax = 0.f;
#pragma unroll
    for (int i = 0; i < 4; ++i) { v[i] = vv[rr][i]; amax = fmaxf(amax, fmaxf(fmaxf(fabsf(v[i][0]), fabsf(v[i][1])), fmaxf(fabsf(v[i][2]), fabsf(v[i][3])))); }
#pragma unroll
    for (int o = 32; o >= 1; o >>= 1) amax = fmaxf(amax, __shfl_xor(amax, o));
    const float sc = amax > 0.f ? amax * (I8 ? 1.f / 127.f : 1.f / 440.f) : 1.f, inv = 1.f / sc;
    u32x4 q;
#pragma unroll
    for (int i = 0; i < 4; ++i) {
      if (I8) {
        q[i] = pack_i8(v[i][0] * inv, v[i][1] * inv, v[i][2] * inv, v[i][3] * inv);
      } else {
        int wd = 0;
        wd = __builtin_amdgcn_cvt_pk_fp8_f32(v[i][0] * inv, v[i][1] * inv, wd, false);
        wd = __builtin_amdgcn_cvt_pk_fp8_f32(v[i][2] * inv, v[i][3] * inv, wd, true);
        q[i] = (unsigned)wd;
      }
    }
    *(u32x4*)(dst + row * DM + 16 * lane) = q;
    if (lane == 0) scale[row] = sc;
  }
}
DI void unit_copy_f4(const float* __restrict__ src, float* __restrict__ dst, int n4) {
  for (int i0 = threadIdx.x + opaque0(); i0 < n4; i0 += 8 * NTHREADS) {
    f32x4 v[8];
#pragma unroll
    for (int k = 0; k < 8; ++k) { const int i = i0 + k * NTHREADS; v[k] = ((const f32x4*)src)[i < n4 ? i : n4 - 1]; }
#pragma unroll
    for (int k = 0; k < 8; ++k) { const int i = i0 + k * NTHREADS; if (i < n4) ((f32x4*)dst)[i] = v[k]; }
  }
}

DI void phase0_filler(const P& p, int f, char* smem) {
  if (f < U0_TIN) { unit_transpose(p.w_in, w_Wt_in(p), 1024, INW, f / 60, f % 60, smem); }
  else {
    for (int i = threadIdx.x + opaque0(); i < 16 * 128; i += NTHREADS) {
      const int head = i >> 7, d = i & 127;
      int bk = d;
      if (d >= 16) { bk = 16 + (int)(logf((float)d / 16.f) / logf(8.f) * 16.f); bk = bk > 31 ? 31 : bk; }
      w_BIAS(p)[i] = p.rel_table[bk * 16 + head];
    }
  }
}
DI void phase2_filler(const P& p, int f, char* smem) {
  if (f < F2_TOUT) unit_transpose(p.w_out, w_Wt_out(p), 1024, 1024, f / 16, f % 16, smem);
  else if (f < F2_E1) { const int v = f - F2_TOUT; unit_transpose(p.w_query, w_Wt_q(p), 1024, 2048, v / 32, v % 32, smem); }
  else if (f < F2_E2) { const int v = f - F2_E1, g = v >> 3, tt = v & 7; unit_transpose(p.pool_w + (size_t)g * 128 * 256, w_PWt(p) + (size_t)g * 256 * 128, 128, 256, tt >> 2, tt & 3, smem); }
  else if (f < F2_E3) { const int b = f - F2_E2; unit_copy_f4(p.cache_k + ((size_t)b * 128 + 1) * 128, p.out + O_KWS + (size_t)b * 128 * 128, 127 * 128 / 4); }
  else if (f < F2_E4) { const int b = f - F2_E3; unit_copy_f4(p.cache_v + ((size_t)b * 128 + 1) * 128, p.out + O_VWS + (size_t)b * 128 * 128, 127 * 128 / 4); }
  else { const int b = f - F2_E4; unit_copy_f4(p.state_pool + ((size_t)b * 15 + 1) * 512, p.out + O_PS + (size_t)b * 15 * 512, 14 * 512 / 4); }
}

template <int NR>
DI void norm_rows(const P& p, int tok0, int tstride, int which) {
  const int lane = (threadIdx.x + opaque0()) & 63;
  const float* g = which == 0 ? p.norm1_g : p.norm2_g;
  f32x4 v[NR][4], gg[4], sh[NR][4], sc[NR][4];
  float ss[NR];
#pragma unroll
  for (int i = 0; i < 4; ++i) gg[i] = *(const f32x4*)(g + 4 * lane + 256 * i);
#pragma unroll
  for (int k = 0; k < NR; ++k) {
    const int token = tok0 + k * tstride;
    const float* mod = w_MOD(p) + (size_t)cond_row(token) * 6144 + (which == 0 ? 0 : 3072);
#pragma unroll
    for (int i = 0; i < 4; ++i) { const int c = 4 * lane + 256 * i; sh[k][i] = *(const f32x4*)(mod + c); sc[k][i] = *(const f32x4*)(mod + 1024 + c); }
  }
  bool assembled = false;
  if constexpr (NR == 1) {
    if (which == 1 && tok0 >= NPR) {
      assembled = true;
      const int token = tok0;
      const float* g1 = w_MOD(p) + (size_t)cond_row(token) * 6144 + 2048;
      f32x4 xv[4], gv[4], pa[4], pb[4], pc[4], pd[4];
#pragma unroll
      for (int i = 0; i < 4; ++i) {
        const int c = 4 * lane + 256 * i;
        const size_t po = (size_t)(token - NPR) * DM + c;
        xv[i] = *(const f32x4*)(xrow(p, token) + c); gv[i] = *(const f32x4*)(g1 + c);
        pa[i] = *(const f32x4*)(w_PART(p) + po); pb[i] = *(const f32x4*)(w_PART(p) + (size_t)NS * DM + po);
        pc[i] = *(const f32x4*)(w_PART(p) + (size_t)2 * NS * DM + po); pd[i] = *(const f32x4*)(w_PART(p) + (size_t)3 * NS * DM + po);
      }
      ss[0] = 0.f;
#pragma unroll
      for (int i = 0; i < 4; ++i) {
#pragma unroll
        for (int j = 0; j < 4; ++j) v[0][i][j] = xv[i][j] + gv[i][j] * ((pa[i][j] + pb[i][j]) + (pc[i][j] + pd[i][j]));
        ss[0] += v[0][i][0] * v[0][i][0] + v[0][i][1] * v[0][i][1] + v[0][i][2] * v[0][i][2] + v[0][i][3] * v[0][i][3];
      }
#pragma unroll
      for (int i = 0; i < 4; ++i) *(f32x4*)(w_X1(p) + (size_t)token * DM + 4 * lane + 256 * i) = v[0][i];
    }
  }
  if (!assembled) {
#pragma unroll
    for (int k = 0; k < NR; ++k) {
      const int token = tok0 + k * tstride;
      const float* src = which == 0 ? xrow(p, token) : w_X1(p) + (size_t)token * DM;
#pragma unroll
      for (int i = 0; i < 4; ++i) v[k][i] = *(const f32x4*)(src + 4 * lane + 256 * i);
    }
#pragma unroll
    for (int k = 0; k < NR; ++k) {
      ss[k] = 0.f;
#pragma unroll
      for (int i = 0; i < 4; ++i) ss[k] += v[k][i][0] * v[k][i][0] + v[k][i][1] * v[k][i][1] + v[k][i][2] * v[k][i][2] + v[k][i][3] * v[k][i][3];
    }
  }
#pragma unroll
  for (int k = 0; k < NR; ++k) {
    const int token = tok0 + k * tstride;
    const float rstd = rsqrtf(wave_sum(ss[k]) * (1.f / DM) + EPS);
#pragma unroll
    for (int i = 0; i < 4; ++i) {
      const int c = 4 * lane + 256 * i;
      bf16x4 o;
#pragma unroll
      for (int j = 0; j < 4; ++j) { v[k][i][j] = (v[k][i][j] * rstd * gg[i][j]) * (1.f + sc[k][i][j]) + sh[k][i][j]; o[j] = (bf16)v[k][i][j]; }
      *(bf16x4*)(w_H(p) + (size_t)token * DM + c) = o;
    }
    if (which == 1) {
      float amax = 0.f;
#pragma unroll
      for (int i = 0; i < 4; ++i) amax = fmaxf(amax, fmaxf(fmaxf(fabsf(v[k][i][0]), fabsf(v[k][i][1])), fmaxf(fabsf(v[k][i][2]), fabsf(v[k][i][3]))));
#pragma unroll
      for (int o = 32; o >= 1; o >>= 1) amax = fmaxf(amax, __shfl_xor(amax, o));
      const float qs = amax > 0.f ? amax * (1.f / 127.f) : 1.f, inv = 1.f / qs;
#pragma unroll
      for (int i = 0; i < 4; ++i) *(unsigned*)(w_H8(p) + (size_t)token * DM + 4 * lane + 256 * i) = pack_i8(v[k][i][0] * inv, v[k][i][1] * inv, v[k][i][2] * inv, v[k][i][3] * inv);
      if (lane == 0) w_HS(p)[token] = qs;
    }
  }
}
DI void norm_phase(const P& p, int which) {
  const int G = gridDim.x, bid = blockIdx.x, w = __builtin_amdgcn_readfirstlane(threadIdx.x >> 6);
  int tk = bid * 4 + w;
  for (; tk + G * 4 < NPR; tk += 2 * G * 4) norm_rows<2>(p, tk, G * 4, which);
  for (; tk < NTOK; tk += G * 4) norm_rows<1>(p, tk, 0, which);
}

constexpr int LDSK = 72;
constexpr int GT = 128 * 64 * 2;
constexpr int GBUF = 2 * GT;
typedef __attribute__((address_space(3))) unsigned lds_u32;
typedef const __attribute__((address_space(1))) unsigned glb_u32;
DI void glds16(const void* g, char* l) { __builtin_amdgcn_global_load_lds((glb_u32*)g, (lds_u32*)l, 16, 0, 0); }
DI void gemm_first(const bf16* __restrict__ Wt, const bf16* __restrict__ X, int ld, int n0, int m0, char* smem) {
  const int t = threadIdx.x + opaque0(), lane = t & 63;
  const int w = __builtin_amdgcn_readfirstlane(t >> 6);
  const int swz = (lane & 7) ^ ((4 * w + (lane >> 4)) & 7);
  const bf16* ga = Wt + (size_t)(n0 + 8 * w + (lane >> 3)) * ld + swz * 8;
  const bf16* gb = X + (size_t)(m0 + 8 * w + (lane >> 3)) * ld + swz * 8;
#pragma unroll
  for (int q = 0; q < 4; ++q) { glds16(ga + (size_t)(32 * q) * ld, smem + 1024 * (w + 4 * q)); glds16(gb + (size_t)(32 * q) * ld, smem + GT + 1024 * (w + 4 * q)); }
}
DI void gemm_main(const bf16* __restrict__ Wt, const bf16* __restrict__ X, int ld, int K, int n0, int m0, char* smem, f32x16 (&acc)[4]) {
  const int t = threadIdx.x + opaque0(), lane = t & 63, r = lane & 31, h = lane >> 5;
  const int w = __builtin_amdgcn_readfirstlane(t >> 6);
#pragma unroll
  for (int i = 0; i < 4; ++i) acc[i] = zero16();
  const int swz = (lane & 7) ^ ((4 * w + (lane >> 4)) & 7);
  const bf16* ga = Wt + (size_t)(n0 + 8 * w + (lane >> 3)) * ld + swz * 8;
  const bf16* gb = X + (size_t)(m0 + 8 * w + (lane >> 3)) * ld + swz * 8;
  const int sw = (r >> 1) & 7;
  const int KT = K >> 6;
  asm volatile("s_waitcnt vmcnt(0)" ::: "memory");
  __syncthreads();
  for (int kt = 0; kt < KT; ++kt) {
    const char* As = smem + (kt & 1) * GBUF;
    const char* Bs = As + GT;
    if (kt + 1 < KT) {
      char* An = smem + ((kt + 1) & 1) * GBUF;
      const int k0 = (kt + 1) * 64;
#pragma unroll
      for (int q = 0; q < 4; ++q) { glds16(ga + (size_t)(32 * q) * ld + k0, An + 1024 * (w + 4 * q)); glds16(gb + (size_t)(32 * q) * ld + k0, An + GT + 1024 * (w + 4 * q)); }
    }
#pragma unroll
    for (int s = 0; s < 4; ++s) {
      const int co = ((2 * s + h) ^ sw) * 16;
      const bf16x8 bfr = *(const bf16x8*)(Bs + (32 * w + r) * 128 + co);
#pragma unroll
      for (int i = 0; i < 4; ++i) {
        const bf16x8 afr = *(const bf16x8*)(As + (32 * i + r) * 128 + co);
        acc[i] = MFMA(afr, bfr, acc[i]);
      }
    }
    asm volatile("s_waitcnt vmcnt(0)" ::: "memory");
    __syncthreads();
  }
}

DI float sigmoid_f(float x) { return __builtin_amdgcn_rcpf(1.f + __expf(-x)); }

DI void gemm1_map(int u, int& mt, int& nt) {
  const int v = u < 3584 ? (u & ~511) + (u & 7) * 64 + ((u >> 3) & 63) : u;
  mt = v / 30; nt = v % 30;
}
DI void unit_gemm1(const P& p, int u, int un, char* smem) {
  int mt, nt; gemm1_map(u, mt, nt);
  const int n0 = nt * 128, m0 = mt * 128;
  f32x16 acc[4];
  gemm_main(w_Wt_in(p), w_H(p), 1024, 1024, n0, m0, smem, acc);
  if (un >= 0) { int mn, nn; gemm1_map(un, mn, nn); gemm_first(w_Wt_in(p), w_H(p), 1024, nn * 128, mn * 128, smem); }
  const int tz = threadIdx.x + opaque0();
  const int lane = tz & 63, w = tz >> 6, r = lane & 31, h = lane >> 5;
  const int token = m0 + 32 * w + r;
  bf16* tw = (bf16*)(smem + GBUF + (tz >> 6) * 8704) + r * 136;
  const bool is_prompt = token < NPR;
  const int b = is_prompt ? (token >> 11) : (token - NPR), pos = token & (SEQ - 1);
  if (n0 < C_V) {
    const float* gn = n0 < C_K ? p.q_norm_g : p.k_norm_g;
    const float post = n0 < C_K ? 0.125f : 1.f;
#pragma unroll
    for (int hh = 0; hh < 2; ++hh) {
      float ss = 0.f;
#pragma unroll
      for (int i = 0; i < 2; ++i)
#pragma unroll
        for (int j = 0; j < 16; ++j) ss += acc[2 * hh + i][j] * acc[2 * hh + i][j];
      ss += __shfl_xor(ss, 32);
      const float rstd = rsqrtf(ss * (1.f / 64.f) + EPS);
#pragma unroll
      for (int i = 0; i < 2; ++i)
#pragma unroll
        for (int q4 = 0; q4 < 4; ++q4) {
          const int d = 32 * i + 8 * q4 + 4 * h;
          const f32x4 gg = *(const f32x4*)(gn + d);
          f32x4 v;
#pragma unroll
          for (int j = 0; j < 4; ++j) v[j] = acc[2 * hh + i][4 * q4 + j] * rstd * gg[j];
          bf16x4 o;
#pragma unroll
          for (int j = 0; j < 4; ++j) o[j] = (bf16)(v[j] * post);
          *(bf16x4*)(tw + 64 * hh + d) = o;
          if (n0 == C_K) {
            if (is_prompt) { if (pos >= SEQ - 128) *(f32x4*)(p.out + O_KWP + ((size_t)b * 128 + (pos - (SEQ - 128))) * 128 + 64 * hh + d) = v; }
            else *(f32x4*)(p.out + O_KWS + ((size_t)b * 128 + 127) * 128 + 64 * hh + d) = v;
          }
        }
    }
  } else if (n0 == C_V) {
#pragma unroll
    for (int i = 0; i < 4; ++i)
#pragma unroll
      for (int q4 = 0; q4 < 4; ++q4) {
        const int f = 32 * i + 8 * q4 + 4 * h;
        f32x4 v;
#pragma unroll
        for (int j = 0; j < 4; ++j) v[j] = acc[i][4 * q4 + j];
        if (is_prompt) {
#pragma unroll
          for (int j = 0; j < 4; ++j) w_VT(p)[((size_t)b * 128 + f + j) * SEQ + pos] = (bf16)v[j];
          if (pos >= SEQ - 128) *(f32x4*)(p.out + O_VWP + ((size_t)b * 128 + (pos - (SEQ - 128))) * 128 + f) = v;
        } else *(f32x4*)(p.out + O_VWS + ((size_t)b * 128 + 127) * 128 + f) = v;
      }
  } else if (n0 < C_GA) {
#pragma unroll
    for (int i = 0; i < 4; ++i)
#pragma unroll
      for (int q4 = 0; q4 < 4; ++q4) {
        const int f = n0 + 32 * i + 8 * q4 + 4 * h;
        f32x4 v; bf16x4 o;
#pragma unroll
        for (int j = 0; j < 4; ++j) { v[j] = acc[i][4 * q4 + j]; o[j] = (bf16)v[j]; }
        *(bf16x4*)(tw + (f - n0)) = o;
        if (is_prompt) { if (pos >= SEQ - 15) *(f32x4*)(p.out + O_PP + ((size_t)b * 15 + (pos - (SEQ - 15))) * 512 + (f - C_PIN)) = v; }
        else *(f32x4*)(p.out + O_PS + ((size_t)b * 15 + 14) * 512 + (f - C_PIN)) = v;
      }
  } else {
#pragma unroll
    for (int i = 0; i < 4; ++i)
#pragma unroll
      for (int q4 = 0; q4 < 4; ++q4) {
        const int f = n0 + 32 * i + 8 * q4 + 4 * h;
        bf16x4 o;
#pragma unroll
        for (int j = 0; j < 4; ++j) o[j] = (bf16)sigmoid_f(acc[i][4 * q4 + j]);
        *(bf16x4*)(tw + (f - n0)) = o;
      }
  }
  if (n0 != C_V) {
    LDS_WAIT();
    const bf16* tr = (const bf16*)(smem + GBUF + (tz >> 6) * 8704);
    bf16* pg = w_PROJ(p) + (size_t)(m0 + 32 * w + (lane >> 4)) * INW + n0 + (lane & 15) * 8;
#pragma unroll
    for (int it = 0; it < 8; ++it) *(u32x4*)(pg + (size_t)(4 * it) * INW) = *(const u32x4*)(tr + ((lane >> 4) + 4 * it) * 136 + (lane & 15) * 8);
  }
}

constexpr int VTS = 260;
constexpr int RS = 136;
DI void attn_head(const P& p, int head, int blk, int w, int r, int h, const bf16x8 (&qf)[4], const bf16* Ks, const bf16* VTs, const float* bsh, bf16x8 (&ob)[4]) {
  const int qi = 32 * w + r;
  f32x16 st[5];
#pragma unroll
  for (int tt = 0; tt < 5; ++tt) {
    st[tt] = zero16();
#pragma unroll
    for (int s = 0; s < 4; ++s) {
      const bf16x8 a = *(const bf16x8*)(Ks + (32 * (w + tt) + r) * LDSK + 16 * s + 8 * h);
      st[tt] = MFMA(a, qf[s], st[tt]);
    }
  }
  const float sink = p.sinks[head];
  float m = -INFINITY;
  {
    const int x = 31 - r + 4 * h;
    const float* bl = bsh + x;
#pragma unroll
    for (int tt = 0; tt < 5; ++tt)
#pragma unroll
      for (int j = 0; j < 16; ++j) {
        const int c = 32 * tt + (j & 3) + 8 * (j >> 2);
        const float s = st[tt][j] + bl[c];
        st[tt][j] = s;
        m = fmaxf(m, s);
      }
    if (blk == 0) {
      m = -INFINITY;
#pragma unroll
      for (int tt = 0; tt < 5; ++tt)
#pragma unroll
        for (int j = 0; j < 16; ++j) {
          const int c = 32 * tt + (j & 3) + 8 * (j >> 2);
          const float s = (159 - (x + c) > qi) ? -INFINITY : st[tt][j];
          st[tt][j] = s;
          m = fmaxf(m, s);
        }
    }
  }
  m = fmaxf(m, __shfl_xor(m, 32));
  m = fmaxf(m, sink);
  float sum = 0.f;
#pragma unroll
  for (int tt = 0; tt < 5; ++tt)
#pragma unroll
    for (int j = 0; j < 16; ++j) { const float e = __expf(st[tt][j] - m); st[tt][j] = e; sum += e; }
  sum += __shfl_xor(sum, 32);
  const float inv = 1.f / (sum + __expf(sink - m));
  f32x16 o[2] = {zero16(), zero16()};
#pragma unroll
  for (int tt = 0; tt < 5; ++tt)
#pragma unroll
    for (int s = 0; s < 2; ++s) {
      const bf16x8 pb = pack_step(st[tt], s);
#pragma unroll
      for (int i = 0; i < 2; ++i) {
        const bf16* vp = VTs + (32 * i + r) * VTS + 32 * (w + tt) + 16 * s + 4 * h;
        const bf16x8 a = cat4(*(const bf16x4*)vp, *(const bf16x4*)(vp + 8));
        o[i] = MFMA(a, pb, o[i]);
      }
    }
#pragma unroll
  for (int i = 0; i < 2; ++i)
#pragma unroll
    for (int j = 0; j < 16; ++j) ob[2 * i + (j >> 3)][j & 7] = (bf16)(o[i][j] * inv);
}
DI void pin_regs(bf16x8 (&ob)[4]) {
#pragma unroll
  for (int k = 0; k < 4; ++k) { const bf16x8 o = ob[k]; u32x4 x = __builtin_bit_cast(u32x4, o); asm volatile("" : "+v"(x)); ob[k] = __builtin_bit_cast(bf16x8, x); }
}
DI void unit_attn_prompt(const P& p, int u0, char* smem) {
  const int u = (u0 & ~511) + (u0 & 7) * 64 + ((u0 >> 3) & 63);
  const int b = u >> 7, blk = (u >> 3) & 15, hp = u & 7, hk = hp >> 2, g = hp >> 1, win = 2 << g;
  const int qpos0 = blk * 128;
  const int t = threadIdx.x + opaque0(), lane = t & 63, w = t >> 6, r = lane & 31, h = lane >> 5;
  bf16* Ks = (bf16*)smem;
  bf16* VTs = Ks + 256 * LDSK;
  float* bs = (float*)(VTs + 64 * VTS);
  bf16* Rs = Ks;
  char* PSt = smem + 256 * LDSK * 2;
  __syncthreads();
  const size_t tokq = (size_t)b * SEQ + qpos0 + 32 * w + r;
  bf16x8 qf0[4], qf1[4];
  {
    u32x4 kv[8], vv[8];
#pragma unroll
    for (int i = 0; i < 8; ++i) {
      const int c = t + 256 * i, row = c >> 3, c16 = c & 7, kp = qpos0 - 128 + row;
      kv[i] = *(const u32x4*)(w_PROJ(p) + ((size_t)b * SEQ + (kp > 0 ? kp : 0)) * INW + C_K + hk * 64 + c16 * 8);
    }
#pragma unroll
    for (int i = 0; i < 8; ++i) {
      const int c = t + 256 * i, drow = c >> 5, c16 = c & 31, kp0 = qpos0 - 128 + c16 * 8;
      vv[i] = *(const u32x4*)(w_VT(p) + ((size_t)(b * 2 + hk) * 64 + drow) * SEQ + (kp0 > 0 ? kp0 : 0));
    }
#pragma unroll
    for (int s = 0; s < 4; ++s) { qf0[s] = *(const bf16x8*)(w_PROJ(p) + tokq * INW + (2 * hp) * 64 + 16 * s + 8 * h); qf1[s] = *(const bf16x8*)(w_PROJ(p) + tokq * INW + (2 * hp + 1) * 64 + 16 * s + 8 * h); }
    const int i2 = t + 256 < 384 ? t + 256 : 383;
    const int hh1 = t >= 192, d1 = 159 - (t - 192 * hh1), d2 = 159 - (i2 - 192);
    const float bv1 = w_BIAS(p)[(2 * hp + hh1) * 128 + (d1 < 0 ? 0 : d1 > 127 ? 127 : d1)], bv2 = w_BIAS(p)[(2 * hp + 1) * 128 + (d2 < 0 ? 0 : d2 > 127 ? 127 : d2)];
#pragma unroll
    for (int i = 0; i < 8; ++i) {
      const int c = t + 256 * i, row = c >> 3, c16 = c & 7, kp = qpos0 - 128 + row;
      const u32x4 z = {0u, 0u, 0u, 0u};
      *(u32x4*)(Ks + row * LDSK + c16 * 8) = kp >= 0 ? kv[i] : z;
    }
#pragma unroll
    for (int i = 0; i < 8; ++i) {
      const int c = t + 256 * i, drow = c >> 5, c16 = c & 31, kp0 = qpos0 - 128 + c16 * 8;
      const u32x4 z = {0u, 0u, 0u, 0u};
      const u32x4 v = kp0 >= 0 ? vv[i] : z;
      u32x2* d2p = (u32x2*)(VTs + drow * VTS + c16 * 8);
      d2p[0] = (u32x2){v[0], v[1]}; d2p[1] = (u32x2){v[2], v[3]};
    }
    bs[t] = (d1 >= 0 && d1 < 128) ? bv1 : -INFINITY;
    if (t < 128) bs[t + 256] = (d2 >= 0 && d2 < 128) ? bv2 : -INFINITY;
  }
  __syncthreads();
  bf16x8 ob0[4], ob1[4];
  attn_head(p, 2 * hp, blk, w, r, h, qf0, Ks, VTs, bs, ob0);
  pin_regs(ob0);
  __builtin_amdgcn_sched_barrier(0);
  attn_head(p, 2 * hp + 1, blk, w, r, h, qf1, Ks, VTs, bs + 192, ob1);
  pin_regs(ob1);
  __builtin_amdgcn_sched_barrier(0);
  __syncthreads();
  {
    const int wu = __builtin_amdgcn_readfirstlane(w);
    const bf16* pinb = w_PROJ(p) + (size_t)b * SEQ * INW + C_PIN + g * 128 + (lane & 15) * 8;
#pragma unroll
    for (int q = 0; q < 9; ++q) {
      const int j = wu + 4 * q, pos = qpos0 - 16 + 4 * j + (lane >> 4);
      glds16(pinb + (size_t)(pos > 0 ? pos : 0) * INW, PSt + 1024 * j);
    }
  }
  const bf16* prow = w_PROJ(p) + tokq * INW;
  u32x2 gav[2][8], gbv[2][8];
#pragma unroll
  for (int k = 0; k < 8; ++k) {
    const int f = (2 * hp) * 64 + 32 * (k >> 2) + 8 * (k & 3) + 4 * h;
    gav[0][k] = *(const u32x2*)(prow + C_GA + f); gbv[0][k] = *(const u32x2*)(prow + C_GB + f);
  }
  asm volatile("s_waitcnt vmcnt(0)" ::: "memory");
  __syncthreads();
  {
    const int tk = t >> 4, cc = t & 15;
    const int p0 = qpos0 + tk * 8;
    const char* pr0 = PSt + (16 + 8 * tk) * 256 + cc * 16;
    u32x4 cur[8];
#pragma unroll
    for (int i = 0; i < 8; ++i) cur[i] = *(const u32x4*)(pr0 + i * 256);
    float S[8];
#pragma unroll
    for (int d = 0; d < 4; ++d) { S[2 * d] = __uint_as_float(cur[0][d] << 16); S[2 * d + 1] = __uint_as_float(cur[0][d] & 0xffff0000u); }
#pragma unroll 1
    for (int i = 1; i < win; ++i) {
      const u32x4 v = *(const u32x4*)(pr0 - i * 256);
      const unsigned m = p0 - i >= 0 ? 0xffffffffu : 0u;
#pragma unroll
      for (int d = 0; d < 4; ++d) { const unsigned x = v[d] & m; S[2 * d] += __uint_as_float(x << 16); S[2 * d + 1] += __uint_as_float(x & 0xffff0000u); }
    }
#pragma unroll
    for (int i = 0; i < 8; ++i) {
      const int pos = p0 + i;
      if (i > 0) {
        const u32x4 old = *(const u32x4*)(pr0 + (i - win) * 256);
        const unsigned m = pos - win >= 0 ? 0xffffffffu : 0u;
#pragma unroll
        for (int d = 0; d < 4; ++d) {
          const unsigned x = old[d] & m;
          S[2 * d] += __uint_as_float(cur[i][d] << 16); S[2 * d + 1] += __uint_as_float(cur[i][d] & 0xffff0000u);
          S[2 * d] -= __uint_as_float(x << 16); S[2 * d + 1] -= __uint_as_float(x & 0xffff0000u);
        }
      }
      const float icnt = __builtin_amdgcn_rcpf((float)(win < pos + 1 ? win : pos + 1));
      bf16x8 rr;
#pragma unroll
      for (int d = 0; d < 4; ++d) {
        rr[2 * d] = (bf16)(S[2 * d] * icnt - __uint_as_float(cur[i][d] << 16));
        rr[2 * d + 1] = (bf16)(S[2 * d + 1] * icnt - __uint_as_float(cur[i][d] & 0xffff0000u));
      }
      *(bf16x8*)(Rs + (tk * 8 + i) * RS + cc * 8) = rr;
    }
  }
  __syncthreads();
#pragma unroll
  for (int hh = 0; hh < 2; ++hh) {
    const int head = 2 * hp + hh;
    f32x4 psv[8];
#pragma unroll
    for (int k = 0; k < 8; ++k) psv[k] = *(const f32x4*)(p.pool_scale + head * 64 + 32 * (k >> 2) + 8 * (k & 3) + 4 * h);
    if (hh == 0) {
#pragma unroll
      for (int k = 0; k < 8; ++k) {
        const int f = (2 * hp + 1) * 64 + 32 * (k >> 2) + 8 * (k & 3) + 4 * h;
        gav[1][k] = *(const u32x2*)(prow + C_GA + f); gbv[1][k] = *(const u32x2*)(prow + C_GB + f);
      }
    }
    f32x16 pa[2] = {zero16(), zero16()};
#pragma unroll
    for (int s = 0; s < 8; ++s) {
      const bf16x8 bfr = *(const bf16x8*)(Rs + (32 * w + r) * RS + 16 * s + 8 * h);
#pragma unroll
      for (int i = 0; i < 2; ++i) {
        const bf16x8 a = *(const bf16x8*)(w_PWt(p) + ((size_t)g * 256 + (head & 3) * 64 + 32 * i + r) * 128 + 16 * s + 8 * h);
        pa[i] = MFMA(a, bfr, pa[i]);
      }
    }
#pragma unroll
    for (int k = 0; k < 8; ++k) {
      const int i = k >> 2, q4 = k & 3;
      const int f = head * 64 + 32 * i + 8 * q4 + 4 * h;
      const u32x2 gar = gav[hh][k], gbr = gbv[hh][k];
      const bf16x4 ga = __builtin_bit_cast(bf16x4, gar), gb = __builtin_bit_cast(bf16x4, gbr);
      bf16x4 ov;
#pragma unroll
      for (int j = 0; j < 4; ++j) { const bf16 av = hh ? ob1[2 * i + (q4 >> 1)][4 * (q4 & 1) + j] : ob0[2 * i + (q4 >> 1)][4 * (q4 & 1) + j];
        ov[j] = (bf16)(bf2f(ga[j]) * bf2f(av) + bf2f(gb[j]) * (pa[i][4 * q4 + j] * psv[k][j])); }
      *(bf16x4*)(w_MIXED(p) + tokq * DM + f) = ov;
    }
    __builtin_amdgcn_sched_barrier(0);
  }
}

DI void unit_attn_sample(const P& p, int u, char* smem) {
  const int b = u >> 2, g = u & 3, hk = g >> 1;
  const int t = threadIdx.x + opaque0(), lane = t & 63, w = t >> 6;
  float* ks = (float*)smem;
  float* vs = ks + 128 * 65;
  float* qs = vs + 128 * 64;
  float* ps = qs + 256;
  float* os = ps + 512;
  float* rs = os + 256;
  const size_t token = (size_t)NPR + b;
  __syncthreads();
  const float* kw = p.out + O_KWS + (size_t)b * 128 * 128 + hk * 64;
  const float* vw = p.out + O_VWS + (size_t)b * 128 * 128 + hk * 64;
  {
    f32x4 kv[8], vv[8];
#pragma unroll
    for (int k = 0; k < 8; ++k) { const int i = t + NTHREADS * k, j = i >> 4, d4 = (i & 15) * 4; kv[k] = *(const f32x4*)(kw + (size_t)j * 128 + d4); vv[k] = *(const f32x4*)(vw + (size_t)j * 128 + d4); }
    const float qv = bf2f(w_PROJ(p)[token * INW + g * 256 + t]);
    const int win = 2 << g, tc = t & 127;
    const float cur = p.out[O_PS + ((size_t)b * 15 + 14) * 512 + g * 128 + tc];
    float hv[15];
#pragma unroll
    for (int i = 1; i < 16; ++i) hv[i - 1] = p.state_pool[((size_t)b * 15 + 15 - i) * 512 + g * 128 + tc];
#pragma unroll
    for (int k = 0; k < 8; ++k) {
      const int i = t + NTHREADS * k, j = i >> 4, d4 = (i & 15) * 4;
      ks[j * 65 + d4] = kv[k][0]; ks[j * 65 + d4 + 1] = kv[k][1]; ks[j * 65 + d4 + 2] = kv[k][2]; ks[j * 65 + d4 + 3] = kv[k][3];
      *(f32x4*)(vs + j * 64 + d4) = vv[k];
    }
    qs[t] = qv;
    float tot = cur;
#pragma unroll
    for (int i = 1; i < 16; ++i) tot += i < win ? hv[i - 1] : 0.f;
    if (t < 128) rs[t] = tot / (float)win - cur;
  }
  __syncthreads();
  const int head = 4 * g + w;
  const float sink = p.sinks[head];
  float s[2];
  float m = sink;
#pragma unroll
  for (int i = 0; i < 2; ++i) {
    const int j = lane + 64 * i;
    float a = 0.f;
#pragma unroll 8
    for (int d = 0; d < 64; ++d) a += qs[w * 64 + d] * ks[j * 65 + d];
    s[i] = a + w_BIAS(p)[head * 128 + 127 - j];
    m = fmaxf(m, s[i]);
  }
  for (int o = 32; o >= 1; o >>= 1) m = fmaxf(m, __shfl_xor(m, o));
  float sum = 0.f;
#pragma unroll
  for (int i = 0; i < 2; ++i) { s[i] = __expf(s[i] - m); sum += s[i]; }
  sum = wave_sum(sum);
  const float inv = 1.f / (sum + __expf(sink - m));
#pragma unroll
  for (int i = 0; i < 2; ++i) ps[w * 128 + lane + 64 * i] = s[i] * inv;
  LDS_WAIT();
  {
    float a = 0.f;
#pragma unroll 8
    for (int j = 0; j < 128; ++j) a += ps[w * 128 + j] * vs[j * 64 + lane];
    os[w * 64 + lane] = a;
  }
  const int f = g * 256 + t;
  float pl = 0.f;
  const float* pw = p.pool_w + (size_t)g * 128 * 256 + t;
#pragma unroll 32
  for (int ch = 0; ch < 128; ++ch) pl += rs[ch] * pw[(size_t)ch * 256];
  pl *= p.pool_scale[f];
  const float ga = bf2f(w_PROJ(p)[token * INW + C_GA + f]), gb = bf2f(w_PROJ(p)[token * INW + C_GB + f]);
  LDS_WAIT();
  w_MIXED(p)[token * DM + f] = (bf16)(ga * os[t] + gb * pl);
}

DI void unit8_map(int u, int& mt, int& nt) {
  if (u < 1024) { const int xcd = u & 7, slot = (u >> 3) & 63, S = (u >> 9) * 8 + xcd; mt = S * 8 + (slot & 7); nt = slot >> 3; }
  else { mt = 128; nt = u - 1024; }
}
constexpr int G2_UNITS = 1024 + 32;
DI void gemm2_map(int u, int& mt, int& nt, int& kq) {
  if (u < 1024) { unit8_map(u, mt, nt); kq = -1; }
  else { mt = 128; nt = (u - 1024) & 7; kq = (u - 1024) >> 3; }
}
DI void gemm2_first(const P& p, int u, char* smem) {
  int mt, nt, kq; gemm2_map(u, mt, nt, kq);
  const int kb = kq < 0 ? 0 : 256 * kq;
  gemm_first(w_Wt_out(p) + kb, w_MIXED(p) + kb, 1024, nt * 128, mt * 128, smem);
}
DI void unit_gemm2(const P& p, int u, int un, char* smem) {
  int mt, nt, kq; gemm2_map(u, mt, nt, kq);
  const int n0 = nt * 128, m0 = mt * 128, kb = kq < 0 ? 0 : 256 * kq;
  const int tz = threadIdx.x + opaque0();
  const int lane = tz & 63, w = tz >> 6, r = lane & 31, h = lane >> 5;
  const int fc = (lane & 15) * 4, tsub = lane >> 4;
  f32x4 xv[16];
#pragma unroll
  for (int k = 0; k < 16; ++k) { const int token = m0 + 32 * w + 4 * (k & 7) + tsub; xv[k] = *(const f32x4*)(xrow(p, token) + n0 + 64 * (k >> 3) + fc); }
  f32x16 acc[4];
  gemm_main(w_Wt_out(p) + kb, w_MIXED(p) + kb, 1024, kq < 0 ? 1024 : 256, n0, m0, smem, acc);
  if (un >= 0) gemm2_first(p, un, smem);
  float* tbase = (float*)(smem + GBUF + w * 8704);
  f32x4 gv[16];
  if (kq < 0) {
#pragma unroll
    for (int k = 0; k < 16; ++k) { const int token = m0 + 32 * w + 4 * (k & 7) + tsub; gv[k] = *(const f32x4*)(w_MOD(p) + (size_t)cond_row(token) * 6144 + 2048 + n0 + 64 * (k >> 3) + fc); }
  }
#pragma unroll
  for (int hf = 0; hf < 2; ++hf) {
    if (hf) LDS_WAIT();
#pragma unroll
    for (int ii = 0; ii < 2; ++ii)
#pragma unroll
      for (int q4 = 0; q4 < 4; ++q4) {
        f32x4 v;
#pragma unroll
        for (int j = 0; j < 4; ++j) v[j] = acc[2 * hf + ii][4 * q4 + j];
        *(f32x4*)(tbase + r * 68 + 32 * ii + 8 * q4 + 4 * h) = v;
      }
    LDS_WAIT();
    if (kq >= 0) {
#pragma unroll
      for (int it = 0; it < 8; ++it) {
        const int tl = 4 * it + tsub, token = m0 + 32 * w + tl, f = n0 + 64 * hf + fc;
        *(f32x4*)(w_PART(p) + ((size_t)kq * NS + (token - NPR)) * DM + f) = *(const f32x4*)(tbase + tl * 68 + fc);
      }
    } else {
#pragma unroll
      for (int it = 0; it < 8; ++it) {
        const int tl = 4 * it + tsub, token = m0 + 32 * w + tl, f = n0 + 64 * hf + fc;
        const f32x4 a = *(const f32x4*)(tbase + tl * 68 + fc);
        f32x4 o;
#pragma unroll
        for (int j = 0; j < 4; ++j) o[j] = xv[8 * hf + it][j] + gv[8 * hf + it][j] * a[j];
        *(f32x4*)(w_X1(p) + (size_t)token * DM + f) = o;
      }
    }
  }
}

DI unsigned f2ord(float f) { const unsigned u = __float_as_uint(f); return (u & 0x80000000u) ? ~u : (u | 0x80000000u); }
DI float ord2f(unsigned u) { return __uint_as_float((u & 0x80000000u) ? (u & 0x7fffffffu) : ~u); }
DI unsigned umin_(unsigned a, unsigned b) { return a < b ? a : b; }
DI unsigned umax_(unsigned a, unsigned b) { return a > b ? a : b; }
template <int OFF> DI void sort16_desc(unsigned (&a)[64]) {
#pragma unroll
  for (int lk = 1; lk <= 4; ++lk)
#pragma unroll
    for (int lj = lk - 1; lj >= 0; --lj)
#pragma unroll
      for (int i = 0; i < 16; ++i) {
        const int k = 1 << lk, j = 1 << lj, l = i ^ j;
        if (l > i) {
          const unsigned lo = umin_(a[OFF + i], a[OFF + l]), hi = umax_(a[OFF + i], a[OFF + l]);
          const bool desc = (i & k) == 0;
          a[OFF + i] = desc ? hi : lo; a[OFF + l] = desc ? lo : hi;
        }
      }
}
DI void merge16_desc(unsigned (&a)[16]) {
#pragma unroll
  for (int lj = 3; lj >= 0; --lj)
#pragma unroll
    for (int i = 0; i < 16; ++i) {
      const int j = 1 << lj, l = i ^ j;
      if (l > i) { const unsigned lo = umin_(a[i], a[l]), hi = umax_(a[i], a[l]); a[i] = hi; a[l] = lo; }
    }
}
DI void top16_of_64(unsigned (&a)[64], unsigned (&out)[16]) {
  sort16_desc<0>(a); sort16_desc<16>(a); sort16_desc<32>(a); sort16_desc<48>(a);
  unsigned x[16], y[16];
#pragma unroll
  for (int i = 0; i < 16; ++i) { x[i] = umax_(a[i], a[31 - i]); y[i] = umax_(a[32 + i], a[63 - i]); }
  merge16_desc(x); merge16_desc(y);
#pragma unroll
  for (int i = 0; i < 16; ++i) out[i] = umax_(x[i], y[15 - i]);
  merge16_desc(out);
}
__device__ constexpr int COFF[16] = {0, 16, 24, 29, 33, 36, 38, 40, 42, 43, 44, 45, 46, 47, 48, 49};
DI unsigned umax3(unsigned a, unsigned b, unsigned c) { const unsigned m = a > b ? a : b; return m > c ? m : c; }

DI void unit_peer_route(const P& p, int u, int un, char* smem) {
  int mt, hd; unit8_map(u, mt, hd);
  const int m0 = mt * 128;
  const int t = threadIdx.x + opaque0(), lane = t & 63, w = t >> 6, r = lane & 31, h = lane >> 5;
  unsigned char* myidx = (unsigned char*)smem + 2 * GBUF + t * 32;
  unsigned top[2][16];
#pragma unroll
  for (int pp = 0; pp < 2; ++pp) {
    f32x16 acc[4];
    gemm_main(w_Wt_q(p), w_H(p), 1024, 1024, hd * 256 + pp * 128, m0, smem, acc);
    if (pp == 0) gemm_first(w_Wt_q(p), w_H(p), 1024, hd * 256 + 128, m0, smem);
    else if (un >= 0) { int mn, hn; unit8_map(un, mn, hn); gemm_first(w_Wt_q(p), w_H(p), 1024, hn * 256, mn * 128, smem); }
    f32x16 sc[4] = {zero16(), zero16(), zero16(), zero16()};
    {
      const bf16* skb = w_SK(p) + (size_t)(hd * 2 + pp) * 128 * 128;
      const int wu = __builtin_amdgcn_readfirstlane(w);
#pragma unroll
      for (int q = 0; q < 8; ++q) {
        const int j = wu + 4 * q, row = 4 * j + (lane >> 4);
        glds16(skb + (size_t)row * 128 + (((lane & 15) ^ (row & 15)) * 8), smem + GBUF + 1024 * j);
      }
      asm volatile("s_waitcnt vmcnt(0)" ::: "memory");
      __syncthreads();
    }
    bf16x8 bqs[8];
#pragma unroll
    for (int i = 0; i < 4; ++i)
#pragma unroll
      for (int s = 0; s < 2; ++s) bqs[2 * i + s] = pack_step(acc[i], s);
#pragma unroll
    for (int i = 0; i < 4; ++i)
#pragma unroll
      for (int s = 0; s < 2; ++s) {
        const bf16x8 bq = bqs[2 * i + s];
#pragma unroll
        for (int kt = 0; kt < 4; ++kt) {
          const int row = 32 * kt + r, cc = 4 * i + 2 * s;
          const char* rp = smem + GBUF + row * 256 + 8 * h;
          const bf16x8 a = cat4(*(const bf16x4*)(rp + ((cc ^ (row & 15)) * 16)), *(const bf16x4*)(rp + (((cc + 1) ^ (row & 15)) * 16)));
          sc[kt] = MFMA(a, bq, sc[kt]);
        }
      }
    unsigned pk[64];
#pragma unroll
    for (int kt = 0; kt < 4; ++kt)
#pragma unroll
      for (int j = 0; j < 16; ++j) { const int key = 32 * kt + crow(j, h); pk[kt * 16 + j] = (f2ord(sc[kt][j]) & ~127u) | (unsigned)(127 - key); }
    unsigned mine[16];
    top16_of_64(pk, mine);
#pragma unroll
    for (int i = 0; i < 16; ++i) top[pp][i] = (unsigned)__shfl_xor((int)mine[15 - i], 32);
#pragma unroll
    for (int i = 0; i < 16; ++i) top[pp][i] = umax_(top[pp][i], mine[i]);
    merge16_desc(top[pp]);
  }
  float v0[16], v1[16];
#pragma unroll
  for (int a = 0; a < 16; ++a) {
    v0[a] = ord2f(top[0][a] & ~127u); v1[a] = ord2f(top[1][a] & ~127u);
    myidx[a] = (unsigned char)(127u - (top[0][a] & 127u)); myidx[16 + a] = (unsigned char)(127u - (top[1][a] & 127u));
  }
  unsigned cand[64];
#pragma unroll
  for (int i = 50; i < 64; ++i) cand[i] = 0u;
#pragma unroll
  for (int a = 0; a < 16; ++a)
#pragma unroll
    for (int bb = 0; bb < 16 / (a + 1); ++bb)
      cand[COFF[a] + bb] = (f2ord(v0[a] + v1[bb]) & ~255u) | (unsigned)(255 - (a * 16 + bb));
  unsigned best[16];
  top16_of_64(cand, best);
  const float smax = ord2f(best[0] & ~255u);
  float e[16], esum = 0.f;
#pragma unroll
  for (int i = 0; i < 16; ++i) { e[i] = __expf(ord2f(best[i] & ~255u) - smax); esum += e[i]; }
  const float einv = 1.f / esum;
  const size_t token = (size_t)m0 + 32 * w + r;
  int* ip = w_IDX(p) + token * 128 + hd * 16 + 8 * h;
  float* gp = w_GATE(p) + token * 128 + hd * 16 + 8 * h;
  const unsigned hmask = 0u - (unsigned)h;
#pragma unroll
  for (int i = 0; i < 8; ++i) {
    const unsigned bsel = best[i] ^ ((best[i] ^ best[8 + i]) & hmask);
    const float esel = __uint_as_float(__float_as_uint(e[i]) ^ ((__float_as_uint(e[i]) ^ __float_as_uint(e[8 + i])) & hmask));
    const unsigned code = 255u - (bsel & 255u);
    const int a = code >> 4, bb = code & 15;
    ip[i] = (int)myidx[a] * 128 + (int)myidx[16 + bb];
    gp[i] = esel * einv;
  }
}

DI float gelu_fast(float v) {
  const float av = fabsf(v), tt = __builtin_amdgcn_rcpf(av * 0.2316418882f + 1.0f);
  float q = tt * 0.5307027145f - 0.7265760135f; q = q * tt + 0.7107068705f; q = q * tt - 0.142248368f; q = q * tt + 0.127414796f; q = q * tt;
  const float e = __builtin_amdgcn_exp2f(v * v * -0.72134752044f);
  const float m = v * (q * e);
  return v < 0.f ? m : v - m;
}
DI float dot2bf(unsigned a, unsigned b, float acc) { return __builtin_amdgcn_fdot2_f32_bf16(__builtin_bit_cast(bf16x2, a), __builtin_bit_cast(bf16x2, b), acc, false); }
DI unsigned pkbf(f32x2 v) { bf16x2 r; r[0] = (bf16)v[0]; r[1] = (bf16)v[1]; return __builtin_bit_cast(unsigned, r); }
DI int dot16i(u32x4 u8, u32x4 x8, int d) {
#pragma unroll
  for (int m = 0; m < 4; ++m) d = __builtin_amdgcn_sdot4((int)u8[m], (int)x8[m], d, false);
  return d;
}
DI void axpy16p(f32x2* o, u32x4 v8, f32x2 c2) {
#pragma unroll
  for (int m = 0; m < 4; ++m) {
    const int wd = (int)v8[m];
    o[2 * m] = __builtin_elementwise_fma(c2, __builtin_amdgcn_cvt_pk_f32_fp8(wd, false), o[2 * m]);
    o[2 * m + 1] = __builtin_elementwise_fma(c2, __builtin_amdgcn_cvt_pk_f32_fp8(wd, true), o[2 * m + 1]);
  }
}
DI int dpp_add16i(int v) {
  v += __builtin_amdgcn_update_dpp(0, v, 0x140, 0xf, 0xf, true);
  v += __builtin_amdgcn_update_dpp(0, v, 0x141, 0xf, 0xf, true);
  v += __builtin_amdgcn_update_dpp(0, v, 0x4e, 0xf, 0xf, true);
  v += __builtin_amdgcn_update_dpp(0, v, 0xb1, 0xf, 0xf, true);
  return v;
}
DI float dot16(u32x4 u8, u32x4 xlo, u32x4 xhi, float d) {
#pragma unroll
  for (int m = 0; m < 4; ++m) {
    const int wd = (int)u8[m];
    const unsigned p01 = pkbf(__builtin_amdgcn_cvt_pk_f32_fp8(wd, false)), p23 = pkbf(__builtin_amdgcn_cvt_pk_f32_fp8(wd, true));
    const unsigned x01 = m < 2 ? xlo[2 * m] : xhi[2 * m - 4], x23 = m < 2 ? xlo[2 * m + 1] : xhi[2 * m - 3];
    d = dot2bf(p01, x01, d); d = dot2bf(p23, x23, d);
  }
  return d;
}
DI void axpy16(float* o, u32x4 v8, float c) {
#pragma unroll
  for (int m = 0; m < 4; ++m) {
    const int wd = (int)v8[m];
    const f32x2 a = __builtin_amdgcn_cvt_pk_f32_fp8(wd, false), b = __builtin_amdgcn_cvt_pk_f32_fp8(wd, true);
    o[4 * m] += c * a[0]; o[4 * m + 1] += c * a[1]; o[4 * m + 2] += c * b[0]; o[4 * m + 3] += c * b[1];
  }
}
DI float reduce4(const float (&d)[4], int lane) {
  const int h = lane >> 5, b4 = (lane >> 4) & 1;
  float a0 = h ? d[2] : d[0], a1 = h ? d[3] : d[1];
  const float s0 = h ? d[0] : d[2], s1 = h ? d[1] : d[3];
  a0 += __shfl_xor(s0, 32); a1 += __shfl_xor(s1, 32);
  float k = b4 ? a1 : a0;
  const float s = b4 ? a0 : a1;
  k += __shfl_xor(s, 16);
  k += __shfl_xor(k, 8); k += __shfl_xor(k, 4); k += __shfl_xor(k, 2); k += __shfl_xor(k, 1);
  return k;
}
DI float dpp_add16(float v) {
  v += __int_as_float(__builtin_amdgcn_update_dpp(0, __float_as_int(v), 0x140, 0xf, 0xf, true));
  v += __int_as_float(__builtin_amdgcn_update_dpp(0, __float_as_int(v), 0x141, 0xf, 0xf, true));
  v += __int_as_float(__builtin_amdgcn_update_dpp(0, __float_as_int(v), 0x4e, 0xf, 0xf, true));
  v += __int_as_float(__builtin_amdgcn_update_dpp(0, __float_as_int(v), 0xb1, 0xf, 0xf, true));
  return v;
}
constexpr int PEER_GLDS = 512 + 128 * 16;
constexpr int PEER_WLDS = 4 * PEER_GLDS;
template <int PART>
DI void peer_wave4(const P& p, int g, char* wl) {
  const int lane = (threadIdx.x + opaque0()) & 63, q = lane >> 4, j16 = lane & 15;
  unsigned* hist = (unsigned*)(wl + q * PEER_GLDS);
  u32x4* list = (u32x4*)(wl + q * PEER_GLDS + 512);
  const int token = 4 * g + q;
  if constexpr (PART != 2) {
  u32x4 x[4];
  {
    const unsigned char* hrow = w_H8(p) + (size_t)token * DM + 16 * j16;
#pragma unroll
    for (int i = 0; i < 4; ++i) x[i] = *(const u32x4*)(hrow + 256 * i);
  }
  const float xs = w_HS(p)[token];
  {
    int ids[8]; float gts[8], su[8];
#pragma unroll
    for (int i = 0; i < 8; ++i) { const size_t o = (size_t)token * 128 + j16 + 16 * i; ids[i] = w_IDX(p)[o]; gts[i] = w_GATE(p)[o]; }
#pragma unroll
    for (int i = 0; i < 8; ++i) { su[i] = w_SU(p)[ids[i]] * xs; gts[i] *= w_SV(p)[ids[i]]; }
    LDS_WAIT();
    *(u32x4*)(hist + 8 * j16) = (u32x4){0u, 0u, 0u, 0u}; *(u32x4*)(hist + 8 * j16 + 4) = (u32x4){0u, 0u, 0u, 0u};
    LDS_WAIT();
#pragma unroll
    for (int i = 0; i < 8; ++i) (void)__hip_atomic_fetch_add(&hist[ids[i] >> 7], 1u, __ATOMIC_RELAXED, __HIP_MEMORY_SCOPE_WAVEFRONT);
    LDS_WAIT();
    const u32x4 ca = *(const u32x4*)(hist + 8 * j16), cb = *(const u32x4*)(hist + 8 * j16 + 4);
    const unsigned tot = ca[0] + ca[1] + ca[2] + ca[3] + cb[0] + cb[1] + cb[2] + cb[3];
    unsigned scan = tot;
#pragma unroll
    for (int o = 1; o < 16; o <<= 1) { const unsigned tv = (unsigned)__shfl_up((int)scan, o, 16); if (j16 >= o) scan += tv; }
    unsigned e0 = scan - tot;
    u32x4 pa, pb;
    pa[0] = e0; e0 += ca[0]; pa[1] = e0; e0 += ca[1]; pa[2] = e0; e0 += ca[2]; pa[3] = e0; e0 += ca[3];
    pb[0] = e0; e0 += cb[0]; pb[1] = e0; e0 += cb[1]; pb[2] = e0; e0 += cb[2]; pb[3] = e0;
    LDS_WAIT();
    *(u32x4*)(hist + 8 * j16) = pa; *(u32x4*)(hist + 8 * j16 + 4) = pb;
    LDS_WAIT();
#pragma unroll
    for (int i = 0; i < 8; ++i) {
      const unsigned pos = __hip_atomic_fetch_add(&hist[ids[i] >> 7], 1u, __ATOMIC_RELAXED, __HIP_MEMORY_SCOPE_WAVEFRONT);
      list[pos] = (u32x4){(unsigned)ids[i], __float_as_uint(su[i]), __float_as_uint(gts[i]), 0u};
    }
    LDS_WAIT();
  }
  const unsigned char* Ub = w_Ub(p) + 16 * j16;
  {
    u32x4 uA[4], uB[4];
    u32x4 eA = list[0], eB = list[1];
#pragma unroll
    for (int i = 0; i < 4; ++i) uA[i] = *(const u32x4*)(Ub + (size_t)eA[0] * DM + 256 * i);
#pragma unroll
    for (int i = 0; i < 4; ++i) uB[i] = *(const u32x4*)(Ub + (size_t)eB[0] * DM + 256 * i);
#define PEER_USTEP(U, E, K)                                                                                            \
    {                                                                                                                  \
      const float su = __uint_as_float(E[1]), gsv = __uint_as_float(E[2]);                                             \
      int d0 = 0, d1 = 0;                                                                                              \
      d0 = dot16i(U[0], x[0], d0); d1 = dot16i(U[1], x[1], d1); d0 = dot16i(U[2], x[2], d0); d1 = dot16i(U[3], x[3], d1); \
      E = list[(K) + 2 < 128 ? (K) + 2 : 127];                       \
      _Pragma("unroll") for (int i = 0; i < 4; ++i) U[i] = *(const u32x4*)(Ub + (size_t)E[0] * DM + 256 * i);          \
      const float c = gsv * gelu_fast(su * (float)dpp_add16i(d0 + d1));                                                \
      if (j16 == 0) ((float*)&list[K])[3] = c;                                                                          \
    }
#pragma unroll 1
    for (int k = 0; k < 128; k += 2) {
      PEER_USTEP(uA, eA, k)
      PEER_USTEP(uB, eB, k + 1)
    }
  }
  }
  if constexpr (PART != 1) {
  LDS_WAIT();
  const unsigned char* Vb = w_Vb(p) + 16 * j16;
  f32x2 acc[32];
#pragma unroll
  for (int i = 0; i < 32; ++i) acc[i] = (f32x2){0.f, 0.f};
  {
    u32x4 vA[4], vB[4];
    u32x4 eA = list[0], eB = list[1];
#pragma unroll
    for (int i = 0; i < 4; ++i) vA[i] = *(const u32x4*)(Vb + (size_t)eA[0] * DM + 256 * i);
#pragma unroll
    for (int i = 0; i < 4; ++i) vB[i] = *(const u32x4*)(Vb + (size_t)eB[0] * DM + 256 * i);
#define PEER_VSTEP(V, E, K)                                                                                            \
    {                                                                                                                  \
      const float c = __uint_as_float(E[3]);                                                                           \
      const f32x2 c2 = {c, c};                                                                                         \
      _Pragma("unroll") for (int i = 0; i < 4; ++i) axpy16p(acc + 8 * i, V[i], c2);                                    \
      E = list[(K) + 2 < 128 ? (K) + 2 : 127];                                                                         \
      _Pragma("unroll") for (int i = 0; i < 4; ++i) V[i] = *(const u32x4*)(Vb + (size_t)E[0] * DM + 256 * i);          \
    }
#pragma unroll 1
    for (int k = 0; k < 128; k += 2) {
      PEER_VSTEP(vA, eA, k)
      PEER_VSTEP(vB, eB, k + 1)
    }
  }
  const float* x1 = w_X1(p) + (size_t)token * DM + 16 * j16;
  const float* g2 = w_MOD(p) + (size_t)cond_row(token) * 6144 + 5120 + 16 * j16;
  float* y = p.out + O_YP + (size_t)token * DM + 16 * j16;
  f32x4 xv[16], gv[16];
#pragma unroll
  for (int k = 0; k < 16; ++k) { const int c0 = 256 * (k >> 2) + 4 * (k & 3); xv[k] = *(const f32x4*)(x1 + c0); gv[k] = *(const f32x4*)(g2 + c0); }
#pragma unroll
  for (int k = 0; k < 16; ++k) {
    const int c0 = 256 * (k >> 2) + 4 * (k & 3);
    f32x4 yv;
#pragma unroll
    for (int j = 0; j < 4; ++j) yv[j] = xv[k][j] + gv[k][j] * acc[2 * k + (j >> 1)][j & 1];
    *(f32x4*)(y + c0) = yv;
  }
  }
}
DI void peer_token_block(const P& p, int token, char* smem) {
  const int t = threadIdx.x + opaque0(), lane = t & 63, w = t >> 6;
  float* red = (float*)smem;
  const u32x4 x8 = *(const u32x4*)(w_H8(p) + (size_t)token * DM + 16 * lane);
  const int myid = w_IDX(p)[(size_t)token * 128 + 32 * w + (lane & 31)];
  const float mysu = w_SU(p)[myid] * w_HS(p)[token];
  const float mygs = w_GATE(p)[(size_t)token * 128 + 32 * w + (lane & 31)] * w_SV(p)[myid];
  float o[16];
#pragma unroll
  for (int i = 0; i < 16; ++i) o[i] = 0.f;
#pragma unroll 1
  for (int e0 = 0; e0 < 32; e0 += 8) {
    u32x4 u8[8], v8[8];
#pragma unroll
    for (int qq = 0; qq < 8; ++qq) {
      const size_t ro = (size_t)__builtin_amdgcn_readlane(myid, e0 + qq) * DM + 16 * lane;
      u8[qq] = *(const u32x4*)(w_Ub(p) + ro); v8[qq] = *(const u32x4*)(w_Vb(p) + ro);
    }
#pragma unroll
    for (int hb = 0; hb < 2; ++hb) {
      float d[4];
#pragma unroll
      for (int qq = 0; qq < 4; ++qq) d[qq] = (float)dot16i(u8[4 * hb + qq], x8, 0);
      const float kv = reduce4(d, lane);
#pragma unroll
      for (int qq = 0; qq < 4; ++qq) {
        const int e = e0 + 4 * hb + qq;
        const float a = __int_as_float(__builtin_amdgcn_readlane(__float_as_int(kv), 16 * qq)) * __int_as_float(__builtin_amdgcn_readlane(__float_as_int(mysu), e));
        const float c = __int_as_float(__builtin_amdgcn_readlane(__float_as_int(mygs), e)) * gelu_fast(a);
        axpy16(o, v8[4 * hb + qq], c);
      }
    }
  }
  __syncthreads();
#pragma unroll
  for (int i = 0; i < 16; ++i) red[w * 1024 + 16 * lane + i] = o[i];
  __syncthreads();
  if (w == 0) {
    const float* x1 = w_X1(p) + (size_t)token * DM + 16 * lane;
    const float* g2 = w_MOD(p) + (size_t)cond_row(token) * 6144 + 5120 + 16 * lane;
    float* y = p.out + O_YP + (size_t)token * DM + 16 * lane;
    f32x4 xv[4], gv[4];
#pragma unroll
    for (int mm = 0; mm < 4; ++mm) { xv[mm] = *(const f32x4*)(x1 + 4 * mm); gv[mm] = *(const f32x4*)(g2 + 4 * mm); }
#pragma unroll
    for (int mm = 0; mm < 4; ++mm) {
      f32x4 yv;
#pragma unroll
      for (int j = 0; j < 4; ++j) { const int c = 16 * lane + 4 * mm + j; yv[j] = xv[mm][j] + gv[mm][j] * (red[c] + red[1024 + c] + red[2048 + c] + red[3072 + c]); }
      *(f32x4*)(y + 4 * mm) = yv;
    }
  }
}

constexpr int NPHASE = 8;

#if defined(PROBE_ATTN) || defined(PROBE_SAMP)
DI int probe_token(int i) { return (i * 131 + 3) % NPR; }
DI float block_sum_p(float v, float* red) {
  __syncthreads();
  v = wave_sum(v);
  if ((threadIdx.x & 63) == 0) red[threadIdx.x >> 6] = v;
  __syncthreads();
  return red[0] + red[1] + red[2] + red[3];
}
DI float block_max_p(float v, float* red) {
  __syncthreads();
  for (int o = 32; o >= 1; o >>= 1) v = fmaxf(v, __shfl_xor(v, o));
  if ((threadIdx.x & 63) == 0) red[threadIdx.x >> 6] = v;
  __syncthreads();
  return fmaxf(fmaxf(red[0], red[1]), fmaxf(red[2], red[3]));
}
#endif
#ifdef PROBE_ATTN
DI void probe_attn(const P& p, int i, char* smem) {
  float* red = (float*)smem;
  float* pr = red + 4;
  float* attn = pr + 128;
  float* rr = attn + 1024;
  const int token = probe_token(i), b = token >> 11, pos = token & 2047, t = threadIdx.x;
  const bf16* prow = w_PROJ(p) + (size_t)token * INW;
  for (int head = 0; head < 16; ++head) {
    const int hk = head >> 3;
    float s = -INFINITY;
    const int kp = pos - 127 + (t & 127);
    if (t < 128 && kp >= 0) {
      float a = 0.f;
      const bf16* kr = w_PROJ(p) + ((size_t)b * SEQ + kp) * INW + C_K + hk * 64;
      for (int d = 0; d < 64; ++d) a += bf2f(prow[head * 64 + d]) * bf2f(kr[d]);
      s = a + w_BIAS(p)[head * 128 + (pos - kp)];
    }
    float m = block_max_p(s, red);
    m = fmaxf(m, p.sinks[head]);
    const float e = (t < 128 && kp >= 0) ? __expf(s - m) : 0.f;
    const float den = block_sum_p(e, red) + __expf(p.sinks[head] - m);
    if (t < 128) pr[t] = e / den;
    __syncthreads();
    if (t < 64) {
      float o = 0.f;
      for (int j = 0; j < 128; ++j) { const int kq = pos - 127 + j; if (kq >= 0) o += pr[j] * bf2f(w_VT(p)[((size_t)(b * 2 + hk) * 64 + t) * SEQ + kq]); }
      attn[head * 64 + t] = o;
    }
    __syncthreads();
  }
  for (int c = t; c < 512; c += 256) {
    const int g = c >> 7, win = 2 << g;
    float tot = 0.f;
    for (int j = 0; j < win; ++j) if (pos - j >= 0) tot += bf2f(w_PROJ(p)[((size_t)b * SEQ + pos - j) * INW + C_PIN + c]);
    const float cnt = (float)(win < pos + 1 ? win : pos + 1);
    rr[c] = bf2f((bf16)(tot / cnt - bf2f(prow[C_PIN + c])));
  }
  __syncthreads();
  for (int f = t; f < 1024; f += 256) {
    const int g = f >> 8;
    float pl = 0.f;
    for (int ch = 0; ch < 128; ++ch) pl += rr[g * 128 + ch] * bf2f(w_PWt(p)[((size_t)g * 256 + (f & 255)) * 128 + ch]);
    const float naive = bf2f(prow[C_GA + f]) * attn[f] + bf2f(prow[C_GB + f]) * (pl * p.pool_scale[f]);
    const float fast = bf2f(w_MIXED(p)[(size_t)token * DM + f]);
    p.out[O_KWP + (size_t)i * DM + f] += (float)(PROBE_ATTN) * (fast - naive);
  }
  __syncthreads();
}
#endif

#ifdef PROBE_SAMP
DI void probe_samp(const P& p, int b, char* smem) {
  float* red = (float*)smem;
  float* pr = red + 4;
  float* attn = pr + 128;
  float* rr = attn + 1024;
  const int t = threadIdx.x;
  const size_t token = (size_t)NPR + b;
  const bf16* prow = w_PROJ(p) + token * INW;
  for (int head = 0; head < 16; ++head) {
    const int hk = head >> 3;
    float s = -INFINITY;
    if (t < 128) {
      const float* kr = t < 127 ? p.cache_k + (((size_t)b * 128 + t + 1) * 2 + hk) * 64 : p.out + O_KWS + (((size_t)b * 128 + 127) * 2 + hk) * 64;
      float a = 0.f;
      for (int d = 0; d < 64; ++d) a += bf2f(prow[head * 64 + d]) * kr[d];
      s = a + p.rel_table[(127 - t < 16 ? 127 - t : min(31, 16 + (int)(logf((float)(127 - t) / 16.f) / logf(8.f) * 16.f))) * 16 + head];
    }
    float m = block_max_p(s, red);
    m = fmaxf(m, p.sinks[head]);
    const float e = t < 128 ? __expf(s - m) : 0.f;
    const float den = block_sum_p(e, red) + __expf(p.sinks[head] - m);
    if (t < 128) pr[t] = e / den;
    __syncthreads();
    if (t < 64) {
      float o = 0.f;
      for (int j = 0; j < 128; ++j) { const float* vr = j < 127 ? p.cache_v + (((size_t)b * 128 + j + 1) * 2 + hk) * 64 : p.out + O_VWS + (((size_t)b * 128 + 127) * 2 + hk) * 64; o += pr[j] * vr[t]; }
      attn[head * 64 + t] = o;
    }
    __syncthreads();
  }
  for (int c = t; c < 512; c += 256) {
    const int g = c >> 7, win = 2 << g;
    const float cur = p.out[O_PS + ((size_t)b * 15 + 14) * 512 + c];
    float tot = cur;
    for (int j = 1; j < win; ++j) tot += p.state_pool[((size_t)b * 15 + 15 - j) * 512 + c];
    rr[c] = tot / (float)win - cur;
  }
  __syncthreads();
  for (int f = t; f < 1024; f += 256) {
    const int g = f >> 8;
    float pl = 0.f;
    for (int ch = 0; ch < 128; ++ch) pl += rr[g * 128 + ch] * p.pool_w[((size_t)g * 128 + ch) * 256 + (f & 255)];
    const float naive = bf2f(prow[C_GA + f]) * attn[f] + bf2f(prow[C_GB + f]) * (pl * p.pool_scale[f]);
    const float fast = bf2f(w_MIXED(p)[token * DM + f]);
    p.out[O_KWP + (size_t)b * DM + f] += (float)(PROBE_SAMP) * (fast - naive);
  }
  __syncthreads();
}
#endif
template <class First, class Main, class Fill> DI void run_with_filler(int G, int bid, int nmain, int nfill, First firstf, Main mainf, Fill fillf) {
  if (bid < nmain) { __syncthreads(); firstf(bid); }
  for (int u = bid; u < nmain; u += G) mainf(u, u + G < nmain ? u + G : -1);
  const int rem = nmain % G;
  if (rem == 0) { for (int f = bid; f < nfill; f += G) fillf(f); }
  else if (bid >= rem) { for (int f = bid - rem; f < nfill; f += G - rem) fillf(f); }
}
template <int PH> DI void run_phase(const P& p, char* smem) {
  const int G = gridDim.x, bid = blockIdx.x, w = __builtin_amdgcn_readfirstlane(threadIdx.x >> 6);
  if constexpr (PH == 0) { run_with_filler(G, bid, U0_MOD, F0_TOTAL, [&](int) {}, [&](int u, int) { unit_mod(p, u, smem); }, [&](int f) { phase0_filler(p, f, smem); }); }
  if constexpr (PH == 1) norm_phase(p, 0);
  if constexpr (PH == 2) {
    run_with_filler(G, bid, 129 * 30, F2_TOTAL, [&](int u) { int mt, nt; gemm1_map(u, mt, nt); gemm_first(w_Wt_in(p), w_H(p), 1024, nt * 128, mt * 128, smem); },
                    [&](int u, int un) { unit_gemm1(p, u, un, smem); }, [&](int f) { phase2_filler(p, f, smem); });
  }
  if constexpr (PH == 3) {
    if (bid >= G / 2) for (int u = bid; u < 512; u += G) unit_attn_sample(p, u, smem);
    for (int u = bid; u < 1024; u += G) unit_attn_prompt(p, u, smem);
    if (bid < G / 2) for (int u = bid; u < 512; u += G) unit_attn_sample(p, u, smem);
  }
  if constexpr (PH == 4) {
    run_with_filler(G, bid, G2_UNITS, F4_TOTAL, [&](int u) { gemm2_first(p, u, smem); },
                    [&](int u, int un) { unit_gemm2(p, u, un, smem); }, [&](int f) { unit_convert(p.sub_keys, w_SK(p), f); });
  }
  if constexpr (PH == 5) norm_phase(p, 1);
  if constexpr (PH == 6) {
    run_with_filler(G, bid, 129 * 8, F6_TOTAL, [&](int u) { int mt, hd; unit8_map(u, mt, hd); gemm_first(w_Wt_q(p), w_H(p), 1024, hd * 256, mt * 128, smem); },
                    [&](int u, int un) { unit_peer_route(p, u, un, smem); }, [&](int f) { if (f < F6_QU) unit_quant_rows<true>(p.peer_u, w_Ub(p), w_SU(p), f); else unit_quant_rows<false>(p.peer_v, w_Vb(p), w_SV(p), f - F6_QU); });
  }
  if constexpr (PH == 7) {
    for (int g = bid * 4 + w; g < NPR / 4; g += G * 4) peer_wave4<0>(p, g, smem + w * PEER_WLDS);
    for (int s = bid; s < NS; s += G) peer_token_block(p, NPR + s, smem + 4 * PEER_WLDS);
  }
}
#if ONE_LAUNCH
__global__ void __launch_bounds__(NTHREADS, 2) mega(P p) {
  __shared__ __attribute__((aligned(16))) char smem[SMEM_BYTES + 16];
  volatile unsigned* st = (volatile unsigned*)(smem + SMEM_BYTES);
  if (threadIdx.x == 0) { st[0] = 0u; st[1] = 0u; }
  __syncthreads();
  const unsigned xcc = xb_xcc_id();
  if (threadIdx.x == 0) (void)xb_add(&w_bar(p)[XB_XCNT(xcc)], 1u);
#ifndef REPEAT_MASK
#define REPEAT_MASK 0
#endif
#define RUN_PH(k) do { run_phase<k>(p, smem); if ((REPEAT_MASK >> k) & 1) { xcd_barrier(w_bar(p), xcc, st); run_phase<k>(p, smem); } } while (0)
  RUN_PH(0); xcd_barrier(w_bar(p), xcc, st);
  RUN_PH(1); xcd_barrier(w_bar(p), xcc, st);
  RUN_PH(2); xcd_barrier(w_bar(p), xcc, st);
  RUN_PH(3); xcd_barrier(w_bar(p), xcc, st);
#ifdef PROBE_ATTN
  for (int i = blockIdx.x; i < 128; i += gridDim.x) probe_attn(p, i, smem);
  xcd_barrier(w_bar(p), xcc, st);
#endif
#ifdef PROBE_SAMP
  for (int i = blockIdx.x; i < 128; i += gridDim.x) probe_samp(p, i, smem);
  xcd_barrier(w_bar(p), xcc, st);
#endif
  RUN_PH(4); xcd_barrier(w_bar(p), xcc, st);
  RUN_PH(5); xcd_barrier(w_bar(p), xcc, st);
  RUN_PH(6); xcd_barrier(w_bar(p), xcc, st);
#if PEER_ALIGN
  { const int G = gridDim.x, bid = blockIdx.x, w = __builtin_amdgcn_readfirstlane(threadIdx.x >> 6);
    for (int g = bid * 4 + w, it = 0; it < (NPR / 4 + G * 4 - 1) / (G * 4); g += G * 4, ++it) {
      if (it > 0) xcd_barrier(w_bar(p), xcc, st);
      if (g < NPR / 4) peer_wave4<1>(p, g, smem + w * PEER_WLDS);
#if PEER_ALIGN > 1
      xcd_barrier(w_bar(p), xcc, st);
#endif
      if (g < NPR / 4) peer_wave4<2>(p, g, smem + w * PEER_WLDS);
    }
    for (int s = bid; s < NS; s += G) peer_token_block(p, NPR + s, smem + 4 * PEER_WLDS); }
#else
  RUN_PH(7);
#endif
}
#else
template <int PH> __global__ void __launch_bounds__(NTHREADS, 2) mega(P p) {
  __shared__ __attribute__((aligned(16))) char smem[SMEM_BYTES];
  run_phase<PH>(p, smem);
}
#endif


extern "C" void kernel_launch(void* const* d_in, const int* in_sizes, int n_in, void* d_out, int out_size, void* d_ws, size_t ws_size, hipStream_t stream) {
  P p{};
  const float* const* in = (const float* const*)d_in;
  p.x_prompt = in[0]; p.x_sample = in[1]; p.cache_k = in[2]; p.cache_v = in[3]; p.state_pool = in[4]; p.c_prompt = in[5]; p.c_sample = in[6];
  p.rel_table = in[7]; p.ada_w = in[8]; p.ada_b = in[9]; p.norm1_g = in[10]; p.w_in = in[11]; p.q_norm_g = in[12]; p.k_norm_g = in[13]; p.sinks = in[14];
  p.pool_w = in[15]; p.pool_scale = in[16]; p.w_out = in[17]; p.norm2_g = in[18]; p.w_query = in[19]; p.sub_keys = in[20]; p.peer_u = in[21]; p.peer_v = in[22];
  p.out = (float*)d_out;
  p.ws = (char*)d_ws;
  if (WS_NEED > ws_size) { fprintf(stderr, "workspace too small: need %zu have %zu\n", (size_t)WS_NEED, ws_size); return; }

  static int grid_blocks = 0;
  if (!grid_blocks) {
    int dev = 0, cus = 0, per_cu = 0;
    (void)hipGetDevice(&dev);
    (void)hipDeviceGetAttribute(&cus, hipDeviceAttributeMultiprocessorCount, dev);
#if ONE_LAUNCH
    (void)hipOccupancyMaxActiveBlocksPerMultiprocessor(&per_cu, mega, NTHREADS, 0);
#else
    per_cu = 2;
#endif
    if (per_cu > 2) per_cu = 2;
    if (per_cu < 1) per_cu = 1;
    if (cus < 1) cus = 256;
    grid_blocks = cus * per_cu;
  }
#if ONE_LAUNCH
  (void)hipMemsetAsync(p.ws + OFF_BAR, 0, XCD_BAR_WORDS * 4, stream);
  hipLaunchKernelGGL(mega, dim3(grid_blocks), dim3(NTHREADS), 0, stream, p);
#else
  hipLaunchKernelGGL(mega<0>, dim3(grid_blocks), dim3(NTHREADS), 0, stream, p);
  hipLaunchKernelGGL(mega<1>, dim3(grid_blocks), dim3(NTHREADS), 0, stream, p);
  hipLaunchKernelGGL(mega<2>, dim3(grid_blocks), dim3(NTHREADS), 0, stream, p);
  hipLaunchKernelGGL(mega<3>, dim3(grid_blocks), dim3(NTHREADS), 0, stream, p);
  hipLaunchKernelGGL(mega<4>, dim3(grid_blocks), dim3(NTHREADS), 0, stream, p);
  hipLaunchKernelGGL(mega<5>, dim3(grid_blocks), dim3(NTHREADS), 0, stream, p);
  hipLaunchKernelGGL(mega<6>, dim3(grid_blocks), dim3(NTHREADS), 0, stream, p);
  hipLaunchKernelGGL(mega<7>, dim3(grid_blocks), dim3(NTHREADS), 0, stream, p);
#endif

}
```

```cpp
#include <hip/hip_runtime.h>
#include <stdint.h>
#include <stdio.h>

#ifndef ONE_LAUNCH
#define ONE_LAUNCH 1
#endif
#ifndef EARLY_INV
#define EARLY_INV 1
#endif
#ifndef PEER_ALIGN
#define PEER_ALIGN 1
#endif

typedef __bf16 bf16;
typedef __bf16 bf16x2 __attribute__((ext_vector_type(2)));
typedef __bf16 bf16x4 __attribute__((ext_vector_type(4)));
typedef __bf16 bf16x8 __attribute__((ext_vector_type(8)));
typedef float f32x2 __attribute__((ext_vector_type(2)));
typedef _Float16 f16x4h __attribute__((ext_vector_type(4)));
typedef float f32x4 __attribute__((ext_vector_type(4)));
typedef float f32x16 __attribute__((ext_vector_type(16)));
typedef unsigned u32x2 __attribute__((ext_vector_type(2)));
typedef unsigned u32x4 __attribute__((ext_vector_type(4)));

#define DI __device__ __forceinline__
#define MFMA(a, b, c) __builtin_amdgcn_mfma_f32_32x32x16_bf16((a), (b), (c), 0, 0, 0)

constexpr int DM = 1024, NB = 8, SEQ = 2048, NS = 128, NPR = NB * SEQ, NTOK = NPR + NS;
constexpr int INW = 3840, NMOD = NB + NS;
constexpr int C_K = 1024, C_V = 1152, C_PIN = 1280, C_GA = 1792, C_GB = 2816;
constexpr int GB0 = C_GA * 2;
constexpr int NEXP = 16384;
constexpr float EPS = 1e-6f;
constexpr size_t O_YP = 0, O_KWP = 16908288, O_VWP = 17039360, O_PP = 17170432, O_KWS = 17231872, O_VWS = 19329024, O_PS = 21426176;

constexpr int SMEM_BYTES = 77824;
constexpr int NTHREADS = 256;

struct P {
  const float *x_prompt, *x_sample, *cache_k, *cache_v, *state_pool, *c_prompt, *c_sample, *rel_table, *ada_w, *ada_b, *norm1_g, *w_in,
      *q_norm_g, *k_norm_g, *sinks, *pool_w, *pool_scale, *w_out, *norm2_g, *w_query, *sub_keys, *peer_u, *peer_v;
  float* out;
  char* ws;
};
constexpr size_t al256(size_t x) { return (x + 255) & ~(size_t)255; }
constexpr size_t OFF_BAR = 0;
constexpr size_t OFF_WTIN = OFF_BAR + al256(4096 * 4);
constexpr size_t OFF_WTOUT = OFF_WTIN + al256((size_t)INW * 1024 * 2);
constexpr size_t OFF_WTQ = OFF_WTOUT + al256((size_t)1024 * 1024 * 2);
constexpr size_t OFF_SK = OFF_WTQ + al256((size_t)2048 * 1024 * 2);
constexpr size_t OFF_PWT = OFF_SK + al256((size_t)16 * 128 * 128 * 2);
constexpr size_t OFF_UB = OFF_PWT + al256((size_t)4 * 256 * 128 * 2);
constexpr size_t OFF_VB = OFF_UB + al256((size_t)NEXP * DM);
constexpr size_t OFF_SU = OFF_VB + al256((size_t)NEXP * DM);
constexpr size_t OFF_SV = OFF_SU + al256((size_t)NEXP * 4);
constexpr size_t OFF_H8 = OFF_SV + al256((size_t)NEXP * 4);
constexpr size_t OFF_HS = OFF_H8 + al256((size_t)NTOK * DM);
constexpr size_t OFF_PART = OFF_HS + al256((size_t)NTOK * 4);
constexpr size_t OFF_MOD = OFF_PART + al256((size_t)4 * NS * DM * 4);
constexpr size_t OFF_BIAS = OFF_MOD + al256((size_t)NMOD * 6144 * 4);
constexpr size_t OFF_VT = OFF_BIAS + al256(16 * 128 * 4);
constexpr size_t OFF_H = OFF_VT + al256((size_t)NB * 128 * SEQ * 2);
constexpr size_t OFF_MIXED = OFF_H;
constexpr size_t OFF_PROJ = OFF_H + al256((size_t)NTOK * DM * 2);
constexpr size_t OFF_X1 = OFF_PROJ;
constexpr size_t OFF_IDX = OFF_X1 + (size_t)NTOK * DM * 4;
constexpr size_t OFF_GATE = OFF_IDX + (size_t)NTOK * 128 * 4;
constexpr size_t WS_NEED = OFF_PROJ + al256((size_t)NTOK * INW * 2);
static_assert(OFF_GATE + (size_t)NTOK * 128 * 4 <= WS_NEED, "overlay fits");
static_assert(WS_NEED <= (size_t)256 * 1024 * 1024, "workspace budget");
#define WS_PTR(T, name, OFF) __device__ __forceinline__ T* name(const P& p) { return (T*)(p.ws + (OFF)); }
WS_PTR(unsigned, w_bar, OFF_BAR) WS_PTR(bf16, w_Wt_in, OFF_WTIN) WS_PTR(bf16, w_Wt_out, OFF_WTOUT) WS_PTR(bf16, w_Wt_q, OFF_WTQ) WS_PTR(bf16, w_SK, OFF_SK)
WS_PTR(bf16, w_PWt, OFF_PWT) WS_PTR(unsigned char, w_Ub, OFF_UB) WS_PTR(unsigned char, w_Vb, OFF_VB) WS_PTR(float, w_SU, OFF_SU) WS_PTR(float, w_SV, OFF_SV) WS_PTR(unsigned char, w_H8, OFF_H8) WS_PTR(float, w_HS, OFF_HS) WS_PTR(float, w_PART, OFF_PART) WS_PTR(float, w_MOD, OFF_MOD) WS_PTR(float, w_BIAS, OFF_BIAS)
WS_PTR(bf16, w_VT, OFF_VT) WS_PTR(bf16, w_H, OFF_H) WS_PTR(bf16, w_MIXED, OFF_MIXED) WS_PTR(bf16, w_PROJ, OFF_PROJ) WS_PTR(bf16, w_X1, OFF_X1)
WS_PTR(int, w_IDX, OFF_IDX) WS_PTR(float, w_GATE, OFF_GATE)

DI int cond_row(int token) { return token < NPR ? (token >> 11) : (NB + token - NPR); }
DI int crow(int reg, int h) { return (reg & 3) + 8 * (reg >> 2) + 4 * h; }
DI const float* xrow(const P& p, int token) { return token < NPR ? p.x_prompt + (size_t)token * DM : p.x_sample + (size_t)(token - NPR) * DM; }

#define LDS_WAIT() asm volatile("s_waitcnt lgkmcnt(0)" ::: "memory")
DI int opaque0() { int z = 0; asm volatile("" : "+v"(z)); return z; }
DI float bf2f(bf16 v) { return (float)v; }
DI f32x4 ldx4(const bf16* q) { const u32x2 r = *(const u32x2*)q; return (f32x4){__uint_as_float(r[0] << 16), __uint_as_float(r[0] & 0xffff0000u), __uint_as_float(r[1] << 16), __uint_as_float(r[1] & 0xffff0000u)}; }
DI void stx4(bf16* q, f32x4 v) { bf16x4 o; o[0] = (bf16)v[0]; o[1] = (bf16)v[1]; o[2] = (bf16)v[2]; o[3] = (bf16)v[3]; *(bf16x4*)q = o; }
DI f32x16 zero16() { f32x16 z; for (int i = 0; i < 16; ++i) z[i] = 0.f; return z; }
DI bf16x8 pack_step(const f32x16& x, int s) { bf16x8 v; for (int j = 0; j < 8; ++j) v[j] = (bf16)x[8 * s + j]; return v; }
DI bf16x8 cat4(bf16x4 lo, bf16x4 hi) { return __builtin_shufflevector(lo, hi, 0, 1, 2, 3, 4, 5, 6, 7); }
DI float wave_sum(float v) { for (int o = 32; o >= 1; o >>= 1) v += __shfl_xor(v, o); return v; }

#define XB_TMO 128
#define XB_XCNT(j) (256 + 64 * (j))
#define XB_XSUB(j) (1280 + 64 * (j))
#define XB_XGEN(j) (2304 + 64 * (j))
#define XB_TOP 3328
#define XB_TOPGEN 3392
#define XCD_BAR_WORDS 3456
#define XB_SPIN_CAP (1u << 22)
DI unsigned xb_ld(unsigned* p) { return __hip_atomic_load(p, __ATOMIC_RELAXED, __HIP_MEMORY_SCOPE_AGENT); }
DI unsigned xb_add(unsigned* p, unsigned v) { return __hip_atomic_fetch_add(p, v, __ATOMIC_RELAXED, __HIP_MEMORY_SCOPE_AGENT); }
DI unsigned xb_xcc_id() { return (unsigned)__builtin_amdgcn_s_getreg((3 << 11) | 20) & 0xFu; }
#define XB_SPIN(cond, bar) do { unsigned _sp = 0; while (cond) { __builtin_amdgcn_s_sleep(1); \
    if ((++_sp & 255u) == 0u) { if (xb_ld(&(bar)[XB_TMO])) break; if (_sp > XB_SPIN_CAP) { atomicAdd(&(bar)[XB_TMO], 1u); break; } } } } while (0)

DI void xcd_barrier_complete(unsigned* bar, unsigned x, unsigned& nloc, unsigned& nx) {
  const unsigned G = gridDim.x;
  unsigned sum, cnt, mine, sp = 0u;
  for (;;) {
    sum = 0u; cnt = 0u; mine = 0u;
#pragma unroll
    for (unsigned j = 0; j < 16; ++j) { const unsigned c = xb_ld(&bar[XB_XCNT(j)]); sum += c; cnt += (c > 0u) ? 1u : 0u; mine = (j == x) ? c : mine; }
    if (sum == G) break;
    __builtin_amdgcn_s_sleep(1);
    if ((++sp & 255u) == 0u) { if (xb_ld(&bar[XB_TMO])) break; if (sp > XB_SPIN_CAP) { atomicAdd(&bar[XB_TMO], 1u); break; } }
  }
  nloc = mine > 0u ? mine : 1u; nx = cnt > 0u ? cnt : 1u;
}
DI void xcd_barrier(unsigned* bar, unsigned x, volatile unsigned* st) {
  asm volatile("s_waitcnt vmcnt(0)" ::: "memory");
  __syncthreads();
  if (threadIdx.x == 0) {
    __builtin_amdgcn_s_waitcnt(0);
    unsigned nloc = st[0], nx = st[1];
    if (nloc == 0u) { xcd_barrier_complete(bar, x, nloc, nx); st[0] = nloc; st[1] = nx; }
    const unsigned old = xb_add(&bar[XB_XSUB(x)], 1u);
    const unsigned gen = old / nloc;
    const bool leader = old + 1u == (gen + 1u) * nloc;
    if (leader) {
      __builtin_amdgcn_fence(__ATOMIC_RELEASE, "agent");
      asm volatile("s_waitcnt vmcnt(0)" ::: "memory");
    }
    if (leader) {
      const unsigned og = xb_add(&bar[XB_TOP], 1u);
      const unsigned tg = og / nx;
      if (og + 1u == (tg + 1u) * nx) {
#pragma unroll
        for (unsigned j = 0; j < 16; ++j) (void)xb_add(&bar[XB_XGEN(j)], 1u);
      } else XB_SPIN(xb_ld(&bar[XB_XGEN(x)]) == gen, bar);
      __builtin_amdgcn_fence(__ATOMIC_ACQUIRE, "agent");
    } else {
#if EARLY_INV
      __builtin_amdgcn_fence(__ATOMIC_ACQUIRE, "agent");
#endif
      XB_SPIN(xb_ld(&bar[XB_XGEN(x)]) == gen, bar);
#if !EARLY_INV
      __builtin_amdgcn_fence(__ATOMIC_ACQUIRE, "agent");
#endif
    }
    asm volatile("s_waitcnt vmcnt(0)" ::: "memory");
  }
  __syncthreads();
}

constexpr int U0_MOD = 192;
constexpr int U0_TIN = (1024 / 64) * (INW / 64);
constexpr int F0_TOTAL = U0_TIN + 1;
constexpr int U0_TPW = 4 * 2 * 4;
constexpr int U0_CSK = 32;
constexpr int U0_KW = 128, U0_VW = 128, U0_PW = 128;
constexpr int F2_TOUT = 16 * 16, F2_TQ = 16 * 32, F2_E1 = F2_TOUT + F2_TQ, F2_E2 = F2_E1 + U0_TPW, F2_E3 = F2_E2 + U0_KW, F2_E4 = F2_E3 + U0_VW,
              F2_TOTAL = F2_E4 + U0_PW;
constexpr int F4_TOTAL = U0_CSK;
constexpr int F4_QU = 1070;
constexpr int F6_QU = 2048 - F4_QU, F6_QV = 2048, F6_TOTAL = F6_QU + F6_QV;

DI float silu_f(float x) { return x * __builtin_amdgcn_rcpf(1.f + __expf(-x)); }

DI void unit_mod(const P& p, int u, char* smem) {
  const int t = threadIdx.x + opaque0(), lane = t & 63, w = t >> 6, r = lane & 31, h = lane >> 5;
  const int f0 = u * 32;
  f32x16 acc[5];
#pragma unroll
  for (int i = 0; i < 5; ++i) acc[i] = zero16();
  const float* wp = p.ada_w + (size_t)(w * 256 + 8 * h) * 6144 + f0 + r;
  const float* cp[5];
#pragma unroll
  for (int i = 0; i < 5; ++i) { const int m = 32 * i + r, mm = m < NMOD ? m : 0; cp[i] = (mm < NB ? p.c_prompt + (size_t)mm * DM : p.c_sample + (size_t)(mm - NB) * DM) + w * 256 + 8 * h; }
  float wv[4][8]; f32x4 cv[5][2];
#pragma unroll
  for (int s = 0; s < 3; ++s)
#pragma unroll
    for (int j = 0; j < 8; ++j) wv[s][j] = wp[(size_t)(s * 16 + j) * 6144];
#pragma unroll
  for (int i = 0; i < 5; ++i) { cv[i][0] = *(const f32x4*)cp[i]; cv[i][1] = *(const f32x4*)(cp[i] + 4); }
#pragma unroll 1
  for (int ks0 = 0; ks0 < 16; ks0 += 4) {
#pragma unroll
    for (int u = 0; u < 4; ++u) {
      const int ks = ks0 + u;
      bf16x8 bfr, afr[5];
#pragma unroll
      for (int j = 0; j < 8; ++j) bfr[j] = (bf16)wv[u][j];
#pragma unroll
      for (int i = 0; i < 5; ++i) {
        const bool ok = 32 * i + r < NMOD;
#pragma unroll
        for (int j = 0; j < 8; ++j) afr[i][j] = (bf16)(ok ? silu_f(cv[i][j >> 2][j & 3]) : 0.f);
      }
      const int kw = ks + 3 < 16 ? ks + 3 : 15, kn = ks + 1 < 16 ? ks + 1 : 15;
#pragma unroll
      for (int i = 0; i < 5; ++i) { cv[i][0] = *(const f32x4*)(cp[i] + kn * 16); cv[i][1] = *(const f32x4*)(cp[i] + kn * 16 + 4); }
#pragma unroll
      for (int j = 0; j < 8; ++j) wv[(u + 3) & 3][j] = wp[(size_t)(kw * 16 + j) * 6144];
#pragma unroll
      for (int i = 0; i < 5; ++i) acc[i] = MFMA(afr[i], bfr, acc[i]);
    }
  }
  float* red = (float*)smem;
  __syncthreads();
  if (w > 0) {
#pragma unroll
    for (int i = 0; i < 5; ++i)
#pragma unroll
      for (int j = 0; j < 16; ++j) red[((w - 1) * 80 + i * 16 + j) * 64 + lane] = acc[i][j];
  }
  __syncthreads();
  if (w == 0) {
    const float bias = p.ada_b[f0 + r];
#pragma unroll
    for (int i = 0; i < 5; ++i)
#pragma unroll
      for (int j = 0; j < 16; ++j) {
        const int m = 32 * i + crow(j, h);
        const float v = acc[i][j] + red[(0 * 80 + i * 16 + j) * 64 + lane] + red[(1 * 80 + i * 16 + j) * 64 + lane] + red[(2 * 80 + i * 16 + j) * 64 + lane] + bias;
        if (m < NMOD) w_MOD(p)[(size_t)m * 6144 + f0 + r] = v;
      }
  }
}

DI void unit_transpose(const float* __restrict__ src, bf16* __restrict__ dst, int R, int C, int tr, int tc, char* smem, const float* __restrict__ rowscale = nullptr) {
  float* tile = (float*)smem;
  const int t = threadIdx.x + opaque0();
  __syncthreads();
#pragma unroll
  for (int i = 0; i < 4; ++i) {
    const int rr = (t >> 4) + 16 * i, cc = (t & 15) * 4;
    const f32x4 v = *(const f32x4*)(src + (size_t)(tr * 64 + rr) * C + tc * 64 + cc);
    tile[rr * 65 + cc] = v[0]; tile[rr * 65 + cc + 1] = v[1]; tile[rr * 65 + cc + 2] = v[2]; tile[rr * 65 + cc + 3] = v[3];
  }
  __syncthreads();
#pragma unroll
  for (int i = 0; i < 2; ++i) {
    const int orow = (t >> 3) + 32 * i, seg = (t & 7) * 8;
    const float sc = rowscale ? rowscale[tc * 64 + orow] : 1.f;
    bf16x8 v;
#pragma unroll
    for (int j = 0; j < 8; ++j) v[j] = (bf16)(tile[(seg + j) * 65 + orow] * sc);
    *(bf16x8*)(dst + (size_t)(tc * 64 + orow) * R + tr * 64 + seg) = v;
  }
}
DI void unit_convert(const float* __restrict__ src, bf16* __restrict__ dst, int u) {
  const size_t base = (size_t)u * 8192 + (threadIdx.x + opaque0()) * 8;
  f32x4 av[4], bv[4];
#pragma unroll
  for (int i = 0; i < 4; ++i) { const size_t o = base + (size_t)i * 2048; av[i] = *(const f32x4*)(src + o); bv[i] = *(const f32x4*)(src + o + 4); }
#pragma unroll
  for (int i = 0; i < 4; ++i) {
    const size_t o = base + (size_t)i * 2048;
    const f32x4 a = av[i], b = bv[i];
    bf16x8 v; v[0] = (bf16)a[0]; v[1] = (bf16)a[1]; v[2] = (bf16)a[2]; v[3] = (bf16)a[3]; v[4] = (bf16)b[0]; v[5] = (bf16)b[1]; v[6] = (bf16)b[2]; v[7] = (bf16)b[3];
    *(bf16x8*)(dst + o) = v;
  }
}
DI unsigned pack_i8(float a, float b, float c, float d) {
  const int ia = max(-127, min(127, __float2int_rn(a))), ib = max(-127, min(127, __float2int_rn(b))), ic = max(-127, min(127, __float2int_rn(c))), id = max(-127, min(127, __float2int_rn(d)));
  return (unsigned)(ia & 255) | ((unsigned)(ib & 255) << 8) | ((unsigned)(ic & 255) << 16) | ((unsigned)(id & 255) << 24);
}
template <bool I8>
DI void unit_quant_rows(const float* __restrict__ src, unsigned char* __restrict__ dst, float* __restrict__ scale, int u) {
  const int t = threadIdx.x + opaque0(), lane = t & 63, w = t >> 6;
  f32x4 vv[2][4];
#pragma unroll
  for (int rr = 0; rr < 2; ++rr)
#pragma unroll
    for (int i = 0; i < 4; ++i) vv[rr][i] = *(const f32x4*)(src + ((size_t)u * 8 + 2 * w + rr) * DM + 16 * lane + 4 * i);
#pragma unroll
  for (int rr = 0; rr < 2; ++rr) {
    const size_t row = (size_t)u * 8 + 2 * w + rr;
    f32x4 v[4];
    float amax = 0.f;
#pragma unroll
    for (int i = 0; i < 4; ++i) { v[i] = vv[rr][i]; amax = fmaxf(amax, fmaxf(fmaxf(fabsf(v[i][0]), fabsf(v[i][1])), fmaxf(fabsf(v[i][2]), fabsf(v[i][3])))); }
#pragma unroll
    for (int o = 32; o >= 1; o >>= 1) amax = fmaxf(amax, __shfl_xor(amax, o));
    const float sc = amax > 0.f ? amax * (I8 ? 1.f / 127.f : 1.f / 440.f) : 1.f, inv = 1.f / sc;
    u32x4 q;
#pragma unroll
    for (int i = 0; i < 4; ++i) {
      if (I8) {
        q[i] = pack_i8(v[i][0] * inv, v[i][1] * inv, v[i][2] * inv, v[i][3] * inv);
      } else {
        int wd = 0;
        wd = __builtin_amdgcn_cvt_pk_fp8_f32(v[i][0] * inv, v[i][1] * inv, wd, false);
        wd = __builtin_amdgcn_cvt_pk_fp8_f32(v[i][2] * inv, v[i][3] * inv, wd, true);
        q[i] = (unsigned)wd;
      }
    }
    *(u32x4*)(dst + row * DM + 16 * lane) = q;
    if (lane == 0) scale[row] = sc;
  }
}
DI void unit_copy_f4(const float* __restrict__ src, float* __restrict__ dst, int n4) {
  for (int i0 = threadIdx.x + opaque0(); i0 < n4; i0 += 8 * NTHREADS) {
    f32x4 v[8];
#pragma unroll
    for (int k = 0; k < 8; ++k) { const int i = i0 + k * NTHREADS; v[k] = ((const f32x4*)src)[i < n4 ? i : n4 - 1]; }
#pragma unroll
    for (int k = 0; k < 8; ++k) { const int i = i0 + k * NTHREADS; if (i < n4) ((f32x4*)dst)[i] = v[k]; }
  }
}

DI void phase0_filler(const P& p, int f, char* smem) {
  if (f < U0_TIN) { __builtin_amdgcn_s_sleep(127); unit_transpose(p.w_in, w_Wt_in(p), 1024, INW, f / 60, f % 60, smem); }
  else {
    for (int i = threadIdx.x + opaque0(); i < 16 * 128; i += NTHREADS) {
      const int head = i >> 7, d = i & 127;
      int bk = d;
      if (d >= 16) { bk = 16 + (int)(logf((float)d / 16.f) / logf(8.f) * 16.f); bk = bk > 31 ? 31 : bk; }
      w_BIAS(p)[i] = p.rel_table[bk * 16 + head];
    }
  }
}
DI void phase2_filler(const P& p, int f, char* smem) {
  if (f < F2_TOUT) unit_transpose(p.w_out, w_Wt_out(p), 1024, 1024, f / 16, f % 16, smem);
  else if (f < F2_E1) { const int v = f - F2_TOUT; unit_transpose(p.w_query, w_Wt_q(p), 1024, 2048, v / 32, v % 32, smem); }
  else if (f < F2_E2) { const int v = f - F2_E1, g = v >> 3, tt = v & 7; unit_transpose(p.pool_w + (size_t)g * 128 * 256, w_PWt(p) + (size_t)g * 256 * 128, 128, 256, tt >> 2, tt & 3, smem, p.pool_scale + g * 256); }
  else if (f < F2_E3) { const int b = f - F2_E2; unit_copy_f4(p.cache_k + ((size_t)b * 128 + 1) * 128, p.out + O_KWS + (size_t)b * 128 * 128, 127 * 128 / 4); }
  else if (f < F2_E4) { const int b = f - F2_E3; unit_copy_f4(p.cache_v + ((size_t)b * 128 + 1) * 128, p.out + O_VWS + (size_t)b * 128 * 128, 127 * 128 / 4); }
  else { const int b = f - F2_E4; unit_copy_f4(p.state_pool + ((size_t)b * 15 + 1) * 512, p.out + O_PS + (size_t)b * 15 * 512, 14 * 512 / 4); }
}

template <int NR>
DI void norm_rows(const P& p, int tok0, int tstride, int which) {
  const int lane = (threadIdx.x + opaque0()) & 63;
  const float* g = which == 0 ? p.norm1_g : p.norm2_g;
  f32x4 v[NR][4], gg[4], sh[NR][4], sc[NR][4];
  float ss[NR];
#pragma unroll
  for (int i = 0; i < 4; ++i) gg[i] = *(const f32x4*)(g + 4 * lane + 256 * i);
#pragma unroll
  for (int k = 0; k < NR; ++k) {
    const int token = tok0 + k * tstride;
    const float* mod = w_MOD(p) + (size_t)cond_row(token) * 6144 + (which == 0 ? 0 : 3072);
#pragma unroll
    for (int i = 0; i < 4; ++i) { const int c = 4 * lane + 256 * i; sh[k][i] = *(const f32x4*)(mod + c); sc[k][i] = *(const f32x4*)(mod + 1024 + c); }
  }
  bool assembled = false;
  if constexpr (NR == 1) {
    if (which == 1 && tok0 >= NPR) {
      assembled = true;
      const int token = tok0;
      const float* g1 = w_MOD(p) + (size_t)cond_row(token) * 6144 + 2048;
      f32x4 xv[4], gv[4], pa[4], pb[4], pc[4], pd[4];
#pragma unroll
      for (int i = 0; i < 4; ++i) {
        const int c = 4 * lane + 256 * i;
        const size_t po = (size_t)(token - NPR) * DM + c;
        xv[i] = *(const f32x4*)(xrow(p, token) + c); gv[i] = *(const f32x4*)(g1 + c);
        pa[i] = *(const f32x4*)(w_PART(p) + po); pb[i] = *(const f32x4*)(w_PART(p) + (size_t)NS * DM + po);
        pc[i] = *(const f32x4*)(w_PART(p) + (size_t)2 * NS * DM + po); pd[i] = *(const f32x4*)(w_PART(p) + (size_t)3 * NS * DM + po);
      }
      ss[0] = 0.f;
#pragma unroll
      for (int i = 0; i < 4; ++i) {
#pragma unroll
        for (int j = 0; j < 4; ++j) v[0][i][j] = xv[i][j] + gv[i][j] * ((pa[i][j] + pb[i][j]) + (pc[i][j] + pd[i][j]));
        ss[0] += v[0][i][0] * v[0][i][0] + v[0][i][1] * v[0][i][1] + v[0][i][2] * v[0][i][2] + v[0][i][3] * v[0][i][3];
      }
#pragma unroll
      for (int i = 0; i < 4; ++i) stx4(w_X1(p) + (size_t)token * DM + 4 * lane + 256 * i, v[0][i]);
    }
  }
  if (!assembled) {
#pragma unroll
    for (int k = 0; k < NR; ++k) {
      const int token = tok0 + k * tstride;
#pragma unroll
      for (int i = 0; i < 4; ++i) v[k][i] = which == 0 ? *(const f32x4*)(xrow(p, token) + 4 * lane + 256 * i) : ldx4(w_X1(p) + (size_t)token * DM + 4 * lane + 256 * i);
    }
#pragma unroll
    for (int k = 0; k < NR; ++k) {
      ss[k] = 0.f;
#pragma unroll
      for (int i = 0; i < 4; ++i) ss[k] += v[k][i][0] * v[k][i][0] + v[k][i][1] * v[k][i][1] + v[k][i][2] * v[k][i][2] + v[k][i][3] * v[k][i][3];
    }
  }
#pragma unroll
  for (int k = 0; k < NR; ++k) {
    const int token = tok0 + k * tstride;
    const float rstd = rsqrtf(wave_sum(ss[k]) * (1.f / DM) + EPS);
#pragma unroll
    for (int i = 0; i < 4; ++i) {
      const int c = 4 * lane + 256 * i;
      bf16x4 o;
#pragma unroll
      for (int j = 0; j < 4; ++j) { v[k][i][j] = (v[k][i][j] * rstd * gg[i][j]) * (1.f + sc[k][i][j]) + sh[k][i][j]; o[j] = (bf16)v[k][i][j]; }
      *(bf16x4*)(w_H(p) + (size_t)token * DM + c) = o;
    }
    if (which == 1) {
      float amax = 0.f;
#pragma unroll
      for (int i = 0; i < 4; ++i) amax = fmaxf(amax, fmaxf(fmaxf(fabsf(v[k][i][0]), fabsf(v[k][i][1])), fmaxf(fabsf(v[k][i][2]), fabsf(v[k][i][3]))));
#pragma unroll
      for (int o = 32; o >= 1; o >>= 1) amax = fmaxf(amax, __shfl_xor(amax, o));
      const float qs = amax > 0.f ? amax * (1.f / 127.f) : 1.f, inv = 1.f / qs;
#pragma unroll
      for (int i = 0; i < 4; ++i) *(unsigned*)(w_H8(p) + (size_t)token * DM + 4 * lane + 256 * i) = pack_i8(v[k][i][0] * inv, v[k][i][1] * inv, v[k][i][2] * inv, v[k][i][3] * inv);
      if (lane == 0) w_HS(p)[token] = qs;
    }
  }
}
DI void norm_phase(const P& p, int which) {
  const int G = gridDim.x, bid = blockIdx.x, w = __builtin_amdgcn_readfirstlane(threadIdx.x >> 6);
  int tk = bid * 4 + w;
  for (; tk + G * 4 < NPR; tk += 2 * G * 4) norm_rows<2>(p, tk, G * 4, which);
  for (; tk < NTOK; tk += G * 4) norm_rows<1>(p, tk, 0, which);
}

constexpr int LDSK = 72;
constexpr int GT = 128 * 64 * 2;
constexpr int GBUF = 2 * GT;
typedef __attribute__((address_space(3))) unsigned lds_u32;
typedef const __attribute__((address_space(1))) unsigned glb_u32;
DI void glds16(const void* g, char* l) { __builtin_amdgcn_global_load_lds((glb_u32*)g, (lds_u32*)l, 16, 0, 0); }
DI void gemm_first(const bf16* __restrict__ Wt, const bf16* __restrict__ X, int ld, int n0, int m0, char* smem) {
  const int t = threadIdx.x + opaque0(), lane = t & 63;
  const int w = __builtin_amdgcn_readfirstlane(t >> 6);
  const int swz = (lane & 7) ^ ((4 * w + (lane >> 4)) & 7);
  const bf16* ga = Wt + (size_t)(n0 + 8 * w + (lane >> 3)) * ld + swz * 8;
  const bf16* gb = X + (size_t)(m0 + 8 * w + (lane >> 3)) * ld + swz * 8;
#pragma unroll
  for (int q = 0; q < 4; ++q) { glds16(ga + (size_t)(32 * q) * ld, smem + 1024 * (w + 4 * q)); glds16(gb + (size_t)(32 * q) * ld, smem + GT + 1024 * (w + 4 * q)); }
}
DI void gemm_main(const bf16* __restrict__ Wt, const bf16* __restrict__ X, int ld, int K, int n0, int m0, char* smem, f32x16 (&acc)[4]) {
  const int t = threadIdx.x + opaque0(), lane = t & 63, r = lane & 31, h = lane >> 5;
  const int w = __builtin_amdgcn_readfirstlane(t >> 6);
#pragma unroll
  for (int i = 0; i < 4; ++i) acc[i] = zero16();
  const int swz = (lane & 7) ^ ((4 * w + (lane >> 4)) & 7);
  const bf16* ga = Wt + (size_t)(n0 + 8 * w + (lane >> 3)) * ld + swz * 8;
  const bf16* gb = X + (size_t)(m0 + 8 * w + (lane >> 3)) * ld + swz * 8;
  const int sw = (r >> 1) & 7;
  const int KT = K >> 6;
  asm volatile("s_waitcnt vmcnt(0)" ::: "memory");
  __syncthreads();
  for (int kt = 0; kt < KT; ++kt) {
    const char* As = smem + (kt & 1) * GBUF;
    const char* Bs = As + GT;
    if (kt + 1 < KT) {
      char* An = smem + ((kt + 1) & 1) * GBUF;
      const int k0 = (kt + 1) * 64;
#pragma unroll
      for (int q = 0; q < 4; ++q) { glds16(ga + (size_t)(32 * q) * ld + k0, An + 1024 * (w + 4 * q)); glds16(gb + (size_t)(32 * q) * ld + k0, An + GT + 1024 * (w + 4 * q)); }
    }
#pragma unroll
    for (int s = 0; s < 4; ++s) {
      const int co = ((2 * s + h) ^ sw) * 16;
      const bf16x8 bfr = *(const bf16x8*)(Bs + (32 * w + r) * 128 + co);
#pragma unroll
      for (int i = 0; i < 4; ++i) {
        const bf16x8 afr = *(const bf16x8*)(As + (32 * i + r) * 128 + co);
        acc[i] = MFMA(afr, bfr, acc[i]);
      }
    }
    asm volatile("s_waitcnt vmcnt(0)" ::: "memory");
    __syncthreads();
  }
}

DI float sigmoid_f(float x) { return __builtin_amdgcn_rcpf(1.f + __expf(-x)); }

DI void gemm1_map(int u, int& mt, int& nt) {
  const int v = u < 3584 ? (u & ~511) + (u & 7) * 64 + ((u >> 3) & 63) : u;
  mt = v / 30; nt = v % 30;
}
DI void unit_gemm1(const P& p, int u, int un, char* smem) {
  int mt, nt; gemm1_map(u, mt, nt);
  const int n0 = nt * 128, m0 = mt * 128;
  f32x16 acc[4];
  gemm_main(w_Wt_in(p), w_H(p), 1024, 1024, n0, m0, smem, acc);
  if (un >= 0) { int mn, nn; gemm1_map(un, mn, nn); gemm_first(w_Wt_in(p), w_H(p), 1024, nn * 128, mn * 128, smem); }
  const int tz = threadIdx.x + opaque0();
  const int lane = tz & 63, w = tz >> 6, r = lane & 31, h = lane >> 5;
  const int token = m0 + 32 * w + r;
  bf16* tw = (bf16*)(smem + GBUF + (tz >> 6) * 8704) + r * 136;
  const bool is_prompt = token < NPR;
  const int b = is_prompt ? (token >> 11) : (token - NPR), pos = token & (SEQ - 1);
  if (n0 < C_V) {
    const float* gn = n0 < C_K ? p.q_norm_g : p.k_norm_g;
    const float post = n0 < C_K ? 0.125f : 1.f;
#pragma unroll
    for (int hh = 0; hh < 2; ++hh) {
      float ss = 0.f;
#pragma unroll
      for (int i = 0; i < 2; ++i)
#pragma unroll
        for (int j = 0; j < 16; ++j) ss += acc[2 * hh + i][j] * acc[2 * hh + i][j];
      ss += __shfl_xor(ss, 32);
      const float rstd = rsqrtf(ss * (1.f / 64.f) + EPS);
#pragma unroll
      for (int i = 0; i < 2; ++i)
#pragma unroll
        for (int q4 = 0; q4 < 4; ++q4) {
          const int d = 32 * i + 8 * q4 + 4 * h;
          const f32x4 gg = *(const f32x4*)(gn + d);
          f32x4 v;
#pragma unroll
          for (int j = 0; j < 4; ++j) v[j] = acc[2 * hh + i][4 * q4 + j] * rstd * gg[j];
          bf16x4 o;
#pragma unroll
          for (int j = 0; j < 4; ++j) o[j] = (bf16)(v[j] * post);
          *(bf16x4*)(tw + 64 * hh + d) = o;
          if (n0 == C_K) {
            if (is_prompt) { if (pos >= SEQ - 128) *(f32x4*)(p.out + O_KWP + ((size_t)b * 128 + (pos - (SEQ - 128))) * 128 + 64 * hh + d) = v; }
            else *(f32x4*)(p.out + O_KWS + ((size_t)b * 128 + 127) * 128 + 64 * hh + d) = v;
          }
        }
    }
  } else if (n0 == C_V) {
#pragma unroll
    for (int i = 0; i < 4; ++i)
#pragma unroll
      for (int q4 = 0; q4 < 4; ++q4) {
        const int f = 32 * i + 8 * q4 + 4 * h;
        f32x4 v;
#pragma unroll
        for (int j = 0; j < 4; ++j) v[j] = acc[i][4 * q4 + j];
        if (is_prompt) {
#pragma unroll
          for (int j = 0; j < 4; ++j) ((bf16*)(smem + GBUF))[(f + j) * 136 + 32 * w + r] = (bf16)v[j];
          if (pos >= SEQ - 128) *(f32x4*)(p.out + O_VWP + ((size_t)b * 128 + (pos - (SEQ - 128))) * 128 + f) = v;
        } else *(f32x4*)(p.out + O_VWS + ((size_t)b * 128 + 127) * 128 + f) = v;
      }
    if (m0 < NPR) {
      __syncthreads();
      const bf16* T = (const bf16*)(smem + GBUF);
      const int bb = m0 >> 11, pos0 = m0 & (SEQ - 1);
#pragma unroll
      for (int it = 0; it < 8; ++it) {
        const int fr = 16 * it + (tz >> 4), c = tz & 15;
        *(u32x4*)(w_VT(p) + ((size_t)bb * 128 + fr) * SEQ + pos0 + c * 8) = *(const u32x4*)(T + fr * 136 + c * 8);
      }
    }
  } else if (n0 < C_GA) {
#pragma unroll
    for (int i = 0; i < 4; ++i)
#pragma unroll
      for (int q4 = 0; q4 < 4; ++q4) {
        const int f = n0 + 32 * i + 8 * q4 + 4 * h;
        f32x4 v; bf16x4 o;
#pragma unroll
        for (int j = 0; j < 4; ++j) { v[j] = acc[i][4 * q4 + j]; o[j] = (bf16)v[j]; }
        *(bf16x4*)(tw + (f - n0)) = o;
        if (is_prompt) { if (pos >= SEQ - 15) *(f32x4*)(p.out + O_PP + ((size_t)b * 15 + (pos - (SEQ - 15))) * 512 + (f - C_PIN)) = v; }
        else *(f32x4*)(p.out + O_PS + ((size_t)b * 15 + 14) * 512 + (f - C_PIN)) = v;
      }
  } else {
    unsigned char* tw8 = (unsigned char*)(smem + GBUF + (tz >> 6) * 8704) + r * 144;
#pragma unroll
    for (int i = 0; i < 4; ++i)
#pragma unroll
      for (int q4 = 0; q4 < 4; ++q4) {
        unsigned wq = 0u;
#pragma unroll
        for (int j = 0; j < 4; ++j) wq |= (unsigned)__float2int_rn(sigmoid_f(acc[i][4 * q4 + j]) * 255.f) << (8 * j);
        *(unsigned*)(tw8 + 32 * i + 8 * q4 + 4 * h) = wq;
      }
    LDS_WAIT();
    const unsigned char* tr8 = (const unsigned char*)(smem + GBUF + (tz >> 6) * 8704);
    unsigned char* pg8 = (unsigned char*)w_PROJ(p) + (size_t)(m0 + 32 * w + (lane >> 3)) * (INW * 2) + GB0 + (n0 - C_GA) + (lane & 7) * 16;
#pragma unroll
    for (int it = 0; it < 4; ++it) *(u32x4*)(pg8 + (size_t)(8 * it) * (INW * 2)) = *(const u32x4*)(tr8 + ((lane >> 3) + 8 * it) * 144 + (lane & 7) * 16);
    return;
  }
  if (n0 != C_V) {
    LDS_WAIT();
    const bf16* tr = (const bf16*)(smem + GBUF + (tz >> 6) * 8704);
    bf16* pg = w_PROJ(p) + (size_t)(m0 + 32 * w + (lane >> 4)) * INW + n0 + (lane & 15) * 8;
#pragma unroll
    for (int it = 0; it < 8; ++it) *(u32x4*)(pg + (size_t)(4 * it) * INW) = *(const u32x4*)(tr + ((lane >> 4) + 4 * it) * 136 + (lane & 15) * 8);
  }
}

constexpr int VTS = 260;
constexpr int RS = 136;
DI void attn_head(const P& p, int head, int blk, int w, int r, int h, const bf16x8 (&qf)[4], const bf16* Ks, const bf16* VTs, const float* bsh, bf16x8 (&ob)[4]) {
  const int qi = 32 * w + r;
  f32x16 st[5];
#pragma unroll
  for (int tt = 0; tt < 5; ++tt) {
    st[tt] = zero16();
#pragma unroll
    for (int s = 0; s < 4; ++s) {
      const bf16x8 a = *(const bf16x8*)(Ks + (32 * (w + tt) + r) * LDSK + 16 * s + 8 * h);
      st[tt] = MFMA(a, qf[s], st[tt]);
    }
  }
  const float sink = p.sinks[head];
  float m = -INFINITY;
  {
    const int x = 31 - r + 4 * h;
    const float* bl = bsh + x;
#pragma unroll
    for (int tt = 0; tt < 5; ++tt)
#pragma unroll
      for (int j = 0; j < 16; ++j) {
        const int c = 32 * tt + (j & 3) + 8 * (j >> 2);
        const float s = st[tt][j] + bl[c];
        st[tt][j] = s;
        m = fmaxf(m, s);
      }
    if (blk == 0) {
      m = -INFINITY;
#pragma unroll
      for (int tt = 0; tt < 5; ++tt)
#pragma unroll
        for (int j = 0; j < 16; ++j) {
          const int c = 32 * tt + (j & 3) + 8 * (j >> 2);
          const float s = (159 - (x + c) > qi) ? -INFINITY : st[tt][j];
          st[tt][j] = s;
          m = fmaxf(m, s);
        }
    }
  }
  m = fmaxf(m, __shfl_xor(m, 32));
  m = fmaxf(m, sink);
  float sum = 0.f;
#pragma unroll
  for (int tt = 0; tt < 5; ++tt)
#pragma unroll
    for (int j = 0; j < 16; ++j) { const float e = __expf(st[tt][j] - m); st[tt][j] = e; sum += e; }
  sum += __shfl_xor(sum, 32);
  const float inv = 1.f / (sum + __expf(sink - m));
  f32x16 o[2] = {zero16(), zero16()};
#pragma unroll
  for (int tt = 0; tt < 5; ++tt)
#pragma unroll
    for (int s = 0; s < 2; ++s) {
      const bf16x8 pb = pack_step(st[tt], s);
#pragma unroll
      for (int i = 0; i < 2; ++i) {
        const bf16* vp = VTs + (32 * i + r) * VTS + 32 * (w + tt) + 16 * s + 4 * h;
        const bf16x8 a = cat4(*(const bf16x4*)vp, *(const bf16x4*)(vp + 8));
        o[i] = MFMA(a, pb, o[i]);
      }
    }
#pragma unroll
  for (int i = 0; i < 2; ++i)
#pragma unroll
    for (int j = 0; j < 16; ++j) ob[2 * i + (j >> 3)][j & 7] = (bf16)(o[i][j] * inv);
}
DI void pin_regs(bf16x8 (&ob)[4]) {
#pragma unroll
  for (int k = 0; k < 4; ++k) { const bf16x8 o = ob[k]; u32x4 x = __builtin_bit_cast(u32x4, o); asm volatile("" : "+v"(x)); ob[k] = __builtin_bit_cast(bf16x8, x); }
}
DI void unit_attn_prompt(const P& p, int u0, char* smem) {
  const int u = (u0 & ~511) + (u0 & 7) * 64 + ((u0 >> 3) & 63);
  const int b = u >> 6, blk = (u >> 2) & 15, g = u & 3, hk = g >> 1, win = 2 << g;
  const int qpos0 = blk * 128;
  const int t = threadIdx.x + opaque0(), lane = t & 63, w = t >> 6, r = lane & 31, h = lane >> 5;
  bf16* Ks = (bf16*)smem;
  bf16* VTs = Ks + 256 * LDSK;
  float* bs = (float*)(VTs + 64 * VTS);
  bf16* Rs = Ks;
  char* PSt = smem + 256 * LDSK * 2;
  __syncthreads();
  const size_t tokq = (size_t)b * SEQ + qpos0 + 32 * w + r;
  {
    u32x4 kv[8], vv[8];
#pragma unroll
    for (int i = 0; i < 8; ++i) {
      const int c = t + 256 * i, row = c >> 3, c16 = c & 7, kp = qpos0 - 128 + row;
      kv[i] = *(const u32x4*)(w_PROJ(p) + ((size_t)b * SEQ + (kp > 0 ? kp : 0)) * INW + C_K + hk * 64 + c16 * 8);
    }
#pragma unroll
    for (int i = 0; i < 8; ++i) {
      const int c = t + 256 * i, drow = c >> 5, c16 = c & 31, kp0 = qpos0 - 128 + c16 * 8;
      vv[i] = *(const u32x4*)(w_VT(p) + ((size_t)(b * 2 + hk) * 64 + drow) * SEQ + (kp0 > 0 ? kp0 : 0));
    }
    float bvv[3]; int dd[3];
#pragma unroll
    for (int k = 0; k < 3; ++k) {
      const int i = t + 256 * k, hh = i / 192, j = i - 192 * hh, d = 159 - j;
      dd[k] = d;
      bvv[k] = w_BIAS(p)[(4 * g + hh) * 128 + (d < 0 ? 0 : d > 127 ? 127 : d)];
    }
#pragma unroll
    for (int i = 0; i < 8; ++i) {
      const int c = t + 256 * i, row = c >> 3, c16 = c & 7, kp = qpos0 - 128 + row;
      const u32x4 z = {0u, 0u, 0u, 0u};
      *(u32x4*)(Ks + row * LDSK + c16 * 8) = kp >= 0 ? kv[i] : z;
    }
#pragma unroll
    for (int i = 0; i < 8; ++i) {
      const int c = t + 256 * i, drow = c >> 5, c16 = c & 31, kp0 = qpos0 - 128 + c16 * 8;
      const u32x4 z = {0u, 0u, 0u, 0u};
      const u32x4 v = kp0 >= 0 ? vv[i] : z;
      u32x2* d2p = (u32x2*)(VTs + drow * VTS + c16 * 8);
      d2p[0] = (u32x2){v[0], v[1]}; d2p[1] = (u32x2){v[2], v[3]};
    }
#pragma unroll
    for (int k = 0; k < 3; ++k) bs[t + 256 * k] = (dd[k] >= 0 && dd[k] < 128) ? bvv[k] : -INFINITY;
  }
  __syncthreads();
  bf16x8 ob[4][4];
  {
    bf16x8 o0[4], o1[4];
#pragma unroll 1
    for (int hp2 = 0; hp2 < 2; ++hp2) {
      const int ha = 4 * g + 2 * hp2;
      bf16x8 qf0[4], qf1[4];
#pragma unroll
      for (int s = 0; s < 4; ++s) { qf0[s] = *(const bf16x8*)(w_PROJ(p) + tokq * INW + ha * 64 + 16 * s + 8 * h); qf1[s] = *(const bf16x8*)(w_PROJ(p) + tokq * INW + (ha + 1) * 64 + 16 * s + 8 * h); }
      attn_head(p, ha, blk, w, r, h, qf0, Ks, VTs, bs + 384 * hp2, o0);
      pin_regs(o0);
      __builtin_amdgcn_sched_barrier(0);
      attn_head(p, ha + 1, blk, w, r, h, qf1, Ks, VTs, bs + 384 * hp2 + 192, o1);
      pin_regs(o1);
      __builtin_amdgcn_sched_barrier(0);
      if (hp2 == 0) {
#pragma unroll
        for (int k = 0; k < 4; ++k) { ob[0][k] = o0[k]; ob[1][k] = o1[k]; }
      }
    }
#pragma unroll
    for (int k = 0; k < 4; ++k) { ob[2][k] = o0[k]; ob[3][k] = o1[k]; }
  }
  __syncthreads();
  {
    const int wu = __builtin_amdgcn_readfirstlane(w);
    const bf16* pinb = w_PROJ(p) + (size_t)b * SEQ * INW + C_PIN + g * 128 + (lane & 15) * 8;
#pragma unroll
    for (int q = 0; q < 9; ++q) {
      const int j = wu + 4 * q, pos = qpos0 - 16 + 4 * j + (lane >> 4);
      glds16(pinb + (size_t)(pos > 0 ? pos : 0) * INW, PSt + 1024 * j);
    }
  }
  const bf16* prow = w_PROJ(p) + tokq * INW;
  u32x2 gaw[4][4], gbw[4][4];
#pragma unroll
  for (int kp = 0; kp < 4; ++kp) {
    const int f = (4 * g) * 64 + 32 * (kp >> 1) + 8 * (2 * (kp & 1) + h);
    gaw[0][kp] = *(const u32x2*)((const char*)prow + GB0 + f); gbw[0][kp] = *(const u32x2*)((const char*)prow + GB0 + 1024 + f);
  }
  asm volatile("s_waitcnt vmcnt(0)" ::: "memory");
  __syncthreads();
  {
    const int tk = t >> 4, cc = t & 15;
    const int p0 = qpos0 + tk * 8;
    const char* pr0 = PSt + (16 + 8 * tk) * 256 + cc * 16;
    u32x4 cur[8];
#pragma unroll
    for (int i = 0; i < 8; ++i) cur[i] = *(const u32x4*)(pr0 + i * 256);
    float S[8];
#pragma unroll
    for (int d = 0; d < 4; ++d) { S[2 * d] = __uint_as_float(cur[0][d] << 16); S[2 * d + 1] = __uint_as_float(cur[0][d] & 0xffff0000u); }
#pragma unroll 1
    for (int i = 1; i < win; ++i) {
      const u32x4 v = *(const u32x4*)(pr0 - i * 256);
      const unsigned m = p0 - i >= 0 ? 0xffffffffu : 0u;
#pragma unroll
      for (int d = 0; d < 4; ++d) { const unsigned x = v[d] & m; S[2 * d] += __uint_as_float(x << 16); S[2 * d + 1] += __uint_as_float(x & 0xffff0000u); }
    }
#pragma unroll
    for (int i = 0; i < 8; ++i) {
      const int pos = p0 + i;
      if (i > 0) {
        const u32x4 old = *(const u32x4*)(pr0 + (i - win) * 256);
        const unsigned m = pos - win >= 0 ? 0xffffffffu : 0u;
#pragma unroll
        for (int d = 0; d < 4; ++d) {
          const unsigned x = old[d] & m;
          S[2 * d] += __uint_as_float(cur[i][d] << 16); S[2 * d + 1] += __uint_as_float(cur[i][d] & 0xffff0000u);
          S[2 * d] -= __uint_as_float(x << 16); S[2 * d + 1] -= __uint_as_float(x & 0xffff0000u);
        }
      }
      const float icnt = __builtin_amdgcn_rcpf((float)(win < pos + 1 ? win : pos + 1));
      bf16x8 rr;
#pragma unroll
      for (int d = 0; d < 4; ++d) {
        rr[2 * d] = (bf16)(S[2 * d] * icnt - __uint_as_float(cur[i][d] << 16));
        rr[2 * d + 1] = (bf16)(S[2 * d + 1] * icnt - __uint_as_float(cur[i][d] & 0xffff0000u));
      }
      *(bf16x8*)(Rs + (tk * 8 + i) * RS + cc * 8) = rr;
    }
  }
  __syncthreads();
  char* PWs = smem + 256 * LDSK * 2;
  const int wuq = __builtin_amdgcn_readfirstlane(w);
  auto pw_issue = [&](int hd, int buf) {
    const bf16* pwb = w_PWt(p) + ((size_t)g * 256 + (hd & 3) * 64) * 128;
#pragma unroll
    for (int q = 0; q < 4; ++q) {
      const int j = wuq + 4 * q, row = 4 * j + (lane >> 4);
      glds16(pwb + (size_t)row * 128 + (((lane & 15) ^ (row & 15)) * 8), PWs + buf * 16384 + 1024 * j);
    }
  };
  pw_issue(4 * g, 0);
#pragma unroll
  for (int hh = 0; hh < 4; ++hh) {
    const int head = 4 * g + hh;
    asm volatile("s_waitcnt vmcnt(0)" ::: "memory");
    __syncthreads();
    if (hh < 3) {
      pw_issue(head + 1, (hh + 1) & 1);
#pragma unroll
      for (int kp = 0; kp < 4; ++kp) {
        const int f = (head + 1) * 64 + 32 * (kp >> 1) + 8 * (2 * (kp & 1) + h);
        gaw[hh + 1][kp] = *(const u32x2*)((const char*)prow + GB0 + f); gbw[hh + 1][kp] = *(const u32x2*)((const char*)prow + GB0 + 1024 + f);
      }
    }
    f32x16 pa[2] = {zero16(), zero16()};
#pragma unroll
    for (int s = 0; s < 8; ++s) {
      const bf16x8 bfr = *(const bf16x8*)(Rs + (32 * w + r) * RS + 16 * s + 8 * h);
#pragma unroll
      for (int i = 0; i < 2; ++i) {
        const int row = 32 * i + r;
        const bf16x8 a = *(const bf16x8*)(PWs + (hh & 1) * 16384 + row * 256 + (((2 * s + h) ^ (row & 15)) * 16));
        pa[i] = MFMA(a, bfr, pa[i]);
      }
    }
#pragma unroll
    for (int kp = 0; kp < 4; ++kp) {
      u32x2 pv[2];
      const unsigned ga0 = gaw[hh][kp][0], ga1 = gaw[hh][kp][1], gb0 = gbw[hh][kp][0], gb1 = gbw[hh][kp][1];
      const u32x2 gas = __builtin_amdgcn_permlane32_swap(ga0, ga1, false, false), gbs = __builtin_amdgcn_permlane32_swap(gb0, gb1, false, false);
#pragma unroll
      for (int t2 = 0; t2 < 2; ++t2) {
        const int k = 2 * kp + t2, i = k >> 2, q4 = k & 3;
        const unsigned gar = gas[t2], gbr = gbs[t2];
        bf16x4 ov;
#pragma unroll
        for (int j = 0; j < 4; ++j) { const bf16 av = ob[hh][2 * i + (q4 >> 1)][4 * (q4 & 1) + j];
          ov[j] = (bf16)(((float)((gar >> (8 * j)) & 255u) * bf2f(av) + (float)((gbr >> (8 * j)) & 255u) * pa[i][4 * q4 + j]) * (1.f / 255.f)); }
        pv[t2] = __builtin_bit_cast(u32x2, ov);
      }
      const unsigned x0 = pv[0][0], x1 = pv[0][1], y0 = pv[1][0], y1 = pv[1][1];
      const u32x2 s0 = __builtin_amdgcn_permlane32_swap(x0, y0, false, false), s1 = __builtin_amdgcn_permlane32_swap(x1, y1, false, false);
      const int i = kp >> 1, q4a = 2 * (kp & 1);
      const int f = head * 64 + 32 * i + 8 * (q4a + h);
      *(u32x4*)(w_MIXED(p) + tokq * DM + f) = (u32x4){s0[0], s1[0], s0[1], s1[1]};
    }
    __builtin_amdgcn_sched_barrier(0);
  }
}

DI void unit_attn_sample(const P& p, int u, char* smem) {
  const int b = u >> 2, g = u & 3, hk = g >> 1;
  const int t = threadIdx.x + opaque0(), lane = t & 63, w = t >> 6;
  float* ks = (float*)smem;
  float* vs = ks + 128 * 65;
  float* qs = vs + 128 * 64;
  float* ps = qs + 256;
  float* os = ps + 512;
  float* rs = os + 256;
  const size_t token = (size_t)NPR + b;
  __syncthreads();
  const float* kw = p.out + O_KWS + (size_t)b * 128 * 128 + hk * 64;
  const float* vw = p.out + O_VWS + (size_t)b * 128 * 128 + hk * 64;
  {
    f32x4 kv[8], vv[8];
#pragma unroll
    for (int k = 0; k < 8; ++k) { const int i = t + NTHREADS * k, j = i >> 4, d4 = (i & 15) * 4; kv[k] = *(const f32x4*)(kw + (size_t)j * 128 + d4); vv[k] = *(const f32x4*)(vw + (size_t)j * 128 + d4); }
    const float qv = bf2f(w_PROJ(p)[token * INW + g * 256 + t]);
    const int win = 2 << g, tc = t & 127;
    const float cur = p.out[O_PS + ((size_t)b * 15 + 14) * 512 + g * 128 + tc];
    float hv[15];
#pragma unroll
    for (int i = 1; i < 16; ++i) hv[i - 1] = p.state_pool[((size_t)b * 15 + 15 - i) * 512 + g * 128 + tc];
#pragma unroll
    for (int k = 0; k < 8; ++k) {
      const int i = t + NTHREADS * k, j = i >> 4, d4 = (i & 15) * 4;
      ks[j * 65 + d4] = kv[k][0]; ks[j * 65 + d4 + 1] = kv[k][1]; ks[j * 65 + d4 + 2] = kv[k][2]; ks[j * 65 + d4 + 3] = kv[k][3];
      *(f32x4*)(vs + j * 64 + d4) = vv[k];
    }
    qs[t] = qv;
    float tot = cur;
#pragma unroll
    for (int i = 1; i < 16; ++i) tot += i < win ? hv[i - 1] : 0.f;
    if (t < 128) rs[t] = tot / (float)win - cur;
  }
  __syncthreads();
  const int head = 4 * g + w;
  const float sink = p.sinks[head];
  float s[2];
  float m = sink;
#pragma unroll
  for (int i = 0; i < 2; ++i) {
    const int j = lane + 64 * i;
    float a = 0.f;
#pragma unroll 8
    for (int d = 0; d < 64; ++d) a += qs[w * 64 + d] * ks[j * 65 + d];
    s[i] = a + w_BIAS(p)[head * 128 + 127 - j];
    m = fmaxf(m, s[i]);
  }
  for (int o = 32; o >= 1; o >>= 1) m = fmaxf(m, __shfl_xor(m, o));
  float sum = 0.f;
#pragma unroll
  for (int i = 0; i < 2; ++i) { s[i] = __expf(s[i] - m); sum += s[i]; }
  sum = wave_sum(sum);
  const float inv = 1.f / (sum + __expf(sink - m));
#pragma unroll
  for (int i = 0; i < 2; ++i) ps[w * 128 + lane + 64 * i] = s[i] * inv;
  LDS_WAIT();
  {
    float a = 0.f;
#pragma unroll 8
    for (int j = 0; j < 128; ++j) a += ps[w * 128 + j] * vs[j * 64 + lane];
    os[w * 64 + lane] = a;
  }
  const int f = g * 256 + t;
  float pl = 0.f;
  const float* pw = p.pool_w + (size_t)g * 128 * 256 + t;
#pragma unroll 32
  for (int ch = 0; ch < 128; ++ch) pl += rs[ch] * pw[(size_t)ch * 256];
  pl *= p.pool_scale[f];
  const unsigned char* grow = (const unsigned char*)(w_PROJ(p) + token * INW) + GB0;
  const float ga = (float)grow[f] * (1.f / 255.f), gb = (float)grow[1024 + f] * (1.f / 255.f);
  LDS_WAIT();
  w_MIXED(p)[token * DM + f] = (bf16)(ga * os[t] + gb * pl);
}

DI void unit8_map(int u, int& mt, int& nt) {
  if (u < 1024) { const int xcd = u & 7, slot = (u >> 3) & 63, S = (u >> 9) * 8 + xcd; mt = S * 8 + (slot & 7); nt = slot >> 3; }
  else { mt = 128; nt = u - 1024; }
}
constexpr int G2_UNITS = 1024 + 32;
DI void gemm2_map(int u, int& mt, int& nt, int& kq) {
  if (u < 1024) { unit8_map(u, mt, nt); kq = -1; }
  else { mt = 128; nt = (u - 1024) & 7; kq = (u - 1024) >> 3; }
}
DI void gemm2_first(const P& p, int u, char* smem) {
  int mt, nt, kq; gemm2_map(u, mt, nt, kq);
  const int kb = kq < 0 ? 0 : 256 * kq;
  gemm_first(w_Wt_out(p) + kb, w_MIXED(p) + kb, 1024, nt * 128, mt * 128, smem);
}
DI void unit_gemm2(const P& p, int u, int un, char* smem) {
  int mt, nt, kq; gemm2_map(u, mt, nt, kq);
  const int n0 = nt * 128, m0 = mt * 128, kb = kq < 0 ? 0 : 256 * kq;
  const int tz = threadIdx.x + opaque0();
  const int lane = tz & 63, w = tz >> 6, r = lane & 31, h = lane >> 5;
  const int fc = (lane & 15) * 4, tsub = lane >> 4;
  f32x4 xv[16];
#pragma unroll
  for (int k = 0; k < 16; ++k) { const int token = m0 + 32 * w + 4 * (k & 7) + tsub; xv[k] = *(const f32x4*)(xrow(p, token) + n0 + 64 * (k >> 3) + fc); }
  f32x16 acc[4];
  gemm_main(w_Wt_out(p) + kb, w_MIXED(p) + kb, 1024, kq < 0 ? 1024 : 256, n0, m0, smem, acc);
  if (un >= 0) gemm2_first(p, un, smem);
  float* tbase = (float*)(smem + GBUF + w * 8704);
  f32x4 gv[16];
  if (kq < 0) {
#pragma unroll
    for (int k = 0; k < 16; ++k) { const int token = m0 + 32 * w + 4 * (k & 7) + tsub; gv[k] = *(const f32x4*)(w_MOD(p) + (size_t)cond_row(token) * 6144 + 2048 + n0 + 64 * (k >> 3) + fc); }
  }
#pragma unroll
  for (int hf = 0; hf < 2; ++hf) {
    if (hf) LDS_WAIT();
#pragma unroll
    for (int ii = 0; ii < 2; ++ii)
#pragma unroll
      for (int q4 = 0; q4 < 4; ++q4) {
        f32x4 v;
#pragma unroll
        for (int j = 0; j < 4; ++j) v[j] = acc[2 * hf + ii][4 * q4 + j];
        *(f32x4*)(tbase + r * 68 + 32 * ii + 8 * q4 + 4 * h) = v;
      }
    LDS_WAIT();
    if (kq >= 0) {
#pragma unroll
      for (int it = 0; it < 8; ++it) {
        const int tl = 4 * it + tsub, token = m0 + 32 * w + tl, f = n0 + 64 * hf + fc;
        *(f32x4*)(w_PART(p) + ((size_t)kq * NS + (token - NPR)) * DM + f) = *(const f32x4*)(tbase + tl * 68 + fc);
      }
    } else {
#pragma unroll
      for (int it = 0; it < 8; ++it) {
        const int tl = 4 * it + tsub, token = m0 + 32 * w + tl, f = n0 + 64 * hf + fc;
        const f32x4 a = *(const f32x4*)(tbase + tl * 68 + fc);
        f32x4 o;
#pragma unroll
        for (int j = 0; j < 4; ++j) o[j] = xv[8 * hf + it][j] + gv[8 * hf + it][j] * a[j];
        stx4(w_X1(p) + (size_t)token * DM + f, o);
      }
    }
  }
}

DI unsigned f2ord(float f) { return __float_as_uint(f); }
DI float ord2f(unsigned u) { return __uint_as_float(u); }
DI unsigned umin_(unsigned a, unsigned b) { return __float_as_uint(__builtin_fminf(__uint_as_float(a), __uint_as_float(b))); }
DI unsigned umax_(unsigned a, unsigned b) { return __float_as_uint(__builtin_fmaxf(__uint_as_float(a), __uint_as_float(b))); }
__device__ constexpr unsigned char S16A[60] = {0, 1, 2, 3, 4, 5, 7, 9, 0, 1, 2, 3, 6, 8, 10, 11, 0, 2, 4, 6, 7, 10, 12, 14, 0, 1, 4, 5, 6, 8, 12, 13, 1, 3, 4, 5, 8, 9, 13, 1, 2, 5, 7, 9, 11, 2, 3, 9, 11, 3, 6, 7, 10, 3, 5, 7, 9, 11, 6, 8};
__device__ constexpr unsigned char S16B[60] = {13, 12, 15, 14, 8, 6, 11, 10, 5, 7, 9, 4, 13, 14, 15, 12, 1, 3, 5, 8, 9, 11, 13, 15, 2, 3, 10, 11, 7, 9, 14, 15, 2, 12, 6, 7, 10, 11, 14, 4, 6, 8, 10, 13, 14, 4, 6, 12, 13, 5, 8, 9, 12, 4, 6, 8, 10, 12, 7, 9};
template <int OFF> DI void sort16_desc(unsigned (&a)[64]) {
#pragma unroll
  for (int c = 0; c < 60; ++c) {
    const unsigned lo = umin_(a[OFF + S16A[c]], a[OFF + S16B[c]]), hi = umax_(a[OFF + S16A[c]], a[OFF + S16B[c]]);
    a[OFF + S16A[c]] = hi; a[OFF + S16B[c]] = lo;
  }
}
DI void merge16_desc(unsigned (&a)[16]) {
#pragma unroll
  for (int lj = 3; lj >= 0; --lj)
#pragma unroll
    for (int i = 0; i < 16; ++i) {
      const int j = 1 << lj, l = i ^ j;
      if (l > i) { const unsigned lo = umin_(a[i], a[l]), hi = umax_(a[i], a[l]); a[i] = hi; a[l] = lo; }
    }
}
template <bool SORTED0 = false>
DI void top16_of_64(unsigned (&a)[64], unsigned (&out)[16]) {
  if (!SORTED0) sort16_desc<0>(a);
  sort16_desc<16>(a); sort16_desc<32>(a); sort16_desc<48>(a);
  unsigned x[16], y[16];
#pragma unroll
  for (int i = 0; i < 16; ++i) { x[i] = umax_(a[i], a[31 - i]); y[i] = umax_(a[32 + i], a[63 - i]); }
  merge16_desc(x); merge16_desc(y);
#pragma unroll
  for (int i = 0; i < 16; ++i) out[i] = umax_(x[i], y[15 - i]);
  merge16_desc(out);
}
__device__ constexpr int COFF[16] = {0, 16, 24, 29, 33, 36, 38, 40, 42, 43, 44, 45, 46, 47, 48, 49};
DI unsigned umax3(unsigned a, unsigned b, unsigned c) { return umax_(umax_(a, b), c); }

constexpr int R_UNITS = 1024 + 16;
#define XB_RCNT 200
DI void route_map(int u, int& mt, int& hd, int& pp0) { if (u < 1024) { unit8_map(u, mt, hd); pp0 = 0; } else { mt = 128; hd = (u - 1024) >> 1; pp0 = (u - 1024) & 1; } }
DI void route_first(const P& p, int u, char* smem) { int mt, hd, pp0; route_map(u, mt, hd, pp0); gemm_first(w_Wt_q(p), w_H(p), 1024, hd * 256 + pp0 * 128, mt * 128, smem); }
template <bool HALF>
DI void unit_peer_route(const P& p, int u, int un, char* smem) {
  int mt, hd, pp0; route_map(u, mt, hd, pp0);
  const int m0 = mt * 128;
  const int t = threadIdx.x + opaque0(), lane = t & 63, w = t >> 6, r = lane & 31, h = lane >> 5;
  unsigned char* myidx = (unsigned char*)smem + 2 * GBUF + t * 32;
  unsigned top[2][16];
  if (HALF) {
#pragma unroll
    for (int i = 0; i < 16; ++i) { top[0][i] = 0u; top[1][i] = 0u; }
  }
#pragma unroll
  for (int pp = 0; pp < 2; ++pp) {
    if (HALF && pp != pp0) continue;
    f32x16 acc[4];
    gemm_main(w_Wt_q(p), w_H(p), 1024, 1024, hd * 256 + pp * 128, m0, smem, acc);
    if (!HALF && pp == 0) gemm_first(w_Wt_q(p), w_H(p), 1024, hd * 256 + 128, m0, smem);
    else if (un >= 0) route_first(p, un, smem);
    f32x16 sc[4] = {zero16(), zero16(), zero16(), zero16()};
    {
      const bf16* skb = w_SK(p) + (size_t)(hd * 2 + pp) * 128 * 128;
      const int wu = __builtin_amdgcn_readfirstlane(w);
#pragma unroll
      for (int q = 0; q < 8; ++q) {
        const int j = wu + 4 * q, row = 4 * j + (lane >> 4);
        glds16(skb + (size_t)row * 128 + (((lane & 15) ^ (row & 15)) * 8), smem + GBUF + 1024 * j);
      }
      asm volatile("s_waitcnt vmcnt(0)" ::: "memory");
      __syncthreads();
    }
    bf16x8 bqs[8];
#pragma unroll
    for (int i = 0; i < 4; ++i)
#pragma unroll
      for (int s = 0; s < 2; ++s) bqs[2 * i + s] = pack_step(acc[i], s);
#pragma unroll
    for (int i = 0; i < 4; ++i)
#pragma unroll
      for (int s = 0; s < 2; ++s) {
        const bf16x8 bq = bqs[2 * i + s];
#pragma unroll
        for (int kt = 0; kt < 4; ++kt) {
          const int row = 32 * kt + r, cc = 4 * i + 2 * s;
          const char* rp = smem + GBUF + row * 256 + 8 * h;
          const bf16x8 a = cat4(*(const bf16x4*)(rp + ((cc ^ (row & 15)) * 16)), *(const bf16x4*)(rp + (((cc + 1) ^ (row & 15)) * 16)));
          sc[kt] = MFMA(a, bq, sc[kt]);
        }
      }
    unsigned pk[64];
#pragma unroll
    for (int kt = 0; kt < 4; ++kt)
#pragma unroll
      for (int j = 0; j < 16; ++j) { const int key = 32 * kt + crow(j, h); pk[kt * 16 + j] = (f2ord(sc[kt][j]) & ~127u) | (unsigned)(127 - key); }
    unsigned mine[16];
    top16_of_64(pk, mine);
#pragma unroll
    for (int i = 0; i < 16; ++i) top[pp][i] = (unsigned)__shfl_xor((int)mine[15 - i], 32);
#pragma unroll
    for (int i = 0; i < 16; ++i) top[pp][i] = umax_(top[pp][i], mine[i]);
    merge16_desc(top[pp]);
  }
  if (HALF) {
    unsigned mine[16];
#pragma unroll
    for (int i = 0; i < 16; ++i) mine[i] = pp0 ? top[1][i] : top[0][i];
    unsigned* xw = (unsigned*)(p.ws + OFF_PART) + (size_t)((hd * 2 + pp0) * 128 + 32 * w + r) * 16;
    if (h == 0) {
#pragma unroll
      for (int q = 0; q < 4; ++q) *(u32x4*)(xw + 4 * q) = (u32x4){mine[4 * q], mine[4 * q + 1], mine[4 * q + 2], mine[4 * q + 3]};
    }
    asm volatile("s_waitcnt vmcnt(0)" ::: "memory");
    __syncthreads();
    volatile unsigned* bx = (volatile unsigned*)(smem + SMEM_BYTES + 8);
    if (threadIdx.x == 0) {
      __builtin_amdgcn_fence(__ATOMIC_RELEASE, "agent");
      asm volatile("s_waitcnt vmcnt(0)" ::: "memory");
      const unsigned old = xb_add(&w_bar(p)[XB_RCNT + hd], 1u);
      if (old) { __builtin_amdgcn_fence(__ATOMIC_ACQUIRE, "agent"); asm volatile("s_waitcnt vmcnt(0)" ::: "memory"); }
      *bx = old;
    }
    __syncthreads();
    if (*bx == 0u) return;
    const unsigned* xo = (const unsigned*)(p.ws + OFF_PART) + (size_t)((hd * 2 + (pp0 ^ 1)) * 128 + 32 * w + r) * 16;
    unsigned oth[16];
#pragma unroll
    for (int q = 0; q < 4; ++q) { const u32x4 v = *(const u32x4*)(xo + 4 * q); oth[4 * q] = v[0]; oth[4 * q + 1] = v[1]; oth[4 * q + 2] = v[2]; oth[4 * q + 3] = v[3]; }
#pragma unroll
    for (int i = 0; i < 16; ++i) { top[0][i] = pp0 ? oth[i] : mine[i]; top[1][i] = pp0 ? mine[i] : oth[i]; }
  }
  float v0[16], v1[16];
#pragma unroll
  for (int a = 0; a < 16; ++a) {
    v0[a] = ord2f(top[0][a] & ~127u); v1[a] = ord2f(top[1][a] & ~127u);
    myidx[a] = (unsigned char)(127u - (top[0][a] & 127u)); myidx[16 + a] = (unsigned char)(127u - (top[1][a] & 127u));
  }
  unsigned cand[64];
#pragma unroll
  for (int i = 50; i < 64; ++i) cand[i] = 0xFF800000u;
#pragma unroll
  for (int a = 0; a < 16; ++a)
#pragma unroll
    for (int bb = 0; bb < 16 / (a + 1); ++bb)
      cand[COFF[a] + bb] = (f2ord(v0[a] + v1[bb]) & ~255u) | (unsigned)(255 - (a * 16 + bb));
  unsigned best[16];
  top16_of_64<true>(cand, best);
  const float smax = ord2f(best[0] & ~255u);
  float e[16], esum = 0.f;
#pragma unroll
  for (int i = 0; i < 16; ++i) { e[i] = __expf(ord2f(best[i] & ~255u) - smax); esum += e[i]; }
  const float einv = 1.f / esum;
  const size_t token = (size_t)m0 + 32 * w + r;
  unsigned* ig = (unsigned*)w_IDX(p) + token * 128 + hd * 16 + 8 * h;
  const unsigned hmask = 0u - (unsigned)h;
#pragma unroll
  for (int i = 0; i < 8; ++i) {
    const unsigned bsel = best[i] ^ ((best[i] ^ best[8 + i]) & hmask);
    const float esel = __uint_as_float(__float_as_uint(e[i]) ^ ((__float_as_uint(e[i]) ^ __float_as_uint(e[8 + i])) & hmask));
    const unsigned code = 255u - (bsel & 255u);
    const int a = code >> 4, bb = code & 15;
    ig[i] = ((unsigned)((int)myidx[a] * 128 + (int)myidx[16 + bb]) << 16) | (unsigned)__builtin_bit_cast(unsigned short, (_Float16)(esel * einv));
  }
}

DI float gelu_fast(float v) {
  const float av = fabsf(v), tt = __builtin_amdgcn_rcpf(av * 0.2316418882f + 1.0f);
  float q = tt * 0.5307027145f - 0.7265760135f; q = q * tt + 0.7107068705f; q = q * tt - 0.142248368f; q = q * tt + 0.127414796f; q = q * tt;
  const float e = __builtin_amdgcn_exp2f(v * v * -0.72134752044f);
  const float m = v * (q * e);
  return v < 0.f ? m : v - m;
}
DI float dot2bf(unsigned a, unsigned b, float acc) { return __builtin_amdgcn_fdot2_f32_bf16(__builtin_bit_cast(bf16x2, a), __builtin_bit_cast(bf16x2, b), acc, false); }
DI unsigned pkbf(f32x2 v) { bf16x2 r; r[0] = (bf16)v[0]; r[1] = (bf16)v[1]; return __builtin_bit_cast(unsigned, r); }
DI int dot16i(u32x4 u8, u32x4 x8, int d) {
#pragma unroll
  for (int m = 0; m < 4; ++m) d = __builtin_amdgcn_sdot4((int)u8[m], (int)x8[m], d, false);
  return d;
}
DI void axpy16p(f32x2* o, u32x4 v8, f32x2 c2) {
#pragma unroll
  for (int m = 0; m < 4; ++m) {
    const int wd = (int)v8[m];
    o[2 * m] = __builtin_elementwise_fma(c2, __builtin_amdgcn_cvt_pk_f32_fp8(wd, false), o[2 * m]);
    o[2 * m + 1] = __builtin_elementwise_fma(c2, __builtin_amdgcn_cvt_pk_f32_fp8(wd, true), o[2 * m + 1]);
  }
}
DI int dpp_add16i(int v) {
  v += __builtin_amdgcn_update_dpp(0, v, 0x140, 0xf, 0xf, true);
  v += __builtin_amdgcn_update_dpp(0, v, 0x141, 0xf, 0xf, true);
  v += __builtin_amdgcn_update_dpp(0, v, 0x4e, 0xf, 0xf, true);
  v += __builtin_amdgcn_update_dpp(0, v, 0xb1, 0xf, 0xf, true);
  return v;
}
DI float dot16(u32x4 u8, u32x4 xlo, u32x4 xhi, float d) {
#pragma unroll
  for (int m = 0; m < 4; ++m) {
    const int wd = (int)u8[m];
    const unsigned p01 = pkbf(__builtin_amdgcn_cvt_pk_f32_fp8(wd, false)), p23 = pkbf(__builtin_amdgcn_cvt_pk_f32_fp8(wd, true));
    const unsigned x01 = m < 2 ? xlo[2 * m] : xhi[2 * m - 4], x23 = m < 2 ? xlo[2 * m + 1] : xhi[2 * m - 3];
    d = dot2bf(p01, x01, d); d = dot2bf(p23, x23, d);
  }
  return d;
}
DI void axpy16(float* o, u32x4 v8, float c) {
#pragma unroll
  for (int m = 0; m < 4; ++m) {
    const int wd = (int)v8[m];
    const f32x2 a = __builtin_amdgcn_cvt_pk_f32_fp8(wd, false), b = __builtin_amdgcn_cvt_pk_f32_fp8(wd, true);
    o[4 * m] += c * a[0]; o[4 * m + 1] += c * a[1]; o[4 * m + 2] += c * b[0]; o[4 * m + 3] += c * b[1];
  }
}
DI float reduce4(const float (&d)[4], int lane) {
  const int h = lane >> 5, b4 = (lane >> 4) & 1;
  float a0 = h ? d[2] : d[0], a1 = h ? d[3] : d[1];
  const float s0 = h ? d[0] : d[2], s1 = h ? d[1] : d[3];
  a0 += __shfl_xor(s0, 32); a1 += __shfl_xor(s1, 32);
  float k = b4 ? a1 : a0;
  const float s = b4 ? a0 : a1;
  k += __shfl_xor(s, 16);
  k += __shfl_xor(k, 8); k += __shfl_xor(k, 4); k += __shfl_xor(k, 2); k += __shfl_xor(k, 1);
  return k;
}
DI float dpp_add16(float v) {
  v += __int_as_float(__builtin_amdgcn_update_dpp(0, __float_as_int(v), 0x140, 0xf, 0xf, true));
  v += __int_as_float(__builtin_amdgcn_update_dpp(0, __float_as_int(v), 0x141, 0xf, 0xf, true));
  v += __int_as_float(__builtin_amdgcn_update_dpp(0, __float_as_int(v), 0x4e, 0xf, 0xf, true));
  v += __int_as_float(__builtin_amdgcn_update_dpp(0, __float_as_int(v), 0xb1, 0xf, 0xf, true));
  return v;
}
constexpr int PEER_GLDS = 512 + 128 * 16;
constexpr int PEER_WLDS = 4 * PEER_GLDS;
template <int PART>
DI void peer_wave4(const P& p, int g, char* wl) {
  const int lane = (threadIdx.x + opaque0()) & 63, q = lane >> 4, j16 = lane & 15;
  unsigned* hist = (unsigned*)(wl + q * PEER_GLDS);
  u32x4* list = (u32x4*)(wl + q * PEER_GLDS + 512);
  const int token = 4 * g + q;
  if constexpr (PART != 2) {
  u32x4 x[4];
  {
    const unsigned char* hrow = w_H8(p) + (size_t)token * DM + 16 * j16;
#pragma unroll
    for (int i = 0; i < 4; ++i) x[i] = *(const u32x4*)(hrow + 256 * i);
  }
  const float xs = w_HS(p)[token];
  {
    int ids[8]; float gts[8], su[8];
#pragma unroll
    for (int i = 0; i < 8; ++i) { const size_t o = (size_t)token * 128 + j16 + 16 * i; const unsigned wv = ((const unsigned*)w_IDX(p))[o]; ids[i] = (int)(wv >> 16); gts[i] = (float)__builtin_bit_cast(_Float16, (unsigned short)(wv & 0xffffu)); }
#pragma unroll
    for (int i = 0; i < 8; ++i) { su[i] = w_SU(p)[ids[i]] * xs; gts[i] *= w_SV(p)[ids[i]]; }
    LDS_WAIT();
    *(u32x4*)(hist + 8 * j16) = (u32x4){0u, 0u, 0u, 0u}; *(u32x4*)(hist + 8 * j16 + 4) = (u32x4){0u, 0u, 0u, 0u};
    LDS_WAIT();
#pragma unroll
    for (int i = 0; i < 8; ++i) (void)__hip_atomic_fetch_add(&hist[ids[i] >> 7], 1u, __ATOMIC_RELAXED, __HIP_MEMORY_SCOPE_WAVEFRONT);
    LDS_WAIT();
    const u32x4 ca = *(const u32x4*)(hist + 8 * j16), cb = *(const u32x4*)(hist + 8 * j16 + 4);
    const unsigned tot = ca[0] + ca[1] + ca[2] + ca[3] + cb[0] + cb[1] + cb[2] + cb[3];
    unsigned scan = tot;
#pragma unroll
    for (int o = 1; o < 16; o <<= 1) { const unsigned tv = (unsigned)__shfl_up((int)scan, o, 16); if (j16 >= o) scan += tv; }
    unsigned e0 = scan - tot;
    u32x4 pa, pb;
    pa[0] = e0; e0 += ca[0]; pa[1] = e0; e0 += ca[1]; pa[2] = e0; e0 += ca[2]; pa[3] = e0; e0 += ca[3];
    pb[0] = e0; e0 += cb[0]; pb[1] = e0; e0 += cb[1]; pb[2] = e0; e0 += cb[2]; pb[3] = e0;
    LDS_WAIT();
    *(u32x4*)(hist + 8 * j16) = pa; *(u32x4*)(hist + 8 * j16 + 4) = pb;
    LDS_WAIT();
#pragma unroll
    for (int i = 0; i < 8; ++i) {
      const unsigned pos = __hip_atomic_fetch_add(&hist[ids[i] >> 7], 1u, __ATOMIC_RELAXED, __HIP_MEMORY_SCOPE_WAVEFRONT);
      list[pos] = (u32x4){(unsigned)ids[i], __float_as_uint(su[i]), __float_as_uint(gts[i]), 0u};
    }
    LDS_WAIT();
  }
  const unsigned char* Ub = w_Ub(p) + 16 * j16;
  {
    u32x4 uA[4], uB[4];
    u32x4 eA = list[0], eB = list[1];
#pragma unroll
    for (int i = 0; i < 4; ++i) uA[i] = *(const u32x4*)(Ub + (size_t)eA[0] * DM + 256 * i);
#pragma unroll
    for (int i = 0; i < 4; ++i) uB[i] = *(const u32x4*)(Ub + (size_t)eB[0] * DM + 256 * i);
#define PEER_USTEP(U, E, K)                                                                                            \
    {                                                                                                                  \
      const float su = __uint_as_float(E[1]), gsv = __uint_as_float(E[2]);                                             \
      int d0 = 0, d1 = 0;                                                                                              \
      d0 = dot16i(U[0], x[0], d0); d1 = dot16i(U[1], x[1], d1); d0 = dot16i(U[2], x[2], d0); d1 = dot16i(U[3], x[3], d1); \
      E = list[(K) + 2 < 128 ? (K) + 2 : 127];                       \
      _Pragma("unroll") for (int i = 0; i < 4; ++i) U[i] = *(const u32x4*)(Ub + (size_t)E[0] * DM + 256 * i);          \
      const float c = gsv * gelu_fast(su * (float)dpp_add16i(d0 + d1));                                                \
      if (j16 == 0) ((float*)&list[K])[3] = c;                                                                          \
    }
#pragma unroll 1
    for (int k = 0; k < 128; k += 2) {
      PEER_USTEP(uA, eA, k)
      PEER_USTEP(uB, eB, k + 1)
    }
  }
  }
  if constexpr (PART != 1) {
  LDS_WAIT();
  const unsigned char* Vb = w_Vb(p) + 16 * j16;
  f32x4 acc4[16];
#pragma unroll
  for (int i = 0; i < 16; ++i) acc4[i] = (f32x4){0.f, 0.f, 0.f, 0.f};
  const int e4 = lane & 3;
  const unsigned am0 = e4 == 0 ? 0x0000FFFFu : e4 == 1 ? 0xFFFF0000u : 0u, am1 = e4 == 2 ? 0x0000FFFFu : e4 == 3 ? 0xFFFF0000u : 0u;
  {
    u32x4 vA[4], vB[4];
    u32x4 eA = list[0], eB = list[1];
#pragma unroll
    for (int i = 0; i < 4; ++i) vA[i] = *(const u32x4*)(Vb + (size_t)eA[0] * DM + 256 * i);
#pragma unroll
    for (int i = 0; i < 4; ++i) vB[i] = *(const u32x4*)(Vb + (size_t)eB[0] * DM + 256 * i);
#define PEER_VSTEP(V, E, K)                                                                                            \
    {                                                                                                                  \
      const _Float16 ch = (_Float16)(__uint_as_float(E[3]) * 4096.f);                                                  \
      const unsigned chb = (unsigned)__builtin_bit_cast(unsigned short, ch), chh = chb | (chb << 16);                  \
      const u32x2 ab = {chh & am0, chh & am1};                                                                         \
      const f16x4h am = __builtin_bit_cast(f16x4h, ab);                                                                \
      _Pragma("unroll") for (int i = 0; i < 4; ++i) _Pragma("unroll") for (int m = 0; m < 4; ++m) {                    \
        const int wd = (int)V[i][m];                                                                                   \
        const auto lo = __builtin_amdgcn_cvt_scalef32_pk_f16_fp8(wd, 1.0f, false), hi = __builtin_amdgcn_cvt_scalef32_pk_f16_fp8(wd, 1.0f, true); \
        const u32x2 bb = {__builtin_bit_cast(unsigned, lo), __builtin_bit_cast(unsigned, hi)};                          \
        acc4[4 * i + m] = __builtin_amdgcn_mfma_f32_4x4x4f16(am, __builtin_bit_cast(f16x4h, bb), acc4[4 * i + m], 0, 0, 0); \
      }                                                                                                                \
      E = list[(K) + 2 < 128 ? (K) + 2 : 127];                                                                         \
      _Pragma("unroll") for (int i = 0; i < 4; ++i) V[i] = *(const u32x4*)(Vb + (size_t)E[0] * DM + 256 * i);          \
    }
#pragma unroll 1
    for (int k = 0; k < 128; k += 2) {
      PEER_VSTEP(vA, eA, k)
      PEER_VSTEP(vB, eB, k + 1)
    }
  }
  const bf16* x1 = w_X1(p) + (size_t)token * DM + 16 * j16;
  const float* g2 = w_MOD(p) + (size_t)cond_row(token) * 6144 + 5120 + 16 * j16;
  float* y = p.out + O_YP + (size_t)token * DM + 16 * j16;
  f32x4 xv[16], gv[16];
#pragma unroll
  for (int k = 0; k < 16; ++k) { const int c0 = 256 * (k >> 2) + 4 * (k & 3); xv[k] = ldx4(x1 + c0); gv[k] = *(const f32x4*)(g2 + c0); }
#pragma unroll
  for (int k = 0; k < 16; ++k) {
    const int c0 = 256 * (k >> 2) + 4 * (k & 3);
    f32x4 yv;
#pragma unroll
    for (int j = 0; j < 4; ++j) yv[j] = xv[k][j] + gv[k][j] * (acc4[k][j] * (1.f / 4096.f));
    *(f32x4*)(y + c0) = yv;
  }
  }
}
constexpr int PEER_GLDS2 = 512 + 2 * 128 * 16;
constexpr int PEER_WLDS2 = 4 * PEER_GLDS2;
DI void peer_sort(const P& p, int token, int j16, unsigned* hist, u32x4* list, u32x4 (&x)[4]) {
  {
    const unsigned char* hrow = w_H8(p) + (size_t)token * DM + 16 * j16;
#pragma unroll
    for (int i = 0; i < 4; ++i) x[i] = *(const u32x4*)(hrow + 256 * i);
  }
  const float xs = w_HS(p)[token];
  int ids[8]; float gts[8], su[8];
#pragma unroll
  for (int i = 0; i < 8; ++i) { const size_t o = (size_t)token * 128 + j16 + 16 * i; const unsigned wv = ((const unsigned*)w_IDX(p))[o]; ids[i] = (int)(wv >> 16); gts[i] = (float)__builtin_bit_cast(_Float16, (unsigned short)(wv & 0xffffu)); }
#pragma unroll
  for (int i = 0; i < 8; ++i) { su[i] = w_SU(p)[ids[i]] * xs; gts[i] *= w_SV(p)[ids[i]]; }
  LDS_WAIT();
  *(u32x4*)(hist + 8 * j16) = (u32x4){0u, 0u, 0u, 0u}; *(u32x4*)(hist + 8 * j16 + 4) = (u32x4){0u, 0u, 0u, 0u};
  LDS_WAIT();
#pragma unroll
  for (int i = 0; i < 8; ++i) (void)__hip_atomic_fetch_add(&hist[ids[i] >> 7], 1u, __ATOMIC_RELAXED, __HIP_MEMORY_SCOPE_WAVEFRONT);
  LDS_WAIT();
  const u32x4 ca = *(const u32x4*)(hist + 8 * j16), cb = *(const u32x4*)(hist + 8 * j16 + 4);
  const unsigned tot = ca[0] + ca[1] + ca[2] + ca[3] + cb[0] + cb[1] + cb[2] + cb[3];
  unsigned scan = tot;
#pragma unroll
  for (int o = 1; o < 16; o <<= 1) { const unsigned tv = (unsigned)__shfl_up((int)scan, o, 16); if (j16 >= o) scan += tv; }
  unsigned e0 = scan - tot;
  u32x4 pa, pb;
  pa[0] = e0; e0 += ca[0]; pa[1] = e0; e0 += ca[1]; pa[2] = e0; e0 += ca[2]; pa[3] = e0; e0 += ca[3];
  pb[0] = e0; e0 += cb[0]; pb[1] = e0; e0 += cb[1]; pb[2] = e0; e0 += cb[2]; pb[3] = e0;
  LDS_WAIT();
  *(u32x4*)(hist + 8 * j16) = pa; *(u32x4*)(hist + 8 * j16 + 4) = pb;
  LDS_WAIT();
#pragma unroll
  for (int i = 0; i < 8; ++i) {
    const unsigned pos = __hip_atomic_fetch_add(&hist[ids[i] >> 7], 1u, __ATOMIC_RELAXED, __HIP_MEMORY_SCOPE_WAVEFRONT);
    list[pos] = (u32x4){(unsigned)ids[i], __float_as_uint(su[i]), __float_as_uint(gts[i]), 0u};
  }
  LDS_WAIT();
}
DI void peer_finish(const P& p, int token, int j16, const f32x4 (&acc4)[16]) {
  const bf16* x1 = w_X1(p) + (size_t)token * DM + 16 * j16;
  const float* g2 = w_MOD(p) + (size_t)cond_row(token) * 6144 + 5120 + 16 * j16;
  float* y = p.out + O_YP + (size_t)token * DM + 16 * j16;
#pragma unroll
  for (int hf = 0; hf < 2; ++hf) {
    f32x4 xv[8], gv[8];
#pragma unroll
    for (int k = 0; k < 8; ++k) { const int kk = 8 * hf + k, c0 = 256 * (kk >> 2) + 4 * (kk & 3); xv[k] = ldx4(x1 + c0); gv[k] = *(const f32x4*)(g2 + c0); }
#pragma unroll
    for (int k = 0; k < 8; ++k) {
      const int kk = 8 * hf + k, c0 = 256 * (kk >> 2) + 4 * (kk & 3);
      f32x4 yv;
#pragma unroll
      for (int j = 0; j < 4; ++j) yv[j] = xv[k][j] + gv[k][j] * (acc4[kk][j] * (1.f / 4096.f));
      *(f32x4*)(y + c0) = yv;
    }
  }
}
DI void peer_wave8(const P& p, int gA, int gB, char* wl) {
  const int lane = (threadIdx.x + opaque0()) & 63, q = lane >> 4, j16 = lane & 15;
  unsigned* hist = (unsigned*)(wl + q * PEER_GLDS2);
  u32x4* listA = (u32x4*)(wl + q * PEER_GLDS2 + 512);
  u32x4* listB = listA + 128;
  const int tokA = 4 * gA + q, tokB = 4 * gB + q;
  {
    u32x4 xA[4], xB[4];
    const unsigned char* Ub = w_Ub(p) + 16 * j16;
    u32x4 uA[4], uB[4];
    peer_sort(p, tokA, j16, hist, listA, xA);
    u32x4 eA = listA[0];
#pragma unroll
    for (int i = 0; i < 4; ++i) uA[i] = *(const u32x4*)(Ub + (size_t)eA[0] * DM + 256 * i);
    peer_sort(p, tokB, j16, hist, listB, xB);
    u32x4 eB = listB[0];
#pragma unroll
    for (int i = 0; i < 4; ++i) uB[i] = *(const u32x4*)(Ub + (size_t)eB[0] * DM + 256 * i);
#define PEER_USTEP2(U, E, LIST, X, K)                                                                                  \
    {                                                                                                                  \
      const float su = __uint_as_float(E[1]), gsv = __uint_as_float(E[2]);                                             \
      int d0 = 0, d1 = 0;                                                                                              \
      d0 = dot16i(U[0], X[0], d0); d1 = dot16i(U[1], X[1], d1); d0 = dot16i(U[2], X[2], d0); d1 = dot16i(U[3], X[3], d1); \
      E = LIST[(K) + 1 < 128 ? (K) + 1 : 127];                      \
      _Pragma("unroll") for (int i = 0; i < 4; ++i) U[i] = *(const u32x4*)(Ub + (size_t)E[0] * DM + 256 * i);          \
      const float c = gsv * gelu_fast(su * (float)dpp_add16i(d0 + d1));                                                \
      if (j16 == 0) ((float*)&LIST[K])[3] = c;                                                                          \
    }
#pragma unroll 1
    for (int k = 0; k < 128; ++k) {
      PEER_USTEP2(uA, eA, listA, xA, k)
      PEER_USTEP2(uB, eB, listB, xB, k)
    }
  }
  LDS_WAIT();
  f32x4 accA[16], accB[16];
#pragma unroll
  for (int i = 0; i < 16; ++i) { accA[i] = (f32x4){0.f, 0.f, 0.f, 0.f}; accB[i] = (f32x4){0.f, 0.f, 0.f, 0.f}; }
  {
    const unsigned char* Vb = w_Vb(p) + 16 * j16;
    const int e4 = lane & 3;
    const unsigned am0 = e4 == 0 ? 0x0000FFFFu : e4 == 1 ? 0xFFFF0000u : 0u, am1 = e4 == 2 ? 0x0000FFFFu : e4 == 3 ? 0xFFFF0000u : 0u;
    u32x4 vA[4], vB[4];
    u32x4 eA = listA[0], eB = listB[0];
#pragma unroll
    for (int i = 0; i < 4; ++i) vA[i] = *(const u32x4*)(Vb + (size_t)eA[0] * DM + 256 * i);
#pragma unroll
    for (int i = 0; i < 4; ++i) vB[i] = *(const u32x4*)(Vb + (size_t)eB[0] * DM + 256 * i);
#define PEER_VSTEP2(V, E, LIST, ACC, K)                                                                                \
    {                                                                                                                  \
      const _Float16 ch = (_Float16)(__uint_as_float(E[3]) * 4096.f);                                                  \
      const unsigned chb = (unsigned)__builtin_bit_cast(unsigned short, ch), chh = chb | (chb << 16);                  \
      const u32x2 ab = {chh & am0, chh & am1};                                                                         \
      const f16x4h am = __builtin_bit_cast(f16x4h, ab);                                                                \
      _Pragma("unroll") for (int i = 0; i < 4; ++i) _Pragma("unroll") for (int m = 0; m < 4; ++m) {                    \
        const int wd = (int)V[i][m];                                                                                   \
        const auto lo = __builtin_amdgcn_cvt_scalef32_pk_f16_fp8(wd, 1.0f, false), hi = __builtin_amdgcn_cvt_scalef32_pk_f16_fp8(wd, 1.0f, true); \
        const u32x2 bb = {__builtin_bit_cast(unsigned, lo), __builtin_bit_cast(unsigned, hi)};                          \
        ACC[4 * i + m] = __builtin_amdgcn_mfma_f32_4x4x4f16(am, __builtin_bit_cast(f16x4h, bb), ACC[4 * i + m], 0, 0, 0); \
      }                                                                                                                \
      E = LIST[(K) + 1 < 128 ? (K) + 1 : 127];                                                                         \
      _Pragma("unroll") for (int i = 0; i < 4; ++i) V[i] = *(const u32x4*)(Vb + (size_t)E[0] * DM + 256 * i);          \
    }
#pragma unroll 1
    for (int k = 0; k < 128; ++k) {
      PEER_VSTEP2(vA, eA, listA, accA, k)
      PEER_VSTEP2(vB, eB, listB, accB, k)
    }
  }
  {
#define FIN_LOAD(TOK, HF, XR, GV)                                                                                      \
    {                                                                                                                  \
      const bf16* x1 = w_X1(p) + (size_t)(TOK) * DM + 16 * j16;                                                        \
      const float* g2 = w_MOD(p) + (size_t)cond_row(TOK) * 6144 + 5120 + 16 * j16;                                     \
      _Pragma("unroll") for (int k = 0; k < 8; ++k) { const int kk = 8 * (HF) + k, c0 = 256 * (kk >> 2) + 4 * (kk & 3); XR[k] = *(const u32x2*)(x1 + c0); GV[k] = *(const f32x4*)(g2 + c0); } \
    }
#define FIN_STORE(TOK, HF, ACC, XR, GV)                                                                                \
    {                                                                                                                  \
      float* y = p.out + O_YP + (size_t)(TOK) * DM + 16 * j16;                                                         \
      _Pragma("unroll") for (int k = 0; k < 8; ++k) {                                                                  \
        const int kk = 8 * (HF) + k, c0 = 256 * (kk >> 2) + 4 * (kk & 3);                                              \
        const f32x4 xv = {__uint_as_float(XR[k][0] << 16), __uint_as_float(XR[k][0] & 0xffff0000u), __uint_as_float(XR[k][1] << 16), __uint_as_float(XR[k][1] & 0xffff0000u)}; \
        f32x4 yv;                                                                                                      \
        _Pragma("unroll") for (int j = 0; j < 4; ++j) yv[j] = xv[j] + GV[k][j] * (ACC[kk][j] * (1.f / 4096.f));        \
        *(f32x4*)(y + c0) = yv;                                                                                        \
      }                                                                                                                \
    }
    u32x2 xr0[8], xr1[8]; f32x4 gv0[8], gv1[8];
    FIN_LOAD(tokA, 0, xr0, gv0)
    FIN_LOAD(tokA, 1, xr1, gv1)
    FIN_STORE(tokA, 0, accA, xr0, gv0)
    FIN_LOAD(tokB, 0, xr0, gv0)
    FIN_STORE(tokA, 1, accA, xr1, gv1)
    FIN_LOAD(tokB, 1, xr1, gv1)
    FIN_STORE(tokB, 0, accB, xr0, gv0)
    FIN_STORE(tokB, 1, accB, xr1, gv1)
  }
}
DI void peer_token_block(const P& p, int token, char* smem) {
  const int t = threadIdx.x + opaque0(), lane = t & 63, w = t >> 6;
  float* red = (float*)smem;
  const u32x4 x8 = *(const u32x4*)(w_H8(p) + (size_t)token * DM + 16 * lane);
  const unsigned myiw = ((const unsigned*)w_IDX(p))[(size_t)token * 128 + 32 * w + (lane & 31)];
  const int myid = (int)(myiw >> 16);
  const float mysu = w_SU(p)[myid] * w_HS(p)[token];
  const float mygs = (float)__builtin_bit_cast(_Float16, (unsigned short)(myiw & 0xffffu)) * w_SV(p)[myid];
  float o[16];
#pragma unroll
  for (int i = 0; i < 16; ++i) o[i] = 0.f;
#pragma unroll 1
  for (int e0 = 0; e0 < 32; e0 += 8) {
    u32x4 u8[8], v8[8];
#pragma unroll
    for (int qq = 0; qq < 8; ++qq) {
      const size_t ro = (size_t)__builtin_amdgcn_readlane(myid, e0 + qq) * DM + 16 * lane;
      u8[qq] = *(const u32x4*)(w_Ub(p) + ro); v8[qq] = *(const u32x4*)(w_Vb(p) + ro);
    }
#pragma unroll
    for (int hb = 0; hb < 2; ++hb) {
      float d[4];
#pragma unroll
      for (int qq = 0; qq < 4; ++qq) d[qq] = (float)dot16i(u8[4 * hb + qq], x8, 0);
      const float kv = reduce4(d, lane);
#pragma unroll
      for (int qq = 0; qq < 4; ++qq) {
        const int e = e0 + 4 * hb + qq;
        const float a = __int_as_float(__builtin_amdgcn_readlane(__float_as_int(kv), 16 * qq)) * __int_as_float(__builtin_amdgcn_readlane(__float_as_int(mysu), e));
        const float c = __int_as_float(__builtin_amdgcn_readlane(__float_as_int(mygs), e)) * gelu_fast(a);
        axpy16(o, v8[4 * hb + qq], c);
      }
    }
  }
  __syncthreads();
#pragma unroll
  for (int i = 0; i < 16; ++i) red[w * 1024 + 16 * lane + i] = o[i];
  __syncthreads();
  if (w == 0) {
    const bf16* x1 = w_X1(p) + (size_t)token * DM + 16 * lane;
    const float* g2 = w_MOD(p) + (size_t)cond_row(token) * 6144 + 5120 + 16 * lane;
    float* y = p.out + O_YP + (size_t)token * DM + 16 * lane;
    f32x4 xv[4], gv[4];
#pragma unroll
    for (int mm = 0; mm < 4; ++mm) { xv[mm] = ldx4(x1 + 4 * mm); gv[mm] = *(const f32x4*)(g2 + 4 * mm); }
#pragma unroll
    for (int mm = 0; mm < 4; ++mm) {
      f32x4 yv;
#pragma unroll
      for (int j = 0; j < 4; ++j) { const int c = 16 * lane + 4 * mm + j; yv[j] = xv[mm][j] + gv[mm][j] * (red[c] + red[1024 + c] + red[2048 + c] + red[3072 + c]); }
      *(f32x4*)(y + 4 * mm) = yv;
    }
  }
}

constexpr int NPHASE = 8;

#if defined(PROBE_ATTN) || defined(PROBE_SAMP)
DI int probe_token(int i) { return (i * 131 + 3) % NPR; }
DI float block_sum_p(float v, float* red) {
  __syncthreads();
  v = wave_sum(v);
  if ((threadIdx.x & 63) == 0) red[threadIdx.x >> 6] = v;
  __syncthreads();
  return red[0] + red[1] + red[2] + red[3];
}
DI float block_max_p(float v, float* red) {
  __syncthreads();
  for (int o = 32; o >= 1; o >>= 1) v = fmaxf(v, __shfl_xor(v, o));
  if ((threadIdx.x & 63) == 0) red[threadIdx.x >> 6] = v;
  __syncthreads();
  return fmaxf(fmaxf(red[0], red[1]), fmaxf(red[2], red[3]));
}
#endif
#ifdef PROBE_ATTN
DI void probe_attn(const P& p, int i, char* smem) {
  float* red = (float*)smem;
  float* pr = red + 4;
  float* attn = pr + 128;
  float* rr = attn + 1024;
  const int token = probe_token(i), b = token >> 11, pos = token & 2047, t = threadIdx.x;
  const bf16* prow = w_PROJ(p) + (size_t)token * INW;
  for (int head = 0; head < 16; ++head) {
    const int hk = head >> 3;
    float s = -INFINITY;
    const int kp = pos - 127 + (t & 127);
    if (t < 128 && kp >= 0) {
      float a = 0.f;
      const bf16* kr = w_PROJ(p) + ((size_t)b * SEQ + kp) * INW + C_K + hk * 64;
      for (int d = 0; d < 64; ++d) a += bf2f(prow[head * 64 + d]) * bf2f(kr[d]);
      s = a + w_BIAS(p)[head * 128 + (pos - kp)];
    }
    float m = block_max_p(s, red);
    m = fmaxf(m, p.sinks[head]);
    const float e = (t < 128 && kp >= 0) ? __expf(s - m) : 0.f;
    const float den = block_sum_p(e, red) + __expf(p.sinks[head] - m);
    if (t < 128) pr[t] = e / den;
    __syncthreads();
    if (t < 64) {
      float o = 0.f;
      for (int j = 0; j < 128; ++j) { const int kq = pos - 127 + j; if (kq >= 0) o += pr[j] * bf2f(w_VT(p)[((size_t)(b * 2 + hk) * 64 + t) * SEQ + kq]); }
      attn[head * 64 + t] = o;
    }
    __syncthreads();
  }
  for (int c = t; c < 512; c += 256) {
    const int g = c >> 7, win = 2 << g;
    float tot = 0.f;
    for (int j = 0; j < win; ++j) if (pos - j >= 0) tot += bf2f(w_PROJ(p)[((size_t)b * SEQ + pos - j) * INW + C_PIN + c]);
    const float cnt = (float)(win < pos + 1 ? win : pos + 1);
    rr[c] = bf2f((bf16)(tot / cnt - bf2f(prow[C_PIN + c])));
  }
  __syncthreads();
  for (int f = t; f < 1024; f += 256) {
    const int g = f >> 8;
    float pl = 0.f;
    for (int ch = 0; ch < 128; ++ch) pl += rr[g * 128 + ch] * bf2f(w_PWt(p)[((size_t)g * 256 + (f & 255)) * 128 + ch]);
    const float naive = bf2f(prow[C_GA + f]) * attn[f] + bf2f(prow[C_GB + f]) * (pl * p.pool_scale[f]);
    const float fast = bf2f(w_MIXED(p)[(size_t)token * DM + f]);
    p.out[O_KWP + (size_t)i * DM + f] += (float)(PROBE_ATTN) * (fast - naive);
  }
  __syncthreads();
}
#endif

#ifdef PROBE_SAMP
DI void probe_samp(const P& p, int b, char* smem) {
  float* red = (float*)smem;
  float* pr = red + 4;
  float* attn = pr + 128;
  float* rr = attn + 1024;
  const int t = threadIdx.x;
  const size_t token = (size_t)NPR + b;
  const bf16* prow = w_PROJ(p) + token * INW;
  for (int head = 0; head < 16; ++head) {
    const int hk = head >> 3;
    float s = -INFINITY;
    if (t < 128) {
      const float* kr = t < 127 ? p.cache_k + (((size_t)b * 128 + t + 1) * 2 + hk) * 64 : p.out + O_KWS + (((size_t)b * 128 + 127) * 2 + hk) * 64;
      float a = 0.f;
      for (int d = 0; d < 64; ++d) a += bf2f(prow[head * 64 + d]) * kr[d];
      s = a + p.rel_table[(127 - t < 16 ? 127 - t : min(31, 16 + (int)(logf((float)(127 - t) / 16.f) / logf(8.f) * 16.f))) * 16 + head];
    }
    float m = block_max_p(s, red);
    m = fmaxf(m, p.sinks[head]);
    const float e = t < 128 ? __expf(s - m) : 0.f;
    const float den = block_sum_p(e, red) + __expf(p.sinks[head] - m);
    if (t < 128) pr[t] = e / den;
    __syncthreads();
    if (t < 64) {
      float o = 0.f;
      for (int j = 0; j < 128; ++j) { const float* vr = j < 127 ? p.cache_v + (((size_t)b * 128 + j + 1) * 2 + hk) * 64 : p.out + O_VWS + (((size_t)b * 128 + 127) * 2 + hk) * 64; o += pr[j] * vr[t]; }
      attn[head * 64 + t] = o;
    }
    __syncthreads();
  }
  for (int c = t; c < 512; c += 256) {
    const int g = c >> 7, win = 2 << g;
    const float cur = p.out[O_PS + ((size_t)b * 15 + 14) * 512 + c];
    float tot = cur;
    for (int j = 1; j < win; ++j) tot += p.state_pool[((size_t)b * 15 + 15 - j) * 512 + c];
    rr[c] = tot / (float)win - cur;
  }
  __syncthreads();
  for (int f = t; f < 1024; f += 256) {
    const int g = f >> 8;
    float pl = 0.f;
    for (int ch = 0; ch < 128; ++ch) pl += rr[g * 128 + ch] * p.pool_w[((size_t)g * 128 + ch) * 256 + (f & 255)];
    const float naive = bf2f(prow[C_GA + f]) * attn[f] + bf2f(prow[C_GB + f]) * (pl * p.pool_scale[f]);
    const float fast = bf2f(w_MIXED(p)[token * DM + f]);
    p.out[O_KWP + (size_t)b * DM + f] += (float)(PROBE_SAMP) * (fast - naive);
  }
  __syncthreads();
}
#endif
template <class First, class Main, class Fill> DI void run_with_filler(int G, int bid, int nmain, int nfill, First firstf, Main mainf, Fill fillf) {
  if (bid < nmain) { __syncthreads(); firstf(bid); }
  for (int u = bid; u < nmain; u += G) mainf(u, u + G < nmain ? u + G : -1);
  const int rem = nmain % G;
  if (rem == 0) { for (int f = bid; f < nfill; f += G) fillf(f); }
  else if (bid >= rem) { for (int f = bid - rem; f < nfill; f += G - rem) fillf(f); }
}
template <int PH> DI void run_phase(const P& p, char* smem) {
  const int G = gridDim.x, bid = blockIdx.x, w = __builtin_amdgcn_readfirstlane(threadIdx.x >> 6);
  if constexpr (PH == 0) { run_with_filler(G, bid, U0_MOD, F0_TOTAL, [&](int) {}, [&](int u, int) { unit_mod(p, u, smem); }, [&](int f) { phase0_filler(p, f, smem); }); }
  if constexpr (PH == 1) norm_phase(p, 0);
  if constexpr (PH == 2) {
    run_with_filler(G, bid, 129 * 30, F2_TOTAL - F2_TQ, [&](int u) { int mt, nt; gemm1_map(u, mt, nt); gemm_first(w_Wt_in(p), w_H(p), 1024, nt * 128, mt * 128, smem); },
                    [&](int u, int un) { unit_gemm1(p, u, un, smem); }, [&](int f) { phase2_filler(p, f < F2_TOUT ? f : f + F2_TQ, smem); });
  }
  if constexpr (PH == 3) {
    if (bid >= G / 2) for (int u = bid; u < 512; u += G) unit_attn_sample(p, u, smem);
    for (int u = bid; u < 512; u += G) unit_attn_prompt(p, u, smem);
    if (bid < G / 2) for (int u = bid; u < 512; u += G) unit_attn_sample(p, u, smem);
  }
  if constexpr (PH == 4) {
    run_with_filler(G, bid, G2_UNITS, F4_TOTAL + F2_TQ + F4_QU, [&](int u) { gemm2_first(p, u, smem); },
                    [&](int u, int un) { unit_gemm2(p, u, un, smem); }, [&](int f) { if (f < F4_TOTAL) unit_convert(p.sub_keys, w_SK(p), f);
                                 else if (f < F4_TOTAL + F2_TQ) { const int v = f - F4_TOTAL; unit_transpose(p.w_query, w_Wt_q(p), 1024, 2048, v / 32, v % 32, smem); }
                                 else unit_quant_rows<true>(p.peer_u, w_Ub(p), w_SU(p), f - F4_TOTAL - F2_TQ); });
  }
  if constexpr (PH == 5) norm_phase(p, 1);
  if constexpr (PH == 6) {
    auto fill = [&](int f) { if (f >= F6_QV) unit_quant_rows<true>(p.peer_u, w_Ub(p), w_SU(p), F4_QU + f - F6_QV); else unit_quant_rows<false>(p.peer_v, w_Vb(p), w_SV(p), f); };
    if (bid < 1024) { __syncthreads(); route_first(p, bid, smem); }
    for (int u = bid; u < 1024; u += G) unit_peer_route<false>(p, u, u + G < 1024 ? u + G : -1, smem);
    const int nh = R_UNITS - 1024, nhb = nh < G ? nh : 0;
    for (int u = 1024 + bid; u < R_UNITS; u += G) { __syncthreads(); route_first(p, u, smem); unit_peer_route<true>(p, u, -1, smem); }
    if (bid >= nhb) for (int f = bid - nhb; f < F6_TOTAL; f += G - nhb) fill(f);
  }
  if constexpr (PH == 7) {
    for (int g = bid * 4 + w; g < NPR / 4; g += G * 4) peer_wave4<0>(p, g, smem + w * PEER_WLDS);
    for (int s = bid; s < NS; s += G) peer_token_block(p, NPR + s, smem + 4 * PEER_WLDS);
  }
}
#if ONE_LAUNCH
__global__ void __launch_bounds__(NTHREADS, 2) mega(P p) {
  __shared__ __attribute__((aligned(16))) char smem[SMEM_BYTES + 16];
  volatile unsigned* st = (volatile unsigned*)(smem + SMEM_BYTES);
  if (threadIdx.x == 0) { st[0] = 0u; st[1] = 0u; }
  __syncthreads();
  const unsigned xcc = xb_xcc_id();
  if (threadIdx.x == 0) (void)xb_add(&w_bar(p)[XB_XCNT(xcc)], 1u);
#ifndef REPEAT_MASK
#define REPEAT_MASK 0
#endif
#define RUN_PH(k) do { run_phase<k>(p, smem); if ((REPEAT_MASK >> k) & 1) { xcd_barrier(w_bar(p), xcc, st); run_phase<k>(p, smem); } } while (0)
  RUN_PH(0); xcd_barrier(w_bar(p), xcc, st);
  RUN_PH(1); xcd_barrier(w_bar(p), xcc, st);
  RUN_PH(2); xcd_barrier(w_bar(p), xcc, st);
  RUN_PH(3); xcd_barrier(w_bar(p), xcc, st);
#ifdef PROBE_ATTN
  for (int i = blockIdx.x; i < 128; i += gridDim.x) probe_attn(p, i, smem);
  xcd_barrier(w_bar(p), xcc, st);
#endif
#ifdef PROBE_SAMP
  for (int i = blockIdx.x; i < 128; i += gridDim.x) probe_samp(p, i, smem);
  xcd_barrier(w_bar(p), xcc, st);
#endif
  RUN_PH(4); xcd_barrier(w_bar(p), xcc, st);
  RUN_PH(5); xcd_barrier(w_bar(p), xcc, st);
  RUN_PH(6); xcd_barrier(w_bar(p), xcc, st);
#if PEER_ALIGN
  { const int G = gridDim.x, bid = blockIdx.x, w = __builtin_amdgcn_readfirstlane(threadIdx.x >> 6);
    if (NPR / 4 == 2 * G * 4) {
      for (int s = bid; s < NS; s += G) { peer_token_block(p, NPR + s, smem); __syncthreads(); }
      const int g = bid * 4 + w;
      peer_wave8(p, g, g + G * 4, smem + w * PEER_WLDS2);
    } else { RUN_PH(7); } }
#else
  RUN_PH(7);
#endif
}
#else
template <int PH> __global__ void __launch_bounds__(NTHREADS, 2) mega(P p) {
  __shared__ __attribute__((aligned(16))) char smem[SMEM_BYTES];
  run_phase<PH>(p, smem);
}
#endif


extern "C" void kernel_launch(void* const* d_in, const int* in_sizes, int n_in, void* d_out, int out_size, void* d_ws, size_t ws_size, hipStream_t stream) {
  P p{};
  const float* const* in = (const float* const*)d_in;
  p.x_prompt = in[0]; p.x_sample = in[1]; p.cache_k = in[2]; p.cache_v = in[3]; p.state_pool = in[4]; p.c_prompt = in[5]; p.c_sample = in[6];
  p.rel_table = in[7]; p.ada_w = in[8]; p.ada_b = in[9]; p.norm1_g = in[10]; p.w_in = in[11]; p.q_norm_g = in[12]; p.k_norm_g = in[13]; p.sinks = in[14];
  p.pool_w = in[15]; p.pool_scale = in[16]; p.w_out = in[17]; p.norm2_g = in[18]; p.w_query = in[19]; p.sub_keys = in[20]; p.peer_u = in[21]; p.peer_v = in[22];
  p.out = (float*)d_out;
  p.ws = (char*)d_ws;
  if (WS_NEED > ws_size) { fprintf(stderr, "workspace too small: need %zu have %zu\n", (size_t)WS_NEED, ws_size); return; }

  static int grid_blocks = 0;
  if (!grid_blocks) {
    int dev = 0, cus = 0, per_cu = 0;
    (void)hipGetDevice(&dev);
    (void)hipDeviceGetAttribute(&cus, hipDeviceAttributeMultiprocessorCount, dev);
#if ONE_LAUNCH
    (void)hipOccupancyMaxActiveBlocksPerMultiprocessor(&per_cu, mega, NTHREADS, 0);
#else
    per_cu = 2;
#endif
    if (per_cu > 2) per_cu = 2;
    if (per_cu < 1) per_cu = 1;
    if (cus < 1) cus = 256;
    grid_blocks = cus * per_cu;
  }
#if ONE_LAUNCH
  (void)hipMemsetAsync(p.ws + OFF_BAR, 0, XCD_BAR_WORDS * 4, stream);
  hipLaunchKernelGGL(mega, dim3(grid_blocks), dim3(NTHREADS), 0, stream, p);
#else
  hipLaunchKernelGGL(mega<0>, dim3(grid_blocks), dim3(NTHREADS), 0, stream, p);
  hipLaunchKernelGGL(mega<1>, dim3(grid_blocks), dim3(NTHREADS), 0, stream, p);
  hipLaunchKernelGGL(mega<2>, dim3(grid_blocks), dim3(NTHREADS), 0, stream, p);
  hipLaunchKernelGGL(mega<3>, dim3(grid_blocks), dim3(NTHREADS), 0, stream, p);
  hipLaunchKernelGGL(mega<4>, dim3(grid_blocks), dim3(NTHREADS), 0, stream, p);
  hipLaunchKernelGGL(mega<5>, dim3(grid_blocks), dim3(NTHREADS), 0, stream, p);
  hipLaunchKernelGGL(mega<6>, dim3(grid_blocks), dim3(NTHREADS), 0, stream, p);
  hipLaunchKernelGGL(mega<7>, dim3(grid_blocks), dim3(NTHREADS), 0, stream, p);
#endif

}
```
